# Optimizing an MI355X kernel written in HIP

```python
import jax, jax.numpy as jnp
from jax import lax
import numpy as np

D_MODEL = 1024
BATCH = 16
SEQ = 2048
DEPTH = 2
DEC_BATCH = 4
DEC_SEQ = 4096
PAST_LEN = 128

GRID_W = 64
N_MEM = 256
HEAD_DIM = 64
N_HEADS = 8
N_KV_HEADS = 2
ATTN_W = N_HEADS * HEAD_DIM
KV_W = N_KV_HEADS * HEAD_DIM
POOL_W = 256
POOL_WINDOWS = (2, 4, 8, 16)
POOL_GROUP = POOL_W // len(POOL_WINDOWS)
N_XHEADS = 4
XATTN_W = N_XHEADS * HEAD_DIM
MIX_W = POOL_W + ATTN_W + XATTN_W
IN_W = 2 * POOL_W + 2 * ATTN_W + 2 * KV_W + 2 * XATTN_W
Q_BLOCK = 128
ROPE_THETA = 10000.0
ROPE_PAIRS = HEAD_DIM // 4
EPS = 1e-6

kernel_name = "hybrid_pool_gqa_memory_encoder"


def rms_norm(x, g):
    xf = x.astype(jnp.float32)
    y = xf * lax.rsqrt(jnp.mean(xf * xf, axis=-1, keepdims=True) + EPS)
    return (y * g.astype(jnp.float32)).astype(x.dtype)


def axial_rope(T):
    rows = T // GRID_W
    row = jnp.repeat(jnp.arange(rows), GRID_W).astype(jnp.float32)
    col = jnp.tile(jnp.arange(GRID_W), rows).astype(jnp.float32)
    freqs = ROPE_THETA ** (-jnp.arange(ROPE_PAIRS, dtype=jnp.float32) / ROPE_PAIRS)
    ang = jnp.stack([row[:, None] * freqs, col[:, None] * freqs], axis=1)
    return jnp.cos(ang), jnp.sin(ang)


def apply_rope(x, cos, sin):
    B, T, H, D = x.shape
    xr = x.astype(jnp.float32).reshape(B, T, H, 2, 2, ROPE_PAIRS)
    a, b = xr[..., 0, :], xr[..., 1, :]
    c, s = cos[None, :, None], sin[None, :, None]
    out = jnp.stack([a * c - b * s, b * c + a * s], axis=-2)
    return out.reshape(B, T, H, D).astype(x.dtype)


def multiscale_pool(u, pool_w, pool_scale):
    B, T, _ = u.shape
    uf = u.astype(jnp.float32)
    cs = jnp.concatenate([jnp.zeros((B, 1, POOL_W), jnp.float32), jnp.cumsum(uf, axis=1)], axis=1)
    t = jnp.arange(T)
    outs = []
    for g, w in enumerate(POOL_WINDOWS):
        lo = jnp.clip(t - w // 2, 0, T)
        hi = jnp.clip(t + w - w // 2, 0, T)
        sl = slice(g * POOL_GROUP, (g + 1) * POOL_GROUP)
        csg = cs[:, :, sl]
        cnt = (hi - lo).astype(jnp.float32)[None, :, None]
        mean = (jnp.take(csg, hi, axis=1) - jnp.take(csg, lo, axis=1)) / cnt
        d = (mean - uf[:, :, sl]).astype(u.dtype)
        outs.append(jnp.einsum('btc,cd->btd', d, pool_w[g]))
    return jnp.concatenate(outs, axis=-1) * pool_scale


def block_self_attention(q, k, v):
    B, T, H, D = q.shape
    G = H // N_KV_HEADS
    nb = T // Q_BLOCK
    qb = q.reshape(B, nb, Q_BLOCK, N_KV_HEADS, G, D).transpose(1, 0, 2, 3, 4, 5)
    scale = D ** -0.5

    def one_block(qblk):
        s = jnp.einsum('bqkgd,bskd->bkgqs', qblk, k, preferred_element_type=jnp.float32) * scale
        p = jax.nn.softmax(s, axis=-1)
        return jnp.einsum('bkgqs,bskd->bqkgd', p.astype(v.dtype), v)

    o = lax.map(one_block, qb)
    return o.transpose(1, 0, 2, 3, 4, 5).reshape(B, T, H * D)


def memory_attention(q, k, v):
    B, T, XH, D = q.shape
    s = jnp.einsum('bthd,bmhd->bhtm', q, k, preferred_element_type=jnp.float32) * (D ** -0.5)
    p = jax.nn.softmax(s, axis=-1)
    return jnp.einsum('bhtm,bmhd->bthd', p.astype(v.dtype), v).reshape(B, T, XH * D)


SPLITS = [int(i) for i in np.cumsum([POOL_W, POOL_W, ATTN_W, KV_W, KV_W, ATTN_W, XATTN_W])]


def hybrid_layer(x, mem, cos, sin, norm_pre, norm_post, w_in, pool_w, pool_scale,
                 q_norm, k_norm, mem_norm, w_mem_kv, w_out):
    B, T, _ = x.shape
    h = rms_norm(x, norm_pre)
    z = jnp.einsum('btd,de->bte', h, w_in)
    u_pool, g_pool, q, k, v, g_attn, q_x, g_x = jnp.split(z, SPLITS, axis=-1)

    pool_out = multiscale_pool(u_pool, pool_w, pool_scale) * jax.nn.silu(g_pool)

    q = apply_rope(rms_norm(q.reshape(B, T, N_HEADS, HEAD_DIM), q_norm), cos, sin)
    k = apply_rope(rms_norm(k.reshape(B, T, N_KV_HEADS, HEAD_DIM), k_norm), cos, sin)
    v = v.reshape(B, T, N_KV_HEADS, HEAD_DIM)
    attn_out = block_self_attention(q, k, v) * jax.nn.silu(g_attn)

    mh = rms_norm(mem, mem_norm)
    kv_m = jnp.einsum('bmd,de->bme', mh, w_mem_kv)
    k_m, v_m = jnp.split(kv_m, [XATTN_W], axis=-1)
    M = mem.shape[1]
    x_out = memory_attention(q_x.reshape(B, T, N_XHEADS, HEAD_DIM),
                             k_m.reshape(B, M, N_XHEADS, HEAD_DIM),
                             v_m.reshape(B, M, N_XHEADS, HEAD_DIM)) * jax.nn.silu(g_x)

    mix = jnp.concatenate([pool_out, attn_out, x_out], axis=-1)
    y = jnp.einsum('bte,ed->btd', mix, w_out)
    return x + rms_norm(y, norm_post)


def run_trunk(x, mem, norm_pre, norm_post, w_in, pool_w, pool_scale,
              q_norm, k_norm, mem_norm, w_mem_kv, w_out):
    cos, sin = axial_rope(x.shape[1])
    for l in range(DEPTH):
        x = hybrid_layer(x, mem, cos, sin, norm_pre[l], norm_post[l], w_in[l], pool_w[l], pool_scale[l],
                         q_norm[l], k_norm[l], mem_norm[l], w_mem_kv[l], w_out[l])
    return x


def setup_inputs(seed: int = 0) -> dict:
    key = jax.random.key(seed)
    ks = jax.random.split(key, 16)
    f32 = jnp.float32

    def gain(k, shape):
        return 1.0 + 0.02 * jax.random.normal(k, shape, f32)

    return {
        "x_prompt": jax.random.normal(ks[0], (BATCH, SEQ, D_MODEL), f32),
        "x_sample": jax.random.normal(ks[1], (DEC_BATCH, DEC_SEQ, D_MODEL), f32),
        "mem_prompt": jax.random.normal(ks[2], (BATCH, N_MEM, D_MODEL), f32),
        "mem_sample": jax.random.normal(ks[3], (DEC_BATCH, N_MEM, D_MODEL), f32),
        "norm_pre": gain(ks[4], (DEPTH, D_MODEL)),
        "norm_post": gain(ks[5], (DEPTH, D_MODEL)),
        "w_in": jax.random.normal(ks[6], (DEPTH, D_MODEL, IN_W), f32) * D_MODEL ** -0.5,
        "pool_w": jax.random.normal(ks[7], (DEPTH, len(POOL_WINDOWS), POOL_GROUP, POOL_GROUP), f32) * POOL_GROUP ** -0.5,
        "pool_scale": 1.0 + 0.1 * jax.random.normal(ks[8], (DEPTH, POOL_W), f32),
        "q_norm": gain(ks[9], (DEPTH, HEAD_DIM)),
        "k_norm": gain(ks[10], (DEPTH, HEAD_DIM)),
        "mem_norm": gain(ks[11], (DEPTH, D_MODEL)),
        "w_mem_kv": jax.random.normal(ks[12], (DEPTH, D_MODEL, 2 * XATTN_W), f32) * D_MODEL ** -0.5,
        "w_out": jax.random.normal(ks[13], (DEPTH, MIX_W, D_MODEL), f32) * MIX_W ** -0.5,
    }


def reference(x_prompt, x_sample, mem_prompt, mem_sample, norm_pre, norm_post, w_in, pool_w, pool_scale,
              q_norm, k_norm, mem_norm, w_mem_kv, w_out):
    y_prompt = run_trunk(x_prompt, mem_prompt, norm_pre, norm_post, w_in, pool_w, pool_scale,
                         q_norm, k_norm, mem_norm, w_mem_kv, w_out)
    y_sample = run_trunk(x_sample, mem_sample, norm_pre, norm_post, w_in, pool_w, pool_scale,
                         q_norm, k_norm, mem_norm, w_mem_kv, w_out)
    return (y_prompt, y_sample)
```

```cpp
#include <hip/hip_runtime.h>
#include <hip/hip_cooperative_groups.h>
#include <stdint.h>
#include <cstdio>
namespace cg = cooperative_groups;

typedef unsigned short bf16_t;
typedef short bf16x8 __attribute__((ext_vector_type(8)));
typedef float f32x4 __attribute__((ext_vector_type(4)));
typedef float f32x16 __attribute__((ext_vector_type(16)));
typedef unsigned u32x4 __attribute__((ext_vector_type(4)));
typedef unsigned u32x2 __attribute__((ext_vector_type(2)));
typedef __bf16 bf16x2_t __attribute__((ext_vector_type(2)));
typedef float f32x2_t __attribute__((ext_vector_type(2)));
#define DI __device__ __forceinline__

constexpr int NTOK = 49152;
constexpr int NPROMPT = 32768;
constexpr int DM = 1024;
constexpr int INW = 2304;
constexpr int NMEMTOK = 5120;
constexpr int DEPTH = 2;
constexpr float EPS = 1e-6f;
constexpr float L2E = 1.4426950408889634f;

constexpr size_t OFF_H    = 0;
constexpr size_t OFF_Z    = OFF_H + (size_t)NTOK * DM * 2;
constexpr size_t OFF_VT   = OFF_Z + (size_t)NTOK * INW * 2;
constexpr size_t OFF_MIX  = OFF_VT + (size_t)NTOK * 128 * 2;
constexpr size_t OFF_WIN  = OFF_MIX + (size_t)NTOK * DM * 2;
constexpr size_t OFF_WOUT = OFF_WIN + (size_t)DEPTH * INW * DM * 2;
constexpr size_t OFF_WMEM = OFF_WOUT + (size_t)DEPTH * DM * DM * 2;
constexpr size_t OFF_PW   = OFF_WMEM + (size_t)DEPTH * 512 * DM * 2;
constexpr size_t OFF_MH   = OFF_PW + (size_t)DEPTH * 4 * 64 * 64 * 2;
constexpr size_t OFF_KM   = OFF_MH + (size_t)DEPTH * NMEMTOK * DM * 2;
constexpr size_t OFF_VMT  = OFF_KM + (size_t)DEPTH * NMEMTOK * 256 * 2;
constexpr size_t OFF_ROPE = OFF_VMT + (size_t)DEPTH * NMEMTOK * 256 * 2;
constexpr size_t WS_TOTAL = OFF_ROPE + 64 * 16 * 2 * 4;

struct Params {
    const float* x_prompt; const float* x_sample; const float* mem_prompt; const float* mem_sample;
    const float* norm_pre; const float* norm_post; const float* w_in; const float* pool_w; const float* pool_scale;
    const float* q_norm; const float* k_norm; const float* mem_norm; const float* w_mem_kv; const float* w_out;
    float* out; unsigned char* ws;
    int phase_begin; int phase_end;
};

DI unsigned pk_bf16(float a, float b) {
    f32x2_t v = {a, b};
    bf16x2_t r = __builtin_convertvector(v, bf16x2_t);
    return __builtin_bit_cast(unsigned, r);
}
DI int opaque_tid() { int t = threadIdx.x; asm volatile("" : "+v"(t)); return t; }
DI float bflo(unsigned u) { return __uint_as_float(u << 16); }
DI float bfhi(unsigned u) { return __uint_as_float(u & 0xffff0000u); }
DI float wave_sum(float v) {
    v += __shfl_xor(v, 1); v += __shfl_xor(v, 2); v += __shfl_xor(v, 4);
    v += __shfl_xor(v, 8); v += __shfl_xor(v, 16); v += __shfl_xor(v, 32);
    return v;
}
DI float silu_f(float x) { return x * __builtin_amdgcn_rcpf(1.0f + __builtin_amdgcn_exp2f(-x * L2E)); }
DI f32x4 mfma16(bf16x8 a, bf16x8 b, f32x4 c) { return __builtin_amdgcn_mfma_f32_16x16x32_bf16(a, b, c, 0, 0, 0); }
DI f32x16 mfma32(bf16x8 a, bf16x8 b, f32x16 c) { return __builtin_amdgcn_mfma_f32_32x32x16_bf16(a, b, c, 0, 0, 0); }

DI void transpose_tile(const float* __restrict__ src, int ldn, bf16_t* __restrict__ dst, int ldk, int k0, int n0, unsigned char* smem) {
    float* tile = (float*)smem;
    const int tid = opaque_tid();
    __syncthreads();
#pragma unroll
    for (int i = 0; i < 16; ++i) {
        const int r = i * 4 + (tid >> 6), c = tid & 63;
        tile[r * 65 + c] = src[(size_t)(k0 + r) * ldn + n0 + c];
    }
    __syncthreads();
#pragma unroll
    for (int i = 0; i < 8; ++i) {
        const int n = i * 8 + (tid >> 5), kp = tid & 31;
        const float v0 = tile[(2 * kp) * 65 + n], v1 = tile[(2 * kp + 1) * 65 + n];
        *(unsigned*)(dst + (size_t)(n0 + n) * ldk + k0 + 2 * kp) = pk_bf16(v0, v1);
    }
}

DI void rms_row_f32(const float* __restrict__ src, const float* __restrict__ g, bf16_t* __restrict__ dst, int lane) {
    f32x4 v[4]; float ss = 0.f;
#pragma unroll
    for (int j = 0; j < 4; ++j) { v[j] = *(const f32x4*)(src + j * 256 + lane * 4); ss += v[j][0] * v[j][0] + v[j][1] * v[j][1] + v[j][2] * v[j][2] + v[j][3] * v[j][3]; }
    ss = wave_sum(ss);
    const float r = rsqrtf(ss * (1.0f / 1024.0f) + EPS);
#pragma unroll
    for (int j = 0; j < 4; ++j) {
        const f32x4 gg = *(const f32x4*)(g + j * 256 + lane * 4);
        u32x2 o; o.x = pk_bf16(v[j][0] * r * gg[0], v[j][1] * r * gg[1]); o.y = pk_bf16(v[j][2] * r * gg[2], v[j][3] * r * gg[3]);
        *(u32x2*)(dst + j * 256 + lane * 4) = o;
    }
}

DI void rope_entry(int idx, float* table) {
    const int n = idx >> 4, pp = idx & 15;
    const double fd = exp2(-(double)pp * (13.287712379549449 / 16.0));
    const float f = (float)fd;
    const float a = (float)n * f;
    double r = (double)a;
    const double k = rint(r * 0.15915494309189535);
    r -= k * 6.283185307179586;
    const double r2 = r * r;
    double sn = r, cs = 1.0, ts = r, tc = 1.0;
    for (int i = 1; i <= 16; ++i) {
        tc = -tc * r2 / (double)((2 * i - 1) * (2 * i));
        ts = -ts * r2 / (double)((2 * i) * (2 * i + 1));
        cs += tc; sn += ts;
    }
    table[idx * 2] = (float)cs; table[idx * 2 + 1] = (float)sn;
}

struct EpiArgs {
    bf16_t* C;
    bf16_t* VT;
    const float* qn; const float* kn; const float* rope;
};

template <int MODE>
DI void gemm_tile(const bf16_t* __restrict__ A, const bf16_t* __restrict__ Bt, int m0, int n0, const EpiArgs& e, unsigned char* smem) {
    const int tid = opaque_tid(), lane = tid & 63, wave = tid >> 6;
    const int wm = wave & 1, wn = wave >> 1;
    const int lrow = tid >> 3, lc = tid & 7;
    const bf16_t* Ag = A + (size_t)(m0 + lrow) * 1024 + lc * 8;
    const bf16_t* Bg = Bt + (size_t)(n0 + lrow) * 1024 + lc * 8;
    const int st_off = lrow * 128 + ((lc ^ ((lrow >> 1) & 7)) << 4);
    const int r16 = lane & 15, q4 = lane >> 4;
    const int fr_off = r16 * 128 + ((q4 ^ (r16 >> 1)) << 4);
    const int a_base = 16384 + (wn * 64) * 128;
    const int b_base = (wm * 64) * 128;

    f32x4 acc[4][4];
#pragma unroll
    for (int i = 0; i < 4; ++i)
#pragma unroll
        for (int j = 0; j < 4; ++j) acc[i][j] = (f32x4){0.f, 0.f, 0.f, 0.f};

    u32x4 ra[4], rb[4];
#pragma unroll
    for (int i = 0; i < 4; ++i) { ra[i] = *(const u32x4*)(Ag + (size_t)i * 32 * 1024); rb[i] = *(const u32x4*)(Bg + (size_t)i * 32 * 1024); }
#pragma unroll
    for (int i = 0; i < 4; ++i) { *(u32x4*)(smem + st_off + i * 4096) = ra[i]; *(u32x4*)(smem + 16384 + st_off + i * 4096) = rb[i]; }
    __syncthreads();

    for (int kt = 0; kt < 16; ++kt) {
        const int cur = (kt & 1) * 32768, nxt = 32768 - cur;
        if (kt < 15) {
#pragma unroll
            for (int i = 0; i < 4; ++i) { ra[i] = *(const u32x4*)(Ag + (size_t)i * 32 * 1024 + (kt + 1) * 64); rb[i] = *(const u32x4*)(Bg + (size_t)i * 32 * 1024 + (kt + 1) * 64); }
        }
#pragma unroll
        for (int ks = 0; ks < 2; ++ks) {
            bf16x8 wf[4], tf[4];
#pragma unroll
            for (int i = 0; i < 4; ++i) {
                wf[i] = *(const bf16x8*)(smem + cur + a_base + i * 2048 + (fr_off ^ (ks * 64)));
                tf[i] = *(const bf16x8*)(smem + cur + b_base + i * 2048 + (fr_off ^ (ks * 64)));
            }
#pragma unroll
            for (int fi = 0; fi < 4; ++fi)
#pragma unroll
                for (int ti = 0; ti < 4; ++ti) acc[fi][ti] = mfma16(wf[fi], tf[ti], acc[fi][ti]);
        }
        if (kt < 15) {
#pragma unroll
            for (int i = 0; i < 4; ++i) { *(u32x4*)(smem + nxt + st_off + i * 4096) = ra[i]; *(u32x4*)(smem + nxt + 16384 + st_off + i * 4096) = rb[i]; }
        }
        __syncthreads();
    }

    const int cb = n0 + wn * 64;
    const int tokb = m0 + wm * 64 + r16;
    if (MODE == 1) {
#pragma unroll
        for (int ti = 0; ti < 4; ++ti) {
            bf16_t* rowp = e.C + (size_t)(tokb + ti * 16) * 1024 + cb + 4 * q4;
#pragma unroll
            for (int fi = 0; fi < 4; ++fi) {
                u32x2 o; o.x = pk_bf16(acc[fi][ti][0], acc[fi][ti][1]); o.y = pk_bf16(acc[fi][ti][2], acc[fi][ti][3]);
                *(u32x2*)(rowp + fi * 16) = o;
            }
        }
    } else if (MODE == 2) {
        if (cb < 256) {
#pragma unroll
            for (int ti = 0; ti < 4; ++ti) {
                bf16_t* rowp = e.C + (size_t)(tokb + ti * 16) * 256 + cb + 4 * q4;
#pragma unroll
                for (int fi = 0; fi < 4; ++fi) {
                    u32x2 o; o.x = pk_bf16(acc[fi][ti][0], acc[fi][ti][1]); o.y = pk_bf16(acc[fi][ti][2], acc[fi][ti][3]);
                    *(u32x2*)(rowp + fi * 16) = o;
                }
            }
        } else {
            const int hx = (cb - 256) >> 6;
#pragma unroll
            for (int ti = 0; ti < 4; ++ti) {
                const int mt = tokb + ti * 16, b = mt >> 8, m = mt & 255;
                bf16_t* bp = e.VT + ((size_t)(b * 4 + hx) * 64) * 256 + m;
#pragma unroll
                for (int fi = 0; fi < 4; ++fi)
#pragma unroll
                    for (int i = 0; i < 4; ++i) bp[(size_t)(fi * 16 + 4 * q4 + i) * 256] = (bf16_t)(pk_bf16(acc[fi][ti][i], 0.f) & 0xffffu);
            }
        }
    } else {
        if (cb >= 512 && cb < 1152) {
            const bool isq = cb < 1024;
            const float* gn = isq ? e.qn : e.kn;
            const float osc = isq ? 0.125f : 1.0f;
            f32x4 g[4];
#pragma unroll
            for (int fi = 0; fi < 4; ++fi) g[fi] = *(const f32x4*)(gn + fi * 16 + 4 * q4);
#pragma unroll
            for (int ti = 0; ti < 4; ++ti) {
                const int tok = tokb + ti * 16;
                float ss = 0.f;
#pragma unroll
                for (int fi = 0; fi < 4; ++fi)
#pragma unroll
                    for (int i = 0; i < 4; ++i) ss += acc[fi][ti][i] * acc[fi][ti][i];
                ss += __shfl_xor(ss, 16); ss += __shfl_xor(ss, 32);
                const float rinv = rsqrtf(ss * (1.0f / 64.0f) + EPS);
                const int t = (tok < NPROMPT) ? (tok & 2047) : (tok & 4095);
                const int rowi = t >> 6, coli = t & 63;
                const f32x4* rt = (const f32x4*)(e.rope + (rowi * 16 + 4 * q4) * 2);
                const f32x4* ct = (const f32x4*)(e.rope + (coli * 16 + 4 * q4) * 2);
                const f32x4 r01 = rt[0], r23 = rt[1], c01 = ct[0], c23 = ct[1];
                const float rc[4] = {r01[0], r01[2], r23[0], r23[2]}, rs[4] = {r01[1], r01[3], r23[1], r23[3]};
                const float cc[4] = {c01[0], c01[2], c23[0], c23[2]}, cs[4] = {c01[1], c01[3], c23[1], c23[3]};
                float o[4][4];
#pragma unroll
                for (int i = 0; i < 4; ++i) {
                    const float a0 = acc[0][ti][i] * rinv * g[0][i], b0 = acc[1][ti][i] * rinv * g[1][i];
                    const float a1 = acc[2][ti][i] * rinv * g[2][i], b1 = acc[3][ti][i] * rinv * g[3][i];
                    o[0][i] = (a0 * rc[i] - b0 * rs[i]) * osc; o[1][i] = (b0 * rc[i] + a0 * rs[i]) * osc;
                    o[2][i] = (a1 * cc[i] - b1 * cs[i]) * osc; o[3][i] = (b1 * cc[i] + a1 * cs[i]) * osc;
                }
                bf16_t* rowp = e.C + (size_t)tok * INW + cb + 4 * q4;
#pragma unroll
                for (int fi = 0; fi < 4; ++fi) {
                    u32x2 w; w.x = pk_bf16(o[fi][0], o[fi][1]); w.y = pk_bf16(o[fi][2], o[fi][3]);
                    *(u32x2*)(rowp + fi * 16) = w;
                }
            }
        } else if (cb >= 1152 && cb < 1280) {
            const int kvh = (cb - 1152) >> 6;
#pragma unroll
            for (int ti = 0; ti < 4; ++ti) {
                const int tok = tokb + ti * 16;
                bf16_t* bp; size_t T;
                if (tok < NPROMPT) { const int b = tok >> 11, t = tok & 2047; T = 2048; bp = e.VT + ((size_t)(b * 2 + kvh) * 64) * 2048 + t; }
                else { const int b = (tok - NPROMPT) >> 12, t = tok & 4095; T = 4096; bp = e.VT + (size_t)NPROMPT * 128 + ((size_t)(b * 2 + kvh) * 64) * 4096 + t; }
#pragma unroll
                for (int fi = 0; fi < 4; ++fi)
#pragma unroll
                    for (int i = 0; i < 4; ++i) bp[(size_t)(fi * 16 + 4 * q4 + i) * T] = (bf16_t)(pk_bf16(acc[fi][ti][i], 0.f) & 0xffffu);
            }
        } else {
            const int kind = (cb < 256) ? 0 : ((cb >= 1792 && cb < 2048) ? 2 : 1);
#pragma unroll
            for (int ti = 0; ti < 4; ++ti) {
                bf16_t* rowp = e.C + (size_t)(tokb + ti * 16) * INW + cb + 4 * q4;
#pragma unroll
                for (int fi = 0; fi < 4; ++fi) {
                    float v[4];
#pragma unroll
                    for (int i = 0; i < 4; ++i) { const float x = acc[fi][ti][i]; v[i] = (kind == 0) ? x : ((kind == 2) ? x * 0.125f : silu_f(x)); }
                    u32x2 o; o.x = pk_bf16(v[0], v[1]); o.y = pk_bf16(v[2], v[3]);
                    *(u32x2*)(rowp + fi * 16) = o;
                }
            }
        }
    }
}

DI void attn_item(const bf16_t* __restrict__ Q, int ldq, const bf16_t* __restrict__ K, int ldk, const bf16_t* __restrict__ VT, int ldv,
                  int nkeys, bf16_t* __restrict__ O, const bf16_t* __restrict__ G, unsigned char* smem) {
    const int tid = opaque_tid(), lane = tid & 63, wave = tid >> 6;
    const int r = lane & 31, h = lane >> 5;
    bf16x8 qf[4];
    {
        const bf16_t* qp = Q + (size_t)(wave * 32 + r) * ldq + h * 8;
#pragma unroll
        for (int ks = 0; ks < 4; ++ks) qf[ks] = *(const bf16x8*)(qp + ks * 16);
    }
    const int lrow = tid >> 3, lc = tid & 7;
    const bf16_t* Kg = K + (size_t)lrow * ldk + lc * 8;
    const bf16_t* Vg = VT + (size_t)lrow * ldv + lc * 8;
    const int st_off = lrow * 128 + ((lc ^ ((lrow >> 1) & 7)) << 4);
    const int pr = (r & ~12) | ((r & 4) << 1) | ((r & 8) >> 1);
    const int kswz = (pr >> 1) & 7, vswz = (r >> 1) & 7;
    const int k_off = pr * 128, v_off = r * 128;

    f32x16 o0, o1;
#pragma unroll
    for (int i = 0; i < 16; ++i) { o0[i] = 0.f; o1[i] = 0.f; }
    float m = -1e30f, lsum = 0.f;

    u32x4 rk[2], rv[2];
#pragma unroll
    for (int i = 0; i < 2; ++i) { rk[i] = *(const u32x4*)(Kg + (size_t)i * 32 * ldk); rv[i] = *(const u32x4*)(Vg + (size_t)i * 32 * ldv); }
    __syncthreads();
#pragma unroll
    for (int i = 0; i < 2; ++i) { *(u32x4*)(smem + st_off + i * 4096) = rk[i]; *(u32x4*)(smem + 8192 + st_off + i * 4096) = rv[i]; }
    __syncthreads();

    const int nt = nkeys >> 6;
    for (int kt = 0; kt < nt; ++kt) {
        const int cur = (kt & 1) * 16384, nxt = 16384 - cur;
        if (kt + 1 < nt) {
#pragma unroll
            for (int i = 0; i < 2; ++i) {
                rk[i] = *(const u32x4*)(Kg + (size_t)((kt + 1) * 64 + i * 32) * ldk);
                rv[i] = *(const u32x4*)(Vg + (size_t)i * 32 * ldv + (kt + 1) * 64);
            }
        }
        f32x16 s0, s1;
#pragma unroll
        for (int i = 0; i < 16; ++i) { s0[i] = 0.f; s1[i] = 0.f; }
#pragma unroll
        for (int ks = 0; ks < 4; ++ks) {
            const int co = ((ks * 2 + h) ^ kswz) << 4;
            const bf16x8 k0 = *(const bf16x8*)(smem + cur + k_off + co);
            const bf16x8 k1 = *(const bf16x8*)(smem + cur + 4096 + k_off + co);
            s0 = mfma32(k0, qf[ks], s0);
            s1 = mfma32(k1, qf[ks], s1);
        }
        float mx = s0[0];
#pragma unroll
        for (int i = 1; i < 16; ++i) mx = fmaxf(mx, s0[i]);
#pragma unroll
        for (int i = 0; i < 16; ++i) mx = fmaxf(mx, s1[i]);
        mx = fmaxf(mx, __shfl_xor(mx, 32));
        const float mnew = fmaxf(m, mx);
        const float alpha = __builtin_amdgcn_exp2f((m - mnew) * L2E);
        m = mnew;
        const float mb = mnew * L2E;
        float rs = 0.f;
#pragma unroll
        for (int i = 0; i < 16; ++i) { s0[i] = __builtin_amdgcn_exp2f(s0[i] * L2E - mb); rs += s0[i]; }
#pragma unroll
        for (int i = 0; i < 16; ++i) { s1[i] = __builtin_amdgcn_exp2f(s1[i] * L2E - mb); rs += s1[i]; }
        lsum = lsum * alpha + rs;
#pragma unroll
        for (int i = 0; i < 16; ++i) { o0[i] *= alpha; o1[i] *= alpha; }
        bf16x8 pf[4];
        {
            u32x4 t;
            t.x = pk_bf16(s0[0], s0[1]); t.y = pk_bf16(s0[2], s0[3]); t.z = pk_bf16(s0[4], s0[5]); t.w = pk_bf16(s0[6], s0[7]);
            pf[0] = __builtin_bit_cast(bf16x8, t);
            t.x = pk_bf16(s0[8], s0[9]); t.y = pk_bf16(s0[10], s0[11]); t.z = pk_bf16(s0[12], s0[13]); t.w = pk_bf16(s0[14], s0[15]);
            pf[1] = __builtin_bit_cast(bf16x8, t);
            t.x = pk_bf16(s1[0], s1[1]); t.y = pk_bf16(s1[2], s1[3]); t.z = pk_bf16(s1[4], s1[5]); t.w = pk_bf16(s1[6], s1[7]);
            pf[2] = __builtin_bit_cast(bf16x8, t);
            t.x = pk_bf16(s1[8], s1[9]); t.y = pk_bf16(s1[10], s1[11]); t.z = pk_bf16(s1[12], s1[13]); t.w = pk_bf16(s1[14], s1[15]);
            pf[3] = __builtin_bit_cast(bf16x8, t);
        }
#pragma unroll
        for (int kk = 0; kk < 4; ++kk) {
            const int co = ((kk * 2 + h) ^ vswz) << 4;
            const bf16x8 v0 = *(const bf16x8*)(smem + cur + 8192 + v_off + co);
            const bf16x8 v1 = *(const bf16x8*)(smem + cur + 8192 + 4096 + v_off + co);
            o0 = mfma32(v0, pf[kk], o0);
            o1 = mfma32(v1, pf[kk], o1);
        }
        if (kt + 1 < nt) {
#pragma unroll
            for (int i = 0; i < 2; ++i) { *(u32x4*)(smem + nxt + st_off + i * 4096) = rk[i]; *(u32x4*)(smem + nxt + 8192 + st_off + i * 4096) = rv[i]; }
        }
        __syncthreads();
    }
    const float lt = lsum + __shfl_xor(lsum, 32);
    const float inv = 1.0f / lt;
    const bf16_t* gp = G + (size_t)(wave * 32 + r) * INW + 4 * h;
    bf16_t* op = O + (size_t)(wave * 32 + r) * 1024 + 4 * h;
#pragma unroll
    for (int gq = 0; gq < 4; ++gq) {
        {
            const u32x2 gg = *(const u32x2*)(gp + 8 * gq);
            u32x2 w;
            w.x = pk_bf16(o0[4 * gq] * inv * bflo(gg.x), o0[4 * gq + 1] * inv * bfhi(gg.x));
            w.y = pk_bf16(o0[4 * gq + 2] * inv * bflo(gg.y), o0[4 * gq + 3] * inv * bfhi(gg.y));
            *(u32x2*)(op + 8 * gq) = w;
        }
        {
            const u32x2 gg = *(const u32x2*)(gp + 32 + 8 * gq);
            u32x2 w;
            w.x = pk_bf16(o1[4 * gq] * inv * bflo(gg.x), o1[4 * gq + 1] * inv * bfhi(gg.x));
            w.y = pk_bf16(o1[4 * gq + 2] * inv * bflo(gg.y), o1[4 * gq + 3] * inv * bfhi(gg.y));
            *(u32x2*)(op + 32 + 8 * gq) = w;
        }
    }
}

DI void pool_item(const bf16_t* __restrict__ Z, const bf16_t* __restrict__ PWT, const float* __restrict__ pscale, bf16_t* __restrict__ MIX,
                  int tokg0, unsigned char* smem) {
    const int tid = opaque_tid(), lane = tid & 63, wave = tid >> 6;
    const int T = (tokg0 < NPROMPT) ? 2048 : 4096;
    const int t0 = tokg0 & (T - 1);
    constexpr int RS = 528;
    __syncthreads();
    for (int id = tid; id < 80 * 32; id += 256) {
        const int rr = id >> 5, c = id & 31;
        const int t = t0 - 8 + rr;
        u32x4 v = (u32x4){0u, 0u, 0u, 0u};
        if (t >= 0 && t < T) v = *(const u32x4*)(Z + (size_t)(tokg0 - 8 + rr) * INW + c * 8);
        *(u32x4*)(smem + rr * RS + c * 16) = v;
    }
    __syncthreads();
    const int g = wave, half = 1 << g;
    const int r16 = lane & 15, q4 = lane >> 4;
    bf16x8 df[4][2];
#pragma unroll
    for (int ti = 0; ti < 4; ++ti)
#pragma unroll
        for (int ks = 0; ks < 2; ++ks) {
            const int tl = ti * 16 + r16, t = t0 + tl;
            const int lo = max(t - half, 0), hi = min(t + half, T);
            const float icnt = 1.0f / (float)(hi - lo);
            float s[8];
#pragma unroll
            for (int j = 0; j < 8; ++j) s[j] = 0.f;
            const unsigned char* bp = smem + (tl + 8 - half) * RS + (g * 64 + ks * 32 + q4 * 8) * 2;
            for (int j = 0; j < 2 * half; ++j) {
                const u32x4 v = *(const u32x4*)(bp + j * RS);
                s[0] += bflo(v.x); s[1] += bfhi(v.x); s[2] += bflo(v.y); s[3] += bfhi(v.y);
                s[4] += bflo(v.z); s[5] += bfhi(v.z); s[6] += bflo(v.w); s[7] += bfhi(v.w);
            }
            const u32x4 c = *(const u32x4*)(bp + half * RS);
            u32x4 o;
            o.x = pk_bf16(s[0] * icnt - bflo(c.x), s[1] * icnt - bfhi(c.x));
            o.y = pk_bf16(s[2] * icnt - bflo(c.y), s[3] * icnt - bfhi(c.y));
            o.z = pk_bf16(s[4] * icnt - bflo(c.z), s[5] * icnt - bfhi(c.z));
            o.w = pk_bf16(s[6] * icnt - bflo(c.w), s[7] * icnt - bfhi(c.w));
            df[ti][ks] = __builtin_bit_cast(bf16x8, o);
        }
    f32x4 acc[4][4];
#pragma unroll
    for (int i = 0; i < 4; ++i)
#pragma unroll
        for (int j = 0; j < 4; ++j) acc[i][j] = (f32x4){0.f, 0.f, 0.f, 0.f};
    const bf16_t* pw = PWT + (size_t)g * 4096 + r16 * 64 + q4 * 8;
#pragma unroll
    for (int fi = 0; fi < 4; ++fi)
#pragma unroll
        for (int ks = 0; ks < 2; ++ks) {
            const bf16x8 wf = *(const bf16x8*)(pw + fi * 16 * 64 + ks * 32);
#pragma unroll
            for (int ti = 0; ti < 4; ++ti) acc[fi][ti] = mfma16(wf, df[ti][ks], acc[fi][ti]);
        }
#pragma unroll
    for (int ti = 0; ti < 4; ++ti) {
        const size_t tok = (size_t)tokg0 + ti * 16 + r16;
#pragma unroll
        for (int fi = 0; fi < 4; ++fi) {
            const int n = g * 64 + fi * 16 + 4 * q4;
            const f32x4 ps = *(const f32x4*)(pscale + n);
            const u32x2 gg = *(const u32x2*)(Z + tok * INW + 256 + n);
            u32x2 w;
            w.x = pk_bf16(acc[fi][ti][0] * ps[0] * bflo(gg.x), acc[fi][ti][1] * ps[1] * bfhi(gg.x));
            w.y = pk_bf16(acc[fi][ti][2] * ps[2] * bflo(gg.y), acc[fi][ti][3] * ps[3] * bfhi(gg.y));
            *(u32x2*)(MIX + tok * 1024 + n) = w;
        }
    }
}

DI void post_row(const float* __restrict__ xsrc, bf16_t* __restrict__ yh, const float* __restrict__ gpost, const float* __restrict__ gpre_next,
                 float* __restrict__ xdst, bool last, int lane) {
    u32x4 yv[2]; f32x4 xv[4];
#pragma unroll
    for (int j = 0; j < 2; ++j) yv[j] = *(const u32x4*)(yh + j * 512 + lane * 8);
#pragma unroll
    for (int j = 0; j < 2; ++j) { xv[2 * j] = *(const f32x4*)(xsrc + j * 512 + lane * 8); xv[2 * j + 1] = *(const f32x4*)(xsrc + j * 512 + lane * 8 + 4); }
    float y[16];
#pragma unroll
    for (int j = 0; j < 2; ++j) {
        y[8 * j + 0] = bflo(yv[j].x); y[8 * j + 1] = bfhi(yv[j].x); y[8 * j + 2] = bflo(yv[j].y); y[8 * j + 3] = bfhi(yv[j].y);
        y[8 * j + 4] = bflo(yv[j].z); y[8 * j + 5] = bfhi(yv[j].z); y[8 * j + 6] = bflo(yv[j].w); y[8 * j + 7] = bfhi(yv[j].w);
    }
    float ss = 0.f;
#pragma unroll
    for (int i = 0; i < 16; ++i) ss += y[i] * y[i];
    ss = wave_sum(ss);
    const float r = rsqrtf(ss * (1.0f / 1024.0f) + EPS);
    float xn[16]; float ss2 = 0.f;
#pragma unroll
    for (int j = 0; j < 2; ++j) {
        const f32x4 g0 = *(const f32x4*)(gpost + j * 512 + lane * 8), g1 = *(const f32x4*)(gpost + j * 512 + lane * 8 + 4);
#pragma unroll
        for (int i = 0; i < 4; ++i) {
            xn[8 * j + i] = xv[2 * j][i] + y[8 * j + i] * r * g0[i];
            xn[8 * j + 4 + i] = xv[2 * j + 1][i] + y[8 * j + 4 + i] * r * g1[i];
        }
    }
#pragma unroll
    for (int i = 0; i < 16; ++i) ss2 += xn[i] * xn[i];
#pragma unroll
    for (int j = 0; j < 2; ++j) {
        *(f32x4*)(xdst + j * 512 + lane * 8) = (f32x4){xn[8 * j], xn[8 * j + 1], xn[8 * j + 2], xn[8 * j + 3]};
        *(f32x4*)(xdst + j * 512 + lane * 8 + 4) = (f32x4){xn[8 * j + 4], xn[8 * j + 5], xn[8 * j + 6], xn[8 * j + 7]};
    }
    if (!last) {
        ss2 = wave_sum(ss2);
        const float r2 = rsqrtf(ss2 * (1.0f / 1024.0f) + EPS);
#pragma unroll
        for (int j = 0; j < 2; ++j) {
            const f32x4 g0 = *(const f32x4*)(gpre_next + j * 512 + lane * 8), g1 = *(const f32x4*)(gpre_next + j * 512 + lane * 8 + 4);
            u32x4 o;
            o.x = pk_bf16(xn[8 * j] * r2 * g0[0], xn[8 * j + 1] * r2 * g0[1]);
            o.y = pk_bf16(xn[8 * j + 2] * r2 * g0[2], xn[8 * j + 3] * r2 * g0[3]);
            o.z = pk_bf16(xn[8 * j + 4] * r2 * g1[0], xn[8 * j + 5] * r2 * g1[1]);
            o.w = pk_bf16(xn[8 * j + 6] * r2 * g1[2], xn[8 * j + 7] * r2 * g1[3]);
            *(u32x4*)(yh + j * 512 + lane * 8) = o;
        }
    }
}

__global__ void __launch_bounds__(256, 2) fwd_megakernel(Params p) {
    __shared__ __attribute__((aligned(16))) unsigned char smem[65536];
    cg::grid_group grid = cg::this_grid();
    const int nb = gridDim.x, bid = blockIdx.x;
    for (int ph = p.phase_begin; ph < p.phase_end; ++ph) {
        const int tid = opaque_tid(), lane = tid & 63, wave = tid >> 6;
        unsigned char* ws = p.ws;
        asm volatile("" : "+s"(ws));
        bf16_t* H = (bf16_t*)(ws + OFF_H);
        bf16_t* Z = (bf16_t*)(ws + OFF_Z);
        bf16_t* VT = (bf16_t*)(ws + OFF_VT);
        bf16_t* MIX = (bf16_t*)(ws + OFF_MIX);
        bf16_t* WIN = (bf16_t*)(ws + OFF_WIN);
        bf16_t* WOUT = (bf16_t*)(ws + OFF_WOUT);
        bf16_t* WMEM = (bf16_t*)(ws + OFF_WMEM);
        bf16_t* PW = (bf16_t*)(ws + OFF_PW);
        bf16_t* MH = (bf16_t*)(ws + OFF_MH);
        bf16_t* KM = (bf16_t*)(ws + OFF_KM);
        bf16_t* VMT = (bf16_t*)(ws + OFF_VMT);
        float* ROPE = (float*)(ws + OFF_ROPE);
        if (ph == 0) {
            for (int i = bid; i < 1928; i += nb) {
                if (i < 1152) { const int l = i / 576, j = i % 576, kt = j / 36, ntile = j % 36;
                    transpose_tile(p.w_in + (size_t)l * DM * INW, INW, WIN + (size_t)l * INW * DM, DM, kt * 64, ntile * 64, smem);
                } else if (i < 1664) { const int ii = i - 1152, l = ii / 256, j = ii % 256, kt = j / 16, ntile = j % 16;
                    transpose_tile(p.w_out + (size_t)l * DM * DM, DM, WOUT + (size_t)l * DM * DM, DM, kt * 64, ntile * 64, smem);
                } else if (i < 1920) { const int ii = i - 1664, l = ii / 128, j = ii % 128, kt = j / 8, ntile = j % 8;
                    transpose_tile(p.w_mem_kv + (size_t)l * DM * 512, 512, WMEM + (size_t)l * 512 * DM, DM, kt * 64, ntile * 64, smem);
                } else { const int ii = i - 1920;
                    transpose_tile(p.pool_w + (size_t)ii * 4096, 64, PW + (size_t)ii * 4096, 64, 0, 0, smem);
                }
            }
            for (int i = bid * 4 + wave; i < NTOK + 2 * NMEMTOK; i += nb * 4) {
                if (i < NTOK) {
                    const float* src = (i < NPROMPT) ? p.x_prompt + (size_t)i * DM : p.x_sample + (size_t)(i - NPROMPT) * DM;
                    rms_row_f32(src, p.norm_pre, H + (size_t)i * DM, lane);
                } else {
                    const int ii = i - NTOK, l = ii / NMEMTOK, mt = ii % NMEMTOK;
                    const float* src = (mt < 4096) ? p.mem_prompt + (size_t)mt * DM : p.mem_sample + (size_t)(mt - 4096) * DM;
                    rms_row_f32(src, p.mem_norm + l * DM, MH + ((size_t)l * NMEMTOK + mt) * DM, lane);
                }
            }
            for (int i = bid * 256 + tid; i < 1024; i += nb * 256) rope_entry(i, ROPE);
        } else {
            const int l = (ph - 1) >> 2, sub = (ph - 1) & 3;
            if (sub == 0) {
                EpiArgs e; e.C = Z; e.VT = VT; e.qn = p.q_norm + l * 64; e.kn = p.k_norm + l * 64; e.rope = ROPE;
                const bf16_t* Wl = WIN + (size_t)l * INW * DM;
                for (int i = bid; i < 6912; i += nb) {
                    const int L = (i & 7) * 864 + (i >> 3);
                    const int mt = L / 18, ntile = L % 18;
                    gemm_tile<0>(H, Wl, mt * 128, ntile * 128, e, smem);
                }
                EpiArgs e2; e2.C = KM + (size_t)l * NMEMTOK * 256; e2.VT = VMT + (size_t)l * NMEMTOK * 256; e2.qn = nullptr; e2.kn = nullptr; e2.rope = nullptr;
                const bf16_t* Wm = WMEM + (size_t)l * 512 * DM;
                const bf16_t* Am = MH + (size_t)l * NMEMTOK * DM;
                for (int i = bid; i < 160; i += nb) gemm_tile<2>(Am, Wm, (i >> 2) * 128, (i & 3) * 128, e2, smem);
            } else if (sub == 1) {
                for (int i = bid; i < 5376; i += nb) {
                    if (i < 3072) {
                        int b, kvh, j, T; size_t tok0, vtb;
                        if (i < 1024) { const int R = i >> 9, ip = i & 511, grp = ip & 7; j = R * 64 + (ip >> 3); b = grp >> 1; kvh = grp & 1; T = 4096;
                            tok0 = (size_t)NPROMPT + (size_t)b * 4096; vtb = (size_t)NPROMPT * 128 + ((size_t)(b * 2 + kvh) * 64) * 4096; }
                        else { const int ii = i - 1024, R = ii >> 9, ip = ii & 511, grp = R * 8 + (ip & 7); j = ip >> 3; b = grp >> 1; kvh = grp & 1; T = 2048;
                            tok0 = (size_t)b * 2048; vtb = ((size_t)(b * 2 + kvh) * 64) * 2048; }
                        const int qblk = j >> 2, head = kvh * 4 + (j & 3);
                        const size_t q0 = tok0 + (size_t)qblk * 128;
                        attn_item(Z + q0 * INW + 512 + head * 64, INW, Z + tok0 * INW + 1024 + kvh * 64, INW, VT + vtb, T, T,
                                  MIX + q0 * 1024 + 256 + head * 64, Z + q0 * INW + 1280 + head * 64, smem);
                    } else if (i < 4608) {
                        const int ii = i - 3072, qb = ii >> 2, hx = ii & 3;
                        const size_t q0 = (size_t)qb * 128;
                        const int b = (q0 < NPROMPT) ? (int)(q0 >> 11) : 16 + (int)((q0 - NPROMPT) >> 12);
                        attn_item(Z + q0 * INW + 1792 + hx * 64, INW, KM + ((size_t)l * NMEMTOK + (size_t)b * 256) * 256 + hx * 64, 256,
                                  VMT + (size_t)l * NMEMTOK * 256 + ((size_t)(b * 4 + hx) * 64) * 256, 256, 256,
                                  MIX + q0 * 1024 + 768 + hx * 64, Z + q0 * INW + 2048 + hx * 64, smem);
                    } else {
                        pool_item(Z, PW + (size_t)l * 4 * 4096, p.pool_scale + l * 256, MIX, (i - 4608) * 64, smem);
                    }
                }
            } else if (sub == 2) {
                EpiArgs e; e.C = H; e.VT = nullptr; e.qn = nullptr; e.kn = nullptr; e.rope = nullptr;
                const bf16_t* Wl = WOUT + (size_t)l * DM * DM;
                for (int i = bid; i < 3072; i += nb) {
                    const int L = (i & 7) * 384 + (i >> 3);
                    gemm_tile<1>(MIX, Wl, (L >> 3) * 128, (L & 7) * 128, e, smem);
                }
            } else {
                const bool last = (l == DEPTH - 1);
                for (int i = bid * 4 + wave; i < NTOK; i += nb * 4) {
                    const float* xs = (l == 0) ? ((i < NPROMPT) ? p.x_prompt + (size_t)i * DM : p.x_sample + (size_t)(i - NPROMPT) * DM) : p.out + (size_t)i * DM;
                    post_row(xs, H + (size_t)i * DM, p.norm_post + l * DM, p.norm_pre + (last ? l : l + 1) * DM, p.out + (size_t)i * DM, last, lane);
                }
            }
        }
        if (ph + 1 < p.phase_end) grid.sync();
    }
}

extern "C" void kernel_launch(void* const* d_in, const int* in_sizes, int n_in, void* d_out, int out_size, void* d_ws, size_t ws_size,
                              hipStream_t stream) {
    static int grid_blocks = 0;
    if (!grid_blocks) {
        int dev = 0, cus = 0, per_cu = 0;
        hipGetDevice(&dev);
        hipDeviceGetAttribute(&cus, hipDeviceAttributeMultiprocessorCount, dev);
        hipOccupancyMaxActiveBlocksPerMultiprocessor(&per_cu, fwd_megakernel, 256, 0);
        if (per_cu > 2) per_cu = 2;
        if (per_cu < 1) per_cu = 1;
        grid_blocks = cus * per_cu;
    }
    Params p{};
    p.x_prompt = (const float*)d_in[0]; p.x_sample = (const float*)d_in[1]; p.mem_prompt = (const float*)d_in[2]; p.mem_sample = (const float*)d_in[3];
    p.norm_pre = (const float*)d_in[4]; p.norm_post = (const float*)d_in[5]; p.w_in = (const float*)d_in[6]; p.pool_w = (const float*)d_in[7];
    p.pool_scale = (const float*)d_in[8]; p.q_norm = (const float*)d_in[9]; p.k_norm = (const float*)d_in[10]; p.mem_norm = (const float*)d_in[11];
    p.w_mem_kv = (const float*)d_in[12]; p.w_out = (const float*)d_in[13];
    p.out = (float*)d_out; p.ws = (unsigned char*)d_ws;
    p.phase_begin = 0; p.phase_end = 1 + 4 * DEPTH;
    if (ws_size < WS_TOTAL) { fprintf(stderr, "workspace too small: %zu < %zu\n", ws_size, (size_t)WS_TOTAL); return; }
    void* args[] = {&p};
    hipError_t e = hipLaunchCooperativeKernel((void*)fwd_megakernel, dim3(grid_blocks), dim3(256), args, 0, stream);
    if (e != hipSuccess) fprintf(stderr, "cooperative launch failed: %s (grid %d)\n", hipGetErrorString(e), grid_blocks);
}
```

```cpp
#include <hip/hip_runtime.h>
#include <hip/hip_cooperative_groups.h>
#include <stdint.h>
#include <cstdio>
namespace cg = cooperative_groups;

typedef unsigned short bf16_t;
typedef short bf16x8 __attribute__((ext_vector_type(8)));
typedef float f32x4 __attribute__((ext_vector_type(4)));
typedef float f32x16 __attribute__((ext_vector_type(16)));
typedef unsigned u32x4 __attribute__((ext_vector_type(4)));
typedef unsigned u32x2 __attribute__((ext_vector_type(2)));
typedef __bf16 bf16x2_t __attribute__((ext_vector_type(2)));
typedef float f32x2_t __attribute__((ext_vector_type(2)));
#define DI __device__ __forceinline__

constexpr int NTOK = 49152;
constexpr int NPROMPT = 32768;
constexpr int DM = 1024;
constexpr int INW = 2304;
constexpr int NMEMTOK = 5120;
constexpr int DEPTH = 2;
constexpr float EPS = 1e-6f;
constexpr float L2E = 1.4426950408889634f;

constexpr size_t OFF_H    = 0;
constexpr size_t OFF_Z    = OFF_H + (size_t)NTOK * DM * 2;
constexpr size_t OFF_VT   = OFF_Z + (size_t)NTOK * INW * 2;
constexpr size_t OFF_MIX  = OFF_VT + (size_t)NTOK * 128 * 2;
constexpr size_t OFF_WIN  = OFF_MIX + (size_t)NTOK * DM * 2;
constexpr size_t OFF_WOUT = OFF_WIN + (size_t)DEPTH * INW * DM * 2;
constexpr size_t OFF_WMEM = OFF_WOUT + (size_t)DEPTH * DM * DM * 2;
constexpr size_t OFF_PW   = OFF_WMEM + (size_t)DEPTH * 512 * DM * 2;
constexpr size_t OFF_MH   = OFF_PW + (size_t)DEPTH * 4 * 64 * 64 * 2;
constexpr size_t OFF_KM   = OFF_MH + (size_t)DEPTH * NMEMTOK * DM * 2;
constexpr size_t OFF_VMT  = OFF_KM + (size_t)DEPTH * NMEMTOK * 256 * 2;
constexpr size_t OFF_ROPE = OFF_VMT + (size_t)DEPTH * NMEMTOK * 256 * 2;
constexpr size_t OFF_BAR  = OFF_ROPE + 64 * 16 * 2 * 4;
constexpr size_t BAR_BYTES = 3456 * 4;
constexpr size_t WS_TOTAL = OFF_BAR + BAR_BYTES;

struct Params {
    const float* x_prompt; const float* x_sample; const float* mem_prompt; const float* mem_sample;
    const float* norm_pre; const float* norm_post; const float* w_in; const float* pool_w; const float* pool_scale;
    const float* q_norm; const float* k_norm; const float* mem_norm; const float* w_mem_kv; const float* w_out;
    float* out; unsigned char* ws;
    int phase_begin; int phase_end;
};

DI unsigned pk_bf16(float a, float b) {
    f32x2_t v = {a, b};
    bf16x2_t r = __builtin_convertvector(v, bf16x2_t);
    return __builtin_bit_cast(unsigned, r);
}
DI int opaque_tid() { int t = threadIdx.x; asm volatile("" : "+v"(t)); return t; }
DI float bflo(unsigned u) { return __uint_as_float(u << 16); }
DI float bfhi(unsigned u) { return __uint_as_float(u & 0xffff0000u); }
DI float wave_sum(float v) {
    v += __shfl_xor(v, 1); v += __shfl_xor(v, 2); v += __shfl_xor(v, 4);
    v += __shfl_xor(v, 8); v += __shfl_xor(v, 16); v += __shfl_xor(v, 32);
    return v;
}
DI float silu_f(float x) { return x * __builtin_amdgcn_rcpf(1.0f + __builtin_amdgcn_exp2f(-x * L2E)); }
DI f32x4 mfma16(bf16x8 a, bf16x8 b, f32x4 c) { return __builtin_amdgcn_mfma_f32_16x16x32_bf16(a, b, c, 0, 0, 0); }
DI f32x16 mfma32(bf16x8 a, bf16x8 b, f32x16 c) { return __builtin_amdgcn_mfma_f32_32x32x16_bf16(a, b, c, 0, 0, 0); }

DI void transpose_tile(const float* __restrict__ src, int ldn, bf16_t* __restrict__ dst, int ldk, int k0, int n0, unsigned char* smem) {
    float* tile = (float*)smem;
    const int tid = opaque_tid();
    __syncthreads();
#pragma unroll
    for (int i = 0; i < 16; ++i) {
        const int r = i * 4 + (tid >> 6), c = tid & 63;
        tile[r * 65 + c] = src[(size_t)(k0 + r) * ldn + n0 + c];
    }
    __syncthreads();
#pragma unroll
    for (int i = 0; i < 8; ++i) {
        const int n = i * 8 + (tid >> 5), kp = tid & 31;
        const float v0 = tile[(2 * kp) * 65 + n], v1 = tile[(2 * kp + 1) * 65 + n];
        *(unsigned*)(dst + (size_t)(n0 + n) * ldk + k0 + 2 * kp) = pk_bf16(v0, v1);
    }
}

DI void rms_row_f32(const float* __restrict__ src, const float* __restrict__ g, bf16_t* __restrict__ dst, int lane) {
    f32x4 v[4]; float ss = 0.f;
#pragma unroll
    for (int j = 0; j < 4; ++j) { v[j] = *(const f32x4*)(src + j * 256 + lane * 4); ss += v[j][0] * v[j][0] + v[j][1] * v[j][1] + v[j][2] * v[j][2] + v[j][3] * v[j][3]; }
    ss = wave_sum(ss);
    const float r = rsqrtf(ss * (1.0f / 1024.0f) + EPS);
#pragma unroll
    for (int j = 0; j < 4; ++j) {
        const f32x4 gg = *(const f32x4*)(g + j * 256 + lane * 4);
        u32x2 o; o.x = pk_bf16(v[j][0] * r * gg[0], v[j][1] * r * gg[1]); o.y = pk_bf16(v[j][2] * r * gg[2], v[j][3] * r * gg[3]);
        *(u32x2*)(dst + j * 256 + lane * 4) = o;
    }
}

DI void rope_entry(int idx, float* table) {
    const int n = idx >> 4, pp = idx & 15;
    const double fd = exp2(-(double)pp * (13.287712379549449 / 16.0));
    const float f = (float)fd;
    const float a = (float)n * f;
    double r = (double)a;
    const double k = rint(r * 0.15915494309189535);
    r -= k * 6.283185307179586;
    const double r2 = r * r;
    double sn = r, cs = 1.0, ts = r, tc = 1.0;
    for (int i = 1; i <= 16; ++i) {
        tc = -tc * r2 / (double)((2 * i - 1) * (2 * i));
        ts = -ts * r2 / (double)((2 * i) * (2 * i + 1));
        cs += tc; sn += ts;
    }
    table[idx * 2] = (float)cs; table[idx * 2 + 1] = (float)sn;
}

struct EpiArgs {
    bf16_t* C;
    bf16_t* VT;
    const float* qn; const float* kn; const float* rope;
};

template <int MODE>
DI void gemm_tile(const bf16_t* __restrict__ A, const bf16_t* __restrict__ Bt, int m0, int n0, const EpiArgs& e, unsigned char* smem) {
    const int tid = opaque_tid(), lane = tid & 63, wave = tid >> 6;
    const int wm = wave & 1, wn = wave >> 1;
    const int lrow = tid >> 3, lc = tid & 7;
    const bf16_t* Ag = A + (size_t)(m0 + lrow) * 1024 + lc * 8;
    const bf16_t* Bg = Bt + (size_t)(n0 + lrow) * 1024 + lc * 8;
    const int st_off = lrow * 128 + ((lc ^ ((lrow >> 1) & 7)) << 4);
    const int r16 = lane & 15, q4 = lane >> 4;
    const int fr_off = r16 * 128 + ((q4 ^ (r16 >> 1)) << 4);
    const int a_base = 16384 + (wn * 64) * 128;
    const int b_base = (wm * 64) * 128;

    f32x4 acc[4][4];
#pragma unroll
    for (int i = 0; i < 4; ++i)
#pragma unroll
        for (int j = 0; j < 4; ++j) acc[i][j] = (f32x4){0.f, 0.f, 0.f, 0.f};

    u32x4 ra[4], rb[4];
#pragma unroll
    for (int i = 0; i < 4; ++i) { ra[i] = *(const u32x4*)(Ag + (size_t)i * 32 * 1024); rb[i] = *(const u32x4*)(Bg + (size_t)i * 32 * 1024); }
#pragma unroll
    for (int i = 0; i < 4; ++i) { *(u32x4*)(smem + st_off + i * 4096) = ra[i]; *(u32x4*)(smem + 16384 + st_off + i * 4096) = rb[i]; }
    __syncthreads();

    for (int kt = 0; kt < 16; ++kt) {
        const int cur = (kt & 1) * 32768, nxt = 32768 - cur;
        if (kt < 15) {
#pragma unroll
            for (int i = 0; i < 4; ++i) { ra[i] = *(const u32x4*)(Ag + (size_t)i * 32 * 1024 + (kt + 1) * 64); rb[i] = *(const u32x4*)(Bg + (size_t)i * 32 * 1024 + (kt + 1) * 64); }
        }
#pragma unroll
        for (int ks = 0; ks < 2; ++ks) {
            bf16x8 wf[4], tf[4];
#pragma unroll
            for (int i = 0; i < 4; ++i) {
                wf[i] = *(const bf16x8*)(smem + cur + a_base + i * 2048 + (fr_off ^ (ks * 64)));
                tf[i] = *(const bf16x8*)(smem + cur + b_base + i * 2048 + (fr_off ^ (ks * 64)));
            }
#pragma unroll
            for (int fi = 0; fi < 4; ++fi)
#pragma unroll
                for (int ti = 0; ti < 4; ++ti) acc[fi][ti] = mfma16(wf[fi], tf[ti], acc[fi][ti]);
        }
        if (kt < 15) {
#pragma unroll
            for (int i = 0; i < 4; ++i) { *(u32x4*)(smem + nxt + st_off + i * 4096) = ra[i]; *(u32x4*)(smem + nxt + 16384 + st_off + i * 4096) = rb[i]; }
        }
        __syncthreads();
    }

    const int cb = n0 + wn * 64;
    const int tokb = m0 + wm * 64 + r16;
    if (MODE == 1) {
#pragma unroll
        for (int ti = 0; ti < 4; ++ti) {
            bf16_t* rowp = e.C + (size_t)(tokb + ti * 16) * 1024 + cb + 4 * q4;
#pragma unroll
            for (int fi = 0; fi < 4; ++fi) {
                u32x2 o; o.x = pk_bf16(acc[fi][ti][0], acc[fi][ti][1]); o.y = pk_bf16(acc[fi][ti][2], acc[fi][ti][3]);
                *(u32x2*)(rowp + fi * 16) = o;
            }
        }
    } else if (MODE == 2) {
        if (cb < 256) {
#pragma unroll
            for (int ti = 0; ti < 4; ++ti) {
                bf16_t* rowp = e.C + (size_t)(tokb + ti * 16) * 256 + cb + 4 * q4;
#pragma unroll
                for (int fi = 0; fi < 4; ++fi) {
                    u32x2 o; o.x = pk_bf16(acc[fi][ti][0], acc[fi][ti][1]); o.y = pk_bf16(acc[fi][ti][2], acc[fi][ti][3]);
                    *(u32x2*)(rowp + fi * 16) = o;
                }
            }
        } else {
            const int hx = (cb - 256) >> 6;
#pragma unroll
            for (int ti = 0; ti < 4; ++ti) {
                const int mt = tokb + ti * 16, b = mt >> 8, m = mt & 255;
                bf16_t* bp = e.VT + ((size_t)(b * 4 + hx) * 64) * 256 + m;
#pragma unroll
                for (int fi = 0; fi < 4; ++fi)
#pragma unroll
                    for (int i = 0; i < 4; ++i) bp[(size_t)(fi * 16 + 4 * q4 + i) * 256] = (bf16_t)(pk_bf16(acc[fi][ti][i], 0.f) & 0xffffu);
            }
        }
    } else {
        if (cb >= 512 && cb < 1152) {
            const bool isq = cb < 1024;
            const float* gn = isq ? e.qn : e.kn;
            const float osc = isq ? 0.125f : 1.0f;
            f32x4 g[4];
#pragma unroll
            for (int fi = 0; fi < 4; ++fi) g[fi] = *(const f32x4*)(gn + fi * 16 + 4 * q4);
#pragma unroll
            for (int ti = 0; ti < 4; ++ti) {
                const int tok = tokb + ti * 16;
                float ss = 0.f;
#pragma unroll
                for (int fi = 0; fi < 4; ++fi)
#pragma unroll
                    for (int i = 0; i < 4; ++i) ss += acc[fi][ti][i] * acc[fi][ti][i];
                ss += __shfl_xor(ss, 16); ss += __shfl_xor(ss, 32);
                const float rinv = rsqrtf(ss * (1.0f / 64.0f) + EPS);
                const int t = (tok < NPROMPT) ? (tok & 2047) : (tok & 4095);
                const int rowi = t >> 6, coli = t & 63;
                const f32x4* rt = (const f32x4*)(e.rope + (rowi * 16 + 4 * q4) * 2);
                const f32x4* ct = (const f32x4*)(e.rope + (coli * 16 + 4 * q4) * 2);
                const f32x4 r01 = rt[0], r23 = rt[1], c01 = ct[0], c23 = ct[1];
                const float rc[4] = {r01[0], r01[2], r23[0], r23[2]}, rs[4] = {r01[1], r01[3], r23[1], r23[3]};
                const float cc[4] = {c01[0], c01[2], c23[0], c23[2]}, cs[4] = {c01[1], c01[3], c23[1], c23[3]};
                float o[4][4];
#pragma unroll
                for (int i = 0; i < 4; ++i) {
                    const float a0 = acc[0][ti][i] * rinv * g[0][i], b0 = acc[1][ti][i] * rinv * g[1][i];
                    const float a1 = acc[2][ti][i] * rinv * g[2][i], b1 = acc[3][ti][i] * rinv * g[3][i];
                    o[0][i] = (a0 * rc[i] - b0 * rs[i]) * osc; o[1][i] = (b0 * rc[i] + a0 * rs[i]) * osc;
                    o[2][i] = (a1 * cc[i] - b1 * cs[i]) * osc; o[3][i] = (b1 * cc[i] + a1 * cs[i]) * osc;
                }
                bf16_t* rowp = e.C + (size_t)tok * INW + cb + 4 * q4;
#pragma unroll
                for (int fi = 0; fi < 4; ++fi) {
                    u32x2 w; w.x = pk_bf16(o[fi][0], o[fi][1]); w.y = pk_bf16(o[fi][2], o[fi][3]);
                    *(u32x2*)(rowp + fi * 16) = w;
                }
            }
        } else if (cb >= 1152 && cb < 1280) {
            const int kvh = (cb - 1152) >> 6;
#pragma unroll
            for (int ti = 0; ti < 4; ++ti) {
                const int tok = tokb + ti * 16;
                bf16_t* bp; size_t T;
                if (tok < NPROMPT) { const int b = tok >> 11, t = tok & 2047; T = 2048; bp = e.VT + ((size_t)(b * 2 + kvh) * 64) * 2048 + t; }
                else { const int b = (tok - NPROMPT) >> 12, t = tok & 4095; T = 4096; bp = e.VT + (size_t)NPROMPT * 128 + ((size_t)(b * 2 + kvh) * 64) * 4096 + t; }
#pragma unroll
                for (int fi = 0; fi < 4; ++fi)
#pragma unroll
                    for (int i = 0; i < 4; ++i) bp[(size_t)(fi * 16 + 4 * q4 + i) * T] = (bf16_t)(pk_bf16(acc[fi][ti][i], 0.f) & 0xffffu);
            }
        } else {
            const int kind = (cb < 256) ? 0 : ((cb >= 1792 && cb < 2048) ? 2 : 1);
#pragma unroll
            for (int ti = 0; ti < 4; ++ti) {
                bf16_t* rowp = e.C + (size_t)(tokb + ti * 16) * INW + cb + 4 * q4;
#pragma unroll
                for (int fi = 0; fi < 4; ++fi) {
                    float v[4];
#pragma unroll
                    for (int i = 0; i < 4; ++i) { const float x = acc[fi][ti][i]; v[i] = (kind == 0) ? x : ((kind == 2) ? x * 0.125f : silu_f(x)); }
                    u32x2 o; o.x = pk_bf16(v[0], v[1]); o.y = pk_bf16(v[2], v[3]);
                    *(u32x2*)(rowp + fi * 16) = o;
                }
            }
        }
    }
}

DI void attn_item(const bf16_t* __restrict__ Q, int ldq, const bf16_t* __restrict__ K, int ldk, const bf16_t* __restrict__ VT, int ldv,
                  int nkeys, bf16_t* __restrict__ O, const bf16_t* __restrict__ G, unsigned char* smem) {
    const int tid = opaque_tid(), lane = tid & 63, wave = tid >> 6;
    const int r = lane & 31, h = lane >> 5;
    bf16x8 qf[4];
    {
        const bf16_t* qp = Q + (size_t)(wave * 32 + r) * ldq + h * 8;
#pragma unroll
        for (int ks = 0; ks < 4; ++ks) qf[ks] = *(const bf16x8*)(qp + ks * 16);
    }
    const int lrow = tid >> 3, lc = tid & 7;
    const bf16_t* Kg = K + (size_t)lrow * ldk + lc * 8;
    const bf16_t* Vg = VT + (size_t)lrow * ldv + lc * 8;
    const int st_off = lrow * 128 + ((lc ^ ((lrow >> 1) & 7)) << 4);
    const int pr = (r & ~12) | ((r & 4) << 1) | ((r & 8) >> 1);
    const int kswz = (pr >> 1) & 7, vswz = (r >> 1) & 7;
    const int k_off = pr * 128, v_off = r * 128;

    f32x16 o0, o1;
#pragma unroll
    for (int i = 0; i < 16; ++i) { o0[i] = 0.f; o1[i] = 0.f; }
    float m = -1e30f, lsum = 0.f;

    u32x4 rk[2], rv[2];
#pragma unroll
    for (int i = 0; i < 2; ++i) { rk[i] = *(const u32x4*)(Kg + (size_t)i * 32 * ldk); rv[i] = *(const u32x4*)(Vg + (size_t)i * 32 * ldv); }
    __syncthreads();
#pragma unroll
    for (int i = 0; i < 2; ++i) { *(u32x4*)(smem + st_off + i * 4096) = rk[i]; *(u32x4*)(smem + 8192 + st_off + i * 4096) = rv[i]; }
    __syncthreads();

    const int nt = nkeys >> 6;
    for (int kt = 0; kt < nt; ++kt) {
        const int cur = (kt & 1) * 16384, nxt = 16384 - cur;
        if (kt + 1 < nt) {
#pragma unroll
            for (int i = 0; i < 2; ++i) {
                rk[i] = *(const u32x4*)(Kg + (size_t)((kt + 1) * 64 + i * 32) * ldk);
                rv[i] = *(const u32x4*)(Vg + (size_t)i * 32 * ldv + (kt + 1) * 64);
            }
        }
        f32x16 s0, s1;
#pragma unroll
        for (int i = 0; i < 16; ++i) { s0[i] = 0.f; s1[i] = 0.f; }
#pragma unroll
        for (int ks = 0; ks < 4; ++ks) {
            const int co = ((ks * 2 + h) ^ kswz) << 4;
            const bf16x8 k0 = *(const bf16x8*)(smem + cur + k_off + co);
            const bf16x8 k1 = *(const bf16x8*)(smem + cur + 4096 + k_off + co);
            s0 = mfma32(k0, qf[ks], s0);
            s1 = mfma32(k1, qf[ks], s1);
        }
        float mx = s0[0];
#pragma unroll
        for (int i = 1; i < 16; ++i) mx = fmaxf(mx, s0[i]);
#pragma unroll
        for (int i = 0; i < 16; ++i) mx = fmaxf(mx, s1[i]);
        mx = fmaxf(mx, __shfl_xor(mx, 32));
        const float mnew = fmaxf(m, mx);
        const float alpha = __builtin_amdgcn_exp2f((m - mnew) * L2E);
        m = mnew;
        const float mb = mnew * L2E;
        float rs = 0.f;
#pragma unroll
        for (int i = 0; i < 16; ++i) { s0[i] = __builtin_amdgcn_exp2f(s0[i] * L2E - mb); rs += s0[i]; }
#pragma unroll
        for (int i = 0; i < 16; ++i) { s1[i] = __builtin_amdgcn_exp2f(s1[i] * L2E - mb); rs += s1[i]; }
        lsum = lsum * alpha + rs;
#pragma unroll
        for (int i = 0; i < 16; ++i) { o0[i] *= alpha; o1[i] *= alpha; }
        bf16x8 pf[4];
        {
            u32x4 t;
            t.x = pk_bf16(s0[0], s0[1]); t.y = pk_bf16(s0[2], s0[3]); t.z = pk_bf16(s0[4], s0[5]); t.w = pk_bf16(s0[6], s0[7]);
            pf[0] = __builtin_bit_cast(bf16x8, t);
            t.x = pk_bf16(s0[8], s0[9]); t.y = pk_bf16(s0[10], s0[11]); t.z = pk_bf16(s0[12], s0[13]); t.w = pk_bf16(s0[14], s0[15]);
            pf[1] = __builtin_bit_cast(bf16x8, t);
            t.x = pk_bf16(s1[0], s1[1]); t.y = pk_bf16(s1[2], s1[3]); t.z = pk_bf16(s1[4], s1[5]); t.w = pk_bf16(s1[6], s1[7]);
            pf[2] = __builtin_bit_cast(bf16x8, t);
            t.x = pk_bf16(s1[8], s1[9]); t.y = pk_bf16(s1[10], s1[11]); t.z = pk_bf16(s1[12], s1[13]); t.w = pk_bf16(s1[14], s1[15]);
            pf[3] = __builtin_bit_cast(bf16x8, t);
        }
#pragma unroll
        for (int kk = 0; kk < 4; ++kk) {
            const int co = ((kk * 2 + h) ^ vswz) << 4;
            const bf16x8 v0 = *(const bf16x8*)(smem + cur + 8192 + v_off + co);
            const bf16x8 v1 = *(const bf16x8*)(smem + cur + 8192 + 4096 + v_off + co);
            o0 = mfma32(v0, pf[kk], o0);
            o1 = mfma32(v1, pf[kk], o1);
        }
        if (kt + 1 < nt) {
#pragma unroll
            for (int i = 0; i < 2; ++i) { *(u32x4*)(smem + nxt + st_off + i * 4096) = rk[i]; *(u32x4*)(smem + nxt + 8192 + st_off + i * 4096) = rv[i]; }
        }
        __syncthreads();
    }
    const float lt = lsum + __shfl_xor(lsum, 32);
    const float inv = 1.0f / lt;
    const bf16_t* gp = G + (size_t)(wave * 32 + r) * INW + 4 * h;
    bf16_t* op = O + (size_t)(wave * 32 + r) * 1024 + 4 * h;
#pragma unroll
    for (int gq = 0; gq < 4; ++gq) {
        {
            const u32x2 gg = *(const u32x2*)(gp + 8 * gq);
            u32x2 w;
            w.x = pk_bf16(o0[4 * gq] * inv * bflo(gg.x), o0[4 * gq + 1] * inv * bfhi(gg.x));
            w.y = pk_bf16(o0[4 * gq + 2] * inv * bflo(gg.y), o0[4 * gq + 3] * inv * bfhi(gg.y));
            *(u32x2*)(op + 8 * gq) = w;
        }
        {
            const u32x2 gg = *(const u32x2*)(gp + 32 + 8 * gq);
            u32x2 w;
            w.x = pk_bf16(o1[4 * gq] * inv * bflo(gg.x), o1[4 * gq + 1] * inv * bfhi(gg.x));
            w.y = pk_bf16(o1[4 * gq + 2] * inv * bflo(gg.y), o1[4 * gq + 3] * inv * bfhi(gg.y));
            *(u32x2*)(op + 32 + 8 * gq) = w;
        }
    }
}

DI void pool_item(const bf16_t* __restrict__ Z, const bf16_t* __restrict__ PWT, const float* __restrict__ pscale, bf16_t* __restrict__ MIX,
                  int tokg0, unsigned char* smem) {
    const int tid = opaque_tid(), lane = tid & 63, wave = tid >> 6;
    const int T = (tokg0 < NPROMPT) ? 2048 : 4096;
    const int t0 = tokg0 & (T - 1);
    constexpr int RS = 528;
    __syncthreads();
    for (int id = tid; id < 80 * 32; id += 256) {
        const int rr = id >> 5, c = id & 31;
        const int t = t0 - 8 + rr;
        u32x4 v = (u32x4){0u, 0u, 0u, 0u};
        if (t >= 0 && t < T) v = *(const u32x4*)(Z + (size_t)(tokg0 - 8 + rr) * INW + c * 8);
        *(u32x4*)(smem + rr * RS + c * 16) = v;
    }
    __syncthreads();
    const int g = wave, half = 1 << g;
    const int r16 = lane & 15, q4 = lane >> 4;
    bf16x8 df[4][2];
#pragma unroll
    for (int ti = 0; ti < 4; ++ti)
#pragma unroll
        for (int ks = 0; ks < 2; ++ks) {
            const int tl = ti * 16 + r16, t = t0 + tl;
            const int lo = max(t - half, 0), hi = min(t + half, T);
            const float icnt = 1.0f / (float)(hi - lo);
            float s[8];
#pragma unroll
            for (int j = 0; j < 8; ++j) s[j] = 0.f;
            const unsigned char* bp = smem + (tl + 8 - half) * RS + (g * 64 + ks * 32 + q4 * 8) * 2;
            for (int j = 0; j < 2 * half; ++j) {
                const u32x4 v = *(const u32x4*)(bp + j * RS);
                s[0] += bflo(v.x); s[1] += bfhi(v.x); s[2] += bflo(v.y); s[3] += bfhi(v.y);
                s[4] += bflo(v.z); s[5] += bfhi(v.z); s[6] += bflo(v.w); s[7] += bfhi(v.w);
            }
            const u32x4 c = *(const u32x4*)(bp + half * RS);
            u32x4 o;
            o.x = pk_bf16(s[0] * icnt - bflo(c.x), s[1] * icnt - bfhi(c.x));
            o.y = pk_bf16(s[2] * icnt - bflo(c.y), s[3] * icnt - bfhi(c.y));
            o.z = pk_bf16(s[4] * icnt - bflo(c.z), s[5] * icnt - bfhi(c.z));
            o.w = pk_bf16(s[6] * icnt - bflo(c.w), s[7] * icnt - bfhi(c.w));
            df[ti][ks] = __builtin_bit_cast(bf16x8, o);
        }
    f32x4 acc[4][4];
#pragma unroll
    for (int i = 0; i < 4; ++i)
#pragma unroll
        for (int j = 0; j < 4; ++j) acc[i][j] = (f32x4){0.f, 0.f, 0.f, 0.f};
    const bf16_t* pw = PWT + (size_t)g * 4096 + r16 * 64 + q4 * 8;
#pragma unroll
    for (int fi = 0; fi < 4; ++fi)
#pragma unroll
        for (int ks = 0; ks < 2; ++ks) {
            const bf16x8 wf = *(const bf16x8*)(pw + fi * 16 * 64 + ks * 32);
#pragma unroll
            for (int ti = 0; ti < 4; ++ti) acc[fi][ti] = mfma16(wf, df[ti][ks], acc[fi][ti]);
        }
#pragma unroll
    for (int ti = 0; ti < 4; ++ti) {
        const size_t tok = (size_t)tokg0 + ti * 16 + r16;
#pragma unroll
        for (int fi = 0; fi < 4; ++fi) {
            const int n = g * 64 + fi * 16 + 4 * q4;
            const f32x4 ps = *(const f32x4*)(pscale + n);
            const u32x2 gg = *(const u32x2*)(Z + tok * INW + 256 + n);
            u32x2 w;
            w.x = pk_bf16(acc[fi][ti][0] * ps[0] * bflo(gg.x), acc[fi][ti][1] * ps[1] * bfhi(gg.x));
            w.y = pk_bf16(acc[fi][ti][2] * ps[2] * bflo(gg.y), acc[fi][ti][3] * ps[3] * bfhi(gg.y));
            *(u32x2*)(MIX + tok * 1024 + n) = w;
        }
    }
}

DI void post_row(const float* __restrict__ xsrc, bf16_t* __restrict__ yh, const float* __restrict__ gpost, const float* __restrict__ gpre_next,
                 float* __restrict__ xdst, bool last, int lane) {
    u32x4 yv[2]; f32x4 xv[4];
#pragma unroll
    for (int j = 0; j < 2; ++j) yv[j] = *(const u32x4*)(yh + j * 512 + lane * 8);
#pragma unroll
    for (int j = 0; j < 2; ++j) { xv[2 * j] = *(const f32x4*)(xsrc + j * 512 + lane * 8); xv[2 * j + 1] = *(const f32x4*)(xsrc + j * 512 + lane * 8 + 4); }
    float y[16];
#pragma unroll
    for (int j = 0; j < 2; ++j) {
        y[8 * j + 0] = bflo(yv[j].x); y[8 * j + 1] = bfhi(yv[j].x); y[8 * j + 2] = bflo(yv[j].y); y[8 * j + 3] = bfhi(yv[j].y);
        y[8 * j + 4] = bflo(yv[j].z); y[8 * j + 5] = bfhi(yv[j].z); y[8 * j + 6] = bflo(yv[j].w); y[8 * j + 7] = bfhi(yv[j].w);
    }
    float ss = 0.f;
#pragma unroll
    for (int i = 0; i < 16; ++i) ss += y[i] * y[i];
    ss = wave_sum(ss);
    const float r = rsqrtf(ss * (1.0f / 1024.0f) + EPS);
    float xn[16]; float ss2 = 0.f;
#pragma unroll
    for (int j = 0; j < 2; ++j) {
        const f32x4 g0 = *(const f32x4*)(gpost + j * 512 + lane * 8), g1 = *(const f32x4*)(gpost + j * 512 + lane * 8 + 4);
#pragma unroll
        for (int i = 0; i < 4; ++i) {
            xn[8 * j + i] = xv[2 * j][i] + y[8 * j + i] * r * g0[i];
            xn[8 * j + 4 + i] = xv[2 * j + 1][i] + y[8 * j + 4 + i] * r * g1[i];
        }
    }
#pragma unroll
    for (int i = 0; i < 16; ++i) ss2 += xn[i] * xn[i];
#pragma unroll
    for (int j = 0; j < 2; ++j) {
        *(f32x4*)(xdst + j * 512 + lane * 8) = (f32x4){xn[8 * j], xn[8 * j + 1], xn[8 * j + 2], xn[8 * j + 3]};
        *(f32x4*)(xdst + j * 512 + lane * 8 + 4) = (f32x4){xn[8 * j + 4], xn[8 * j + 5], xn[8 * j + 6], xn[8 * j + 7]};
    }
    if (!last) {
        ss2 = wave_sum(ss2);
        const float r2 = rsqrtf(ss2 * (1.0f / 1024.0f) + EPS);
#pragma unroll
        for (int j = 0; j < 2; ++j) {
            const f32x4 g0 = *(const f32x4*)(gpre_next + j * 512 + lane * 8), g1 = *(const f32x4*)(gpre_next + j * 512 + lane * 8 + 4);
            u32x4 o;
            o.x = pk_bf16(xn[8 * j] * r2 * g0[0], xn[8 * j + 1] * r2 * g0[1]);
            o.y = pk_bf16(xn[8 * j + 2] * r2 * g0[2], xn[8 * j + 3] * r2 * g0[3]);
            o.z = pk_bf16(xn[8 * j + 4] * r2 * g1[0], xn[8 * j + 5] * r2 * g1[1]);
            o.w = pk_bf16(xn[8 * j + 6] * r2 * g1[2], xn[8 * j + 7] * r2 * g1[3]);
            *(u32x4*)(yh + j * 512 + lane * 8) = o;
        }
    }
}

#define XB_TMO      128
#define XB_XCNT(j)  (256  + 64 * (j))
#define XB_XSUB(j)  (1280 + 64 * (j))
#define XB_XGEN(j)  (2304 + 64 * (j))
#define XB_TOP      3328
#define XB_TOPGEN   3392
#define XCD_BAR_WORDS 3456
#define XB_SPIN_CAP (1u << 18)
#define LAS __attribute__((address_space(3)))
DI unsigned xb_ld(unsigned* p)              { return __hip_atomic_load(p, __ATOMIC_RELAXED, __HIP_MEMORY_SCOPE_AGENT); }
DI unsigned xb_add(unsigned* p, unsigned v) { return __hip_atomic_fetch_add(p, v, __ATOMIC_RELAXED, __HIP_MEMORY_SCOPE_AGENT); }
DI unsigned xb_xcc_id() { return (unsigned)__builtin_amdgcn_s_getreg((3 << 11) | 20) & 0xFu; }
#define XB_SPIN(cond, bar) do { unsigned _sp = 0; while (cond) { __builtin_amdgcn_s_sleep(1); \
    if ((++_sp & 255u) == 0u) { if (xb_ld(&(bar)[XB_TMO])) break; if (_sp > XB_SPIN_CAP) { atomicAdd(&(bar)[XB_TMO], 1u); break; } } } } while (0)
struct XcdBarrier { unsigned* bar; unsigned x; volatile LAS unsigned* st; };
DI XcdBarrier xcd_barrier_post(unsigned* bar, volatile LAS unsigned* st) {
    XcdBarrier b; b.bar = bar; b.x = xb_xcc_id(); b.st = st;
    if (threadIdx.x == 0) (void)xb_add(&bar[XB_XCNT(b.x)], 1u);
    return b;
}
DI void xcd_barrier_complete(unsigned* bar, unsigned x, unsigned& nloc, unsigned& nx) {
    const unsigned G = gridDim.x * gridDim.y * gridDim.z;
    unsigned sum, cnt, mine, sp = 0u;
    for (;;) {
        sum = 0u; cnt = 0u; mine = 0u;
#pragma unroll
        for (unsigned j = 0; j < 16; ++j) { const unsigned c = xb_ld(&bar[XB_XCNT(j)]); sum += c; cnt += (c > 0u) ? 1u : 0u; mine = (j == x) ? c : mine; }
        if (sum == G) break;
        __builtin_amdgcn_s_sleep(1);
        if ((++sp & 255u) == 0u) { if (xb_ld(&bar[XB_TMO])) break; if (sp > XB_SPIN_CAP) { atomicAdd(&bar[XB_TMO], 1u); break; } }
    }
    nloc = mine > 0u ? mine : 1u; nx = cnt > 0u ? cnt : 1u;
}
DI void xcd_barrier(const XcdBarrier& b) {
    asm volatile("s_waitcnt vmcnt(0)" ::: "memory");
    __syncthreads();
    if (threadIdx.x == 0) {
        unsigned* bar = b.bar;
        __builtin_amdgcn_s_waitcnt(0);
        unsigned nloc = b.st[0], nx = b.st[1];
        if (nloc == 0u) { xcd_barrier_complete(bar, b.x, nloc, nx); b.st[0] = nloc; b.st[1] = nx; }
        const unsigned old = xb_add(&bar[XB_XSUB(b.x)], 1u);
        const unsigned gen = old / nloc;
        if (old + 1u == (gen + 1u) * nloc) {
            __builtin_amdgcn_fence(__ATOMIC_RELEASE, "agent");
            asm volatile("s_waitcnt vmcnt(0)" ::: "memory");
            const unsigned og = xb_add(&bar[XB_TOP], 1u);
            const unsigned tg = og / nx;
            if (og + 1u == (tg + 1u) * nx) xb_add(&bar[XB_TOPGEN], 1u);
            else XB_SPIN(xb_ld(&bar[XB_TOPGEN]) == tg, bar);
            __builtin_amdgcn_fence(__ATOMIC_ACQUIRE, "agent");
            xb_add(&bar[XB_XGEN(b.x)], 1u);
            asm volatile("s_waitcnt vmcnt(0)" ::: "memory");
        } else {
            XB_SPIN(xb_ld(&bar[XB_XGEN(b.x)]) == gen, bar);
            __builtin_amdgcn_fence(__ATOMIC_ACQUIRE, "agent");
            asm volatile("s_waitcnt vmcnt(0)" ::: "memory");
        }
    }
    __syncthreads();
}

__global__ void __launch_bounds__(256, 2) fwd_megakernel(Params p) {
    __shared__ __attribute__((aligned(16))) unsigned char smem[65536];
    __shared__ uint4 xb_words;
    cg::grid_group grid = cg::this_grid();
    const int nb = gridDim.x, bid = blockIdx.x;
    if (threadIdx.x == 0) xb_words = make_uint4(0u, 0u, 0u, 0u);
    __syncthreads();
    XcdBarrier xb = xcd_barrier_post((unsigned*)(p.ws + OFF_BAR), (volatile LAS unsigned*)&xb_words);
    if (p.phase_end > 1000) grid.sync();
    for (int ph = p.phase_begin; ph < p.phase_end; ++ph) {
        const int tid = opaque_tid(), lane = tid & 63, wave = tid >> 6;
        unsigned char* ws = p.ws;
        asm volatile("" : "+s"(ws));
        bf16_t* H = (bf16_t*)(ws + OFF_H);
        bf16_t* Z = (bf16_t*)(ws + OFF_Z);
        bf16_t* VT = (bf16_t*)(ws + OFF_VT);
        bf16_t* MIX = (bf16_t*)(ws + OFF_MIX);
        bf16_t* WIN = (bf16_t*)(ws + OFF_WIN);
        bf16_t* WOUT = (bf16_t*)(ws + OFF_WOUT);
        bf16_t* WMEM = (bf16_t*)(ws + OFF_WMEM);
        bf16_t* PW = (bf16_t*)(ws + OFF_PW);
        bf16_t* MH = (bf16_t*)(ws + OFF_MH);
        bf16_t* KM = (bf16_t*)(ws + OFF_KM);
        bf16_t* VMT = (bf16_t*)(ws + OFF_VMT);
        float* ROPE = (float*)(ws + OFF_ROPE);
        if (ph == 0) {
            for (int i = bid; i < 1928; i += nb) {
                if (i < 1152) { const int l = i / 576, j = i % 576, kt = j / 36, ntile = j % 36;
                    transpose_tile(p.w_in + (size_t)l * DM * INW, INW, WIN + (size_t)l * INW * DM, DM, kt * 64, ntile * 64, smem);
                } else if (i < 1664) { const int ii = i - 1152, l = ii / 256, j = ii % 256, kt = j / 16, ntile = j % 16;
                    transpose_tile(p.w_out + (size_t)l * DM * DM, DM, WOUT + (size_t)l * DM * DM, DM, kt * 64, ntile * 64, smem);
                } else if (i < 1920) { const int ii = i - 1664, l = ii / 128, j = ii % 128, kt = j / 8, ntile = j % 8;
                    transpose_tile(p.w_mem_kv + (size_t)l * DM * 512, 512, WMEM + (size_t)l * 512 * DM, DM, kt * 64, ntile * 64, smem);
                } else { const int ii = i - 1920;
                    transpose_tile(p.pool_w + (size_t)ii * 4096, 64, PW + (size_t)ii * 4096, 64, 0, 0, smem);
                }
            }
            for (int i = bid * 4 + wave; i < NTOK + 2 * NMEMTOK; i += nb * 4) {
                if (i < NTOK) {
                    const float* src = (i < NPROMPT) ? p.x_prompt + (size_t)i * DM : p.x_sample + (size_t)(i - NPROMPT) * DM;
                    rms_row_f32(src, p.norm_pre, H + (size_t)i * DM, lane);
                } else {
                    const int ii = i - NTOK, l = ii / NMEMTOK, mt = ii % NMEMTOK;
                    const float* src = (mt < 4096) ? p.mem_prompt + (size_t)mt * DM : p.mem_sample + (size_t)(mt - 4096) * DM;
                    rms_row_f32(src, p.mem_norm + l * DM, MH + ((size_t)l * NMEMTOK + mt) * DM, lane);
                }
            }
            for (int i = bid * 256 + tid; i < 1024; i += nb * 256) rope_entry(i, ROPE);
        } else {
            const int l = (ph - 1) >> 2, sub = (ph - 1) & 3;
            if (sub == 0) {
                EpiArgs e; e.C = Z; e.VT = VT; e.qn = p.q_norm + l * 64; e.kn = p.k_norm + l * 64; e.rope = ROPE;
                const bf16_t* Wl = WIN + (size_t)l * INW * DM;
                EpiArgs e2; e2.C = KM + (size_t)l * NMEMTOK * 256; e2.VT = VMT + (size_t)l * NMEMTOK * 256; e2.qn = nullptr; e2.kn = nullptr; e2.rope = nullptr;
                const bf16_t* Wm = WMEM + (size_t)l * 512 * DM;
                const bf16_t* Am = MH + (size_t)l * NMEMTOK * DM;
                for (int i = bid; i < 6912 + 160; i += nb) {
                    if (i < 6912) {
                        const int L = (i & 7) * 864 + (i >> 3);
                        const int mt = L / 18, ntile = L % 18;
                        gemm_tile<0>(H, Wl, mt * 128, ntile * 128, e, smem);
                    } else {
                        const int j = i - 6912;
                        gemm_tile<2>(Am, Wm, (j >> 2) * 128, (j & 3) * 128, e2, smem);
                    }
                }
            } else if (sub == 1) {
                for (int i = bid; i < 5376; i += nb) {
                    if (i < 3072) {
                        int b, kvh, j, T; size_t tok0, vtb;
                        if (i < 1024) { const int R = i >> 9, ip = i & 511, grp = ip & 7; j = R * 64 + (ip >> 3); b = grp >> 1; kvh = grp & 1; T = 4096;
                            tok0 = (size_t)NPROMPT + (size_t)b * 4096; vtb = (size_t)NPROMPT * 128 + ((size_t)(b * 2 + kvh) * 64) * 4096; }
                        else { const int ii = i - 1024, R = ii >> 9, ip = ii & 511, grp = R * 8 + (ip & 7); j = ip >> 3; b = grp >> 1; kvh = grp & 1; T = 2048;
                            tok0 = (size_t)b * 2048; vtb = ((size_t)(b * 2 + kvh) * 64) * 2048; }
                        const int qblk = j >> 2, head = kvh * 4 + (j & 3);
                        const size_t q0 = tok0 + (size_t)qblk * 128;
                        attn_item(Z + q0 * INW + 512 + head * 64, INW, Z + tok0 * INW + 1024 + kvh * 64, INW, VT + vtb, T, T,
                                  MIX + q0 * 1024 + 256 + head * 64, Z + q0 * INW + 1280 + head * 64, smem);
                    } else if (i < 4608) {
                        const int ii = i - 3072, qb = ii >> 2, hx = ii & 3;
                        const size_t q0 = (size_t)qb * 128;
                        const int b = (q0 < NPROMPT) ? (int)(q0 >> 11) : 16 + (int)((q0 - NPROMPT) >> 12);
                        attn_item(Z + q0 * INW + 1792 + hx * 64, INW, KM + ((size_t)l * NMEMTOK + (size_t)b * 256) * 256 + hx * 64, 256,
                                  VMT + (size_t)l * NMEMTOK * 256 + ((size_t)(b * 4 + hx) * 64) * 256, 256, 256,
                                  MIX + q0 * 1024 + 768 + hx * 64, Z + q0 * INW + 2048 + hx * 64, smem);
                    } else {
                        pool_item(Z, PW + (size_t)l * 4 * 4096, p.pool_scale + l * 256, MIX, (i - 4608) * 64, smem);
                    }
                }
            } else if (sub == 2) {
                EpiArgs e; e.C = H; e.VT = nullptr; e.qn = nullptr; e.kn = nullptr; e.rope = nullptr;
                const bf16_t* Wl = WOUT + (size_t)l * DM * DM;
                for (int i = bid; i < 3072; i += nb) {
                    const int L = (i & 7) * 384 + (i >> 3);
                    gemm_tile<1>(MIX, Wl, (L >> 3) * 128, (L & 7) * 128, e, smem);
                }
            } else {
                const bool last = (l == DEPTH - 1);
                for (int i = bid * 4 + wave; i < NTOK; i += nb * 4) {
                    const float* xs = (l == 0) ? ((i < NPROMPT) ? p.x_prompt + (size_t)i * DM : p.x_sample + (size_t)(i - NPROMPT) * DM) : p.out + (size_t)i * DM;
                    post_row(xs, H + (size_t)i * DM, p.norm_post + l * DM, p.norm_pre + (last ? l : l + 1) * DM, p.out + (size_t)i * DM, last, lane);
                }
            }
        }
        if (ph + 1 < p.phase_end) xcd_barrier(xb);
    }
}

extern "C" void kernel_launch(void* const* d_in, const int* in_sizes, int n_in, void* d_out, int out_size, void* d_ws, size_t ws_size,
                              hipStream_t stream) {
    static int grid_blocks = 0;
    if (!grid_blocks) {
        int dev = 0, cus = 0, per_cu = 0;
        hipGetDevice(&dev);
        hipDeviceGetAttribute(&cus, hipDeviceAttributeMultiprocessorCount, dev);
        hipOccupancyMaxActiveBlocksPerMultiprocessor(&per_cu, fwd_megakernel, 256, 0);
        if (per_cu > 2) per_cu = 2;
        if (per_cu < 1) per_cu = 1;
        grid_blocks = cus * per_cu;
    }
    Params p{};
    p.x_prompt = (const float*)d_in[0]; p.x_sample = (const float*)d_in[1]; p.mem_prompt = (const float*)d_in[2]; p.mem_sample = (const float*)d_in[3];
    p.norm_pre = (const float*)d_in[4]; p.norm_post = (const float*)d_in[5]; p.w_in = (const float*)d_in[6]; p.pool_w = (const float*)d_in[7];
    p.pool_scale = (const float*)d_in[8]; p.q_norm = (const float*)d_in[9]; p.k_norm = (const float*)d_in[10]; p.mem_norm = (const float*)d_in[11];
    p.w_mem_kv = (const float*)d_in[12]; p.w_out = (const float*)d_in[13];
    p.out = (float*)d_out; p.ws = (unsigned char*)d_ws;
    p.phase_begin = 0; p.phase_end = 1 + 4 * DEPTH;
    if (ws_size < WS_TOTAL) { fprintf(stderr, "workspace too small: %zu < %zu\n", ws_size, (size_t)WS_TOTAL); return; }
    hipMemsetAsync((unsigned char*)d_ws + OFF_BAR, 0, BAR_BYTES, stream);
    void* args[] = {&p};
    hipError_t e = hipLaunchCooperativeKernel((void*)fwd_megakernel, dim3(grid_blocks), dim3(256), args, 0, stream);
    if (e != hipSuccess) fprintf(stderr, "cooperative launch failed: %s (grid %d)\n", hipGetErrorString(e), grid_blocks);
}
```

```cpp
#include <hip/hip_runtime.h>
#include <hip/hip_cooperative_groups.h>
#include <stdint.h>
#include <cstdio>
namespace cg = cooperative_groups;

typedef unsigned short bf16_t;
typedef short bf16x8 __attribute__((ext_vector_type(8)));
typedef float f32x4 __attribute__((ext_vector_type(4)));
typedef float f32x16 __attribute__((ext_vector_type(16)));
typedef unsigned u32x4 __attribute__((ext_vector_type(4)));
typedef unsigned u32x2 __attribute__((ext_vector_type(2)));
typedef __bf16 bf16x2_t __attribute__((ext_vector_type(2)));
typedef float f32x2_t __attribute__((ext_vector_type(2)));
#define DI __device__ __forceinline__

constexpr int NTOK = 49152;
constexpr int NPROMPT = 32768;
constexpr int DM = 1024;
constexpr int INW = 2304;
constexpr int NMEMTOK = 5120;
constexpr int DEPTH = 2;
constexpr float EPS = 1e-6f;
constexpr float L2E = 1.4426950408889634f;

constexpr size_t OFF_H    = 0;
constexpr size_t OFF_Z    = OFF_H + (size_t)NTOK * DM * 2;
constexpr size_t OFF_VT   = OFF_Z + (size_t)NTOK * INW * 2;
constexpr size_t OFF_MIX  = OFF_VT + (size_t)NTOK * 128 * 2;
constexpr size_t OFF_WIN  = OFF_MIX + (size_t)NTOK * DM * 2;
constexpr size_t OFF_WOUT = OFF_WIN + (size_t)DEPTH * INW * DM * 2;
constexpr size_t OFF_WMEM = OFF_WOUT + (size_t)DEPTH * DM * DM * 2;
constexpr size_t OFF_PW   = OFF_WMEM + (size_t)DEPTH * 512 * DM * 2;
constexpr size_t OFF_MH   = OFF_PW + (size_t)DEPTH * 4 * 64 * 64 * 2;
constexpr size_t OFF_KM   = OFF_MH + (size_t)DEPTH * NMEMTOK * DM * 2;
constexpr size_t OFF_VMT  = OFF_KM + (size_t)DEPTH * NMEMTOK * 256 * 2;
constexpr size_t OFF_ROPE = OFF_VMT + (size_t)DEPTH * NMEMTOK * 256 * 2;
constexpr size_t OFF_BAR  = OFF_ROPE + 64 * 16 * 2 * 4;
constexpr size_t BAR_BYTES = 3456 * 4;
constexpr size_t WS_TOTAL = OFF_BAR + BAR_BYTES;

struct Params {
    const float* x_prompt; const float* x_sample; const float* mem_prompt; const float* mem_sample;
    const float* norm_pre; const float* norm_post; const float* w_in; const float* pool_w; const float* pool_scale;
    const float* q_norm; const float* k_norm; const float* mem_norm; const float* w_mem_kv; const float* w_out;
    float* out; unsigned char* ws;
    int phase_begin; int phase_end;
};

DI unsigned pk_bf16(float a, float b) {
    f32x2_t v = {a, b};
    bf16x2_t r = __builtin_convertvector(v, bf16x2_t);
    return __builtin_bit_cast(unsigned, r);
}
DI int opaque_tid() { int t = threadIdx.x; asm volatile("" : "+v"(t)); return t; }
DI void lds_barrier() { asm volatile("s_waitcnt lgkmcnt(0)\n\ts_barrier" ::: "memory"); }
DI float bflo(unsigned u) { return __uint_as_float(u << 16); }
DI float bfhi(unsigned u) { return __uint_as_float(u & 0xffff0000u); }
DI float wave_sum(float v) {
    v += __shfl_xor(v, 1); v += __shfl_xor(v, 2); v += __shfl_xor(v, 4);
    v += __shfl_xor(v, 8); v += __shfl_xor(v, 16); v += __shfl_xor(v, 32);
    return v;
}
DI float silu_f(float x) { return x * __builtin_amdgcn_rcpf(1.0f + __builtin_amdgcn_exp2f(-x * L2E)); }
DI f32x4 mfma16(bf16x8 a, bf16x8 b, f32x4 c) { return __builtin_amdgcn_mfma_f32_16x16x32_bf16(a, b, c, 0, 0, 0); }
DI f32x16 mfma32(bf16x8 a, bf16x8 b, f32x16 c) { return __builtin_amdgcn_mfma_f32_32x32x16_bf16(a, b, c, 0, 0, 0); }

DI void transpose_tile(const float* __restrict__ src, int ldn, bf16_t* __restrict__ dst, int ldk, int k0, int n0, unsigned char* smem) {
    float* tile = (float*)smem;
    const int tid = opaque_tid();
    __syncthreads();
#pragma unroll
    for (int i = 0; i < 16; ++i) {
        const int r = i * 4 + (tid >> 6), c = tid & 63;
        tile[r * 65 + c] = src[(size_t)(k0 + r) * ldn + n0 + c];
    }
    __syncthreads();
#pragma unroll
    for (int i = 0; i < 8; ++i) {
        const int n = i * 8 + (tid >> 5), kp = tid & 31;
        const float v0 = tile[(2 * kp) * 65 + n], v1 = tile[(2 * kp + 1) * 65 + n];
        *(unsigned*)(dst + (size_t)(n0 + n) * ldk + k0 + 2 * kp) = pk_bf16(v0, v1);
    }
}

DI void rms_row_f32(const float* __restrict__ src, const float* __restrict__ g, bf16_t* __restrict__ dst, int lane) {
    f32x4 v[4]; float ss = 0.f;
#pragma unroll
    for (int j = 0; j < 4; ++j) { v[j] = *(const f32x4*)(src + j * 256 + lane * 4); ss += v[j][0] * v[j][0] + v[j][1] * v[j][1] + v[j][2] * v[j][2] + v[j][3] * v[j][3]; }
    ss = wave_sum(ss);
    const float r = rsqrtf(ss * (1.0f / 1024.0f) + EPS);
#pragma unroll
    for (int j = 0; j < 4; ++j) {
        const f32x4 gg = *(const f32x4*)(g + j * 256 + lane * 4);
        u32x2 o; o.x = pk_bf16(v[j][0] * r * gg[0], v[j][1] * r * gg[1]); o.y = pk_bf16(v[j][2] * r * gg[2], v[j][3] * r * gg[3]);
        *(u32x2*)(dst + j * 256 + lane * 4) = o;
    }
}

DI void rope_entry(int idx, float* table) {
    const int n = idx >> 4, pp = idx & 15;
    double fd = 1.0;
    for (int i = 0; i < pp; ++i) fd *= 0.5623413251903491;
    const float f = (float)fd;
    const float a = (float)n * f;
    double r = (double)a;
    const double k = rint(r * 0.15915494309189535);
    r -= k * 6.283185307179586;
    const double r2 = r * r;
    double sn = r, cs = 1.0, ts = r, tc = 1.0;
    for (int i = 1; i <= 16; ++i) {
        tc = -tc * r2 / (double)((2 * i - 1) * (2 * i));
        ts = -ts * r2 / (double)((2 * i) * (2 * i + 1));
        cs += tc; sn += ts;
    }
    table[idx * 2] = (float)cs; table[idx * 2 + 1] = (float)sn;
}

struct EpiArgs {
    bf16_t* C;
    bf16_t* VT;
    const float* qn; const float* kn; const float* rope;
};

template <int MODE>
DI void gemm_tile(const bf16_t* __restrict__ A, const bf16_t* __restrict__ Bt, int m0, int n0, const EpiArgs& e, unsigned char* smem) {
    const int tid = opaque_tid(), lane = tid & 63, wave = tid >> 6;
    const int wm = wave & 1, wn = wave >> 1;
    const int lrow = tid >> 3, lc = tid & 7;
    const bf16_t* Ag = A + (size_t)(m0 + lrow) * 1024 + lc * 8;
    const bf16_t* Bg = Bt + (size_t)(n0 + lrow) * 1024 + lc * 8;
    const int st_off = lrow * 128 + ((lc ^ ((lrow >> 1) & 7)) << 4);
    const int r16 = lane & 15, q4 = lane >> 4;
    const int fr_off = r16 * 128 + ((q4 ^ (r16 >> 1)) << 4);
    const int a_base = 16384 + (wn * 64) * 128;
    const int b_base = (wm * 64) * 128;

    f32x4 acc[4][4];
#pragma unroll
    for (int i = 0; i < 4; ++i)
#pragma unroll
        for (int j = 0; j < 4; ++j) acc[i][j] = (f32x4){0.f, 0.f, 0.f, 0.f};

    u32x4 ra0[4], rb0[4], ra1[4], rb1[4];
#define G_LOAD(RA, RB, KT) { _Pragma("unroll") for (int i = 0; i < 4; ++i) { RA[i] = *(const u32x4*)(Ag + (size_t)i * 32 * 1024 + (KT) * 64); RB[i] = *(const u32x4*)(Bg + (size_t)i * 32 * 1024 + (KT) * 64); } }
#define G_STORE(RA, RB, OFF) { _Pragma("unroll") for (int i = 0; i < 4; ++i) { *(u32x4*)(smem + (OFF) + st_off + i * 4096) = RA[i]; *(u32x4*)(smem + (OFF) + 16384 + st_off + i * 4096) = RB[i]; } }
#define G_COMPUTE(CUR) { _Pragma("unroll") for (int ks = 0; ks < 2; ++ks) { bf16x8 wf[4], tf[4]; \
        _Pragma("unroll") for (int i = 0; i < 4; ++i) { \
            wf[i] = *(const bf16x8*)(smem + (CUR) + a_base + i * 2048 + (fr_off ^ (ks * 64))); \
            tf[i] = *(const bf16x8*)(smem + (CUR) + b_base + i * 2048 + (fr_off ^ (ks * 64))); } \
        _Pragma("unroll") for (int fi = 0; fi < 4; ++fi) _Pragma("unroll") for (int ti = 0; ti < 4; ++ti) acc[fi][ti] = mfma16(wf[fi], tf[ti], acc[fi][ti]); } }
    G_LOAD(ra0, rb0, 0);
    G_LOAD(ra1, rb1, 1);
    G_STORE(ra0, rb0, 0);
    lds_barrier();
    for (int kt = 0; kt < 14; kt += 2) {
        G_LOAD(ra0, rb0, kt + 2);
        G_COMPUTE(0);
        G_STORE(ra1, rb1, 32768);
        lds_barrier();
        G_LOAD(ra1, rb1, kt + 3);
        G_COMPUTE(32768);
        G_STORE(ra0, rb0, 0);
        lds_barrier();
    }
    G_COMPUTE(0);
    G_STORE(ra1, rb1, 32768);
    lds_barrier();
    G_COMPUTE(32768);
    lds_barrier();
#undef G_LOAD
#undef G_STORE
#undef G_COMPUTE

    const int cb = n0 + wn * 64;
    const int tokb = m0 + wm * 64 + r16;
    if (MODE == 1) {
#pragma unroll
        for (int ti = 0; ti < 4; ++ti) {
            bf16_t* rowp = e.C + (size_t)(tokb + ti * 16) * 1024 + cb + 4 * q4;
#pragma unroll
            for (int fi = 0; fi < 4; ++fi) {
                u32x2 o; o.x = pk_bf16(acc[fi][ti][0], acc[fi][ti][1]); o.y = pk_bf16(acc[fi][ti][2], acc[fi][ti][3]);
                *(u32x2*)(rowp + fi * 16) = o;
            }
        }
    } else if (MODE == 2) {
        if (cb < 256) {
#pragma unroll
            for (int ti = 0; ti < 4; ++ti) {
                bf16_t* rowp = e.C + (size_t)(tokb + ti * 16) * 256 + cb + 4 * q4;
#pragma unroll
                for (int fi = 0; fi < 4; ++fi) {
                    u32x2 o; o.x = pk_bf16(acc[fi][ti][0], acc[fi][ti][1]); o.y = pk_bf16(acc[fi][ti][2], acc[fi][ti][3]);
                    *(u32x2*)(rowp + fi * 16) = o;
                }
            }
        } else {
            const int hx = (cb - 256) >> 6;
#pragma unroll
            for (int ti = 0; ti < 4; ++ti) {
                const int mt = tokb + ti * 16, b = mt >> 8, m = mt & 255;
                bf16_t* bp = e.VT + ((size_t)(b * 4 + hx) * 64) * 256 + m;
#pragma unroll
                for (int fi = 0; fi < 4; ++fi)
#pragma unroll
                    for (int i = 0; i < 4; ++i) bp[(size_t)(fi * 16 + 4 * q4 + i) * 256] = (bf16_t)(pk_bf16(acc[fi][ti][i], 0.f) & 0xffffu);
            }
        }
    } else {
        if (cb >= 512 && cb < 1152) {
            const bool isq = cb < 1024;
            const float* gn = isq ? e.qn : e.kn;
            const float osc = isq ? 0.125f : 1.0f;
            f32x4 g[4];
#pragma unroll
            for (int fi = 0; fi < 4; ++fi) g[fi] = *(const f32x4*)(gn + fi * 16 + 4 * q4);
#pragma unroll
            for (int ti = 0; ti < 4; ++ti) {
                const int tok = tokb + ti * 16;
                float ss = 0.f;
#pragma unroll
                for (int fi = 0; fi < 4; ++fi)
#pragma unroll
                    for (int i = 0; i < 4; ++i) ss += acc[fi][ti][i] * acc[fi][ti][i];
                ss += __shfl_xor(ss, 16); ss += __shfl_xor(ss, 32);
                const float rinv = rsqrtf(ss * (1.0f / 64.0f) + EPS);
                const int t = (tok < NPROMPT) ? (tok & 2047) : (tok & 4095);
                const int rowi = t >> 6, coli = t & 63;
                const f32x4* rt = (const f32x4*)(e.rope + (rowi * 16 + 4 * q4) * 2);
                const f32x4* ct = (const f32x4*)(e.rope + (coli * 16 + 4 * q4) * 2);
                const f32x4 r01 = rt[0], r23 = rt[1], c01 = ct[0], c23 = ct[1];
                const float rc[4] = {r01[0], r01[2], r23[0], r23[2]}, rs[4] = {r01[1], r01[3], r23[1], r23[3]};
                const float cc[4] = {c01[0], c01[2], c23[0], c23[2]}, cs[4] = {c01[1], c01[3], c23[1], c23[3]};
                float o[4][4];
#pragma unroll
                for (int i = 0; i < 4; ++i) {
                    const float a0 = acc[0][ti][i] * rinv * g[0][i], b0 = acc[1][ti][i] * rinv * g[1][i];
                    const float a1 = acc[2][ti][i] * rinv * g[2][i], b1 = acc[3][ti][i] * rinv * g[3][i];
                    o[0][i] = (a0 * rc[i] - b0 * rs[i]) * osc; o[1][i] = (b0 * rc[i] + a0 * rs[i]) * osc;
                    o[2][i] = (a1 * cc[i] - b1 * cs[i]) * osc; o[3][i] = (b1 * cc[i] + a1 * cs[i]) * osc;
                }
                bf16_t* rowp = e.C + (size_t)tok * INW + cb + 4 * q4;
#pragma unroll
                for (int fi = 0; fi < 4; ++fi) {
                    u32x2 w; w.x = pk_bf16(o[fi][0], o[fi][1]); w.y = pk_bf16(o[fi][2], o[fi][3]);
                    *(u32x2*)(rowp + fi * 16) = w;
                }
            }
        } else if (cb >= 1152 && cb < 1280) {
            const int kvh = (cb - 1152) >> 6;
#pragma unroll
            for (int ti = 0; ti < 4; ++ti) {
                const int tok = tokb + ti * 16;
                bf16_t* bp; size_t T;
                if (tok < NPROMPT) { const int b = tok >> 11, t = tok & 2047; T = 2048; bp = e.VT + ((size_t)(b * 2 + kvh) * 64) * 2048 + t; }
                else { const int b = (tok - NPROMPT) >> 12, t = tok & 4095; T = 4096; bp = e.VT + (size_t)NPROMPT * 128 + ((size_t)(b * 2 + kvh) * 64) * 4096 + t; }
#pragma unroll
                for (int fi = 0; fi < 4; ++fi)
#pragma unroll
                    for (int i = 0; i < 4; ++i) bp[(size_t)(fi * 16 + 4 * q4 + i) * T] = (bf16_t)(pk_bf16(acc[fi][ti][i], 0.f) & 0xffffu);
            }
        } else {
            const int kind = (cb < 256) ? 0 : ((cb >= 1792 && cb < 2048) ? 2 : 1);
#pragma unroll
            for (int ti = 0; ti < 4; ++ti) {
                bf16_t* rowp = e.C + (size_t)(tokb + ti * 16) * INW + cb + 4 * q4;
#pragma unroll
                for (int fi = 0; fi < 4; ++fi) {
                    float v[4];
#pragma unroll
                    for (int i = 0; i < 4; ++i) { const float x = acc[fi][ti][i]; v[i] = (kind == 0) ? x : ((kind == 2) ? x * 0.125f : silu_f(x)); }
                    u32x2 o; o.x = pk_bf16(v[0], v[1]); o.y = pk_bf16(v[2], v[3]);
                    *(u32x2*)(rowp + fi * 16) = o;
                }
            }
        }
    }
}

DI void attn_item(const bf16_t* __restrict__ Q, int ldq, const bf16_t* __restrict__ K, int ldk, const bf16_t* __restrict__ VT, int ldv,
                  int nkeys, bf16_t* __restrict__ O, const bf16_t* __restrict__ G, unsigned char* smem) {
    const int tid = opaque_tid(), lane = tid & 63, wave = tid >> 6;
    const int r = lane & 31, h = lane >> 5;
    bf16x8 qf[4];
    {
        const bf16_t* qp = Q + (size_t)(wave * 32 + r) * ldq + h * 8;
#pragma unroll
        for (int ks = 0; ks < 4; ++ks) qf[ks] = *(const bf16x8*)(qp + ks * 16);
    }
    const int lrow = tid >> 3, lc = tid & 7;
    const bf16_t* Kg = K + (size_t)lrow * ldk + lc * 8;
    const bf16_t* Vg = VT + (size_t)lrow * ldv + lc * 8;
    const int st_off = lrow * 128 + ((lc ^ ((lrow >> 1) & 7)) << 4);
    const int pr = (r & ~12) | ((r & 4) << 1) | ((r & 8) >> 1);
    const int kswz = (pr >> 1) & 7, vswz = (r >> 1) & 7;
    const int k_off = pr * 128, v_off = r * 128;

    f32x16 o0, o1;
#pragma unroll
    for (int i = 0; i < 16; ++i) { o0[i] = 0.f; o1[i] = 0.f; }
    float m = -1e30f, lsum = 0.f;

    u32x4 rk0[2], rv0[2], rk1[2], rv1[2];
#define A_LOAD(RK, RV, KT) { _Pragma("unroll") for (int i = 0; i < 2; ++i) { \
        RK[i] = *(const u32x4*)(Kg + (size_t)((KT) * 64 + i * 32) * ldk); RV[i] = *(const u32x4*)(Vg + (size_t)i * 32 * ldv + (KT) * 64); } }
#define A_STORE(RK, RV, OFF) { _Pragma("unroll") for (int i = 0; i < 2; ++i) { *(u32x4*)(smem + (OFF) + st_off + i * 4096) = RK[i]; *(u32x4*)(smem + (OFF) + 8192 + st_off + i * 4096) = RV[i]; } }
    auto compute = [&](const int cur) __attribute__((always_inline)) {
        f32x16 s0, s1;
#pragma unroll
        for (int i = 0; i < 16; ++i) { s0[i] = 0.f; s1[i] = 0.f; }
#pragma unroll
        for (int ks = 0; ks < 4; ++ks) {
            const int co = ((ks * 2 + h) ^ kswz) << 4;
            const bf16x8 k0 = *(const bf16x8*)(smem + cur + k_off + co);
            const bf16x8 k1 = *(const bf16x8*)(smem + cur + 4096 + k_off + co);
            s0 = mfma32(k0, qf[ks], s0);
            s1 = mfma32(k1, qf[ks], s1);
        }
        float mx = s0[0];
#pragma unroll
        for (int i = 1; i < 16; ++i) mx = fmaxf(mx, s0[i]);
#pragma unroll
        for (int i = 0; i < 16; ++i) mx = fmaxf(mx, s1[i]);
        mx = fmaxf(mx, __shfl_xor(mx, 32));
        const float mnew = fmaxf(m, mx);
        const float alpha = __builtin_amdgcn_exp2f((m - mnew) * L2E);
        m = mnew;
        const float mb = mnew * L2E;
        float rs = 0.f;
#pragma unroll
        for (int i = 0; i < 16; ++i) { s0[i] = __builtin_amdgcn_exp2f(s0[i] * L2E - mb); rs += s0[i]; }
#pragma unroll
        for (int i = 0; i < 16; ++i) { s1[i] = __builtin_amdgcn_exp2f(s1[i] * L2E - mb); rs += s1[i]; }
        lsum = lsum * alpha + rs;
#pragma unroll
        for (int i = 0; i < 16; ++i) { o0[i] *= alpha; o1[i] *= alpha; }
        bf16x8 pf[4];
        {
            u32x4 t;
            t.x = pk_bf16(s0[0], s0[1]); t.y = pk_bf16(s0[2], s0[3]); t.z = pk_bf16(s0[4], s0[5]); t.w = pk_bf16(s0[6], s0[7]);
            pf[0] = __builtin_bit_cast(bf16x8, t);
            t.x = pk_bf16(s0[8], s0[9]); t.y = pk_bf16(s0[10], s0[11]); t.z = pk_bf16(s0[12], s0[13]); t.w = pk_bf16(s0[14], s0[15]);
            pf[1] = __builtin_bit_cast(bf16x8, t);
            t.x = pk_bf16(s1[0], s1[1]); t.y = pk_bf16(s1[2], s1[3]); t.z = pk_bf16(s1[4], s1[5]); t.w = pk_bf16(s1[6], s1[7]);
            pf[2] = __builtin_bit_cast(bf16x8, t);
            t.x = pk_bf16(s1[8], s1[9]); t.y = pk_bf16(s1[10], s1[11]); t.z = pk_bf16(s1[12], s1[13]); t.w = pk_bf16(s1[14], s1[15]);
            pf[3] = __builtin_bit_cast(bf16x8, t);
        }
#pragma unroll
        for (int kk = 0; kk < 4; ++kk) {
            const int co = ((kk * 2 + h) ^ vswz) << 4;
            const bf16x8 v0 = *(const bf16x8*)(smem + cur + 8192 + v_off + co);
            const bf16x8 v1 = *(const bf16x8*)(smem + cur + 8192 + 4096 + v_off + co);
            o0 = mfma32(v0, pf[kk], o0);
            o1 = mfma32(v1, pf[kk], o1);
        }
    };
    const int nt = nkeys >> 6;
    A_LOAD(rk0, rv0, 0);
    A_LOAD(rk1, rv1, 1);
    lds_barrier();
    A_STORE(rk0, rv0, 0);
    lds_barrier();
    for (int kt = 0; kt < nt - 2; kt += 2) {
        A_LOAD(rk0, rv0, kt + 2);
        compute(0);
        A_STORE(rk1, rv1, 16384);
        lds_barrier();
        A_LOAD(rk1, rv1, kt + 3);
        compute(16384);
        A_STORE(rk0, rv0, 0);
        lds_barrier();
    }
    compute(0);
    A_STORE(rk1, rv1, 16384);
    lds_barrier();
    compute(16384);
    lds_barrier();
#undef A_LOAD
#undef A_STORE
    const float lt = lsum + __shfl_xor(lsum, 32);
    const float inv = 1.0f / lt;
    const bf16_t* gp = G + (size_t)(wave * 32 + r) * INW + 4 * h;
    bf16_t* op = O + (size_t)(wave * 32 + r) * 1024 + 4 * h;
#pragma unroll
    for (int gq = 0; gq < 4; ++gq) {
        {
            const u32x2 gg = *(const u32x2*)(gp + 8 * gq);
            u32x2 w;
            w.x = pk_bf16(o0[4 * gq] * inv * bflo(gg.x), o0[4 * gq + 1] * inv * bfhi(gg.x));
            w.y = pk_bf16(o0[4 * gq + 2] * inv * bflo(gg.y), o0[4 * gq + 3] * inv * bfhi(gg.y));
            *(u32x2*)(op + 8 * gq) = w;
        }
        {
            const u32x2 gg = *(const u32x2*)(gp + 32 + 8 * gq);
            u32x2 w;
            w.x = pk_bf16(o1[4 * gq] * inv * bflo(gg.x), o1[4 * gq + 1] * inv * bfhi(gg.x));
            w.y = pk_bf16(o1[4 * gq + 2] * inv * bflo(gg.y), o1[4 * gq + 3] * inv * bfhi(gg.y));
            *(u32x2*)(op + 32 + 8 * gq) = w;
        }
    }
}

DI void pool_item(const bf16_t* __restrict__ Z, const bf16_t* __restrict__ PWT, const float* __restrict__ pscale, bf16_t* __restrict__ MIX,
                  int tokg0, unsigned char* smem) {
    const int tid = opaque_tid(), lane = tid & 63, wave = tid >> 6;
    const int T = (tokg0 < NPROMPT) ? 2048 : 4096;
    const int t0 = tokg0 & (T - 1);
    constexpr int RS = 528;
    __syncthreads();
    for (int id = tid; id < 80 * 32; id += 256) {
        const int rr = id >> 5, c = id & 31;
        const int t = t0 - 8 + rr;
        u32x4 v = (u32x4){0u, 0u, 0u, 0u};
        if (t >= 0 && t < T) v = *(const u32x4*)(Z + (size_t)(tokg0 - 8 + rr) * INW + c * 8);
        *(u32x4*)(smem + rr * RS + c * 16) = v;
    }
    __syncthreads();
    const int g = wave, half = 1 << g;
    const int r16 = lane & 15, q4 = lane >> 4;
    const bf16_t* pw = PWT + (size_t)g * 4096 + r16 * 64 + q4 * 8;
#pragma unroll 1
    for (int th = 0; th < 2; ++th) {
        bf16x8 df[2][2];
#pragma unroll
        for (int t2 = 0; t2 < 2; ++t2)
#pragma unroll
            for (int ks = 0; ks < 2; ++ks) {
                const int tl = (th * 2 + t2) * 16 + r16, t = t0 + tl;
                const int lo = max(t - half, 0), hi = min(t + half, T);
                const float icnt = 1.0f / (float)(hi - lo);
                float s[8];
#pragma unroll
                for (int j = 0; j < 8; ++j) s[j] = 0.f;
                const unsigned char* bp = smem + (tl + 8 - half) * RS + (g * 64 + ks * 32 + q4 * 8) * 2;
                for (int j = 0; j < 2 * half; ++j) {
                    const u32x4 v = *(const u32x4*)(bp + j * RS);
                    s[0] += bflo(v.x); s[1] += bfhi(v.x); s[2] += bflo(v.y); s[3] += bfhi(v.y);
                    s[4] += bflo(v.z); s[5] += bfhi(v.z); s[6] += bflo(v.w); s[7] += bfhi(v.w);
                }
                const u32x4 c = *(const u32x4*)(bp + half * RS);
                u32x4 o;
                o.x = pk_bf16(s[0] * icnt - bflo(c.x), s[1] * icnt - bfhi(c.x));
                o.y = pk_bf16(s[2] * icnt - bflo(c.y), s[3] * icnt - bfhi(c.y));
                o.z = pk_bf16(s[4] * icnt - bflo(c.z), s[5] * icnt - bfhi(c.z));
                o.w = pk_bf16(s[6] * icnt - bflo(c.w), s[7] * icnt - bfhi(c.w));
                df[t2][ks] = __builtin_bit_cast(bf16x8, o);
            }
        f32x4 acc[4][2];
#pragma unroll
        for (int i = 0; i < 4; ++i)
#pragma unroll
            for (int j = 0; j < 2; ++j) acc[i][j] = (f32x4){0.f, 0.f, 0.f, 0.f};
#pragma unroll
        for (int fi = 0; fi < 4; ++fi)
#pragma unroll
            for (int ks = 0; ks < 2; ++ks) {
                const bf16x8 wf = *(const bf16x8*)(pw + fi * 16 * 64 + ks * 32);
#pragma unroll
                for (int t2 = 0; t2 < 2; ++t2) acc[fi][t2] = mfma16(wf, df[t2][ks], acc[fi][t2]);
            }
#pragma unroll
        for (int t2 = 0; t2 < 2; ++t2) {
            const size_t tok = (size_t)tokg0 + (th * 2 + t2) * 16 + r16;
#pragma unroll
            for (int fi = 0; fi < 4; ++fi) {
                const int n = g * 64 + fi * 16 + 4 * q4;
                const f32x4 ps = *(const f32x4*)(pscale + n);
                const u32x2 gg = *(const u32x2*)(Z + tok * INW + 256 + n);
                u32x2 w;
                w.x = pk_bf16(acc[fi][t2][0] * ps[0] * bflo(gg.x), acc[fi][t2][1] * ps[1] * bfhi(gg.x));
                w.y = pk_bf16(acc[fi][t2][2] * ps[2] * bflo(gg.y), acc[fi][t2][3] * ps[3] * bfhi(gg.y));
                *(u32x2*)(MIX + tok * 1024 + n) = w;
            }
        }
    }
}

DI void post_row(const float* __restrict__ xsrc, bf16_t* __restrict__ yh, const float* __restrict__ gpost, const float* __restrict__ gpre_next,
                 float* __restrict__ xdst, bool last, int lane) {
    u32x4 yv[2]; f32x4 xv[4];
#pragma unroll
    for (int j = 0; j < 2; ++j) yv[j] = *(const u32x4*)(yh + j * 512 + lane * 8);
#pragma unroll
    for (int j = 0; j < 2; ++j) { xv[2 * j] = *(const f32x4*)(xsrc + j * 512 + lane * 8); xv[2 * j + 1] = *(const f32x4*)(xsrc + j * 512 + lane * 8 + 4); }
    float y[16];
#pragma unroll
    for (int j = 0; j < 2; ++j) {
        y[8 * j + 0] = bflo(yv[j].x); y[8 * j + 1] = bfhi(yv[j].x); y[8 * j + 2] = bflo(yv[j].y); y[8 * j + 3] = bfhi(yv[j].y);
        y[8 * j + 4] = bflo(yv[j].z); y[8 * j + 5] = bfhi(yv[j].z); y[8 * j + 6] = bflo(yv[j].w); y[8 * j + 7] = bfhi(yv[j].w);
    }
    float ss = 0.f;
#pragma unroll
    for (int i = 0; i < 16; ++i) ss += y[i] * y[i];
    ss = wave_sum(ss);
    const float r = rsqrtf(ss * (1.0f / 1024.0f) + EPS);
    float xn[16]; float ss2 = 0.f;
#pragma unroll
    for (int j = 0; j < 2; ++j) {
        const f32x4 g0 = *(const f32x4*)(gpost + j * 512 + lane * 8), g1 = *(const f32x4*)(gpost + j * 512 + lane * 8 + 4);
#pragma unroll
        for (int i = 0; i < 4; ++i) {
            xn[8 * j + i] = xv[2 * j][i] + y[8 * j + i] * r * g0[i];
            xn[8 * j + 4 + i] = xv[2 * j + 1][i] + y[8 * j + 4 + i] * r * g1[i];
        }
    }
#pragma unroll
    for (int i = 0; i < 16; ++i) ss2 += xn[i] * xn[i];
#pragma unroll
    for (int j = 0; j < 2; ++j) {
        *(f32x4*)(xdst + j * 512 + lane * 8) = (f32x4){xn[8 * j], xn[8 * j + 1], xn[8 * j + 2], xn[8 * j + 3]};
        *(f32x4*)(xdst + j * 512 + lane * 8 + 4) = (f32x4){xn[8 * j + 4], xn[8 * j + 5], xn[8 * j + 6], xn[8 * j + 7]};
    }
    if (!last) {
        ss2 = wave_sum(ss2);
        const float r2 = rsqrtf(ss2 * (1.0f / 1024.0f) + EPS);
#pragma unroll
        for (int j = 0; j < 2; ++j) {
            const f32x4 g0 = *(const f32x4*)(gpre_next + j * 512 + lane * 8), g1 = *(const f32x4*)(gpre_next + j * 512 + lane * 8 + 4);
            u32x4 o;
            o.x = pk_bf16(xn[8 * j] * r2 * g0[0], xn[8 * j + 1] * r2 * g0[1]);
            o.y = pk_bf16(xn[8 * j + 2] * r2 * g0[2], xn[8 * j + 3] * r2 * g0[3]);
            o.z = pk_bf16(xn[8 * j + 4] * r2 * g1[0], xn[8 * j + 5] * r2 * g1[1]);
            o.w = pk_bf16(xn[8 * j + 6] * r2 * g1[2], xn[8 * j + 7] * r2 * g1[3]);
            *(u32x4*)(yh + j * 512 + lane * 8) = o;
        }
    }
}

#define XB_TMO      128
#define XB_XCNT(j)  (256  + 64 * (j))
#define XB_XSUB(j)  (1280 + 64 * (j))
#define XB_XGEN(j)  (2304 + 64 * (j))
#define XB_TOP      3328
#define XB_TOPGEN   3392
#define XCD_BAR_WORDS 3456
#define XB_SPIN_CAP (1u << 18)
#define LAS __attribute__((address_space(3)))
DI unsigned xb_ld(unsigned* p)              { return __hip_atomic_load(p, __ATOMIC_RELAXED, __HIP_MEMORY_SCOPE_AGENT); }
DI unsigned xb_add(unsigned* p, unsigned v) { return __hip_atomic_fetch_add(p, v, __ATOMIC_RELAXED, __HIP_MEMORY_SCOPE_AGENT); }
DI unsigned xb_xcc_id() { return (unsigned)__builtin_amdgcn_s_getreg((3 << 11) | 20) & 0xFu; }
#define XB_SPIN(cond, bar) do { unsigned _sp = 0; while (cond) { __builtin_amdgcn_s_sleep(1); \
    if ((++_sp & 255u) == 0u) { if (xb_ld(&(bar)[XB_TMO])) break; if (_sp > XB_SPIN_CAP) { atomicAdd(&(bar)[XB_TMO], 1u); break; } } } } while (0)
struct XcdBarrier { unsigned* bar; unsigned x; volatile LAS unsigned* st; };
DI XcdBarrier xcd_barrier_post(unsigned* bar, volatile LAS unsigned* st) {
    XcdBarrier b; b.bar = bar; b.x = xb_xcc_id(); b.st = st;
    if (threadIdx.x == 0) (void)xb_add(&bar[XB_XCNT(b.x)], 1u);
    return b;
}
DI void xcd_barrier_complete(unsigned* bar, unsigned x, unsigned& nloc, unsigned& nx) {
    const unsigned G = gridDim.x * gridDim.y * gridDim.z;
    unsigned sum, cnt, mine, sp = 0u;
    for (;;) {
        sum = 0u; cnt = 0u; mine = 0u;
#pragma unroll
        for (unsigned j = 0; j < 16; ++j) { const unsigned c = xb_ld(&bar[XB_XCNT(j)]); sum += c; cnt += (c > 0u) ? 1u : 0u; mine = (j == x) ? c : mine; }
        if (sum == G) break;
        __builtin_amdgcn_s_sleep(1);
        if ((++sp & 255u) == 0u) { if (xb_ld(&bar[XB_TMO])) break; if (sp > XB_SPIN_CAP) { atomicAdd(&bar[XB_TMO], 1u); break; } }
    }
    nloc = mine > 0u ? mine : 1u; nx = cnt > 0u ? cnt : 1u;
}
DI void xcd_barrier(const XcdBarrier& b) {
    asm volatile("s_waitcnt vmcnt(0)" ::: "memory");
    __syncthreads();
    if (threadIdx.x == 0) {
        unsigned* bar = b.bar;
        __builtin_amdgcn_s_waitcnt(0);
        unsigned nloc = b.st[0], nx = b.st[1];
        if (nloc == 0u) { xcd_barrier_complete(bar, b.x, nloc, nx); b.st[0] = nloc; b.st[1] = nx; }
        const unsigned old = xb_add(&bar[XB_XSUB(b.x)], 1u);
        const unsigned gen = old / nloc;
        if (old + 1u == (gen + 1u) * nloc) {
            __builtin_amdgcn_fence(__ATOMIC_RELEASE, "agent");
            asm volatile("s_waitcnt vmcnt(0)" ::: "memory");
            const unsigned og = xb_add(&bar[XB_TOP], 1u);
            const unsigned tg = og / nx;
            if (og + 1u == (tg + 1u) * nx) xb_add(&bar[XB_TOPGEN], 1u);
            else XB_SPIN(xb_ld(&bar[XB_TOPGEN]) == tg, bar);
            __builtin_amdgcn_fence(__ATOMIC_ACQUIRE, "agent");
            xb_add(&bar[XB_XGEN(b.x)], 1u);
            asm volatile("s_waitcnt vmcnt(0)" ::: "memory");
        } else {
            XB_SPIN(xb_ld(&bar[XB_XGEN(b.x)]) == gen, bar);
            __builtin_amdgcn_fence(__ATOMIC_ACQUIRE, "agent");
            asm volatile("s_waitcnt vmcnt(0)" ::: "memory");
        }
    }
    __syncthreads();
}

__global__ void __launch_bounds__(256, 2) fwd_megakernel(Params p) {
    __shared__ __attribute__((aligned(16))) unsigned char smem[65536];
    __shared__ uint4 xb_words;
    cg::grid_group grid = cg::this_grid();
    const int nb = gridDim.x, bid = blockIdx.x;
    if (threadIdx.x == 0) xb_words = make_uint4(0u, 0u, 0u, 0u);
    __syncthreads();
    XcdBarrier xb = xcd_barrier_post((unsigned*)(p.ws + OFF_BAR), (volatile LAS unsigned*)&xb_words);
    if (p.phase_end > 1000) grid.sync();
    for (int ph = p.phase_begin; ph < p.phase_end; ++ph) {
        const int tid = opaque_tid(), lane = tid & 63, wave = tid >> 6;
        unsigned char* ws = p.ws;
        bf16_t* H = (bf16_t*)(ws + OFF_H);
        bf16_t* Z = (bf16_t*)(ws + OFF_Z);
        bf16_t* VT = (bf16_t*)(ws + OFF_VT);
        bf16_t* MIX = (bf16_t*)(ws + OFF_MIX);
        bf16_t* WIN = (bf16_t*)(ws + OFF_WIN);
        bf16_t* WOUT = (bf16_t*)(ws + OFF_WOUT);
        bf16_t* WMEM = (bf16_t*)(ws + OFF_WMEM);
        bf16_t* PW = (bf16_t*)(ws + OFF_PW);
        bf16_t* MH = (bf16_t*)(ws + OFF_MH);
        bf16_t* KM = (bf16_t*)(ws + OFF_KM);
        bf16_t* VMT = (bf16_t*)(ws + OFF_VMT);
        float* ROPE = (float*)(ws + OFF_ROPE);
        if (ph == 0) {
            for (int i = bid; i < 1928; i += nb) {
                if (i < 1152) { const int l = i / 576, j = i % 576, kt = j / 36, ntile = j % 36;
                    transpose_tile(p.w_in + (size_t)l * DM * INW, INW, WIN + (size_t)l * INW * DM, DM, kt * 64, ntile * 64, smem);
                } else if (i < 1664) { const int ii = i - 1152, l = ii / 256, j = ii % 256, kt = j / 16, ntile = j % 16;
                    transpose_tile(p.w_out + (size_t)l * DM * DM, DM, WOUT + (size_t)l * DM * DM, DM, kt * 64, ntile * 64, smem);
                } else if (i < 1920) { const int ii = i - 1664, l = ii / 128, j = ii % 128, kt = j / 8, ntile = j % 8;
                    transpose_tile(p.w_mem_kv + (size_t)l * DM * 512, 512, WMEM + (size_t)l * 512 * DM, DM, kt * 64, ntile * 64, smem);
                } else { const int ii = i - 1920;
                    transpose_tile(p.pool_w + (size_t)ii * 4096, 64, PW + (size_t)ii * 4096, 64, 0, 0, smem);
                }
            }
            for (int i = bid * 4 + wave; i < NTOK + 2 * NMEMTOK; i += nb * 4) {
                if (i < NTOK) {
                    const float* src = (i < NPROMPT) ? p.x_prompt + (size_t)i * DM : p.x_sample + (size_t)(i - NPROMPT) * DM;
                    rms_row_f32(src, p.norm_pre, H + (size_t)i * DM, lane);
                } else {
                    const int ii = i - NTOK, l = ii / NMEMTOK, mt = ii % NMEMTOK;
                    const float* src = (mt < 4096) ? p.mem_prompt + (size_t)mt * DM : p.mem_sample + (size_t)(mt - 4096) * DM;
                    rms_row_f32(src, p.mem_norm + l * DM, MH + ((size_t)l * NMEMTOK + mt) * DM, lane);
                }
            }
            for (int i = bid * 256 + tid; i < 1024; i += nb * 256) rope_entry(i, ROPE);
        } else {
            const int l = (ph - 1) >> 2, sub = (ph - 1) & 3;
            if (sub == 0) {
                EpiArgs e; e.C = Z; e.VT = VT; e.qn = p.q_norm + l * 64; e.kn = p.k_norm + l * 64; e.rope = ROPE;
                const bf16_t* Wl = WIN + (size_t)l * INW * DM;
                EpiArgs e2; e2.C = KM + (size_t)l * NMEMTOK * 256; e2.VT = VMT + (size_t)l * NMEMTOK * 256; e2.qn = nullptr; e2.kn = nullptr; e2.rope = nullptr;
                const bf16_t* Wm = WMEM + (size_t)l * 512 * DM;
                const bf16_t* Am = MH + (size_t)l * NMEMTOK * DM;
                for (int i = bid; i < 6912 + 160; i += nb) {
                    if (i < 6912) {
                        const int L = (i & 7) * 864 + (i >> 3);
                        const int mt = L / 18, ntile = L % 18;
                        gemm_tile<0>(H, Wl, mt * 128, ntile * 128, e, smem);
                    } else {
                        const int j = i - 6912;
                        gemm_tile<2>(Am, Wm, (j >> 2) * 128, (j & 3) * 128, e2, smem);
                    }
                }
            } else if (sub == 1) {
                for (int i = bid; i < 5376; i += nb) {
                    if (i < 3072) {
                        int b, kvh, j, T; size_t tok0, vtb;
                        if (i < 1024) { const int R = i >> 9, ip = i & 511, grp = ip & 7; j = R * 64 + (ip >> 3); b = grp >> 1; kvh = grp & 1; T = 4096;
                            tok0 = (size_t)NPROMPT + (size_t)b * 4096; vtb = (size_t)NPROMPT * 128 + ((size_t)(b * 2 + kvh) * 64) * 4096; }
                        else { const int ii = i - 1024, R = ii >> 9, ip = ii & 511, grp = R * 8 + (ip & 7); j = ip >> 3; b = grp >> 1; kvh = grp & 1; T = 2048;
                            tok0 = (size_t)b * 2048; vtb = ((size_t)(b * 2 + kvh) * 64) * 2048; }
                        const int qblk = j >> 2, head = kvh * 4 + (j & 3);
                        const size_t q0 = tok0 + (size_t)qblk * 128;
                        attn_item(Z + q0 * INW + 512 + head * 64, INW, Z + tok0 * INW + 1024 + kvh * 64, INW, VT + vtb, T, T,
                                  MIX + q0 * 1024 + 256 + head * 64, Z + q0 * INW + 1280 + head * 64, smem);
                    } else if (i < 4608) {
                        const int ii = i - 3072, qb = ii >> 2, hx = ii & 3;
                        const size_t q0 = (size_t)qb * 128;
                        const int b = (q0 < NPROMPT) ? (int)(q0 >> 11) : 16 + (int)((q0 - NPROMPT) >> 12);
                        attn_item(Z + q0 * INW + 1792 + hx * 64, INW, KM + ((size_t)l * NMEMTOK + (size_t)b * 256) * 256 + hx * 64, 256,
                                  VMT + (size_t)l * NMEMTOK * 256 + ((size_t)(b * 4 + hx) * 64) * 256, 256, 256,
                                  MIX + q0 * 1024 + 768 + hx * 64, Z + q0 * INW + 2048 + hx * 64, smem);
                    } else {
                        pool_item(Z, PW + (size_t)l * 4 * 4096, p.pool_scale + l * 256, MIX, (i - 4608) * 64, smem);
                    }
                }
            } else if (sub == 2) {
                EpiArgs e; e.C = H; e.VT = nullptr; e.qn = nullptr; e.kn = nullptr; e.rope = nullptr;
                const bf16_t* Wl = WOUT + (size_t)l * DM * DM;
                for (int i = bid; i < 3072; i += nb) {
                    const int L = (i & 7) * 384 + (i >> 3);
                    gemm_tile<1>(MIX, Wl, (L >> 3) * 128, (L & 7) * 128, e, smem);
                }
            } else {
                const bool last = (l == DEPTH - 1);
                for (int i = bid * 4 + wave; i < NTOK; i += nb * 4) {
                    const float* xs = (l == 0) ? ((i < NPROMPT) ? p.x_prompt + (size_t)i * DM : p.x_sample + (size_t)(i - NPROMPT) * DM) : p.out + (size_t)i * DM;
                    post_row(xs, H + (size_t)i * DM, p.norm_post + l * DM, p.norm_pre + (last ? l : l + 1) * DM, p.out + (size_t)i * DM, last, lane);
                }
            }
        }
        if (ph + 1 < p.phase_end) xcd_barrier(xb);
    }
}

extern "C" void kernel_launch(void* const* d_in, const int* in_sizes, int n_in, void* d_out, int out_size, void* d_ws, size_t ws_size,
                              hipStream_t stream) {
    static int grid_blocks = 0;
    if (!grid_blocks) {
        int dev = 0, cus = 0, per_cu = 0;
        hipGetDevice(&dev);
        hipDeviceGetAttribute(&cus, hipDeviceAttributeMultiprocessorCount, dev);
        hipOccupancyMaxActiveBlocksPerMultiprocessor(&per_cu, fwd_megakernel, 256, 0);
        if (per_cu > 2) per_cu = 2;
        if (per_cu < 1) per_cu = 1;
        grid_blocks = cus * per_cu;
    }
    Params p{};
    p.x_prompt = (const float*)d_in[0]; p.x_sample = (const float*)d_in[1]; p.mem_prompt = (const float*)d_in[2]; p.mem_sample = (const float*)d_in[3];
    p.norm_pre = (const float*)d_in[4]; p.norm_post = (const float*)d_in[5]; p.w_in = (const float*)d_in[6]; p.pool_w = (const float*)d_in[7];
    p.pool_scale = (const float*)d_in[8]; p.q_norm = (const float*)d_in[9]; p.k_norm = (const float*)d_in[10]; p.mem_norm = (const float*)d_in[11];
    p.w_mem_kv = (const float*)d_in[12]; p.w_out = (const float*)d_in[13];
    p.out = (float*)d_out; p.ws = (unsigned char*)d_ws;
    p.phase_begin = 0; p.phase_end = 1 + 4 * DEPTH;
    if (ws_size < WS_TOTAL) { fprintf(stderr, "workspace too small: %zu < %zu\n", ws_size, (size_t)WS_TOTAL); return; }
    hipMemsetAsync((unsigned char*)d_ws + OFF_BAR, 0, BAR_BYTES, stream);
    void* args[] = {&p};
    hipError_t e = hipLaunchCooperativeKernel((void*)fwd_megakernel, dim3(grid_blocks), dim3(256), args, 0, stream);
    if (e != hipSuccess) fprintf(stderr, "cooperative launch failed: %s (grid %d)\n", hipGetErrorString(e), grid_blocks);
}
```

```cpp
#include <hip/hip_runtime.h>
#include <hip/hip_cooperative_groups.h>
#include <stdint.h>
#include <cstdio>
namespace cg = cooperative_groups;

typedef unsigned short bf16_t;
typedef short bf16x8 __attribute__((ext_vector_type(8)));
typedef float f32x4 __attribute__((ext_vector_type(4)));
typedef float f32x16 __attribute__((ext_vector_type(16)));
typedef unsigned u32x4 __attribute__((ext_vector_type(4)));
typedef unsigned u32x2 __attribute__((ext_vector_type(2)));
typedef __bf16 bf16x2_t __attribute__((ext_vector_type(2)));
typedef float f32x2_t __attribute__((ext_vector_type(2)));
#define DI __device__ __forceinline__

constexpr int NTOK = 49152;
constexpr int NPROMPT = 32768;
constexpr int DM = 1024;
constexpr int INW = 2304;
constexpr int NMEMTOK = 5120;
constexpr int DEPTH = 2;
constexpr float EPS = 1e-6f;
constexpr float L2E = 1.4426950408889634f;

constexpr size_t OFF_H    = 0;
constexpr size_t OFF_Z    = OFF_H + (size_t)NTOK * DM * 2;
constexpr size_t OFF_VT   = OFF_Z + (size_t)NTOK * INW * 2;
constexpr size_t OFF_MIX  = OFF_VT + (size_t)NTOK * 128 * 2;
constexpr size_t OFF_WIN  = OFF_MIX + (size_t)NTOK * DM * 2;
constexpr size_t OFF_WOUT = OFF_WIN + (size_t)DEPTH * INW * DM * 2;
constexpr size_t OFF_WMEM = OFF_WOUT + (size_t)DEPTH * DM * DM * 2;
constexpr size_t OFF_PW   = OFF_WMEM + (size_t)DEPTH * 512 * DM * 2;
constexpr size_t OFF_MH   = OFF_PW + (size_t)DEPTH * 4 * 64 * 64 * 2;
constexpr size_t OFF_KM   = OFF_MH + (size_t)DEPTH * NMEMTOK * DM * 2;
constexpr size_t OFF_VMT  = OFF_KM + (size_t)DEPTH * NMEMTOK * 256 * 2;
constexpr size_t OFF_ROPE = OFF_VMT + (size_t)DEPTH * NMEMTOK * 256 * 2;
constexpr size_t OFF_BAR  = OFF_ROPE + 64 * 16 * 2 * 4;
constexpr size_t BAR_BYTES = 3456 * 4;
constexpr size_t WS_TOTAL = OFF_BAR + BAR_BYTES;

struct Params {
    const float* x_prompt; const float* x_sample; const float* mem_prompt; const float* mem_sample;
    const float* norm_pre; const float* norm_post; const float* w_in; const float* pool_w; const float* pool_scale;
    const float* q_norm; const float* k_norm; const float* mem_norm; const float* w_mem_kv; const float* w_out;
    float* out; unsigned char* ws;
    int phase_begin; int phase_end;
};

DI unsigned pk_bf16(float a, float b) {
    f32x2_t v = {a, b};
    bf16x2_t r = __builtin_convertvector(v, bf16x2_t);
    return __builtin_bit_cast(unsigned, r);
}
DI int opaque_tid() { int t = threadIdx.x; asm volatile("" : "+v"(t)); return t; }
DI void lds_barrier() { asm volatile("s_waitcnt lgkmcnt(0)\n\ts_barrier" ::: "memory"); }
DI float bflo(unsigned u) { return __uint_as_float(u << 16); }
DI float bfhi(unsigned u) { return __uint_as_float(u & 0xffff0000u); }
DI float wave_sum(float v) {
    v += __shfl_xor(v, 1); v += __shfl_xor(v, 2); v += __shfl_xor(v, 4);
    v += __shfl_xor(v, 8); v += __shfl_xor(v, 16); v += __shfl_xor(v, 32);
    return v;
}
DI float silu_f(float x) { return x * __builtin_amdgcn_rcpf(1.0f + __builtin_amdgcn_exp2f(-x * L2E)); }
DI f32x4 mfma16(bf16x8 a, bf16x8 b, f32x4 c) { return __builtin_amdgcn_mfma_f32_16x16x32_bf16(a, b, c, 0, 0, 0); }
DI f32x16 mfma32(bf16x8 a, bf16x8 b, f32x16 c) { return __builtin_amdgcn_mfma_f32_32x32x16_bf16(a, b, c, 0, 0, 0); }

DI void transpose_tile(const float* __restrict__ src, int ldn, bf16_t* __restrict__ dst, int ldk, int k0, int n0, unsigned char* smem) {
    float* tile = (float*)smem;
    const int tid = opaque_tid();
    __syncthreads();
#pragma unroll
    for (int i = 0; i < 8; ++i) {
        const int r = i * 8 + (tid >> 6), c = tid & 63;
        tile[r * 65 + c] = src[(size_t)(k0 + r) * ldn + n0 + c];
    }
    __syncthreads();
#pragma unroll
    for (int i = 0; i < 4; ++i) {
        const int n = i * 16 + (tid >> 5), kp = tid & 31;
        const float v0 = tile[(2 * kp) * 65 + n], v1 = tile[(2 * kp + 1) * 65 + n];
        *(unsigned*)(dst + (size_t)(n0 + n) * ldk + k0 + 2 * kp) = pk_bf16(v0, v1);
    }
}

DI void rms_row_f32(const float* __restrict__ src, const float* __restrict__ g, bf16_t* __restrict__ dst, int lane) {
    f32x4 v[4]; float ss = 0.f;
#pragma unroll
    for (int j = 0; j < 4; ++j) { v[j] = *(const f32x4*)(src + j * 256 + lane * 4); ss += v[j][0] * v[j][0] + v[j][1] * v[j][1] + v[j][2] * v[j][2] + v[j][3] * v[j][3]; }
    ss = wave_sum(ss);
    const float r = rsqrtf(ss * (1.0f / 1024.0f) + EPS);
#pragma unroll
    for (int j = 0; j < 4; ++j) {
        const f32x4 gg = *(const f32x4*)(g + j * 256 + lane * 4);
        u32x2 o; o.x = pk_bf16(v[j][0] * r * gg[0], v[j][1] * r * gg[1]); o.y = pk_bf16(v[j][2] * r * gg[2], v[j][3] * r * gg[3]);
        *(u32x2*)(dst + j * 256 + lane * 4) = o;
    }
}

DI void rope_entry(int idx, float* table) {
    const int n = idx >> 4, pp = idx & 15;
    double fd = 1.0;
    for (int i = 0; i < pp; ++i) fd *= 0.5623413251903491;
    const float f = (float)fd;
    const float a = (float)n * f;
    double r = (double)a;
    const double k = rint(r * 0.15915494309189535);
    r -= k * 6.283185307179586;
    const double r2 = r * r;
    double sn = r, cs = 1.0, ts = r, tc = 1.0;
    for (int i = 1; i <= 16; ++i) {
        tc = -tc * r2 / (double)((2 * i - 1) * (2 * i));
        ts = -ts * r2 / (double)((2 * i) * (2 * i + 1));
        cs += tc; sn += ts;
    }
    table[idx * 2] = (float)cs; table[idx * 2 + 1] = (float)sn;
}

struct EpiArgs {
    bf16_t* C;
    bf16_t* VT;
    const float* qn; const float* kn; const float* rope;
};

template <int MODE>
DI void gemm_tile(const bf16_t* __restrict__ A, const bf16_t* __restrict__ Bt, int m0, int n0, const EpiArgs& e, unsigned char* smem) {
    const int tid = opaque_tid(), lane = tid & 63, wave = tid >> 6;
    const int wm = wave >> 2, wn = wave & 3;
    const int lrow = tid >> 3, lc = tid & 7;
    const bf16_t* Ag = A + (size_t)(m0 + lrow) * 1024 + lc * 8;
    const bf16_t* Bg = Bt + (size_t)(n0 + lrow) * 1024 + lc * 8;
    const int st_off = lrow * 128 + ((lc ^ ((lrow >> 1) & 7)) << 4);
    const int r16 = lane & 15, q4 = lane >> 4;
    const int fr_off = r16 * 128 + ((q4 ^ (r16 >> 1)) << 4);
    const int a_base = 32768 + (wn * 64) * 128;
    const int b_base = (wm * 128) * 128;
    constexpr int TI = 8;

    f32x4 acc[4][TI];
#pragma unroll
    for (int i = 0; i < 4; ++i)
#pragma unroll
        for (int j = 0; j < TI; ++j) acc[i][j] = (f32x4){0.f, 0.f, 0.f, 0.f};

    u32x4 ra[4], rb[4];
#define G_LOAD(KT) { _Pragma("unroll") for (int i = 0; i < 4; ++i) { ra[i] = *(const u32x4*)(Ag + (size_t)i * 64 * 1024 + (KT) * 64); rb[i] = *(const u32x4*)(Bg + (size_t)i * 64 * 1024 + (KT) * 64); } }
#define G_STORE(OFF) { _Pragma("unroll") for (int i = 0; i < 4; ++i) { *(u32x4*)(smem + (OFF) + st_off + i * 8192) = ra[i]; *(u32x4*)(smem + (OFF) + 32768 + st_off + i * 8192) = rb[i]; } }
#define G_COMPUTE(CUR) { _Pragma("unroll") for (int ks = 0; ks < 2; ++ks) { bf16x8 wf[4], tf[TI]; \
        _Pragma("unroll") for (int i = 0; i < 4; ++i) wf[i] = *(const bf16x8*)(smem + (CUR) + a_base + i * 2048 + (fr_off ^ (ks * 64))); \
        _Pragma("unroll") for (int i = 0; i < TI; ++i) tf[i] = *(const bf16x8*)(smem + (CUR) + b_base + i * 2048 + (fr_off ^ (ks * 64))); \
        _Pragma("unroll") for (int ti = 0; ti < TI; ++ti) _Pragma("unroll") for (int fi = 0; fi < 4; ++fi) acc[fi][ti] = mfma16(wf[fi], tf[ti], acc[fi][ti]); \
        __builtin_amdgcn_sched_barrier(0); } }
    G_LOAD(0);
    G_STORE(0);
    G_LOAD(1);
    lds_barrier();
    for (int kt = 0; kt < 14; kt += 2) {
        G_STORE(65536);
        G_LOAD(kt + 2);
        __builtin_amdgcn_sched_barrier(0);
        G_COMPUTE(0);
        lds_barrier();
        G_STORE(0);
        G_LOAD(kt + 3);
        __builtin_amdgcn_sched_barrier(0);
        G_COMPUTE(65536);
        lds_barrier();
    }
    G_STORE(65536);
    __builtin_amdgcn_sched_barrier(0);
    G_COMPUTE(0);
    lds_barrier();
    G_COMPUTE(65536);
    lds_barrier();
#undef G_LOAD
#undef G_STORE
#undef G_COMPUTE

    const int cb = n0 + wn * 64;
    const int tokb = m0 + wm * 128 + r16;
    if (MODE == 1) {
#pragma unroll
        for (int ti = 0; ti < TI; ++ti) {
            bf16_t* rowp = e.C + (size_t)(tokb + ti * 16) * 1024 + cb + 4 * q4;
#pragma unroll
            for (int fi = 0; fi < 4; ++fi) {
                u32x2 o; o.x = pk_bf16(acc[fi][ti][0], acc[fi][ti][1]); o.y = pk_bf16(acc[fi][ti][2], acc[fi][ti][3]);
                *(u32x2*)(rowp + fi * 16) = o;
            }
        }
    } else if (MODE == 2) {
        if (cb < 256) {
#pragma unroll
            for (int ti = 0; ti < TI; ++ti) {
                bf16_t* rowp = e.C + (size_t)(tokb + ti * 16) * 256 + cb + 4 * q4;
#pragma unroll
                for (int fi = 0; fi < 4; ++fi) {
                    u32x2 o; o.x = pk_bf16(acc[fi][ti][0], acc[fi][ti][1]); o.y = pk_bf16(acc[fi][ti][2], acc[fi][ti][3]);
                    *(u32x2*)(rowp + fi * 16) = o;
                }
            }
        } else {
            const int hx = (cb - 256) >> 6;
#pragma unroll
            for (int ti = 0; ti < TI; ++ti) {
                const int mt = tokb + ti * 16, b = mt >> 8, m = mt & 255;
                bf16_t* bp = e.VT + ((size_t)(b * 4 + hx) * 64) * 256 + m;
#pragma unroll
                for (int fi = 0; fi < 4; ++fi)
#pragma unroll
                    for (int i = 0; i < 4; ++i) bp[(size_t)(fi * 16 + 4 * q4 + i) * 256] = (bf16_t)(pk_bf16(acc[fi][ti][i], 0.f) & 0xffffu);
            }
        }
    } else {
        if (cb >= 512 && cb < 1152) {
            const bool isq = cb < 1024;
            const float* gn = isq ? e.qn : e.kn;
            const float osc = isq ? 0.125f : 1.0f;
            f32x4 g[4];
#pragma unroll
            for (int fi = 0; fi < 4; ++fi) g[fi] = *(const f32x4*)(gn + fi * 16 + 4 * q4);
#pragma unroll
            for (int ti = 0; ti < TI; ++ti) {
                const int tok = tokb + ti * 16;
                float ss = 0.f;
#pragma unroll
                for (int fi = 0; fi < 4; ++fi)
#pragma unroll
                    for (int i = 0; i < 4; ++i) ss += acc[fi][ti][i] * acc[fi][ti][i];
                ss += __shfl_xor(ss, 16); ss += __shfl_xor(ss, 32);
                const float rinv = rsqrtf(ss * (1.0f / 64.0f) + EPS);
                const int t = (tok < NPROMPT) ? (tok & 2047) : (tok & 4095);
                const int rowi = t >> 6, coli = t & 63;
                const f32x4* rt = (const f32x4*)(e.rope + (rowi * 16 + 4 * q4) * 2);
                const f32x4* ct = (const f32x4*)(e.rope + (coli * 16 + 4 * q4) * 2);
                const f32x4 r01 = rt[0], r23 = rt[1], c01 = ct[0], c23 = ct[1];
                const float rc[4] = {r01[0], r01[2], r23[0], r23[2]}, rs[4] = {r01[1], r01[3], r23[1], r23[3]};
                const float cc[4] = {c01[0], c01[2], c23[0], c23[2]}, cs[4] = {c01[1], c01[3], c23[1], c23[3]};
                float o[4][4];
#pragma unroll
                for (int i = 0; i < 4; ++i) {
                    const float a0 = acc[0][ti][i] * rinv * g[0][i], b0 = acc[1][ti][i] * rinv * g[1][i];
                    const float a1 = acc[2][ti][i] * rinv * g[2][i], b1 = acc[3][ti][i] * rinv * g[3][i];
                    o[0][i] = (a0 * rc[i] - b0 * rs[i]) * osc; o[1][i] = (b0 * rc[i] + a0 * rs[i]) * osc;
                    o[2][i] = (a1 * cc[i] - b1 * cs[i]) * osc; o[3][i] = (b1 * cc[i] + a1 * cs[i]) * osc;
                }
                bf16_t* rowp = e.C + (size_t)tok * INW + cb + 4 * q4;
#pragma unroll
                for (int fi = 0; fi < 4; ++fi) {
                    u32x2 w; w.x = pk_bf16(o[fi][0], o[fi][1]); w.y = pk_bf16(o[fi][2], o[fi][3]);
                    *(u32x2*)(rowp + fi * 16) = w;
                }
            }
        } else if (cb >= 1152 && cb < 1280) {
            const int kvh = (cb - 1152) >> 6;
#pragma unroll
            for (int ti = 0; ti < TI; ++ti) {
                const int tok = tokb + ti * 16;
                bf16_t* bp; size_t T;
                if (tok < NPROMPT) { const int b = tok >> 11, t = tok & 2047; T = 2048; bp = e.VT + ((size_t)(b * 2 + kvh) * 64) * 2048 + t; }
                else { const int b = (tok - NPROMPT) >> 12, t = tok & 4095; T = 4096; bp = e.VT + (size_t)NPROMPT * 128 + ((size_t)(b * 2 + kvh) * 64) * 4096 + t; }
#pragma unroll
                for (int fi = 0; fi < 4; ++fi)
#pragma unroll
                    for (int i = 0; i < 4; ++i) bp[(size_t)(fi * 16 + 4 * q4 + i) * T] = (bf16_t)(pk_bf16(acc[fi][ti][i], 0.f) & 0xffffu);
            }
        } else {
            const int kind = (cb < 256) ? 0 : ((cb >= 1792 && cb < 2048) ? 2 : 1);
#pragma unroll
            for (int ti = 0; ti < TI; ++ti) {
                bf16_t* rowp = e.C + (size_t)(tokb + ti * 16) * INW + cb + 4 * q4;
#pragma unroll
                for (int fi = 0; fi < 4; ++fi) {
                    float v[4];
#pragma unroll
                    for (int i = 0; i < 4; ++i) { const float x = acc[fi][ti][i]; v[i] = (kind == 0) ? x : ((kind == 2) ? x * 0.125f : silu_f(x)); }
                    u32x2 o; o.x = pk_bf16(v[0], v[1]); o.y = pk_bf16(v[2], v[3]);
                    *(u32x2*)(rowp + fi * 16) = o;
                }
            }
        }
    }
}

DI void attn_item(const bf16_t* __restrict__ Q, int ldq, const bf16_t* __restrict__ K, int ldk, const bf16_t* __restrict__ VT, int ldv,
                  int nkeys, bf16_t* __restrict__ O, const bf16_t* __restrict__ G, unsigned char* smem) {
    const int tid = opaque_tid(), lane = tid & 63, wave = tid >> 6;
    const int r = lane & 31, h = lane >> 5;
    bf16x8 qf[4];
    {
        const bf16_t* qp = Q + (size_t)(wave * 32 + r) * ldq + h * 8;
#pragma unroll
        for (int ks = 0; ks < 4; ++ks) qf[ks] = *(const bf16x8*)(qp + ks * 16);
    }
    const int lrow = tid >> 3, lc = tid & 7;
    const bf16_t* Kg = K + (size_t)lrow * ldk + lc * 8;
    const bf16_t* Vg = VT + (size_t)lrow * ldv + lc * 8;
    const int st_off = lrow * 128 + ((lc ^ ((lrow >> 1) & 7)) << 4);
    const int pr = (r & ~12) | ((r & 4) << 1) | ((r & 8) >> 1);
    const int kswz = (pr >> 1) & 7, vswz = (r >> 1) & 7;
    const int k_off = pr * 128, v_off = r * 128;

    f32x16 o0, o1;
#pragma unroll
    for (int i = 0; i < 16; ++i) { o0[i] = 0.f; o1[i] = 0.f; }
    float m = -1e30f, lsum = 0.f;

    u32x4 rk, rv;
#define A_LOAD(KT) { rk = *(const u32x4*)(Kg + (size_t)((KT) * 64) * ldk); rv = *(const u32x4*)(Vg + (KT) * 64); }
#define A_STORE(OFF) { *(u32x4*)(smem + (OFF) + st_off) = rk; *(u32x4*)(smem + (OFF) + 8192 + st_off) = rv; }
    auto compute = [&](const int cur) __attribute__((always_inline)) {
        f32x16 s0, s1;
#pragma unroll
        for (int i = 0; i < 16; ++i) { s0[i] = 0.f; s1[i] = 0.f; }
#pragma unroll
        for (int ks = 0; ks < 4; ++ks) {
            const int co = ((ks * 2 + h) ^ kswz) << 4;
            const bf16x8 k0 = *(const bf16x8*)(smem + cur + k_off + co);
            const bf16x8 k1 = *(const bf16x8*)(smem + cur + 4096 + k_off + co);
            s0 = mfma32(k0, qf[ks], s0);
            s1 = mfma32(k1, qf[ks], s1);
        }
        float mx = s0[0];
#pragma unroll
        for (int i = 1; i < 16; ++i) mx = fmaxf(mx, s0[i]);
#pragma unroll
        for (int i = 0; i < 16; ++i) mx = fmaxf(mx, s1[i]);
        mx = fmaxf(mx, __shfl_xor(mx, 32));
        const float mnew = fmaxf(m, mx);
        const float alpha = __builtin_amdgcn_exp2f((m - mnew) * L2E);
        m = mnew;
        const float mb = mnew * L2E;
        float rs = 0.f;
#pragma unroll
        for (int i = 0; i < 16; ++i) { s0[i] = __builtin_amdgcn_exp2f(s0[i] * L2E - mb); rs += s0[i]; }
#pragma unroll
        for (int i = 0; i < 16; ++i) { s1[i] = __builtin_amdgcn_exp2f(s1[i] * L2E - mb); rs += s1[i]; }
        lsum = lsum * alpha + rs;
#pragma unroll
        for (int i = 0; i < 16; ++i) { o0[i] *= alpha; o1[i] *= alpha; }
        bf16x8 pf[4];
        {
            u32x4 t;
            t.x = pk_bf16(s0[0], s0[1]); t.y = pk_bf16(s0[2], s0[3]); t.z = pk_bf16(s0[4], s0[5]); t.w = pk_bf16(s0[6], s0[7]);
            pf[0] = __builtin_bit_cast(bf16x8, t);
            t.x = pk_bf16(s0[8], s0[9]); t.y = pk_bf16(s0[10], s0[11]); t.z = pk_bf16(s0[12], s0[13]); t.w = pk_bf16(s0[14], s0[15]);
            pf[1] = __builtin_bit_cast(bf16x8, t);
            t.x = pk_bf16(s1[0], s1[1]); t.y = pk_bf16(s1[2], s1[3]); t.z = pk_bf16(s1[4], s1[5]); t.w = pk_bf16(s1[6], s1[7]);
            pf[2] = __builtin_bit_cast(bf16x8, t);
            t.x = pk_bf16(s1[8], s1[9]); t.y = pk_bf16(s1[10], s1[11]); t.z = pk_bf16(s1[12], s1[13]); t.w = pk_bf16(s1[14], s1[15]);
            pf[3] = __builtin_bit_cast(bf16x8, t);
        }
#pragma unroll
        for (int kk = 0; kk < 4; ++kk) {
            const int co = ((kk * 2 + h) ^ vswz) << 4;
            const bf16x8 v0 = *(const bf16x8*)(smem + cur + 8192 + v_off + co);
            const bf16x8 v1 = *(const bf16x8*)(smem + cur + 8192 + 4096 + v_off + co);
            o0 = mfma32(v0, pf[kk], o0);
            o1 = mfma32(v1, pf[kk], o1);
        }
    };
    const int nt = nkeys >> 6;
    A_LOAD(0);
    __syncthreads();
    A_STORE(0);
    A_LOAD(1);
    lds_barrier();
    for (int kt = 0; kt < nt - 2; kt += 2) {
        A_STORE(16384);
        A_LOAD(kt + 2);
        __builtin_amdgcn_sched_barrier(0);
        compute(0);
        lds_barrier();
        A_STORE(0);
        A_LOAD(kt + 3);
        __builtin_amdgcn_sched_barrier(0);
        compute(16384);
        lds_barrier();
    }
    A_STORE(16384);
    __builtin_amdgcn_sched_barrier(0);
    compute(0);
    lds_barrier();
    compute(16384);
    lds_barrier();
#undef A_LOAD
#undef A_STORE
    const float lt = lsum + __shfl_xor(lsum, 32);
    const float inv = 1.0f / lt;
    const bf16_t* gp = G + (size_t)(wave * 32 + r) * INW + 4 * h;
    bf16_t* op = O + (size_t)(wave * 32 + r) * 1024 + 4 * h;
#pragma unroll
    for (int gq = 0; gq < 4; ++gq) {
        {
            const u32x2 gg = *(const u32x2*)(gp + 8 * gq);
            u32x2 w;
            w.x = pk_bf16(o0[4 * gq] * inv * bflo(gg.x), o0[4 * gq + 1] * inv * bfhi(gg.x));
            w.y = pk_bf16(o0[4 * gq + 2] * inv * bflo(gg.y), o0[4 * gq + 3] * inv * bfhi(gg.y));
            *(u32x2*)(op + 8 * gq) = w;
        }
        {
            const u32x2 gg = *(const u32x2*)(gp + 32 + 8 * gq);
            u32x2 w;
            w.x = pk_bf16(o1[4 * gq] * inv * bflo(gg.x), o1[4 * gq + 1] * inv * bfhi(gg.x));
            w.y = pk_bf16(o1[4 * gq + 2] * inv * bflo(gg.y), o1[4 * gq + 3] * inv * bfhi(gg.y));
            *(u32x2*)(op + 32 + 8 * gq) = w;
        }
    }
}

DI void pool_item(const bf16_t* __restrict__ Z, const bf16_t* __restrict__ PWT, const float* __restrict__ pscale, bf16_t* __restrict__ MIX,
                  int tokg0, unsigned char* smem) {
    const int tid = opaque_tid(), lane = tid & 63, wave = tid >> 6;
    const int T = (tokg0 < NPROMPT) ? 2048 : 4096;
    const int t0 = tokg0 & (T - 1);
    constexpr int RS = 528;
    __syncthreads();
    for (int id = tid; id < 80 * 32; id += 512) {
        const int rr = id >> 5, c = id & 31;
        const int t = t0 - 8 + rr;
        u32x4 v = (u32x4){0u, 0u, 0u, 0u};
        if (t >= 0 && t < T) v = *(const u32x4*)(Z + (size_t)(tokg0 - 8 + rr) * INW + c * 8);
        *(u32x4*)(smem + rr * RS + c * 16) = v;
    }
    __syncthreads();
    const int g = wave & 3, half = 1 << g;
    const int r16 = lane & 15, q4 = lane >> 4;
    const bf16_t* pw = PWT + (size_t)g * 4096 + r16 * 64 + q4 * 8;
    {
        const int th = wave >> 2;
        bf16x8 df[2][2];
#pragma unroll
        for (int t2 = 0; t2 < 2; ++t2)
#pragma unroll
            for (int ks = 0; ks < 2; ++ks) {
                const int tl = (th * 2 + t2) * 16 + r16, t = t0 + tl;
                const int lo = max(t - half, 0), hi = min(t + half, T);
                const float icnt = 1.0f / (float)(hi - lo);
                float s[8];
#pragma unroll
                for (int j = 0; j < 8; ++j) s[j] = 0.f;
                const unsigned char* bp = smem + (tl + 8 - half) * RS + (g * 64 + ks * 32 + q4 * 8) * 2;
                for (int j = 0; j < 2 * half; ++j) {
                    const u32x4 v = *(const u32x4*)(bp + j * RS);
                    s[0] += bflo(v.x); s[1] += bfhi(v.x); s[2] += bflo(v.y); s[3] += bfhi(v.y);
                    s[4] += bflo(v.z); s[5] += bfhi(v.z); s[6] += bflo(v.w); s[7] += bfhi(v.w);
                }
                const u32x4 c = *(const u32x4*)(bp + half * RS);
                u32x4 o;
                o.x = pk_bf16(s[0] * icnt - bflo(c.x), s[1] * icnt - bfhi(c.x));
                o.y = pk_bf16(s[2] * icnt - bflo(c.y), s[3] * icnt - bfhi(c.y));
                o.z = pk_bf16(s[4] * icnt - bflo(c.z), s[5] * icnt - bfhi(c.z));
                o.w = pk_bf16(s[6] * icnt - bflo(c.w), s[7] * icnt - bfhi(c.w));
                df[t2][ks] = __builtin_bit_cast(bf16x8, o);
            }
        f32x4 acc[4][2];
#pragma unroll
        for (int i = 0; i < 4; ++i)
#pragma unroll
            for (int j = 0; j < 2; ++j) acc[i][j] = (f32x4){0.f, 0.f, 0.f, 0.f};
#pragma unroll
        for (int fi = 0; fi < 4; ++fi)
#pragma unroll
            for (int ks = 0; ks < 2; ++ks) {
                const bf16x8 wf = *(const bf16x8*)(pw + fi * 16 * 64 + ks * 32);
#pragma unroll
                for (int t2 = 0; t2 < 2; ++t2) acc[fi][t2] = mfma16(wf, df[t2][ks], acc[fi][t2]);
            }
#pragma unroll
        for (int t2 = 0; t2 < 2; ++t2) {
            const size_t tok = (size_t)tokg0 + (th * 2 + t2) * 16 + r16;
#pragma unroll
            for (int fi = 0; fi < 4; ++fi) {
                const int n = g * 64 + fi * 16 + 4 * q4;
                const f32x4 ps = *(const f32x4*)(pscale + n);
                const u32x2 gg = *(const u32x2*)(Z + tok * INW + 256 + n);
                u32x2 w;
                w.x = pk_bf16(acc[fi][t2][0] * ps[0] * bflo(gg.x), acc[fi][t2][1] * ps[1] * bfhi(gg.x));
                w.y = pk_bf16(acc[fi][t2][2] * ps[2] * bflo(gg.y), acc[fi][t2][3] * ps[3] * bfhi(gg.y));
                *(u32x2*)(MIX + tok * 1024 + n) = w;
            }
        }
    }
}

DI void post_row(const float* __restrict__ xsrc, bf16_t* __restrict__ yh, const float* __restrict__ gpost, const float* __restrict__ gpre_next,
                 float* __restrict__ xdst, bool last, int lane) {
    u32x4 yv[2]; f32x4 xv[4];
#pragma unroll
    for (int j = 0; j < 2; ++j) yv[j] = *(const u32x4*)(yh + j * 512 + lane * 8);
#pragma unroll
    for (int j = 0; j < 2; ++j) { xv[2 * j] = *(const f32x4*)(xsrc + j * 512 + lane * 8); xv[2 * j + 1] = *(const f32x4*)(xsrc + j * 512 + lane * 8 + 4); }
    float y[16];
#pragma unroll
    for (int j = 0; j < 2; ++j) {
        y[8 * j + 0] = bflo(yv[j].x); y[8 * j + 1] = bfhi(yv[j].x); y[8 * j + 2] = bflo(yv[j].y); y[8 * j + 3] = bfhi(yv[j].y);
        y[8 * j + 4] = bflo(yv[j].z); y[8 * j + 5] = bfhi(yv[j].z); y[8 * j + 6] = bflo(yv[j].w); y[8 * j + 7] = bfhi(yv[j].w);
    }
    float ss = 0.f;
#pragma unroll
    for (int i = 0; i < 16; ++i) ss += y[i] * y[i];
    ss = wave_sum(ss);
    const float r = rsqrtf(ss * (1.0f / 1024.0f) + EPS);
    float xn[16]; float ss2 = 0.f;
#pragma unroll
    for (int j = 0; j < 2; ++j) {
        const f32x4 g0 = *(const f32x4*)(gpost + j * 512 + lane * 8), g1 = *(const f32x4*)(gpost + j * 512 + lane * 8 + 4);
#pragma unroll
        for (int i = 0; i < 4; ++i) {
            xn[8 * j + i] = xv[2 * j][i] + y[8 * j + i] * r * g0[i];
            xn[8 * j + 4 + i] = xv[2 * j + 1][i] + y[8 * j + 4 + i] * r * g1[i];
        }
    }
#pragma unroll
    for (int i = 0; i < 16; ++i) ss2 += xn[i] * xn[i];
#pragma unroll
    for (int j = 0; j < 2; ++j) {
        *(f32x4*)(xdst + j * 512 + lane * 8) = (f32x4){xn[8 * j], xn[8 * j + 1], xn[8 * j + 2], xn[8 * j + 3]};
        *(f32x4*)(xdst + j * 512 + lane * 8 + 4) = (f32x4){xn[8 * j + 4], xn[8 * j + 5], xn[8 * j + 6], xn[8 * j + 7]};
    }
    if (!last) {
        ss2 = wave_sum(ss2);
        const float r2 = rsqrtf(ss2 * (1.0f / 1024.0f) + EPS);
#pragma unroll
        for (int j = 0; j < 2; ++j) {
            const f32x4 g0 = *(const f32x4*)(gpre_next + j * 512 + lane * 8), g1 = *(const f32x4*)(gpre_next + j * 512 + lane * 8 + 4);
            u32x4 o;
            o.x = pk_bf16(xn[8 * j] * r2 * g0[0], xn[8 * j + 1] * r2 * g0[1]);
            o.y = pk_bf16(xn[8 * j + 2] * r2 * g0[2], xn[8 * j + 3] * r2 * g0[3]);
            o.z = pk_bf16(xn[8 * j + 4] * r2 * g1[0], xn[8 * j + 5] * r2 * g1[1]);
            o.w = pk_bf16(xn[8 * j + 6] * r2 * g1[2], xn[8 * j + 7] * r2 * g1[3]);
            *(u32x4*)(yh + j * 512 + lane * 8) = o;
        }
    }
}

#define XB_TMO      128
#define XB_XCNT(j)  (256  + 64 * (j))
#define XB_XSUB(j)  (1280 + 64 * (j))
#define XB_XGEN(j)  (2304 + 64 * (j))
#define XB_TOP      3328
#define XB_TOPGEN   3392
#define XCD_BAR_WORDS 3456
#define XB_SPIN_CAP (1u << 18)
#define LAS __attribute__((address_space(3)))
DI unsigned xb_ld(unsigned* p)              { return __hip_atomic_load(p, __ATOMIC_RELAXED, __HIP_MEMORY_SCOPE_AGENT); }
DI unsigned xb_add(unsigned* p, unsigned v) { return __hip_atomic_fetch_add(p, v, __ATOMIC_RELAXED, __HIP_MEMORY_SCOPE_AGENT); }
DI unsigned xb_xcc_id() { return (unsigned)__builtin_amdgcn_s_getreg((3 << 11) | 20) & 0xFu; }
#define XB_SPIN(cond, bar) do { unsigned _sp = 0; while (cond) { __builtin_amdgcn_s_sleep(1); \
    if ((++_sp & 255u) == 0u) { if (xb_ld(&(bar)[XB_TMO])) break; if (_sp > XB_SPIN_CAP) { atomicAdd(&(bar)[XB_TMO], 1u); break; } } } } while (0)
struct XcdBarrier { unsigned* bar; unsigned x; volatile LAS unsigned* st; };
DI XcdBarrier xcd_barrier_post(unsigned* bar, volatile LAS unsigned* st) {
    XcdBarrier b; b.bar = bar; b.x = xb_xcc_id(); b.st = st;
    if (threadIdx.x == 0) (void)xb_add(&bar[XB_XCNT(b.x)], 1u);
    return b;
}
DI void xcd_barrier_complete(unsigned* bar, unsigned x, unsigned& nloc, unsigned& nx) {
    const unsigned G = gridDim.x * gridDim.y * gridDim.z;
    unsigned sum, cnt, mine, sp = 0u;
    for (;;) {
        sum = 0u; cnt = 0u; mine = 0u;
#pragma unroll
        for (unsigned j = 0; j < 16; ++j) { const unsigned c = xb_ld(&bar[XB_XCNT(j)]); sum += c; cnt += (c > 0u) ? 1u : 0u; mine = (j == x) ? c : mine; }
        if (sum == G) break;
        __builtin_amdgcn_s_sleep(1);
        if ((++sp & 255u) == 0u) { if (xb_ld(&bar[XB_TMO])) break; if (sp > XB_SPIN_CAP) { atomicAdd(&bar[XB_TMO], 1u); break; } }
    }
    nloc = mine > 0u ? mine : 1u; nx = cnt > 0u ? cnt : 1u;
}
DI void xcd_barrier(const XcdBarrier& b) {
    asm volatile("s_waitcnt vmcnt(0)" ::: "memory");
    __syncthreads();
    if (threadIdx.x == 0) {
        unsigned* bar = b.bar;
        __builtin_amdgcn_s_waitcnt(0);
        unsigned nloc = b.st[0], nx = b.st[1];
        if (nloc == 0u) { xcd_barrier_complete(bar, b.x, nloc, nx); b.st[0] = nloc; b.st[1] = nx; }
        const unsigned old = xb_add(&bar[XB_XSUB(b.x)], 1u);
        const unsigned gen = old / nloc;
        if (old + 1u == (gen + 1u) * nloc) {
            __builtin_amdgcn_fence(__ATOMIC_RELEASE, "agent");
            asm volatile("s_waitcnt vmcnt(0)" ::: "memory");
            const unsigned og = xb_add(&bar[XB_TOP], 1u);
            const unsigned tg = og / nx;
            if (og + 1u == (tg + 1u) * nx) xb_add(&bar[XB_TOPGEN], 1u);
            else XB_SPIN(xb_ld(&bar[XB_TOPGEN]) == tg, bar);
            __builtin_amdgcn_fence(__ATOMIC_ACQUIRE, "agent");
            xb_add(&bar[XB_XGEN(b.x)], 1u);
            asm volatile("s_waitcnt vmcnt(0)" ::: "memory");
        } else {
            XB_SPIN(xb_ld(&bar[XB_XGEN(b.x)]) == gen, bar);
            __builtin_amdgcn_fence(__ATOMIC_ACQUIRE, "agent");
            asm volatile("s_waitcnt vmcnt(0)" ::: "memory");
        }
    }
    __syncthreads();
}

__global__ void __launch_bounds__(512, 2) fwd_megakernel(Params p) {
    __shared__ __attribute__((aligned(16))) unsigned char smem[131072];
    __shared__ uint4 xb_words;
    cg::grid_group grid = cg::this_grid();
    const int nb = gridDim.x, bid = blockIdx.x;
    if (threadIdx.x == 0) xb_words = make_uint4(0u, 0u, 0u, 0u);
    __syncthreads();
    XcdBarrier xb = xcd_barrier_post((unsigned*)(p.ws + OFF_BAR), (volatile LAS unsigned*)&xb_words);
    if (p.phase_end > 1000) grid.sync();
    for (int ph = p.phase_begin; ph < p.phase_end; ++ph) {
        const int tid = opaque_tid(), lane = tid & 63, wave = tid >> 6;
        unsigned char* ws = p.ws;
        bf16_t* H = (bf16_t*)(ws + OFF_H);
        bf16_t* Z = (bf16_t*)(ws + OFF_Z);
        bf16_t* VT = (bf16_t*)(ws + OFF_VT);
        bf16_t* MIX = (bf16_t*)(ws + OFF_MIX);
        bf16_t* WIN = (bf16_t*)(ws + OFF_WIN);
        bf16_t* WOUT = (bf16_t*)(ws + OFF_WOUT);
        bf16_t* WMEM = (bf16_t*)(ws + OFF_WMEM);
        bf16_t* PW = (bf16_t*)(ws + OFF_PW);
        bf16_t* MH = (bf16_t*)(ws + OFF_MH);
        bf16_t* KM = (bf16_t*)(ws + OFF_KM);
        bf16_t* VMT = (bf16_t*)(ws + OFF_VMT);
        float* ROPE = (float*)(ws + OFF_ROPE);
        if (ph == 0) {
            for (int i = bid; i < 1928; i += nb) {
                if (i < 1152) { const int l = i / 576, j = i % 576, kt = j / 36, ntile = j % 36;
                    transpose_tile(p.w_in + (size_t)l * DM * INW, INW, WIN + (size_t)l * INW * DM, DM, kt * 64, ntile * 64, smem);
                } else if (i < 1664) { const int ii = i - 1152, l = ii / 256, j = ii % 256, kt = j / 16, ntile = j % 16;
                    transpose_tile(p.w_out + (size_t)l * DM * DM, DM, WOUT + (size_t)l * DM * DM, DM, kt * 64, ntile * 64, smem);
                } else if (i < 1920) { const int ii = i - 1664, l = ii / 128, j = ii % 128, kt = j / 8, ntile = j % 8;
                    transpose_tile(p.w_mem_kv + (size_t)l * DM * 512, 512, WMEM + (size_t)l * 512 * DM, DM, kt * 64, ntile * 64, smem);
                } else { const int ii = i - 1920;
                    transpose_tile(p.pool_w + (size_t)ii * 4096, 64, PW + (size_t)ii * 4096, 64, 0, 0, smem);
                }
            }
            for (int i = bid * 8 + wave; i < NTOK + 2 * NMEMTOK; i += nb * 8) {
                if (i < NTOK) {
                    const float* src = (i < NPROMPT) ? p.x_prompt + (size_t)i * DM : p.x_sample + (size_t)(i - NPROMPT) * DM;
                    rms_row_f32(src, p.norm_pre, H + (size_t)i * DM, lane);
                } else {
                    const int ii = i - NTOK, l = ii / NMEMTOK, mt = ii % NMEMTOK;
                    const float* src = (mt < 4096) ? p.mem_prompt + (size_t)mt * DM : p.mem_sample + (size_t)(mt - 4096) * DM;
                    rms_row_f32(src, p.mem_norm + l * DM, MH + ((size_t)l * NMEMTOK + mt) * DM, lane);
                }
            }
            for (int i = bid * 512 + tid; i < 1024; i += nb * 512) rope_entry(i, ROPE);
        } else {
            const int l = (ph - 1) >> 2, sub = (ph - 1) & 3;
            if (sub == 0) {
                EpiArgs e; e.C = Z; e.VT = VT; e.qn = p.q_norm + l * 64; e.kn = p.k_norm + l * 64; e.rope = ROPE;
                const bf16_t* Wl = WIN + (size_t)l * INW * DM;
                EpiArgs e2; e2.C = KM + (size_t)l * NMEMTOK * 256; e2.VT = VMT + (size_t)l * NMEMTOK * 256; e2.qn = nullptr; e2.kn = nullptr; e2.rope = nullptr;
                const bf16_t* Wm = WMEM + (size_t)l * 512 * DM;
                const bf16_t* Am = MH + (size_t)l * NMEMTOK * DM;
                for (int i = bid; i < 1728 + 40; i += nb) {
                    if (i < 1728) {
                        const int j = i >> 3, mg = j / 72, rem = j % 72;
                        const int mt = (i & 7) * 24 + mg * 8 + (rem & 7), ntile = rem >> 3;
                        gemm_tile<0>(H, Wl, mt * 256, ntile * 256, e, smem);
                    } else {
                        const int j = i - 1728;
                        gemm_tile<2>(Am, Wm, (j >> 1) * 256, (j & 1) * 256, e2, smem);
                    }
                }
            } else if (sub == 1) {
                for (int i = bid; i < 3072; i += nb) {
                    if (i < 1536) {
                        int b, kvh, j, T; size_t tok0, vtb;
                        if (i < 512) { const int R = i >> 8, ip = i & 255, grp = ip & 7; j = R * 32 + (ip >> 3); b = grp >> 1; kvh = grp & 1; T = 4096;
                            tok0 = (size_t)NPROMPT + (size_t)b * 4096; vtb = (size_t)NPROMPT * 128 + ((size_t)(b * 2 + kvh) * 64) * 4096; }
                        else { const int ii = i - 512, R = ii >> 8, ip = ii & 255, grp = R * 8 + (ip & 7); j = ip >> 3; b = grp >> 1; kvh = grp & 1; T = 2048;
                            tok0 = (size_t)b * 2048; vtb = ((size_t)(b * 2 + kvh) * 64) * 2048; }
                        const int qblk = j >> 2, head = kvh * 4 + (j & 3);
                        const size_t q0 = tok0 + (size_t)qblk * 256;
                        attn_item(Z + q0 * INW + 512 + head * 64, INW, Z + tok0 * INW + 1024 + kvh * 64, INW, VT + vtb, T, T,
                                  MIX + q0 * 1024 + 256 + head * 64, Z + q0 * INW + 1280 + head * 64, smem);
                    } else if (i < 2304) {
                        const int ii = i - 1536, qb = ii >> 2, hx = ii & 3;
                        const size_t q0 = (size_t)qb * 256;
                        const int b = (q0 < NPROMPT) ? (int)(q0 >> 11) : 16 + (int)((q0 - NPROMPT) >> 12);
                        attn_item(Z + q0 * INW + 1792 + hx * 64, INW, KM + ((size_t)l * NMEMTOK + (size_t)b * 256) * 256 + hx * 64, 256,
                                  VMT + (size_t)l * NMEMTOK * 256 + ((size_t)(b * 4 + hx) * 64) * 256, 256, 256,
                                  MIX + q0 * 1024 + 768 + hx * 64, Z + q0 * INW + 2048 + hx * 64, smem);
                    } else {
                        pool_item(Z, PW + (size_t)l * 4 * 4096, p.pool_scale + l * 256, MIX, (i - 2304) * 64, smem);
                    }
                }
            } else if (sub == 2) {
                EpiArgs e; e.C = H; e.VT = nullptr; e.qn = nullptr; e.kn = nullptr; e.rope = nullptr;
                const bf16_t* Wl = WOUT + (size_t)l * DM * DM;
                for (int i = bid; i < 768; i += nb) {
                    const int j = i >> 3, mg = j >> 5, rem = j & 31;
                    const int mt = (i & 7) * 24 + mg * 8 + (rem & 7), ntile = rem >> 3;
                    gemm_tile<1>(MIX, Wl, mt * 256, ntile * 256, e, smem);
                }
            } else {
                const bool last = (l == DEPTH - 1);
                for (int i = bid * 8 + wave; i < NTOK; i += nb * 8) {
                    const float* xs = (l == 0) ? ((i < NPROMPT) ? p.x_prompt + (size_t)i * DM : p.x_sample + (size_t)(i - NPROMPT) * DM) : p.out + (size_t)i * DM;
                    post_row(xs, H + (size_t)i * DM, p.norm_post + l * DM, p.norm_pre + (last ? l : l + 1) * DM, p.out + (size_t)i * DM, last, lane);
                }
            }
        }
        if (ph + 1 < p.phase_end) xcd_barrier(xb);
    }
}

extern "C" void kernel_launch(void* const* d_in, const int* in_sizes, int n_in, void* d_out, int out_size, void* d_ws, size_t ws_size,
                              hipStream_t stream) {
    static int grid_blocks = 0;
    if (!grid_blocks) {
        int dev = 0, cus = 0, per_cu = 0;
        hipGetDevice(&dev);
        hipDeviceGetAttribute(&cus, hipDeviceAttributeMultiprocessorCount, dev);
        hipOccupancyMaxActiveBlocksPerMultiprocessor(&per_cu, fwd_megakernel, 512, 0);
        if (per_cu > 1) per_cu = 1;
        if (per_cu < 1) per_cu = 1;
        grid_blocks = cus * per_cu;
    }
    Params p{};
    p.x_prompt = (const float*)d_in[0]; p.x_sample = (const float*)d_in[1]; p.mem_prompt = (const float*)d_in[2]; p.mem_sample = (const float*)d_in[3];
    p.norm_pre = (const float*)d_in[4]; p.norm_post = (const float*)d_in[5]; p.w_in = (const float*)d_in[6]; p.pool_w = (const float*)d_in[7];
    p.pool_scale = (const float*)d_in[8]; p.q_norm = (const float*)d_in[9]; p.k_norm = (const float*)d_in[10]; p.mem_norm = (const float*)d_in[11];
    p.w_mem_kv = (const float*)d_in[12]; p.w_out = (const float*)d_in[13];
    p.out = (float*)d_out; p.ws = (unsigned char*)d_ws;
    p.phase_begin = 0; p.phase_end = 1 + 4 * DEPTH;
    if (ws_size < WS_TOTAL) { fprintf(stderr, "workspace too small: %zu < %zu\n", ws_size, (size_t)WS_TOTAL); return; }
    hipMemsetAsync((unsigned char*)d_ws + OFF_BAR, 0, BAR_BYTES, stream);
    void* args[] = {&p};
    hipError_t e = hipLaunchCooperativeKernel((void*)fwd_megakernel, dim3(grid_blocks), dim3(512), args, 0, stream);
    if (e != hipSuccess) fprintf(stderr, "cooperative launch failed: %s (grid %d)\n", hipGetErrorString(e), grid_blocks);
}
```

```cpp
#include <hip/hip_runtime.h>
#include <hip/hip_cooperative_groups.h>
#include <stdint.h>
#include <cstdio>
namespace cg = cooperative_groups;

typedef unsigned short bf16_t;
typedef short bf16x8 __attribute__((ext_vector_type(8)));
typedef float f32x4 __attribute__((ext_vector_type(4)));
typedef float f32x16 __attribute__((ext_vector_type(16)));
typedef unsigned u32x4 __attribute__((ext_vector_type(4)));
typedef unsigned u32x2 __attribute__((ext_vector_type(2)));
typedef __bf16 bf16x2_t __attribute__((ext_vector_type(2)));
typedef float f32x2_t __attribute__((ext_vector_type(2)));
#define DI __device__ __forceinline__

constexpr int NTOK = 49152;
constexpr int NPROMPT = 32768;
constexpr int DM = 1024;
constexpr int INW = 2304;
constexpr int NMEMTOK = 5120;
constexpr int DEPTH = 2;
constexpr float EPS = 1e-6f;
constexpr float L2E = 1.4426950408889634f;

constexpr size_t OFF_H    = 0;
constexpr size_t OFF_Z    = OFF_H + (size_t)NTOK * DM * 2;
constexpr size_t OFF_VT   = OFF_Z + (size_t)NTOK * INW * 2;
constexpr size_t OFF_MIX  = OFF_VT + (size_t)NTOK * 128 * 2;
constexpr size_t OFF_WIN  = OFF_MIX + (size_t)NTOK * DM * 2;
constexpr size_t OFF_WOUT = OFF_WIN + (size_t)DEPTH * INW * DM * 2;
constexpr size_t OFF_WMEM = OFF_WOUT + (size_t)DEPTH * DM * DM * 2;
constexpr size_t OFF_PW   = OFF_WMEM + (size_t)DEPTH * 512 * DM * 2;
constexpr size_t OFF_MH   = OFF_PW + (size_t)DEPTH * 4 * 64 * 64 * 2;
constexpr size_t OFF_KM   = OFF_MH + (size_t)DEPTH * NMEMTOK * DM * 2;
constexpr size_t OFF_VMT  = OFF_KM + (size_t)DEPTH * NMEMTOK * 256 * 2;
constexpr size_t OFF_ROPE = OFF_VMT + (size_t)DEPTH * NMEMTOK * 256 * 2;
constexpr size_t OFF_BAR  = OFF_ROPE + 64 * 16 * 2 * 4;
constexpr size_t BAR_BYTES = 3456 * 4;
constexpr size_t WS_TOTAL = OFF_BAR + BAR_BYTES;

struct Params {
    const float* x_prompt; const float* x_sample; const float* mem_prompt; const float* mem_sample;
    const float* norm_pre; const float* norm_post; const float* w_in; const float* pool_w; const float* pool_scale;
    const float* q_norm; const float* k_norm; const float* mem_norm; const float* w_mem_kv; const float* w_out;
    float* out; unsigned char* ws;
    int phase_begin; int phase_end;
};

DI unsigned pk_bf16(float a, float b) {
    f32x2_t v = {a, b};
    bf16x2_t r = __builtin_convertvector(v, bf16x2_t);
    return __builtin_bit_cast(unsigned, r);
}
DI int opaque_tid() { int t = threadIdx.x; asm volatile("" : "+v"(t)); return t; }
DI void lds_barrier() { asm volatile("s_waitcnt lgkmcnt(0)\n\ts_barrier" ::: "memory"); }
DI float bflo(unsigned u) { return __uint_as_float(u << 16); }
DI float bfhi(unsigned u) { return __uint_as_float(u & 0xffff0000u); }
DI float wave_sum(float v) {
    v += __shfl_xor(v, 1); v += __shfl_xor(v, 2); v += __shfl_xor(v, 4);
    v += __shfl_xor(v, 8); v += __shfl_xor(v, 16); v += __shfl_xor(v, 32);
    return v;
}
DI float xhalf_max(float v) {
    auto r = __builtin_amdgcn_permlane32_swap(__float_as_uint(v), __float_as_uint(v), false, false);
    return fmaxf(__uint_as_float(r[0]), __uint_as_float(r[1]));
}
DI float silu_f(float x) { return x * __builtin_amdgcn_rcpf(1.0f + __builtin_amdgcn_exp2f(-x * L2E)); }
DI f32x4 mfma16(bf16x8 a, bf16x8 b, f32x4 c) { return __builtin_amdgcn_mfma_f32_16x16x32_bf16(a, b, c, 0, 0, 0); }
DI f32x16 mfma32(bf16x8 a, bf16x8 b, f32x16 c) { return __builtin_amdgcn_mfma_f32_32x32x16_bf16(a, b, c, 0, 0, 0); }

DI void transpose_tile(const float* __restrict__ src, int ldn, bf16_t* __restrict__ dst, int ldk, int k0, int n0, unsigned char* smem) {
    float* tile = (float*)smem;
    const int tid = opaque_tid();
    __syncthreads();
#pragma unroll
    for (int i = 0; i < 8; ++i) {
        const int r = i * 8 + (tid >> 6), c = tid & 63;
        tile[r * 65 + c] = src[(size_t)(k0 + r) * ldn + n0 + c];
    }
    __syncthreads();
#pragma unroll
    for (int i = 0; i < 4; ++i) {
        const int n = i * 16 + (tid >> 5), kp = tid & 31;
        const float v0 = tile[(2 * kp) * 65 + n], v1 = tile[(2 * kp + 1) * 65 + n];
        *(unsigned*)(dst + (size_t)(n0 + n) * ldk + k0 + 2 * kp) = pk_bf16(v0, v1);
    }
}

DI void rms_row_f32(const float* __restrict__ src, const float* __restrict__ g, bf16_t* __restrict__ dst, int lane) {
    f32x4 v[4]; float ss = 0.f;
#pragma unroll
    for (int j = 0; j < 4; ++j) { v[j] = *(const f32x4*)(src + j * 256 + lane * 4); ss += v[j][0] * v[j][0] + v[j][1] * v[j][1] + v[j][2] * v[j][2] + v[j][3] * v[j][3]; }
    ss = wave_sum(ss);
    const float r = rsqrtf(ss * (1.0f / 1024.0f) + EPS);
#pragma unroll
    for (int j = 0; j < 4; ++j) {
        const f32x4 gg = *(const f32x4*)(g + j * 256 + lane * 4);
        u32x2 o; o.x = pk_bf16(v[j][0] * r * gg[0], v[j][1] * r * gg[1]); o.y = pk_bf16(v[j][2] * r * gg[2], v[j][3] * r * gg[3]);
        *(u32x2*)(dst + j * 256 + lane * 4) = o;
    }
}

DI void rope_entry(int idx, float* table) {
    const int n = idx >> 4, pp = idx & 15;
    double fd = 1.0;
    for (int i = 0; i < pp; ++i) fd *= 0.5623413251903491;
    const float f = (float)fd;
    const float a = (float)n * f;
    double r = (double)a;
    const double k = rint(r * 0.15915494309189535);
    r -= k * 6.283185307179586;
    const double r2 = r * r;
    double sn = r, cs = 1.0, ts = r, tc = 1.0;
    for (int i = 1; i <= 16; ++i) {
        tc = -tc * r2 / (double)((2 * i - 1) * (2 * i));
        ts = -ts * r2 / (double)((2 * i) * (2 * i + 1));
        cs += tc; sn += ts;
    }
    table[idx * 2] = (float)cs; table[idx * 2 + 1] = (float)sn;
}

struct EpiArgs {
    bf16_t* C;
    bf16_t* VT;
    const float* qn; const float* kn; const float* rope;
};

template <int MODE>
DI void gemm_tile(const bf16_t* __restrict__ A, const bf16_t* __restrict__ Bt, int m0, int n0, const EpiArgs& e, unsigned char* smem) {
    const int tid = opaque_tid(), lane = tid & 63, wave = tid >> 6;
    const int wm = wave >> 2, wn = wave & 3;
    const int lrow = tid >> 3, lc = tid & 7;
    const bf16_t* Ag = A + (size_t)(m0 + lrow) * 1024 + lc * 8;
    const bf16_t* Bg = Bt + (size_t)(n0 + lrow) * 1024 + lc * 8;
    const int st_off = lrow * 128 + ((lc ^ ((lrow >> 1) & 7)) << 4);
    const int r16 = lane & 15, q4 = lane >> 4;
    const int fr_off = r16 * 128 + ((q4 ^ (r16 >> 1)) << 4);
    const int a_base = 32768 + (wn * 64) * 128;
    const int b_base = (wm * 128) * 128;
    constexpr int TI = 8;

    f32x4 acc[4][TI];
#pragma unroll
    for (int i = 0; i < 4; ++i)
#pragma unroll
        for (int j = 0; j < TI; ++j) acc[i][j] = (f32x4){0.f, 0.f, 0.f, 0.f};

    u32x4 ra[4], rb[4];
#define G_LOAD(KT) { _Pragma("unroll") for (int i = 0; i < 4; ++i) { ra[i] = *(const u32x4*)(Ag + (size_t)i * 64 * 1024 + (KT) * 64); rb[i] = *(const u32x4*)(Bg + (size_t)i * 64 * 1024 + (KT) * 64); } }
#define G_STORE(OFF) { _Pragma("unroll") for (int i = 0; i < 4; ++i) { *(u32x4*)(smem + (OFF) + st_off + i * 8192) = ra[i]; *(u32x4*)(smem + (OFF) + 32768 + st_off + i * 8192) = rb[i]; } }
#define G_COMPUTE(CUR) { _Pragma("unroll") for (int ks = 0; ks < 2; ++ks) { bf16x8 wf[4], tf[TI]; \
        _Pragma("unroll") for (int i = 0; i < 4; ++i) wf[i] = *(const bf16x8*)(smem + (CUR) + a_base + i * 2048 + (fr_off ^ (ks * 64))); \
        _Pragma("unroll") for (int i = 0; i < TI; ++i) tf[i] = *(const bf16x8*)(smem + (CUR) + b_base + i * 2048 + (fr_off ^ (ks * 64))); \
        _Pragma("unroll") for (int ti = 0; ti < TI; ++ti) _Pragma("unroll") for (int fi = 0; fi < 4; ++fi) acc[fi][ti] = mfma16(wf[fi], tf[ti], acc[fi][ti]); \
        __builtin_amdgcn_sched_barrier(0); } }
    G_LOAD(0);
    G_STORE(0);
    G_LOAD(1);
    lds_barrier();
    for (int kt = 0; kt < 14; kt += 2) {
        G_STORE(65536);
        G_LOAD(kt + 2);
        __builtin_amdgcn_sched_barrier(0);
        G_COMPUTE(0);
        lds_barrier();
        G_STORE(0);
        G_LOAD(kt + 3);
        __builtin_amdgcn_sched_barrier(0);
        G_COMPUTE(65536);
        lds_barrier();
    }
    G_STORE(65536);
    __builtin_amdgcn_sched_barrier(0);
    G_COMPUTE(0);
    lds_barrier();
    G_COMPUTE(65536);
    lds_barrier();
#undef G_LOAD
#undef G_STORE
#undef G_COMPUTE

    const int cb = n0 + wn * 64;
    const int tokb = m0 + wm * 128 + r16;
    if (MODE == 1) {
#pragma unroll
        for (int ti = 0; ti < TI; ++ti) {
            bf16_t* rowp = e.C + (size_t)(tokb + ti * 16) * 1024 + cb + 4 * q4;
#pragma unroll
            for (int fi = 0; fi < 4; ++fi) {
                u32x2 o; o.x = pk_bf16(acc[fi][ti][0], acc[fi][ti][1]); o.y = pk_bf16(acc[fi][ti][2], acc[fi][ti][3]);
                *(u32x2*)(rowp + fi * 16) = o;
            }
        }
    } else if (MODE == 2) {
        if (cb < 256) {
#pragma unroll
            for (int ti = 0; ti < TI; ++ti) {
                bf16_t* rowp = e.C + (size_t)(tokb + ti * 16) * 256 + cb + 4 * q4;
#pragma unroll
                for (int fi = 0; fi < 4; ++fi) {
                    u32x2 o; o.x = pk_bf16(acc[fi][ti][0], acc[fi][ti][1]); o.y = pk_bf16(acc[fi][ti][2], acc[fi][ti][3]);
                    *(u32x2*)(rowp + fi * 16) = o;
                }
            }
        } else {
            const int hx = (cb - 256) >> 6;
#pragma unroll
            for (int ti = 0; ti < TI; ++ti) {
                const int mt = tokb + ti * 16, b = mt >> 8, m = mt & 255;
                bf16_t* bp = e.VT + ((size_t)(b * 4 + hx) * 64) * 256 + m;
#pragma unroll
                for (int fi = 0; fi < 4; ++fi)
#pragma unroll
                    for (int i = 0; i < 4; ++i) bp[(size_t)(fi * 16 + 4 * q4 + i) * 256] = (bf16_t)(pk_bf16(acc[fi][ti][i], 0.f) & 0xffffu);
            }
        }
    } else {
        if (cb >= 512 && cb < 1152) {
            const bool isq = cb < 1024;
            const float* gn = isq ? e.qn : e.kn;
            const float osc = isq ? 0.125f : 1.0f;
            f32x4 g[4];
#pragma unroll
            for (int fi = 0; fi < 4; ++fi) g[fi] = *(const f32x4*)(gn + fi * 16 + 4 * q4);
#pragma unroll
            for (int ti = 0; ti < TI; ++ti) {
                const int tok = tokb + ti * 16;
                float ss = 0.f;
#pragma unroll
                for (int fi = 0; fi < 4; ++fi)
#pragma unroll
                    for (int i = 0; i < 4; ++i) ss += acc[fi][ti][i] * acc[fi][ti][i];
                ss += __shfl_xor(ss, 16); ss += __shfl_xor(ss, 32);
                const float rinv = rsqrtf(ss * (1.0f / 64.0f) + EPS);
                const int t = (tok < NPROMPT) ? (tok & 2047) : (tok & 4095);
                const int rowi = t >> 6, coli = t & 63;
                const f32x4* rt = (const f32x4*)(e.rope + (rowi * 16 + 4 * q4) * 2);
                const f32x4* ct = (const f32x4*)(e.rope + (coli * 16 + 4 * q4) * 2);
                const f32x4 r01 = rt[0], r23 = rt[1], c01 = ct[0], c23 = ct[1];
                const float rc[4] = {r01[0], r01[2], r23[0], r23[2]}, rs[4] = {r01[1], r01[3], r23[1], r23[3]};
                const float cc[4] = {c01[0], c01[2], c23[0], c23[2]}, cs[4] = {c01[1], c01[3], c23[1], c23[3]};
                float o[4][4];
#pragma unroll
                for (int i = 0; i < 4; ++i) {
                    const float a0 = acc[0][ti][i] * rinv * g[0][i], b0 = acc[1][ti][i] * rinv * g[1][i];
                    const float a1 = acc[2][ti][i] * rinv * g[2][i], b1 = acc[3][ti][i] * rinv * g[3][i];
                    o[0][i] = (a0 * rc[i] - b0 * rs[i]) * osc; o[1][i] = (b0 * rc[i] + a0 * rs[i]) * osc;
                    o[2][i] = (a1 * cc[i] - b1 * cs[i]) * osc; o[3][i] = (b1 * cc[i] + a1 * cs[i]) * osc;
                }
                bf16_t* rowp = e.C + (size_t)tok * INW + cb + 4 * q4;
#pragma unroll
                for (int fi = 0; fi < 4; ++fi) {
                    u32x2 w; w.x = pk_bf16(o[fi][0], o[fi][1]); w.y = pk_bf16(o[fi][2], o[fi][3]);
                    *(u32x2*)(rowp + fi * 16) = w;
                }
            }
        } else if (cb >= 1152 && cb < 1280) {
            const int kvh = (cb - 1152) >> 6;
#pragma unroll
            for (int ti = 0; ti < TI; ++ti) {
                const int tok = tokb + ti * 16;
                bf16_t* bp; size_t T;
                if (tok < NPROMPT) { const int b = tok >> 11, t = tok & 2047; T = 2048; bp = e.VT + ((size_t)(b * 2 + kvh) * 64) * 2048 + t; }
                else { const int b = (tok - NPROMPT) >> 12, t = tok & 4095; T = 4096; bp = e.VT + (size_t)NPROMPT * 128 + ((size_t)(b * 2 + kvh) * 64) * 4096 + t; }
#pragma unroll
                for (int fi = 0; fi < 4; ++fi)
#pragma unroll
                    for (int i = 0; i < 4; ++i) bp[(size_t)(fi * 16 + 4 * q4 + i) * T] = (bf16_t)(pk_bf16(acc[fi][ti][i], 0.f) & 0xffffu);
            }
        } else {
            const int kind = (cb < 256) ? 0 : ((cb >= 1792 && cb < 2048) ? 2 : 1);
#pragma unroll
            for (int ti = 0; ti < TI; ++ti) {
                bf16_t* rowp = e.C + (size_t)(tokb + ti * 16) * INW + cb + 4 * q4;
#pragma unroll
                for (int fi = 0; fi < 4; ++fi) {
                    float v[4];
#pragma unroll
                    for (int i = 0; i < 4; ++i) { const float x = acc[fi][ti][i]; v[i] = (kind == 0) ? x : ((kind == 2) ? x * 0.125f : silu_f(x)); }
                    u32x2 o; o.x = pk_bf16(v[0], v[1]); o.y = pk_bf16(v[2], v[3]);
                    *(u32x2*)(rowp + fi * 16) = o;
                }
            }
        }
    }
}

#define SB_() __builtin_amdgcn_sched_barrier(0)
#define KFRAG(KS, KB) (*(const bf16x8*)(kp + (KB) * 4096 + k_off + ((((KS) * 2 + h) ^ kswz) << 4)))
#define VFRAG(KK, DB) (*(const bf16x8*)(vp + (DB) * 4096 + v_off + ((((KK) * 2 + h) ^ vswz) << 4)))
#define EXP4(S, I0) { _Pragma("unroll") for (int i_ = (I0); i_ < (I0) + 4; ++i_) { S[i_] = __builtin_amdgcn_exp2f(S[i_] * L2E - mb); rs += S[i_]; } }
#define EXP4F(S, I0) { f32x2_t a_ = {S[(I0)], S[(I0) + 1]}, b_ = {S[(I0) + 2], S[(I0) + 3]}; \
        a_ = a_ * (f32x2_t){L2E, L2E} - (f32x2_t){mb, mb}; b_ = b_ * (f32x2_t){L2E, L2E} - (f32x2_t){mb, mb}; \
        S[(I0)] = __builtin_amdgcn_exp2f(a_.x); S[(I0) + 1] = __builtin_amdgcn_exp2f(a_.y); S[(I0) + 2] = __builtin_amdgcn_exp2f(b_.x); S[(I0) + 3] = __builtin_amdgcn_exp2f(b_.y); \
        rs2 += (f32x2_t){S[(I0)], S[(I0) + 1]} + (f32x2_t){S[(I0) + 2], S[(I0) + 3]}; }
#define EXPQ(S, I0) { if (FIXM) EXP4F(S, I0) else EXP4(S, I0) }
#define PACK8(S, I0) ({ u32x4 t_; t_.x = pk_bf16(S[(I0)], S[(I0) + 1]); t_.y = pk_bf16(S[(I0) + 2], S[(I0) + 3]); t_.z = pk_bf16(S[(I0) + 4], S[(I0) + 5]); t_.w = pk_bf16(S[(I0) + 6], S[(I0) + 7]); __builtin_bit_cast(bf16x8, t_); })
DI float max8(const f32x16& s, int i0, float mx) {
    mx = fmaxf(fmaxf(mx, s[i0]), s[i0 + 1]); mx = fmaxf(fmaxf(mx, s[i0 + 2]), s[i0 + 3]);
    mx = fmaxf(fmaxf(mx, s[i0 + 4]), s[i0 + 5]); mx = fmaxf(fmaxf(mx, s[i0 + 6]), s[i0 + 7]);
    return mx;
}
template <bool DO_PV, bool DO_QK, bool FIXM>
DI void attn_step(f32x16& s0, f32x16& s1, f32x16& n0, f32x16& n1, const bf16x8 (&pp)[4], bf16x8 (&pc)[4],
                  f32x16& o0, f32x16& o1, float& m, float& lsum, const bf16x8 (&qf)[4],
                  const unsigned char* kp, const unsigned char* vp, int k_off, int kswz, int v_off, int vswz, int h) {
    bf16x8 va0, vb0, va1, vb1, va2, vb2, va3, vb3, ka0, kb0, ka1, kb1, ka2, kb2, ka3, kb3;
    if (DO_PV) { va0 = VFRAG(0, 0); vb0 = VFRAG(0, 1); va1 = VFRAG(1, 0); vb1 = VFRAG(1, 1); }
    float mx = s0[0];
    if (DO_PV) o0 = mfma32(va0, pp[0], o0);
    if (!FIXM) mx = max8(s0, 0, mx);
    SB_();
    if (DO_PV) { o1 = mfma32(vb0, pp[0], o1); va2 = VFRAG(2, 0); vb2 = VFRAG(2, 1); }
    if (!FIXM) mx = max8(s0, 8, mx);
    SB_();
    if (DO_PV) { o0 = mfma32(va1, pp[1], o0); va3 = VFRAG(3, 0); vb3 = VFRAG(3, 1); }
    if (!FIXM) mx = max8(s1, 0, mx);
    SB_();
    if (DO_PV) o1 = mfma32(vb1, pp[1], o1);
    bool need = false; float alpha = 1.0f;
    if (!FIXM) {
        mx = max8(s1, 8, mx);
        mx = xhalf_max(mx);
        need = mx > m + 5.5f;
        const float mnew = need ? mx : m;
        alpha = __builtin_amdgcn_exp2f((m - mnew) * L2E);
        m = mnew;
    }
    const float mb = m * L2E;
    float rs = 0.f; f32x2_t rs2 = {0.f, 0.f};
    SB_();
    if (DO_PV) o0 = mfma32(va2, pp[2], o0);
    if (DO_QK) { ka0 = KFRAG(0, 0); kb0 = KFRAG(0, 1); }
    EXPQ(s0, 0);
    SB_();
    if (DO_PV) o1 = mfma32(vb2, pp[2], o1);
    if (DO_QK) { ka1 = KFRAG(1, 0); kb1 = KFRAG(1, 1); }
    EXPQ(s0, 4);
    SB_();
    if (DO_PV) o0 = mfma32(va3, pp[3], o0);
    EXPQ(s0, 8);
    SB_();
    if (DO_PV) o1 = mfma32(vb3, pp[3], o1);
    EXPQ(s0, 12);
    SB_();
    if (DO_QK) { n0 = mfma32(ka0, qf[0], (f32x16){0.f, 0.f, 0.f, 0.f, 0.f, 0.f, 0.f, 0.f, 0.f, 0.f, 0.f, 0.f, 0.f, 0.f, 0.f, 0.f}); ka2 = KFRAG(2, 0); kb2 = KFRAG(2, 1); }
    EXPQ(s1, 0);
    SB_();
    if (DO_QK) { n1 = mfma32(kb0, qf[0], (f32x16){0.f, 0.f, 0.f, 0.f, 0.f, 0.f, 0.f, 0.f, 0.f, 0.f, 0.f, 0.f, 0.f, 0.f, 0.f, 0.f}); ka3 = KFRAG(3, 0); kb3 = KFRAG(3, 1); }
    EXPQ(s1, 4);
    SB_();
    if (DO_QK) n0 = mfma32(ka1, qf[1], n0);
    EXPQ(s1, 8);
    SB_();
    if (DO_QK) n1 = mfma32(kb1, qf[1], n1);
    EXPQ(s1, 12);
    SB_();
    if (DO_QK) n0 = mfma32(ka2, qf[2], n0);
    pc[0] = PACK8(s0, 0);
    SB_();
    if (DO_QK) n1 = mfma32(kb2, qf[2], n1);
    pc[1] = PACK8(s0, 8);
    SB_();
    if (DO_QK) n0 = mfma32(ka3, qf[3], n0);
    pc[2] = PACK8(s1, 0);
    SB_();
    if (DO_QK) n1 = mfma32(kb3, qf[3], n1);
    pc[3] = PACK8(s1, 8);
    if (FIXM) lsum += rs2.x + rs2.y; else lsum = lsum * alpha + rs;
    SB_();
    if (!FIXM) {
        if (__builtin_amdgcn_ballot_w64(need)) {
#pragma unroll
            for (int i = 0; i < 16; ++i) { o0[i] *= alpha; o1[i] *= alpha; }
        }
    }
}

template <bool FIXM>
DI void attn_item(const bf16_t* __restrict__ Q, int ldq, const bf16_t* __restrict__ K, int ldk, const bf16_t* __restrict__ VT, int ldv,
                  int nkeys, bf16_t* __restrict__ O, const bf16_t* __restrict__ G, unsigned char* smem, float mfix) {
    const int tid = opaque_tid(), lane = tid & 63, wave = tid >> 6;
    const int r = lane & 31, h = lane >> 5;
    bf16x8 qf[4];
    {
        const bf16_t* qp = Q + (size_t)(wave * 32 + r) * ldq + h * 8;
#pragma unroll
        for (int ks = 0; ks < 4; ++ks) qf[ks] = *(const bf16x8*)(qp + ks * 16);
    }
    const int lrow = tid >> 3, lc = tid & 7;
    const bf16_t* Kg = K + (size_t)lrow * ldk + lc * 8;
    const bf16_t* Vg = VT + (size_t)lrow * ldv + lc * 8;
    const int st_off = lrow * 128 + ((lc ^ ((lrow >> 1) & 7)) << 4);
    const int pr = (r & ~12) | ((r & 4) << 1) | ((r & 8) >> 1);
    const int kswz = (pr >> 1) & 7, vswz = (r >> 1) & 7;
    const int k_off = pr * 128, v_off = r * 128;
    const int nt = nkeys >> 6;

    f32x16 o0, o1, sa0, sa1, sb0, sb1;
#pragma unroll
    for (int i = 0; i < 16; ++i) { o0[i] = 0.f; o1[i] = 0.f; }
    float m = FIXM ? mfix : -1e30f, lsum = 0.f;
    bf16x8 pa[4], pb[4];

    u32x4 rk, rv;
#define A_LOAD(U) { const int kt_ = ((U) + 2 < nt) ? (U) + 2 : nt - 1; rk = *(const u32x4*)(Kg + (size_t)(kt_ * 64) * ldk); rv = *(const u32x4*)(Vg + (U) * 64); }
#define A_STORE(OFF) { *(u32x4*)(smem + (OFF) + st_off) = rk; *(u32x4*)(smem + (OFF) + 8192 + st_off) = rv; }
    rk = *(const u32x4*)(Kg); rv = *(const u32x4*)(Kg + (size_t)64 * ldk);
    __syncthreads();
    A_STORE(16384);
    A_LOAD(0);
    A_STORE(0);
    A_LOAD(1);
    lds_barrier();
    {
        const unsigned char* kp = smem + 16384;
        sa0 = mfma32(KFRAG(0, 0), qf[0], (f32x16){0.f, 0.f, 0.f, 0.f, 0.f, 0.f, 0.f, 0.f, 0.f, 0.f, 0.f, 0.f, 0.f, 0.f, 0.f, 0.f});
        sa1 = mfma32(KFRAG(0, 1), qf[0], (f32x16){0.f, 0.f, 0.f, 0.f, 0.f, 0.f, 0.f, 0.f, 0.f, 0.f, 0.f, 0.f, 0.f, 0.f, 0.f, 0.f});
#pragma unroll
        for (int ks = 1; ks < 4; ++ks) { sa0 = mfma32(KFRAG(ks, 0), qf[ks], sa0); sa1 = mfma32(KFRAG(ks, 1), qf[ks], sa1); }
    }
    attn_step<false, true, FIXM>(sa0, sa1, sb0, sb1, pb, pa, o0, o1, m, lsum, qf, smem + 16384 + 8192, smem, k_off, kswz, v_off, vswz, h);
    lds_barrier();
    for (int t = 1; t < nt - 1; t += 2) {
        A_STORE(16384);
        A_LOAD(t + 1);
        SB_();
        attn_step<true, true, FIXM>(sb0, sb1, sa0, sa1, pa, pb, o0, o1, m, lsum, qf, smem, smem + 8192, k_off, kswz, v_off, vswz, h);
        lds_barrier();
        A_STORE(0);
        A_LOAD(t + 2);
        SB_();
        attn_step<true, true, FIXM>(sa0, sa1, sb0, sb1, pb, pa, o0, o1, m, lsum, qf, smem + 16384, smem + 16384 + 8192, k_off, kswz, v_off, vswz, h);
        lds_barrier();
    }
    A_STORE(16384);
    SB_();
    attn_step<true, false, FIXM>(sb0, sb1, sa0, sa1, pa, pb, o0, o1, m, lsum, qf, smem, smem + 8192, k_off, kswz, v_off, vswz, h);
    lds_barrier();
    {
        const unsigned char* vp = smem + 16384 + 8192;
#pragma unroll
        for (int kk = 0; kk < 4; ++kk) { o0 = mfma32(VFRAG(kk, 0), pb[kk], o0); o1 = mfma32(VFRAG(kk, 1), pb[kk], o1); }
    }
#undef A_LOAD
#undef A_STORE
    const float lt = lsum + __shfl_xor(lsum, 32);
    const float inv = 1.0f / lt;
    const bf16_t* gp = G + (size_t)(wave * 32 + r) * INW + 4 * h;
    bf16_t* op = O + (size_t)(wave * 32 + r) * 1024 + 4 * h;
#pragma unroll
    for (int gq = 0; gq < 4; ++gq) {
        {
            const u32x2 gg = *(const u32x2*)(gp + 8 * gq);
            u32x2 w;
            w.x = pk_bf16(o0[4 * gq] * inv * bflo(gg.x), o0[4 * gq + 1] * inv * bfhi(gg.x));
            w.y = pk_bf16(o0[4 * gq + 2] * inv * bflo(gg.y), o0[4 * gq + 3] * inv * bfhi(gg.y));
            *(u32x2*)(op + 8 * gq) = w;
        }
        {
            const u32x2 gg = *(const u32x2*)(gp + 32 + 8 * gq);
            u32x2 w;
            w.x = pk_bf16(o1[4 * gq] * inv * bflo(gg.x), o1[4 * gq + 1] * inv * bfhi(gg.x));
            w.y = pk_bf16(o1[4 * gq + 2] * inv * bflo(gg.y), o1[4 * gq + 3] * inv * bfhi(gg.y));
            *(u32x2*)(op + 32 + 8 * gq) = w;
        }
    }
}

DI void pool_item(const bf16_t* __restrict__ Z, const bf16_t* __restrict__ PWT, const float* __restrict__ pscale, bf16_t* __restrict__ MIX,
                  int tokg0, unsigned char* smem) {
    const int tid = opaque_tid(), lane = tid & 63, wave = tid >> 6;
    const int T = (tokg0 < NPROMPT) ? 2048 : 4096;
    const int t0 = tokg0 & (T - 1);
    constexpr int RS = 528;
    __syncthreads();
    for (int id = tid; id < 80 * 32; id += 512) {
        const int rr = id >> 5, c = id & 31;
        const int t = t0 - 8 + rr;
        u32x4 v = (u32x4){0u, 0u, 0u, 0u};
        if (t >= 0 && t < T) v = *(const u32x4*)(Z + (size_t)(tokg0 - 8 + rr) * INW + c * 8);
        *(u32x4*)(smem + rr * RS + c * 16) = v;
    }
    __syncthreads();
    const int g = wave & 3, half = 1 << g;
    const int r16 = lane & 15, q4 = lane >> 4;
    const bf16_t* pw = PWT + (size_t)g * 4096 + r16 * 64 + q4 * 8;
    {
        const int th = wave >> 2;
        bf16x8 df[2][2];
#pragma unroll
        for (int t2 = 0; t2 < 2; ++t2)
#pragma unroll
            for (int ks = 0; ks < 2; ++ks) {
                const int tl = (th * 2 + t2) * 16 + r16, t = t0 + tl;
                const int lo = max(t - half, 0), hi = min(t + half, T);
                const float icnt = 1.0f / (float)(hi - lo);
                float s[8];
#pragma unroll
                for (int j = 0; j < 8; ++j) s[j] = 0.f;
                const unsigned char* bp = smem + (tl + 8 - half) * RS + (g * 64 + ks * 32 + q4 * 8) * 2;
                for (int j = 0; j < 2 * half; ++j) {
                    const u32x4 v = *(const u32x4*)(bp + j * RS);
                    s[0] += bflo(v.x); s[1] += bfhi(v.x); s[2] += bflo(v.y); s[3] += bfhi(v.y);
                    s[4] += bflo(v.z); s[5] += bfhi(v.z); s[6] += bflo(v.w); s[7] += bfhi(v.w);
                }
                const u32x4 c = *(const u32x4*)(bp + half * RS);
                u32x4 o;
                o.x = pk_bf16(s[0] * icnt - bflo(c.x), s[1] * icnt - bfhi(c.x));
                o.y = pk_bf16(s[2] * icnt - bflo(c.y), s[3] * icnt - bfhi(c.y));
                o.z = pk_bf16(s[4] * icnt - bflo(c.z), s[5] * icnt - bfhi(c.z));
                o.w = pk_bf16(s[6] * icnt - bflo(c.w), s[7] * icnt - bfhi(c.w));
                df[t2][ks] = __builtin_bit_cast(bf16x8, o);
            }
        f32x4 acc[4][2];
#pragma unroll
        for (int i = 0; i < 4; ++i)
#pragma unroll
            for (int j = 0; j < 2; ++j) acc[i][j] = (f32x4){0.f, 0.f, 0.f, 0.f};
#pragma unroll
        for (int fi = 0; fi < 4; ++fi)
#pragma unroll
            for (int ks = 0; ks < 2; ++ks) {
                const bf16x8 wf = *(const bf16x8*)(pw + fi * 16 * 64 + ks * 32);
#pragma unroll
                for (int t2 = 0; t2 < 2; ++t2) acc[fi][t2] = mfma16(wf, df[t2][ks], acc[fi][t2]);
            }
#pragma unroll
        for (int t2 = 0; t2 < 2; ++t2) {
            const size_t tok = (size_t)tokg0 + (th * 2 + t2) * 16 + r16;
#pragma unroll
            for (int fi = 0; fi < 4; ++fi) {
                const int n = g * 64 + fi * 16 + 4 * q4;
                const f32x4 ps = *(const f32x4*)(pscale + n);
                const u32x2 gg = *(const u32x2*)(Z + tok * INW + 256 + n);
                u32x2 w;
                w.x = pk_bf16(acc[fi][t2][0] * ps[0] * bflo(gg.x), acc[fi][t2][1] * ps[1] * bfhi(gg.x));
                w.y = pk_bf16(acc[fi][t2][2] * ps[2] * bflo(gg.y), acc[fi][t2][3] * ps[3] * bfhi(gg.y));
                *(u32x2*)(MIX + tok * 1024 + n) = w;
            }
        }
    }
}

DI void post_row(const float* __restrict__ xsrc, bf16_t* __restrict__ yh, const float* __restrict__ gpost, const float* __restrict__ gpre_next,
                 float* __restrict__ xdst, bool last, int lane) {
    u32x4 yv[2]; f32x4 xv[4];
#pragma unroll
    for (int j = 0; j < 2; ++j) yv[j] = *(const u32x4*)(yh + j * 512 + lane * 8);
#pragma unroll
    for (int j = 0; j < 2; ++j) { xv[2 * j] = *(const f32x4*)(xsrc + j * 512 + lane * 8); xv[2 * j + 1] = *(const f32x4*)(xsrc + j * 512 + lane * 8 + 4); }
    float y[16];
#pragma unroll
    for (int j = 0; j < 2; ++j) {
        y[8 * j + 0] = bflo(yv[j].x); y[8 * j + 1] = bfhi(yv[j].x); y[8 * j + 2] = bflo(yv[j].y); y[8 * j + 3] = bfhi(yv[j].y);
        y[8 * j + 4] = bflo(yv[j].z); y[8 * j + 5] = bfhi(yv[j].z); y[8 * j + 6] = bflo(yv[j].w); y[8 * j + 7] = bfhi(yv[j].w);
    }
    float ss = 0.f;
#pragma unroll
    for (int i = 0; i < 16; ++i) ss += y[i] * y[i];
    ss = wave_sum(ss);
    const float r = rsqrtf(ss * (1.0f / 1024.0f) + EPS);
    float xn[16]; float ss2 = 0.f;
#pragma unroll
    for (int j = 0; j < 2; ++j) {
        const f32x4 g0 = *(const f32x4*)(gpost + j * 512 + lane * 8), g1 = *(const f32x4*)(gpost + j * 512 + lane * 8 + 4);
#pragma unroll
        for (int i = 0; i < 4; ++i) {
            xn[8 * j + i] = xv[2 * j][i] + y[8 * j + i] * r * g0[i];
            xn[8 * j + 4 + i] = xv[2 * j + 1][i] + y[8 * j + 4 + i] * r * g1[i];
        }
    }
#pragma unroll
    for (int i = 0; i < 16; ++i) ss2 += xn[i] * xn[i];
#pragma unroll
    for (int j = 0; j < 2; ++j) {
        *(f32x4*)(xdst + j * 512 + lane * 8) = (f32x4){xn[8 * j], xn[8 * j + 1], xn[8 * j + 2], xn[8 * j + 3]};
        *(f32x4*)(xdst + j * 512 + lane * 8 + 4) = (f32x4){xn[8 * j + 4], xn[8 * j + 5], xn[8 * j + 6], xn[8 * j + 7]};
    }
    if (!last) {
        ss2 = wave_sum(ss2);
        const float r2 = rsqrtf(ss2 * (1.0f / 1024.0f) + EPS);
#pragma unroll
        for (int j = 0; j < 2; ++j) {
            const f32x4 g0 = *(const f32x4*)(gpre_next + j * 512 + lane * 8), g1 = *(const f32x4*)(gpre_next + j * 512 + lane * 8 + 4);
            u32x4 o;
            o.x = pk_bf16(xn[8 * j] * r2 * g0[0], xn[8 * j + 1] * r2 * g0[1]);
            o.y = pk_bf16(xn[8 * j + 2] * r2 * g0[2], xn[8 * j + 3] * r2 * g0[3]);
            o.z = pk_bf16(xn[8 * j + 4] * r2 * g1[0], xn[8 * j + 5] * r2 * g1[1]);
            o.w = pk_bf16(xn[8 * j + 6] * r2 * g1[2], xn[8 * j + 7] * r2 * g1[3]);
            *(u32x4*)(yh + j * 512 + lane * 8) = o;
        }
    }
}

#define XB_TMO      128
#define XB_XCNT(j)  (256  + 64 * (j))
#define XB_XSUB(j)  (1280 + 64 * (j))
#define XB_XGEN(j)  (2304 + 64 * (j))
#define XB_TOP      3328
#define XB_TOPGEN   3392
#define XCD_BAR_WORDS 3456
#define XB_SPIN_CAP (1u << 18)
#define LAS __attribute__((address_space(3)))
DI unsigned xb_ld(unsigned* p)              { return __hip_atomic_load(p, __ATOMIC_RELAXED, __HIP_MEMORY_SCOPE_AGENT); }
DI unsigned xb_add(unsigned* p, unsigned v) { return __hip_atomic_fetch_add(p, v, __ATOMIC_RELAXED, __HIP_MEMORY_SCOPE_AGENT); }
DI unsigned xb_xcc_id() { return (unsigned)__builtin_amdgcn_s_getreg((3 << 11) | 20) & 0xFu; }
#define XB_SPIN(cond, bar) do { unsigned _sp = 0; while (cond) { __builtin_amdgcn_s_sleep(1); \
    if ((++_sp & 255u) == 0u) { if (xb_ld(&(bar)[XB_TMO])) break; if (_sp > XB_SPIN_CAP) { atomicAdd(&(bar)[XB_TMO], 1u); break; } } } } while (0)
struct XcdBarrier { unsigned* bar; unsigned x; volatile LAS unsigned* st; };
DI XcdBarrier xcd_barrier_post(unsigned* bar, volatile LAS unsigned* st) {
    XcdBarrier b; b.bar = bar; b.x = xb_xcc_id(); b.st = st;
    if (threadIdx.x == 0) (void)xb_add(&bar[XB_XCNT(b.x)], 1u);
    return b;
}
DI void xcd_barrier_complete(unsigned* bar, unsigned x, unsigned& nloc, unsigned& nx) {
    const unsigned G = gridDim.x * gridDim.y * gridDim.z;
    unsigned sum, cnt, mine, sp = 0u;
    for (;;) {
        sum = 0u; cnt = 0u; mine = 0u;
#pragma unroll
        for (unsigned j = 0; j < 16; ++j) { const unsigned c = xb_ld(&bar[XB_XCNT(j)]); sum += c; cnt += (c > 0u) ? 1u : 0u; mine = (j == x) ? c : mine; }
        if (sum == G) break;
        __builtin_amdgcn_s_sleep(1);
        if ((++sp & 255u) == 0u) { if (xb_ld(&bar[XB_TMO])) break; if (sp > XB_SPIN_CAP) { atomicAdd(&bar[XB_TMO], 1u); break; } }
    }
    nloc = mine > 0u ? mine : 1u; nx = cnt > 0u ? cnt : 1u;
}
DI void xcd_barrier(const XcdBarrier& b) {
    asm volatile("s_waitcnt vmcnt(0)" ::: "memory");
    __syncthreads();
    if (threadIdx.x == 0) {
        unsigned* bar = b.bar;
        __builtin_amdgcn_s_waitcnt(0);
        unsigned nloc = b.st[0], nx = b.st[1];
        if (nloc == 0u) { xcd_barrier_complete(bar, b.x, nloc, nx); b.st[0] = nloc; b.st[1] = nx; }
        const unsigned old = xb_add(&bar[XB_XSUB(b.x)], 1u);
        const unsigned gen = old / nloc;
        if (old + 1u == (gen + 1u) * nloc) {
            __builtin_amdgcn_fence(__ATOMIC_RELEASE, "agent");
            asm volatile("s_waitcnt vmcnt(0)" ::: "memory");
            const unsigned og = xb_add(&bar[XB_TOP], 1u);
            const unsigned tg = og / nx;
            if (og + 1u == (tg + 1u) * nx) xb_add(&bar[XB_TOPGEN], 1u);
            else XB_SPIN(xb_ld(&bar[XB_TOPGEN]) == tg, bar);
            __builtin_amdgcn_fence(__ATOMIC_ACQUIRE, "agent");
            xb_add(&bar[XB_XGEN(b.x)], 1u);
            asm volatile("s_waitcnt vmcnt(0)" ::: "memory");
        } else {
            XB_SPIN(xb_ld(&bar[XB_XGEN(b.x)]) == gen, bar);
            __builtin_amdgcn_fence(__ATOMIC_ACQUIRE, "agent");
            asm volatile("s_waitcnt vmcnt(0)" ::: "memory");
        }
    }
    __syncthreads();
}

__global__ void __launch_bounds__(512, 2) fwd_megakernel(Params p) {
    __shared__ __attribute__((aligned(16))) unsigned char smem[131072];
    __shared__ uint4 xb_words;
    cg::grid_group grid = cg::this_grid();
    const int nb = gridDim.x, bid = blockIdx.x;
    if (threadIdx.x == 0) xb_words = make_uint4(0u, 0u, 0u, 0u);
    __syncthreads();
    XcdBarrier xb = xcd_barrier_post((unsigned*)(p.ws + OFF_BAR), (volatile LAS unsigned*)&xb_words);
    if (p.phase_end > 1000) grid.sync();
    for (int ph = p.phase_begin; ph < p.phase_end; ++ph) {
        const int tid = opaque_tid(), lane = tid & 63, wave = tid >> 6;
        unsigned char* ws = p.ws;
        bf16_t* H = (bf16_t*)(ws + OFF_H);
        bf16_t* Z = (bf16_t*)(ws + OFF_Z);
        bf16_t* VT = (bf16_t*)(ws + OFF_VT);
        bf16_t* MIX = (bf16_t*)(ws + OFF_MIX);
        bf16_t* WIN = (bf16_t*)(ws + OFF_WIN);
        bf16_t* WOUT = (bf16_t*)(ws + OFF_WOUT);
        bf16_t* WMEM = (bf16_t*)(ws + OFF_WMEM);
        bf16_t* PW = (bf16_t*)(ws + OFF_PW);
        bf16_t* MH = (bf16_t*)(ws + OFF_MH);
        bf16_t* KM = (bf16_t*)(ws + OFF_KM);
        bf16_t* VMT = (bf16_t*)(ws + OFF_VMT);
        float* ROPE = (float*)(ws + OFF_ROPE);
        if (ph == 0) {
            for (int i = bid; i < 1928; i += nb) {
                if (i < 1152) { const int l = i / 576, j = i % 576, kt = j / 36, ntile = j % 36;
                    transpose_tile(p.w_in + (size_t)l * DM * INW, INW, WIN + (size_t)l * INW * DM, DM, kt * 64, ntile * 64, smem);
                } else if (i < 1664) { const int ii = i - 1152, l = ii / 256, j = ii % 256, kt = j / 16, ntile = j % 16;
                    transpose_tile(p.w_out + (size_t)l * DM * DM, DM, WOUT + (size_t)l * DM * DM, DM, kt * 64, ntile * 64, smem);
                } else if (i < 1920) { const int ii = i - 1664, l = ii / 128, j = ii % 128, kt = j / 8, ntile = j % 8;
                    transpose_tile(p.w_mem_kv + (size_t)l * DM * 512, 512, WMEM + (size_t)l * 512 * DM, DM, kt * 64, ntile * 64, smem);
                } else { const int ii = i - 1920;
                    transpose_tile(p.pool_w + (size_t)ii * 4096, 64, PW + (size_t)ii * 4096, 64, 0, 0, smem);
                }
            }
            for (int i = bid * 8 + wave; i < NTOK + 2 * NMEMTOK; i += nb * 8) {
                if (i < NTOK) {
                    const float* src = (i < NPROMPT) ? p.x_prompt + (size_t)i * DM : p.x_sample + (size_t)(i - NPROMPT) * DM;
                    rms_row_f32(src, p.norm_pre, H + (size_t)i * DM, lane);
                } else {
                    const int ii = i - NTOK, l = ii / NMEMTOK, mt = ii % NMEMTOK;
                    const float* src = (mt < 4096) ? p.mem_prompt + (size_t)mt * DM : p.mem_sample + (size_t)(mt - 4096) * DM;
                    rms_row_f32(src, p.mem_norm + l * DM, MH + ((size_t)l * NMEMTOK + mt) * DM, lane);
                }
            }
            for (int i = bid * 512 + tid; i < 1024; i += nb * 512) rope_entry(i, ROPE);
        } else {
            const int l = (ph - 1) >> 2, sub = (ph - 1) & 3;
            if (sub == 0) {
                EpiArgs e; e.C = Z; e.VT = VT; e.qn = p.q_norm + l * 64; e.kn = p.k_norm + l * 64; e.rope = ROPE;
                const bf16_t* Wl = WIN + (size_t)l * INW * DM;
                EpiArgs e2; e2.C = KM + (size_t)l * NMEMTOK * 256; e2.VT = VMT + (size_t)l * NMEMTOK * 256; e2.qn = nullptr; e2.kn = nullptr; e2.rope = nullptr;
                const bf16_t* Wm = WMEM + (size_t)l * 512 * DM;
                const bf16_t* Am = MH + (size_t)l * NMEMTOK * DM;
                for (int i = bid; i < 1728 + 40; i += nb) {
                    if (i < 1728) {
                        const int j = i >> 3, mg = j / 72, rem = j % 72;
                        const int mt = (i & 7) * 24 + mg * 8 + (rem & 7), ntile = rem >> 3;
                        gemm_tile<0>(H, Wl, mt * 256, ntile * 256, e, smem);
                    } else {
                        const int j = i - 1728;
                        gemm_tile<2>(Am, Wm, (j >> 1) * 256, (j & 1) * 256, e2, smem);
                    }
                }
            } else if (sub == 1) {
                float gq = fabsf(p.q_norm[l * 64 + lane]), gk = fabsf(p.k_norm[l * 64 + lane]);
#pragma unroll
                for (int o = 1; o < 64; o <<= 1) { gq = fmaxf(gq, __shfl_xor(gq, o)); gk = fmaxf(gk, __shfl_xor(gk, o)); }
                const float mfix = 8.0f * gq * gk * 1.02f;
                const bool fixm = mfix < 20.0f;
                for (int i = bid; i < 3072; i += nb) {
                    if (i < 1536) {
                        int b, kvh, j, T; size_t tok0, vtb;
                        if (i < 512) { const int R = i >> 8, ip = i & 255, grp = ip & 7; j = R * 32 + (ip >> 3); b = grp >> 1; kvh = grp & 1; T = 4096;
                            tok0 = (size_t)NPROMPT + (size_t)b * 4096; vtb = (size_t)NPROMPT * 128 + ((size_t)(b * 2 + kvh) * 64) * 4096; }
                        else { const int ii = i - 512, R = ii >> 8, ip = ii & 255, grp = R * 8 + (ip & 7); j = ip >> 3; b = grp >> 1; kvh = grp & 1; T = 2048;
                            tok0 = (size_t)b * 2048; vtb = ((size_t)(b * 2 + kvh) * 64) * 2048; }
                        const int qblk = j >> 2, head = kvh * 4 + (j & 3);
                        const size_t q0 = tok0 + (size_t)qblk * 256;
                        if (fixm) attn_item<true>(Z + q0 * INW + 512 + head * 64, INW, Z + tok0 * INW + 1024 + kvh * 64, INW, VT + vtb, T, T,
                                  MIX + q0 * 1024 + 256 + head * 64, Z + q0 * INW + 1280 + head * 64, smem, mfix);
                        else attn_item<false>(Z + q0 * INW + 512 + head * 64, INW, Z + tok0 * INW + 1024 + kvh * 64, INW, VT + vtb, T, T,
                                  MIX + q0 * 1024 + 256 + head * 64, Z + q0 * INW + 1280 + head * 64, smem, 0.f);
                    } else if (i < 2304) {
                        const int ii = i - 1536, qb = ii >> 2, hx = ii & 3;
                        const size_t q0 = (size_t)qb * 256;
                        const int b = (q0 < NPROMPT) ? (int)(q0 >> 11) : 16 + (int)((q0 - NPROMPT) >> 12);
                        attn_item<false>(Z + q0 * INW + 1792 + hx * 64, INW, KM + ((size_t)l * NMEMTOK + (size_t)b * 256) * 256 + hx * 64, 256,
                                  VMT + (size_t)l * NMEMTOK * 256 + ((size_t)(b * 4 + hx) * 64) * 256, 256, 256,
                                  MIX + q0 * 1024 + 768 + hx * 64, Z + q0 * INW + 2048 + hx * 64, smem, 0.f);
                    } else {
                        pool_item(Z, PW + (size_t)l * 4 * 4096, p.pool_scale + l * 256, MIX, (i - 2304) * 64, smem);
                    }
                }
            } else if (sub == 2) {
                EpiArgs e; e.C = H; e.VT = nullptr; e.qn = nullptr; e.kn = nullptr; e.rope = nullptr;
                const bf16_t* Wl = WOUT + (size_t)l * DM * DM;
                for (int i = bid; i < 768; i += nb) {
                    const int j = i >> 3, mg = j >> 5, rem = j & 31;
                    const int mt = (i & 7) * 24 + mg * 8 + (rem & 7), ntile = rem >> 3;
                    gemm_tile<1>(MIX, Wl, mt * 256, ntile * 256, e, smem);
                }
            } else {
                const bool last = (l == DEPTH - 1);
                for (int i = bid * 8 + wave; i < NTOK; i += nb * 8) {
                    const float* xs = (l == 0) ? ((i < NPROMPT) ? p.x_prompt + (size_t)i * DM : p.x_sample + (size_t)(i - NPROMPT) * DM) : p.out + (size_t)i * DM;
                    post_row(xs, H + (size_t)i * DM, p.norm_post + l * DM, p.norm_pre + (last ? l : l + 1) * DM, p.out + (size_t)i * DM, last, lane);
                }
            }
        }
        if (ph + 1 < p.phase_end) xcd_barrier(xb);
    }
}

extern "C" void kernel_launch(void* const* d_in, const int* in_sizes, int n_in, void* d_out, int out_size, void* d_ws, size_t ws_size,
                              hipStream_t stream) {
    static int grid_blocks = 0;
    if (!grid_blocks) {
        int dev = 0, cus = 0, per_cu = 0;
        hipGetDevice(&dev);
        hipDeviceGetAttribute(&cus, hipDeviceAttributeMultiprocessorCount, dev);
        hipOccupancyMaxActiveBlocksPerMultiprocessor(&per_cu, fwd_megakernel, 512, 0);
        if (per_cu > 1) per_cu = 1;
        if (per_cu < 1) per_cu = 1;
        grid_blocks = cus * per_cu;
    }
    Params p{};
    p.x_prompt = (const float*)d_in[0]; p.x_sample = (const float*)d_in[1]; p.mem_prompt = (const float*)d_in[2]; p.mem_sample = (const float*)d_in[3];
    p.norm_pre = (const float*)d_in[4]; p.norm_post = (const float*)d_in[5]; p.w_in = (const float*)d_in[6]; p.pool_w = (const float*)d_in[7];
    p.pool_scale = (const float*)d_in[8]; p.q_norm = (const float*)d_in[9]; p.k_norm = (const float*)d_in[10]; p.mem_norm = (const float*)d_in[11];
    p.w_mem_kv = (const float*)d_in[12]; p.w_out = (const float*)d_in[13];
    p.out = (float*)d_out; p.ws = (unsigned char*)d_ws;
    p.phase_begin = 0; p.phase_end = 1 + 4 * DEPTH;
    if (ws_size < WS_TOTAL) { fprintf(stderr, "workspace too small: %zu < %zu\n", ws_size, (size_t)WS_TOTAL); return; }
    hipMemsetAsync((unsigned char*)d_ws + OFF_BAR, 0, BAR_BYTES, stream);
    void* args[] = {&p};
    hipError_t e = hipLaunchCooperativeKernel((void*)fwd_megakernel, dim3(grid_blocks), dim3(512), args, 0, stream);
    if (e != hipSuccess) fprintf(stderr, "cooperative launch failed: %s (grid %d)\n", hipGetErrorString(e), grid_blocks);
}
```

```cpp
#include <hip/hip_runtime.h>
#include <hip/hip_cooperative_groups.h>
#include <stdint.h>
#include <cstdio>
namespace cg = cooperative_groups;

typedef unsigned short bf16_t;
typedef short bf16x8 __attribute__((ext_vector_type(8)));
typedef float f32x4 __attribute__((ext_vector_type(4)));
typedef float f32x16 __attribute__((ext_vector_type(16)));
typedef unsigned u32x4 __attribute__((ext_vector_type(4)));
typedef unsigned u32x2 __attribute__((ext_vector_type(2)));
typedef __bf16 bf16x2_t __attribute__((ext_vector_type(2)));
typedef float f32x2_t __attribute__((ext_vector_type(2)));
#define DI __device__ __forceinline__

constexpr int NTOK = 49152;
constexpr int NPROMPT = 32768;
constexpr int DM = 1024;
constexpr int INW = 2304;
constexpr int NMEMTOK = 5120;
constexpr int DEPTH = 2;
constexpr float EPS = 1e-6f;
constexpr float L2E = 1.4426950408889634f;

constexpr size_t OFF_H    = 0;
constexpr size_t OFF_Z    = OFF_H + (size_t)NTOK * DM * 2;
constexpr size_t OFF_VT   = OFF_Z + (size_t)NTOK * INW * 2;
constexpr size_t OFF_MIX  = OFF_VT + (size_t)NTOK * 128 * 2;
constexpr size_t OFF_WIN  = OFF_MIX + (size_t)NTOK * DM * 2;
constexpr size_t OFF_WOUT = OFF_WIN + (size_t)DEPTH * INW * DM * 2;
constexpr size_t OFF_WMEM = OFF_WOUT + (size_t)DEPTH * DM * DM * 2;
constexpr size_t OFF_PW   = OFF_WMEM + (size_t)DEPTH * 512 * DM * 2;
constexpr size_t OFF_MH   = OFF_PW + (size_t)DEPTH * 4 * 64 * 64 * 2;
constexpr size_t OFF_KM   = OFF_MH + (size_t)DEPTH * NMEMTOK * DM * 2;
constexpr size_t OFF_VMT  = OFF_KM + (size_t)DEPTH * NMEMTOK * 256 * 2;
constexpr size_t OFF_ROPE = OFF_VMT + (size_t)DEPTH * NMEMTOK * 256 * 2;
constexpr size_t OFF_BAR  = OFF_ROPE + 64 * 16 * 2 * 4;
constexpr size_t BAR_BYTES = 3456 * 4;
constexpr size_t WS_TOTAL = OFF_BAR + BAR_BYTES;

struct Params {
    const float* x_prompt; const float* x_sample; const float* mem_prompt; const float* mem_sample;
    const float* norm_pre; const float* norm_post; const float* w_in; const float* pool_w; const float* pool_scale;
    const float* q_norm; const float* k_norm; const float* mem_norm; const float* w_mem_kv; const float* w_out;
    float* out; unsigned char* ws;
    int phase_begin; int phase_end;
};

DI unsigned pk_bf16(float a, float b) {
    f32x2_t v = {a, b};
    bf16x2_t r = __builtin_convertvector(v, bf16x2_t);
    return __builtin_bit_cast(unsigned, r);
}
DI int opaque_tid() { int t = threadIdx.x; asm volatile("" : "+v"(t)); return t; }
DI void lds_barrier() { asm volatile("s_waitcnt lgkmcnt(0)\n\ts_barrier" ::: "memory"); }
DI float bflo(unsigned u) { return __uint_as_float(u << 16); }
DI float bfhi(unsigned u) { return __uint_as_float(u & 0xffff0000u); }
DI float wave_sum(float v) {
    v += __shfl_xor(v, 1); v += __shfl_xor(v, 2); v += __shfl_xor(v, 4);
    v += __shfl_xor(v, 8); v += __shfl_xor(v, 16); v += __shfl_xor(v, 32);
    return v;
}
DI float xhalf_max(float v) {
    auto r = __builtin_amdgcn_permlane32_swap(__float_as_uint(v), __float_as_uint(v), false, false);
    return fmaxf(__uint_as_float(r[0]), __uint_as_float(r[1]));
}
DI float silu_f(float x) { return x * __builtin_amdgcn_rcpf(1.0f + __builtin_amdgcn_exp2f(-x * L2E)); }
DI f32x4 mfma16(bf16x8 a, bf16x8 b, f32x4 c) { return __builtin_amdgcn_mfma_f32_16x16x32_bf16(a, b, c, 0, 0, 0); }
DI f32x16 mfma32(bf16x8 a, bf16x8 b, f32x16 c) { return __builtin_amdgcn_mfma_f32_32x32x16_bf16(a, b, c, 0, 0, 0); }

DI void transpose_tile(const float* __restrict__ src, int ldn, bf16_t* __restrict__ dst, int ldk, int k0, int n0, unsigned char* smem) {
    float* tile = (float*)smem;
    const int tid = opaque_tid();
    __syncthreads();
#pragma unroll
    for (int i = 0; i < 8; ++i) {
        const int r = i * 8 + (tid >> 6), c = tid & 63;
        tile[r * 65 + c] = src[(size_t)(k0 + r) * ldn + n0 + c];
    }
    __syncthreads();
#pragma unroll
    for (int i = 0; i < 4; ++i) {
        const int n = i * 16 + (tid >> 5), kp = tid & 31;
        const float v0 = tile[(2 * kp) * 65 + n], v1 = tile[(2 * kp + 1) * 65 + n];
        *(unsigned*)(dst + (size_t)(n0 + n) * ldk + k0 + 2 * kp) = pk_bf16(v0, v1);
    }
}

DI void rms_row_f32(const float* __restrict__ src, const float* __restrict__ g, bf16_t* __restrict__ dst, int lane) {
    f32x4 v[4]; float ss = 0.f;
#pragma unroll
    for (int j = 0; j < 4; ++j) { v[j] = *(const f32x4*)(src + j * 256 + lane * 4); ss += v[j][0] * v[j][0] + v[j][1] * v[j][1] + v[j][2] * v[j][2] + v[j][3] * v[j][3]; }
    ss = wave_sum(ss);
    const float r = rsqrtf(ss * (1.0f / 1024.0f) + EPS);
#pragma unroll
    for (int j = 0; j < 4; ++j) {
        const f32x4 gg = *(const f32x4*)(g + j * 256 + lane * 4);
        u32x2 o; o.x = pk_bf16(v[j][0] * r * gg[0], v[j][1] * r * gg[1]); o.y = pk_bf16(v[j][2] * r * gg[2], v[j][3] * r * gg[3]);
        *(u32x2*)(dst + j * 256 + lane * 4) = o;
    }
}

DI void rope_entry(int idx, float* table) {
    const int n = idx >> 4, pp = idx & 15;
    double fd = 1.0;
    for (int i = 0; i < pp; ++i) fd *= 0.5623413251903491;
    const float f = (float)fd;
    const float a = (float)n * f;
    double r = (double)a;
    const double k = rint(r * 0.15915494309189535);
    r -= k * 6.283185307179586;
    const double r2 = r * r;
    double sn = r, cs = 1.0, ts = r, tc = 1.0;
    for (int i = 1; i <= 16; ++i) {
        tc = -tc * r2 / (double)((2 * i - 1) * (2 * i));
        ts = -ts * r2 / (double)((2 * i) * (2 * i + 1));
        cs += tc; sn += ts;
    }
    table[idx * 2] = (float)cs; table[idx * 2 + 1] = (float)sn;
}

struct EpiArgs {
    bf16_t* C;
    bf16_t* VT;
    const float* qn; const float* kn; const float* rope;
};

template <int MODE>
DI void gemm_tile(const bf16_t* __restrict__ A, const bf16_t* __restrict__ Bt, int m0, int n0, const EpiArgs& e, unsigned char* smem) {
    const int tid = opaque_tid(), lane = tid & 63, wave = tid >> 6;
    const int wm = wave >> 2, wn = wave & 3;
    const int lrow = tid >> 3, lc = tid & 7;
    const unsigned char* Ab = (const unsigned char*)(A + (size_t)m0 * 1024);
    const unsigned char* Bb = (const unsigned char*)(Bt + (size_t)n0 * 1024);
    const unsigned goff = (unsigned)(lrow * 1024 + lc * 8) * 2u;
#define GA(I, KT) (*(const u32x4*)(Ab + (goff + (unsigned)((I) * 131072 + (KT) * 128))))
#define GB(I, KT) (*(const u32x4*)(Bb + (goff + (unsigned)((I) * 131072 + (KT) * 128))))
    const int st_off = lrow * 128 + ((lc ^ ((lrow >> 1) & 7)) << 4);
    const int r16 = lane & 15, q4 = lane >> 4;
    const int fr_off = r16 * 128 + ((q4 ^ (r16 >> 1)) << 4);
    const int a_base = 32768 + (wn * 64) * 128;
    const int b_base = (wm * 128) * 128;
    constexpr int TI = 8;

    f32x4 acc[4][TI];
#pragma unroll
    for (int i = 0; i < 4; ++i)
#pragma unroll
        for (int j = 0; j < TI; ++j) acc[i][j] = (f32x4){0.f, 0.f, 0.f, 0.f};

    u32x4 ra[4], rb[4];
#define G_LOAD(KT) { _Pragma("unroll") for (int i = 0; i < 4; ++i) { ra[i] = GA(i, KT); rb[i] = GB(i, KT); } }
#define G_STORE(OFF) { _Pragma("unroll") for (int i = 0; i < 4; ++i) { *(u32x4*)(smem + (OFF) + st_off + i * 8192) = ra[i]; *(u32x4*)(smem + (OFF) + 32768 + st_off + i * 8192) = rb[i]; } }
#define G_STEP(CUR, NXT, KTL, DO_ST, DO_LD) { \
        { bf16x8 wf[4], tf[TI]; \
          _Pragma("unroll") for (int i = 0; i < 4; ++i) wf[i] = *(const bf16x8*)(smem + (CUR) + a_base + i * 2048 + fr_off); \
          _Pragma("unroll") for (int i = 0; i < TI; ++i) tf[i] = *(const bf16x8*)(smem + (CUR) + b_base + i * 2048 + fr_off); \
          _Pragma("unroll") for (int ti = 0; ti < TI; ++ti) { \
              _Pragma("unroll") for (int fi = 0; fi < 4; ++fi) acc[fi][ti] = mfma16(wf[fi], tf[ti], acc[fi][ti]); \
              if (DO_ST) { if (ti < 4) *(u32x4*)(smem + (NXT) + st_off + ti * 8192) = ra[ti]; else *(u32x4*)(smem + (NXT) + 32768 + st_off + (ti - 4) * 8192) = rb[ti - 4]; } \
              __builtin_amdgcn_sched_barrier(0); } } \
        { bf16x8 wf[4], tf[TI]; \
          _Pragma("unroll") for (int i = 0; i < 4; ++i) wf[i] = *(const bf16x8*)(smem + (CUR) + a_base + i * 2048 + (fr_off ^ 64)); \
          _Pragma("unroll") for (int i = 0; i < TI; ++i) tf[i] = *(const bf16x8*)(smem + (CUR) + b_base + i * 2048 + (fr_off ^ 64)); \
          _Pragma("unroll") for (int ti = 0; ti < TI; ++ti) { \
              _Pragma("unroll") for (int fi = 0; fi < 4; ++fi) acc[fi][ti] = mfma16(wf[fi], tf[ti], acc[fi][ti]); \
              if (DO_LD) { if (ti < 4) ra[ti] = GA(ti, KTL); else rb[ti - 4] = GB(ti - 4, KTL); } \
              __builtin_amdgcn_sched_barrier(0); } } }
    G_LOAD(0);
    G_STORE(0);
    G_LOAD(1);
    lds_barrier();
    for (int kt = 0; kt < 14; kt += 2) {
        G_STEP(0, 65536, kt + 2, true, true);
        lds_barrier();
        G_STEP(65536, 0, kt + 3, true, true);
        lds_barrier();
    }
    G_STEP(0, 65536, 0, true, false);
    lds_barrier();
    G_STEP(65536, 0, 0, false, false);
    lds_barrier();
#undef G_LOAD
#undef G_STORE
#undef G_STEP
#undef GA
#undef GB

    const int cb = n0 + wn * 64;
    const int tokb = m0 + wm * 128 + r16;
    if (MODE == 1) {
#pragma unroll
        for (int ti = 0; ti < TI; ++ti) {
            bf16_t* rowp = e.C + (size_t)(tokb + ti * 16) * 1024 + cb + 4 * q4;
#pragma unroll
            for (int fi = 0; fi < 4; ++fi) {
                u32x2 o; o.x = pk_bf16(acc[fi][ti][0], acc[fi][ti][1]); o.y = pk_bf16(acc[fi][ti][2], acc[fi][ti][3]);
                *(u32x2*)(rowp + fi * 16) = o;
            }
        }
    } else if (MODE == 2) {
        if (cb < 256) {
#pragma unroll
            for (int ti = 0; ti < TI; ++ti) {
                bf16_t* rowp = e.C + (size_t)(tokb + ti * 16) * 256 + cb + 4 * q4;
#pragma unroll
                for (int fi = 0; fi < 4; ++fi) {
                    u32x2 o; o.x = pk_bf16(acc[fi][ti][0], acc[fi][ti][1]); o.y = pk_bf16(acc[fi][ti][2], acc[fi][ti][3]);
                    *(u32x2*)(rowp + fi * 16) = o;
                }
            }
        } else {
            const int hx = (cb - 256) >> 6;
#pragma unroll
            for (int ti = 0; ti < TI; ++ti) {
                const int mt = tokb + ti * 16, b = mt >> 8, m = mt & 255;
                bf16_t* bp = e.VT + ((size_t)(b * 4 + hx) * 64) * 256 + m;
#pragma unroll
                for (int fi = 0; fi < 4; ++fi)
#pragma unroll
                    for (int i = 0; i < 4; ++i) bp[(size_t)(fi * 16 + 4 * q4 + i) * 256] = (bf16_t)(pk_bf16(acc[fi][ti][i], 0.f) & 0xffffu);
            }
        }
    } else {
        if (cb >= 512 && cb < 1152) {
            const bool isq = cb < 1024;
            const float* gn = isq ? e.qn : e.kn;
            const float osc = isq ? 0.125f : 1.0f;
            f32x4 g[4];
#pragma unroll
            for (int fi = 0; fi < 4; ++fi) g[fi] = *(const f32x4*)(gn + fi * 16 + 4 * q4);
#pragma unroll
            for (int ti = 0; ti < TI; ++ti) {
                const int tok = tokb + ti * 16;
                float ss = 0.f;
#pragma unroll
                for (int fi = 0; fi < 4; ++fi)
#pragma unroll
                    for (int i = 0; i < 4; ++i) ss += acc[fi][ti][i] * acc[fi][ti][i];
                ss += __shfl_xor(ss, 16); ss += __shfl_xor(ss, 32);
                const float rinv = rsqrtf(ss * (1.0f / 64.0f) + EPS);
                const int t = (tok < NPROMPT) ? (tok & 2047) : (tok & 4095);
                const int rowi = t >> 6, coli = t & 63;
                const f32x4* rt = (const f32x4*)(e.rope + (rowi * 16 + 4 * q4) * 2);
                const f32x4* ct = (const f32x4*)(e.rope + (coli * 16 + 4 * q4) * 2);
                const f32x4 r01 = rt[0], r23 = rt[1], c01 = ct[0], c23 = ct[1];
                const float rc[4] = {r01[0], r01[2], r23[0], r23[2]}, rs[4] = {r01[1], r01[3], r23[1], r23[3]};
                const float cc[4] = {c01[0], c01[2], c23[0], c23[2]}, cs[4] = {c01[1], c01[3], c23[1], c23[3]};
                float o[4][4];
#pragma unroll
                for (int i = 0; i < 4; ++i) {
                    const float a0 = acc[0][ti][i] * rinv * g[0][i], b0 = acc[1][ti][i] * rinv * g[1][i];
                    const float a1 = acc[2][ti][i] * rinv * g[2][i], b1 = acc[3][ti][i] * rinv * g[3][i];
                    o[0][i] = (a0 * rc[i] - b0 * rs[i]) * osc; o[1][i] = (b0 * rc[i] + a0 * rs[i]) * osc;
                    o[2][i] = (a1 * cc[i] - b1 * cs[i]) * osc; o[3][i] = (b1 * cc[i] + a1 * cs[i]) * osc;
                }
                bf16_t* rowp = e.C + (size_t)tok * INW + cb + 4 * q4;
#pragma unroll
                for (int fi = 0; fi < 4; ++fi) {
                    u32x2 w; w.x = pk_bf16(o[fi][0], o[fi][1]); w.y = pk_bf16(o[fi][2], o[fi][3]);
                    *(u32x2*)(rowp + fi * 16) = w;
                }
            }
        } else if (cb >= 1152 && cb < 1280) {
            const int kvh = (cb - 1152) >> 6;
#pragma unroll
            for (int ti = 0; ti < TI; ++ti) {
                const int tok = tokb + ti * 16;
                bf16_t* bp; size_t T;
                if (tok < NPROMPT) { const int b = tok >> 11, t = tok & 2047; T = 2048; bp = e.VT + ((size_t)(b * 2 + kvh) * 64) * 2048 + t; }
                else { const int b = (tok - NPROMPT) >> 12, t = tok & 4095; T = 4096; bp = e.VT + (size_t)NPROMPT * 128 + ((size_t)(b * 2 + kvh) * 64) * 4096 + t; }
#pragma unroll
                for (int fi = 0; fi < 4; ++fi)
#pragma unroll
                    for (int i = 0; i < 4; ++i) bp[(size_t)(fi * 16 + 4 * q4 + i) * T] = (bf16_t)(pk_bf16(acc[fi][ti][i], 0.f) & 0xffffu);
            }
        } else {
            const int kind = (cb < 256) ? 0 : ((cb >= 1792 && cb < 2048) ? 2 : 1);
#pragma unroll
            for (int ti = 0; ti < TI; ++ti) {
                bf16_t* rowp = e.C + (size_t)(tokb + ti * 16) * INW + cb + 4 * q4;
#pragma unroll
                for (int fi = 0; fi < 4; ++fi) {
                    float v[4];
#pragma unroll
                    for (int i = 0; i < 4; ++i) { const float x = acc[fi][ti][i]; v[i] = (kind == 0) ? x : ((kind == 2) ? x * 0.125f : silu_f(x)); }
                    u32x2 o; o.x = pk_bf16(v[0], v[1]); o.y = pk_bf16(v[2], v[3]);
                    *(u32x2*)(rowp + fi * 16) = o;
                }
            }
        }
    }
}

#define SB_() __builtin_amdgcn_sched_barrier(0)
#define KFRAG(KS, KB) (*(const bf16x8*)(kp + (KB) * 4096 + k_off + ((((KS) * 2 + h) ^ kswz) << 4)))
#define VFRAG(KK, DB) (*(const bf16x8*)(vp + (DB) * 4096 + v_off + ((((KK) * 2 + h) ^ vswz) << 4)))
#define EXP4(S, I0) { _Pragma("unroll") for (int i_ = (I0); i_ < (I0) + 4; ++i_) { S[i_] = __builtin_amdgcn_exp2f(S[i_] * L2E - mb); rs += S[i_]; } }
#define EXP4F(S, I0) { f32x2_t a_ = {S[(I0)], S[(I0) + 1]}, b_ = {S[(I0) + 2], S[(I0) + 3]}; \
        a_ = a_ * (f32x2_t){L2E, L2E} - (f32x2_t){mb, mb}; b_ = b_ * (f32x2_t){L2E, L2E} - (f32x2_t){mb, mb}; \
        S[(I0)] = __builtin_amdgcn_exp2f(a_.x); S[(I0) + 1] = __builtin_amdgcn_exp2f(a_.y); S[(I0) + 2] = __builtin_amdgcn_exp2f(b_.x); S[(I0) + 3] = __builtin_amdgcn_exp2f(b_.y); \
        rs2 += (f32x2_t){S[(I0)], S[(I0) + 1]} + (f32x2_t){S[(I0) + 2], S[(I0) + 3]}; }
#define EXPQ(S, I0) { if (FIXM) EXP4F(S, I0) else EXP4(S, I0) }
#define PACK8(S, I0) ({ u32x4 t_; t_.x = pk_bf16(S[(I0)], S[(I0) + 1]); t_.y = pk_bf16(S[(I0) + 2], S[(I0) + 3]); t_.z = pk_bf16(S[(I0) + 4], S[(I0) + 5]); t_.w = pk_bf16(S[(I0) + 6], S[(I0) + 7]); __builtin_bit_cast(bf16x8, t_); })
DI float max8(const f32x16& s, int i0, float mx) {
    mx = fmaxf(fmaxf(mx, s[i0]), s[i0 + 1]); mx = fmaxf(fmaxf(mx, s[i0 + 2]), s[i0 + 3]);
    mx = fmaxf(fmaxf(mx, s[i0 + 4]), s[i0 + 5]); mx = fmaxf(fmaxf(mx, s[i0 + 6]), s[i0 + 7]);
    return mx;
}
template <bool DO_PV, bool DO_QK, bool FIXM>
DI void attn_step(f32x16& s0, f32x16& s1, f32x16& n0, f32x16& n1, const bf16x8 (&pp)[4], bf16x8 (&pc)[4],
                  f32x16& o0, f32x16& o1, float& m, float& lsum, const bf16x8 (&qf)[4],
                  const unsigned char* kp, const unsigned char* vp, int k_off, int kswz, int v_off, int vswz, int h) {
    bf16x8 va0, vb0, va1, vb1, va2, vb2, va3, vb3, ka0, kb0, ka1, kb1, ka2, kb2, ka3, kb3;
    if (DO_PV) { va0 = VFRAG(0, 0); vb0 = VFRAG(0, 1); va1 = VFRAG(1, 0); vb1 = VFRAG(1, 1); }
    float mx = s0[0];
    if (DO_PV) o0 = mfma32(va0, pp[0], o0);
    if (!FIXM) mx = max8(s0, 0, mx);
    SB_();
    if (DO_PV) { o1 = mfma32(vb0, pp[0], o1); va2 = VFRAG(2, 0); vb2 = VFRAG(2, 1); }
    if (!FIXM) mx = max8(s0, 8, mx);
    SB_();
    if (DO_PV) { o0 = mfma32(va1, pp[1], o0); va3 = VFRAG(3, 0); vb3 = VFRAG(3, 1); }
    if (!FIXM) mx = max8(s1, 0, mx);
    SB_();
    if (DO_PV) o1 = mfma32(vb1, pp[1], o1);
    bool need = false; float alpha = 1.0f;
    if (!FIXM) {
        mx = max8(s1, 8, mx);
        mx = xhalf_max(mx);
        need = mx > m + 5.5f;
        const float mnew = need ? mx : m;
        alpha = __builtin_amdgcn_exp2f((m - mnew) * L2E);
        m = mnew;
    }
    const float mb = m * L2E;
    float rs = 0.f; f32x2_t rs2 = {0.f, 0.f};
    SB_();
    if (DO_PV) o0 = mfma32(va2, pp[2], o0);
    if (DO_QK) { ka0 = KFRAG(0, 0); kb0 = KFRAG(0, 1); }
    EXPQ(s0, 0);
    SB_();
    if (DO_PV) o1 = mfma32(vb2, pp[2], o1);
    if (DO_QK) { ka1 = KFRAG(1, 0); kb1 = KFRAG(1, 1); }
    EXPQ(s0, 4);
    SB_();
    if (DO_PV) o0 = mfma32(va3, pp[3], o0);
    EXPQ(s0, 8);
    SB_();
    if (DO_PV) o1 = mfma32(vb3, pp[3], o1);
    EXPQ(s0, 12);
    SB_();
    if (DO_QK) { n0 = mfma32(ka0, qf[0], (f32x16){0.f, 0.f, 0.f, 0.f, 0.f, 0.f, 0.f, 0.f, 0.f, 0.f, 0.f, 0.f, 0.f, 0.f, 0.f, 0.f}); ka2 = KFRAG(2, 0); kb2 = KFRAG(2, 1); }
    EXPQ(s1, 0);
    SB_();
    if (DO_QK) { n1 = mfma32(kb0, qf[0], (f32x16){0.f, 0.f, 0.f, 0.f, 0.f, 0.f, 0.f, 0.f, 0.f, 0.f, 0.f, 0.f, 0.f, 0.f, 0.f, 0.f}); ka3 = KFRAG(3, 0); kb3 = KFRAG(3, 1); }
    EXPQ(s1, 4);
    SB_();
    if (DO_QK) n0 = mfma32(ka1, qf[1], n0);
    EXPQ(s1, 8);
    SB_();
    if (DO_QK) n1 = mfma32(kb1, qf[1], n1);
    EXPQ(s1, 12);
    SB_();
    if (DO_QK) n0 = mfma32(ka2, qf[2], n0);
    pc[0] = PACK8(s0, 0);
    SB_();
    if (DO_QK) n1 = mfma32(kb2, qf[2], n1);
    pc[1] = PACK8(s0, 8);
    SB_();
    if (DO_QK) n0 = mfma32(ka3, qf[3], n0);
    pc[2] = PACK8(s1, 0);
    SB_();
    if (DO_QK) n1 = mfma32(kb3, qf[3], n1);
    pc[3] = PACK8(s1, 8);
    if (FIXM) lsum += rs2.x + rs2.y; else lsum = lsum * alpha + rs;
    SB_();
    if (!FIXM) {
        if (__builtin_amdgcn_ballot_w64(need)) {
#pragma unroll
            for (int i = 0; i < 16; ++i) { o0[i] *= alpha; o1[i] *= alpha; }
        }
    }
}

template <bool FIXM>
DI void attn_item(const bf16_t* __restrict__ Q, int ldq, const bf16_t* __restrict__ K, int ldk, const bf16_t* __restrict__ VT, int ldv,
                  int nkeys, bf16_t* __restrict__ O, const bf16_t* __restrict__ G, unsigned char* smem, float mfix) {
    const int tid = opaque_tid(), lane = tid & 63, wave = tid >> 6;
    const int r = lane & 31, h = lane >> 5;
    bf16x8 qf[4];
    {
        const bf16_t* qp = Q + (size_t)(wave * 32 + r) * ldq + h * 8;
#pragma unroll
        for (int ks = 0; ks < 4; ++ks) qf[ks] = *(const bf16x8*)(qp + ks * 16);
    }
    const int lrow = tid >> 3, lc = tid & 7;
    const bf16_t* Kg = K + (size_t)lrow * ldk + lc * 8;
    const bf16_t* Vg = VT + (size_t)lrow * ldv + lc * 8;
    const int st_off = lrow * 128 + ((lc ^ ((lrow >> 1) & 7)) << 4);
    const int pr = (r & ~12) | ((r & 4) << 1) | ((r & 8) >> 1);
    const int kswz = (pr >> 1) & 7, vswz = (r >> 1) & 7;
    const int k_off = pr * 128, v_off = r * 128;
    const int nt = nkeys >> 6;

    f32x16 o0, o1, sa0, sa1, sb0, sb1;
#pragma unroll
    for (int i = 0; i < 16; ++i) { o0[i] = 0.f; o1[i] = 0.f; }
    float m = FIXM ? mfix : -1e30f, lsum = 0.f;
    bf16x8 pa[4], pb[4];

    u32x4 rk, rv;
#define A_LOAD(U) { const int kt_ = ((U) + 2 < nt) ? (U) + 2 : nt - 1; rk = *(const u32x4*)(Kg + (size_t)(kt_ * 64) * ldk); rv = *(const u32x4*)(Vg + (U) * 64); }
#define A_STORE(OFF) { *(u32x4*)(smem + (OFF) + st_off) = rk; *(u32x4*)(smem + (OFF) + 8192 + st_off) = rv; }
    rk = *(const u32x4*)(Kg); rv = *(const u32x4*)(Kg + (size_t)64 * ldk);
    __syncthreads();
    A_STORE(16384);
    A_LOAD(0);
    A_STORE(0);
    A_LOAD(1);
    lds_barrier();
    {
        const unsigned char* kp = smem + 16384;
        sa0 = mfma32(KFRAG(0, 0), qf[0], (f32x16){0.f, 0.f, 0.f, 0.f, 0.f, 0.f, 0.f, 0.f, 0.f, 0.f, 0.f, 0.f, 0.f, 0.f, 0.f, 0.f});
        sa1 = mfma32(KFRAG(0, 1), qf[0], (f32x16){0.f, 0.f, 0.f, 0.f, 0.f, 0.f, 0.f, 0.f, 0.f, 0.f, 0.f, 0.f, 0.f, 0.f, 0.f, 0.f});
#pragma unroll
        for (int ks = 1; ks < 4; ++ks) { sa0 = mfma32(KFRAG(ks, 0), qf[ks], sa0); sa1 = mfma32(KFRAG(ks, 1), qf[ks], sa1); }
    }
    attn_step<false, true, FIXM>(sa0, sa1, sb0, sb1, pb, pa, o0, o1, m, lsum, qf, smem + 16384 + 8192, smem, k_off, kswz, v_off, vswz, h);
    lds_barrier();
    for (int t = 1; t < nt - 1; t += 2) {
        A_STORE(16384);
        A_LOAD(t + 1);
        SB_();
        attn_step<true, true, FIXM>(sb0, sb1, sa0, sa1, pa, pb, o0, o1, m, lsum, qf, smem, smem + 8192, k_off, kswz, v_off, vswz, h);
        lds_barrier();
        A_STORE(0);
        A_LOAD(t + 2);
        SB_();
        attn_step<true, true, FIXM>(sa0, sa1, sb0, sb1, pb, pa, o0, o1, m, lsum, qf, smem + 16384, smem + 16384 + 8192, k_off, kswz, v_off, vswz, h);
        lds_barrier();
    }
    A_STORE(16384);
    SB_();
    attn_step<true, false, FIXM>(sb0, sb1, sa0, sa1, pa, pb, o0, o1, m, lsum, qf, smem, smem + 8192, k_off, kswz, v_off, vswz, h);
    lds_barrier();
    {
        const unsigned char* vp = smem + 16384 + 8192;
#pragma unroll
        for (int kk = 0; kk < 4; ++kk) { o0 = mfma32(VFRAG(kk, 0), pb[kk], o0); o1 = mfma32(VFRAG(kk, 1), pb[kk], o1); }
    }
#undef A_LOAD
#undef A_STORE
    const float lt = lsum + __shfl_xor(lsum, 32);
    const float inv = 1.0f / lt;
    const bf16_t* gp = G + (size_t)(wave * 32 + r) * INW + 4 * h;
    bf16_t* op = O + (size_t)(wave * 32 + r) * 1024 + 4 * h;
#pragma unroll
    for (int gq = 0; gq < 4; ++gq) {
        {
            const u32x2 gg = *(const u32x2*)(gp + 8 * gq);
            u32x2 w;
            w.x = pk_bf16(o0[4 * gq] * inv * bflo(gg.x), o0[4 * gq + 1] * inv * bfhi(gg.x));
            w.y = pk_bf16(o0[4 * gq + 2] * inv * bflo(gg.y), o0[4 * gq + 3] * inv * bfhi(gg.y));
            *(u32x2*)(op + 8 * gq) = w;
        }
        {
            const u32x2 gg = *(const u32x2*)(gp + 32 + 8 * gq);
            u32x2 w;
            w.x = pk_bf16(o1[4 * gq] * inv * bflo(gg.x), o1[4 * gq + 1] * inv * bfhi(gg.x));
            w.y = pk_bf16(o1[4 * gq + 2] * inv * bflo(gg.y), o1[4 * gq + 3] * inv * bfhi(gg.y));
            *(u32x2*)(op + 32 + 8 * gq) = w;
        }
    }
}

DI void pool_item(const bf16_t* __restrict__ Z, const bf16_t* __restrict__ PWT, const float* __restrict__ pscale, bf16_t* __restrict__ MIX,
                  int tokg0, unsigned char* smem) {
    const int tid = opaque_tid(), lane = tid & 63, wave = tid >> 6;
    const int T = (tokg0 < NPROMPT) ? 2048 : 4096;
    const int t0 = tokg0 & (T - 1);
    constexpr int RS = 528;
    __syncthreads();
    for (int id = tid; id < 80 * 32; id += 512) {
        const int rr = id >> 5, c = id & 31;
        const int t = t0 - 8 + rr;
        u32x4 v = (u32x4){0u, 0u, 0u, 0u};
        if (t >= 0 && t < T) v = *(const u32x4*)(Z + (size_t)(tokg0 - 8 + rr) * INW + c * 8);
        *(u32x4*)(smem + rr * RS + c * 16) = v;
    }
    __syncthreads();
    const int g = wave & 3, half = 1 << g;
    const int r16 = lane & 15, q4 = lane >> 4;
    const bf16_t* pw = PWT + (size_t)g * 4096 + r16 * 64 + q4 * 8;
    {
        const int th = wave >> 2;
        bf16x8 df[2][2];
#pragma unroll
        for (int t2 = 0; t2 < 2; ++t2)
#pragma unroll
            for (int ks = 0; ks < 2; ++ks) {
                const int tl = (th * 2 + t2) * 16 + r16, t = t0 + tl;
                const int lo = max(t - half, 0), hi = min(t + half, T);
                const float icnt = 1.0f / (float)(hi - lo);
                float s[8];
#pragma unroll
                for (int j = 0; j < 8; ++j) s[j] = 0.f;
                const unsigned char* bp = smem + (tl + 8 - half) * RS + (g * 64 + ks * 32 + q4 * 8) * 2;
                for (int j = 0; j < 2 * half; ++j) {
                    const u32x4 v = *(const u32x4*)(bp + j * RS);
                    s[0] += bflo(v.x); s[1] += bfhi(v.x); s[2] += bflo(v.y); s[3] += bfhi(v.y);
                    s[4] += bflo(v.z); s[5] += bfhi(v.z); s[6] += bflo(v.w); s[7] += bfhi(v.w);
                }
                const u32x4 c = *(const u32x4*)(bp + half * RS);
                u32x4 o;
                o.x = pk_bf16(s[0] * icnt - bflo(c.x), s[1] * icnt - bfhi(c.x));
                o.y = pk_bf16(s[2] * icnt - bflo(c.y), s[3] * icnt - bfhi(c.y));
                o.z = pk_bf16(s[4] * icnt - bflo(c.z), s[5] * icnt - bfhi(c.z));
                o.w = pk_bf16(s[6] * icnt - bflo(c.w), s[7] * icnt - bfhi(c.w));
                df[t2][ks] = __builtin_bit_cast(bf16x8, o);
            }
        f32x4 acc[4][2];
#pragma unroll
        for (int i = 0; i < 4; ++i)
#pragma unroll
            for (int j = 0; j < 2; ++j) acc[i][j] = (f32x4){0.f, 0.f, 0.f, 0.f};
#pragma unroll
        for (int fi = 0; fi < 4; ++fi)
#pragma unroll
            for (int ks = 0; ks < 2; ++ks) {
                const bf16x8 wf = *(const bf16x8*)(pw + fi * 16 * 64 + ks * 32);
#pragma unroll
                for (int t2 = 0; t2 < 2; ++t2) acc[fi][t2] = mfma16(wf, df[t2][ks], acc[fi][t2]);
            }
#pragma unroll
        for (int t2 = 0; t2 < 2; ++t2) {
            const size_t tok = (size_t)tokg0 + (th * 2 + t2) * 16 + r16;
#pragma unroll
            for (int fi = 0; fi < 4; ++fi) {
                const int n = g * 64 + fi * 16 + 4 * q4;
                const f32x4 ps = *(const f32x4*)(pscale + n);
                const u32x2 gg = *(const u32x2*)(Z + tok * INW + 256 + n);
                u32x2 w;
                w.x = pk_bf16(acc[fi][t2][0] * ps[0] * bflo(gg.x), acc[fi][t2][1] * ps[1] * bfhi(gg.x));
                w.y = pk_bf16(acc[fi][t2][2] * ps[2] * bflo(gg.y), acc[fi][t2][3] * ps[3] * bfhi(gg.y));
                *(u32x2*)(MIX + tok * 1024 + n) = w;
            }
        }
    }
}

DI void post_row(const float* __restrict__ xsrc, bf16_t* __restrict__ yh, const float* __restrict__ gpost, const float* __restrict__ gpre_next,
                 float* __restrict__ xdst, bool last, int lane) {
    u32x4 yv[2]; f32x4 xv[4];
#pragma unroll
    for (int j = 0; j < 2; ++j) yv[j] = *(const u32x4*)(yh + j * 512 + lane * 8);
#pragma unroll
    for (int j = 0; j < 2; ++j) { xv[2 * j] = *(const f32x4*)(xsrc + j * 512 + lane * 8); xv[2 * j + 1] = *(const f32x4*)(xsrc + j * 512 + lane * 8 + 4); }
    float y[16];
#pragma unroll
    for (int j = 0; j < 2; ++j) {
        y[8 * j + 0] = bflo(yv[j].x); y[8 * j + 1] = bfhi(yv[j].x); y[8 * j + 2] = bflo(yv[j].y); y[8 * j + 3] = bfhi(yv[j].y);
        y[8 * j + 4] = bflo(yv[j].z); y[8 * j + 5] = bfhi(yv[j].z); y[8 * j + 6] = bflo(yv[j].w); y[8 * j + 7] = bfhi(yv[j].w);
    }
    float ss = 0.f;
#pragma unroll
    for (int i = 0; i < 16; ++i) ss += y[i] * y[i];
    ss = wave_sum(ss);
    const float r = rsqrtf(ss * (1.0f / 1024.0f) + EPS);
    float xn[16]; float ss2 = 0.f;
#pragma unroll
    for (int j = 0; j < 2; ++j) {
        const f32x4 g0 = *(const f32x4*)(gpost + j * 512 + lane * 8), g1 = *(const f32x4*)(gpost + j * 512 + lane * 8 + 4);
#pragma unroll
        for (int i = 0; i < 4; ++i) {
            xn[8 * j + i] = xv[2 * j][i] + y[8 * j + i] * r * g0[i];
            xn[8 * j + 4 + i] = xv[2 * j + 1][i] + y[8 * j + 4 + i] * r * g1[i];
        }
    }
#pragma unroll
    for (int i = 0; i < 16; ++i) ss2 += xn[i] * xn[i];
#pragma unroll
    for (int j = 0; j < 2; ++j) {
        *(f32x4*)(xdst + j * 512 + lane * 8) = (f32x4){xn[8 * j], xn[8 * j + 1], xn[8 * j + 2], xn[8 * j + 3]};
        *(f32x4*)(xdst + j * 512 + lane * 8 + 4) = (f32x4){xn[8 * j + 4], xn[8 * j + 5], xn[8 * j + 6], xn[8 * j + 7]};
    }
    if (!last) {
        ss2 = wave_sum(ss2);
        const float r2 = rsqrtf(ss2 * (1.0f / 1024.0f) + EPS);
#pragma unroll
        for (int j = 0; j < 2; ++j) {
            const f32x4 g0 = *(const f32x4*)(gpre_next + j * 512 + lane * 8), g1 = *(const f32x4*)(gpre_next + j * 512 + lane * 8 + 4);
            u32x4 o;
            o.x = pk_bf16(xn[8 * j] * r2 * g0[0], xn[8 * j + 1] * r2 * g0[1]);
            o.y = pk_bf16(xn[8 * j + 2] * r2 * g0[2], xn[8 * j + 3] * r2 * g0[3]);
            o.z = pk_bf16(xn[8 * j + 4] * r2 * g1[0], xn[8 * j + 5] * r2 * g1[1]);
            o.w = pk_bf16(xn[8 * j + 6] * r2 * g1[2], xn[8 * j + 7] * r2 * g1[3]);
            *(u32x4*)(yh + j * 512 + lane * 8) = o;
        }
    }
}

#define XB_TMO      128
#define XB_XCNT(j)  (256  + 64 * (j))
#define XB_XSUB(j)  (1280 + 64 * (j))
#define XB_XGEN(j)  (2304 + 64 * (j))
#define XB_TOP      3328
#define XB_TOPGEN   3392
#define XCD_BAR_WORDS 3456
#define XB_SPIN_CAP (1u << 18)
#define LAS __attribute__((address_space(3)))
DI unsigned xb_ld(unsigned* p)              { return __hip_atomic_load(p, __ATOMIC_RELAXED, __HIP_MEMORY_SCOPE_AGENT); }
DI unsigned xb_add(unsigned* p, unsigned v) { return __hip_atomic_fetch_add(p, v, __ATOMIC_RELAXED, __HIP_MEMORY_SCOPE_AGENT); }
DI unsigned xb_xcc_id() { return (unsigned)__builtin_amdgcn_s_getreg((3 << 11) | 20) & 0xFu; }
#define XB_SPIN(cond, bar) do { unsigned _sp = 0; while (cond) { __builtin_amdgcn_s_sleep(1); \
    if ((++_sp & 255u) == 0u) { if (xb_ld(&(bar)[XB_TMO])) break; if (_sp > XB_SPIN_CAP) { atomicAdd(&(bar)[XB_TMO], 1u); break; } } } } while (0)
struct XcdBarrier { unsigned* bar; unsigned x; volatile LAS unsigned* st; };
DI XcdBarrier xcd_barrier_post(unsigned* bar, volatile LAS unsigned* st) {
    XcdBarrier b; b.bar = bar; b.x = xb_xcc_id(); b.st = st;
    if (threadIdx.x == 0) (void)xb_add(&bar[XB_XCNT(b.x)], 1u);
    return b;
}
DI void xcd_barrier_complete(unsigned* bar, unsigned x, unsigned& nloc, unsigned& nx) {
    const unsigned G = gridDim.x * gridDim.y * gridDim.z;
    unsigned sum, cnt, mine, sp = 0u;
    for (;;) {
        sum = 0u; cnt = 0u; mine = 0u;
#pragma unroll
        for (unsigned j = 0; j < 16; ++j) { const unsigned c = xb_ld(&bar[XB_XCNT(j)]); sum += c; cnt += (c > 0u) ? 1u : 0u; mine = (j == x) ? c : mine; }
        if (sum == G) break;
        __builtin_amdgcn_s_sleep(1);
        if ((++sp & 255u) == 0u) { if (xb_ld(&bar[XB_TMO])) break; if (sp > XB_SPIN_CAP) { atomicAdd(&bar[XB_TMO], 1u); break; } }
    }
    nloc = mine > 0u ? mine : 1u; nx = cnt > 0u ? cnt : 1u;
}
DI void xcd_barrier(const XcdBarrier& b) {
    asm volatile("s_waitcnt vmcnt(0)" ::: "memory");
    __syncthreads();
    if (threadIdx.x == 0) {
        unsigned* bar = b.bar;
        __builtin_amdgcn_s_waitcnt(0);
        unsigned nloc = b.st[0], nx = b.st[1];
        if (nloc == 0u) { xcd_barrier_complete(bar, b.x, nloc, nx); b.st[0] = nloc; b.st[1] = nx; }
        const unsigned old = xb_add(&bar[XB_XSUB(b.x)], 1u);
        const unsigned gen = old / nloc;
        if (old + 1u == (gen + 1u) * nloc) {
            __builtin_amdgcn_fence(__ATOMIC_RELEASE, "agent");
            asm volatile("s_waitcnt vmcnt(0)" ::: "memory");
            const unsigned og = xb_add(&bar[XB_TOP], 1u);
            const unsigned tg = og / nx;
            if (og + 1u == (tg + 1u) * nx) xb_add(&bar[XB_TOPGEN], 1u);
            else XB_SPIN(xb_ld(&bar[XB_TOPGEN]) == tg, bar);
            __builtin_amdgcn_fence(__ATOMIC_ACQUIRE, "agent");
            xb_add(&bar[XB_XGEN(b.x)], 1u);
            asm volatile("s_waitcnt vmcnt(0)" ::: "memory");
        } else {
            XB_SPIN(xb_ld(&bar[XB_XGEN(b.x)]) == gen, bar);
            __builtin_amdgcn_fence(__ATOMIC_ACQUIRE, "agent");
            asm volatile("s_waitcnt vmcnt(0)" ::: "memory");
        }
    }
    __syncthreads();
}

__global__ void __launch_bounds__(512, 2) fwd_megakernel(Params p) {
    __shared__ __attribute__((aligned(16))) unsigned char smem[131072];
    __shared__ uint4 xb_words;
    cg::grid_group grid = cg::this_grid();
    const int nb = gridDim.x, bid = blockIdx.x;
    if (threadIdx.x == 0) xb_words = make_uint4(0u, 0u, 0u, 0u);
    __syncthreads();
    XcdBarrier xb = xcd_barrier_post((unsigned*)(p.ws + OFF_BAR), (volatile LAS unsigned*)&xb_words);
    if (p.phase_end > 1000) grid.sync();
    for (int ph = p.phase_begin; ph < p.phase_end; ++ph) {
        const int tid = opaque_tid(), lane = tid & 63, wave = tid >> 6;
        unsigned char* ws = p.ws;
        bf16_t* H = (bf16_t*)(ws + OFF_H);
        bf16_t* Z = (bf16_t*)(ws + OFF_Z);
        bf16_t* VT = (bf16_t*)(ws + OFF_VT);
        bf16_t* MIX = (bf16_t*)(ws + OFF_MIX);
        bf16_t* WIN = (bf16_t*)(ws + OFF_WIN);
        bf16_t* WOUT = (bf16_t*)(ws + OFF_WOUT);
        bf16_t* WMEM = (bf16_t*)(ws + OFF_WMEM);
        bf16_t* PW = (bf16_t*)(ws + OFF_PW);
        bf16_t* MH = (bf16_t*)(ws + OFF_MH);
        bf16_t* KM = (bf16_t*)(ws + OFF_KM);
        bf16_t* VMT = (bf16_t*)(ws + OFF_VMT);
        float* ROPE = (float*)(ws + OFF_ROPE);
        if (ph == 0) {
            for (int i = bid; i < 1928; i += nb) {
                if (i < 1152) { const int l = i / 576, j = i % 576, kt = j / 36, ntile = j % 36;
                    transpose_tile(p.w_in + (size_t)l * DM * INW, INW, WIN + (size_t)l * INW * DM, DM, kt * 64, ntile * 64, smem);
                } else if (i < 1664) { const int ii = i - 1152, l = ii / 256, j = ii % 256, kt = j / 16, ntile = j % 16;
                    transpose_tile(p.w_out + (size_t)l * DM * DM, DM, WOUT + (size_t)l * DM * DM, DM, kt * 64, ntile * 64, smem);
                } else if (i < 1920) { const int ii = i - 1664, l = ii / 128, j = ii % 128, kt = j / 8, ntile = j % 8;
                    transpose_tile(p.w_mem_kv + (size_t)l * DM * 512, 512, WMEM + (size_t)l * 512 * DM, DM, kt * 64, ntile * 64, smem);
                } else { const int ii = i - 1920;
                    transpose_tile(p.pool_w + (size_t)ii * 4096, 64, PW + (size_t)ii * 4096, 64, 0, 0, smem);
                }
            }
            for (int i = bid * 8 + wave; i < NTOK + 2 * NMEMTOK; i += nb * 8) {
                if (i < NTOK) {
                    const float* src = (i < NPROMPT) ? p.x_prompt + (size_t)i * DM : p.x_sample + (size_t)(i - NPROMPT) * DM;
                    rms_row_f32(src, p.norm_pre, H + (size_t)i * DM, lane);
                } else {
                    const int ii = i - NTOK, l = ii / NMEMTOK, mt = ii % NMEMTOK;
                    const float* src = (mt < 4096) ? p.mem_prompt + (size_t)mt * DM : p.mem_sample + (size_t)(mt - 4096) * DM;
                    rms_row_f32(src, p.mem_norm + l * DM, MH + ((size_t)l * NMEMTOK + mt) * DM, lane);
                }
            }
            for (int i = bid * 512 + tid; i < 1024; i += nb * 512) rope_entry(i, ROPE);
        } else {
            const int l = (ph - 1) >> 2, sub = (ph - 1) & 3;
            if (sub == 0) {
                EpiArgs e; e.C = Z; e.VT = VT; e.qn = p.q_norm + l * 64; e.kn = p.k_norm + l * 64; e.rope = ROPE;
                const bf16_t* Wl = WIN + (size_t)l * INW * DM;
                EpiArgs e2; e2.C = KM + (size_t)l * NMEMTOK * 256; e2.VT = VMT + (size_t)l * NMEMTOK * 256; e2.qn = nullptr; e2.kn = nullptr; e2.rope = nullptr;
                const bf16_t* Wm = WMEM + (size_t)l * 512 * DM;
                const bf16_t* Am = MH + (size_t)l * NMEMTOK * DM;
                for (int i = bid; i < 1728 + 40; i += nb) {
                    if (i < 1728) {
                        const int j = i >> 3, mg = j / 72, rem = j % 72;
                        const int mt = (i & 7) * 24 + mg * 8 + (rem & 7), ntile = rem >> 3;
                        gemm_tile<0>(H, Wl, mt * 256, ntile * 256, e, smem);
                    } else {
                        const int j = i - 1728;
                        gemm_tile<2>(Am, Wm, (j >> 1) * 256, (j & 1) * 256, e2, smem);
                    }
                }
            } else if (sub == 1) {
                float gq = fabsf(p.q_norm[l * 64 + lane]), gk = fabsf(p.k_norm[l * 64 + lane]);
#pragma unroll
                for (int o = 1; o < 64; o <<= 1) { gq = fmaxf(gq, __shfl_xor(gq, o)); gk = fmaxf(gk, __shfl_xor(gk, o)); }
                const float mfix = 8.0f * gq * gk * 1.02f;
                const bool fixm = mfix < 20.0f;
                for (int i = bid; i < 3072; i += nb) {
                    if (i < 1536) {
                        int b, kvh, j, T; size_t tok0, vtb;
                        if (i < 512) { const int R = i >> 8, ip = i & 255, grp = ip & 7; j = R * 32 + (ip >> 3); b = grp >> 1; kvh = grp & 1; T = 4096;
                            tok0 = (size_t)NPROMPT + (size_t)b * 4096; vtb = (size_t)NPROMPT * 128 + ((size_t)(b * 2 + kvh) * 64) * 4096; }
                        else { const int ii = i - 512, R = ii >> 8, ip = ii & 255, grp = R * 8 + (ip & 7); j = ip >> 3; b = grp >> 1; kvh = grp & 1; T = 2048;
                            tok0 = (size_t)b * 2048; vtb = ((size_t)(b * 2 + kvh) * 64) * 2048; }
                        const int qblk = j >> 2, head = kvh * 4 + (j & 3);
                        const size_t q0 = tok0 + (size_t)qblk * 256;
                        if (fixm) attn_item<true>(Z + q0 * INW + 512 + head * 64, INW, Z + tok0 * INW + 1024 + kvh * 64, INW, VT + vtb, T, T,
                                  MIX + q0 * 1024 + 256 + head * 64, Z + q0 * INW + 1280 + head * 64, smem, mfix);
                        else attn_item<false>(Z + q0 * INW + 512 + head * 64, INW, Z + tok0 * INW + 1024 + kvh * 64, INW, VT + vtb, T, T,
                                  MIX + q0 * 1024 + 256 + head * 64, Z + q0 * INW + 1280 + head * 64, smem, 0.f);
                    } else if (i < 2304) {
                        const int ii = i - 1536, qb = ii >> 2, hx = ii & 3;
                        const size_t q0 = (size_t)qb * 256;
                        const int b = (q0 < NPROMPT) ? (int)(q0 >> 11) : 16 + (int)((q0 - NPROMPT) >> 12);
                        attn_item<false>(Z + q0 * INW + 1792 + hx * 64, INW, KM + ((size_t)l * NMEMTOK + (size_t)b * 256) * 256 + hx * 64, 256,
                                  VMT + (size_t)l * NMEMTOK * 256 + ((size_t)(b * 4 + hx) * 64) * 256, 256, 256,
                                  MIX + q0 * 1024 + 768 + hx * 64, Z + q0 * INW + 2048 + hx * 64, smem, 0.f);
                    } else {
                        pool_item(Z, PW + (size_t)l * 4 * 4096, p.pool_scale + l * 256, MIX, (i - 2304) * 64, smem);
                    }
                }
            } else if (sub == 2) {
                EpiArgs e; e.C = H; e.VT = nullptr; e.qn = nullptr; e.kn = nullptr; e.rope = nullptr;
                const bf16_t* Wl = WOUT + (size_t)l * DM * DM;
                for (int i = bid; i < 768; i += nb) {
                    const int j = i >> 3, mg = j >> 5, rem = j & 31;
                    const int mt = (i & 7) * 24 + mg * 8 + (rem & 7), ntile = rem >> 3;
                    gemm_tile<1>(MIX, Wl, mt * 256, ntile * 256, e, smem);
                }
            } else {
                const bool last = (l == DEPTH - 1);
                for (int i = bid * 8 + wave; i < NTOK; i += nb * 8) {
                    const float* xs = (l == 0) ? ((i < NPROMPT) ? p.x_prompt + (size_t)i * DM : p.x_sample + (size_t)(i - NPROMPT) * DM) : p.out + (size_t)i * DM;
                    post_row(xs, H + (size_t)i * DM, p.norm_post + l * DM, p.norm_pre + (last ? l : l + 1) * DM, p.out + (size_t)i * DM, last, lane);
                }
            }
        }
        if (ph + 1 < p.phase_end) xcd_barrier(xb);
    }
}

extern "C" void kernel_launch(void* const* d_in, const int* in_sizes, int n_in, void* d_out, int out_size, void* d_ws, size_t ws_size,
                              hipStream_t stream) {
    static int grid_blocks = 0;
    if (!grid_blocks) {
        int dev = 0, cus = 0, per_cu = 0;
        hipGetDevice(&dev);
        hipDeviceGetAttribute(&cus, hipDeviceAttributeMultiprocessorCount, dev);
        hipOccupancyMaxActiveBlocksPerMultiprocessor(&per_cu, fwd_megakernel, 512, 0);
        if (per_cu > 1) per_cu = 1;
        if (per_cu < 1) per_cu = 1;
        grid_blocks = cus * per_cu;
    }
    Params p{};
    p.x_prompt = (const float*)d_in[0]; p.x_sample = (const float*)d_in[1]; p.mem_prompt = (const float*)d_in[2]; p.mem_sample = (const float*)d_in[3];
    p.norm_pre = (const float*)d_in[4]; p.norm_post = (const float*)d_in[5]; p.w_in = (const float*)d_in[6]; p.pool_w = (const float*)d_in[7];
    p.pool_scale = (const float*)d_in[8]; p.q_norm = (const float*)d_in[9]; p.k_norm = (const float*)d_in[10]; p.mem_norm = (const float*)d_in[11];
    p.w_mem_kv = (const float*)d_in[12]; p.w_out = (const float*)d_in[13];
    p.out = (float*)d_out; p.ws = (unsigned char*)d_ws;
    p.phase_begin = 0; p.phase_end = 1 + 4 * DEPTH;
    if (ws_size < WS_TOTAL) { fprintf(stderr, "workspace too small: %zu < %zu\n", ws_size, (size_t)WS_TOTAL); return; }
    hipMemsetAsync((unsigned char*)d_ws + OFF_BAR, 0, BAR_BYTES, stream);
    void* args[] = {&p};
    hipError_t e = hipLaunchCooperativeKernel((void*)fwd_megakernel, dim3(grid_blocks), dim3(512), args, 0, stream);
    if (e != hipSuccess) fprintf(stderr, "cooperative launch failed: %s (grid %d)\n", hipGetErrorString(e), grid_blocks);
}
```

```cpp
#include <hip/hip_runtime.h>
#include <hip/hip_cooperative_groups.h>
#include <stdint.h>
#include <cstdio>
namespace cg = cooperative_groups;

typedef unsigned short bf16_t;
typedef short bf16x8 __attribute__((ext_vector_type(8)));
typedef float f32x4 __attribute__((ext_vector_type(4)));
typedef float f32x16 __attribute__((ext_vector_type(16)));
typedef unsigned u32x4 __attribute__((ext_vector_type(4)));
typedef unsigned u32x2 __attribute__((ext_vector_type(2)));
typedef __bf16 bf16x2_t __attribute__((ext_vector_type(2)));
typedef float f32x2_t __attribute__((ext_vector_type(2)));
#define DI __device__ __forceinline__

constexpr int NTOK = 49152;
constexpr int NPROMPT = 32768;
constexpr int DM = 1024;
constexpr int INW = 2304;
constexpr int NMEMTOK = 5120;
constexpr int DEPTH = 2;
constexpr float EPS = 1e-6f;
constexpr float L2E = 1.4426950408889634f;

constexpr size_t OFF_H    = 0;
constexpr size_t OFF_Z    = OFF_H + (size_t)NTOK * DM * 2;
constexpr size_t OFF_VT   = OFF_Z + (size_t)NTOK * INW * 2;
constexpr size_t OFF_MIX  = OFF_VT + (size_t)NTOK * 128 * 2;
constexpr size_t OFF_WIN  = OFF_MIX + (size_t)NTOK * DM * 2;
constexpr size_t OFF_WOUT = OFF_WIN + (size_t)DEPTH * INW * DM * 2;
constexpr size_t OFF_WMEM = OFF_WOUT + (size_t)DEPTH * DM * DM * 2;
constexpr size_t OFF_PW   = OFF_WMEM + (size_t)DEPTH * 512 * DM * 2;
constexpr size_t OFF_MH   = OFF_PW + (size_t)DEPTH * 4 * 64 * 64 * 2;
constexpr size_t OFF_KM   = OFF_MH + (size_t)DEPTH * NMEMTOK * DM * 2;
constexpr size_t OFF_VMT  = OFF_KM + (size_t)DEPTH * NMEMTOK * 256 * 2;
constexpr size_t OFF_ROPE = OFF_VMT + (size_t)DEPTH * NMEMTOK * 256 * 2;
constexpr size_t OFF_BAR  = OFF_ROPE + 64 * 16 * 2 * 4;
constexpr size_t BAR_BYTES = 3456 * 4;
constexpr size_t WS_TOTAL = OFF_BAR + BAR_BYTES;

struct Params {
    const float* x_prompt; const float* x_sample; const float* mem_prompt; const float* mem_sample;
    const float* norm_pre; const float* norm_post; const float* w_in; const float* pool_w; const float* pool_scale;
    const float* q_norm; const float* k_norm; const float* mem_norm; const float* w_mem_kv; const float* w_out;
    float* out; unsigned char* ws;
    int phase_begin; int phase_end;
};

DI unsigned pk_bf16(float a, float b) {
    f32x2_t v = {a, b};
    bf16x2_t r = __builtin_convertvector(v, bf16x2_t);
    return __builtin_bit_cast(unsigned, r);
}
DI int opaque_tid() { int t = threadIdx.x; asm volatile("" : "+v"(t)); return t; }
DI void lds_barrier() { asm volatile("s_waitcnt lgkmcnt(0)\n\ts_barrier" ::: "memory"); }
DI float bflo(unsigned u) { return __uint_as_float(u << 16); }
DI float bfhi(unsigned u) { return __uint_as_float(u & 0xffff0000u); }
DI float wave_sum(float v) {
    v += __shfl_xor(v, 1); v += __shfl_xor(v, 2); v += __shfl_xor(v, 4);
    v += __shfl_xor(v, 8); v += __shfl_xor(v, 16); v += __shfl_xor(v, 32);
    return v;
}
DI float xhalf_max(float v) {
    auto r = __builtin_amdgcn_permlane32_swap(__float_as_uint(v), __float_as_uint(v), false, false);
    return fmaxf(__uint_as_float(r[0]), __uint_as_float(r[1]));
}
DI float silu_f(float x) { return x * __builtin_amdgcn_rcpf(1.0f + __builtin_amdgcn_exp2f(-x * L2E)); }
DI f32x4 mfma16(bf16x8 a, bf16x8 b, f32x4 c) { return __builtin_amdgcn_mfma_f32_16x16x32_bf16(a, b, c, 0, 0, 0); }
DI f32x16 mfma32(bf16x8 a, bf16x8 b, f32x16 c) { return __builtin_amdgcn_mfma_f32_32x32x16_bf16(a, b, c, 0, 0, 0); }

DI void transpose_tile(const float* __restrict__ src, int ldn, bf16_t* __restrict__ dst, int ldk, int k0, int n0, unsigned char* smem) {
    float* tile = (float*)smem;
    const int tid = opaque_tid();
    __syncthreads();
#pragma unroll
    for (int i = 0; i < 8; ++i) {
        const int r = i * 8 + (tid >> 6), c = tid & 63;
        tile[r * 65 + c] = src[(size_t)(k0 + r) * ldn + n0 + c];
    }
    __syncthreads();
#pragma unroll
    for (int i = 0; i < 4; ++i) {
        const int n = i * 16 + (tid >> 5), kp = tid & 31;
        const float v0 = tile[(2 * kp) * 65 + n], v1 = tile[(2 * kp + 1) * 65 + n];
        *(unsigned*)(dst + (size_t)(n0 + n) * ldk + k0 + 2 * kp) = pk_bf16(v0, v1);
    }
}

DI void rms_row_f32(const float* __restrict__ src, const float* __restrict__ g, bf16_t* __restrict__ dst, int lane) {
    f32x4 v[4]; float ss = 0.f;
#pragma unroll
    for (int j = 0; j < 4; ++j) { v[j] = *(const f32x4*)(src + j * 256 + lane * 4); ss += v[j][0] * v[j][0] + v[j][1] * v[j][1] + v[j][2] * v[j][2] + v[j][3] * v[j][3]; }
    ss = wave_sum(ss);
    const float r = rsqrtf(ss * (1.0f / 1024.0f) + EPS);
#pragma unroll
    for (int j = 0; j < 4; ++j) {
        const f32x4 gg = *(const f32x4*)(g + j * 256 + lane * 4);
        u32x2 o; o.x = pk_bf16(v[j][0] * r * gg[0], v[j][1] * r * gg[1]); o.y = pk_bf16(v[j][2] * r * gg[2], v[j][3] * r * gg[3]);
        *(u32x2*)(dst + j * 256 + lane * 4) = o;
    }
}

DI void rope_entry(int idx, float* table) {
    const int n = idx >> 4, pp = idx & 15;
    double fd = 1.0;
    for (int i = 0; i < pp; ++i) fd *= 0.5623413251903491;
    const float f = (float)fd;
    const float a = (float)n * f;
    double r = (double)a;
    const double k = rint(r * 0.15915494309189535);
    r -= k * 6.283185307179586;
    const double r2 = r * r;
    double sn = r, cs = 1.0, ts = r, tc = 1.0;
    for (int i = 1; i <= 16; ++i) {
        tc = -tc * r2 / (double)((2 * i - 1) * (2 * i));
        ts = -ts * r2 / (double)((2 * i) * (2 * i + 1));
        cs += tc; sn += ts;
    }
    table[idx * 2] = (float)cs; table[idx * 2 + 1] = (float)sn;
}

struct EpiArgs {
    bf16_t* C;
    bf16_t* VT;
    const float* qn; const float* kn; const float* rope;
};

template <int MODE>
DI void gemm_tile(const bf16_t* __restrict__ A, const bf16_t* __restrict__ Bt, int m0, int n0, const EpiArgs& e, unsigned char* smem) {
    const int tid = opaque_tid(), lane = tid & 63, wave = tid >> 6;
    const int wm = wave >> 2, wn = wave & 3;
    const int lrow = tid >> 3, lc = tid & 7;
    const unsigned char* Ab = (const unsigned char*)(A + (size_t)m0 * 1024);
    const unsigned char* Bb = (const unsigned char*)(Bt + (size_t)n0 * 1024);
    const unsigned goff = (unsigned)(lrow * 1024 + lc * 8) * 2u;
#define GA(I, KT) (*(const u32x4*)(Ab + (goff + (unsigned)((I) * 131072 + (KT) * 128))))
#define GB(I, KT) (*(const u32x4*)(Bb + (goff + (unsigned)((I) * 131072 + (KT) * 128))))
    const int st_off = lrow * 128 + ((lc ^ ((lrow >> 1) & 7)) << 4);
    const int r16 = lane & 15, q4 = lane >> 4;
    const int fr_off = r16 * 128 + ((q4 ^ (r16 >> 1)) << 4);
    const int a_base = 32768 + (wn * 64) * 128;
    const int b_base = (wm * 128) * 128;
    constexpr int TI = 8;

    f32x4 acc[4][TI];
#pragma unroll
    for (int i = 0; i < 4; ++i)
#pragma unroll
        for (int j = 0; j < TI; ++j) acc[i][j] = (f32x4){0.f, 0.f, 0.f, 0.f};

    u32x4 ra[4], rb[4];
#define G_LOAD(KT) { _Pragma("unroll") for (int i = 0; i < 4; ++i) { ra[i] = GA(i, KT); rb[i] = GB(i, KT); } }
#define G_STORE(OFF) { _Pragma("unroll") for (int i = 0; i < 4; ++i) { *(u32x4*)(smem + (OFF) + st_off + i * 8192) = ra[i]; *(u32x4*)(smem + (OFF) + 32768 + st_off + i * 8192) = rb[i]; } }
#define G_STEP(CUR, NXT, KTL, DO_ST, DO_LD) { \
        { bf16x8 wf[4], tf[TI]; \
          _Pragma("unroll") for (int i = 0; i < 4; ++i) wf[i] = *(const bf16x8*)(smem + (CUR) + a_base + i * 2048 + fr_off); \
          _Pragma("unroll") for (int i = 0; i < TI; ++i) tf[i] = *(const bf16x8*)(smem + (CUR) + b_base + i * 2048 + fr_off); \
          _Pragma("unroll") for (int ti = 0; ti < TI; ++ti) { \
              _Pragma("unroll") for (int fi = 0; fi < 4; ++fi) acc[fi][ti] = mfma16(wf[fi], tf[ti], acc[fi][ti]); \
              if (DO_ST) { if (ti < 4) *(u32x4*)(smem + (NXT) + st_off + ti * 8192) = ra[ti]; else *(u32x4*)(smem + (NXT) + 32768 + st_off + (ti - 4) * 8192) = rb[ti - 4]; } \
              __builtin_amdgcn_sched_barrier(0); } } \
        { bf16x8 wf[4], tf[TI]; \
          _Pragma("unroll") for (int i = 0; i < 4; ++i) wf[i] = *(const bf16x8*)(smem + (CUR) + a_base + i * 2048 + (fr_off ^ 64)); \
          _Pragma("unroll") for (int i = 0; i < TI; ++i) tf[i] = *(const bf16x8*)(smem + (CUR) + b_base + i * 2048 + (fr_off ^ 64)); \
          _Pragma("unroll") for (int ti = 0; ti < TI; ++ti) { \
              _Pragma("unroll") for (int fi = 0; fi < 4; ++fi) acc[fi][ti] = mfma16(wf[fi], tf[ti], acc[fi][ti]); \
              if (DO_LD) { if (ti < 4) ra[ti] = GA(ti, KTL); else rb[ti - 4] = GB(ti - 4, KTL); } \
              __builtin_amdgcn_sched_barrier(0); } } }
    G_LOAD(0);
    G_STORE(0);
    G_LOAD(1);
    lds_barrier();
    for (int kt = 0; kt < 14; kt += 2) {
        G_STEP(0, 65536, kt + 2, true, true);
        lds_barrier();
        G_STEP(65536, 0, kt + 3, true, true);
        lds_barrier();
    }
    G_STEP(0, 65536, 0, true, false);
    lds_barrier();
    G_STEP(65536, 0, 0, false, false);
    lds_barrier();
#undef G_LOAD
#undef G_STORE
#undef G_STEP
#undef GA
#undef GB

    const int cb = n0 + wn * 64;
    const int tokb = m0 + wm * 128 + r16;
    if (MODE == 1) {
#pragma unroll
        for (int ti = 0; ti < TI; ++ti) {
            bf16_t* rowp = e.C + (size_t)(tokb + ti * 16) * 1024 + cb + 4 * q4;
#pragma unroll
            for (int fi = 0; fi < 4; ++fi) {
                u32x2 o; o.x = pk_bf16(acc[fi][ti][0], acc[fi][ti][1]); o.y = pk_bf16(acc[fi][ti][2], acc[fi][ti][3]);
                *(u32x2*)(rowp + fi * 16) = o;
            }
        }
    } else if (MODE == 2) {
        if (cb < 256) {
#pragma unroll
            for (int ti = 0; ti < TI; ++ti) {
                bf16_t* rowp = e.C + (size_t)(tokb + ti * 16) * 256 + cb + 4 * q4;
#pragma unroll
                for (int fi = 0; fi < 4; ++fi) {
                    u32x2 o; o.x = pk_bf16(acc[fi][ti][0], acc[fi][ti][1]); o.y = pk_bf16(acc[fi][ti][2], acc[fi][ti][3]);
                    *(u32x2*)(rowp + fi * 16) = o;
                }
            }
        } else {
            const int hx = (cb - 256) >> 6;
#pragma unroll
            for (int ti = 0; ti < TI; ++ti) {
                const int mt = tokb + ti * 16, b = mt >> 8, m = mt & 255;
                bf16_t* bp = e.VT + ((size_t)(b * 4 + hx) * 64) * 256 + m;
#pragma unroll
                for (int fi = 0; fi < 4; ++fi)
#pragma unroll
                    for (int i = 0; i < 4; ++i) bp[(size_t)(fi * 16 + 4 * q4 + i) * 256] = (bf16_t)(pk_bf16(acc[fi][ti][i], 0.f) & 0xffffu);
            }
        }
    } else {
        if (cb >= 512 && cb < 1152) {
            const bool isq = cb < 1024;
            const float* gn = isq ? e.qn : e.kn;
            const float osc = isq ? 0.125f : 1.0f;
            f32x4 g[4];
#pragma unroll
            for (int fi = 0; fi < 4; ++fi) g[fi] = *(const f32x4*)(gn + fi * 16 + 4 * q4);
#pragma unroll
            for (int ti = 0; ti < TI; ++ti) {
                const int tok = tokb + ti * 16;
                float ss = 0.f;
#pragma unroll
                for (int fi = 0; fi < 4; ++fi)
#pragma unroll
                    for (int i = 0; i < 4; ++i) ss += acc[fi][ti][i] * acc[fi][ti][i];
                ss += __shfl_xor(ss, 16); ss += __shfl_xor(ss, 32);
                const float rinv = rsqrtf(ss * (1.0f / 64.0f) + EPS);
                const int t = (tok < NPROMPT) ? (tok & 2047) : (tok & 4095);
                const int rowi = t >> 6, coli = t & 63;
                const f32x4* rt = (const f32x4*)(e.rope + (rowi * 16 + 4 * q4) * 2);
                const f32x4* ct = (const f32x4*)(e.rope + (coli * 16 + 4 * q4) * 2);
                const f32x4 r01 = rt[0], r23 = rt[1], c01 = ct[0], c23 = ct[1];
                const float rc[4] = {r01[0], r01[2], r23[0], r23[2]}, rs[4] = {r01[1], r01[3], r23[1], r23[3]};
                const float cc[4] = {c01[0], c01[2], c23[0], c23[2]}, cs[4] = {c01[1], c01[3], c23[1], c23[3]};
                float o[4][4];
#pragma unroll
                for (int i = 0; i < 4; ++i) {
                    const float a0 = acc[0][ti][i] * rinv * g[0][i], b0 = acc[1][ti][i] * rinv * g[1][i];
                    const float a1 = acc[2][ti][i] * rinv * g[2][i], b1 = acc[3][ti][i] * rinv * g[3][i];
                    o[0][i] = (a0 * rc[i] - b0 * rs[i]) * osc; o[1][i] = (b0 * rc[i] + a0 * rs[i]) * osc;
                    o[2][i] = (a1 * cc[i] - b1 * cs[i]) * osc; o[3][i] = (b1 * cc[i] + a1 * cs[i]) * osc;
                }
                bf16_t* rowp = e.C + (size_t)tok * INW + cb + 4 * q4;
#pragma unroll
                for (int fi = 0; fi < 4; ++fi) {
                    u32x2 w; w.x = pk_bf16(o[fi][0], o[fi][1]); w.y = pk_bf16(o[fi][2], o[fi][3]);
                    *(u32x2*)(rowp + fi * 16) = w;
                }
            }
        } else if (cb >= 1152 && cb < 1280) {
            const int kvh = (cb - 1152) >> 6;
#pragma unroll
            for (int ti = 0; ti < TI; ++ti) {
                const int tok = tokb + ti * 16;
                bf16_t* bp; size_t T;
                if (tok < NPROMPT) { const int b = tok >> 11, t = tok & 2047; T = 2048; bp = e.VT + ((size_t)(b * 2 + kvh) * 64) * 2048 + t; }
                else { const int b = (tok - NPROMPT) >> 12, t = tok & 4095; T = 4096; bp = e.VT + (size_t)NPROMPT * 128 + ((size_t)(b * 2 + kvh) * 64) * 4096 + t; }
#pragma unroll
                for (int fi = 0; fi < 4; ++fi)
#pragma unroll
                    for (int i = 0; i < 4; ++i) bp[(size_t)(fi * 16 + 4 * q4 + i) * T] = (bf16_t)(pk_bf16(acc[fi][ti][i], 0.f) & 0xffffu);
            }
        } else {
            const int kind = (cb < 256) ? 0 : ((cb >= 1792 && cb < 2048) ? 2 : 1);
#pragma unroll
            for (int ti = 0; ti < TI; ++ti) {
                bf16_t* rowp = e.C + (size_t)(tokb + ti * 16) * INW + cb + 4 * q4;
#pragma unroll
                for (int fi = 0; fi < 4; ++fi) {
                    float v[4];
#pragma unroll
                    for (int i = 0; i < 4; ++i) { const float x = acc[fi][ti][i]; v[i] = (kind == 0) ? x : ((kind == 2) ? x * 0.125f : silu_f(x)); }
                    u32x2 o; o.x = pk_bf16(v[0], v[1]); o.y = pk_bf16(v[2], v[3]);
                    *(u32x2*)(rowp + fi * 16) = o;
                }
            }
        }
    }
}

#define SB_() __builtin_amdgcn_sched_barrier(0)
#define KFRAG(KS, KB) (*(const bf16x8*)(kp + (KB) * 4096 + k_off + ((((KS) * 2 + h) ^ kswz) << 4)))
#define VFRAG(KK, DB) (*(const bf16x8*)(vp + (DB) * 4096 + v_off + ((((KK) * 2 + h) ^ vswz) << 4)))
#define EXP4(S, I0) { _Pragma("unroll") for (int i_ = (I0); i_ < (I0) + 4; ++i_) { S[i_] = __builtin_amdgcn_exp2f(S[i_] * L2E - mb); rs += S[i_]; } }
#define EXP4F(S, I0) { f32x2_t a_ = {S[(I0)], S[(I0) + 1]}, b_ = {S[(I0) + 2], S[(I0) + 3]}; \
        a_ = a_ * (f32x2_t){L2E, L2E} - (f32x2_t){mb, mb}; b_ = b_ * (f32x2_t){L2E, L2E} - (f32x2_t){mb, mb}; \
        S[(I0)] = __builtin_amdgcn_exp2f(a_.x); S[(I0) + 1] = __builtin_amdgcn_exp2f(a_.y); S[(I0) + 2] = __builtin_amdgcn_exp2f(b_.x); S[(I0) + 3] = __builtin_amdgcn_exp2f(b_.y); \
        rs2 += (f32x2_t){S[(I0)], S[(I0) + 1]} + (f32x2_t){S[(I0) + 2], S[(I0) + 3]}; }
#define EXPQ(S, I0) { if (FIXM) EXP4F(S, I0) else EXP4(S, I0) }
#define PACK8(S, I0) ({ u32x4 t_; t_.x = pk_bf16(S[(I0)], S[(I0) + 1]); t_.y = pk_bf16(S[(I0) + 2], S[(I0) + 3]); t_.z = pk_bf16(S[(I0) + 4], S[(I0) + 5]); t_.w = pk_bf16(S[(I0) + 6], S[(I0) + 7]); __builtin_bit_cast(bf16x8, t_); })
DI float max8(const f32x16& s, int i0, float mx) {
    mx = fmaxf(fmaxf(mx, s[i0]), s[i0 + 1]); mx = fmaxf(fmaxf(mx, s[i0 + 2]), s[i0 + 3]);
    mx = fmaxf(fmaxf(mx, s[i0 + 4]), s[i0 + 5]); mx = fmaxf(fmaxf(mx, s[i0 + 6]), s[i0 + 7]);
    return mx;
}
#define EXP2F(S, I0) { S[(I0)] = __builtin_amdgcn_exp2f(S[(I0)] * L2E - mb); S[(I0) + 1] = __builtin_amdgcn_exp2f(S[(I0) + 1] * L2E - mb); rs += S[(I0)] + S[(I0) + 1]; \
        asm volatile("" : "+v"(S[(I0)]), "+v"(S[(I0) + 1]), "+v"(rs)); }
#define PIN1(X) asm volatile("" : "+v"(X))
template <bool DO_PV, bool DO_QK>
DI void attn_step_fix(f32x16& s0, f32x16& s1, f32x16& n0, f32x16& n1, const bf16x8 (&pp)[4], bf16x8 (&pc)[4],
                      f32x16& o0, f32x16& o1, const float m, float& lsum, const bf16x8 (&qf)[4],
                      const unsigned char* kp, const unsigned char* vp, int k_off, int kswz, int v_off, int vswz, int h) {
    bf16x8 va0, vb0, va1, vb1, va2, vb2, va3, vb3, ka0, kb0, ka1, kb1, ka2, kb2, ka3, kb3;
    const float mb = m * L2E;
    float rs = 0.f;
    if (DO_PV) { va0 = VFRAG(0, 0); vb0 = VFRAG(0, 1); va1 = VFRAG(1, 0); vb1 = VFRAG(1, 1); }
    EXP2F(s0, 0);  if (DO_PV) { o0 = mfma32(va0, pp[0], o0); va2 = VFRAG(2, 0); vb2 = VFRAG(2, 1); } SB_();
    EXP2F(s0, 2);  if (DO_PV) { o1 = mfma32(vb0, pp[0], o1); va3 = VFRAG(3, 0); vb3 = VFRAG(3, 1); } SB_();
    EXP2F(s0, 4);  if (DO_PV) { o0 = mfma32(va1, pp[1], o0); } if (DO_QK) { ka0 = KFRAG(0, 0); kb0 = KFRAG(0, 1); } SB_();
    EXP2F(s0, 6);  if (DO_PV) { o1 = mfma32(vb1, pp[1], o1); } if (DO_QK) { ka1 = KFRAG(1, 0); kb1 = KFRAG(1, 1); } SB_();
    EXP2F(s0, 8);  if (DO_PV) { o0 = mfma32(va2, pp[2], o0); } SB_();
    EXP2F(s0, 10); if (DO_PV) { o1 = mfma32(vb2, pp[2], o1); } pc[0] = PACK8(s0, 0); PIN1(pc[0]); SB_();
    EXP2F(s0, 12); if (DO_PV) { o0 = mfma32(va3, pp[3], o0); } SB_();
    EXP2F(s0, 14); if (DO_PV) { o1 = mfma32(vb3, pp[3], o1); } SB_();
    EXP2F(s1, 0);  if (DO_QK) { n0 = mfma32(ka0, qf[0], (f32x16){0.f, 0.f, 0.f, 0.f, 0.f, 0.f, 0.f, 0.f, 0.f, 0.f, 0.f, 0.f, 0.f, 0.f, 0.f, 0.f}); ka2 = KFRAG(2, 0); kb2 = KFRAG(2, 1); } pc[1] = PACK8(s0, 8); PIN1(pc[1]); SB_();
    EXP2F(s1, 2);  if (DO_QK) { n1 = mfma32(kb0, qf[0], (f32x16){0.f, 0.f, 0.f, 0.f, 0.f, 0.f, 0.f, 0.f, 0.f, 0.f, 0.f, 0.f, 0.f, 0.f, 0.f, 0.f}); ka3 = KFRAG(3, 0); kb3 = KFRAG(3, 1); } SB_();
    EXP2F(s1, 4);  if (DO_QK) { n0 = mfma32(ka1, qf[1], n0); } SB_();
    EXP2F(s1, 6);  if (DO_QK) { n1 = mfma32(kb1, qf[1], n1); } SB_();
    EXP2F(s1, 8);  if (DO_QK) { n0 = mfma32(ka2, qf[2], n0); } pc[2] = PACK8(s1, 0); PIN1(pc[2]); SB_();
    EXP2F(s1, 10); if (DO_QK) { n1 = mfma32(kb2, qf[2], n1); } SB_();
    EXP2F(s1, 12); if (DO_QK) { n0 = mfma32(ka3, qf[3], n0); } SB_();
    EXP2F(s1, 14); if (DO_QK) { n1 = mfma32(kb3, qf[3], n1); } pc[3] = PACK8(s1, 8); PIN1(pc[3]);
    lsum += rs;
    SB_();
}
template <bool DO_PV, bool DO_QK, bool FIXM>
DI void attn_step(f32x16& s0, f32x16& s1, f32x16& n0, f32x16& n1, const bf16x8 (&pp)[4], bf16x8 (&pc)[4],
                  f32x16& o0, f32x16& o1, float& m, float& lsum, const bf16x8 (&qf)[4],
                  const unsigned char* kp, const unsigned char* vp, int k_off, int kswz, int v_off, int vswz, int h) {
    if (FIXM) { attn_step_fix<DO_PV, DO_QK>(s0, s1, n0, n1, pp, pc, o0, o1, m, lsum, qf, kp, vp, k_off, kswz, v_off, vswz, h); return; }
    bf16x8 va0, vb0, va1, vb1, va2, vb2, va3, vb3, ka0, kb0, ka1, kb1, ka2, kb2, ka3, kb3;
    if (DO_PV) { va0 = VFRAG(0, 0); vb0 = VFRAG(0, 1); va1 = VFRAG(1, 0); vb1 = VFRAG(1, 1); }
    float mx = s0[0];
    if (DO_PV) o0 = mfma32(va0, pp[0], o0);
    if (!FIXM) mx = max8(s0, 0, mx);
    SB_();
    if (DO_PV) { o1 = mfma32(vb0, pp[0], o1); va2 = VFRAG(2, 0); vb2 = VFRAG(2, 1); }
    if (!FIXM) mx = max8(s0, 8, mx);
    SB_();
    if (DO_PV) { o0 = mfma32(va1, pp[1], o0); va3 = VFRAG(3, 0); vb3 = VFRAG(3, 1); }
    if (!FIXM) mx = max8(s1, 0, mx);
    SB_();
    if (DO_PV) o1 = mfma32(vb1, pp[1], o1);
    bool need = false; float alpha = 1.0f;
    if (!FIXM) {
        mx = max8(s1, 8, mx);
        mx = xhalf_max(mx);
        need = mx > m + 5.5f;
        const float mnew = need ? mx : m;
        alpha = __builtin_amdgcn_exp2f((m - mnew) * L2E);
        m = mnew;
    }
    const float mb = m * L2E;
    float rs = 0.f; f32x2_t rs2 = {0.f, 0.f};
    SB_();
    if (DO_PV) o0 = mfma32(va2, pp[2], o0);
    if (DO_QK) { ka0 = KFRAG(0, 0); kb0 = KFRAG(0, 1); }
    EXPQ(s0, 0);
    SB_();
    if (DO_PV) o1 = mfma32(vb2, pp[2], o1);
    if (DO_QK) { ka1 = KFRAG(1, 0); kb1 = KFRAG(1, 1); }
    EXPQ(s0, 4);
    SB_();
    if (DO_PV) o0 = mfma32(va3, pp[3], o0);
    EXPQ(s0, 8);
    SB_();
    if (DO_PV) o1 = mfma32(vb3, pp[3], o1);
    EXPQ(s0, 12);
    SB_();
    if (DO_QK) { n0 = mfma32(ka0, qf[0], (f32x16){0.f, 0.f, 0.f, 0.f, 0.f, 0.f, 0.f, 0.f, 0.f, 0.f, 0.f, 0.f, 0.f, 0.f, 0.f, 0.f}); ka2 = KFRAG(2, 0); kb2 = KFRAG(2, 1); }
    EXPQ(s1, 0);
    SB_();
    if (DO_QK) { n1 = mfma32(kb0, qf[0], (f32x16){0.f, 0.f, 0.f, 0.f, 0.f, 0.f, 0.f, 0.f, 0.f, 0.f, 0.f, 0.f, 0.f, 0.f, 0.f, 0.f}); ka3 = KFRAG(3, 0); kb3 = KFRAG(3, 1); }
    EXPQ(s1, 4);
    SB_();
    if (DO_QK) n0 = mfma32(ka1, qf[1], n0);
    EXPQ(s1, 8);
    SB_();
    if (DO_QK) n1 = mfma32(kb1, qf[1], n1);
    EXPQ(s1, 12);
    SB_();
    if (DO_QK) n0 = mfma32(ka2, qf[2], n0);
    pc[0] = PACK8(s0, 0);
    SB_();
    if (DO_QK) n1 = mfma32(kb2, qf[2], n1);
    pc[1] = PACK8(s0, 8);
    SB_();
    if (DO_QK) n0 = mfma32(ka3, qf[3], n0);
    pc[2] = PACK8(s1, 0);
    SB_();
    if (DO_QK) n1 = mfma32(kb3, qf[3], n1);
    pc[3] = PACK8(s1, 8);
    if (FIXM) lsum += rs2.x + rs2.y; else lsum = lsum * alpha + rs;
    SB_();
    if (!FIXM) {
        if (__builtin_amdgcn_ballot_w64(need)) {
#pragma unroll
            for (int i = 0; i < 16; ++i) { o0[i] *= alpha; o1[i] *= alpha; }
        }
    }
}

template <bool FIXM>
DI void attn_item(const bf16_t* __restrict__ Q, int ldq, const bf16_t* __restrict__ K, int ldk, const bf16_t* __restrict__ VT, int ldv,
                  int nkeys, bf16_t* __restrict__ O, const bf16_t* __restrict__ G, unsigned char* smem, float mfix) {
    const int tid = opaque_tid(), lane = tid & 63, wave = tid >> 6;
    const int r = lane & 31, h = lane >> 5;
    bf16x8 qf[4];
    {
        const bf16_t* qp = Q + (size_t)(wave * 32 + r) * ldq + h * 8;
#pragma unroll
        for (int ks = 0; ks < 4; ++ks) qf[ks] = *(const bf16x8*)(qp + ks * 16);
    }
    const int lrow = tid >> 3, lc = tid & 7;
    const bf16_t* Kg = K + (size_t)lrow * ldk + lc * 8;
    const bf16_t* Vg = VT + (size_t)lrow * ldv + lc * 8;
    const int st_off = lrow * 128 + ((lc ^ ((lrow >> 1) & 7)) << 4);
    const int pr = (r & ~12) | ((r & 4) << 1) | ((r & 8) >> 1);
    const int kswz = (pr >> 1) & 7, vswz = (r >> 1) & 7;
    const int k_off = pr * 128, v_off = r * 128;
    const int nt = nkeys >> 6;

    f32x16 o0, o1, sa0, sa1, sb0, sb1;
#pragma unroll
    for (int i = 0; i < 16; ++i) { o0[i] = 0.f; o1[i] = 0.f; }
    float m = FIXM ? mfix : -1e30f, lsum = 0.f;
    bf16x8 pa[4], pb[4];

    u32x4 rk, rv;
#define A_LOAD(U) { const int kt_ = ((U) + 2 < nt) ? (U) + 2 : nt - 1; rk = *(const u32x4*)(Kg + (size_t)(kt_ * 64) * ldk); rv = *(const u32x4*)(Vg + (U) * 64); }
#define A_STORE(OFF) { *(u32x4*)(smem + (OFF) + st_off) = rk; *(u32x4*)(smem + (OFF) + 8192 + st_off) = rv; }
    rk = *(const u32x4*)(Kg); rv = *(const u32x4*)(Kg + (size_t)64 * ldk);
    __syncthreads();
    A_STORE(16384);
    A_LOAD(0);
    A_STORE(0);
    A_LOAD(1);
    lds_barrier();
    {
        const unsigned char* kp = smem + 16384;
        sa0 = mfma32(KFRAG(0, 0), qf[0], (f32x16){0.f, 0.f, 0.f, 0.f, 0.f, 0.f, 0.f, 0.f, 0.f, 0.f, 0.f, 0.f, 0.f, 0.f, 0.f, 0.f});
        sa1 = mfma32(KFRAG(0, 1), qf[0], (f32x16){0.f, 0.f, 0.f, 0.f, 0.f, 0.f, 0.f, 0.f, 0.f, 0.f, 0.f, 0.f, 0.f, 0.f, 0.f, 0.f});
#pragma unroll
        for (int ks = 1; ks < 4; ++ks) { sa0 = mfma32(KFRAG(ks, 0), qf[ks], sa0); sa1 = mfma32(KFRAG(ks, 1), qf[ks], sa1); }
    }
    attn_step<false, true, FIXM>(sa0, sa1, sb0, sb1, pb, pa, o0, o1, m, lsum, qf, smem + 16384 + 8192, smem, k_off, kswz, v_off, vswz, h);
    lds_barrier();
    for (int t = 1; t < nt - 1; t += 2) {
        A_STORE(16384);
        A_LOAD(t + 1);
        SB_();
        attn_step<true, true, FIXM>(sb0, sb1, sa0, sa1, pa, pb, o0, o1, m, lsum, qf, smem, smem + 8192, k_off, kswz, v_off, vswz, h);
        lds_barrier();
        A_STORE(0);
        A_LOAD(t + 2);
        SB_();
        attn_step<true, true, FIXM>(sa0, sa1, sb0, sb1, pb, pa, o0, o1, m, lsum, qf, smem + 16384, smem + 16384 + 8192, k_off, kswz, v_off, vswz, h);
        lds_barrier();
    }
    A_STORE(16384);
    const bf16_t* gp = G + (size_t)(wave * 32 + r) * INW + 4 * h;
    u32x2 gga[4], ggb[4];
#pragma unroll
    for (int gq = 0; gq < 4; ++gq) { gga[gq] = *(const u32x2*)(gp + 8 * gq); ggb[gq] = *(const u32x2*)(gp + 32 + 8 * gq); }
    SB_();
    attn_step<true, false, FIXM>(sb0, sb1, sa0, sa1, pa, pb, o0, o1, m, lsum, qf, smem, smem + 8192, k_off, kswz, v_off, vswz, h);
    lds_barrier();
    {
        const unsigned char* vp = smem + 16384 + 8192;
#pragma unroll
        for (int kk = 0; kk < 4; ++kk) { o0 = mfma32(VFRAG(kk, 0), pb[kk], o0); o1 = mfma32(VFRAG(kk, 1), pb[kk], o1); }
    }
#undef A_LOAD
#undef A_STORE
    const float lt = lsum + __shfl_xor(lsum, 32);
    const float inv = 1.0f / lt;
    bf16_t* op = O + (size_t)(wave * 32 + r) * 1024 + 4 * h;
#pragma unroll
    for (int gq = 0; gq < 4; ++gq) {
        {
            const u32x2 gg = gga[gq];
            u32x2 w;
            w.x = pk_bf16(o0[4 * gq] * inv * bflo(gg.x), o0[4 * gq + 1] * inv * bfhi(gg.x));
            w.y = pk_bf16(o0[4 * gq + 2] * inv * bflo(gg.y), o0[4 * gq + 3] * inv * bfhi(gg.y));
            *(u32x2*)(op + 8 * gq) = w;
        }
        {
            const u32x2 gg = ggb[gq];
            u32x2 w;
            w.x = pk_bf16(o1[4 * gq] * inv * bflo(gg.x), o1[4 * gq + 1] * inv * bfhi(gg.x));
            w.y = pk_bf16(o1[4 * gq + 2] * inv * bflo(gg.y), o1[4 * gq + 3] * inv * bfhi(gg.y));
            *(u32x2*)(op + 32 + 8 * gq) = w;
        }
    }
}

DI void cross_item(const bf16_t* __restrict__ Q, const bf16_t* __restrict__ K, const bf16_t* __restrict__ VT,
                   bf16_t* __restrict__ O, const bf16_t* __restrict__ G, unsigned char* smem) {
    const int tid = opaque_tid(), lane = tid & 63, wave = tid >> 6;
    const int r = lane & 31, h = lane >> 5;
    bf16x8 qf[4];
    {
        const bf16_t* qp = Q + (size_t)(wave * 32 + r) * INW + h * 8;
#pragma unroll
        for (int ks = 0; ks < 4; ++ks) qf[ks] = *(const bf16x8*)(qp + ks * 16);
    }
    const int lrow = tid >> 3, lc = tid & 7;
    const int st_off = lrow * 128 + ((lc ^ ((lrow >> 1) & 7)) << 4);
    {
        u32x4 kk[4], vv[4];
#pragma unroll
        for (int i = 0; i < 4; ++i) { kk[i] = *(const u32x4*)(K + (size_t)(lrow + 64 * i) * 256 + lc * 8); vv[i] = *(const u32x4*)(VT + (size_t)lrow * 256 + (i * 8 + lc) * 8); }
        __syncthreads();
#pragma unroll
        for (int i = 0; i < 4; ++i) { *(u32x4*)(smem + i * 16384 + st_off) = kk[i]; *(u32x4*)(smem + i * 16384 + 8192 + st_off) = vv[i]; }
    }
    const bf16_t* gp = G + (size_t)(wave * 32 + r) * INW + 4 * h;
    u32x2 gga[4], ggb[4];
#pragma unroll
    for (int gq = 0; gq < 4; ++gq) { gga[gq] = *(const u32x2*)(gp + 8 * gq); ggb[gq] = *(const u32x2*)(gp + 32 + 8 * gq); }
    __syncthreads();
    const int pr = (r & ~12) | ((r & 4) << 1) | ((r & 8) >> 1);
    const int kswz = (pr >> 1) & 7, vswz = (r >> 1) & 7;
    const int k_off = pr * 128, v_off = r * 128;
    f32x16 o0, o1;
#pragma unroll
    for (int i = 0; i < 16; ++i) { o0[i] = 0.f; o1[i] = 0.f; }
    float m = -1e30f, lsum = 0.f;
#pragma unroll 1
    for (int kt = 0; kt < 4; ++kt) {
        const unsigned char* kp = smem + kt * 16384;
        const unsigned char* vp = kp + 8192;
        f32x16 s0, s1;
        s0 = mfma32(KFRAG(0, 0), qf[0], (f32x16){0.f, 0.f, 0.f, 0.f, 0.f, 0.f, 0.f, 0.f, 0.f, 0.f, 0.f, 0.f, 0.f, 0.f, 0.f, 0.f});
        s1 = mfma32(KFRAG(0, 1), qf[0], (f32x16){0.f, 0.f, 0.f, 0.f, 0.f, 0.f, 0.f, 0.f, 0.f, 0.f, 0.f, 0.f, 0.f, 0.f, 0.f, 0.f});
#pragma unroll
        for (int ks = 1; ks < 4; ++ks) { s0 = mfma32(KFRAG(ks, 0), qf[ks], s0); s1 = mfma32(KFRAG(ks, 1), qf[ks], s1); }
        float mx = s0[0];
        mx = max8(s0, 0, mx); mx = max8(s0, 8, mx); mx = max8(s1, 0, mx); mx = max8(s1, 8, mx);
        mx = xhalf_max(mx);
        const float mnew = fmaxf(m, mx);
        const float alpha = __builtin_amdgcn_exp2f((m - mnew) * L2E);
        m = mnew;
        const float mb = mnew * L2E;
        float rs = 0.f;
#pragma unroll
        for (int i = 0; i < 16; ++i) { s0[i] = __builtin_amdgcn_exp2f(s0[i] * L2E - mb); s1[i] = __builtin_amdgcn_exp2f(s1[i] * L2E - mb); rs += s0[i] + s1[i]; }
        lsum = lsum * alpha + rs;
#pragma unroll
        for (int i = 0; i < 16; ++i) { o0[i] *= alpha; o1[i] *= alpha; }
        bf16x8 pf[4];
        pf[0] = PACK8(s0, 0); pf[1] = PACK8(s0, 8); pf[2] = PACK8(s1, 0); pf[3] = PACK8(s1, 8);
#pragma unroll
        for (int kk2 = 0; kk2 < 4; ++kk2) { o0 = mfma32(VFRAG(kk2, 0), pf[kk2], o0); o1 = mfma32(VFRAG(kk2, 1), pf[kk2], o1); }
    }
    const float lt = lsum + __shfl_xor(lsum, 32);
    const float inv = 1.0f / lt;
    bf16_t* op = O + (size_t)(wave * 32 + r) * 1024 + 4 * h;
#pragma unroll
    for (int gq = 0; gq < 4; ++gq) {
        {
            const u32x2 gg = gga[gq];
            u32x2 w;
            w.x = pk_bf16(o0[4 * gq] * inv * bflo(gg.x), o0[4 * gq + 1] * inv * bfhi(gg.x));
            w.y = pk_bf16(o0[4 * gq + 2] * inv * bflo(gg.y), o0[4 * gq + 3] * inv * bfhi(gg.y));
            *(u32x2*)(op + 8 * gq) = w;
        }
        {
            const u32x2 gg = ggb[gq];
            u32x2 w;
            w.x = pk_bf16(o1[4 * gq] * inv * bflo(gg.x), o1[4 * gq + 1] * inv * bfhi(gg.x));
            w.y = pk_bf16(o1[4 * gq + 2] * inv * bflo(gg.y), o1[4 * gq + 3] * inv * bfhi(gg.y));
            *(u32x2*)(op + 32 + 8 * gq) = w;
        }
    }
}

DI void pool_item(const bf16_t* __restrict__ Z, const bf16_t* __restrict__ PWT, const float* __restrict__ pscale, bf16_t* __restrict__ MIX,
                  int tokg0, unsigned char* smem) {
    const int tid = opaque_tid(), lane = tid & 63, wave = tid >> 6;
    const int T = (tokg0 < NPROMPT) ? 2048 : 4096;
    const int t0 = tokg0 & (T - 1);
    constexpr int RS = 528;
    __syncthreads();
    for (int id = tid; id < 80 * 32; id += 512) {
        const int rr = id >> 5, c = id & 31;
        const int t = t0 - 8 + rr;
        u32x4 v = (u32x4){0u, 0u, 0u, 0u};
        if (t >= 0 && t < T) v = *(const u32x4*)(Z + (size_t)(tokg0 - 8 + rr) * INW + c * 8);
        *(u32x4*)(smem + rr * RS + c * 16) = v;
    }
    __syncthreads();
    const int g = wave & 3, half = 1 << g;
    const int r16 = lane & 15, q4 = lane >> 4;
    const bf16_t* pw = PWT + (size_t)g * 4096 + r16 * 64 + q4 * 8;
    {
        const int th = wave >> 2;
        bf16x8 df[2][2];
#pragma unroll
        for (int t2 = 0; t2 < 2; ++t2)
#pragma unroll
            for (int ks = 0; ks < 2; ++ks) {
                const int tl = (th * 2 + t2) * 16 + r16, t = t0 + tl;
                const int lo = max(t - half, 0), hi = min(t + half, T);
                const float icnt = 1.0f / (float)(hi - lo);
                float s[8];
#pragma unroll
                for (int j = 0; j < 8; ++j) s[j] = 0.f;
                const unsigned char* bp = smem + (tl + 8 - half) * RS + (g * 64 + ks * 32 + q4 * 8) * 2;
                for (int j = 0; j < 2 * half; ++j) {
                    const u32x4 v = *(const u32x4*)(bp + j * RS);
                    s[0] += bflo(v.x); s[1] += bfhi(v.x); s[2] += bflo(v.y); s[3] += bfhi(v.y);
                    s[4] += bflo(v.z); s[5] += bfhi(v.z); s[6] += bflo(v.w); s[7] += bfhi(v.w);
                }
                const u32x4 c = *(const u32x4*)(bp + half * RS);
                u32x4 o;
                o.x = pk_bf16(s[0] * icnt - bflo(c.x), s[1] * icnt - bfhi(c.x));
                o.y = pk_bf16(s[2] * icnt - bflo(c.y), s[3] * icnt - bfhi(c.y));
                o.z = pk_bf16(s[4] * icnt - bflo(c.z), s[5] * icnt - bfhi(c.z));
                o.w = pk_bf16(s[6] * icnt - bflo(c.w), s[7] * icnt - bfhi(c.w));
                df[t2][ks] = __builtin_bit_cast(bf16x8, o);
            }
        f32x4 acc[4][2];
#pragma unroll
        for (int i = 0; i < 4; ++i)
#pragma unroll
            for (int j = 0; j < 2; ++j) acc[i][j] = (f32x4){0.f, 0.f, 0.f, 0.f};
#pragma unroll
        for (int fi = 0; fi < 4; ++fi)
#pragma unroll
            for (int ks = 0; ks < 2; ++ks) {
                const bf16x8 wf = *(const bf16x8*)(pw + fi * 16 * 64 + ks * 32);
#pragma unroll
                for (int t2 = 0; t2 < 2; ++t2) acc[fi][t2] = mfma16(wf, df[t2][ks], acc[fi][t2]);
            }
#pragma unroll
        for (int t2 = 0; t2 < 2; ++t2) {
            const size_t tok = (size_t)tokg0 + (th * 2 + t2) * 16 + r16;
#pragma unroll
            for (int fi = 0; fi < 4; ++fi) {
                const int n = g * 64 + fi * 16 + 4 * q4;
                const f32x4 ps = *(const f32x4*)(pscale + n);
                const u32x2 gg = *(const u32x2*)(Z + tok * INW + 256 + n);
                u32x2 w;
                w.x = pk_bf16(acc[fi][t2][0] * ps[0] * bflo(gg.x), acc[fi][t2][1] * ps[1] * bfhi(gg.x));
                w.y = pk_bf16(acc[fi][t2][2] * ps[2] * bflo(gg.y), acc[fi][t2][3] * ps[3] * bfhi(gg.y));
                *(u32x2*)(MIX + tok * 1024 + n) = w;
            }
        }
    }
}

DI void post_row(const float* __restrict__ xsrc, bf16_t* __restrict__ yh, const float* __restrict__ gpost, const float* __restrict__ gpre_next,
                 float* __restrict__ xdst, bool last, int lane) {
    u32x4 yv[2]; f32x4 xv[4];
#pragma unroll
    for (int j = 0; j < 2; ++j) yv[j] = *(const u32x4*)(yh + j * 512 + lane * 8);
#pragma unroll
    for (int j = 0; j < 2; ++j) { xv[2 * j] = *(const f32x4*)(xsrc + j * 512 + lane * 8); xv[2 * j + 1] = *(const f32x4*)(xsrc + j * 512 + lane * 8 + 4); }
    float y[16];
#pragma unroll
    for (int j = 0; j < 2; ++j) {
        y[8 * j + 0] = bflo(yv[j].x); y[8 * j + 1] = bfhi(yv[j].x); y[8 * j + 2] = bflo(yv[j].y); y[8 * j + 3] = bfhi(yv[j].y);
        y[8 * j + 4] = bflo(yv[j].z); y[8 * j + 5] = bfhi(yv[j].z); y[8 * j + 6] = bflo(yv[j].w); y[8 * j + 7] = bfhi(yv[j].w);
    }
    float ss = 0.f;
#pragma unroll
    for (int i = 0; i < 16; ++i) ss += y[i] * y[i];
    ss = wave_sum(ss);
    const float r = rsqrtf(ss * (1.0f / 1024.0f) + EPS);
    float xn[16]; float ss2 = 0.f;
#pragma unroll
    for (int j = 0; j < 2; ++j) {
        const f32x4 g0 = *(const f32x4*)(gpost + j * 512 + lane * 8), g1 = *(const f32x4*)(gpost + j * 512 + lane * 8 + 4);
#pragma unroll
        for (int i = 0; i < 4; ++i) {
            xn[8 * j + i] = xv[2 * j][i] + y[8 * j + i] * r * g0[i];
            xn[8 * j + 4 + i] = xv[2 * j + 1][i] + y[8 * j + 4 + i] * r * g1[i];
        }
    }
#pragma unroll
    for (int i = 0; i < 16; ++i) ss2 += xn[i] * xn[i];
#pragma unroll
    for (int j = 0; j < 2; ++j) {
        *(f32x4*)(xdst + j * 512 + lane * 8) = (f32x4){xn[8 * j], xn[8 * j + 1], xn[8 * j + 2], xn[8 * j + 3]};
        *(f32x4*)(xdst + j * 512 + lane * 8 + 4) = (f32x4){xn[8 * j + 4], xn[8 * j + 5], xn[8 * j + 6], xn[8 * j + 7]};
    }
    if (!last) {
        ss2 = wave_sum(ss2);
        const float r2 = rsqrtf(ss2 * (1.0f / 1024.0f) + EPS);
#pragma unroll
        for (int j = 0; j < 2; ++j) {
            const f32x4 g0 = *(const f32x4*)(gpre_next + j * 512 + lane * 8), g1 = *(const f32x4*)(gpre_next + j * 512 + lane * 8 + 4);
            u32x4 o;
            o.x = pk_bf16(xn[8 * j] * r2 * g0[0], xn[8 * j + 1] * r2 * g0[1]);
            o.y = pk_bf16(xn[8 * j + 2] * r2 * g0[2], xn[8 * j + 3] * r2 * g0[3]);
            o.z = pk_bf16(xn[8 * j + 4] * r2 * g1[0], xn[8 * j + 5] * r2 * g1[1]);
            o.w = pk_bf16(xn[8 * j + 6] * r2 * g1[2], xn[8 * j + 7] * r2 * g1[3]);
            *(u32x4*)(yh + j * 512 + lane * 8) = o;
        }
    }
}

#define XB_TMO      128
#define XB_XCNT(j)  (256  + 64 * (j))
#define XB_XSUB(j)  (1280 + 64 * (j))
#define XB_XGEN(j)  (2304 + 64 * (j))
#define XB_TOP      3328
#define XB_TOPGEN   3392
#define XCD_BAR_WORDS 3456
#define XB_SPIN_CAP (1u << 18)
#define LAS __attribute__((address_space(3)))
DI unsigned xb_ld(unsigned* p)              { return __hip_atomic_load(p, __ATOMIC_RELAXED, __HIP_MEMORY_SCOPE_AGENT); }
DI unsigned xb_add(unsigned* p, unsigned v) { return __hip_atomic_fetch_add(p, v, __ATOMIC_RELAXED, __HIP_MEMORY_SCOPE_AGENT); }
DI unsigned xb_xcc_id() { return (unsigned)__builtin_amdgcn_s_getreg((3 << 11) | 20) & 0xFu; }
#define XB_SPIN(cond, bar) do { unsigned _sp = 0; while (cond) { __builtin_amdgcn_s_sleep(1); \
    if ((++_sp & 255u) == 0u) { if (xb_ld(&(bar)[XB_TMO])) break; if (_sp > XB_SPIN_CAP) { atomicAdd(&(bar)[XB_TMO], 1u); break; } } } } while (0)
struct XcdBarrier { unsigned* bar; unsigned x; volatile LAS unsigned* st; };
DI XcdBarrier xcd_barrier_post(unsigned* bar, volatile LAS unsigned* st) {
    XcdBarrier b; b.bar = bar; b.x = xb_xcc_id(); b.st = st;
    if (threadIdx.x == 0) (void)xb_add(&bar[XB_XCNT(b.x)], 1u);
    return b;
}
DI void xcd_barrier_complete(unsigned* bar, unsigned x, unsigned& nloc, unsigned& nx) {
    const unsigned G = gridDim.x * gridDim.y * gridDim.z;
    unsigned sum, cnt, mine, sp = 0u;
    for (;;) {
        sum = 0u; cnt = 0u; mine = 0u;
#pragma unroll
        for (unsigned j = 0; j < 16; ++j) { const unsigned c = xb_ld(&bar[XB_XCNT(j)]); sum += c; cnt += (c > 0u) ? 1u : 0u; mine = (j == x) ? c : mine; }
        if (sum == G) break;
        __builtin_amdgcn_s_sleep(1);
        if ((++sp & 255u) == 0u) { if (xb_ld(&bar[XB_TMO])) break; if (sp > XB_SPIN_CAP) { atomicAdd(&bar[XB_TMO], 1u); break; } }
    }
    nloc = mine > 0u ? mine : 1u; nx = cnt > 0u ? cnt : 1u;
}
DI void xcd_barrier(const XcdBarrier& b) {
    asm volatile("s_waitcnt vmcnt(0)" ::: "memory");
    __syncthreads();
    if (threadIdx.x == 0) {
        unsigned* bar = b.bar;
        __builtin_amdgcn_s_waitcnt(0);
        unsigned nloc = b.st[0], nx = b.st[1];
        if (nloc == 0u) { xcd_barrier_complete(bar, b.x, nloc, nx); b.st[0] = nloc; b.st[1] = nx; }
        const unsigned old = xb_add(&bar[XB_XSUB(b.x)], 1u);
        const unsigned gen = old / nloc;
        if (old + 1u == (gen + 1u) * nloc) {
            __builtin_amdgcn_fence(__ATOMIC_RELEASE, "agent");
            asm volatile("s_waitcnt vmcnt(0)" ::: "memory");
            const unsigned og = xb_add(&bar[XB_TOP], 1u);
            const unsigned tg = og / nx;
            if (og + 1u == (tg + 1u) * nx) xb_add(&bar[XB_TOPGEN], 1u);
            else XB_SPIN(xb_ld(&bar[XB_TOPGEN]) == tg, bar);
            __builtin_amdgcn_fence(__ATOMIC_ACQUIRE, "agent");
            xb_add(&bar[XB_XGEN(b.x)], 1u);
            asm volatile("s_waitcnt vmcnt(0)" ::: "memory");
        } else {
            XB_SPIN(xb_ld(&bar[XB_XGEN(b.x)]) == gen, bar);
            __builtin_amdgcn_fence(__ATOMIC_ACQUIRE, "agent");
            asm volatile("s_waitcnt vmcnt(0)" ::: "memory");
        }
    }
    __syncthreads();
}

__global__ void __launch_bounds__(512, 2) fwd_megakernel(Params p) {
    __shared__ __attribute__((aligned(16))) unsigned char smem[131072];
    __shared__ uint4 xb_words;
    cg::grid_group grid = cg::this_grid();
    const int nb = gridDim.x, bid = blockIdx.x;
    if (threadIdx.x == 0) xb_words = make_uint4(0u, 0u, 0u, 0u);
    __syncthreads();
    XcdBarrier xb = xcd_barrier_post((unsigned*)(p.ws + OFF_BAR), (volatile LAS unsigned*)&xb_words);
    if (p.phase_end > 1000) grid.sync();
    for (int ph = p.phase_begin; ph < p.phase_end; ++ph) {
        const int tid = opaque_tid(), lane = tid & 63, wave = tid >> 6;
        unsigned char* ws = p.ws;
        bf16_t* H = (bf16_t*)(ws + OFF_H);
        bf16_t* Z = (bf16_t*)(ws + OFF_Z);
        bf16_t* VT = (bf16_t*)(ws + OFF_VT);
        bf16_t* MIX = (bf16_t*)(ws + OFF_MIX);
        bf16_t* WIN = (bf16_t*)(ws + OFF_WIN);
        bf16_t* WOUT = (bf16_t*)(ws + OFF_WOUT);
        bf16_t* WMEM = (bf16_t*)(ws + OFF_WMEM);
        bf16_t* PW = (bf16_t*)(ws + OFF_PW);
        bf16_t* MH = (bf16_t*)(ws + OFF_MH);
        bf16_t* KM = (bf16_t*)(ws + OFF_KM);
        bf16_t* VMT = (bf16_t*)(ws + OFF_VMT);
        float* ROPE = (float*)(ws + OFF_ROPE);
        if (ph == 0) {
            for (int i = bid; i < 1928; i += nb) {
                if (i < 1152) { const int l = i / 576, j = i % 576, kt = j / 36, ntile = j % 36;
                    transpose_tile(p.w_in + (size_t)l * DM * INW, INW, WIN + (size_t)l * INW * DM, DM, kt * 64, ntile * 64, smem);
                } else if (i < 1664) { const int ii = i - 1152, l = ii / 256, j = ii % 256, kt = j / 16, ntile = j % 16;
                    transpose_tile(p.w_out + (size_t)l * DM * DM, DM, WOUT + (size_t)l * DM * DM, DM, kt * 64, ntile * 64, smem);
                } else if (i < 1920) { const int ii = i - 1664, l = ii / 128, j = ii % 128, kt = j / 8, ntile = j % 8;
                    transpose_tile(p.w_mem_kv + (size_t)l * DM * 512, 512, WMEM + (size_t)l * 512 * DM, DM, kt * 64, ntile * 64, smem);
                } else { const int ii = i - 1920;
                    transpose_tile(p.pool_w + (size_t)ii * 4096, 64, PW + (size_t)ii * 4096, 64, 0, 0, smem);
                }
            }
            for (int i = bid * 8 + wave; i < NTOK + 2 * NMEMTOK; i += nb * 8) {
                if (i < NTOK) {
                    const float* src = (i < NPROMPT) ? p.x_prompt + (size_t)i * DM : p.x_sample + (size_t)(i - NPROMPT) * DM;
                    rms_row_f32(src, p.norm_pre, H + (size_t)i * DM, lane);
                } else {
                    const int ii = i - NTOK, l = ii / NMEMTOK, mt = ii % NMEMTOK;
                    const float* src = (mt < 4096) ? p.mem_prompt + (size_t)mt * DM : p.mem_sample + (size_t)(mt - 4096) * DM;
                    rms_row_f32(src, p.mem_norm + l * DM, MH + ((size_t)l * NMEMTOK + mt) * DM, lane);
                }
            }
            for (int i = bid * 512 + tid; i < 1024; i += nb * 512) rope_entry(i, ROPE);
        } else {
            const int l = (ph - 1) >> 2, sub = (ph - 1) & 3;
            if (sub == 0) {
                EpiArgs e; e.C = Z; e.VT = VT; e.qn = p.q_norm + l * 64; e.kn = p.k_norm + l * 64; e.rope = ROPE;
                const bf16_t* Wl = WIN + (size_t)l * INW * DM;
                EpiArgs e2; e2.C = KM + (size_t)l * NMEMTOK * 256; e2.VT = VMT + (size_t)l * NMEMTOK * 256; e2.qn = nullptr; e2.kn = nullptr; e2.rope = nullptr;
                const bf16_t* Wm = WMEM + (size_t)l * 512 * DM;
                const bf16_t* Am = MH + (size_t)l * NMEMTOK * DM;
                for (int i = bid; i < 1728 + 40; i += nb) {
                    if (i < 1728) {
                        const int j = i >> 3, mg = j / 72, rem = j % 72;
                        const int mt = (i & 7) * 24 + mg * 8 + (rem & 7), ntile = rem >> 3;
                        gemm_tile<0>(H, Wl, mt * 256, ntile * 256, e, smem);
                    } else {
                        const int j = i - 1728;
                        gemm_tile<2>(Am, Wm, (j >> 1) * 256, (j & 1) * 256, e2, smem);
                    }
                }
            } else if (sub == 1) {
                float gq = fabsf(p.q_norm[l * 64 + lane]), gk = fabsf(p.k_norm[l * 64 + lane]);
#pragma unroll
                for (int o = 1; o < 64; o <<= 1) { gq = fmaxf(gq, __shfl_xor(gq, o)); gk = fmaxf(gk, __shfl_xor(gk, o)); }
                const float mfix = 8.0f * gq * gk * 1.02f;
                const bool fixm = mfix < 20.0f;
                for (int i = bid; i < 3072; i += nb) {
                    if (i < 1536) {
                        int b, kvh, j, T; size_t tok0, vtb;
                        if (i < 512) { const int R = i >> 8, ip = i & 255, grp = ip & 7; j = R * 32 + (ip >> 3); b = grp >> 1; kvh = grp & 1; T = 4096;
                            tok0 = (size_t)NPROMPT + (size_t)b * 4096; vtb = (size_t)NPROMPT * 128 + ((size_t)(b * 2 + kvh) * 64) * 4096; }
                        else { const int ii = i - 512, R = ii >> 8, ip = ii & 255, grp = R * 8 + (ip & 7); j = ip >> 3; b = grp >> 1; kvh = grp & 1; T = 2048;
                            tok0 = (size_t)b * 2048; vtb = ((size_t)(b * 2 + kvh) * 64) * 2048; }
                        const int qblk = j >> 2, head = kvh * 4 + (j & 3);
                        const size_t q0 = tok0 + (size_t)qblk * 256;
                        if (fixm) attn_item<true>(Z + q0 * INW + 512 + head * 64, INW, Z + tok0 * INW + 1024 + kvh * 64, INW, VT + vtb, T, T,
                                  MIX + q0 * 1024 + 256 + head * 64, Z + q0 * INW + 1280 + head * 64, smem, mfix);
                        else attn_item<false>(Z + q0 * INW + 512 + head * 64, INW, Z + tok0 * INW + 1024 + kvh * 64, INW, VT + vtb, T, T,
                                  MIX + q0 * 1024 + 256 + head * 64, Z + q0 * INW + 1280 + head * 64, smem, 0.f);
                    } else if (i < 2304) {
                        const int ii = i - 1536, qb = ii >> 2, hx = ii & 3;
                        const size_t q0 = (size_t)qb * 256;
                        const int b = (q0 < NPROMPT) ? (int)(q0 >> 11) : 16 + (int)((q0 - NPROMPT) >> 12);
cross_item(Z + q0 * INW + 1792 + hx * 64, KM + ((size_t)l * NMEMTOK + (size_t)b * 256) * 256 + hx * 64,
                                   VMT + (size_t)l * NMEMTOK * 256 + ((size_t)(b * 4 + hx) * 64) * 256,
                                   MIX + q0 * 1024 + 768 + hx * 64, Z + q0 * INW + 2048 + hx * 64, smem);
                    } else {
                        pool_item(Z, PW + (size_t)l * 4 * 4096, p.pool_scale + l * 256, MIX, (i - 2304) * 64, smem);
                    }
                }
            } else if (sub == 2) {
                EpiArgs e; e.C = H; e.VT = nullptr; e.qn = nullptr; e.kn = nullptr; e.rope = nullptr;
                const bf16_t* Wl = WOUT + (size_t)l * DM * DM;
                for (int i = bid; i < 768; i += nb) {
                    const int j = i >> 3, mg = j >> 5, rem = j & 31;
                    const int mt = (i & 7) * 24 + mg * 8 + (rem & 7), ntile = rem >> 3;
                    gemm_tile<1>(MIX, Wl, mt * 256, ntile * 256, e, smem);
                }
            } else {
                const bool last = (l == DEPTH - 1);
                for (int i = bid * 8 + wave; i < NTOK; i += nb * 8) {
                    const float* xs = (l == 0) ? ((i < NPROMPT) ? p.x_prompt + (size_t)i * DM : p.x_sample + (size_t)(i - NPROMPT) * DM) : p.out + (size_t)i * DM;
                    post_row(xs, H + (size_t)i * DM, p.norm_post + l * DM, p.norm_pre + (last ? l : l + 1) * DM, p.out + (size_t)i * DM, last, lane);
                }
            }
        }
        if (ph + 1 < p.phase_end) xcd_barrier(xb);
    }
}

extern "C" void kernel_launch(void* const* d_in, const int* in_sizes, int n_in, void* d_out, int out_size, void* d_ws, size_t ws_size,
                              hipStream_t stream) {
    static int grid_blocks = 0;
    if (!grid_blocks) {
        int dev = 0, cus = 0, per_cu = 0;
        hipGetDevice(&dev);
        hipDeviceGetAttribute(&cus, hipDeviceAttributeMultiprocessorCount, dev);
        hipOccupancyMaxActiveBlocksPerMultiprocessor(&per_cu, fwd_megakernel, 512, 0);
        if (per_cu > 1) per_cu = 1;
        if (per_cu < 1) per_cu = 1;
        grid_blocks = cus * per_cu;
    }
    Params p{};
    p.x_prompt = (const float*)d_in[0]; p.x_sample = (const float*)d_in[1]; p.mem_prompt = (const float*)d_in[2]; p.mem_sample = (const float*)d_in[3];
    p.norm_pre = (const float*)d_in[4]; p.norm_post = (const float*)d_in[5]; p.w_in = (const float*)d_in[6]; p.pool_w = (const float*)d_in[7];
    p.pool_scale = (const float*)d_in[8]; p.q_norm = (const float*)d_in[9]; p.k_norm = (const float*)d_in[10]; p.mem_norm = (const float*)d_in[11];
    p.w_mem_kv = (const float*)d_in[12]; p.w_out = (const float*)d_in[13];
    p.out = (float*)d_out; p.ws = (unsigned char*)d_ws;
    p.phase_begin = 0; p.phase_end = 1 + 4 * DEPTH;
    if (ws_size < WS_TOTAL) { fprintf(stderr, "workspace too small: %zu < %zu\n", ws_size, (size_t)WS_TOTAL); return; }
    hipMemsetAsync((unsigned char*)d_ws + OFF_BAR, 0, BAR_BYTES, stream);
    void* args[] = {&p};
    hipError_t e = hipLaunchCooperativeKernel((void*)fwd_megakernel, dim3(grid_blocks), dim3(512), args, 0, stream);
    if (e != hipSuccess) fprintf(stderr, "cooperative launch failed: %s (grid %d)\n", hipGetErrorString(e), grid_blocks);
}
```

```cpp
#include <hip/hip_runtime.h>
#include <hip/hip_cooperative_groups.h>
#include <stdint.h>
#include <cstdio>
namespace cg = cooperative_groups;

typedef unsigned short bf16_t;
typedef short bf16x8 __attribute__((ext_vector_type(8)));
typedef float f32x4 __attribute__((ext_vector_type(4)));
typedef float f32x16 __attribute__((ext_vector_type(16)));
typedef unsigned u32x4 __attribute__((ext_vector_type(4)));
typedef unsigned u32x2 __attribute__((ext_vector_type(2)));
typedef __bf16 bf16x2_t __attribute__((ext_vector_type(2)));
typedef float f32x2_t __attribute__((ext_vector_type(2)));
#define DI __device__ __forceinline__

constexpr int NTOK = 49152;
constexpr int NPROMPT = 32768;
constexpr int DM = 1024;
constexpr int INW = 2304;
constexpr int NMEMTOK = 5120;
constexpr int DEPTH = 2;
constexpr float EPS = 1e-6f;
constexpr float L2E = 1.4426950408889634f;

constexpr size_t OFF_H    = 0;
constexpr size_t OFF_Z    = OFF_H + (size_t)NTOK * DM * 2;
constexpr size_t OFF_VT   = OFF_Z + (size_t)NTOK * INW * 2;
constexpr size_t OFF_MIX  = OFF_VT + (size_t)NTOK * 128 * 2;
constexpr size_t OFF_WIN  = OFF_MIX + (size_t)NTOK * DM * 2;
constexpr size_t OFF_WOUT = OFF_WIN + (size_t)DEPTH * INW * DM * 2;
constexpr size_t OFF_WMEM = OFF_WOUT + (size_t)DEPTH * DM * DM * 2;
constexpr size_t OFF_PW   = OFF_WMEM + (size_t)DEPTH * 512 * DM * 2;
constexpr size_t OFF_MH   = OFF_PW + (size_t)DEPTH * 4 * 64 * 64 * 2;
constexpr size_t OFF_KM   = OFF_MH + (size_t)DEPTH * NMEMTOK * DM * 2;
constexpr size_t OFF_VMT  = OFF_KM + (size_t)DEPTH * NMEMTOK * 256 * 2;
constexpr size_t OFF_ROPE = OFF_VMT + (size_t)DEPTH * NMEMTOK * 256 * 2;
constexpr size_t OFF_BAR  = OFF_ROPE + 64 * 16 * 2 * 4;
constexpr size_t BAR_BYTES = 3456 * 4;
constexpr size_t WS_TOTAL = OFF_BAR + BAR_BYTES;

struct Params {
    const float* x_prompt; const float* x_sample; const float* mem_prompt; const float* mem_sample;
    const float* norm_pre; const float* norm_post; const float* w_in; const float* pool_w; const float* pool_scale;
    const float* q_norm; const float* k_norm; const float* mem_norm; const float* w_mem_kv; const float* w_out;
    float* out; unsigned char* ws;
    int phase_begin; int phase_end;
};

DI unsigned pk_bf16(float a, float b) {
    f32x2_t v = {a, b};
    bf16x2_t r = __builtin_convertvector(v, bf16x2_t);
    return __builtin_bit_cast(unsigned, r);
}
DI int opaque_tid() { int t = threadIdx.x; asm volatile("" : "+v"(t)); return t; }
DI void lds_barrier() { asm volatile("s_waitcnt lgkmcnt(0)\n\ts_barrier" ::: "memory"); }
DI float bflo(unsigned u) { return __uint_as_float(u << 16); }
DI float bfhi(unsigned u) { return __uint_as_float(u & 0xffff0000u); }
DI float wave_sum(float v) {
    v += __shfl_xor(v, 1); v += __shfl_xor(v, 2); v += __shfl_xor(v, 4);
    v += __shfl_xor(v, 8); v += __shfl_xor(v, 16); v += __shfl_xor(v, 32);
    return v;
}
DI float xhalf_max(float v) {
    auto r = __builtin_amdgcn_permlane32_swap(__float_as_uint(v), __float_as_uint(v), false, false);
    return fmaxf(__uint_as_float(r[0]), __uint_as_float(r[1]));
}
DI float silu_f(float x) { return x * __builtin_amdgcn_rcpf(1.0f + __builtin_amdgcn_exp2f(-x * L2E)); }
DI f32x4 mfma16(bf16x8 a, bf16x8 b, f32x4 c) { return __builtin_amdgcn_mfma_f32_16x16x32_bf16(a, b, c, 0, 0, 0); }
DI f32x16 mfma32(bf16x8 a, bf16x8 b, f32x16 c) { return __builtin_amdgcn_mfma_f32_32x32x16_bf16(a, b, c, 0, 0, 0); }

DI void transpose_tile(const float* __restrict__ src, int ldn, bf16_t* __restrict__ dst, int ldk, int k0, int n0, unsigned char* smem) {
    float* tile = (float*)smem;
    const int tid = opaque_tid();
    __syncthreads();
#pragma unroll
    for (int i = 0; i < 2; ++i) {
        const int id = tid + 512 * i, r = id >> 4, c4 = id & 15;
        const f32x4 v = *(const f32x4*)(src + (size_t)(k0 + r) * ldn + n0 + c4 * 4);
        tile[r * 65 + c4 * 4 + 0] = v[0]; tile[r * 65 + c4 * 4 + 1] = v[1]; tile[r * 65 + c4 * 4 + 2] = v[2]; tile[r * 65 + c4 * 4 + 3] = v[3];
    }
    __syncthreads();
    {
        const int n = tid >> 3, kc = tid & 7;
        float v[8];
#pragma unroll
        for (int j = 0; j < 8; ++j) v[j] = tile[(kc * 8 + j) * 65 + n];
        u32x4 o; o.x = pk_bf16(v[0], v[1]); o.y = pk_bf16(v[2], v[3]); o.z = pk_bf16(v[4], v[5]); o.w = pk_bf16(v[6], v[7]);
        *(u32x4*)(dst + (size_t)(n0 + n) * ldk + k0 + kc * 8) = o;
    }
}

DI void rms_row_f32(const float* __restrict__ src, const float* __restrict__ g, bf16_t* __restrict__ dst, int lane) {
    f32x4 v[4]; float ss = 0.f;
#pragma unroll
    for (int j = 0; j < 4; ++j) { v[j] = *(const f32x4*)(src + j * 256 + lane * 4); ss += v[j][0] * v[j][0] + v[j][1] * v[j][1] + v[j][2] * v[j][2] + v[j][3] * v[j][3]; }
    ss = wave_sum(ss);
    const float r = rsqrtf(ss * (1.0f / 1024.0f) + EPS);
#pragma unroll
    for (int j = 0; j < 4; ++j) {
        const f32x4 gg = *(const f32x4*)(g + j * 256 + lane * 4);
        u32x2 o; o.x = pk_bf16(v[j][0] * r * gg[0], v[j][1] * r * gg[1]); o.y = pk_bf16(v[j][2] * r * gg[2], v[j][3] * r * gg[3]);
        *(u32x2*)(dst + j * 256 + lane * 4) = o;
    }
}

DI void rope_entry(int idx, float* table) {
    const int n = idx >> 4, pp = idx & 15;
    double fd = 1.0;
    for (int i = 0; i < pp; ++i) fd *= 0.5623413251903491;
    const float f = (float)fd;
    const float a = (float)n * f;
    double r = (double)a;
    const double k = rint(r * 0.15915494309189535);
    r -= k * 6.283185307179586;
    const double r2 = r * r;
    double sn = r, cs = 1.0, ts = r, tc = 1.0;
    for (int i = 1; i <= 16; ++i) {
        tc = -tc * r2 / (double)((2 * i - 1) * (2 * i));
        ts = -ts * r2 / (double)((2 * i) * (2 * i + 1));
        cs += tc; sn += ts;
    }
    table[idx * 2] = (float)cs; table[idx * 2 + 1] = (float)sn;
}

struct EpiArgs {
    bf16_t* C;
    bf16_t* VT;
    const float* qn; const float* kn; const float* rope;
};

template <int MODE>
DI void gemm_tile(const bf16_t* __restrict__ A, const bf16_t* __restrict__ Bt, int m0, int n0, const EpiArgs& e, unsigned char* smem) {
    const int tid = opaque_tid(), lane = tid & 63, wave = tid >> 6;
    const int wm = wave >> 2, wn = wave & 3;
    const int lrow = tid >> 3, lc = tid & 7;
    const unsigned char* Ab = (const unsigned char*)(A + (size_t)m0 * 1024);
    const unsigned char* Bb = (const unsigned char*)(Bt + (size_t)n0 * 1024);
    const unsigned goff = (unsigned)(lrow * 1024 + lc * 8) * 2u;
#define GA(I, KT) (*(const u32x4*)(Ab + (goff + (unsigned)((I) * 131072 + (KT) * 128))))
#define GB(I, KT) (*(const u32x4*)(Bb + (goff + (unsigned)((I) * 131072 + (KT) * 128))))
    const int st_off = lrow * 128 + ((lc ^ ((lrow >> 1) & 7)) << 4);
    const int r16 = lane & 15, q4 = lane >> 4;
    const int fr_off = r16 * 128 + ((q4 ^ (r16 >> 1)) << 4);
    const int a_base = 32768 + (wn * 64) * 128;
    const int b_base = (wm * 128) * 128;
    constexpr int TI = 8;

    f32x4 acc[4][TI];
#pragma unroll
    for (int i = 0; i < 4; ++i)
#pragma unroll
        for (int j = 0; j < TI; ++j) acc[i][j] = (f32x4){0.f, 0.f, 0.f, 0.f};

    u32x4 ra[4], rb[4];
#define G_LOAD(KT) { _Pragma("unroll") for (int i = 0; i < 4; ++i) { ra[i] = GA(i, KT); rb[i] = GB(i, KT); } }
#define G_STORE(OFF) { _Pragma("unroll") for (int i = 0; i < 4; ++i) { *(u32x4*)(smem + (OFF) + st_off + i * 8192) = ra[i]; *(u32x4*)(smem + (OFF) + 32768 + st_off + i * 8192) = rb[i]; } }
#define G_STEP(CUR, NXT, KTL, DO_ST, DO_LD) { \
        { bf16x8 wf[4], tf[TI]; \
          _Pragma("unroll") for (int i = 0; i < 4; ++i) wf[i] = *(const bf16x8*)(smem + (CUR) + a_base + i * 2048 + fr_off); \
          _Pragma("unroll") for (int i = 0; i < TI; ++i) tf[i] = *(const bf16x8*)(smem + (CUR) + b_base + i * 2048 + fr_off); \
          _Pragma("unroll") for (int ti = 0; ti < TI; ++ti) { \
              _Pragma("unroll") for (int fi = 0; fi < 4; ++fi) acc[fi][ti] = mfma16(wf[fi], tf[ti], acc[fi][ti]); \
              if (DO_ST) { if (ti < 4) *(u32x4*)(smem + (NXT) + st_off + ti * 8192) = ra[ti]; else *(u32x4*)(smem + (NXT) + 32768 + st_off + (ti - 4) * 8192) = rb[ti - 4]; } \
              __builtin_amdgcn_sched_barrier(0); } } \
        { bf16x8 wf[4], tf[TI]; \
          _Pragma("unroll") for (int i = 0; i < 4; ++i) wf[i] = *(const bf16x8*)(smem + (CUR) + a_base + i * 2048 + (fr_off ^ 64)); \
          _Pragma("unroll") for (int i = 0; i < TI; ++i) tf[i] = *(const bf16x8*)(smem + (CUR) + b_base + i * 2048 + (fr_off ^ 64)); \
          _Pragma("unroll") for (int ti = 0; ti < TI; ++ti) { \
              _Pragma("unroll") for (int fi = 0; fi < 4; ++fi) acc[fi][ti] = mfma16(wf[fi], tf[ti], acc[fi][ti]); \
              if (DO_LD) { if (ti < 4) ra[ti] = GA(ti, KTL); else rb[ti - 4] = GB(ti - 4, KTL); } \
              __builtin_amdgcn_sched_barrier(0); } } }
    G_LOAD(0);
    G_STORE(0);
    G_LOAD(1);
    lds_barrier();
    for (int kt = 0; kt < 14; kt += 2) {
        G_STEP(0, 65536, kt + 2, true, true);
        lds_barrier();
        G_STEP(65536, 0, kt + 3, true, true);
        lds_barrier();
    }
    G_STEP(0, 65536, 0, true, false);
    lds_barrier();
    G_STEP(65536, 0, 0, false, false);
    lds_barrier();
#undef G_LOAD
#undef G_STORE
#undef G_STEP
#undef GA
#undef GB

    const int cb = n0 + wn * 64;
    const int tokb = m0 + wm * 128 + r16;
    if (MODE == 1) {
#pragma unroll
        for (int ti = 0; ti < TI; ++ti) {
            bf16_t* rowp = e.C + (size_t)(tokb + ti * 16) * 1024 + cb + 4 * q4;
#pragma unroll
            for (int fi = 0; fi < 4; ++fi) {
                u32x2 o; o.x = pk_bf16(acc[fi][ti][0], acc[fi][ti][1]); o.y = pk_bf16(acc[fi][ti][2], acc[fi][ti][3]);
                *(u32x2*)(rowp + fi * 16) = o;
            }
        }
    } else if (MODE == 2) {
        if (cb < 256) {
#pragma unroll
            for (int ti = 0; ti < TI; ++ti) {
                bf16_t* rowp = e.C + (size_t)(tokb + ti * 16) * 256 + cb + 4 * q4;
#pragma unroll
                for (int fi = 0; fi < 4; ++fi) {
                    u32x2 o; o.x = pk_bf16(acc[fi][ti][0], acc[fi][ti][1]); o.y = pk_bf16(acc[fi][ti][2], acc[fi][ti][3]);
                    *(u32x2*)(rowp + fi * 16) = o;
                }
            }
        } else {
            const int hx = (cb - 256) >> 6;
#pragma unroll
            for (int ti = 0; ti < TI; ++ti) {
                const int mt = tokb + ti * 16, b = mt >> 8, m = mt & 255;
                bf16_t* bp = e.VT + ((size_t)(b * 4 + hx) * 64) * 256 + m;
#pragma unroll
                for (int fi = 0; fi < 4; ++fi)
#pragma unroll
                    for (int i = 0; i < 4; ++i) bp[(size_t)(fi * 16 + 4 * q4 + i) * 256] = (bf16_t)(pk_bf16(acc[fi][ti][i], 0.f) & 0xffffu);
            }
        }
    } else {
        if (cb >= 512 && cb < 1152) {
            const bool isq = cb < 1024;
            const float* gn = isq ? e.qn : e.kn;
            const float osc = isq ? 0.125f : 1.0f;
            f32x4 g[4];
#pragma unroll
            for (int fi = 0; fi < 4; ++fi) g[fi] = *(const f32x4*)(gn + fi * 16 + 4 * q4);
#pragma unroll
            for (int ti = 0; ti < TI; ++ti) {
                const int tok = tokb + ti * 16;
                float ss = 0.f;
#pragma unroll
                for (int fi = 0; fi < 4; ++fi)
#pragma unroll
                    for (int i = 0; i < 4; ++i) ss += acc[fi][ti][i] * acc[fi][ti][i];
                ss += __shfl_xor(ss, 16); ss += __shfl_xor(ss, 32);
                const float rinv = rsqrtf(ss * (1.0f / 64.0f) + EPS);
                const int t = (tok < NPROMPT) ? (tok & 2047) : (tok & 4095);
                const int rowi = t >> 6, coli = t & 63;
                const f32x4* rt = (const f32x4*)(e.rope + (rowi * 16 + 4 * q4) * 2);
                const f32x4* ct = (const f32x4*)(e.rope + (coli * 16 + 4 * q4) * 2);
                const f32x4 r01 = rt[0], r23 = rt[1], c01 = ct[0], c23 = ct[1];
                const float rc[4] = {r01[0], r01[2], r23[0], r23[2]}, rs[4] = {r01[1], r01[3], r23[1], r23[3]};
                const float cc[4] = {c01[0], c01[2], c23[0], c23[2]}, cs[4] = {c01[1], c01[3], c23[1], c23[3]};
                float o[4][4];
#pragma unroll
                for (int i = 0; i < 4; ++i) {
                    const float a0 = acc[0][ti][i] * rinv * g[0][i], b0 = acc[1][ti][i] * rinv * g[1][i];
                    const float a1 = acc[2][ti][i] * rinv * g[2][i], b1 = acc[3][ti][i] * rinv * g[3][i];
                    o[0][i] = (a0 * rc[i] - b0 * rs[i]) * osc; o[1][i] = (b0 * rc[i] + a0 * rs[i]) * osc;
                    o[2][i] = (a1 * cc[i] - b1 * cs[i]) * osc; o[3][i] = (b1 * cc[i] + a1 * cs[i]) * osc;
                }
                bf16_t* rowp = e.C + (size_t)tok * INW + cb + 4 * q4;
#pragma unroll
                for (int fi = 0; fi < 4; ++fi) {
                    u32x2 w; w.x = pk_bf16(o[fi][0], o[fi][1]); w.y = pk_bf16(o[fi][2], o[fi][3]);
                    *(u32x2*)(rowp + fi * 16) = w;
                }
            }
        } else if (cb >= 1152 && cb < 1280) {
            const int kvh = (cb - 1152) >> 6;
#pragma unroll
            for (int ti = 0; ti < TI; ++ti) {
                const int tok = tokb + ti * 16;
                bf16_t* bp; size_t T;
                if (tok < NPROMPT) { const int b = tok >> 11, t = tok & 2047; T = 2048; bp = e.VT + ((size_t)(b * 2 + kvh) * 64) * 2048 + t; }
                else { const int b = (tok - NPROMPT) >> 12, t = tok & 4095; T = 4096; bp = e.VT + (size_t)NPROMPT * 128 + ((size_t)(b * 2 + kvh) * 64) * 4096 + t; }
#pragma unroll
                for (int fi = 0; fi < 4; ++fi)
#pragma unroll
                    for (int i = 0; i < 4; ++i) bp[(size_t)(fi * 16 + 4 * q4 + i) * T] = (bf16_t)(pk_bf16(acc[fi][ti][i], 0.f) & 0xffffu);
            }
        } else {
            const int kind = (cb < 256) ? 0 : ((cb >= 1792 && cb < 2048) ? 2 : 1);
#pragma unroll
            for (int ti = 0; ti < TI; ++ti) {
                bf16_t* rowp = e.C + (size_t)(tokb + ti * 16) * INW + cb + 4 * q4;
#pragma unroll
                for (int fi = 0; fi < 4; ++fi) {
                    float v[4];
#pragma unroll
                    for (int i = 0; i < 4; ++i) { const float x = acc[fi][ti][i]; v[i] = (kind == 0) ? x : ((kind == 2) ? x * 0.125f : silu_f(x)); }
                    u32x2 o; o.x = pk_bf16(v[0], v[1]); o.y = pk_bf16(v[2], v[3]);
                    *(u32x2*)(rowp + fi * 16) = o;
                }
            }
        }
    }
}

#define SB_() __builtin_amdgcn_sched_barrier(0)
#define KFRAG(KS, KB) (*(const bf16x8*)(kp + (KB) * 4096 + k_off + ((((KS) * 2 + h) ^ kswz) << 4)))
#define VFRAG(KK, DB) (*(const bf16x8*)(vp + (DB) * 4096 + v_off + ((((KK) * 2 + h) ^ vswz) << 4)))
#define EXP4(S, I0) { _Pragma("unroll") for (int i_ = (I0); i_ < (I0) + 4; ++i_) { S[i_] = __builtin_amdgcn_exp2f(S[i_] * L2E - mb); rs += S[i_]; } }
#define EXP4F(S, I0) { f32x2_t a_ = {S[(I0)], S[(I0) + 1]}, b_ = {S[(I0) + 2], S[(I0) + 3]}; \
        a_ = a_ * (f32x2_t){L2E, L2E} - (f32x2_t){mb, mb}; b_ = b_ * (f32x2_t){L2E, L2E} - (f32x2_t){mb, mb}; \
        S[(I0)] = __builtin_amdgcn_exp2f(a_.x); S[(I0) + 1] = __builtin_amdgcn_exp2f(a_.y); S[(I0) + 2] = __builtin_amdgcn_exp2f(b_.x); S[(I0) + 3] = __builtin_amdgcn_exp2f(b_.y); \
        rs2 += (f32x2_t){S[(I0)], S[(I0) + 1]} + (f32x2_t){S[(I0) + 2], S[(I0) + 3]}; }
#define EXPQ(S, I0) { if (FIXM) EXP4F(S, I0) else EXP4(S, I0) }
#define PACK8(S, I0) ({ u32x4 t_; t_.x = pk_bf16(S[(I0)], S[(I0) + 1]); t_.y = pk_bf16(S[(I0) + 2], S[(I0) + 3]); t_.z = pk_bf16(S[(I0) + 4], S[(I0) + 5]); t_.w = pk_bf16(S[(I0) + 6], S[(I0) + 7]); __builtin_bit_cast(bf16x8, t_); })
DI float max8(const f32x16& s, int i0, float mx) {
    mx = fmaxf(fmaxf(mx, s[i0]), s[i0 + 1]); mx = fmaxf(fmaxf(mx, s[i0 + 2]), s[i0 + 3]);
    mx = fmaxf(fmaxf(mx, s[i0 + 4]), s[i0 + 5]); mx = fmaxf(fmaxf(mx, s[i0 + 6]), s[i0 + 7]);
    return mx;
}
#define EXP2F(S, I0) { S[(I0)] = __builtin_amdgcn_exp2f(S[(I0)] * L2E - mb); S[(I0) + 1] = __builtin_amdgcn_exp2f(S[(I0) + 1] * L2E - mb); rs += S[(I0)] + S[(I0) + 1]; \
        asm volatile("" : "+v"(S[(I0)]), "+v"(S[(I0) + 1]), "+v"(rs)); }
#define PIN1(X) asm volatile("" : "+v"(X))
template <bool DO_PV, bool DO_QK>
DI void attn_step_fix(f32x16& s0, f32x16& s1, f32x16& n0, f32x16& n1, const bf16x8 (&pp)[4], bf16x8 (&pc)[4],
                      f32x16& o0, f32x16& o1, const float m, float& lsum, const bf16x8 (&qf)[4],
                      const unsigned char* kp, const unsigned char* vp, int k_off, int kswz, int v_off, int vswz, int h) {
    bf16x8 va0, vb0, va1, vb1, va2, vb2, va3, vb3, ka0, kb0, ka1, kb1, ka2, kb2, ka3, kb3;
    const float mb = m * L2E;
    float rs = 0.f;
    if (DO_PV) { va0 = VFRAG(0, 0); vb0 = VFRAG(0, 1); va1 = VFRAG(1, 0); vb1 = VFRAG(1, 1); }
    EXP2F(s0, 0);  if (DO_PV) { o0 = mfma32(va0, pp[0], o0); va2 = VFRAG(2, 0); vb2 = VFRAG(2, 1); } SB_();
    EXP2F(s0, 2);  if (DO_PV) { o1 = mfma32(vb0, pp[0], o1); va3 = VFRAG(3, 0); vb3 = VFRAG(3, 1); } SB_();
    EXP2F(s0, 4);  if (DO_PV) { o0 = mfma32(va1, pp[1], o0); } if (DO_QK) { ka0 = KFRAG(0, 0); kb0 = KFRAG(0, 1); } SB_();
    EXP2F(s0, 6);  if (DO_PV) { o1 = mfma32(vb1, pp[1], o1); } if (DO_QK) { ka1 = KFRAG(1, 0); kb1 = KFRAG(1, 1); } SB_();
    EXP2F(s0, 8);  if (DO_PV) { o0 = mfma32(va2, pp[2], o0); } SB_();
    EXP2F(s0, 10); if (DO_PV) { o1 = mfma32(vb2, pp[2], o1); } pc[0] = PACK8(s0, 0); PIN1(pc[0]); SB_();
    EXP2F(s0, 12); if (DO_PV) { o0 = mfma32(va3, pp[3], o0); } SB_();
    EXP2F(s0, 14); if (DO_PV) { o1 = mfma32(vb3, pp[3], o1); } SB_();
    EXP2F(s1, 0);  if (DO_QK) { n0 = mfma32(ka0, qf[0], (f32x16){0.f, 0.f, 0.f, 0.f, 0.f, 0.f, 0.f, 0.f, 0.f, 0.f, 0.f, 0.f, 0.f, 0.f, 0.f, 0.f}); ka2 = KFRAG(2, 0); kb2 = KFRAG(2, 1); } pc[1] = PACK8(s0, 8); PIN1(pc[1]); SB_();
    EXP2F(s1, 2);  if (DO_QK) { n1 = mfma32(kb0, qf[0], (f32x16){0.f, 0.f, 0.f, 0.f, 0.f, 0.f, 0.f, 0.f, 0.f, 0.f, 0.f, 0.f, 0.f, 0.f, 0.f, 0.f}); ka3 = KFRAG(3, 0); kb3 = KFRAG(3, 1); } SB_();
    EXP2F(s1, 4);  if (DO_QK) { n0 = mfma32(ka1, qf[1], n0); } SB_();
    EXP2F(s1, 6);  if (DO_QK) { n1 = mfma32(kb1, qf[1], n1); } SB_();
    EXP2F(s1, 8);  if (DO_QK) { n0 = mfma32(ka2, qf[2], n0); } pc[2] = PACK8(s1, 0); PIN1(pc[2]); SB_();
    EXP2F(s1, 10); if (DO_QK) { n1 = mfma32(kb2, qf[2], n1); } SB_();
    EXP2F(s1, 12); if (DO_QK) { n0 = mfma32(ka3, qf[3], n0); } SB_();
    EXP2F(s1, 14); if (DO_QK) { n1 = mfma32(kb3, qf[3], n1); } pc[3] = PACK8(s1, 8); PIN1(pc[3]);
    lsum += rs;
    SB_();
}
template <bool DO_PV, bool DO_QK, bool FIXM>
DI void attn_step(f32x16& s0, f32x16& s1, f32x16& n0, f32x16& n1, const bf16x8 (&pp)[4], bf16x8 (&pc)[4],
                  f32x16& o0, f32x16& o1, float& m, float& lsum, const bf16x8 (&qf)[4],
                  const unsigned char* kp, const unsigned char* vp, int k_off, int kswz, int v_off, int vswz, int h) {
    if (FIXM) { attn_step_fix<DO_PV, DO_QK>(s0, s1, n0, n1, pp, pc, o0, o1, m, lsum, qf, kp, vp, k_off, kswz, v_off, vswz, h); return; }
    bf16x8 va0, vb0, va1, vb1, va2, vb2, va3, vb3, ka0, kb0, ka1, kb1, ka2, kb2, ka3, kb3;
    if (DO_PV) { va0 = VFRAG(0, 0); vb0 = VFRAG(0, 1); va1 = VFRAG(1, 0); vb1 = VFRAG(1, 1); }
    float mx = s0[0];
    if (DO_PV) o0 = mfma32(va0, pp[0], o0);
    if (!FIXM) mx = max8(s0, 0, mx);
    SB_();
    if (DO_PV) { o1 = mfma32(vb0, pp[0], o1); va2 = VFRAG(2, 0); vb2 = VFRAG(2, 1); }
    if (!FIXM) mx = max8(s0, 8, mx);
    SB_();
    if (DO_PV) { o0 = mfma32(va1, pp[1], o0); va3 = VFRAG(3, 0); vb3 = VFRAG(3, 1); }
    if (!FIXM) mx = max8(s1, 0, mx);
    SB_();
    if (DO_PV) o1 = mfma32(vb1, pp[1], o1);
    bool need = false; float alpha = 1.0f;
    if (!FIXM) {
        mx = max8(s1, 8, mx);
        mx = xhalf_max(mx);
        need = mx > m + 5.5f;
        const float mnew = need ? mx : m;
        alpha = __builtin_amdgcn_exp2f((m - mnew) * L2E);
        m = mnew;
    }
    const float mb = m * L2E;
    float rs = 0.f; f32x2_t rs2 = {0.f, 0.f};
    SB_();
    if (DO_PV) o0 = mfma32(va2, pp[2], o0);
    if (DO_QK) { ka0 = KFRAG(0, 0); kb0 = KFRAG(0, 1); }
    EXPQ(s0, 0);
    SB_();
    if (DO_PV) o1 = mfma32(vb2, pp[2], o1);
    if (DO_QK) { ka1 = KFRAG(1, 0); kb1 = KFRAG(1, 1); }
    EXPQ(s0, 4);
    SB_();
    if (DO_PV) o0 = mfma32(va3, pp[3], o0);
    EXPQ(s0, 8);
    SB_();
    if (DO_PV) o1 = mfma32(vb3, pp[3], o1);
    EXPQ(s0, 12);
    SB_();
    if (DO_QK) { n0 = mfma32(ka0, qf[0], (f32x16){0.f, 0.f, 0.f, 0.f, 0.f, 0.f, 0.f, 0.f, 0.f, 0.f, 0.f, 0.f, 0.f, 0.f, 0.f, 0.f}); ka2 = KFRAG(2, 0); kb2 = KFRAG(2, 1); }
    EXPQ(s1, 0);
    SB_();
    if (DO_QK) { n1 = mfma32(kb0, qf[0], (f32x16){0.f, 0.f, 0.f, 0.f, 0.f, 0.f, 0.f, 0.f, 0.f, 0.f, 0.f, 0.f, 0.f, 0.f, 0.f, 0.f}); ka3 = KFRAG(3, 0); kb3 = KFRAG(3, 1); }
    EXPQ(s1, 4);
    SB_();
    if (DO_QK) n0 = mfma32(ka1, qf[1], n0);
    EXPQ(s1, 8);
    SB_();
    if (DO_QK) n1 = mfma32(kb1, qf[1], n1);
    EXPQ(s1, 12);
    SB_();
    if (DO_QK) n0 = mfma32(ka2, qf[2], n0);
    pc[0] = PACK8(s0, 0);
    SB_();
    if (DO_QK) n1 = mfma32(kb2, qf[2], n1);
    pc[1] = PACK8(s0, 8);
    SB_();
    if (DO_QK) n0 = mfma32(ka3, qf[3], n0);
    pc[2] = PACK8(s1, 0);
    SB_();
    if (DO_QK) n1 = mfma32(kb3, qf[3], n1);
    pc[3] = PACK8(s1, 8);
    if (FIXM) lsum += rs2.x + rs2.y; else lsum = lsum * alpha + rs;
    SB_();
    if (!FIXM) {
        if (__builtin_amdgcn_ballot_w64(need)) {
#pragma unroll
            for (int i = 0; i < 16; ++i) { o0[i] *= alpha; o1[i] *= alpha; }
        }
    }
}

template <bool FIXM>
DI void attn_item(const bf16_t* __restrict__ Q, int ldq, const bf16_t* __restrict__ K, int ldk, const bf16_t* __restrict__ VT, int ldv,
                  int nkeys, bf16_t* __restrict__ O, const bf16_t* __restrict__ G, unsigned char* smem, float mfix) {
    const int tid = opaque_tid(), lane = tid & 63, wave = tid >> 6;
    const int r = lane & 31, h = lane >> 5;
    bf16x8 qf[4];
    {
        const bf16_t* qp = Q + (size_t)(wave * 32 + r) * ldq + h * 8;
#pragma unroll
        for (int ks = 0; ks < 4; ++ks) qf[ks] = *(const bf16x8*)(qp + ks * 16);
    }
    const int lrow = tid >> 3, lc = tid & 7;
    const bf16_t* Kg = K + (size_t)lrow * ldk + lc * 8;
    const bf16_t* Vg = VT + (size_t)lrow * ldv + lc * 8;
    const int st_off = lrow * 128 + ((lc ^ ((lrow >> 1) & 7)) << 4);
    const int pr = (r & ~12) | ((r & 4) << 1) | ((r & 8) >> 1);
    const int kswz = (pr >> 1) & 7, vswz = (r >> 1) & 7;
    const int k_off = pr * 128, v_off = r * 128;
    const int nt = nkeys >> 6;

    f32x16 o0, o1, sa0, sa1, sb0, sb1;
#pragma unroll
    for (int i = 0; i < 16; ++i) { o0[i] = 0.f; o1[i] = 0.f; }
    float m = FIXM ? mfix : -1e30f, lsum = 0.f;
    bf16x8 pa[4], pb[4];

    u32x4 rk, rv;
#define A_LOAD(U) { const int kt_ = ((U) + 2 < nt) ? (U) + 2 : nt - 1; rk = *(const u32x4*)(Kg + (size_t)(kt_ * 64) * ldk); rv = *(const u32x4*)(Vg + (U) * 64); }
#define A_STORE(OFF) { *(u32x4*)(smem + (OFF) + st_off) = rk; *(u32x4*)(smem + (OFF) + 8192 + st_off) = rv; }
    rk = *(const u32x4*)(Kg); rv = *(const u32x4*)(Kg + (size_t)64 * ldk);
    __syncthreads();
    A_STORE(16384);
    A_LOAD(0);
    A_STORE(0);
    A_LOAD(1);
    lds_barrier();
    {
        const unsigned char* kp = smem + 16384;
        sa0 = mfma32(KFRAG(0, 0), qf[0], (f32x16){0.f, 0.f, 0.f, 0.f, 0.f, 0.f, 0.f, 0.f, 0.f, 0.f, 0.f, 0.f, 0.f, 0.f, 0.f, 0.f});
        sa1 = mfma32(KFRAG(0, 1), qf[0], (f32x16){0.f, 0.f, 0.f, 0.f, 0.f, 0.f, 0.f, 0.f, 0.f, 0.f, 0.f, 0.f, 0.f, 0.f, 0.f, 0.f});
#pragma unroll
        for (int ks = 1; ks < 4; ++ks) { sa0 = mfma32(KFRAG(ks, 0), qf[ks], sa0); sa1 = mfma32(KFRAG(ks, 1), qf[ks], sa1); }
    }
    attn_step<false, true, FIXM>(sa0, sa1, sb0, sb1, pb, pa, o0, o1, m, lsum, qf, smem + 16384 + 8192, smem, k_off, kswz, v_off, vswz, h);
    lds_barrier();
    for (int t = 1; t < nt - 1; t += 2) {
        A_STORE(16384);
        A_LOAD(t + 1);
        SB_();
        attn_step<true, true, FIXM>(sb0, sb1, sa0, sa1, pa, pb, o0, o1, m, lsum, qf, smem, smem + 8192, k_off, kswz, v_off, vswz, h);
        lds_barrier();
        A_STORE(0);
        A_LOAD(t + 2);
        SB_();
        attn_step<true, true, FIXM>(sa0, sa1, sb0, sb1, pb, pa, o0, o1, m, lsum, qf, smem + 16384, smem + 16384 + 8192, k_off, kswz, v_off, vswz, h);
        lds_barrier();
    }
    A_STORE(16384);
    const bf16_t* gp = G + (size_t)(wave * 32 + r) * INW + 4 * h;
    u32x2 gga[4], ggb[4];
#pragma unroll
    for (int gq = 0; gq < 4; ++gq) { gga[gq] = *(const u32x2*)(gp + 8 * gq); ggb[gq] = *(const u32x2*)(gp + 32 + 8 * gq); }
    SB_();
    attn_step<true, false, FIXM>(sb0, sb1, sa0, sa1, pa, pb, o0, o1, m, lsum, qf, smem, smem + 8192, k_off, kswz, v_off, vswz, h);
    lds_barrier();
    {
        const unsigned char* vp = smem + 16384 + 8192;
#pragma unroll
        for (int kk = 0; kk < 4; ++kk) { o0 = mfma32(VFRAG(kk, 0), pb[kk], o0); o1 = mfma32(VFRAG(kk, 1), pb[kk], o1); }
    }
#undef A_LOAD
#undef A_STORE
    const float lt = lsum + __shfl_xor(lsum, 32);
    const float inv = 1.0f / lt;
    bf16_t* op = O + (size_t)(wave * 32 + r) * 1024 + 4 * h;
#pragma unroll
    for (int gq = 0; gq < 4; ++gq) {
        {
            const u32x2 gg = gga[gq];
            u32x2 w;
            w.x = pk_bf16(o0[4 * gq] * inv * bflo(gg.x), o0[4 * gq + 1] * inv * bfhi(gg.x));
            w.y = pk_bf16(o0[4 * gq + 2] * inv * bflo(gg.y), o0[4 * gq + 3] * inv * bfhi(gg.y));
            *(u32x2*)(op + 8 * gq) = w;
        }
        {
            const u32x2 gg = ggb[gq];
            u32x2 w;
            w.x = pk_bf16(o1[4 * gq] * inv * bflo(gg.x), o1[4 * gq + 1] * inv * bfhi(gg.x));
            w.y = pk_bf16(o1[4 * gq + 2] * inv * bflo(gg.y), o1[4 * gq + 3] * inv * bfhi(gg.y));
            *(u32x2*)(op + 32 + 8 * gq) = w;
        }
    }
}

DI void cross_item(const bf16_t* __restrict__ Q, const bf16_t* __restrict__ K, const bf16_t* __restrict__ VT,
                   bf16_t* __restrict__ O, const bf16_t* __restrict__ G, unsigned char* smem) {
    const int tid = opaque_tid(), lane = tid & 63, wave = tid >> 6;
    const int r = lane & 31, h = lane >> 5;
    bf16x8 qf[4];
    {
        const bf16_t* qp = Q + (size_t)(wave * 32 + r) * INW + h * 8;
#pragma unroll
        for (int ks = 0; ks < 4; ++ks) qf[ks] = *(const bf16x8*)(qp + ks * 16);
    }
    const int lrow = tid >> 3, lc = tid & 7;
    const int st_off = lrow * 128 + ((lc ^ ((lrow >> 1) & 7)) << 4);
    {
        u32x4 kk[4], vv[4];
#pragma unroll
        for (int i = 0; i < 4; ++i) { kk[i] = *(const u32x4*)(K + (size_t)(lrow + 64 * i) * 256 + lc * 8); vv[i] = *(const u32x4*)(VT + (size_t)lrow * 256 + (i * 8 + lc) * 8); }
        __syncthreads();
#pragma unroll
        for (int i = 0; i < 4; ++i) { *(u32x4*)(smem + i * 16384 + st_off) = kk[i]; *(u32x4*)(smem + i * 16384 + 8192 + st_off) = vv[i]; }
    }
    const bf16_t* gp = G + (size_t)(wave * 32 + r) * INW + 4 * h;
    u32x2 gga[4], ggb[4];
#pragma unroll
    for (int gq = 0; gq < 4; ++gq) { gga[gq] = *(const u32x2*)(gp + 8 * gq); ggb[gq] = *(const u32x2*)(gp + 32 + 8 * gq); }
    __syncthreads();
    const int pr = (r & ~12) | ((r & 4) << 1) | ((r & 8) >> 1);
    const int kswz = (pr >> 1) & 7, vswz = (r >> 1) & 7;
    const int k_off = pr * 128, v_off = r * 128;
    f32x16 o0, o1;
#pragma unroll
    for (int i = 0; i < 16; ++i) { o0[i] = 0.f; o1[i] = 0.f; }
    float m = -1e30f, lsum = 0.f;
#pragma unroll 1
    for (int kt = 0; kt < 4; ++kt) {
        const unsigned char* kp = smem + kt * 16384;
        const unsigned char* vp = kp + 8192;
        f32x16 s0, s1;
        s0 = mfma32(KFRAG(0, 0), qf[0], (f32x16){0.f, 0.f, 0.f, 0.f, 0.f, 0.f, 0.f, 0.f, 0.f, 0.f, 0.f, 0.f, 0.f, 0.f, 0.f, 0.f});
        s1 = mfma32(KFRAG(0, 1), qf[0], (f32x16){0.f, 0.f, 0.f, 0.f, 0.f, 0.f, 0.f, 0.f, 0.f, 0.f, 0.f, 0.f, 0.f, 0.f, 0.f, 0.f});
#pragma unroll
        for (int ks = 1; ks < 4; ++ks) { s0 = mfma32(KFRAG(ks, 0), qf[ks], s0); s1 = mfma32(KFRAG(ks, 1), qf[ks], s1); }
        float mx = s0[0];
        mx = max8(s0, 0, mx); mx = max8(s0, 8, mx); mx = max8(s1, 0, mx); mx = max8(s1, 8, mx);
        mx = xhalf_max(mx);
        const float mnew = fmaxf(m, mx);
        const float alpha = __builtin_amdgcn_exp2f((m - mnew) * L2E);
        m = mnew;
        const float mb = mnew * L2E;
        float rs = 0.f;
#pragma unroll
        for (int i = 0; i < 16; ++i) { s0[i] = __builtin_amdgcn_exp2f(s0[i] * L2E - mb); s1[i] = __builtin_amdgcn_exp2f(s1[i] * L2E - mb); rs += s0[i] + s1[i]; }
        lsum = lsum * alpha + rs;
#pragma unroll
        for (int i = 0; i < 16; ++i) { o0[i] *= alpha; o1[i] *= alpha; }
        bf16x8 pf[4];
        pf[0] = PACK8(s0, 0); pf[1] = PACK8(s0, 8); pf[2] = PACK8(s1, 0); pf[3] = PACK8(s1, 8);
#pragma unroll
        for (int kk2 = 0; kk2 < 4; ++kk2) { o0 = mfma32(VFRAG(kk2, 0), pf[kk2], o0); o1 = mfma32(VFRAG(kk2, 1), pf[kk2], o1); }
    }
    const float lt = lsum + __shfl_xor(lsum, 32);
    const float inv = 1.0f / lt;
    bf16_t* op = O + (size_t)(wave * 32 + r) * 1024 + 4 * h;
#pragma unroll
    for (int gq = 0; gq < 4; ++gq) {
        {
            const u32x2 gg = gga[gq];
            u32x2 w;
            w.x = pk_bf16(o0[4 * gq] * inv * bflo(gg.x), o0[4 * gq + 1] * inv * bfhi(gg.x));
            w.y = pk_bf16(o0[4 * gq + 2] * inv * bflo(gg.y), o0[4 * gq + 3] * inv * bfhi(gg.y));
            *(u32x2*)(op + 8 * gq) = w;
        }
        {
            const u32x2 gg = ggb[gq];
            u32x2 w;
            w.x = pk_bf16(o1[4 * gq] * inv * bflo(gg.x), o1[4 * gq + 1] * inv * bfhi(gg.x));
            w.y = pk_bf16(o1[4 * gq + 2] * inv * bflo(gg.y), o1[4 * gq + 3] * inv * bfhi(gg.y));
            *(u32x2*)(op + 32 + 8 * gq) = w;
        }
    }
}

DI void pool_item(const bf16_t* __restrict__ Z, const bf16_t* __restrict__ PWT, const float* __restrict__ pscale, bf16_t* __restrict__ MIX,
                  int tokg0, unsigned char* smem) {
    const int tid = opaque_tid(), lane = tid & 63, wave = tid >> 6;
    const int T = (tokg0 < NPROMPT) ? 2048 : 4096;
    const int t0 = tokg0 & (T - 1);
    constexpr int RS = 528;
    const int g = wave & 3, half = 1 << g;
    const int r16 = lane & 15, q4 = lane >> 4;
    const bf16_t* pw = PWT + (size_t)g * 4096 + r16 * 64 + q4 * 8;
    bf16x8 wfr[4][2]; f32x4 psr[4]; u32x2 ggr[2][4];
#pragma unroll
    for (int fi = 0; fi < 4; ++fi) {
        psr[fi] = *(const f32x4*)(pscale + g * 64 + fi * 16 + 4 * q4);
#pragma unroll
        for (int ks = 0; ks < 2; ++ks) wfr[fi][ks] = *(const bf16x8*)(pw + fi * 16 * 64 + ks * 32);
#pragma unroll
        for (int t2 = 0; t2 < 2; ++t2) ggr[t2][fi] = *(const u32x2*)(Z + ((size_t)tokg0 + ((wave >> 2) * 2 + t2) * 16 + r16) * INW + 256 + g * 64 + fi * 16 + 4 * q4);
    }
    __syncthreads();
    for (int id = tid; id < 80 * 32; id += 512) {
        const int rr = id >> 5, c = id & 31;
        const int t = t0 - 8 + rr;
        u32x4 v = (u32x4){0u, 0u, 0u, 0u};
        if (t >= 0 && t < T) v = *(const u32x4*)(Z + (size_t)(tokg0 - 8 + rr) * INW + c * 8);
        *(u32x4*)(smem + rr * RS + c * 16) = v;
    }
    __syncthreads();
    {
        const int th = wave >> 2;
        bf16x8 df[2][2];
#pragma unroll
        for (int t2 = 0; t2 < 2; ++t2)
#pragma unroll
            for (int ks = 0; ks < 2; ++ks) {
                const int tl = (th * 2 + t2) * 16 + r16, t = t0 + tl;
                const int lo = max(t - half, 0), hi = min(t + half, T);
                const float icnt = 1.0f / (float)(hi - lo);
                float s[8];
#pragma unroll
                for (int j = 0; j < 8; ++j) s[j] = 0.f;
                const unsigned char* bp = smem + (tl + 8 - half) * RS + (g * 64 + ks * 32 + q4 * 8) * 2;
                for (int j = 0; j < 2 * half; ++j) {
                    const u32x4 v = *(const u32x4*)(bp + j * RS);
                    s[0] += bflo(v.x); s[1] += bfhi(v.x); s[2] += bflo(v.y); s[3] += bfhi(v.y);
                    s[4] += bflo(v.z); s[5] += bfhi(v.z); s[6] += bflo(v.w); s[7] += bfhi(v.w);
                }
                const u32x4 c = *(const u32x4*)(bp + half * RS);
                u32x4 o;
                o.x = pk_bf16(s[0] * icnt - bflo(c.x), s[1] * icnt - bfhi(c.x));
                o.y = pk_bf16(s[2] * icnt - bflo(c.y), s[3] * icnt - bfhi(c.y));
                o.z = pk_bf16(s[4] * icnt - bflo(c.z), s[5] * icnt - bfhi(c.z));
                o.w = pk_bf16(s[6] * icnt - bflo(c.w), s[7] * icnt - bfhi(c.w));
                df[t2][ks] = __builtin_bit_cast(bf16x8, o);
            }
        f32x4 acc[4][2];
#pragma unroll
        for (int i = 0; i < 4; ++i)
#pragma unroll
            for (int j = 0; j < 2; ++j) acc[i][j] = (f32x4){0.f, 0.f, 0.f, 0.f};
#pragma unroll
        for (int fi = 0; fi < 4; ++fi)
#pragma unroll
            for (int ks = 0; ks < 2; ++ks) {
                const bf16x8 wf = wfr[fi][ks];
#pragma unroll
                for (int t2 = 0; t2 < 2; ++t2) acc[fi][t2] = mfma16(wf, df[t2][ks], acc[fi][t2]);
            }
#pragma unroll
        for (int t2 = 0; t2 < 2; ++t2) {
            const size_t tok = (size_t)tokg0 + (th * 2 + t2) * 16 + r16;
#pragma unroll
            for (int fi = 0; fi < 4; ++fi) {
                const int n = g * 64 + fi * 16 + 4 * q4;
                const f32x4 ps = psr[fi];
                const u32x2 gg = ggr[t2][fi];
                u32x2 w;
                w.x = pk_bf16(acc[fi][t2][0] * ps[0] * bflo(gg.x), acc[fi][t2][1] * ps[1] * bfhi(gg.x));
                w.y = pk_bf16(acc[fi][t2][2] * ps[2] * bflo(gg.y), acc[fi][t2][3] * ps[3] * bfhi(gg.y));
                *(u32x2*)(MIX + tok * 1024 + n) = w;
            }
        }
    }
}

DI void post_row(const float* __restrict__ xsrc, bf16_t* __restrict__ yh, const float* __restrict__ gpost, const float* __restrict__ gpre_next,
                 float* __restrict__ xdst, bool last, int lane) {
    u32x4 yv[2]; f32x4 xv[4];
#pragma unroll
    for (int j = 0; j < 2; ++j) yv[j] = *(const u32x4*)(yh + j * 512 + lane * 8);
#pragma unroll
    for (int j = 0; j < 2; ++j) { xv[2 * j] = *(const f32x4*)(xsrc + j * 512 + lane * 8); xv[2 * j + 1] = *(const f32x4*)(xsrc + j * 512 + lane * 8 + 4); }
    float y[16];
#pragma unroll
    for (int j = 0; j < 2; ++j) {
        y[8 * j + 0] = bflo(yv[j].x); y[8 * j + 1] = bfhi(yv[j].x); y[8 * j + 2] = bflo(yv[j].y); y[8 * j + 3] = bfhi(yv[j].y);
        y[8 * j + 4] = bflo(yv[j].z); y[8 * j + 5] = bfhi(yv[j].z); y[8 * j + 6] = bflo(yv[j].w); y[8 * j + 7] = bfhi(yv[j].w);
    }
    float ss = 0.f;
#pragma unroll
    for (int i = 0; i < 16; ++i) ss += y[i] * y[i];
    ss = wave_sum(ss);
    const float r = rsqrtf(ss * (1.0f / 1024.0f) + EPS);
    float xn[16]; float ss2 = 0.f;
#pragma unroll
    for (int j = 0; j < 2; ++j) {
        const f32x4 g0 = *(const f32x4*)(gpost + j * 512 + lane * 8), g1 = *(const f32x4*)(gpost + j * 512 + lane * 8 + 4);
#pragma unroll
        for (int i = 0; i < 4; ++i) {
            xn[8 * j + i] = xv[2 * j][i] + y[8 * j + i] * r * g0[i];
            xn[8 * j + 4 + i] = xv[2 * j + 1][i] + y[8 * j + 4 + i] * r * g1[i];
        }
    }
#pragma unroll
    for (int i = 0; i < 16; ++i) ss2 += xn[i] * xn[i];
#pragma unroll
    for (int j = 0; j < 2; ++j) {
        *(f32x4*)(xdst + j * 512 + lane * 8) = (f32x4){xn[8 * j], xn[8 * j + 1], xn[8 * j + 2], xn[8 * j + 3]};
        *(f32x4*)(xdst + j * 512 + lane * 8 + 4) = (f32x4){xn[8 * j + 4], xn[8 * j + 5], xn[8 * j + 6], xn[8 * j + 7]};
    }
    if (!last) {
        ss2 = wave_sum(ss2);
        const float r2 = rsqrtf(ss2 * (1.0f / 1024.0f) + EPS);
#pragma unroll
        for (int j = 0; j < 2; ++j) {
            const f32x4 g0 = *(const f32x4*)(gpre_next + j * 512 + lane * 8), g1 = *(const f32x4*)(gpre_next + j * 512 + lane * 8 + 4);
            u32x4 o;
            o.x = pk_bf16(xn[8 * j] * r2 * g0[0], xn[8 * j + 1] * r2 * g0[1]);
            o.y = pk_bf16(xn[8 * j + 2] * r2 * g0[2], xn[8 * j + 3] * r2 * g0[3]);
            o.z = pk_bf16(xn[8 * j + 4] * r2 * g1[0], xn[8 * j + 5] * r2 * g1[1]);
            o.w = pk_bf16(xn[8 * j + 6] * r2 * g1[2], xn[8 * j + 7] * r2 * g1[3]);
            *(u32x4*)(yh + j * 512 + lane * 8) = o;
        }
    }
}

#define XB_TMO      128
#define XB_XCNT(j)  (256  + 64 * (j))
#define XB_XSUB(j)  (1280 + 64 * (j))
#define XB_XGEN(j)  (2304 + 64 * (j))
#define XB_TOP      3328
#define XB_TOPGEN   3392
#define XCD_BAR_WORDS 3456
#define XB_SPIN_CAP (1u << 18)
#define LAS __attribute__((address_space(3)))
DI unsigned xb_ld(unsigned* p)              { return __hip_atomic_load(p, __ATOMIC_RELAXED, __HIP_MEMORY_SCOPE_AGENT); }
DI unsigned xb_add(unsigned* p, unsigned v) { return __hip_atomic_fetch_add(p, v, __ATOMIC_RELAXED, __HIP_MEMORY_SCOPE_AGENT); }
DI unsigned xb_xcc_id() { return (unsigned)__builtin_amdgcn_s_getreg((3 << 11) | 20) & 0xFu; }
#define XB_SPIN(cond, bar) do { unsigned _sp = 0; while (cond) { __builtin_amdgcn_s_sleep(1); \
    if ((++_sp & 255u) == 0u) { if (xb_ld(&(bar)[XB_TMO])) break; if (_sp > XB_SPIN_CAP) { atomicAdd(&(bar)[XB_TMO], 1u); break; } } } } while (0)
struct XcdBarrier { unsigned* bar; unsigned x; volatile LAS unsigned* st; };
DI XcdBarrier xcd_barrier_post(unsigned* bar, volatile LAS unsigned* st) {
    XcdBarrier b; b.bar = bar; b.x = xb_xcc_id(); b.st = st;
    if (threadIdx.x == 0) (void)xb_add(&bar[XB_XCNT(b.x)], 1u);
    return b;
}
DI void xcd_barrier_complete(unsigned* bar, unsigned x, unsigned& nloc, unsigned& nx) {
    const unsigned G = gridDim.x * gridDim.y * gridDim.z;
    unsigned sum, cnt, mine, sp = 0u;
    for (;;) {
        sum = 0u; cnt = 0u; mine = 0u;
#pragma unroll
        for (unsigned j = 0; j < 16; ++j) { const unsigned c = xb_ld(&bar[XB_XCNT(j)]); sum += c; cnt += (c > 0u) ? 1u : 0u; mine = (j == x) ? c : mine; }
        if (sum == G) break;
        __builtin_amdgcn_s_sleep(1);
        if ((++sp & 255u) == 0u) { if (xb_ld(&bar[XB_TMO])) break; if (sp > XB_SPIN_CAP) { atomicAdd(&bar[XB_TMO], 1u); break; } }
    }
    nloc = mine > 0u ? mine : 1u; nx = cnt > 0u ? cnt : 1u;
}
DI void xcd_barrier(const XcdBarrier& b) {
    asm volatile("s_waitcnt vmcnt(0)" ::: "memory");
    __syncthreads();
    if (threadIdx.x == 0) {
        unsigned* bar = b.bar;
        __builtin_amdgcn_s_waitcnt(0);
        unsigned nloc = b.st[0], nx = b.st[1];
        if (nloc == 0u) { xcd_barrier_complete(bar, b.x, nloc, nx); b.st[0] = nloc; b.st[1] = nx; }
        const unsigned old = xb_add(&bar[XB_XSUB(b.x)], 1u);
        const unsigned gen = old / nloc;
        if (old + 1u == (gen + 1u) * nloc) {
            __builtin_amdgcn_fence(__ATOMIC_RELEASE, "agent");
            asm volatile("s_waitcnt vmcnt(0)" ::: "memory");
            const unsigned og = xb_add(&bar[XB_TOP], 1u);
            const unsigned tg = og / nx;
            if (og + 1u == (tg + 1u) * nx) xb_add(&bar[XB_TOPGEN], 1u);
            else XB_SPIN(xb_ld(&bar[XB_TOPGEN]) == tg, bar);
            __builtin_amdgcn_fence(__ATOMIC_ACQUIRE, "agent");
            xb_add(&bar[XB_XGEN(b.x)], 1u);
            asm volatile("s_waitcnt vmcnt(0)" ::: "memory");
        } else {
            XB_SPIN(xb_ld(&bar[XB_XGEN(b.x)]) == gen, bar);
            __builtin_amdgcn_fence(__ATOMIC_ACQUIRE, "agent");
            asm volatile("s_waitcnt vmcnt(0)" ::: "memory");
        }
    }
    __syncthreads();
}

__global__ void __launch_bounds__(512, 2) fwd_megakernel(Params p) {
    __shared__ __attribute__((aligned(16))) unsigned char smem[131072];
    __shared__ uint4 xb_words;
    cg::grid_group grid = cg::this_grid();
    const int nb = gridDim.x, bid = blockIdx.x;
    if (threadIdx.x == 0) xb_words = make_uint4(0u, 0u, 0u, 0u);
    __syncthreads();
    XcdBarrier xb = xcd_barrier_post((unsigned*)(p.ws + OFF_BAR), (volatile LAS unsigned*)&xb_words);
    if (p.phase_end > 1000) grid.sync();
    for (int ph = p.phase_begin; ph < p.phase_end; ++ph) {
        const int tid = opaque_tid(), lane = tid & 63, wave = tid >> 6;
        unsigned char* ws = p.ws;
        bf16_t* H = (bf16_t*)(ws + OFF_H);
        bf16_t* Z = (bf16_t*)(ws + OFF_Z);
        bf16_t* VT = (bf16_t*)(ws + OFF_VT);
        bf16_t* MIX = (bf16_t*)(ws + OFF_MIX);
        bf16_t* WIN = (bf16_t*)(ws + OFF_WIN);
        bf16_t* WOUT = (bf16_t*)(ws + OFF_WOUT);
        bf16_t* WMEM = (bf16_t*)(ws + OFF_WMEM);
        bf16_t* PW = (bf16_t*)(ws + OFF_PW);
        bf16_t* MH = (bf16_t*)(ws + OFF_MH);
        bf16_t* KM = (bf16_t*)(ws + OFF_KM);
        bf16_t* VMT = (bf16_t*)(ws + OFF_VMT);
        float* ROPE = (float*)(ws + OFF_ROPE);
        if (ph == 0) {
            for (int i = bid; i < 1928; i += nb) {
                if (i < 1152) { const int l = i / 576, j = i % 576, kt = j / 36, ntile = j % 36;
                    transpose_tile(p.w_in + (size_t)l * DM * INW, INW, WIN + (size_t)l * INW * DM, DM, kt * 64, ntile * 64, smem);
                } else if (i < 1664) { const int ii = i - 1152, l = ii / 256, j = ii % 256, kt = j / 16, ntile = j % 16;
                    transpose_tile(p.w_out + (size_t)l * DM * DM, DM, WOUT + (size_t)l * DM * DM, DM, kt * 64, ntile * 64, smem);
                } else if (i < 1920) { const int ii = i - 1664, l = ii / 128, j = ii % 128, kt = j / 8, ntile = j % 8;
                    transpose_tile(p.w_mem_kv + (size_t)l * DM * 512, 512, WMEM + (size_t)l * 512 * DM, DM, kt * 64, ntile * 64, smem);
                } else { const int ii = i - 1920;
                    transpose_tile(p.pool_w + (size_t)ii * 4096, 64, PW + (size_t)ii * 4096, 64, 0, 0, smem);
                }
            }
            for (int i = bid * 8 + wave; i < NTOK + 2 * NMEMTOK; i += nb * 8) {
                if (i < NTOK) {
                    const float* src = (i < NPROMPT) ? p.x_prompt + (size_t)i * DM : p.x_sample + (size_t)(i - NPROMPT) * DM;
                    rms_row_f32(src, p.norm_pre, H + (size_t)i * DM, lane);
                } else {
                    const int ii = i - NTOK, l = ii / NMEMTOK, mt = ii % NMEMTOK;
                    const float* src = (mt < 4096) ? p.mem_prompt + (size_t)mt * DM : p.mem_sample + (size_t)(mt - 4096) * DM;
                    rms_row_f32(src, p.mem_norm + l * DM, MH + ((size_t)l * NMEMTOK + mt) * DM, lane);
                }
            }
            for (int i = bid * 512 + tid; i < 1024; i += nb * 512) rope_entry(i, ROPE);
        } else {
            const int l = (ph - 1) >> 2, sub = (ph - 1) & 3;
            if (sub == 0) {
                EpiArgs e; e.C = Z; e.VT = VT; e.qn = p.q_norm + l * 64; e.kn = p.k_norm + l * 64; e.rope = ROPE;
                const bf16_t* Wl = WIN + (size_t)l * INW * DM;
                EpiArgs e2; e2.C = KM + (size_t)l * NMEMTOK * 256; e2.VT = VMT + (size_t)l * NMEMTOK * 256; e2.qn = nullptr; e2.kn = nullptr; e2.rope = nullptr;
                const bf16_t* Wm = WMEM + (size_t)l * 512 * DM;
                const bf16_t* Am = MH + (size_t)l * NMEMTOK * DM;
                for (int i = bid; i < 1728 + 40; i += nb) {
                    if (i < 1728) {
                        const int j = i >> 3, mg = j / 72, rem = j % 72;
                        const int mt = (i & 7) * 24 + mg * 8 + (rem & 7), ntile = rem >> 3;
                        gemm_tile<0>(H, Wl, mt * 256, ntile * 256, e, smem);
                    } else {
                        const int j = i - 1728;
                        gemm_tile<2>(Am, Wm, (j >> 1) * 256, (j & 1) * 256, e2, smem);
                    }
                }
            } else if (sub == 1) {
                float gq = fabsf(p.q_norm[l * 64 + lane]), gk = fabsf(p.k_norm[l * 64 + lane]);
#pragma unroll
                for (int o = 1; o < 64; o <<= 1) { gq = fmaxf(gq, __shfl_xor(gq, o)); gk = fmaxf(gk, __shfl_xor(gk, o)); }
                const float mfix = 8.0f * gq * gk * 1.02f;
                const bool fixm = mfix < 20.0f;
                for (int i = bid; i < 3072; i += nb) {
                    if (i < 1536) {
                        int b, kvh, j, T; size_t tok0, vtb;
                        if (i < 512) { const int R = i >> 8, ip = i & 255, grp = ip & 7; j = R * 32 + (ip >> 3); b = grp >> 1; kvh = grp & 1; T = 4096;
                            tok0 = (size_t)NPROMPT + (size_t)b * 4096; vtb = (size_t)NPROMPT * 128 + ((size_t)(b * 2 + kvh) * 64) * 4096; }
                        else { const int ii = i - 512, R = ii >> 8, ip = ii & 255, grp = R * 8 + (ip & 7); j = ip >> 3; b = grp >> 1; kvh = grp & 1; T = 2048;
                            tok0 = (size_t)b * 2048; vtb = ((size_t)(b * 2 + kvh) * 64) * 2048; }
                        const int qblk = j >> 2, head = kvh * 4 + (j & 3);
                        const size_t q0 = tok0 + (size_t)qblk * 256;
                        if (fixm) attn_item<true>(Z + q0 * INW + 512 + head * 64, INW, Z + tok0 * INW + 1024 + kvh * 64, INW, VT + vtb, T, T,
                                  MIX + q0 * 1024 + 256 + head * 64, Z + q0 * INW + 1280 + head * 64, smem, mfix);
                        else attn_item<false>(Z + q0 * INW + 512 + head * 64, INW, Z + tok0 * INW + 1024 + kvh * 64, INW, VT + vtb, T, T,
                                  MIX + q0 * 1024 + 256 + head * 64, Z + q0 * INW + 1280 + head * 64, smem, 0.f);
                    } else if (i < 2304) {
                        const int ii = i - 1536, qb = ii >> 2, hx = ii & 3;
                        const size_t q0 = (size_t)qb * 256;
                        const int b = (q0 < NPROMPT) ? (int)(q0 >> 11) : 16 + (int)((q0 - NPROMPT) >> 12);
cross_item(Z + q0 * INW + 1792 + hx * 64, KM + ((size_t)l * NMEMTOK + (size_t)b * 256) * 256 + hx * 64,
                                   VMT + (size_t)l * NMEMTOK * 256 + ((size_t)(b * 4 + hx) * 64) * 256,
                                   MIX + q0 * 1024 + 768 + hx * 64, Z + q0 * INW + 2048 + hx * 64, smem);
                    } else {
                        pool_item(Z, PW + (size_t)l * 4 * 4096, p.pool_scale + l * 256, MIX, (i - 2304) * 64, smem);
                    }
                }
            } else if (sub == 2) {
                EpiArgs e; e.C = H; e.VT = nullptr; e.qn = nullptr; e.kn = nullptr; e.rope = nullptr;
                const bf16_t* Wl = WOUT + (size_t)l * DM * DM;
                for (int i = bid; i < 768; i += nb) {
                    const int j = i >> 3, mg = j >> 5, rem = j & 31;
                    const int mt = (i & 7) * 24 + mg * 8 + (rem & 7), ntile = rem >> 3;
                    gemm_tile<1>(MIX, Wl, mt * 256, ntile * 256, e, smem);
                }
            } else {
                const bool last = (l == DEPTH - 1);
                for (int i = bid * 8 + wave; i < NTOK; i += nb * 8) {
                    const float* xs = (l == 0) ? ((i < NPROMPT) ? p.x_prompt + (size_t)i * DM : p.x_sample + (size_t)(i - NPROMPT) * DM) : p.out + (size_t)i * DM;
                    post_row(xs, H + (size_t)i * DM, p.norm_post + l * DM, p.norm_pre + (last ? l : l + 1) * DM, p.out + (size_t)i * DM, last, lane);
                }
            }
        }
        if (ph + 1 < p.phase_end) xcd_barrier(xb);
    }
}

extern "C" void kernel_launch(void* const* d_in, const int* in_sizes, int n_in, void* d_out, int out_size, void* d_ws, size_t ws_size,
                              hipStream_t stream) {
    static int grid_blocks = 0;
    if (!grid_blocks) {
        int dev = 0, cus = 0, per_cu = 0;
        hipGetDevice(&dev);
        hipDeviceGetAttribute(&cus, hipDeviceAttributeMultiprocessorCount, dev);
        hipOccupancyMaxActiveBlocksPerMultiprocessor(&per_cu, fwd_megakernel, 512, 0);
        if (per_cu > 1) per_cu = 1;
        if (per_cu < 1) per_cu = 1;
        grid_blocks = cus * per_cu;
    }
    Params p{};
    p.x_prompt = (const float*)d_in[0]; p.x_sample = (const float*)d_in[1]; p.mem_prompt = (const float*)d_in[2]; p.mem_sample = (const float*)d_in[3];
    p.norm_pre = (const float*)d_in[4]; p.norm_post = (const float*)d_in[5]; p.w_in = (const float*)d_in[6]; p.pool_w = (const float*)d_in[7];
    p.pool_scale = (const float*)d_in[8]; p.q_norm = (const float*)d_in[9]; p.k_norm = (const float*)d_in[10]; p.mem_norm = (const float*)d_in[11];
    p.w_mem_kv = (const float*)d_in[12]; p.w_out = (const float*)d_in[13];
    p.out = (float*)d_out; p.ws = (unsigned char*)d_ws;
    p.phase_begin = 0; p.phase_end = 1 + 4 * DEPTH;
    if (ws_size < WS_TOTAL) { fprintf(stderr, "workspace too small: %zu < %zu\n", ws_size, (size_t)WS_TOTAL); return; }
    hipMemsetAsync((unsigned char*)d_ws + OFF_BAR, 0, BAR_BYTES, stream);
    void* args[] = {&p};
    hipError_t e = hipLaunchCooperativeKernel((void*)fwd_megakernel, dim3(grid_blocks), dim3(512), args, 0, stream);
    if (e != hipSuccess) fprintf(stderr, "cooperative launch failed: %s (grid %d)\n", hipGetErrorString(e), grid_blocks);
}
```

```cpp
#include <hip/hip_runtime.h>
#include <hip/hip_cooperative_groups.h>
#include <stdint.h>
#include <cstdio>
namespace cg = cooperative_groups;

typedef unsigned short bf16_t;
typedef short bf16x8 __attribute__((ext_vector_type(8)));
typedef float f32x4 __attribute__((ext_vector_type(4)));
typedef float f32x16 __attribute__((ext_vector_type(16)));
typedef unsigned u32x4 __attribute__((ext_vector_type(4)));
typedef unsigned u32x2 __attribute__((ext_vector_type(2)));
typedef __bf16 bf16x2_t __attribute__((ext_vector_type(2)));
typedef float f32x2_t __attribute__((ext_vector_type(2)));
#define DI __device__ __forceinline__

constexpr int NTOK = 49152;
constexpr int NPROMPT = 32768;
constexpr int DM = 1024;
constexpr int INW = 2304;
constexpr int NMEMTOK = 5120;
constexpr int DEPTH = 2;
constexpr float EPS = 1e-6f;
constexpr float L2E = 1.4426950408889634f;

constexpr size_t OFF_H    = 0;
constexpr size_t OFF_Z    = OFF_H + (size_t)NTOK * DM * 2;
constexpr size_t OFF_VT   = OFF_Z + (size_t)NTOK * INW * 2;
constexpr size_t OFF_MIX  = OFF_VT + (size_t)NTOK * 128 * 2;
constexpr size_t OFF_WIN  = OFF_MIX + (size_t)NTOK * DM * 2;
constexpr size_t OFF_WOUT = OFF_WIN + (size_t)DEPTH * INW * DM * 2;
constexpr size_t OFF_WMEM = OFF_WOUT + (size_t)DEPTH * DM * DM * 2;
constexpr size_t OFF_PW   = OFF_WMEM + (size_t)DEPTH * 512 * DM * 2;
constexpr size_t OFF_MH   = OFF_PW + (size_t)DEPTH * 4 * 64 * 64 * 2;
constexpr size_t OFF_KM   = OFF_MH + (size_t)DEPTH * NMEMTOK * DM * 2;
constexpr size_t OFF_VMT  = OFF_KM + (size_t)DEPTH * NMEMTOK * 256 * 2;
constexpr size_t OFF_ROPE = OFF_VMT + (size_t)DEPTH * NMEMTOK * 256 * 2;
constexpr size_t OFF_BAR  = OFF_ROPE + 64 * 16 * 2 * 4;
constexpr size_t BAR_BYTES = 3456 * 4;
constexpr size_t WS_TOTAL = OFF_BAR + BAR_BYTES;

struct Params {
    const float* x_prompt; const float* x_sample; const float* mem_prompt; const float* mem_sample;
    const float* norm_pre; const float* norm_post; const float* w_in; const float* pool_w; const float* pool_scale;
    const float* q_norm; const float* k_norm; const float* mem_norm; const float* w_mem_kv; const float* w_out;
    float* out; unsigned char* ws;
    int phase_begin; int phase_end;
};

DI unsigned pk_bf16(float a, float b) {
    f32x2_t v = {a, b};
    bf16x2_t r = __builtin_convertvector(v, bf16x2_t);
    return __builtin_bit_cast(unsigned, r);
}
DI int opaque_tid() { int t = threadIdx.x; asm volatile("" : "+v"(t)); return t; }
DI void lds_barrier() { asm volatile("s_waitcnt lgkmcnt(0)\n\ts_barrier" ::: "memory"); }
DI float bflo(unsigned u) { return __uint_as_float(u << 16); }
DI float bfhi(unsigned u) { return __uint_as_float(u & 0xffff0000u); }
DI float wave_sum(float v) {
    v += __shfl_xor(v, 1); v += __shfl_xor(v, 2); v += __shfl_xor(v, 4);
    v += __shfl_xor(v, 8); v += __shfl_xor(v, 16); v += __shfl_xor(v, 32);
    return v;
}
DI float xhalf_max(float v) {
    auto r = __builtin_amdgcn_permlane32_swap(__float_as_uint(v), __float_as_uint(v), false, false);
    return fmaxf(__uint_as_float(r[0]), __uint_as_float(r[1]));
}
DI float silu_f(float x) { return x * __builtin_amdgcn_rcpf(1.0f + __builtin_amdgcn_exp2f(-x * L2E)); }
DI f32x4 mfma16(bf16x8 a, bf16x8 b, f32x4 c) { return __builtin_amdgcn_mfma_f32_16x16x32_bf16(a, b, c, 0, 0, 0); }
DI f32x16 mfma32(bf16x8 a, bf16x8 b, f32x16 c) { return __builtin_amdgcn_mfma_f32_32x32x16_bf16(a, b, c, 0, 0, 0); }

DI void transpose_tile(const float* __restrict__ src, int ldn, bf16_t* __restrict__ dst, int ldk, int k0, int n0, unsigned char* smem) {
    float* tile = (float*)smem;
    const int tid = opaque_tid();
    __syncthreads();
#pragma unroll
    for (int i = 0; i < 2; ++i) {
        const int id = tid + 512 * i, r = id >> 4, c4 = id & 15;
        const f32x4 v = *(const f32x4*)(src + (size_t)(k0 + r) * ldn + n0 + c4 * 4);
        tile[r * 65 + c4 * 4 + 0] = v[0]; tile[r * 65 + c4 * 4 + 1] = v[1]; tile[r * 65 + c4 * 4 + 2] = v[2]; tile[r * 65 + c4 * 4 + 3] = v[3];
    }
    __syncthreads();
    {
        const int n = tid >> 3, kc = tid & 7;
        float v[8];
#pragma unroll
        for (int j = 0; j < 8; ++j) v[j] = tile[(kc * 8 + j) * 65 + n];
        u32x4 o; o.x = pk_bf16(v[0], v[1]); o.y = pk_bf16(v[2], v[3]); o.z = pk_bf16(v[4], v[5]); o.w = pk_bf16(v[6], v[7]);
        *(u32x4*)(dst + (size_t)(n0 + n) * ldk + k0 + kc * 8) = o;
    }
}

DI void rms_row_f32(const float* __restrict__ src, const float* __restrict__ g, bf16_t* __restrict__ dst, int lane) {
    f32x4 v[4]; float ss = 0.f;
#pragma unroll
    for (int j = 0; j < 4; ++j) { v[j] = *(const f32x4*)(src + j * 256 + lane * 4); ss += v[j][0] * v[j][0] + v[j][1] * v[j][1] + v[j][2] * v[j][2] + v[j][3] * v[j][3]; }
    ss = wave_sum(ss);
    const float r = rsqrtf(ss * (1.0f / 1024.0f) + EPS);
#pragma unroll
    for (int j = 0; j < 4; ++j) {
        const f32x4 gg = *(const f32x4*)(g + j * 256 + lane * 4);
        u32x2 o; o.x = pk_bf16(v[j][0] * r * gg[0], v[j][1] * r * gg[1]); o.y = pk_bf16(v[j][2] * r * gg[2], v[j][3] * r * gg[3]);
        *(u32x2*)(dst + j * 256 + lane * 4) = o;
    }
}

DI void rope_entry(int idx, float* table) {
    const int n = idx >> 4, pp = idx & 15;
    double fd = 1.0;
    for (int i = 0; i < pp; ++i) fd *= 0.5623413251903491;
    const float f = (float)fd;
    const float a = (float)n * f;
    double r = (double)a;
    const double k = rint(r * 0.15915494309189535);
    r -= k * 6.283185307179586;
    const double r2 = r * r;
    double sn = r, cs = 1.0, ts = r, tc = 1.0;
    for (int i = 1; i <= 16; ++i) {
        tc = -tc * r2 / (double)((2 * i - 1) * (2 * i));
        ts = -ts * r2 / (double)((2 * i) * (2 * i + 1));
        cs += tc; sn += ts;
    }
    table[idx * 2] = (float)cs; table[idx * 2 + 1] = (float)sn;
}

struct EpiArgs {
    bf16_t* C;
    bf16_t* VT;
    const float* qn; const float* kn; const float* rope;
};

template <int MODE>
DI void gemm_tile(const bf16_t* __restrict__ A, const bf16_t* __restrict__ Bt, int m0, int n0, const EpiArgs& e, unsigned char* smem) {
    const int tid = opaque_tid(), lane = tid & 63, wave = tid >> 6;
    const int wm = wave >> 2, wn = wave & 3;
    const int lrow = tid >> 3, lc = tid & 7;
    const unsigned char* Ab = (const unsigned char*)(A + (size_t)m0 * 1024);
    const unsigned char* Bb = (const unsigned char*)(Bt + (size_t)n0 * 1024);
    const unsigned goff = (unsigned)(lrow * 1024 + lc * 8) * 2u;
#define GA(I, KT) (*(const u32x4*)(Ab + (goff + (unsigned)((I) * 131072 + (KT) * 128))))
#define GB(I, KT) (*(const u32x4*)(Bb + (goff + (unsigned)((I) * 131072 + (KT) * 128))))
    const int st_off = lrow * 128 + ((lc ^ ((lrow >> 1) & 7)) << 4);
    const int r16 = lane & 15, q4 = lane >> 4;
    const int fr_off = r16 * 128 + ((q4 ^ (r16 >> 1)) << 4);
    const int a_base = 32768 + (wn * 64) * 128;
    const int b_base = (wm * 128) * 128;
    constexpr int TI = 8;

    f32x4 acc[4][TI];
#pragma unroll
    for (int i = 0; i < 4; ++i)
#pragma unroll
        for (int j = 0; j < TI; ++j) acc[i][j] = (f32x4){0.f, 0.f, 0.f, 0.f};

    u32x4 ra[4], rb[4];
#define G_LOAD(KT) { _Pragma("unroll") for (int i = 0; i < 4; ++i) { ra[i] = GA(i, KT); rb[i] = GB(i, KT); } }
#define G_STORE(OFF) { _Pragma("unroll") for (int i = 0; i < 4; ++i) { *(u32x4*)(smem + (OFF) + st_off + i * 8192) = ra[i]; *(u32x4*)(smem + (OFF) + 32768 + st_off + i * 8192) = rb[i]; } }
#define G_STEP(CUR, NXT, KTL, DO_ST, DO_LD) { \
        { bf16x8 wf[4], tf[TI]; \
          _Pragma("unroll") for (int i = 0; i < 4; ++i) wf[i] = *(const bf16x8*)(smem + (CUR) + a_base + i * 2048 + fr_off); \
          _Pragma("unroll") for (int i = 0; i < 4; ++i) tf[i] = *(const bf16x8*)(smem + (CUR) + b_base + i * 2048 + fr_off); \
          _Pragma("unroll") for (int ti = 0; ti < TI; ++ti) { \
              if (ti == 1) { _Pragma("unroll") for (int i = 4; i < TI; ++i) tf[i] = *(const bf16x8*)(smem + (CUR) + b_base + i * 2048 + fr_off); } \
              _Pragma("unroll") for (int fi = 0; fi < 4; ++fi) acc[fi][ti] = mfma16(wf[fi], tf[ti], acc[fi][ti]); \
              if (DO_ST) { if (ti < 4) *(u32x4*)(smem + (NXT) + st_off + ti * 8192) = ra[ti]; else *(u32x4*)(smem + (NXT) + 32768 + st_off + (ti - 4) * 8192) = rb[ti - 4]; } \
              __builtin_amdgcn_sched_barrier(0); } } \
        { bf16x8 wf[4], tf[TI]; \
          _Pragma("unroll") for (int i = 0; i < 4; ++i) wf[i] = *(const bf16x8*)(smem + (CUR) + a_base + i * 2048 + (fr_off ^ 64)); \
          _Pragma("unroll") for (int i = 0; i < 4; ++i) tf[i] = *(const bf16x8*)(smem + (CUR) + b_base + i * 2048 + (fr_off ^ 64)); \
          _Pragma("unroll") for (int ti = 0; ti < TI; ++ti) { \
              if (ti == 1) { _Pragma("unroll") for (int i = 4; i < TI; ++i) tf[i] = *(const bf16x8*)(smem + (CUR) + b_base + i * 2048 + (fr_off ^ 64)); } \
              _Pragma("unroll") for (int fi = 0; fi < 4; ++fi) acc[fi][ti] = mfma16(wf[fi], tf[ti], acc[fi][ti]); \
              if (DO_LD) { if (ti < 4) ra[ti] = GA(ti, KTL); else rb[ti - 4] = GB(ti - 4, KTL); } \
              __builtin_amdgcn_sched_barrier(0); } } }
    G_LOAD(0);
    G_STORE(0);
    G_LOAD(1);
    lds_barrier();
    for (int kt = 0; kt < 14; kt += 2) {
        G_STEP(0, 65536, kt + 2, true, true);
        lds_barrier();
        G_STEP(65536, 0, kt + 3, true, true);
        lds_barrier();
    }
    G_STEP(0, 65536, 0, true, false);
    lds_barrier();
    G_STEP(65536, 0, 0, false, false);
    lds_barrier();
#undef G_LOAD
#undef G_STORE
#undef G_STEP
#undef GA
#undef GB

    const int cb = n0 + wn * 64;
    const int tokb = m0 + wm * 128 + r16;
    if (MODE == 1) {
#pragma unroll
        for (int ti = 0; ti < TI; ++ti) {
            bf16_t* rowp = e.C + (size_t)(tokb + ti * 16) * 1024 + cb + 4 * q4;
#pragma unroll
            for (int fi = 0; fi < 4; ++fi) {
                u32x2 o; o.x = pk_bf16(acc[fi][ti][0], acc[fi][ti][1]); o.y = pk_bf16(acc[fi][ti][2], acc[fi][ti][3]);
                *(u32x2*)(rowp + fi * 16) = o;
            }
        }
    } else if (MODE == 2) {
        if (cb < 256) {
#pragma unroll
            for (int ti = 0; ti < TI; ++ti) {
                bf16_t* rowp = e.C + (size_t)(tokb + ti * 16) * 256 + cb + 4 * q4;
#pragma unroll
                for (int fi = 0; fi < 4; ++fi) {
                    u32x2 o; o.x = pk_bf16(acc[fi][ti][0], acc[fi][ti][1]); o.y = pk_bf16(acc[fi][ti][2], acc[fi][ti][3]);
                    *(u32x2*)(rowp + fi * 16) = o;
                }
            }
        } else {
            const int hx = (cb - 256) >> 6;
#pragma unroll
            for (int ti = 0; ti < TI; ++ti) {
                const int mt = tokb + ti * 16, b = mt >> 8, m = mt & 255;
                bf16_t* bp = e.VT + ((size_t)(b * 4 + hx) * 64) * 256 + m;
#pragma unroll
                for (int fi = 0; fi < 4; ++fi)
#pragma unroll
                    for (int i = 0; i < 4; ++i) bp[(size_t)(fi * 16 + 4 * q4 + i) * 256] = (bf16_t)(pk_bf16(acc[fi][ti][i], 0.f) & 0xffffu);
            }
        }
    } else {
        if (cb >= 512 && cb < 1152) {
            const bool isq = cb < 1024;
            const float* gn = isq ? e.qn : e.kn;
            const float osc = isq ? 0.125f : 1.0f;
            f32x4 g[4];
#pragma unroll
            for (int fi = 0; fi < 4; ++fi) g[fi] = *(const f32x4*)(gn + fi * 16 + 4 * q4);
#pragma unroll
            for (int ti = 0; ti < TI; ++ti) {
                const int tok = tokb + ti * 16;
                float ss = 0.f;
#pragma unroll
                for (int fi = 0; fi < 4; ++fi)
#pragma unroll
                    for (int i = 0; i < 4; ++i) ss += acc[fi][ti][i] * acc[fi][ti][i];
                ss += __shfl_xor(ss, 16); ss += __shfl_xor(ss, 32);
                const float rinv = rsqrtf(ss * (1.0f / 64.0f) + EPS);
                const int t = (tok < NPROMPT) ? (tok & 2047) : (tok & 4095);
                const int rowi = t >> 6, coli = t & 63;
                const f32x4* rt = (const f32x4*)(e.rope + (rowi * 16 + 4 * q4) * 2);
                const f32x4* ct = (const f32x4*)(e.rope + (coli * 16 + 4 * q4) * 2);
                const f32x4 r01 = rt[0], r23 = rt[1], c01 = ct[0], c23 = ct[1];
                const float rc[4] = {r01[0], r01[2], r23[0], r23[2]}, rs[4] = {r01[1], r01[3], r23[1], r23[3]};
                const float cc[4] = {c01[0], c01[2], c23[0], c23[2]}, cs[4] = {c01[1], c01[3], c23[1], c23[3]};
                float o[4][4];
#pragma unroll
                for (int i = 0; i < 4; ++i) {
                    const float a0 = acc[0][ti][i] * rinv * g[0][i], b0 = acc[1][ti][i] * rinv * g[1][i];
                    const float a1 = acc[2][ti][i] * rinv * g[2][i], b1 = acc[3][ti][i] * rinv * g[3][i];
                    o[0][i] = (a0 * rc[i] - b0 * rs[i]) * osc; o[1][i] = (b0 * rc[i] + a0 * rs[i]) * osc;
                    o[2][i] = (a1 * cc[i] - b1 * cs[i]) * osc; o[3][i] = (b1 * cc[i] + a1 * cs[i]) * osc;
                }
                bf16_t* rowp = e.C + (size_t)tok * INW + cb + 4 * q4;
#pragma unroll
                for (int fi = 0; fi < 4; ++fi) {
                    u32x2 w; w.x = pk_bf16(o[fi][0], o[fi][1]); w.y = pk_bf16(o[fi][2], o[fi][3]);
                    *(u32x2*)(rowp + fi * 16) = w;
                }
            }
        } else if (cb >= 1152 && cb < 1280) {
            const int kvh = (cb - 1152) >> 6;
#pragma unroll
            for (int ti = 0; ti < TI; ++ti) {
                const int tok = tokb + ti * 16;
                bf16_t* bp; size_t T;
                if (tok < NPROMPT) { const int b = tok >> 11, t = tok & 2047; T = 2048; bp = e.VT + ((size_t)(b * 2 + kvh) * 64) * 2048 + t; }
                else { const int b = (tok - NPROMPT) >> 12, t = tok & 4095; T = 4096; bp = e.VT + (size_t)NPROMPT * 128 + ((size_t)(b * 2 + kvh) * 64) * 4096 + t; }
#pragma unroll
                for (int fi = 0; fi < 4; ++fi)
#pragma unroll
                    for (int i = 0; i < 4; ++i) bp[(size_t)(fi * 16 + 4 * q4 + i) * T] = (bf16_t)(pk_bf16(acc[fi][ti][i], 0.f) & 0xffffu);
            }
        } else {
            const int kind = (cb < 256) ? 0 : ((cb >= 1792 && cb < 2048) ? 2 : 1);
#pragma unroll
            for (int ti = 0; ti < TI; ++ti) {
                bf16_t* rowp = e.C + (size_t)(tokb + ti * 16) * INW + cb + 4 * q4;
#pragma unroll
                for (int fi = 0; fi < 4; ++fi) {
                    float v[4];
#pragma unroll
                    for (int i = 0; i < 4; ++i) { const float x = acc[fi][ti][i]; v[i] = (kind == 0) ? x : ((kind == 2) ? x * 0.125f : silu_f(x)); }
                    u32x2 o; o.x = pk_bf16(v[0], v[1]); o.y = pk_bf16(v[2], v[3]);
                    *(u32x2*)(rowp + fi * 16) = o;
                }
            }
        }
    }
}

#define SB_() __builtin_amdgcn_sched_barrier(0)
#define KFRAG(KS, KB) (*(const bf16x8*)(kp + (KB) * 4096 + k_off + ((((KS) * 2 + h) ^ kswz) << 4)))
#define VFRAG(KK, DB) (*(const bf16x8*)(vp + (DB) * 4096 + v_off + ((((KK) * 2 + h) ^ vswz) << 4)))
#define EXP4(S, I0) { _Pragma("unroll") for (int i_ = (I0); i_ < (I0) + 4; ++i_) { S[i_] = __builtin_amdgcn_exp2f(S[i_] * L2E - mb); rs += S[i_]; } }
#define EXP4F(S, I0) { f32x2_t a_ = {S[(I0)], S[(I0) + 1]}, b_ = {S[(I0) + 2], S[(I0) + 3]}; \
        a_ = a_ * (f32x2_t){L2E, L2E} - (f32x2_t){mb, mb}; b_ = b_ * (f32x2_t){L2E, L2E} - (f32x2_t){mb, mb}; \
        S[(I0)] = __builtin_amdgcn_exp2f(a_.x); S[(I0) + 1] = __builtin_amdgcn_exp2f(a_.y); S[(I0) + 2] = __builtin_amdgcn_exp2f(b_.x); S[(I0) + 3] = __builtin_amdgcn_exp2f(b_.y); \
        rs2 += (f32x2_t){S[(I0)], S[(I0) + 1]} + (f32x2_t){S[(I0) + 2], S[(I0) + 3]}; }
#define EXPQ(S, I0) { if (FIXM) EXP4F(S, I0) else EXP4(S, I0) }
#define PACK8(S, I0) ({ u32x4 t_; t_.x = pk_bf16(S[(I0)], S[(I0) + 1]); t_.y = pk_bf16(S[(I0) + 2], S[(I0) + 3]); t_.z = pk_bf16(S[(I0) + 4], S[(I0) + 5]); t_.w = pk_bf16(S[(I0) + 6], S[(I0) + 7]); __builtin_bit_cast(bf16x8, t_); })
DI float max8(const f32x16& s, int i0, float mx) {
    mx = fmaxf(fmaxf(mx, s[i0]), s[i0 + 1]); mx = fmaxf(fmaxf(mx, s[i0 + 2]), s[i0 + 3]);
    mx = fmaxf(fmaxf(mx, s[i0 + 4]), s[i0 + 5]); mx = fmaxf(fmaxf(mx, s[i0 + 6]), s[i0 + 7]);
    return mx;
}
#define EXP2F(S, I0) { S[(I0)] = __builtin_amdgcn_exp2f(S[(I0)] * L2E - mb); S[(I0) + 1] = __builtin_amdgcn_exp2f(S[(I0) + 1] * L2E - mb); rs += S[(I0)] + S[(I0) + 1]; \
        asm volatile("" : "+v"(S[(I0)]), "+v"(S[(I0) + 1]), "+v"(rs)); }
#define PIN1(X) asm volatile("" : "+v"(X))
template <bool DO_PV, bool DO_QK>
DI void attn_step_fix(f32x16& s0, f32x16& s1, f32x16& n0, f32x16& n1, const bf16x8 (&pp)[4], bf16x8 (&pc)[4],
                      f32x16& o0, f32x16& o1, const float m, float& lsum, const bf16x8 (&qf)[4],
                      const unsigned char* kp, const unsigned char* vp, int k_off, int kswz, int v_off, int vswz, int h) {
    bf16x8 va0, vb0, va1, vb1, va2, vb2, va3, vb3, ka0, kb0, ka1, kb1, ka2, kb2, ka3, kb3;
    const float mb = m * L2E;
    float rs = 0.f;
    if (DO_PV) { va0 = VFRAG(0, 0); vb0 = VFRAG(0, 1); va1 = VFRAG(1, 0); vb1 = VFRAG(1, 1); }
    EXP2F(s0, 0);  if (DO_PV) { o0 = mfma32(va0, pp[0], o0); va2 = VFRAG(2, 0); vb2 = VFRAG(2, 1); } SB_();
    EXP2F(s0, 2);  if (DO_PV) { o1 = mfma32(vb0, pp[0], o1); va3 = VFRAG(3, 0); vb3 = VFRAG(3, 1); } SB_();
    EXP2F(s0, 4);  if (DO_PV) { o0 = mfma32(va1, pp[1], o0); } if (DO_QK) { ka0 = KFRAG(0, 0); kb0 = KFRAG(0, 1); } SB_();
    EXP2F(s0, 6);  if (DO_PV) { o1 = mfma32(vb1, pp[1], o1); } if (DO_QK) { ka1 = KFRAG(1, 0); kb1 = KFRAG(1, 1); } SB_();
    EXP2F(s0, 8);  if (DO_PV) { o0 = mfma32(va2, pp[2], o0); } SB_();
    EXP2F(s0, 10); if (DO_PV) { o1 = mfma32(vb2, pp[2], o1); } pc[0] = PACK8(s0, 0); PIN1(pc[0]); SB_();
    EXP2F(s0, 12); if (DO_PV) { o0 = mfma32(va3, pp[3], o0); } SB_();
    EXP2F(s0, 14); if (DO_PV) { o1 = mfma32(vb3, pp[3], o1); } SB_();
    EXP2F(s1, 0);  if (DO_QK) { n0 = mfma32(ka0, qf[0], (f32x16){0.f, 0.f, 0.f, 0.f, 0.f, 0.f, 0.f, 0.f, 0.f, 0.f, 0.f, 0.f, 0.f, 0.f, 0.f, 0.f}); ka2 = KFRAG(2, 0); kb2 = KFRAG(2, 1); } pc[1] = PACK8(s0, 8); PIN1(pc[1]); SB_();
    EXP2F(s1, 2);  if (DO_QK) { n1 = mfma32(kb0, qf[0], (f32x16){0.f, 0.f, 0.f, 0.f, 0.f, 0.f, 0.f, 0.f, 0.f, 0.f, 0.f, 0.f, 0.f, 0.f, 0.f, 0.f}); ka3 = KFRAG(3, 0); kb3 = KFRAG(3, 1); } SB_();
    EXP2F(s1, 4);  if (DO_QK) { n0 = mfma32(ka1, qf[1], n0); } SB_();
    EXP2F(s1, 6);  if (DO_QK) { n1 = mfma32(kb1, qf[1], n1); } SB_();
    EXP2F(s1, 8);  if (DO_QK) { n0 = mfma32(ka2, qf[2], n0); } pc[2] = PACK8(s1, 0); PIN1(pc[2]); SB_();
    EXP2F(s1, 10); if (DO_QK) { n1 = mfma32(kb2, qf[2], n1); } SB_();
    EXP2F(s1, 12); if (DO_QK) { n0 = mfma32(ka3, qf[3], n0); } SB_();
    EXP2F(s1, 14); if (DO_QK) { n1 = mfma32(kb3, qf[3], n1); } pc[3] = PACK8(s1, 8); PIN1(pc[3]);
    lsum += rs;
    SB_();
}
template <bool DO_PV, bool DO_QK, bool FIXM>
DI void attn_step(f32x16& s0, f32x16& s1, f32x16& n0, f32x16& n1, const bf16x8 (&pp)[4], bf16x8 (&pc)[4],
                  f32x16& o0, f32x16& o1, float& m, float& lsum, const bf16x8 (&qf)[4],
                  const unsigned char* kp, const unsigned char* vp, int k_off, int kswz, int v_off, int vswz, int h) {
    if (FIXM) { attn_step_fix<DO_PV, DO_QK>(s0, s1, n0, n1, pp, pc, o0, o1, m, lsum, qf, kp, vp, k_off, kswz, v_off, vswz, h); return; }
    bf16x8 va0, vb0, va1, vb1, va2, vb2, va3, vb3, ka0, kb0, ka1, kb1, ka2, kb2, ka3, kb3;
    if (DO_PV) { va0 = VFRAG(0, 0); vb0 = VFRAG(0, 1); va1 = VFRAG(1, 0); vb1 = VFRAG(1, 1); }
    float mx = s0[0];
    if (DO_PV) o0 = mfma32(va0, pp[0], o0);
    if (!FIXM) mx = max8(s0, 0, mx);
    SB_();
    if (DO_PV) { o1 = mfma32(vb0, pp[0], o1); va2 = VFRAG(2, 0); vb2 = VFRAG(2, 1); }
    if (!FIXM) mx = max8(s0, 8, mx);
    SB_();
    if (DO_PV) { o0 = mfma32(va1, pp[1], o0); va3 = VFRAG(3, 0); vb3 = VFRAG(3, 1); }
    if (!FIXM) mx = max8(s1, 0, mx);
    SB_();
    if (DO_PV) o1 = mfma32(vb1, pp[1], o1);
    bool need = false; float alpha = 1.0f;
    if (!FIXM) {
        mx = max8(s1, 8, mx);
        mx = xhalf_max(mx);
        need = mx > m + 5.5f;
        const float mnew = need ? mx : m;
        alpha = __builtin_amdgcn_exp2f((m - mnew) * L2E);
        m = mnew;
    }
    const float mb = m * L2E;
    float rs = 0.f; f32x2_t rs2 = {0.f, 0.f};
    SB_();
    if (DO_PV) o0 = mfma32(va2, pp[2], o0);
    if (DO_QK) { ka0 = KFRAG(0, 0); kb0 = KFRAG(0, 1); }
    EXPQ(s0, 0);
    SB_();
    if (DO_PV) o1 = mfma32(vb2, pp[2], o1);
    if (DO_QK) { ka1 = KFRAG(1, 0); kb1 = KFRAG(1, 1); }
    EXPQ(s0, 4);
    SB_();
    if (DO_PV) o0 = mfma32(va3, pp[3], o0);
    EXPQ(s0, 8);
    SB_();
    if (DO_PV) o1 = mfma32(vb3, pp[3], o1);
    EXPQ(s0, 12);
    SB_();
    if (DO_QK) { n0 = mfma32(ka0, qf[0], (f32x16){0.f, 0.f, 0.f, 0.f, 0.f, 0.f, 0.f, 0.f, 0.f, 0.f, 0.f, 0.f, 0.f, 0.f, 0.f, 0.f}); ka2 = KFRAG(2, 0); kb2 = KFRAG(2, 1); }
    EXPQ(s1, 0);
    SB_();
    if (DO_QK) { n1 = mfma32(kb0, qf[0], (f32x16){0.f, 0.f, 0.f, 0.f, 0.f, 0.f, 0.f, 0.f, 0.f, 0.f, 0.f, 0.f, 0.f, 0.f, 0.f, 0.f}); ka3 = KFRAG(3, 0); kb3 = KFRAG(3, 1); }
    EXPQ(s1, 4);
    SB_();
    if (DO_QK) n0 = mfma32(ka1, qf[1], n0);
    EXPQ(s1, 8);
    SB_();
    if (DO_QK) n1 = mfma32(kb1, qf[1], n1);
    EXPQ(s1, 12);
    SB_();
    if (DO_QK) n0 = mfma32(ka2, qf[2], n0);
    pc[0] = PACK8(s0, 0);
    SB_();
    if (DO_QK) n1 = mfma32(kb2, qf[2], n1);
    pc[1] = PACK8(s0, 8);
    SB_();
    if (DO_QK) n0 = mfma32(ka3, qf[3], n0);
    pc[2] = PACK8(s1, 0);
    SB_();
    if (DO_QK) n1 = mfma32(kb3, qf[3], n1);
    pc[3] = PACK8(s1, 8);
    if (FIXM) lsum += rs2.x + rs2.y; else lsum = lsum * alpha + rs;
    SB_();
    if (!FIXM) {
        if (__builtin_amdgcn_ballot_w64(need)) {
#pragma unroll
            for (int i = 0; i < 16; ++i) { o0[i] *= alpha; o1[i] *= alpha; }
        }
    }
}

template <bool FIXM>
DI void attn_item(const bf16_t* __restrict__ Q, int ldq, const bf16_t* __restrict__ K, int ldk, const bf16_t* __restrict__ VT, int ldv,
                  int nkeys, bf16_t* __restrict__ O, const bf16_t* __restrict__ G, unsigned char* smem, float mfix) {
    const int tid = opaque_tid(), lane = tid & 63, wave = tid >> 6;
    const int r = lane & 31, h = lane >> 5;
    bf16x8 qf[4];
    {
        const bf16_t* qp = Q + (size_t)(wave * 32 + r) * ldq + h * 8;
#pragma unroll
        for (int ks = 0; ks < 4; ++ks) qf[ks] = *(const bf16x8*)(qp + ks * 16);
    }
    const int lrow = tid >> 3, lc = tid & 7;
    const bf16_t* Kg = K + (size_t)lrow * ldk + lc * 8;
    const bf16_t* Vg = VT + (size_t)lrow * ldv + lc * 8;
    const int st_off = lrow * 128 + ((lc ^ ((lrow >> 1) & 7)) << 4);
    const int pr = (r & ~12) | ((r & 4) << 1) | ((r & 8) >> 1);
    const int kswz = (pr >> 1) & 7, vswz = (r >> 1) & 7;
    const int k_off = pr * 128, v_off = r * 128;
    const int nt = nkeys >> 6;

    f32x16 o0, o1, sa0, sa1, sb0, sb1;
#pragma unroll
    for (int i = 0; i < 16; ++i) { o0[i] = 0.f; o1[i] = 0.f; }
    float m = FIXM ? mfix : -1e30f, lsum = 0.f;
    bf16x8 pa[4], pb[4];

    u32x4 rk, rv;
#define A_LOAD(U) { const int kt_ = ((U) + 2 < nt) ? (U) + 2 : nt - 1; rk = *(const u32x4*)(Kg + (size_t)(kt_ * 64) * ldk); rv = *(const u32x4*)(Vg + (U) * 64); }
#define A_STORE(OFF) { *(u32x4*)(smem + (OFF) + st_off) = rk; *(u32x4*)(smem + (OFF) + 8192 + st_off) = rv; }
    rk = *(const u32x4*)(Kg); rv = *(const u32x4*)(Kg + (size_t)64 * ldk);
    __syncthreads();
    A_STORE(16384);
    A_LOAD(0);
    A_STORE(0);
    A_LOAD(1);
    lds_barrier();
    {
        const unsigned char* kp = smem + 16384;
        sa0 = mfma32(KFRAG(0, 0), qf[0], (f32x16){0.f, 0.f, 0.f, 0.f, 0.f, 0.f, 0.f, 0.f, 0.f, 0.f, 0.f, 0.f, 0.f, 0.f, 0.f, 0.f});
        sa1 = mfma32(KFRAG(0, 1), qf[0], (f32x16){0.f, 0.f, 0.f, 0.f, 0.f, 0.f, 0.f, 0.f, 0.f, 0.f, 0.f, 0.f, 0.f, 0.f, 0.f, 0.f});
#pragma unroll
        for (int ks = 1; ks < 4; ++ks) { sa0 = mfma32(KFRAG(ks, 0), qf[ks], sa0); sa1 = mfma32(KFRAG(ks, 1), qf[ks], sa1); }
    }
    attn_step<false, true, FIXM>(sa0, sa1, sb0, sb1, pb, pa, o0, o1, m, lsum, qf, smem + 16384 + 8192, smem, k_off, kswz, v_off, vswz, h);
    lds_barrier();
    for (int t = 1; t < nt - 1; t += 2) {
        A_STORE(16384);
        A_LOAD(t + 1);
        SB_();
        attn_step<true, true, FIXM>(sb0, sb1, sa0, sa1, pa, pb, o0, o1, m, lsum, qf, smem, smem + 8192, k_off, kswz, v_off, vswz, h);
        lds_barrier();
        A_STORE(0);
        A_LOAD(t + 2);
        SB_();
        attn_step<true, true, FIXM>(sa0, sa1, sb0, sb1, pb, pa, o0, o1, m, lsum, qf, smem + 16384, smem + 16384 + 8192, k_off, kswz, v_off, vswz, h);
        lds_barrier();
    }
    A_STORE(16384);
    const bf16_t* gp = G + (size_t)(wave * 32 + r) * INW + 4 * h;
    u32x2 gga[4], ggb[4];
#pragma unroll
    for (int gq = 0; gq < 4; ++gq) { gga[gq] = *(const u32x2*)(gp + 8 * gq); ggb[gq] = *(const u32x2*)(gp + 32 + 8 * gq); }
    SB_();
    attn_step<true, false, FIXM>(sb0, sb1, sa0, sa1, pa, pb, o0, o1, m, lsum, qf, smem, smem + 8192, k_off, kswz, v_off, vswz, h);
    lds_barrier();
    {
        const unsigned char* vp = smem + 16384 + 8192;
#pragma unroll
        for (int kk = 0; kk < 4; ++kk) { o0 = mfma32(VFRAG(kk, 0), pb[kk], o0); o1 = mfma32(VFRAG(kk, 1), pb[kk], o1); }
    }
#undef A_LOAD
#undef A_STORE
    const float lt = lsum + __shfl_xor(lsum, 32);
    const float inv = 1.0f / lt;
    bf16_t* op = O + (size_t)(wave * 32 + r) * 1024 + 4 * h;
#pragma unroll
    for (int gq = 0; gq < 4; ++gq) {
        {
            const u32x2 gg = gga[gq];
            u32x2 w;
            w.x = pk_bf16(o0[4 * gq] * inv * bflo(gg.x), o0[4 * gq + 1] * inv * bfhi(gg.x));
            w.y = pk_bf16(o0[4 * gq + 2] * inv * bflo(gg.y), o0[4 * gq + 3] * inv * bfhi(gg.y));
            *(u32x2*)(op + 8 * gq) = w;
        }
        {
            const u32x2 gg = ggb[gq];
            u32x2 w;
            w.x = pk_bf16(o1[4 * gq] * inv * bflo(gg.x), o1[4 * gq + 1] * inv * bfhi(gg.x));
            w.y = pk_bf16(o1[4 * gq + 2] * inv * bflo(gg.y), o1[4 * gq + 3] * inv * bfhi(gg.y));
            *(u32x2*)(op + 32 + 8 * gq) = w;
        }
    }
}

DI void cross_item(const bf16_t* __restrict__ Q, const bf16_t* __restrict__ K, const bf16_t* __restrict__ VT,
                   bf16_t* __restrict__ O, const bf16_t* __restrict__ G, unsigned char* smem) {
    const int tid = opaque_tid(), lane = tid & 63, wave = tid >> 6;
    const int r = lane & 31, h = lane >> 5;
    bf16x8 qf[4];
    {
        const bf16_t* qp = Q + (size_t)(wave * 32 + r) * INW + h * 8;
#pragma unroll
        for (int ks = 0; ks < 4; ++ks) qf[ks] = *(const bf16x8*)(qp + ks * 16);
    }
    const int lrow = tid >> 3, lc = tid & 7;
    const int st_off = lrow * 128 + ((lc ^ ((lrow >> 1) & 7)) << 4);
    {
        u32x4 kk[4], vv[4];
#pragma unroll
        for (int i = 0; i < 4; ++i) { kk[i] = *(const u32x4*)(K + (size_t)(lrow + 64 * i) * 256 + lc * 8); vv[i] = *(const u32x4*)(VT + (size_t)lrow * 256 + (i * 8 + lc) * 8); }
        __syncthreads();
#pragma unroll
        for (int i = 0; i < 4; ++i) { *(u32x4*)(smem + i * 16384 + st_off) = kk[i]; *(u32x4*)(smem + i * 16384 + 8192 + st_off) = vv[i]; }
    }
    const bf16_t* gp = G + (size_t)(wave * 32 + r) * INW + 4 * h;
    u32x2 gga[4], ggb[4];
#pragma unroll
    for (int gq = 0; gq < 4; ++gq) { gga[gq] = *(const u32x2*)(gp + 8 * gq); ggb[gq] = *(const u32x2*)(gp + 32 + 8 * gq); }
    __syncthreads();
    const int pr = (r & ~12) | ((r & 4) << 1) | ((r & 8) >> 1);
    const int kswz = (pr >> 1) & 7, vswz = (r >> 1) & 7;
    const int k_off = pr * 128, v_off = r * 128;
    f32x16 o0, o1;
#pragma unroll
    for (int i = 0; i < 16; ++i) { o0[i] = 0.f; o1[i] = 0.f; }
    float m = -1e30f, lsum = 0.f;
#pragma unroll 1
    for (int kt = 0; kt < 4; ++kt) {
        const unsigned char* kp = smem + kt * 16384;
        const unsigned char* vp = kp + 8192;
        f32x16 s0, s1;
        s0 = mfma32(KFRAG(0, 0), qf[0], (f32x16){0.f, 0.f, 0.f, 0.f, 0.f, 0.f, 0.f, 0.f, 0.f, 0.f, 0.f, 0.f, 0.f, 0.f, 0.f, 0.f});
        s1 = mfma32(KFRAG(0, 1), qf[0], (f32x16){0.f, 0.f, 0.f, 0.f, 0.f, 0.f, 0.f, 0.f, 0.f, 0.f, 0.f, 0.f, 0.f, 0.f, 0.f, 0.f});
#pragma unroll
        for (int ks = 1; ks < 4; ++ks) { s0 = mfma32(KFRAG(ks, 0), qf[ks], s0); s1 = mfma32(KFRAG(ks, 1), qf[ks], s1); }
        float mx = s0[0];
        mx = max8(s0, 0, mx); mx = max8(s0, 8, mx); mx = max8(s1, 0, mx); mx = max8(s1, 8, mx);
        mx = xhalf_max(mx);
        const float mnew = fmaxf(m, mx);
        const float alpha = __builtin_amdgcn_exp2f((m - mnew) * L2E);
        m = mnew;
        const float mb = mnew * L2E;
        float rs = 0.f;
#pragma unroll
        for (int i = 0; i < 16; ++i) { s0[i] = __builtin_amdgcn_exp2f(s0[i] * L2E - mb); s1[i] = __builtin_amdgcn_exp2f(s1[i] * L2E - mb); rs += s0[i] + s1[i]; }
        lsum = lsum * alpha + rs;
#pragma unroll
        for (int i = 0; i < 16; ++i) { o0[i] *= alpha; o1[i] *= alpha; }
        bf16x8 pf[4];
        pf[0] = PACK8(s0, 0); pf[1] = PACK8(s0, 8); pf[2] = PACK8(s1, 0); pf[3] = PACK8(s1, 8);
#pragma unroll
        for (int kk2 = 0; kk2 < 4; ++kk2) { o0 = mfma32(VFRAG(kk2, 0), pf[kk2], o0); o1 = mfma32(VFRAG(kk2, 1), pf[kk2], o1); }
    }
    const float lt = lsum + __shfl_xor(lsum, 32);
    const float inv = 1.0f / lt;
    bf16_t* op = O + (size_t)(wave * 32 + r) * 1024 + 4 * h;
#pragma unroll
    for (int gq = 0; gq < 4; ++gq) {
        {
            const u32x2 gg = gga[gq];
            u32x2 w;
            w.x = pk_bf16(o0[4 * gq] * inv * bflo(gg.x), o0[4 * gq + 1] * inv * bfhi(gg.x));
            w.y = pk_bf16(o0[4 * gq + 2] * inv * bflo(gg.y), o0[4 * gq + 3] * inv * bfhi(gg.y));
            *(u32x2*)(op + 8 * gq) = w;
        }
        {
            const u32x2 gg = ggb[gq];
            u32x2 w;
            w.x = pk_bf16(o1[4 * gq] * inv * bflo(gg.x), o1[4 * gq + 1] * inv * bfhi(gg.x));
            w.y = pk_bf16(o1[4 * gq + 2] * inv * bflo(gg.y), o1[4 * gq + 3] * inv * bfhi(gg.y));
            *(u32x2*)(op + 32 + 8 * gq) = w;
        }
    }
}

DI void pool_item(const bf16_t* __restrict__ Z, const bf16_t* __restrict__ PWT, const float* __restrict__ pscale, bf16_t* __restrict__ MIX,
                  int tokg0, unsigned char* smem) {
    const int tid = opaque_tid(), lane = tid & 63, wave = tid >> 6;
    const int T = (tokg0 < NPROMPT) ? 2048 : 4096;
    const int t0 = tokg0 & (T - 1);
    constexpr int RS = 528;
    const int g = wave & 3, half = 1 << g;
    const int r16 = lane & 15, q4 = lane >> 4;
    const bf16_t* pw = PWT + (size_t)g * 4096 + r16 * 64 + q4 * 8;
    bf16x8 wfr[4][2]; f32x4 psr[4]; u32x2 ggr[2][4];
#pragma unroll
    for (int fi = 0; fi < 4; ++fi) {
        psr[fi] = *(const f32x4*)(pscale + g * 64 + fi * 16 + 4 * q4);
#pragma unroll
        for (int ks = 0; ks < 2; ++ks) wfr[fi][ks] = *(const bf16x8*)(pw + fi * 16 * 64 + ks * 32);
#pragma unroll
        for (int t2 = 0; t2 < 2; ++t2) ggr[t2][fi] = *(const u32x2*)(Z + ((size_t)tokg0 + ((wave >> 2) * 2 + t2) * 16 + r16) * INW + 256 + g * 64 + fi * 16 + 4 * q4);
    }
    __syncthreads();
    for (int id = tid; id < 80 * 32; id += 512) {
        const int rr = id >> 5, c = id & 31;
        const int t = t0 - 8 + rr;
        u32x4 v = (u32x4){0u, 0u, 0u, 0u};
        if (t >= 0 && t < T) v = *(const u32x4*)(Z + (size_t)(tokg0 - 8 + rr) * INW + c * 8);
        *(u32x4*)(smem + rr * RS + c * 16) = v;
    }
    __syncthreads();
    {
        const int th = wave >> 2;
        bf16x8 df[2][2];
#pragma unroll
        for (int t2 = 0; t2 < 2; ++t2)
#pragma unroll
            for (int ks = 0; ks < 2; ++ks) {
                const int tl = (th * 2 + t2) * 16 + r16, t = t0 + tl;
                const int lo = max(t - half, 0), hi = min(t + half, T);
                const float icnt = 1.0f / (float)(hi - lo);
                float s[8];
#pragma unroll
                for (int j = 0; j < 8; ++j) s[j] = 0.f;
                const unsigned char* bp = smem + (tl + 8 - half) * RS + (g * 64 + ks * 32 + q4 * 8) * 2;
                for (int j = 0; j < 2 * half; ++j) {
                    const u32x4 v = *(const u32x4*)(bp + j * RS);
                    s[0] += bflo(v.x); s[1] += bfhi(v.x); s[2] += bflo(v.y); s[3] += bfhi(v.y);
                    s[4] += bflo(v.z); s[5] += bfhi(v.z); s[6] += bflo(v.w); s[7] += bfhi(v.w);
                }
                const u32x4 c = *(const u32x4*)(bp + half * RS);
                u32x4 o;
                o.x = pk_bf16(s[0] * icnt - bflo(c.x), s[1] * icnt - bfhi(c.x));
                o.y = pk_bf16(s[2] * icnt - bflo(c.y), s[3] * icnt - bfhi(c.y));
                o.z = pk_bf16(s[4] * icnt - bflo(c.z), s[5] * icnt - bfhi(c.z));
                o.w = pk_bf16(s[6] * icnt - bflo(c.w), s[7] * icnt - bfhi(c.w));
                df[t2][ks] = __builtin_bit_cast(bf16x8, o);
            }
        f32x4 acc[4][2];
#pragma unroll
        for (int i = 0; i < 4; ++i)
#pragma unroll
            for (int j = 0; j < 2; ++j) acc[i][j] = (f32x4){0.f, 0.f, 0.f, 0.f};
#pragma unroll
        for (int fi = 0; fi < 4; ++fi)
#pragma unroll
            for (int ks = 0; ks < 2; ++ks) {
                const bf16x8 wf = wfr[fi][ks];
#pragma unroll
                for (int t2 = 0; t2 < 2; ++t2) acc[fi][t2] = mfma16(wf, df[t2][ks], acc[fi][t2]);
            }
#pragma unroll
        for (int t2 = 0; t2 < 2; ++t2) {
            const size_t tok = (size_t)tokg0 + (th * 2 + t2) * 16 + r16;
#pragma unroll
            for (int fi = 0; fi < 4; ++fi) {
                const int n = g * 64 + fi * 16 + 4 * q4;
                const f32x4 ps = psr[fi];
                const u32x2 gg = ggr[t2][fi];
                u32x2 w;
                w.x = pk_bf16(acc[fi][t2][0] * ps[0] * bflo(gg.x), acc[fi][t2][1] * ps[1] * bfhi(gg.x));
                w.y = pk_bf16(acc[fi][t2][2] * ps[2] * bflo(gg.y), acc[fi][t2][3] * ps[3] * bfhi(gg.y));
                *(u32x2*)(MIX + tok * 1024 + n) = w;
            }
        }
    }
}

DI void post_row(const float* __restrict__ xsrc, bf16_t* __restrict__ yh, const float* __restrict__ gpost, const float* __restrict__ gpre_next,
                 float* __restrict__ xdst, bool last, int lane) {
    u32x4 yv[2]; f32x4 xv[4];
#pragma unroll
    for (int j = 0; j < 2; ++j) yv[j] = *(const u32x4*)(yh + j * 512 + lane * 8);
#pragma unroll
    for (int j = 0; j < 2; ++j) { xv[2 * j] = *(const f32x4*)(xsrc + j * 512 + lane * 8); xv[2 * j + 1] = *(const f32x4*)(xsrc + j * 512 + lane * 8 + 4); }
    float y[16];
#pragma unroll
    for (int j = 0; j < 2; ++j) {
        y[8 * j + 0] = bflo(yv[j].x); y[8 * j + 1] = bfhi(yv[j].x); y[8 * j + 2] = bflo(yv[j].y); y[8 * j + 3] = bfhi(yv[j].y);
        y[8 * j + 4] = bflo(yv[j].z); y[8 * j + 5] = bfhi(yv[j].z); y[8 * j + 6] = bflo(yv[j].w); y[8 * j + 7] = bfhi(yv[j].w);
    }
    float ss = 0.f;
#pragma unroll
    for (int i = 0; i < 16; ++i) ss += y[i] * y[i];
    ss = wave_sum(ss);
    const float r = rsqrtf(ss * (1.0f / 1024.0f) + EPS);
    float xn[16]; float ss2 = 0.f;
#pragma unroll
    for (int j = 0; j < 2; ++j) {
        const f32x4 g0 = *(const f32x4*)(gpost + j * 512 + lane * 8), g1 = *(const f32x4*)(gpost + j * 512 + lane * 8 + 4);
#pragma unroll
        for (int i = 0; i < 4; ++i) {
            xn[8 * j + i] = xv[2 * j][i] + y[8 * j + i] * r * g0[i];
            xn[8 * j + 4 + i] = xv[2 * j + 1][i] + y[8 * j + 4 + i] * r * g1[i];
        }
    }
#pragma unroll
    for (int i = 0; i < 16; ++i) ss2 += xn[i] * xn[i];
#pragma unroll
    for (int j = 0; j < 2; ++j) {
        *(f32x4*)(xdst + j * 512 + lane * 8) = (f32x4){xn[8 * j], xn[8 * j + 1], xn[8 * j + 2], xn[8 * j + 3]};
        *(f32x4*)(xdst + j * 512 + lane * 8 + 4) = (f32x4){xn[8 * j + 4], xn[8 * j + 5], xn[8 * j + 6], xn[8 * j + 7]};
    }
    if (!last) {
        ss2 = wave_sum(ss2);
        const float r2 = rsqrtf(ss2 * (1.0f / 1024.0f) + EPS);
#pragma unroll
        for (int j = 0; j < 2; ++j) {
            const f32x4 g0 = *(const f32x4*)(gpre_next + j * 512 + lane * 8), g1 = *(const f32x4*)(gpre_next + j * 512 + lane * 8 + 4);
            u32x4 o;
            o.x = pk_bf16(xn[8 * j] * r2 * g0[0], xn[8 * j + 1] * r2 * g0[1]);
            o.y = pk_bf16(xn[8 * j + 2] * r2 * g0[2], xn[8 * j + 3] * r2 * g0[3]);
            o.z = pk_bf16(xn[8 * j + 4] * r2 * g1[0], xn[8 * j + 5] * r2 * g1[1]);
            o.w = pk_bf16(xn[8 * j + 6] * r2 * g1[2], xn[8 * j + 7] * r2 * g1[3]);
            *(u32x4*)(yh + j * 512 + lane * 8) = o;
        }
    }
}

#define XB_TMO      128
#define XB_XCNT(j)  (256  + 64 * (j))
#define XB_XSUB(j)  (1280 + 64 * (j))
#define XB_XGEN(j)  (2304 + 64 * (j))
#define XB_TOP      3328
#define XB_TOPGEN   3392
#define XCD_BAR_WORDS 3456
#define XB_SPIN_CAP (1u << 18)
#define LAS __attribute__((address_space(3)))
DI unsigned xb_ld(unsigned* p)              { return __hip_atomic_load(p, __ATOMIC_RELAXED, __HIP_MEMORY_SCOPE_AGENT); }
DI unsigned xb_add(unsigned* p, unsigned v) { return __hip_atomic_fetch_add(p, v, __ATOMIC_RELAXED, __HIP_MEMORY_SCOPE_AGENT); }
DI unsigned xb_xcc_id() { return (unsigned)__builtin_amdgcn_s_getreg((3 << 11) | 20) & 0xFu; }
#define XB_SPIN(cond, bar) do { unsigned _sp = 0; while (cond) { __builtin_amdgcn_s_sleep(1); \
    if ((++_sp & 255u) == 0u) { if (xb_ld(&(bar)[XB_TMO])) break; if (_sp > XB_SPIN_CAP) { atomicAdd(&(bar)[XB_TMO], 1u); break; } } } } while (0)
struct XcdBarrier { unsigned* bar; unsigned x; volatile LAS unsigned* st; };
DI XcdBarrier xcd_barrier_post(unsigned* bar, volatile LAS unsigned* st) {
    XcdBarrier b; b.bar = bar; b.x = xb_xcc_id(); b.st = st;
    if (threadIdx.x == 0) (void)xb_add(&bar[XB_XCNT(b.x)], 1u);
    return b;
}
DI void xcd_barrier_complete(unsigned* bar, unsigned x, unsigned& nloc, unsigned& nx) {
    const unsigned G = gridDim.x * gridDim.y * gridDim.z;
    unsigned sum, cnt, mine, sp = 0u;
    for (;;) {
        sum = 0u; cnt = 0u; mine = 0u;
#pragma unroll
        for (unsigned j = 0; j < 16; ++j) { const unsigned c = xb_ld(&bar[XB_XCNT(j)]); sum += c; cnt += (c > 0u) ? 1u : 0u; mine = (j == x) ? c : mine; }
        if (sum == G) break;
        __builtin_amdgcn_s_sleep(1);
        if ((++sp & 255u) == 0u) { if (xb_ld(&bar[XB_TMO])) break; if (sp > XB_SPIN_CAP) { atomicAdd(&bar[XB_TMO], 1u); break; } }
    }
    nloc = mine > 0u ? mine : 1u; nx = cnt > 0u ? cnt : 1u;
}
DI void xcd_barrier(const XcdBarrier& b) {
    asm volatile("s_waitcnt vmcnt(0)" ::: "memory");
    __syncthreads();
    if (threadIdx.x == 0) {
        unsigned* bar = b.bar;
        __builtin_amdgcn_s_waitcnt(0);
        unsigned nloc = b.st[0], nx = b.st[1];
        if (nloc == 0u) { xcd_barrier_complete(bar, b.x, nloc, nx); b.st[0] = nloc; b.st[1] = nx; }
        const unsigned old = xb_add(&bar[XB_XSUB(b.x)], 1u);
        const unsigned gen = old / nloc;
        if (old + 1u == (gen + 1u) * nloc) {
            __builtin_amdgcn_fence(__ATOMIC_RELEASE, "agent");
            asm volatile("s_waitcnt vmcnt(0)" ::: "memory");
            const unsigned og = xb_add(&bar[XB_TOP], 1u);
            const unsigned tg = og / nx;
            if (og + 1u == (tg + 1u) * nx) xb_add(&bar[XB_TOPGEN], 1u);
            else XB_SPIN(xb_ld(&bar[XB_TOPGEN]) == tg, bar);
            __builtin_amdgcn_fence(__ATOMIC_ACQUIRE, "agent");
            xb_add(&bar[XB_XGEN(b.x)], 1u);
            asm volatile("s_waitcnt vmcnt(0)" ::: "memory");
        } else {
            XB_SPIN(xb_ld(&bar[XB_XGEN(b.x)]) == gen, bar);
            __builtin_amdgcn_fence(__ATOMIC_ACQUIRE, "agent");
            asm volatile("s_waitcnt vmcnt(0)" ::: "memory");
        }
    }
    __syncthreads();
}

__global__ void __launch_bounds__(512, 2) fwd_megakernel(Params p) {
    __shared__ __attribute__((aligned(16))) unsigned char smem[131072];
    __shared__ uint4 xb_words;
    cg::grid_group grid = cg::this_grid();
    const int nb = gridDim.x, bid = blockIdx.x;
    if (threadIdx.x == 0) xb_words = make_uint4(0u, 0u, 0u, 0u);
    __syncthreads();
    XcdBarrier xb = xcd_barrier_post((unsigned*)(p.ws + OFF_BAR), (volatile LAS unsigned*)&xb_words);
    if (p.phase_end > 1000) grid.sync();
    for (int ph = p.phase_begin; ph < p.phase_end; ++ph) {
        const int tid = opaque_tid(), lane = tid & 63, wave = tid >> 6;
        unsigned char* ws = p.ws;
        bf16_t* H = (bf16_t*)(ws + OFF_H);
        bf16_t* Z = (bf16_t*)(ws + OFF_Z);
        bf16_t* VT = (bf16_t*)(ws + OFF_VT);
        bf16_t* MIX = (bf16_t*)(ws + OFF_MIX);
        bf16_t* WIN = (bf16_t*)(ws + OFF_WIN);
        bf16_t* WOUT = (bf16_t*)(ws + OFF_WOUT);
        bf16_t* WMEM = (bf16_t*)(ws + OFF_WMEM);
        bf16_t* PW = (bf16_t*)(ws + OFF_PW);
        bf16_t* MH = (bf16_t*)(ws + OFF_MH);
        bf16_t* KM = (bf16_t*)(ws + OFF_KM);
        bf16_t* VMT = (bf16_t*)(ws + OFF_VMT);
        float* ROPE = (float*)(ws + OFF_ROPE);
        if (ph == 0) {
            for (int i = bid; i < 1928; i += nb) {
                if (i < 1152) { const int l = i / 576, j = i % 576, kt = j / 36, ntile = j % 36;
                    transpose_tile(p.w_in + (size_t)l * DM * INW, INW, WIN + (size_t)l * INW * DM, DM, kt * 64, ntile * 64, smem);
                } else if (i < 1664) { const int ii = i - 1152, l = ii / 256, j = ii % 256, kt = j / 16, ntile = j % 16;
                    transpose_tile(p.w_out + (size_t)l * DM * DM, DM, WOUT + (size_t)l * DM * DM, DM, kt * 64, ntile * 64, smem);
                } else if (i < 1920) { const int ii = i - 1664, l = ii / 128, j = ii % 128, kt = j / 8, ntile = j % 8;
                    transpose_tile(p.w_mem_kv + (size_t)l * DM * 512, 512, WMEM + (size_t)l * 512 * DM, DM, kt * 64, ntile * 64, smem);
                } else { const int ii = i - 1920;
                    transpose_tile(p.pool_w + (size_t)ii * 4096, 64, PW + (size_t)ii * 4096, 64, 0, 0, smem);
                }
            }
            for (int i = bid * 8 + wave; i < NTOK + 2 * NMEMTOK; i += nb * 8) {
                if (i < NTOK) {
                    const float* src = (i < NPROMPT) ? p.x_prompt + (size_t)i * DM : p.x_sample + (size_t)(i - NPROMPT) * DM;
                    rms_row_f32(src, p.norm_pre, H + (size_t)i * DM, lane);
                } else {
                    const int ii = i - NTOK, l = ii / NMEMTOK, mt = ii % NMEMTOK;
                    const float* src = (mt < 4096) ? p.mem_prompt + (size_t)mt * DM : p.mem_sample + (size_t)(mt - 4096) * DM;
                    rms_row_f32(src, p.mem_norm + l * DM, MH + ((size_t)l * NMEMTOK + mt) * DM, lane);
                }
            }
            for (int i = bid * 512 + tid; i < 1024; i += nb * 512) rope_entry(i, ROPE);
        } else {
            const int l = (ph - 1) >> 2, sub = (ph - 1) & 3;
            if (sub == 0) {
                EpiArgs e; e.C = Z; e.VT = VT; e.qn = p.q_norm + l * 64; e.kn = p.k_norm + l * 64; e.rope = ROPE;
                const bf16_t* Wl = WIN + (size_t)l * INW * DM;
                EpiArgs e2; e2.C = KM + (size_t)l * NMEMTOK * 256; e2.VT = VMT + (size_t)l * NMEMTOK * 256; e2.qn = nullptr; e2.kn = nullptr; e2.rope = nullptr;
                const bf16_t* Wm = WMEM + (size_t)l * 512 * DM;
                const bf16_t* Am = MH + (size_t)l * NMEMTOK * DM;
                for (int i = bid; i < 1728 + 40; i += nb) {
                    if (i < 1728) {
                        const int j = i >> 3, mg = j / 72, rem = j % 72;
                        const int mt = (i & 7) * 24 + mg * 8 + (rem & 7), ntile = rem >> 3;
                        gemm_tile<0>(H, Wl, mt * 256, ntile * 256, e, smem);
                    } else {
                        const int j = i - 1728;
                        gemm_tile<2>(Am, Wm, (j >> 1) * 256, (j & 1) * 256, e2, smem);
                    }
                }
            } else if (sub == 1) {
                float gq = fabsf(p.q_norm[l * 64 + lane]), gk = fabsf(p.k_norm[l * 64 + lane]);
#pragma unroll
                for (int o = 1; o < 64; o <<= 1) { gq = fmaxf(gq, __shfl_xor(gq, o)); gk = fmaxf(gk, __shfl_xor(gk, o)); }
                const float mfix = 8.0f * gq * gk * 1.02f;
                const bool fixm = mfix < 20.0f;
                for (int i = bid; i < 3072; i += nb) {
                    if (i < 1536) {
                        int b, kvh, j, T; size_t tok0, vtb;
                        if (i < 512) { const int R = i >> 8, ip = i & 255, grp = ip & 7; j = R * 32 + (ip >> 3); b = grp >> 1; kvh = grp & 1; T = 4096;
                            tok0 = (size_t)NPROMPT + (size_t)b * 4096; vtb = (size_t)NPROMPT * 128 + ((size_t)(b * 2 + kvh) * 64) * 4096; }
                        else { const int ii = i - 512, R = ii >> 8, ip = ii & 255, grp = R * 8 + (ip & 7); j = ip >> 3; b = grp >> 1; kvh = grp & 1; T = 2048;
                            tok0 = (size_t)b * 2048; vtb = ((size_t)(b * 2 + kvh) * 64) * 2048; }
                        const int qblk = j >> 2, head = kvh * 4 + (j & 3);
                        const size_t q0 = tok0 + (size_t)qblk * 256;
                        if (fixm) attn_item<true>(Z + q0 * INW + 512 + head * 64, INW, Z + tok0 * INW + 1024 + kvh * 64, INW, VT + vtb, T, T,
                                  MIX + q0 * 1024 + 256 + head * 64, Z + q0 * INW + 1280 + head * 64, smem, mfix);
                        else attn_item<false>(Z + q0 * INW + 512 + head * 64, INW, Z + tok0 * INW + 1024 + kvh * 64, INW, VT + vtb, T, T,
                                  MIX + q0 * 1024 + 256 + head * 64, Z + q0 * INW + 1280 + head * 64, smem, 0.f);
                    } else if (i < 2304) {
                        const int ii = i - 1536, qb = ii >> 2, hx = ii & 3;
                        const size_t q0 = (size_t)qb * 256;
                        const int b = (q0 < NPROMPT) ? (int)(q0 >> 11) : 16 + (int)((q0 - NPROMPT) >> 12);
cross_item(Z + q0 * INW + 1792 + hx * 64, KM + ((size_t)l * NMEMTOK + (size_t)b * 256) * 256 + hx * 64,
                                   VMT + (size_t)l * NMEMTOK * 256 + ((size_t)(b * 4 + hx) * 64) * 256,
                                   MIX + q0 * 1024 + 768 + hx * 64, Z + q0 * INW + 2048 + hx * 64, smem);
                    } else {
                        pool_item(Z, PW + (size_t)l * 4 * 4096, p.pool_scale + l * 256, MIX, (i - 2304) * 64, smem);
                    }
                }
            } else if (sub == 2) {
                EpiArgs e; e.C = H; e.VT = nullptr; e.qn = nullptr; e.kn = nullptr; e.rope = nullptr;
                const bf16_t* Wl = WOUT + (size_t)l * DM * DM;
                for (int i = bid; i < 768; i += nb) {
                    const int j = i >> 3, mg = j >> 5, rem = j & 31;
                    const int mt = (i & 7) * 24 + mg * 8 + (rem & 7), ntile = rem >> 3;
                    gemm_tile<1>(MIX, Wl, mt * 256, ntile * 256, e, smem);
                }
            } else {
                const bool last = (l == DEPTH - 1);
                for (int i = bid * 8 + wave; i < NTOK; i += nb * 8) {
                    const float* xs = (l == 0) ? ((i < NPROMPT) ? p.x_prompt + (size_t)i * DM : p.x_sample + (size_t)(i - NPROMPT) * DM) : p.out + (size_t)i * DM;
                    post_row(xs, H + (size_t)i * DM, p.norm_post + l * DM, p.norm_pre + (last ? l : l + 1) * DM, p.out + (size_t)i * DM, last, lane);
                }
            }
        }
        if (ph + 1 < p.phase_end) xcd_barrier(xb);
    }
}

extern "C" void kernel_launch(void* const* d_in, const int* in_sizes, int n_in, void* d_out, int out_size, void* d_ws, size_t ws_size,
                              hipStream_t stream) {
    static int grid_blocks = 0;
    if (!grid_blocks) {
        int dev = 0, cus = 0, per_cu = 0;
        hipGetDevice(&dev);
        hipDeviceGetAttribute(&cus, hipDeviceAttributeMultiprocessorCount, dev);
        hipOccupancyMaxActiveBlocksPerMultiprocessor(&per_cu, fwd_megakernel, 512, 0);
        if (per_cu > 1) per_cu = 1;
        if (per_cu < 1) per_cu = 1;
        grid_blocks = cus * per_cu;
    }
    Params p{};
    p.x_prompt = (const float*)d_in[0]; p.x_sample = (const float*)d_in[1]; p.mem_prompt = (const float*)d_in[2]; p.mem_sample = (const float*)d_in[3];
    p.norm_pre = (const float*)d_in[4]; p.norm_post = (const float*)d_in[5]; p.w_in = (const float*)d_in[6]; p.pool_w = (const float*)d_in[7];
    p.pool_scale = (const float*)d_in[8]; p.q_norm = (const float*)d_in[9]; p.k_norm = (const float*)d_in[10]; p.mem_norm = (const float*)d_in[11];
    p.w_mem_kv = (const float*)d_in[12]; p.w_out = (const float*)d_in[13];
    p.out = (float*)d_out; p.ws = (unsigned char*)d_ws;
    p.phase_begin = 0; p.phase_end = 1 + 4 * DEPTH;
    if (ws_size < WS_TOTAL) { fprintf(stderr, "workspace too small: %zu < %zu\n", ws_size, (size_t)WS_TOTAL); return; }
    hipMemsetAsync((unsigned char*)d_ws + OFF_BAR, 0, BAR_BYTES, stream);
    void* args[] = {&p};
    hipError_t e = hipLaunchCooperativeKernel((void*)fwd_megakernel, dim3(grid_blocks), dim3(512), args, 0, stream);
    if (e != hipSuccess) fprintf(stderr, "cooperative launch failed: %s (grid %d)\n", hipGetErrorString(e), grid_blocks);
}
```

```cpp
#include <hip/hip_runtime.h>
#include <hip/hip_cooperative_groups.h>
#include <stdint.h>
#include <cstdio>
namespace cg = cooperative_groups;

typedef unsigned short bf16_t;
typedef short bf16x8 __attribute__((ext_vector_type(8)));
typedef float f32x4 __attribute__((ext_vector_type(4)));
typedef float f32x16 __attribute__((ext_vector_type(16)));
typedef unsigned u32x4 __attribute__((ext_vector_type(4)));
typedef unsigned u32x2 __attribute__((ext_vector_type(2)));
typedef __bf16 bf16x2_t __attribute__((ext_vector_type(2)));
typedef float f32x2_t __attribute__((ext_vector_type(2)));
#define DI __device__ __forceinline__

constexpr int NTOK = 49152;
constexpr int NPROMPT = 32768;
constexpr int DM = 1024;
constexpr int INW = 2304;
constexpr int NMEMTOK = 5120;
constexpr int DEPTH = 2;
constexpr float EPS = 1e-6f;
constexpr float L2E = 1.4426950408889634f;

constexpr size_t OFF_H    = 0;
constexpr size_t OFF_Z    = OFF_H + (size_t)NTOK * DM * 2;
constexpr size_t OFF_VT   = OFF_Z + (size_t)NTOK * INW * 2;
constexpr size_t OFF_MIX  = OFF_VT + (size_t)NTOK * 128 * 2;
constexpr size_t OFF_WIN  = OFF_MIX + (size_t)NTOK * DM * 2;
constexpr size_t OFF_WOUT = OFF_WIN + (size_t)DEPTH * INW * DM * 2;
constexpr size_t OFF_WMEM = OFF_WOUT + (size_t)DEPTH * DM * DM * 2;
constexpr size_t OFF_PW   = OFF_WMEM + (size_t)DEPTH * 512 * DM * 2;
constexpr size_t OFF_MH   = OFF_PW + (size_t)DEPTH * 4 * 64 * 64 * 2;
constexpr size_t OFF_KM   = OFF_MH + (size_t)DEPTH * NMEMTOK * DM * 2;
constexpr size_t OFF_VMT  = OFF_KM + (size_t)DEPTH * NMEMTOK * 256 * 2;
constexpr size_t OFF_ROPE = OFF_VMT + (size_t)DEPTH * NMEMTOK * 256 * 2;
constexpr size_t OFF_BAR  = OFF_ROPE + 64 * 16 * 2 * 4;
constexpr size_t BAR_BYTES = 3456 * 4;
constexpr size_t WS_TOTAL = OFF_BAR + BAR_BYTES;

struct Params {
    const float* x_prompt; const float* x_sample; const float* mem_prompt; const float* mem_sample;
    const float* norm_pre; const float* norm_post; const float* w_in; const float* pool_w; const float* pool_scale;
    const float* q_norm; const float* k_norm; const float* mem_norm; const float* w_mem_kv; const float* w_out;
    float* out; unsigned char* ws;
    int phase_begin; int phase_end;
};

DI unsigned pk_bf16(float a, float b) {
    f32x2_t v = {a, b};
    bf16x2_t r = __builtin_convertvector(v, bf16x2_t);
    return __builtin_bit_cast(unsigned, r);
}
DI int opaque_tid() { int t = threadIdx.x; asm volatile("" : "+v"(t)); return t; }
DI void lds_barrier() { asm volatile("s_waitcnt lgkmcnt(0)\n\ts_barrier" ::: "memory"); }
DI float bflo(unsigned u) { return __uint_as_float(u << 16); }
DI float bfhi(unsigned u) { return __uint_as_float(u & 0xffff0000u); }
DI float wave_sum(float v) {
    v += __shfl_xor(v, 1); v += __shfl_xor(v, 2); v += __shfl_xor(v, 4);
    v += __shfl_xor(v, 8); v += __shfl_xor(v, 16); v += __shfl_xor(v, 32);
    return v;
}
DI float xhalf_max(float v) {
    auto r = __builtin_amdgcn_permlane32_swap(__float_as_uint(v), __float_as_uint(v), false, false);
    return fmaxf(__uint_as_float(r[0]), __uint_as_float(r[1]));
}
DI float silu_f(float x) { return x * __builtin_amdgcn_rcpf(1.0f + __builtin_amdgcn_exp2f(-x * L2E)); }
DI f32x4 mfma16(bf16x8 a, bf16x8 b, f32x4 c) { return __builtin_amdgcn_mfma_f32_16x16x32_bf16(a, b, c, 0, 0, 0); }
DI f32x16 mfma32(bf16x8 a, bf16x8 b, f32x16 c) { return __builtin_amdgcn_mfma_f32_32x32x16_bf16(a, b, c, 0, 0, 0); }

DI void transpose_tile(const float* __restrict__ src, int ldn, bf16_t* __restrict__ dst, int ldk, int k0, int n0, unsigned char* smem) {
    float* tile = (float*)smem;
    const int tid = opaque_tid();
    __syncthreads();
#pragma unroll
    for (int i = 0; i < 2; ++i) {
        const int id = tid + 512 * i, r = id >> 4, c4 = id & 15;
        const f32x4 v = *(const f32x4*)(src + (size_t)(k0 + r) * ldn + n0 + c4 * 4);
        tile[r * 65 + c4 * 4 + 0] = v[0]; tile[r * 65 + c4 * 4 + 1] = v[1]; tile[r * 65 + c4 * 4 + 2] = v[2]; tile[r * 65 + c4 * 4 + 3] = v[3];
    }
    __syncthreads();
    {
        const int n = tid >> 3, kc = tid & 7;
        float v[8];
#pragma unroll
        for (int j = 0; j < 8; ++j) v[j] = tile[(kc * 8 + j) * 65 + n];
        u32x4 o; o.x = pk_bf16(v[0], v[1]); o.y = pk_bf16(v[2], v[3]); o.z = pk_bf16(v[4], v[5]); o.w = pk_bf16(v[6], v[7]);
        *(u32x4*)(dst + (size_t)(n0 + n) * ldk + k0 + kc * 8) = o;
    }
}

struct RowIn { f32x4 v[4]; };
DI RowIn rms_row_load(const float* __restrict__ src, int lane) {
    RowIn r;
#pragma unroll
    for (int j = 0; j < 4; ++j) r.v[j] = *(const f32x4*)(src + j * 256 + lane * 4);
    return r;
}
DI void rms_row_finish(const RowIn& in, const float* __restrict__ g, bf16_t* __restrict__ dst, int lane) {
    f32x4 v[4]; float ss = 0.f;
#pragma unroll
    for (int j = 0; j < 4; ++j) { v[j] = in.v[j]; ss += v[j][0] * v[j][0] + v[j][1] * v[j][1] + v[j][2] * v[j][2] + v[j][3] * v[j][3]; }
    ss = wave_sum(ss);
    const float r = rsqrtf(ss * (1.0f / 1024.0f) + EPS);
#pragma unroll
    for (int j = 0; j < 4; ++j) {
        const f32x4 gg = *(const f32x4*)(g + j * 256 + lane * 4);
        u32x2 o; o.x = pk_bf16(v[j][0] * r * gg[0], v[j][1] * r * gg[1]); o.y = pk_bf16(v[j][2] * r * gg[2], v[j][3] * r * gg[3]);
        *(u32x2*)(dst + j * 256 + lane * 4) = o;
    }
}

DI void rope_entry(int idx, float* table) {
    const int n = idx >> 4, pp = idx & 15;
    double fd = 1.0;
    for (int i = 0; i < pp; ++i) fd *= 0.5623413251903491;
    const float f = (float)fd;
    const float a = (float)n * f;
    double r = (double)a;
    const double k = rint(r * 0.15915494309189535);
    r -= k * 6.283185307179586;
    const double r2 = r * r;
    double sn = r, cs = 1.0, ts = r, tc = 1.0;
    for (int i = 1; i <= 16; ++i) {
        tc = -tc * r2 / (double)((2 * i - 1) * (2 * i));
        ts = -ts * r2 / (double)((2 * i) * (2 * i + 1));
        cs += tc; sn += ts;
    }
    table[idx * 2] = (float)cs; table[idx * 2 + 1] = (float)sn;
}

struct EpiArgs {
    bf16_t* C;
    bf16_t* VT;
    const float* qn; const float* kn; const float* rope;
};

template <int MODE>
DI void gemm_tile(const bf16_t* __restrict__ A, const bf16_t* __restrict__ Bt, int m0, int n0, const EpiArgs& e, unsigned char* smem) {
    const int tid = opaque_tid(), lane = tid & 63, wave = tid >> 6;
    const int wm = wave >> 2, wn = wave & 3;
    const int lrow = tid >> 3, lc = tid & 7;
    const unsigned char* Ab = (const unsigned char*)(A + (size_t)m0 * 1024);
    const unsigned char* Bb = (const unsigned char*)(Bt + (size_t)n0 * 1024);
    const unsigned goff = (unsigned)(lrow * 1024 + lc * 8) * 2u;
#define GA(I, KT) (*(const u32x4*)(Ab + (goff + (unsigned)((I) * 131072 + (KT) * 128))))
#define GB(I, KT) (*(const u32x4*)(Bb + (goff + (unsigned)((I) * 131072 + (KT) * 128))))
    const int st_off = lrow * 128 + ((lc ^ ((lrow >> 1) & 7)) << 4);
    const int r16 = lane & 15, q4 = lane >> 4;
    const int fr_off = r16 * 128 + ((q4 ^ (r16 >> 1)) << 4);
    const int a_base = 32768 + (wn * 64) * 128;
    const int b_base = (wm * 128) * 128;
    constexpr int TI = 8;

    f32x4 acc[4][TI];
#pragma unroll
    for (int i = 0; i < 4; ++i)
#pragma unroll
        for (int j = 0; j < TI; ++j) acc[i][j] = (f32x4){0.f, 0.f, 0.f, 0.f};

    u32x4 ra[4], rb[4];
#define G_LOAD(KT) { _Pragma("unroll") for (int i = 0; i < 4; ++i) { ra[i] = GA(i, KT); rb[i] = GB(i, KT); } }
#define G_STORE(OFF) { _Pragma("unroll") for (int i = 0; i < 4; ++i) { *(u32x4*)(smem + (OFF) + st_off + i * 8192) = ra[i]; *(u32x4*)(smem + (OFF) + 32768 + st_off + i * 8192) = rb[i]; } }
#define G_STEP(CUR, NXT, KTL, DO_ST, DO_LD) { \
        { bf16x8 wf[4], tf[TI]; \
          _Pragma("unroll") for (int i = 0; i < 4; ++i) wf[i] = *(const bf16x8*)(smem + (CUR) + a_base + i * 2048 + fr_off); \
          _Pragma("unroll") for (int i = 0; i < 4; ++i) tf[i] = *(const bf16x8*)(smem + (CUR) + b_base + i * 2048 + fr_off); \
          _Pragma("unroll") for (int ti = 0; ti < TI; ++ti) { \
              if (ti == 1) { _Pragma("unroll") for (int i = 4; i < TI; ++i) tf[i] = *(const bf16x8*)(smem + (CUR) + b_base + i * 2048 + fr_off); } \
              _Pragma("unroll") for (int fi = 0; fi < 4; ++fi) acc[fi][ti] = mfma16(wf[fi], tf[ti], acc[fi][ti]); \
              if (DO_ST) { if (ti < 4) *(u32x4*)(smem + (NXT) + st_off + ti * 8192) = ra[ti]; else *(u32x4*)(smem + (NXT) + 32768 + st_off + (ti - 4) * 8192) = rb[ti - 4]; } \
              __builtin_amdgcn_sched_barrier(0); } } \
        { bf16x8 wf[4], tf[TI]; \
          _Pragma("unroll") for (int i = 0; i < 4; ++i) wf[i] = *(const bf16x8*)(smem + (CUR) + a_base + i * 2048 + (fr_off ^ 64)); \
          _Pragma("unroll") for (int i = 0; i < 4; ++i) tf[i] = *(const bf16x8*)(smem + (CUR) + b_base + i * 2048 + (fr_off ^ 64)); \
          _Pragma("unroll") for (int ti = 0; ti < TI; ++ti) { \
              if (ti == 1) { _Pragma("unroll") for (int i = 4; i < TI; ++i) tf[i] = *(const bf16x8*)(smem + (CUR) + b_base + i * 2048 + (fr_off ^ 64)); } \
              _Pragma("unroll") for (int fi = 0; fi < 4; ++fi) acc[fi][ti] = mfma16(wf[fi], tf[ti], acc[fi][ti]); \
              if (DO_LD) { if (ti < 4) ra[ti] = GA(ti, KTL); else rb[ti - 4] = GB(ti - 4, KTL); } \
              __builtin_amdgcn_sched_barrier(0); } } }
    G_LOAD(0);
    G_STORE(0);
    G_LOAD(1);
    lds_barrier();
    for (int kt = 0; kt < 14; kt += 2) {
        G_STEP(0, 65536, kt + 2, true, true);
        lds_barrier();
        G_STEP(65536, 0, kt + 3, true, true);
        lds_barrier();
    }
    G_STEP(0, 65536, 0, true, false);
    lds_barrier();
    G_STEP(65536, 0, 0, false, false);
    lds_barrier();
#undef G_LOAD
#undef G_STORE
#undef G_STEP
#undef GA
#undef GB

    const int cb = n0 + wn * 64;
    const int tokb = m0 + wm * 128 + r16;
    if (MODE == 1) {
#pragma unroll
        for (int ti = 0; ti < TI; ++ti) {
            bf16_t* rowp = e.C + (size_t)(tokb + ti * 16) * 1024 + cb + 4 * q4;
#pragma unroll
            for (int fi = 0; fi < 4; ++fi) {
                u32x2 o; o.x = pk_bf16(acc[fi][ti][0], acc[fi][ti][1]); o.y = pk_bf16(acc[fi][ti][2], acc[fi][ti][3]);
                *(u32x2*)(rowp + fi * 16) = o;
            }
        }
    } else if (MODE == 2) {
        if (cb < 256) {
#pragma unroll
            for (int ti = 0; ti < TI; ++ti) {
                bf16_t* rowp = e.C + (size_t)(tokb + ti * 16) * 256 + cb + 4 * q4;
#pragma unroll
                for (int fi = 0; fi < 4; ++fi) {
                    u32x2 o; o.x = pk_bf16(acc[fi][ti][0], acc[fi][ti][1]); o.y = pk_bf16(acc[fi][ti][2], acc[fi][ti][3]);
                    *(u32x2*)(rowp + fi * 16) = o;
                }
            }
        } else {
            const int hx = (cb - 256) >> 6;
#pragma unroll
            for (int ti = 0; ti < TI; ++ti) {
                const int mt = tokb + ti * 16, b = mt >> 8, m = mt & 255;
                bf16_t* bp = e.VT + ((size_t)(b * 4 + hx) * 64) * 256 + m;
#pragma unroll
                for (int fi = 0; fi < 4; ++fi)
#pragma unroll
                    for (int i = 0; i < 4; ++i) bp[(size_t)(fi * 16 + 4 * q4 + i) * 256] = (bf16_t)(pk_bf16(acc[fi][ti][i], 0.f) & 0xffffu);
            }
        }
    } else {
        if (cb >= 512 && cb < 1152) {
            const bool isq = cb < 1024;
            const float* gn = isq ? e.qn : e.kn;
            const float osc = isq ? 0.125f * L2E : 1.0f;
            f32x4 g[4];
#pragma unroll
            for (int fi = 0; fi < 4; ++fi) g[fi] = *(const f32x4*)(gn + fi * 16 + 4 * q4);
#pragma unroll
            for (int ti = 0; ti < TI; ++ti) {
                const int tok = tokb + ti * 16;
                float ss = 0.f;
#pragma unroll
                for (int fi = 0; fi < 4; ++fi)
#pragma unroll
                    for (int i = 0; i < 4; ++i) ss += acc[fi][ti][i] * acc[fi][ti][i];
                ss += __shfl_xor(ss, 16); ss += __shfl_xor(ss, 32);
                const float rinv = rsqrtf(ss * (1.0f / 64.0f) + EPS);
                const int t = (tok < NPROMPT) ? (tok & 2047) : (tok & 4095);
                const int rowi = t >> 6, coli = t & 63;
                const f32x4* rt = (const f32x4*)(e.rope + (rowi * 16 + 4 * q4) * 2);
                const f32x4* ct = (const f32x4*)(e.rope + (coli * 16 + 4 * q4) * 2);
                const f32x4 r01 = rt[0], r23 = rt[1], c01 = ct[0], c23 = ct[1];
                const float rc[4] = {r01[0], r01[2], r23[0], r23[2]}, rs[4] = {r01[1], r01[3], r23[1], r23[3]};
                const float cc[4] = {c01[0], c01[2], c23[0], c23[2]}, cs[4] = {c01[1], c01[3], c23[1], c23[3]};
                float o[4][4];
#pragma unroll
                for (int i = 0; i < 4; ++i) {
                    const float a0 = acc[0][ti][i] * rinv * g[0][i], b0 = acc[1][ti][i] * rinv * g[1][i];
                    const float a1 = acc[2][ti][i] * rinv * g[2][i], b1 = acc[3][ti][i] * rinv * g[3][i];
                    o[0][i] = (a0 * rc[i] - b0 * rs[i]) * osc; o[1][i] = (b0 * rc[i] + a0 * rs[i]) * osc;
                    o[2][i] = (a1 * cc[i] - b1 * cs[i]) * osc; o[3][i] = (b1 * cc[i] + a1 * cs[i]) * osc;
                }
                bf16_t* rowp = e.C + (size_t)tok * INW + cb + 4 * q4;
#pragma unroll
                for (int fi = 0; fi < 4; ++fi) {
                    u32x2 w; w.x = pk_bf16(o[fi][0], o[fi][1]); w.y = pk_bf16(o[fi][2], o[fi][3]);
                    *(u32x2*)(rowp + fi * 16) = w;
                }
            }
        } else if (cb >= 1152 && cb < 1280) {
            const int kvh = (cb - 1152) >> 6;
#pragma unroll
            for (int ti = 0; ti < TI; ++ti) {
                const int tok = tokb + ti * 16;
                bf16_t* bp; size_t T;
                if (tok < NPROMPT) { const int b = tok >> 11, t = tok & 2047; T = 2048; bp = e.VT + ((size_t)(b * 2 + kvh) * 64) * 2048 + t; }
                else { const int b = (tok - NPROMPT) >> 12, t = tok & 4095; T = 4096; bp = e.VT + (size_t)NPROMPT * 128 + ((size_t)(b * 2 + kvh) * 64) * 4096 + t; }
#pragma unroll
                for (int fi = 0; fi < 4; ++fi)
#pragma unroll
                    for (int i = 0; i < 4; ++i) bp[(size_t)(fi * 16 + 4 * q4 + i) * T] = (bf16_t)(pk_bf16(acc[fi][ti][i], 0.f) & 0xffffu);
            }
        } else {
            const int kind = (cb < 256) ? 0 : ((cb >= 1792 && cb < 2048) ? 2 : 1);
#pragma unroll
            for (int ti = 0; ti < TI; ++ti) {
                bf16_t* rowp = e.C + (size_t)(tokb + ti * 16) * INW + cb + 4 * q4;
#pragma unroll
                for (int fi = 0; fi < 4; ++fi) {
                    float v[4];
#pragma unroll
                    for (int i = 0; i < 4; ++i) { const float x = acc[fi][ti][i]; v[i] = (kind == 0) ? x : ((kind == 2) ? x * (0.125f * L2E) : silu_f(x)); }
                    u32x2 o; o.x = pk_bf16(v[0], v[1]); o.y = pk_bf16(v[2], v[3]);
                    *(u32x2*)(rowp + fi * 16) = o;
                }
            }
        }
    }
}

#define SB_() __builtin_amdgcn_sched_barrier(0)
#define KFRAG(KS, KB) (*(const bf16x8*)(kp + (KB) * 4096 + k_off + ((((KS) * 2 + h) ^ kswz) << 4)))
#define VFRAG(KK, DB) (*(const bf16x8*)(vp + (DB) * 4096 + v_off + ((((KK) * 2 + h) ^ vswz) << 4)))
#define EXP4(S, I0) { _Pragma("unroll") for (int i_ = (I0); i_ < (I0) + 4; ++i_) { S[i_] = __builtin_amdgcn_exp2f(S[i_] - mb); rs += S[i_]; } }
#define EXP4F(S, I0) { f32x2_t a_ = {S[(I0)], S[(I0) + 1]}, b_ = {S[(I0) + 2], S[(I0) + 3]}; \
        a_ = a_ - (f32x2_t){mb, mb}; b_ = b_ - (f32x2_t){mb, mb}; \
        S[(I0)] = __builtin_amdgcn_exp2f(a_.x); S[(I0) + 1] = __builtin_amdgcn_exp2f(a_.y); S[(I0) + 2] = __builtin_amdgcn_exp2f(b_.x); S[(I0) + 3] = __builtin_amdgcn_exp2f(b_.y); \
        rs2 += (f32x2_t){S[(I0)], S[(I0) + 1]} + (f32x2_t){S[(I0) + 2], S[(I0) + 3]}; }
#define EXPQ(S, I0) { if (FIXM) EXP4F(S, I0) else EXP4(S, I0) }
#define PACK8(S, I0) ({ u32x4 t_; t_.x = pk_bf16(S[(I0)], S[(I0) + 1]); t_.y = pk_bf16(S[(I0) + 2], S[(I0) + 3]); t_.z = pk_bf16(S[(I0) + 4], S[(I0) + 5]); t_.w = pk_bf16(S[(I0) + 6], S[(I0) + 7]); __builtin_bit_cast(bf16x8, t_); })
DI float max8(const f32x16& s, int i0, float mx) {
    mx = fmaxf(fmaxf(mx, s[i0]), s[i0 + 1]); mx = fmaxf(fmaxf(mx, s[i0 + 2]), s[i0 + 3]);
    mx = fmaxf(fmaxf(mx, s[i0 + 4]), s[i0 + 5]); mx = fmaxf(fmaxf(mx, s[i0 + 6]), s[i0 + 7]);
    return mx;
}
#define EXP2F(S, I0) { S[(I0)] = __builtin_amdgcn_exp2f(S[(I0)]); S[(I0) + 1] = __builtin_amdgcn_exp2f(S[(I0) + 1]); rs += S[(I0)] + S[(I0) + 1]; \
        asm volatile("" : "+v"(S[(I0)]), "+v"(S[(I0) + 1]), "+v"(rs)); }
#define PIN1(X) asm volatile("" : "+v"(X))
template <bool DO_PV, bool DO_QK>
DI void attn_step_fix(f32x16& s0, f32x16& s1, f32x16& n0, f32x16& n1, const bf16x8 (&pp)[4], bf16x8 (&pc)[4],
                      f32x16& o0, f32x16& o1, const float m, float& lsum, const bf16x8 (&qf)[4],
                      const unsigned char* kp, const unsigned char* vp, int k_off, int kswz, int v_off, int vswz, int h) {
    bf16x8 va0, vb0, va1, vb1, va2, vb2, va3, vb3, ka0, kb0, ka1, kb1, ka2, kb2, ka3, kb3;
    float rs = 0.f;
    if (DO_PV) { va0 = VFRAG(0, 0); vb0 = VFRAG(0, 1); va1 = VFRAG(1, 0); vb1 = VFRAG(1, 1); }
    EXP2F(s0, 0);  if (DO_PV) { o0 = mfma32(va0, pp[0], o0); va2 = VFRAG(2, 0); vb2 = VFRAG(2, 1); } SB_();
    EXP2F(s0, 2);  if (DO_PV) { o1 = mfma32(vb0, pp[0], o1); va3 = VFRAG(3, 0); vb3 = VFRAG(3, 1); } SB_();
    EXP2F(s0, 4);  if (DO_PV) { o0 = mfma32(va1, pp[1], o0); } if (DO_QK) { ka0 = KFRAG(0, 0); kb0 = KFRAG(0, 1); } SB_();
    EXP2F(s0, 6);  if (DO_PV) { o1 = mfma32(vb1, pp[1], o1); } if (DO_QK) { ka1 = KFRAG(1, 0); kb1 = KFRAG(1, 1); } SB_();
    EXP2F(s0, 8);  if (DO_PV) { o0 = mfma32(va2, pp[2], o0); } SB_();
    EXP2F(s0, 10); if (DO_PV) { o1 = mfma32(vb2, pp[2], o1); } pc[0] = PACK8(s0, 0); PIN1(pc[0]); SB_();
    EXP2F(s0, 12); if (DO_PV) { o0 = mfma32(va3, pp[3], o0); } SB_();
    EXP2F(s0, 14); if (DO_PV) { o1 = mfma32(vb3, pp[3], o1); } SB_();
    EXP2F(s1, 0);  if (DO_QK) { n0 = mfma32(ka0, qf[0], (f32x16){0.f, 0.f, 0.f, 0.f, 0.f, 0.f, 0.f, 0.f, 0.f, 0.f, 0.f, 0.f, 0.f, 0.f, 0.f, 0.f}); ka2 = KFRAG(2, 0); kb2 = KFRAG(2, 1); } pc[1] = PACK8(s0, 8); PIN1(pc[1]); SB_();
    EXP2F(s1, 2);  if (DO_QK) { n1 = mfma32(kb0, qf[0], (f32x16){0.f, 0.f, 0.f, 0.f, 0.f, 0.f, 0.f, 0.f, 0.f, 0.f, 0.f, 0.f, 0.f, 0.f, 0.f, 0.f}); ka3 = KFRAG(3, 0); kb3 = KFRAG(3, 1); } SB_();
    EXP2F(s1, 4);  if (DO_QK) { n0 = mfma32(ka1, qf[1], n0); } SB_();
    EXP2F(s1, 6);  if (DO_QK) { n1 = mfma32(kb1, qf[1], n1); } SB_();
    EXP2F(s1, 8);  if (DO_QK) { n0 = mfma32(ka2, qf[2], n0); } pc[2] = PACK8(s1, 0); PIN1(pc[2]); SB_();
    EXP2F(s1, 10); if (DO_QK) { n1 = mfma32(kb2, qf[2], n1); } SB_();
    EXP2F(s1, 12); if (DO_QK) { n0 = mfma32(ka3, qf[3], n0); } SB_();
    EXP2F(s1, 14); if (DO_QK) { n1 = mfma32(kb3, qf[3], n1); } pc[3] = PACK8(s1, 8); PIN1(pc[3]);
    lsum += rs;
    SB_();
}
template <bool DO_PV, bool DO_QK, bool FIXM>
DI void attn_step(f32x16& s0, f32x16& s1, f32x16& n0, f32x16& n1, const bf16x8 (&pp)[4], bf16x8 (&pc)[4],
                  f32x16& o0, f32x16& o1, float& m, float& lsum, const bf16x8 (&qf)[4],
                  const unsigned char* kp, const unsigned char* vp, int k_off, int kswz, int v_off, int vswz, int h) {
    if (FIXM) { attn_step_fix<DO_PV, DO_QK>(s0, s1, n0, n1, pp, pc, o0, o1, m, lsum, qf, kp, vp, k_off, kswz, v_off, vswz, h); return; }
    bf16x8 va0, vb0, va1, vb1, va2, vb2, va3, vb3, ka0, kb0, ka1, kb1, ka2, kb2, ka3, kb3;
    if (DO_PV) { va0 = VFRAG(0, 0); vb0 = VFRAG(0, 1); va1 = VFRAG(1, 0); vb1 = VFRAG(1, 1); }
    float mx = s0[0];
    if (DO_PV) o0 = mfma32(va0, pp[0], o0);
    if (!FIXM) mx = max8(s0, 0, mx);
    SB_();
    if (DO_PV) { o1 = mfma32(vb0, pp[0], o1); va2 = VFRAG(2, 0); vb2 = VFRAG(2, 1); }
    if (!FIXM) mx = max8(s0, 8, mx);
    SB_();
    if (DO_PV) { o0 = mfma32(va1, pp[1], o0); va3 = VFRAG(3, 0); vb3 = VFRAG(3, 1); }
    if (!FIXM) mx = max8(s1, 0, mx);
    SB_();
    if (DO_PV) o1 = mfma32(vb1, pp[1], o1);
    bool need = false; float alpha = 1.0f;
    if (!FIXM) {
        mx = max8(s1, 8, mx);
        mx = xhalf_max(mx);
        need = mx > m + 8.0f;
        const float mnew = need ? mx : m;
        alpha = __builtin_amdgcn_exp2f(m - mnew);
        m = mnew;
    }
    const float mb = m;
    float rs = 0.f; f32x2_t rs2 = {0.f, 0.f};
    SB_();
    if (DO_PV) o0 = mfma32(va2, pp[2], o0);
    if (DO_QK) { ka0 = KFRAG(0, 0); kb0 = KFRAG(0, 1); }
    EXPQ(s0, 0);
    SB_();
    if (DO_PV) o1 = mfma32(vb2, pp[2], o1);
    if (DO_QK) { ka1 = KFRAG(1, 0); kb1 = KFRAG(1, 1); }
    EXPQ(s0, 4);
    SB_();
    if (DO_PV) o0 = mfma32(va3, pp[3], o0);
    EXPQ(s0, 8);
    SB_();
    if (DO_PV) o1 = mfma32(vb3, pp[3], o1);
    EXPQ(s0, 12);
    SB_();
    if (DO_QK) { n0 = mfma32(ka0, qf[0], (f32x16){0.f, 0.f, 0.f, 0.f, 0.f, 0.f, 0.f, 0.f, 0.f, 0.f, 0.f, 0.f, 0.f, 0.f, 0.f, 0.f}); ka2 = KFRAG(2, 0); kb2 = KFRAG(2, 1); }
    EXPQ(s1, 0);
    SB_();
    if (DO_QK) { n1 = mfma32(kb0, qf[0], (f32x16){0.f, 0.f, 0.f, 0.f, 0.f, 0.f, 0.f, 0.f, 0.f, 0.f, 0.f, 0.f, 0.f, 0.f, 0.f, 0.f}); ka3 = KFRAG(3, 0); kb3 = KFRAG(3, 1); }
    EXPQ(s1, 4);
    SB_();
    if (DO_QK) n0 = mfma32(ka1, qf[1], n0);
    EXPQ(s1, 8);
    SB_();
    if (DO_QK) n1 = mfma32(kb1, qf[1], n1);
    EXPQ(s1, 12);
    SB_();
    if (DO_QK) n0 = mfma32(ka2, qf[2], n0);
    pc[0] = PACK8(s0, 0);
    SB_();
    if (DO_QK) n1 = mfma32(kb2, qf[2], n1);
    pc[1] = PACK8(s0, 8);
    SB_();
    if (DO_QK) n0 = mfma32(ka3, qf[3], n0);
    pc[2] = PACK8(s1, 0);
    SB_();
    if (DO_QK) n1 = mfma32(kb3, qf[3], n1);
    pc[3] = PACK8(s1, 8);
    if (FIXM) lsum += rs2.x + rs2.y; else lsum = lsum * alpha + rs;
    SB_();
    if (!FIXM) {
        if (__builtin_amdgcn_ballot_w64(need)) {
#pragma unroll
            for (int i = 0; i < 16; ++i) { o0[i] *= alpha; o1[i] *= alpha; }
        }
    }
}

template <bool FIXM>
DI void attn_item(const bf16_t* __restrict__ Q, int ldq, const bf16_t* __restrict__ K, int ldk, const bf16_t* __restrict__ VT, int ldv,
                  int nkeys, bf16_t* __restrict__ O, const bf16_t* __restrict__ G, unsigned char* smem, float mfix) {
    const int tid = opaque_tid(), lane = tid & 63, wave = tid >> 6;
    const int r = lane & 31, h = lane >> 5;
    bf16x8 qf[4];
    {
        const bf16_t* qp = Q + (size_t)(wave * 32 + r) * ldq + h * 8;
#pragma unroll
        for (int ks = 0; ks < 4; ++ks) qf[ks] = *(const bf16x8*)(qp + ks * 16);
    }
    const int lrow = tid >> 3, lc = tid & 7;
    const bf16_t* Kg = K + (size_t)lrow * ldk + lc * 8;
    const bf16_t* Vg = VT + (size_t)lrow * ldv + lc * 8;
    const int st_off = lrow * 128 + ((lc ^ ((lrow >> 1) & 7)) << 4);
    const int pr = (r & ~12) | ((r & 4) << 1) | ((r & 8) >> 1);
    const int kswz = (pr >> 1) & 7, vswz = (r >> 1) & 7;
    const int k_off = pr * 128, v_off = r * 128;
    const int nt = nkeys >> 6;

    f32x16 o0, o1, sa0, sa1, sb0, sb1;
#pragma unroll
    for (int i = 0; i < 16; ++i) { o0[i] = 0.f; o1[i] = 0.f; }
    float m = FIXM ? mfix : -1e30f, lsum = 0.f;
    bf16x8 pa[4], pb[4];

    u32x4 rk, rv;
#define A_LOAD(U) { const int kt_ = ((U) + 2 < nt) ? (U) + 2 : nt - 1; rk = *(const u32x4*)(Kg + (size_t)(kt_ * 64) * ldk); rv = *(const u32x4*)(Vg + (U) * 64); }
#define A_STORE(OFF) { *(u32x4*)(smem + (OFF) + st_off) = rk; *(u32x4*)(smem + (OFF) + 8192 + st_off) = rv; }
    rk = *(const u32x4*)(Kg); rv = *(const u32x4*)(Kg + (size_t)64 * ldk);
    __syncthreads();
    A_STORE(16384);
    A_LOAD(0);
    A_STORE(0);
    A_LOAD(1);
    lds_barrier();
    {
        const unsigned char* kp = smem + 16384;
        sa0 = mfma32(KFRAG(0, 0), qf[0], (f32x16){0.f, 0.f, 0.f, 0.f, 0.f, 0.f, 0.f, 0.f, 0.f, 0.f, 0.f, 0.f, 0.f, 0.f, 0.f, 0.f});
        sa1 = mfma32(KFRAG(0, 1), qf[0], (f32x16){0.f, 0.f, 0.f, 0.f, 0.f, 0.f, 0.f, 0.f, 0.f, 0.f, 0.f, 0.f, 0.f, 0.f, 0.f, 0.f});
#pragma unroll
        for (int ks = 1; ks < 4; ++ks) { sa0 = mfma32(KFRAG(ks, 0), qf[ks], sa0); sa1 = mfma32(KFRAG(ks, 1), qf[ks], sa1); }
    }
    attn_step<false, true, FIXM>(sa0, sa1, sb0, sb1, pb, pa, o0, o1, m, lsum, qf, smem + 16384 + 8192, smem, k_off, kswz, v_off, vswz, h);
    lds_barrier();
    for (int t = 1; t < nt - 1; t += 2) {
        A_STORE(16384);
        A_LOAD(t + 1);
        SB_();
        attn_step<true, true, FIXM>(sb0, sb1, sa0, sa1, pa, pb, o0, o1, m, lsum, qf, smem, smem + 8192, k_off, kswz, v_off, vswz, h);
        lds_barrier();
        A_STORE(0);
        A_LOAD(t + 2);
        SB_();
        attn_step<true, true, FIXM>(sa0, sa1, sb0, sb1, pb, pa, o0, o1, m, lsum, qf, smem + 16384, smem + 16384 + 8192, k_off, kswz, v_off, vswz, h);
        lds_barrier();
    }
    A_STORE(16384);
    const bf16_t* gp = G + (size_t)(wave * 32 + r) * INW + 4 * h;
    u32x2 gga[4], ggb[4];
#pragma unroll
    for (int gq = 0; gq < 4; ++gq) { gga[gq] = *(const u32x2*)(gp + 8 * gq); ggb[gq] = *(const u32x2*)(gp + 32 + 8 * gq); }
    SB_();
    attn_step<true, false, FIXM>(sb0, sb1, sa0, sa1, pa, pb, o0, o1, m, lsum, qf, smem, smem + 8192, k_off, kswz, v_off, vswz, h);
    lds_barrier();
    {
        const unsigned char* vp = smem + 16384 + 8192;
#pragma unroll
        for (int kk = 0; kk < 4; ++kk) { o0 = mfma32(VFRAG(kk, 0), pb[kk], o0); o1 = mfma32(VFRAG(kk, 1), pb[kk], o1); }
    }
#undef A_LOAD
#undef A_STORE
    const float lt = lsum + __shfl_xor(lsum, 32);
    const float inv = 1.0f / lt;
    bf16_t* op = O + (size_t)(wave * 32 + r) * 1024 + 4 * h;
#pragma unroll
    for (int gq = 0; gq < 4; ++gq) {
        {
            const u32x2 gg = gga[gq];
            u32x2 w;
            w.x = pk_bf16(o0[4 * gq] * inv * bflo(gg.x), o0[4 * gq + 1] * inv * bfhi(gg.x));
            w.y = pk_bf16(o0[4 * gq + 2] * inv * bflo(gg.y), o0[4 * gq + 3] * inv * bfhi(gg.y));
            *(u32x2*)(op + 8 * gq) = w;
        }
        {
            const u32x2 gg = ggb[gq];
            u32x2 w;
            w.x = pk_bf16(o1[4 * gq] * inv * bflo(gg.x), o1[4 * gq + 1] * inv * bfhi(gg.x));
            w.y = pk_bf16(o1[4 * gq + 2] * inv * bflo(gg.y), o1[4 * gq + 3] * inv * bfhi(gg.y));
            *(u32x2*)(op + 32 + 8 * gq) = w;
        }
    }
}

DI void cross_item(const bf16_t* __restrict__ Q, const bf16_t* __restrict__ K, const bf16_t* __restrict__ VT,
                   bf16_t* __restrict__ O, const bf16_t* __restrict__ G, unsigned char* smem) {
    const int tid = opaque_tid(), lane = tid & 63, wave = tid >> 6;
    const int r = lane & 31, h = lane >> 5;
    bf16x8 qf[4];
    {
        const bf16_t* qp = Q + (size_t)(wave * 32 + r) * INW + h * 8;
#pragma unroll
        for (int ks = 0; ks < 4; ++ks) qf[ks] = *(const bf16x8*)(qp + ks * 16);
    }
    const int lrow = tid >> 3, lc = tid & 7;
    const int st_off = lrow * 128 + ((lc ^ ((lrow >> 1) & 7)) << 4);
    {
        u32x4 kk[4], vv[4];
#pragma unroll
        for (int i = 0; i < 4; ++i) { kk[i] = *(const u32x4*)(K + (size_t)(lrow + 64 * i) * 256 + lc * 8); vv[i] = *(const u32x4*)(VT + (size_t)lrow * 256 + (i * 8 + lc) * 8); }
        __syncthreads();
#pragma unroll
        for (int i = 0; i < 4; ++i) { *(u32x4*)(smem + i * 16384 + st_off) = kk[i]; *(u32x4*)(smem + i * 16384 + 8192 + st_off) = vv[i]; }
    }
    const bf16_t* gp = G + (size_t)(wave * 32 + r) * INW + 4 * h;
    u32x2 gga[4], ggb[4];
#pragma unroll
    for (int gq = 0; gq < 4; ++gq) { gga[gq] = *(const u32x2*)(gp + 8 * gq); ggb[gq] = *(const u32x2*)(gp + 32 + 8 * gq); }
    __syncthreads();
    const int pr = (r & ~12) | ((r & 4) << 1) | ((r & 8) >> 1);
    const int kswz = (pr >> 1) & 7, vswz = (r >> 1) & 7;
    const int k_off = pr * 128, v_off = r * 128;
    f32x16 o0, o1;
#pragma unroll
    for (int i = 0; i < 16; ++i) { o0[i] = 0.f; o1[i] = 0.f; }
    float m = -1e30f, lsum = 0.f;
#pragma unroll 1
    for (int kt = 0; kt < 4; ++kt) {
        const unsigned char* kp = smem + kt * 16384;
        const unsigned char* vp = kp + 8192;
        f32x16 s0, s1;
        s0 = mfma32(KFRAG(0, 0), qf[0], (f32x16){0.f, 0.f, 0.f, 0.f, 0.f, 0.f, 0.f, 0.f, 0.f, 0.f, 0.f, 0.f, 0.f, 0.f, 0.f, 0.f});
        s1 = mfma32(KFRAG(0, 1), qf[0], (f32x16){0.f, 0.f, 0.f, 0.f, 0.f, 0.f, 0.f, 0.f, 0.f, 0.f, 0.f, 0.f, 0.f, 0.f, 0.f, 0.f});
#pragma unroll
        for (int ks = 1; ks < 4; ++ks) { s0 = mfma32(KFRAG(ks, 0), qf[ks], s0); s1 = mfma32(KFRAG(ks, 1), qf[ks], s1); }
        float mx = s0[0];
        mx = max8(s0, 0, mx); mx = max8(s0, 8, mx); mx = max8(s1, 0, mx); mx = max8(s1, 8, mx);
        mx = xhalf_max(mx);
        const float mnew = fmaxf(m, mx);
        const float alpha = __builtin_amdgcn_exp2f(m - mnew);
        m = mnew;
        const float mb = mnew;
        float rs = 0.f;
#pragma unroll
        for (int i = 0; i < 16; ++i) { s0[i] = __builtin_amdgcn_exp2f(s0[i] - mb); s1[i] = __builtin_amdgcn_exp2f(s1[i] - mb); rs += s0[i] + s1[i]; }
        lsum = lsum * alpha + rs;
#pragma unroll
        for (int i = 0; i < 16; ++i) { o0[i] *= alpha; o1[i] *= alpha; }
        bf16x8 pf[4];
        pf[0] = PACK8(s0, 0); pf[1] = PACK8(s0, 8); pf[2] = PACK8(s1, 0); pf[3] = PACK8(s1, 8);
#pragma unroll
        for (int kk2 = 0; kk2 < 4; ++kk2) { o0 = mfma32(VFRAG(kk2, 0), pf[kk2], o0); o1 = mfma32(VFRAG(kk2, 1), pf[kk2], o1); }
    }
    const float lt = lsum + __shfl_xor(lsum, 32);
    const float inv = 1.0f / lt;
    bf16_t* op = O + (size_t)(wave * 32 + r) * 1024 + 4 * h;
#pragma unroll
    for (int gq = 0; gq < 4; ++gq) {
        {
            const u32x2 gg = gga[gq];
            u32x2 w;
            w.x = pk_bf16(o0[4 * gq] * inv * bflo(gg.x), o0[4 * gq + 1] * inv * bfhi(gg.x));
            w.y = pk_bf16(o0[4 * gq + 2] * inv * bflo(gg.y), o0[4 * gq + 3] * inv * bfhi(gg.y));
            *(u32x2*)(op + 8 * gq) = w;
        }
        {
            const u32x2 gg = ggb[gq];
            u32x2 w;
            w.x = pk_bf16(o1[4 * gq] * inv * bflo(gg.x), o1[4 * gq + 1] * inv * bfhi(gg.x));
            w.y = pk_bf16(o1[4 * gq + 2] * inv * bflo(gg.y), o1[4 * gq + 3] * inv * bfhi(gg.y));
            *(u32x2*)(op + 32 + 8 * gq) = w;
        }
    }
}

DI void pool_item(const bf16_t* __restrict__ Z, const bf16_t* __restrict__ PWT, const float* __restrict__ pscale, bf16_t* __restrict__ MIX,
                  int tokg0, unsigned char* smem) {
    const int tid = opaque_tid(), lane = tid & 63, wave = tid >> 6;
    const int T = (tokg0 < NPROMPT) ? 2048 : 4096;
    const int t0 = tokg0 & (T - 1);
    constexpr int RS = 528;
    const int g = wave & 3, half = 1 << g;
    const int r16 = lane & 15, q4 = lane >> 4;
    const bf16_t* pw = PWT + (size_t)g * 4096 + r16 * 64 + q4 * 8;
    bf16x8 wfr[4][2]; f32x4 psr[4]; u32x2 ggr[2][4];
#pragma unroll
    for (int fi = 0; fi < 4; ++fi) {
        psr[fi] = *(const f32x4*)(pscale + g * 64 + fi * 16 + 4 * q4);
#pragma unroll
        for (int ks = 0; ks < 2; ++ks) wfr[fi][ks] = *(const bf16x8*)(pw + fi * 16 * 64 + ks * 32);
#pragma unroll
        for (int t2 = 0; t2 < 2; ++t2) ggr[t2][fi] = *(const u32x2*)(Z + ((size_t)tokg0 + ((wave >> 2) * 2 + t2) * 16 + r16) * INW + 256 + g * 64 + fi * 16 + 4 * q4);
    }
    __syncthreads();
    for (int id = tid; id < 80 * 32; id += 512) {
        const int rr = id >> 5, c = id & 31;
        const int t = t0 - 8 + rr;
        u32x4 v = (u32x4){0u, 0u, 0u, 0u};
        if (t >= 0 && t < T) v = *(const u32x4*)(Z + (size_t)(tokg0 - 8 + rr) * INW + c * 8);
        *(u32x4*)(smem + rr * RS + c * 16) = v;
    }
    __syncthreads();
    {
        const int th = wave >> 2;
        bf16x8 df[2][2];
#pragma unroll
        for (int t2 = 0; t2 < 2; ++t2)
#pragma unroll
            for (int ks = 0; ks < 2; ++ks) {
                const int tl = (th * 2 + t2) * 16 + r16, t = t0 + tl;
                const int lo = max(t - half, 0), hi = min(t + half, T);
                const float icnt = 1.0f / (float)(hi - lo);
                float s[8];
#pragma unroll
                for (int j = 0; j < 8; ++j) s[j] = 0.f;
                const unsigned char* bp = smem + (tl + 8 - half) * RS + (g * 64 + ks * 32 + q4 * 8) * 2;
                for (int j = 0; j < 2 * half; ++j) {
                    const u32x4 v = *(const u32x4*)(bp + j * RS);
                    s[0] += bflo(v.x); s[1] += bfhi(v.x); s[2] += bflo(v.y); s[3] += bfhi(v.y);
                    s[4] += bflo(v.z); s[5] += bfhi(v.z); s[6] += bflo(v.w); s[7] += bfhi(v.w);
                }
                const u32x4 c = *(const u32x4*)(bp + half * RS);
                u32x4 o;
                o.x = pk_bf16(s[0] * icnt - bflo(c.x), s[1] * icnt - bfhi(c.x));
                o.y = pk_bf16(s[2] * icnt - bflo(c.y), s[3] * icnt - bfhi(c.y));
                o.z = pk_bf16(s[4] * icnt - bflo(c.z), s[5] * icnt - bfhi(c.z));
                o.w = pk_bf16(s[6] * icnt - bflo(c.w), s[7] * icnt - bfhi(c.w));
                df[t2][ks] = __builtin_bit_cast(bf16x8, o);
            }
        f32x4 acc[4][2];
#pragma unroll
        for (int i = 0; i < 4; ++i)
#pragma unroll
            for (int j = 0; j < 2; ++j) acc[i][j] = (f32x4){0.f, 0.f, 0.f, 0.f};
#pragma unroll
        for (int fi = 0; fi < 4; ++fi)
#pragma unroll
            for (int ks = 0; ks < 2; ++ks) {
                const bf16x8 wf = wfr[fi][ks];
#pragma unroll
                for (int t2 = 0; t2 < 2; ++t2) acc[fi][t2] = mfma16(wf, df[t2][ks], acc[fi][t2]);
            }
#pragma unroll
        for (int t2 = 0; t2 < 2; ++t2) {
            const size_t tok = (size_t)tokg0 + (th * 2 + t2) * 16 + r16;
#pragma unroll
            for (int fi = 0; fi < 4; ++fi) {
                const int n = g * 64 + fi * 16 + 4 * q4;
                const f32x4 ps = psr[fi];
                const u32x2 gg = ggr[t2][fi];
                u32x2 w;
                w.x = pk_bf16(acc[fi][t2][0] * ps[0] * bflo(gg.x), acc[fi][t2][1] * ps[1] * bfhi(gg.x));
                w.y = pk_bf16(acc[fi][t2][2] * ps[2] * bflo(gg.y), acc[fi][t2][3] * ps[3] * bfhi(gg.y));
                *(u32x2*)(MIX + tok * 1024 + n) = w;
            }
        }
    }
}

struct PostIn { u32x4 yv[2]; f32x4 xv[4]; };
DI PostIn post_row_load(const float* __restrict__ xsrc, const bf16_t* __restrict__ yh, int lane) {
    PostIn r;
#pragma unroll
    for (int j = 0; j < 2; ++j) r.yv[j] = *(const u32x4*)(yh + j * 512 + lane * 8);
#pragma unroll
    for (int j = 0; j < 2; ++j) { r.xv[2 * j] = *(const f32x4*)(xsrc + j * 512 + lane * 8); r.xv[2 * j + 1] = *(const f32x4*)(xsrc + j * 512 + lane * 8 + 4); }
    return r;
}
DI void post_row_finish(const PostIn& in, bf16_t* __restrict__ yh, const float* __restrict__ gpost, const float* __restrict__ gpre_next,
                        float* __restrict__ xdst, bool last, int lane) {
    u32x4 yv[2]; f32x4 xv[4];
#pragma unroll
    for (int j = 0; j < 2; ++j) yv[j] = in.yv[j];
#pragma unroll
    for (int j = 0; j < 4; ++j) xv[j] = in.xv[j];
    float y[16];
#pragma unroll
    for (int j = 0; j < 2; ++j) {
        y[8 * j + 0] = bflo(yv[j].x); y[8 * j + 1] = bfhi(yv[j].x); y[8 * j + 2] = bflo(yv[j].y); y[8 * j + 3] = bfhi(yv[j].y);
        y[8 * j + 4] = bflo(yv[j].z); y[8 * j + 5] = bfhi(yv[j].z); y[8 * j + 6] = bflo(yv[j].w); y[8 * j + 7] = bfhi(yv[j].w);
    }
    float ss = 0.f;
#pragma unroll
    for (int i = 0; i < 16; ++i) ss += y[i] * y[i];
    ss = wave_sum(ss);
    const float r = rsqrtf(ss * (1.0f / 1024.0f) + EPS);
    float xn[16]; float ss2 = 0.f;
#pragma unroll
    for (int j = 0; j < 2; ++j) {
        const f32x4 g0 = *(const f32x4*)(gpost + j * 512 + lane * 8), g1 = *(const f32x4*)(gpost + j * 512 + lane * 8 + 4);
#pragma unroll
        for (int i = 0; i < 4; ++i) {
            xn[8 * j + i] = xv[2 * j][i] + y[8 * j + i] * r * g0[i];
            xn[8 * j + 4 + i] = xv[2 * j + 1][i] + y[8 * j + 4 + i] * r * g1[i];
        }
    }
#pragma unroll
    for (int i = 0; i < 16; ++i) ss2 += xn[i] * xn[i];
#pragma unroll
    for (int j = 0; j < 2; ++j) {
        *(f32x4*)(xdst + j * 512 + lane * 8) = (f32x4){xn[8 * j], xn[8 * j + 1], xn[8 * j + 2], xn[8 * j + 3]};
        *(f32x4*)(xdst + j * 512 + lane * 8 + 4) = (f32x4){xn[8 * j + 4], xn[8 * j + 5], xn[8 * j + 6], xn[8 * j + 7]};
    }
    if (!last) {
        ss2 = wave_sum(ss2);
        const float r2 = rsqrtf(ss2 * (1.0f / 1024.0f) + EPS);
#pragma unroll
        for (int j = 0; j < 2; ++j) {
            const f32x4 g0 = *(const f32x4*)(gpre_next + j * 512 + lane * 8), g1 = *(const f32x4*)(gpre_next + j * 512 + lane * 8 + 4);
            u32x4 o;
            o.x = pk_bf16(xn[8 * j] * r2 * g0[0], xn[8 * j + 1] * r2 * g0[1]);
            o.y = pk_bf16(xn[8 * j + 2] * r2 * g0[2], xn[8 * j + 3] * r2 * g0[3]);
            o.z = pk_bf16(xn[8 * j + 4] * r2 * g1[0], xn[8 * j + 5] * r2 * g1[1]);
            o.w = pk_bf16(xn[8 * j + 6] * r2 * g1[2], xn[8 * j + 7] * r2 * g1[3]);
            *(u32x4*)(yh + j * 512 + lane * 8) = o;
        }
    }
}

#define XB_TMO      128
#define XB_XCNT(j)  (256  + 64 * (j))
#define XB_XSUB(j)  (1280 + 64 * (j))
#define XB_XGEN(j)  (2304 + 64 * (j))
#define XB_TOP      3328
#define XB_TOPGEN   3392
#define XCD_BAR_WORDS 3456
#define XB_SPIN_CAP (1u << 18)
#define LAS __attribute__((address_space(3)))
DI unsigned xb_ld(unsigned* p)              { return __hip_atomic_load(p, __ATOMIC_RELAXED, __HIP_MEMORY_SCOPE_AGENT); }
DI unsigned xb_add(unsigned* p, unsigned v) { return __hip_atomic_fetch_add(p, v, __ATOMIC_RELAXED, __HIP_MEMORY_SCOPE_AGENT); }
DI unsigned xb_xcc_id() { return (unsigned)__builtin_amdgcn_s_getreg((3 << 11) | 20) & 0xFu; }
#define XB_SPIN(cond, bar) do { unsigned _sp = 0; while (cond) { __builtin_amdgcn_s_sleep(1); \
    if ((++_sp & 255u) == 0u) { if (xb_ld(&(bar)[XB_TMO])) break; if (_sp > XB_SPIN_CAP) { atomicAdd(&(bar)[XB_TMO], 1u); break; } } } } while (0)
struct XcdBarrier { unsigned* bar; unsigned x; volatile LAS unsigned* st; };
DI XcdBarrier xcd_barrier_post(unsigned* bar, volatile LAS unsigned* st) {
    XcdBarrier b; b.bar = bar; b.x = xb_xcc_id(); b.st = st;
    if (threadIdx.x == 0) (void)xb_add(&bar[XB_XCNT(b.x)], 1u);
    return b;
}
DI void xcd_barrier_complete(unsigned* bar, unsigned x, unsigned& nloc, unsigned& nx) {
    const unsigned G = gridDim.x * gridDim.y * gridDim.z;
    unsigned sum, cnt, mine, sp = 0u;
    for (;;) {
        sum = 0u; cnt = 0u; mine = 0u;
#pragma unroll
        for (unsigned j = 0; j < 16; ++j) { const unsigned c = xb_ld(&bar[XB_XCNT(j)]); sum += c; cnt += (c > 0u) ? 1u : 0u; mine = (j == x) ? c : mine; }
        if (sum == G) break;
        __builtin_amdgcn_s_sleep(1);
        if ((++sp & 255u) == 0u) { if (xb_ld(&bar[XB_TMO])) break; if (sp > XB_SPIN_CAP) { atomicAdd(&bar[XB_TMO], 1u); break; } }
    }
    nloc = mine > 0u ? mine : 1u; nx = cnt > 0u ? cnt : 1u;
}
DI void xcd_barrier(const XcdBarrier& b) {
    asm volatile("s_waitcnt vmcnt(0)" ::: "memory");
    __syncthreads();
    if (threadIdx.x == 0) {
        unsigned* bar = b.bar;
        __builtin_amdgcn_s_waitcnt(0);
        unsigned nloc = b.st[0], nx = b.st[1];
        if (nloc == 0u) { xcd_barrier_complete(bar, b.x, nloc, nx); b.st[0] = nloc; b.st[1] = nx; }
        const unsigned old = xb_add(&bar[XB_XSUB(b.x)], 1u);
        const unsigned gen = old / nloc;
        if (old + 1u == (gen + 1u) * nloc) {
            __builtin_amdgcn_fence(__ATOMIC_RELEASE, "agent");
            asm volatile("s_waitcnt vmcnt(0)" ::: "memory");
            const unsigned og = xb_add(&bar[XB_TOP], 1u);
            const unsigned tg = og / nx;
            if (og + 1u == (tg + 1u) * nx) xb_add(&bar[XB_TOPGEN], 1u);
            else XB_SPIN(xb_ld(&bar[XB_TOPGEN]) == tg, bar);
            __builtin_amdgcn_fence(__ATOMIC_ACQUIRE, "agent");
            xb_add(&bar[XB_XGEN(b.x)], 1u);
            asm volatile("s_waitcnt vmcnt(0)" ::: "memory");
        } else {
            XB_SPIN(xb_ld(&bar[XB_XGEN(b.x)]) == gen, bar);
            __builtin_amdgcn_fence(__ATOMIC_ACQUIRE, "agent");
            asm volatile("s_waitcnt vmcnt(0)" ::: "memory");
        }
    }
    __syncthreads();
}

__global__ void __launch_bounds__(512, 2) fwd_megakernel(Params p) {
    __shared__ __attribute__((aligned(16))) unsigned char smem[131072];
    __shared__ uint4 xb_words;
    cg::grid_group grid = cg::this_grid();
    const int nb = gridDim.x, bid = blockIdx.x;
    if (threadIdx.x == 0) xb_words = make_uint4(0u, 0u, 0u, 0u);
    __syncthreads();
    XcdBarrier xb = xcd_barrier_post((unsigned*)(p.ws + OFF_BAR), (volatile LAS unsigned*)&xb_words);
    if (p.phase_end > 1000) grid.sync();
    for (int ph = p.phase_begin; ph < p.phase_end; ++ph) {
        const int tid = opaque_tid(), lane = tid & 63, wave = tid >> 6;
        unsigned char* ws = p.ws;
        bf16_t* H = (bf16_t*)(ws + OFF_H);
        bf16_t* Z = (bf16_t*)(ws + OFF_Z);
        bf16_t* VT = (bf16_t*)(ws + OFF_VT);
        bf16_t* MIX = (bf16_t*)(ws + OFF_MIX);
        bf16_t* WIN = (bf16_t*)(ws + OFF_WIN);
        bf16_t* WOUT = (bf16_t*)(ws + OFF_WOUT);
        bf16_t* WMEM = (bf16_t*)(ws + OFF_WMEM);
        bf16_t* PW = (bf16_t*)(ws + OFF_PW);
        bf16_t* MH = (bf16_t*)(ws + OFF_MH);
        bf16_t* KM = (bf16_t*)(ws + OFF_KM);
        bf16_t* VMT = (bf16_t*)(ws + OFF_VMT);
        float* ROPE = (float*)(ws + OFF_ROPE);
        if (ph == 0) {
            for (int i = bid; i < 1928; i += nb) {
                if (i < 1152) { const int l = i / 576, j = i % 576, kt = j / 36, ntile = j % 36;
                    transpose_tile(p.w_in + (size_t)l * DM * INW, INW, WIN + (size_t)l * INW * DM, DM, kt * 64, ntile * 64, smem);
                } else if (i < 1664) { const int ii = i - 1152, l = ii / 256, j = ii % 256, kt = j / 16, ntile = j % 16;
                    transpose_tile(p.w_out + (size_t)l * DM * DM, DM, WOUT + (size_t)l * DM * DM, DM, kt * 64, ntile * 64, smem);
                } else if (i < 1920) { const int ii = i - 1664, l = ii / 128, j = ii % 128, kt = j / 8, ntile = j % 8;
                    transpose_tile(p.w_mem_kv + (size_t)l * DM * 512, 512, WMEM + (size_t)l * 512 * DM, DM, kt * 64, ntile * 64, smem);
                } else { const int ii = i - 1920;
                    transpose_tile(p.pool_w + (size_t)ii * 4096, 64, PW + (size_t)ii * 4096, 64, 0, 0, smem);
                }
            }
            {
                constexpr int NR = NTOK + 2 * NMEMTOK;
                auto desc = [&](int i, const float*& src, const float*& g, bf16_t*& dst) {
                    if (i < NTOK) { src = (i < NPROMPT) ? p.x_prompt + (size_t)i * DM : p.x_sample + (size_t)(i - NPROMPT) * DM; g = p.norm_pre; dst = H + (size_t)i * DM; }
                    else { const int ii = i - NTOK, l = ii / NMEMTOK, mt = ii % NMEMTOK;
                           src = (mt < 4096) ? p.mem_prompt + (size_t)mt * DM : p.mem_sample + (size_t)(mt - 4096) * DM; g = p.mem_norm + l * DM; dst = MH + ((size_t)l * NMEMTOK + mt) * DM; }
                };
                int i = bid * 8 + wave;
                if (i < NR) {
                    const float *s, *g; bf16_t* d; desc(i, s, g, d);
                    RowIn cur = rms_row_load(s, lane);
                    for (; i < NR; i += nb * 8) {
                        const int in = (i + nb * 8 < NR) ? i + nb * 8 : NR - 1;
                        const float *s2, *g2; bf16_t* d2; desc(in, s2, g2, d2);
                        const RowIn nxt = rms_row_load(s2, lane);
                        rms_row_finish(cur, g, d, lane);
                        cur = nxt; g = g2; d = d2;
                    }
                }
            }
            for (int i = bid * 512 + tid; i < 1024; i += nb * 512) rope_entry(i, ROPE);
        } else {
            const int l = (ph - 1) >> 2, sub = (ph - 1) & 3;
            if (sub == 0) {
                EpiArgs e; e.C = Z; e.VT = VT; e.qn = p.q_norm + l * 64; e.kn = p.k_norm + l * 64; e.rope = ROPE;
                const bf16_t* Wl = WIN + (size_t)l * INW * DM;
                EpiArgs e2; e2.C = KM + (size_t)l * NMEMTOK * 256; e2.VT = VMT + (size_t)l * NMEMTOK * 256; e2.qn = nullptr; e2.kn = nullptr; e2.rope = nullptr;
                const bf16_t* Wm = WMEM + (size_t)l * 512 * DM;
                const bf16_t* Am = MH + (size_t)l * NMEMTOK * DM;
                for (int i = bid; i < 1728 + 40; i += nb) {
                    if (i < 1728) {
                        const int j = i >> 3, mg = j / 72, rem = j % 72;
                        const int mt = (i & 7) * 24 + mg * 8 + (rem & 7), ntile = rem >> 3;
                        gemm_tile<0>(H, Wl, mt * 256, ntile * 256, e, smem);
                    } else {
                        const int j = i - 1728;
                        gemm_tile<2>(Am, Wm, (j >> 1) * 256, (j & 1) * 256, e2, smem);
                    }
                }
            } else if (sub == 1) {
                float gq = fabsf(p.q_norm[l * 64 + lane]), gk = fabsf(p.k_norm[l * 64 + lane]);
#pragma unroll
                for (int o = 1; o < 64; o <<= 1) { gq = fmaxf(gq, __shfl_xor(gq, o)); gk = fmaxf(gk, __shfl_xor(gk, o)); }
                const float mfix = 8.0f * gq * gk * 1.02f * L2E;
                const bool fixm = mfix < 28.0f;
                for (int i = bid; i < 3072; i += nb) {
                    if (i < 1536) {
                        int b, kvh, j, T; size_t tok0, vtb;
                        if (i < 512) { const int R = i >> 8, ip = i & 255, grp = ip & 7; j = R * 32 + (ip >> 3); b = grp >> 1; kvh = grp & 1; T = 4096;
                            tok0 = (size_t)NPROMPT + (size_t)b * 4096; vtb = (size_t)NPROMPT * 128 + ((size_t)(b * 2 + kvh) * 64) * 4096; }
                        else { const int ii = i - 512, R = ii >> 8, ip = ii & 255, grp = R * 8 + (ip & 7); j = ip >> 3; b = grp >> 1; kvh = grp & 1; T = 2048;
                            tok0 = (size_t)b * 2048; vtb = ((size_t)(b * 2 + kvh) * 64) * 2048; }
                        const int qblk = j >> 2, head = kvh * 4 + (j & 3);
                        const size_t q0 = tok0 + (size_t)qblk * 256;
                        if (fixm) attn_item<true>(Z + q0 * INW + 512 + head * 64, INW, Z + tok0 * INW + 1024 + kvh * 64, INW, VT + vtb, T, T,
                                  MIX + q0 * 1024 + 256 + head * 64, Z + q0 * INW + 1280 + head * 64, smem, mfix);
                        else attn_item<false>(Z + q0 * INW + 512 + head * 64, INW, Z + tok0 * INW + 1024 + kvh * 64, INW, VT + vtb, T, T,
                                  MIX + q0 * 1024 + 256 + head * 64, Z + q0 * INW + 1280 + head * 64, smem, 0.f);
                    } else if (i < 2304) {
                        const int ii = i - 1536, qb = ii >> 2, hx = ii & 3;
                        const size_t q0 = (size_t)qb * 256;
                        const int b = (q0 < NPROMPT) ? (int)(q0 >> 11) : 16 + (int)((q0 - NPROMPT) >> 12);
cross_item(Z + q0 * INW + 1792 + hx * 64, KM + ((size_t)l * NMEMTOK + (size_t)b * 256) * 256 + hx * 64,
                                   VMT + (size_t)l * NMEMTOK * 256 + ((size_t)(b * 4 + hx) * 64) * 256,
                                   MIX + q0 * 1024 + 768 + hx * 64, Z + q0 * INW + 2048 + hx * 64, smem);
                    } else {
                        pool_item(Z, PW + (size_t)l * 4 * 4096, p.pool_scale + l * 256, MIX, (i - 2304) * 64, smem);
                    }
                }
            } else if (sub == 2) {
                EpiArgs e; e.C = H; e.VT = nullptr; e.qn = nullptr; e.kn = nullptr; e.rope = nullptr;
                const bf16_t* Wl = WOUT + (size_t)l * DM * DM;
                for (int i = bid; i < 768; i += nb) {
                    const int j = i >> 3, mg = j >> 5, rem = j & 31;
                    const int mt = (i & 7) * 24 + mg * 8 + (rem & 7), ntile = rem >> 3;
                    gemm_tile<1>(MIX, Wl, mt * 256, ntile * 256, e, smem);
                }
            } else {
                const bool last = (l == DEPTH - 1);
                auto xsrc = [&](int i) -> const float* {
                    return (l == 0) ? ((i < NPROMPT) ? p.x_prompt + (size_t)i * DM : p.x_sample + (size_t)(i - NPROMPT) * DM) : p.out + (size_t)i * DM; };
                int i = bid * 8 + wave;
                if (i < NTOK) {
                    PostIn cur = post_row_load(xsrc(i), H + (size_t)i * DM, lane);
                    for (; i < NTOK; i += nb * 8) {
                        const int in = (i + nb * 8 < NTOK) ? i + nb * 8 : i;
                        const PostIn nxt = post_row_load(xsrc(in), H + (size_t)in * DM, lane);
                        post_row_finish(cur, H + (size_t)i * DM, p.norm_post + l * DM, p.norm_pre + (last ? l : l + 1) * DM, p.out + (size_t)i * DM, last, lane);
                        cur = nxt;
                    }
                }
            }
        }
        if (ph + 1 < p.phase_end) xcd_barrier(xb);
    }
}

extern "C" void kernel_launch(void* const* d_in, const int* in_sizes, int n_in, void* d_out, int out_size, void* d_ws, size_t ws_size,
                              hipStream_t stream) {
    static int grid_blocks = 0;
    if (!grid_blocks) {
        int dev = 0, cus = 0, per_cu = 0;
        hipGetDevice(&dev);
        hipDeviceGetAttribute(&cus, hipDeviceAttributeMultiprocessorCount, dev);
        hipOccupancyMaxActiveBlocksPerMultiprocessor(&per_cu, fwd_megakernel, 512, 0);
        if (per_cu > 1) per_cu = 1;
        if (per_cu < 1) per_cu = 1;
        grid_blocks = cus * per_cu;
    }
    Params p{};
    p.x_prompt = (const float*)d_in[0]; p.x_sample = (const float*)d_in[1]; p.mem_prompt = (const float*)d_in[2]; p.mem_sample = (const float*)d_in[3];
    p.norm_pre = (const float*)d_in[4]; p.norm_post = (const float*)d_in[5]; p.w_in = (const float*)d_in[6]; p.pool_w = (const float*)d_in[7];
    p.pool_scale = (const float*)d_in[8]; p.q_norm = (const float*)d_in[9]; p.k_norm = (const float*)d_in[10]; p.mem_norm = (const float*)d_in[11];
    p.w_mem_kv = (const float*)d_in[12]; p.w_out = (const float*)d_in[13];
    p.out = (float*)d_out; p.ws = (unsigned char*)d_ws;
    p.phase_begin = 0; p.phase_end = 1 + 4 * DEPTH;
    if (ws_size < WS_TOTAL) { fprintf(stderr, "workspace too small: %zu < %zu\n", ws_size, (size_t)WS_TOTAL); return; }
    hipMemsetAsync((unsigned char*)d_ws + OFF_BAR, 0, BAR_BYTES, stream);
    void* args[] = {&p};
    hipError_t e = hipLaunchCooperativeKernel((void*)fwd_megakernel, dim3(grid_blocks), dim3(512), args, 0, stream);
    if (e != hipSuccess) fprintf(stderr, "cooperative launch failed: %s (grid %d)\n", hipGetErrorString(e), grid_blocks);
}
```

```cpp
#include <hip/hip_runtime.h>
#include <hip/hip_cooperative_groups.h>
#include <stdint.h>
#include <cstdio>
namespace cg = cooperative_groups;

typedef unsigned short bf16_t;
typedef short bf16x8 __attribute__((ext_vector_type(8)));
typedef float f32x4 __attribute__((ext_vector_type(4)));
typedef float f32x16 __attribute__((ext_vector_type(16)));
typedef unsigned u32x4 __attribute__((ext_vector_type(4)));
typedef unsigned u32x2 __attribute__((ext_vector_type(2)));
typedef __bf16 bf16x2_t __attribute__((ext_vector_type(2)));
typedef float f32x2_t __attribute__((ext_vector_type(2)));
#define DI __device__ __forceinline__

constexpr int NTOK = 49152;
constexpr int NPROMPT = 32768;
constexpr int DM = 1024;
constexpr int INW = 2304;
constexpr int NMEMTOK = 5120;
constexpr int DEPTH = 2;
constexpr float EPS = 1e-6f;
constexpr float L2E = 1.4426950408889634f;

constexpr size_t OFF_H    = 0;
constexpr size_t OFF_Z    = OFF_H + (size_t)NTOK * DM * 2;
constexpr size_t OFF_VT   = OFF_Z + (size_t)NTOK * INW * 2;
constexpr size_t OFF_MIX  = OFF_VT + (size_t)NTOK * 128 * 2;
constexpr size_t OFF_WIN  = OFF_MIX + (size_t)NTOK * DM * 2;
constexpr size_t OFF_WOUT = OFF_WIN + (size_t)DEPTH * INW * DM * 2;
constexpr size_t OFF_WMEM = OFF_WOUT + (size_t)DEPTH * DM * DM * 2;
constexpr size_t OFF_PW   = OFF_WMEM + (size_t)DEPTH * 512 * DM * 2;
constexpr size_t OFF_MH   = OFF_PW + (size_t)DEPTH * 4 * 64 * 64 * 2;
constexpr size_t OFF_KM   = OFF_MH + (size_t)DEPTH * NMEMTOK * DM * 2;
constexpr size_t OFF_VMT  = OFF_KM + (size_t)DEPTH * NMEMTOK * 256 * 2;
constexpr size_t OFF_ROPE = OFF_VMT + (size_t)DEPTH * NMEMTOK * 256 * 2;
constexpr size_t OFF_BAR  = OFF_ROPE + 64 * 16 * 2 * 4;
constexpr size_t BAR_BYTES = 3456 * 4;
constexpr size_t WS_TOTAL = OFF_BAR + BAR_BYTES;

struct Params {
    const float* x_prompt; const float* x_sample; const float* mem_prompt; const float* mem_sample;
    const float* norm_pre; const float* norm_post; const float* w_in; const float* pool_w; const float* pool_scale;
    const float* q_norm; const float* k_norm; const float* mem_norm; const float* w_mem_kv; const float* w_out;
    float* out; unsigned char* ws;
    int phase_begin; int phase_end;
};

DI unsigned pk_bf16(float a, float b) {
    f32x2_t v = {a, b};
    bf16x2_t r = __builtin_convertvector(v, bf16x2_t);
    return __builtin_bit_cast(unsigned, r);
}
DI int opaque_tid() { int t = threadIdx.x; asm volatile("" : "+v"(t)); return t; }
DI void lds_barrier() { asm volatile("s_waitcnt lgkmcnt(0)\n\ts_barrier" ::: "memory"); }
DI float bflo(unsigned u) { return __uint_as_float(u << 16); }
DI float bfhi(unsigned u) { return __uint_as_float(u & 0xffff0000u); }
template <int CTRL> DI float dppf(float v) { return __uint_as_float(__builtin_amdgcn_update_dpp(0u, __float_as_uint(v), CTRL, 0xf, 0xf, true)); }
DI float x16_add(float v) { auto r = __builtin_amdgcn_permlane16_swap(__float_as_uint(v), __float_as_uint(v), false, false); return __uint_as_float(r[0]) + __uint_as_float(r[1]); }
DI float x32_add(float v) { auto r = __builtin_amdgcn_permlane32_swap(__float_as_uint(v), __float_as_uint(v), false, false); return __uint_as_float(r[0]) + __uint_as_float(r[1]); }
DI float x16_max(float v) { auto r = __builtin_amdgcn_permlane16_swap(__float_as_uint(v), __float_as_uint(v), false, false); return fmaxf(__uint_as_float(r[0]), __uint_as_float(r[1])); }
DI float x32_max(float v) { auto r = __builtin_amdgcn_permlane32_swap(__float_as_uint(v), __float_as_uint(v), false, false); return fmaxf(__uint_as_float(r[0]), __uint_as_float(r[1])); }
DI float wave_sum(float v) {
    v += dppf<0xB1>(v); v += dppf<0x4E>(v); v += dppf<0x141>(v); v += dppf<0x140>(v);
    v = x16_add(v); v = x32_add(v);
    return v;
}
DI float wave_max(float v) {
    v = fmaxf(v, dppf<0xB1>(v)); v = fmaxf(v, dppf<0x4E>(v)); v = fmaxf(v, dppf<0x141>(v)); v = fmaxf(v, dppf<0x140>(v));
    v = x16_max(v); v = x32_max(v);
    return v;
}
DI float xhalf_max(float v) {
    auto r = __builtin_amdgcn_permlane32_swap(__float_as_uint(v), __float_as_uint(v), false, false);
    return fmaxf(__uint_as_float(r[0]), __uint_as_float(r[1]));
}
DI float silu_f(float x) { return x * __builtin_amdgcn_rcpf(1.0f + __builtin_amdgcn_exp2f(-x * L2E)); }
DI f32x4 mfma16(bf16x8 a, bf16x8 b, f32x4 c) { return __builtin_amdgcn_mfma_f32_16x16x32_bf16(a, b, c, 0, 0, 0); }
DI f32x16 mfma32(bf16x8 a, bf16x8 b, f32x16 c) { return __builtin_amdgcn_mfma_f32_32x32x16_bf16(a, b, c, 0, 0, 0); }

DI void transpose_tile(const float* __restrict__ src, int ldn, bf16_t* __restrict__ dst, int ldk, int k0, int n0, unsigned char* smem) {
    float* tile = (float*)smem;
    const int tid = opaque_tid();
    __syncthreads();
#pragma unroll
    for (int i = 0; i < 2; ++i) {
        const int id = tid + 512 * i, r = id >> 4, c4 = id & 15;
        const f32x4 v = *(const f32x4*)(src + (size_t)(k0 + r) * ldn + n0 + c4 * 4);
        tile[r * 65 + c4 * 4 + 0] = v[0]; tile[r * 65 + c4 * 4 + 1] = v[1]; tile[r * 65 + c4 * 4 + 2] = v[2]; tile[r * 65 + c4 * 4 + 3] = v[3];
    }
    __syncthreads();
    {
        const int n = tid >> 3, kc = tid & 7;
        float v[8];
#pragma unroll
        for (int j = 0; j < 8; ++j) v[j] = tile[(kc * 8 + j) * 65 + n];
        u32x4 o; o.x = pk_bf16(v[0], v[1]); o.y = pk_bf16(v[2], v[3]); o.z = pk_bf16(v[4], v[5]); o.w = pk_bf16(v[6], v[7]);
        *(u32x4*)(dst + (size_t)(n0 + n) * ldk + k0 + kc * 8) = o;
    }
}

struct RowIn { f32x4 v[4]; };
DI RowIn rms_row_load(const float* __restrict__ src, int lane) {
    RowIn r;
#pragma unroll
    for (int j = 0; j < 4; ++j) r.v[j] = *(const f32x4*)(src + j * 256 + lane * 4);
    return r;
}
DI void rms_row_finish(const RowIn& in, const float* __restrict__ g, bf16_t* __restrict__ dst, int lane) {
    f32x4 v[4]; float ss = 0.f;
#pragma unroll
    for (int j = 0; j < 4; ++j) { v[j] = in.v[j]; ss += v[j][0] * v[j][0] + v[j][1] * v[j][1] + v[j][2] * v[j][2] + v[j][3] * v[j][3]; }
    ss = wave_sum(ss);
    const float r = rsqrtf(ss * (1.0f / 1024.0f) + EPS);
#pragma unroll
    for (int j = 0; j < 4; ++j) {
        const f32x4 gg = *(const f32x4*)(g + j * 256 + lane * 4);
        u32x2 o; o.x = pk_bf16(v[j][0] * r * gg[0], v[j][1] * r * gg[1]); o.y = pk_bf16(v[j][2] * r * gg[2], v[j][3] * r * gg[3]);
        *(u32x2*)(dst + j * 256 + lane * 4) = o;
    }
}

DI void rope_entry(int idx, float* table) {
    const int n = idx >> 4, pp = idx & 15;
    double fd = 1.0;
    for (int i = 0; i < pp; ++i) fd *= 0.5623413251903491;
    const float f = (float)fd;
    const float a = (float)n * f;
    double r = (double)a;
    const double k = rint(r * 0.15915494309189535);
    r -= k * 6.283185307179586;
    const double r2 = r * r;
    double sn = r, cs = 1.0, ts = r, tc = 1.0;
    for (int i = 1; i <= 16; ++i) {
        tc = -tc * r2 / (double)((2 * i - 1) * (2 * i));
        ts = -ts * r2 / (double)((2 * i) * (2 * i + 1));
        cs += tc; sn += ts;
    }
    table[idx * 2] = (float)cs; table[idx * 2 + 1] = (float)sn;
}

struct EpiArgs {
    bf16_t* C;
    bf16_t* VT;
    const float* qn; const float* kn; const float* rope;
};

DI int g8_lds_byte(int r, int c) { const int st = (r >> 4) * 2 + (c >> 5), rr = r & 15, cc = c & 31, ob = rr * 64 + cc * 2; return st * 1024 + (ob ^ (((ob >> 9) & 1) << 5)); }
DI void g8_stage_rc(int b, int& R, int& C) { const int st = b >> 10, sb = b & 1023, swz = sb ^ (((sb >> 9) & 1) << 5); R = (st >> 1) * 16 + (swz >> 6); C = (st & 1) * 32 + ((swz & 63) >> 1); }

template <int MODE>
DI void gemm_tile(const bf16_t* __restrict__ A, const bf16_t* __restrict__ Bt, int m0, int n0, const EpiArgs& e, unsigned char* smem) {
    constexpr int K = 1024, BK = 64, HALF = 128, HTB = 16384, nt = K / BK;
    const int tid = opaque_tid(), lane = tid & 63, wave = tid >> 6;
    const int wr = wave >> 2, wc = wave & 3, fr = lane & 15, fq = lane >> 4;
    int sR0, sC0, sR1, sC1;
    g8_stage_rc(tid * 16, sR0, sC0); g8_stage_rc(tid * 16 + 8192, sR1, sC1);
    const unsigned so0b = (unsigned)(sR0 * K + sC0) * 2u, so1b = (unsigned)(sR1 * K + sC1) * 2u;
    __attribute__((address_space(3))) unsigned char* lds = (__attribute__((address_space(3))) unsigned char*)smem;
#define G8_SA(b, h) (((b) * 2 + (h)) * HTB)
#define G8_SB(b, h) ((4 + (b) * 2 + (h)) * HTB)
#define G8_STAGE(POFF, BASE, br, kt) { const unsigned char* g_ = (const unsigned char*)((BASE) + (size_t)(br) * K + (kt) * BK); \
        __builtin_amdgcn_global_load_lds((const __attribute__((address_space(1))) unsigned*)(g_ + so0b), (__attribute__((address_space(3))) unsigned*)(lds + (POFF) + tid * 16), 16, 0, 0); \
        __builtin_amdgcn_global_load_lds((const __attribute__((address_space(1))) unsigned*)(g_ + so1b), (__attribute__((address_space(3))) unsigned*)(lds + (POFF) + tid * 16 + 8192), 16, 0, 0); }
    const int lane_off = (fr * 64 + fq * 16) ^ ((fr >> 3) << 5);
    const unsigned ldsA = (unsigned)(size_t)lds + (unsigned)(lane_off + wr * 8192);
    const unsigned ldsB = (unsigned)(size_t)lds + (unsigned)(lane_off + wc * 4096);
#define G8_DSR(dst, addr, OFF) asm volatile("ds_read_b128 %0, %1 offset:" #OFF : "=v"(dst) : "v"(addr))
#define G8_LDA(dst, b, h) { const unsigned a_ = ldsA + G8_SA(b, h); \
        G8_DSR(dst[0][0], a_, 0); G8_DSR(dst[0][1], a_, 1024); G8_DSR(dst[1][0], a_, 2048); G8_DSR(dst[1][1], a_, 3072); \
        G8_DSR(dst[2][0], a_, 4096); G8_DSR(dst[2][1], a_, 5120); G8_DSR(dst[3][0], a_, 6144); G8_DSR(dst[3][1], a_, 7168); }
#define G8_LDB(dst, b, h) { const unsigned a_ = ldsB + G8_SB(b, h); \
        G8_DSR(dst[0][0], a_, 0); G8_DSR(dst[0][1], a_, 1024); G8_DSR(dst[1][0], a_, 2048); G8_DSR(dst[1][1], a_, 3072); }
#define G8_TIE_A(AT) asm volatile("s_waitcnt lgkmcnt(0)" : "+v"(AT[0][0]), "+v"(AT[0][1]), "+v"(AT[1][0]), "+v"(AT[1][1]), "+v"(AT[2][0]), "+v"(AT[2][1]), "+v"(AT[3][0]), "+v"(AT[3][1]) :: "memory")
#define G8_TIE_B(BX) asm volatile("s_waitcnt lgkmcnt(0)" : "+v"(BX[0][0]), "+v"(BX[0][1]), "+v"(BX[1][0]), "+v"(BX[1][1]) :: "memory")
#define G8_MMA(ai, bj, AT, BX) { __builtin_amdgcn_s_setprio(1); \
        _Pragma("unroll") for (int m = 0; m < 4; ++m) _Pragma("unroll") for (int n = 0; n < 2; ++n) _Pragma("unroll") for (int k = 0; k < 2; ++k) \
            acc[ai][bj][m][n] = mfma16(BX[n][k], AT[m][k], acc[ai][bj][m][n]); \
        __builtin_amdgcn_s_setprio(0); }
#define G8_WV(n) asm volatile("s_waitcnt vmcnt(" #n ")" ::: "memory")
#define G8_WL(n) asm volatile("s_waitcnt lgkmcnt(" #n ")" ::: "memory")
#define G8_BAR __builtin_amdgcn_s_barrier()
#define G8_SCHED __builtin_amdgcn_sched_barrier(0)
    f32x4 acc[2][2][4][2];
#pragma unroll
    for (int a = 0; a < 2; ++a)
#pragma unroll
        for (int b = 0; b < 2; ++b)
#pragma unroll
            for (int m = 0; m < 4; ++m)
#pragma unroll
                for (int n = 0; n < 2; ++n) acc[a][b][m][n] = (f32x4){0.f, 0.f, 0.f, 0.f};
    bf16x8 At[4][2], B0[2][2], B1[2][2];
    __syncthreads();
    G8_STAGE(G8_SB(0, 0), Bt, n0, 0); G8_STAGE(G8_SA(0, 0), A, m0, 0);
    G8_STAGE(G8_SB(0, 1), Bt, n0 + HALF, 0); G8_STAGE(G8_SA(0, 1), A, m0 + HALF, 0);
    if (wr == 1) G8_BAR;
    G8_WV(4); G8_BAR;
    G8_STAGE(G8_SB(1, 0), Bt, n0, 1); G8_STAGE(G8_SA(1, 0), A, m0, 1); G8_STAGE(G8_SB(1, 1), Bt, n0 + HALF, 1);
    G8_WV(6); G8_BAR;
    for (int t = 0; t < nt - 2; t += 2) {
        G8_LDB(B0, 0, 0); G8_SCHED; G8_LDA(At, 0, 0); G8_STAGE(G8_SA(1, 1), A, m0 + HALF, t + 1);
        G8_WL(8); G8_BAR; G8_TIE_B(B0); G8_TIE_A(At); G8_MMA(0, 0, At, B0); G8_BAR; G8_SCHED;
        G8_LDB(B1, 0, 1); G8_STAGE(G8_SB(0, 0), Bt, n0, t + 2);
        G8_BAR; G8_TIE_B(B1); G8_MMA(0, 1, At, B1); G8_BAR;
        G8_LDA(At, 0, 1); G8_STAGE(G8_SA(0, 0), A, m0, t + 2);
        G8_BAR; G8_TIE_A(At); G8_MMA(1, 0, At, B0); G8_BAR; G8_SCHED;
        G8_STAGE(G8_SB(0, 1), Bt, n0 + HALF, t + 2);
        G8_WV(6); G8_BAR; G8_MMA(1, 1, At, B1); G8_BAR;
        G8_LDB(B0, 1, 0); G8_SCHED; G8_LDA(At, 1, 0); G8_STAGE(G8_SA(0, 1), A, m0 + HALF, t + 2);
        G8_WL(8); G8_BAR; G8_TIE_B(B0); G8_TIE_A(At); G8_MMA(0, 0, At, B0); G8_BAR; G8_SCHED;
        G8_LDB(B1, 1, 1); G8_STAGE(G8_SB(1, 0), Bt, n0, t + 3);
        G8_BAR; G8_TIE_B(B1); G8_MMA(0, 1, At, B1); G8_BAR;
        G8_LDA(At, 1, 1); G8_STAGE(G8_SA(1, 0), A, m0, t + 3);
        G8_BAR; G8_TIE_A(At); G8_MMA(1, 0, At, B0); G8_BAR; G8_SCHED;
        G8_STAGE(G8_SB(1, 1), Bt, n0 + HALF, t + 3);
        G8_WV(6); G8_BAR; G8_MMA(1, 1, At, B1); G8_BAR;
    }
    {
        G8_LDB(B0, 0, 0); G8_LDA(At, 0, 0); G8_STAGE(G8_SA(1, 1), A, m0 + HALF, nt - 1);
        G8_BAR; G8_TIE_B(B0); G8_TIE_A(At); G8_MMA(0, 0, At, B0); G8_BAR;
        G8_LDB(B1, 0, 1); G8_BAR; G8_TIE_B(B1); G8_MMA(0, 1, At, B1); G8_BAR;
        G8_LDA(At, 0, 1); G8_WV(4); G8_BAR; G8_TIE_A(At); G8_MMA(1, 0, At, B0); G8_MMA(1, 1, At, B1); G8_BAR;
    }
    {
        G8_LDB(B0, 1, 0); G8_LDA(At, 1, 0); G8_WV(2); G8_BAR; G8_TIE_B(B0); G8_TIE_A(At); G8_MMA(0, 0, At, B0); G8_BAR;
        G8_LDB(B1, 1, 1); G8_WV(0); G8_BAR; G8_TIE_B(B1); G8_MMA(0, 1, At, B1); G8_BAR;
        G8_LDA(At, 1, 1); G8_BAR; G8_TIE_A(At); G8_MMA(1, 0, At, B0); G8_MMA(1, 1, At, B1); G8_BAR;
    }
    if (wr == 0) G8_BAR;
#undef G8_SA
#undef G8_SB
#undef G8_STAGE
#undef G8_LDA
#undef G8_LDB
#undef G8_DSR
#undef G8_TIE_A
#undef G8_TIE_B
#undef G8_MMA
#undef G8_WV
#undef G8_WL
#undef G8_BAR
#undef G8_SCHED

    const int tid_e = opaque_tid(), wave_e = tid_e >> 6;
    const int wr_e = wave_e >> 2, wc_e = wave_e & 3, fr_e = tid_e & 15, fq_e = (tid_e >> 4) & 3;
    const int tok_w = m0 + wr_e * 64 + fr_e;
    const int col_w = n0 + wc_e * 32 + 4 * fq_e;
    if (MODE == 1) {
#pragma unroll
        for (int ai = 0; ai < 2; ++ai)
#pragma unroll
            for (int m = 0; m < 4; ++m) {
                bf16_t* rowp = e.C + (size_t)(tok_w + ai * 128 + m * 16) * 1024 + col_w;
#pragma unroll
                for (int bj = 0; bj < 2; ++bj)
#pragma unroll
                    for (int n = 0; n < 2; ++n) {
                        const f32x4 v = acc[ai][bj][m][n];
                        u32x2 o; o.x = pk_bf16(v[0], v[1]); o.y = pk_bf16(v[2], v[3]);
                        *(u32x2*)(rowp + bj * 128 + n * 16) = o;
                    }
            }
    } else if (MODE == 2) {
        if (n0 == 0) {
#pragma unroll
            for (int ai = 0; ai < 2; ++ai)
#pragma unroll
                for (int m = 0; m < 4; ++m) {
                    bf16_t* rowp = e.C + (size_t)(tok_w + ai * 128 + m * 16) * 256 + col_w;
#pragma unroll
                    for (int bj = 0; bj < 2; ++bj)
#pragma unroll
                        for (int n = 0; n < 2; ++n) {
                            const f32x4 v = acc[ai][bj][m][n];
                            u32x2 o; o.x = pk_bf16(v[0], v[1]); o.y = pk_bf16(v[2], v[3]);
                            *(u32x2*)(rowp + bj * 128 + n * 16) = o;
                        }
                }
        } else {
#pragma unroll
            for (int ai = 0; ai < 2; ++ai)
#pragma unroll
                for (int m = 0; m < 4; ++m) {
                    const int mt = tok_w + ai * 128 + m * 16, b = mt >> 8, mm = mt & 255;
#pragma unroll
                    for (int bj = 0; bj < 2; ++bj)
#pragma unroll
                        for (int n = 0; n < 2; ++n) {
                            const int f = (col_w - 256) + bj * 128 + n * 16, hx = f >> 6, d = f & 63;
                            bf16_t* bp = e.VT + ((size_t)(b * 4 + hx) * 64 + d) * 256 + mm;
#pragma unroll
                            for (int j = 0; j < 4; ++j) bp[(size_t)j * 256] = (bf16_t)(pk_bf16(acc[ai][bj][m][n][j], 0.f) & 0xffffu);
                        }
                }
        }
    } else {
        const bool has_qk = (n0 >= 512 && n0 < 1152);
        float* ssx = (float*)smem;
        if (has_qk) {
#pragma unroll
            for (int ai = 0; ai < 2; ++ai)
#pragma unroll
                for (int bj = 0; bj < 2; ++bj)
#pragma unroll
                    for (int m = 0; m < 4; ++m) {
                        float ss = 0.f;
#pragma unroll
                        for (int n = 0; n < 2; ++n)
#pragma unroll
                            for (int j = 0; j < 4; ++j) ss += acc[ai][bj][m][n][j] * acc[ai][bj][m][n][j];
                        ss = x16_add(ss); ss = x32_add(ss);
                        if (fq_e == 0) ssx[((wave_e * 2 + ai) * 2 + bj) * 64 + m * 16 + fr_e] = ss;
                    }
            __syncthreads();
        }
#pragma unroll
        for (int bj = 0; bj < 2; ++bj) {
            const int cb = n0 + bj * 128 + wc_e * 32;
            const int c64 = cb & ~63;
            if (c64 >= 512 && c64 < 1152) {
                const bool isq = c64 < 1024;
                const float* gn = (isq ? e.qn : e.kn) + (wc_e & 1) * 32 + 4 * fq_e;
                const float osc = isq ? 0.125f * L2E : 1.0f;
                const f32x4 g0 = *(const f32x4*)(gn), g1 = *(const f32x4*)(gn + 16);
#pragma unroll
                for (int ai = 0; ai < 2; ++ai)
#pragma unroll
                    for (int m = 0; m < 4; ++m) {
                        const int tok = tok_w + ai * 128 + m * 16;
                        const float ss = ssx[((wave_e * 2 + ai) * 2 + bj) * 64 + m * 16 + fr_e] + ssx[(((wave_e ^ 1) * 2 + ai) * 2 + bj) * 64 + m * 16 + fr_e];
                        const float rinv = rsqrtf(ss * (1.0f / 64.0f) + EPS);
                        const int t = (tok < NPROMPT) ? (tok & 2047) : (tok & 4095);
                        const int ridx = (wc_e & 1) ? (t & 63) : (t >> 6);
                        const f32x4* rt = (const f32x4*)(e.rope + (ridx * 16 + 4 * fq_e) * 2);
                        const f32x4 r01 = rt[0], r23 = rt[1];
                        const float rc[4] = {r01[0], r01[2], r23[0], r23[2]}, rs[4] = {r01[1], r01[3], r23[1], r23[3]};
                        float oa[4], ob[4];
#pragma unroll
                        for (int j = 0; j < 4; ++j) {
                            const float a = acc[ai][bj][m][0][j] * rinv * g0[j], b = acc[ai][bj][m][1][j] * rinv * g1[j];
                            oa[j] = (a * rc[j] - b * rs[j]) * osc; ob[j] = (b * rc[j] + a * rs[j]) * osc;
                        }
                        bf16_t* rowp = e.C + (size_t)tok * INW + cb + 4 * fq_e;
                        u32x2 w0, w1; w0.x = pk_bf16(oa[0], oa[1]); w0.y = pk_bf16(oa[2], oa[3]); w1.x = pk_bf16(ob[0], ob[1]); w1.y = pk_bf16(ob[2], ob[3]);
                        *(u32x2*)(rowp) = w0; *(u32x2*)(rowp + 16) = w1;
                    }
            } else if (c64 >= 1152 && c64 < 1280) {
#pragma unroll
                for (int ai = 0; ai < 2; ++ai)
#pragma unroll
                    for (int m = 0; m < 4; ++m) {
                        const int tok = tok_w + ai * 128 + m * 16;
#pragma unroll
                        for (int n = 0; n < 2; ++n) {
                            const int f = cb + n * 16 + 4 * fq_e - 1152, kvh = f >> 6, d = f & 63;
                            bf16_t* bp; size_t T;
                            if (tok < NPROMPT) { const int b = tok >> 11, t = tok & 2047; T = 2048; bp = e.VT + ((size_t)(b * 2 + kvh) * 64 + d) * 2048 + t; }
                            else { const int b = (tok - NPROMPT) >> 12, t = tok & 4095; T = 4096; bp = e.VT + (size_t)NPROMPT * 128 + ((size_t)(b * 2 + kvh) * 64 + d) * 4096 + t; }
#pragma unroll
                            for (int j = 0; j < 4; ++j) bp[(size_t)j * T] = (bf16_t)(pk_bf16(acc[ai][bj][m][n][j], 0.f) & 0xffffu);
                        }
                    }
            } else {
                const int kind = (c64 < 256) ? 0 : ((c64 >= 1792 && c64 < 2048) ? 2 : 1);
#pragma unroll
                for (int ai = 0; ai < 2; ++ai)
#pragma unroll
                    for (int m = 0; m < 4; ++m) {
                        bf16_t* rowp = e.C + (size_t)(tok_w + ai * 128 + m * 16) * INW + cb + 4 * fq_e;
#pragma unroll
                        for (int n = 0; n < 2; ++n) {
                            float v[4];
#pragma unroll
                            for (int j = 0; j < 4; ++j) { const float x = acc[ai][bj][m][n][j]; v[j] = (kind == 0) ? x : ((kind == 2) ? x * (0.125f * L2E) : silu_f(x)); }
                            u32x2 o; o.x = pk_bf16(v[0], v[1]); o.y = pk_bf16(v[2], v[3]);
                            *(u32x2*)(rowp + n * 16) = o;
                        }
                    }
            }
        }
    }
}

#define SB_() __builtin_amdgcn_sched_barrier(0)
#define KFRAG(KS, KB) (*(const bf16x8*)(kp + (KB) * 4096 + k_off + ((((KS) * 2 + h) ^ kswz) << 4)))
#define VFRAG(KK, DB) (*(const bf16x8*)(vp + (DB) * 4096 + v_off + ((((KK) * 2 + h) ^ vswz) << 4)))
#define EXP4(S, I0) { _Pragma("unroll") for (int i_ = (I0); i_ < (I0) + 4; ++i_) { S[i_] = __builtin_amdgcn_exp2f(S[i_] - mb); rs += S[i_]; } }
#define EXP4F(S, I0) { f32x2_t a_ = {S[(I0)], S[(I0) + 1]}, b_ = {S[(I0) + 2], S[(I0) + 3]}; \
        a_ = a_ - (f32x2_t){mb, mb}; b_ = b_ - (f32x2_t){mb, mb}; \
        S[(I0)] = __builtin_amdgcn_exp2f(a_.x); S[(I0) + 1] = __builtin_amdgcn_exp2f(a_.y); S[(I0) + 2] = __builtin_amdgcn_exp2f(b_.x); S[(I0) + 3] = __builtin_amdgcn_exp2f(b_.y); \
        rs2 += (f32x2_t){S[(I0)], S[(I0) + 1]} + (f32x2_t){S[(I0) + 2], S[(I0) + 3]}; }
#define EXPQ(S, I0) { if (FIXM) EXP4F(S, I0) else EXP4(S, I0) }
#define PACK8(S, I0) ({ u32x4 t_; t_.x = pk_bf16(S[(I0)], S[(I0) + 1]); t_.y = pk_bf16(S[(I0) + 2], S[(I0) + 3]); t_.z = pk_bf16(S[(I0) + 4], S[(I0) + 5]); t_.w = pk_bf16(S[(I0) + 6], S[(I0) + 7]); __builtin_bit_cast(bf16x8, t_); })
DI float max8(const f32x16& s, int i0, float mx) {
    mx = fmaxf(fmaxf(mx, s[i0]), s[i0 + 1]); mx = fmaxf(fmaxf(mx, s[i0 + 2]), s[i0 + 3]);
    mx = fmaxf(fmaxf(mx, s[i0 + 4]), s[i0 + 5]); mx = fmaxf(fmaxf(mx, s[i0 + 6]), s[i0 + 7]);
    return mx;
}
#define EXP2F(S, I0) { S[(I0)] = __builtin_amdgcn_exp2f(S[(I0)]); S[(I0) + 1] = __builtin_amdgcn_exp2f(S[(I0) + 1]); rs += S[(I0)] + S[(I0) + 1]; \
        asm volatile("" : "+v"(S[(I0)]), "+v"(S[(I0) + 1]), "+v"(rs)); }
#define PIN1(X) asm volatile("" : "+v"(X))
template <bool DO_PV, bool DO_QK>
DI void attn_step_fix(f32x16& s0, f32x16& s1, f32x16& n0, f32x16& n1, const bf16x8 (&pp)[4], bf16x8 (&pc)[4],
                      f32x16& o0, f32x16& o1, const float m, float& lsum, const bf16x8 (&qf)[4],
                      const unsigned char* kp, const unsigned char* vp, int k_off, int kswz, int v_off, int vswz, int h) {
    bf16x8 va0, vb0, va1, vb1, va2, vb2, va3, vb3, ka0, kb0, ka1, kb1, ka2, kb2, ka3, kb3;
    float rs = 0.f;
    if (DO_PV) { va0 = VFRAG(0, 0); vb0 = VFRAG(0, 1); va1 = VFRAG(1, 0); vb1 = VFRAG(1, 1); }
    EXP2F(s0, 0);  if (DO_PV) { o0 = mfma32(va0, pp[0], o0); va2 = VFRAG(2, 0); vb2 = VFRAG(2, 1); } SB_();
    EXP2F(s0, 2);  if (DO_PV) { o1 = mfma32(vb0, pp[0], o1); va3 = VFRAG(3, 0); vb3 = VFRAG(3, 1); } SB_();
    EXP2F(s0, 4);  if (DO_PV) { o0 = mfma32(va1, pp[1], o0); } if (DO_QK) { ka0 = KFRAG(0, 0); kb0 = KFRAG(0, 1); } SB_();
    EXP2F(s0, 6);  if (DO_PV) { o1 = mfma32(vb1, pp[1], o1); } if (DO_QK) { ka1 = KFRAG(1, 0); kb1 = KFRAG(1, 1); } SB_();
    EXP2F(s0, 8);  if (DO_PV) { o0 = mfma32(va2, pp[2], o0); } SB_();
    EXP2F(s0, 10); if (DO_PV) { o1 = mfma32(vb2, pp[2], o1); } pc[0] = PACK8(s0, 0); PIN1(pc[0]); SB_();
    EXP2F(s0, 12); if (DO_PV) { o0 = mfma32(va3, pp[3], o0); } SB_();
    EXP2F(s0, 14); if (DO_PV) { o1 = mfma32(vb3, pp[3], o1); } SB_();
    EXP2F(s1, 0);  if (DO_QK) { n0 = mfma32(ka0, qf[0], (f32x16){0.f, 0.f, 0.f, 0.f, 0.f, 0.f, 0.f, 0.f, 0.f, 0.f, 0.f, 0.f, 0.f, 0.f, 0.f, 0.f}); ka2 = KFRAG(2, 0); kb2 = KFRAG(2, 1); } pc[1] = PACK8(s0, 8); PIN1(pc[1]); SB_();
    EXP2F(s1, 2);  if (DO_QK) { n1 = mfma32(kb0, qf[0], (f32x16){0.f, 0.f, 0.f, 0.f, 0.f, 0.f, 0.f, 0.f, 0.f, 0.f, 0.f, 0.f, 0.f, 0.f, 0.f, 0.f}); ka3 = KFRAG(3, 0); kb3 = KFRAG(3, 1); } SB_();
    EXP2F(s1, 4);  if (DO_QK) { n0 = mfma32(ka1, qf[1], n0); } SB_();
    EXP2F(s1, 6);  if (DO_QK) { n1 = mfma32(kb1, qf[1], n1); } SB_();
    EXP2F(s1, 8);  if (DO_QK) { n0 = mfma32(ka2, qf[2], n0); } pc[2] = PACK8(s1, 0); PIN1(pc[2]); SB_();
    EXP2F(s1, 10); if (DO_QK) { n1 = mfma32(kb2, qf[2], n1); } SB_();
    EXP2F(s1, 12); if (DO_QK) { n0 = mfma32(ka3, qf[3], n0); } SB_();
    EXP2F(s1, 14); if (DO_QK) { n1 = mfma32(kb3, qf[3], n1); } pc[3] = PACK8(s1, 8); PIN1(pc[3]);
    lsum += rs;
    SB_();
}
template <bool DO_PV, bool DO_QK, bool FIXM>
DI void attn_step(f32x16& s0, f32x16& s1, f32x16& n0, f32x16& n1, const bf16x8 (&pp)[4], bf16x8 (&pc)[4],
                  f32x16& o0, f32x16& o1, float& m, float& lsum, const bf16x8 (&qf)[4],
                  const unsigned char* kp, const unsigned char* vp, int k_off, int kswz, int v_off, int vswz, int h) {
    if (FIXM) { attn_step_fix<DO_PV, DO_QK>(s0, s1, n0, n1, pp, pc, o0, o1, m, lsum, qf, kp, vp, k_off, kswz, v_off, vswz, h); return; }
    bf16x8 va0, vb0, va1, vb1, va2, vb2, va3, vb3, ka0, kb0, ka1, kb1, ka2, kb2, ka3, kb3;
    if (DO_PV) { va0 = VFRAG(0, 0); vb0 = VFRAG(0, 1); va1 = VFRAG(1, 0); vb1 = VFRAG(1, 1); }
    float mx = s0[0];
    if (DO_PV) o0 = mfma32(va0, pp[0], o0);
    if (!FIXM) mx = max8(s0, 0, mx);
    SB_();
    if (DO_PV) { o1 = mfma32(vb0, pp[0], o1); va2 = VFRAG(2, 0); vb2 = VFRAG(2, 1); }
    if (!FIXM) mx = max8(s0, 8, mx);
    SB_();
    if (DO_PV) { o0 = mfma32(va1, pp[1], o0); va3 = VFRAG(3, 0); vb3 = VFRAG(3, 1); }
    if (!FIXM) mx = max8(s1, 0, mx);
    SB_();
    if (DO_PV) o1 = mfma32(vb1, pp[1], o1);
    bool need = false; float alpha = 1.0f;
    if (!FIXM) {
        mx = max8(s1, 8, mx);
        mx = xhalf_max(mx);
        need = mx > m + 8.0f;
        const float mnew = need ? mx : m;
        alpha = __builtin_amdgcn_exp2f(m - mnew);
        m = mnew;
    }
    const float mb = m;
    float rs = 0.f; f32x2_t rs2 = {0.f, 0.f};
    SB_();
    if (DO_PV) o0 = mfma32(va2, pp[2], o0);
    if (DO_QK) { ka0 = KFRAG(0, 0); kb0 = KFRAG(0, 1); }
    EXPQ(s0, 0);
    SB_();
    if (DO_PV) o1 = mfma32(vb2, pp[2], o1);
    if (DO_QK) { ka1 = KFRAG(1, 0); kb1 = KFRAG(1, 1); }
    EXPQ(s0, 4);
    SB_();
    if (DO_PV) o0 = mfma32(va3, pp[3], o0);
    EXPQ(s0, 8);
    SB_();
    if (DO_PV) o1 = mfma32(vb3, pp[3], o1);
    EXPQ(s0, 12);
    SB_();
    if (DO_QK) { n0 = mfma32(ka0, qf[0], (f32x16){0.f, 0.f, 0.f, 0.f, 0.f, 0.f, 0.f, 0.f, 0.f, 0.f, 0.f, 0.f, 0.f, 0.f, 0.f, 0.f}); ka2 = KFRAG(2, 0); kb2 = KFRAG(2, 1); }
    EXPQ(s1, 0);
    SB_();
    if (DO_QK) { n1 = mfma32(kb0, qf[0], (f32x16){0.f, 0.f, 0.f, 0.f, 0.f, 0.f, 0.f, 0.f, 0.f, 0.f, 0.f, 0.f, 0.f, 0.f, 0.f, 0.f}); ka3 = KFRAG(3, 0); kb3 = KFRAG(3, 1); }
    EXPQ(s1, 4);
    SB_();
    if (DO_QK) n0 = mfma32(ka1, qf[1], n0);
    EXPQ(s1, 8);
    SB_();
    if (DO_QK) n1 = mfma32(kb1, qf[1], n1);
    EXPQ(s1, 12);
    SB_();
    if (DO_QK) n0 = mfma32(ka2, qf[2], n0);
    pc[0] = PACK8(s0, 0);
    SB_();
    if (DO_QK) n1 = mfma32(kb2, qf[2], n1);
    pc[1] = PACK8(s0, 8);
    SB_();
    if (DO_QK) n0 = mfma32(ka3, qf[3], n0);
    pc[2] = PACK8(s1, 0);
    SB_();
    if (DO_QK) n1 = mfma32(kb3, qf[3], n1);
    pc[3] = PACK8(s1, 8);
    if (FIXM) lsum += rs2.x + rs2.y; else lsum = lsum * alpha + rs;
    SB_();
    if (!FIXM) {
        if (__builtin_amdgcn_ballot_w64(need)) {
#pragma unroll
            for (int i = 0; i < 16; ++i) { o0[i] *= alpha; o1[i] *= alpha; }
        }
    }
}

template <bool FIXM>
DI void attn_item(const bf16_t* __restrict__ Q, int ldq, const bf16_t* __restrict__ K, int ldk, const bf16_t* __restrict__ VT, int ldv,
                  int nkeys, bf16_t* __restrict__ O, const bf16_t* __restrict__ G, unsigned char* smem, float mfix) {
    const int tid = opaque_tid(), lane = tid & 63, wave = tid >> 6;
    const int r = lane & 31, h = lane >> 5;
    bf16x8 qf[4];
    {
        const bf16_t* qp = Q + (size_t)(wave * 32 + r) * ldq + h * 8;
#pragma unroll
        for (int ks = 0; ks < 4; ++ks) qf[ks] = *(const bf16x8*)(qp + ks * 16);
    }
    const int lrow = tid >> 3, lc = tid & 7;
    const bf16_t* Kg = K + (size_t)lrow * ldk + lc * 8;
    const bf16_t* Vg = VT + (size_t)lrow * ldv + lc * 8;
    const int st_off = lrow * 128 + ((lc ^ ((lrow >> 1) & 7)) << 4);
    const int pr = (r & ~12) | ((r & 4) << 1) | ((r & 8) >> 1);
    const int kswz = (pr >> 1) & 7, vswz = (r >> 1) & 7;
    const int k_off = pr * 128, v_off = r * 128;
    const int nt = nkeys >> 6;

    f32x16 o0, o1, sa0, sa1, sb0, sb1;
#pragma unroll
    for (int i = 0; i < 16; ++i) { o0[i] = 0.f; o1[i] = 0.f; }
    float m = FIXM ? mfix : -1e30f, lsum = 0.f;
    bf16x8 pa[4], pb[4];

    u32x4 rk, rv;
#define A_LOAD(U) { const int kt_ = ((U) + 2 < nt) ? (U) + 2 : nt - 1; rk = *(const u32x4*)(Kg + (size_t)(kt_ * 64) * ldk); rv = *(const u32x4*)(Vg + (U) * 64); }
#define A_STORE(OFF) { *(u32x4*)(smem + (OFF) + st_off) = rk; *(u32x4*)(smem + (OFF) + 8192 + st_off) = rv; }
    rk = *(const u32x4*)(Kg); rv = *(const u32x4*)(Kg + (size_t)64 * ldk);
    __syncthreads();
    A_STORE(16384);
    A_LOAD(0);
    A_STORE(0);
    A_LOAD(1);
    lds_barrier();
    {
        const unsigned char* kp = smem + 16384;
        sa0 = mfma32(KFRAG(0, 0), qf[0], (f32x16){0.f, 0.f, 0.f, 0.f, 0.f, 0.f, 0.f, 0.f, 0.f, 0.f, 0.f, 0.f, 0.f, 0.f, 0.f, 0.f});
        sa1 = mfma32(KFRAG(0, 1), qf[0], (f32x16){0.f, 0.f, 0.f, 0.f, 0.f, 0.f, 0.f, 0.f, 0.f, 0.f, 0.f, 0.f, 0.f, 0.f, 0.f, 0.f});
#pragma unroll
        for (int ks = 1; ks < 4; ++ks) { sa0 = mfma32(KFRAG(ks, 0), qf[ks], sa0); sa1 = mfma32(KFRAG(ks, 1), qf[ks], sa1); }
    }
    attn_step<false, true, FIXM>(sa0, sa1, sb0, sb1, pb, pa, o0, o1, m, lsum, qf, smem + 16384 + 8192, smem, k_off, kswz, v_off, vswz, h);
    lds_barrier();
    for (int t = 1; t < nt - 1; t += 2) {
        A_STORE(16384);
        A_LOAD(t + 1);
        SB_();
        attn_step<true, true, FIXM>(sb0, sb1, sa0, sa1, pa, pb, o0, o1, m, lsum, qf, smem, smem + 8192, k_off, kswz, v_off, vswz, h);
        lds_barrier();
        A_STORE(0);
        A_LOAD(t + 2);
        SB_();
        attn_step<true, true, FIXM>(sa0, sa1, sb0, sb1, pb, pa, o0, o1, m, lsum, qf, smem + 16384, smem + 16384 + 8192, k_off, kswz, v_off, vswz, h);
        lds_barrier();
    }
    A_STORE(16384);
    const bf16_t* gp = G + (size_t)(wave * 32 + r) * INW + 4 * h;
    u32x2 gga[4], ggb[4];
#pragma unroll
    for (int gq = 0; gq < 4; ++gq) { gga[gq] = *(const u32x2*)(gp + 8 * gq); ggb[gq] = *(const u32x2*)(gp + 32 + 8 * gq); }
    SB_();
    attn_step<true, false, FIXM>(sb0, sb1, sa0, sa1, pa, pb, o0, o1, m, lsum, qf, smem, smem + 8192, k_off, kswz, v_off, vswz, h);
    lds_barrier();
    {
        const unsigned char* vp = smem + 16384 + 8192;
#pragma unroll
        for (int kk = 0; kk < 4; ++kk) { o0 = mfma32(VFRAG(kk, 0), pb[kk], o0); o1 = mfma32(VFRAG(kk, 1), pb[kk], o1); }
    }
#undef A_LOAD
#undef A_STORE
    const float lt = x32_add(lsum);
    const float inv = 1.0f / lt;
    bf16_t* op = O + (size_t)(wave * 32 + r) * 1024 + 4 * h;
#pragma unroll
    for (int gq = 0; gq < 4; ++gq) {
        {
            const u32x2 gg = gga[gq];
            u32x2 w;
            w.x = pk_bf16(o0[4 * gq] * inv * bflo(gg.x), o0[4 * gq + 1] * inv * bfhi(gg.x));
            w.y = pk_bf16(o0[4 * gq + 2] * inv * bflo(gg.y), o0[4 * gq + 3] * inv * bfhi(gg.y));
            *(u32x2*)(op + 8 * gq) = w;
        }
        {
            const u32x2 gg = ggb[gq];
            u32x2 w;
            w.x = pk_bf16(o1[4 * gq] * inv * bflo(gg.x), o1[4 * gq + 1] * inv * bfhi(gg.x));
            w.y = pk_bf16(o1[4 * gq + 2] * inv * bflo(gg.y), o1[4 * gq + 3] * inv * bfhi(gg.y));
            *(u32x2*)(op + 32 + 8 * gq) = w;
        }
    }
}

DI void cross_item(const bf16_t* __restrict__ Q, const bf16_t* __restrict__ K, const bf16_t* __restrict__ VT,
                   bf16_t* __restrict__ O, const bf16_t* __restrict__ G, unsigned char* smem) {
    const int tid = opaque_tid(), lane = tid & 63, wave = tid >> 6;
    const int r = lane & 31, h = lane >> 5;
    bf16x8 qf[4];
    {
        const bf16_t* qp = Q + (size_t)(wave * 32 + r) * INW + h * 8;
#pragma unroll
        for (int ks = 0; ks < 4; ++ks) qf[ks] = *(const bf16x8*)(qp + ks * 16);
    }
    const int lrow = tid >> 3, lc = tid & 7;
    const int st_off = lrow * 128 + ((lc ^ ((lrow >> 1) & 7)) << 4);
    {
        u32x4 kk[4], vv[4];
#pragma unroll
        for (int i = 0; i < 4; ++i) { kk[i] = *(const u32x4*)(K + (size_t)(lrow + 64 * i) * 256 + lc * 8); vv[i] = *(const u32x4*)(VT + (size_t)lrow * 256 + (i * 8 + lc) * 8); }
        __syncthreads();
#pragma unroll
        for (int i = 0; i < 4; ++i) { *(u32x4*)(smem + i * 16384 + st_off) = kk[i]; *(u32x4*)(smem + i * 16384 + 8192 + st_off) = vv[i]; }
    }
    const bf16_t* gp = G + (size_t)(wave * 32 + r) * INW + 4 * h;
    u32x2 gga[4], ggb[4];
#pragma unroll
    for (int gq = 0; gq < 4; ++gq) { gga[gq] = *(const u32x2*)(gp + 8 * gq); ggb[gq] = *(const u32x2*)(gp + 32 + 8 * gq); }
    __syncthreads();
    const int pr = (r & ~12) | ((r & 4) << 1) | ((r & 8) >> 1);
    const int kswz = (pr >> 1) & 7, vswz = (r >> 1) & 7;
    const int k_off = pr * 128, v_off = r * 128;
    f32x16 o0, o1;
#pragma unroll
    for (int i = 0; i < 16; ++i) { o0[i] = 0.f; o1[i] = 0.f; }
    float m = -1e30f, lsum = 0.f;
#pragma unroll 1
    for (int kt = 0; kt < 4; ++kt) {
        const unsigned char* kp = smem + kt * 16384;
        const unsigned char* vp = kp + 8192;
        f32x16 s0, s1;
        s0 = mfma32(KFRAG(0, 0), qf[0], (f32x16){0.f, 0.f, 0.f, 0.f, 0.f, 0.f, 0.f, 0.f, 0.f, 0.f, 0.f, 0.f, 0.f, 0.f, 0.f, 0.f});
        s1 = mfma32(KFRAG(0, 1), qf[0], (f32x16){0.f, 0.f, 0.f, 0.f, 0.f, 0.f, 0.f, 0.f, 0.f, 0.f, 0.f, 0.f, 0.f, 0.f, 0.f, 0.f});
#pragma unroll
        for (int ks = 1; ks < 4; ++ks) { s0 = mfma32(KFRAG(ks, 0), qf[ks], s0); s1 = mfma32(KFRAG(ks, 1), qf[ks], s1); }
        float mx = s0[0];
        mx = max8(s0, 0, mx); mx = max8(s0, 8, mx); mx = max8(s1, 0, mx); mx = max8(s1, 8, mx);
        mx = xhalf_max(mx);
        const float mnew = fmaxf(m, mx);
        const float alpha = __builtin_amdgcn_exp2f(m - mnew);
        m = mnew;
        const float mb = mnew;
        float rs = 0.f;
#pragma unroll
        for (int i = 0; i < 16; ++i) { s0[i] = __builtin_amdgcn_exp2f(s0[i] - mb); s1[i] = __builtin_amdgcn_exp2f(s1[i] - mb); rs += s0[i] + s1[i]; }
        lsum = lsum * alpha + rs;
#pragma unroll
        for (int i = 0; i < 16; ++i) { o0[i] *= alpha; o1[i] *= alpha; }
        bf16x8 pf[4];
        pf[0] = PACK8(s0, 0); pf[1] = PACK8(s0, 8); pf[2] = PACK8(s1, 0); pf[3] = PACK8(s1, 8);
#pragma unroll
        for (int kk2 = 0; kk2 < 4; ++kk2) { o0 = mfma32(VFRAG(kk2, 0), pf[kk2], o0); o1 = mfma32(VFRAG(kk2, 1), pf[kk2], o1); }
    }
    const float lt = x32_add(lsum);
    const float inv = 1.0f / lt;
    bf16_t* op = O + (size_t)(wave * 32 + r) * 1024 + 4 * h;
#pragma unroll
    for (int gq = 0; gq < 4; ++gq) {
        {
            const u32x2 gg = gga[gq];
            u32x2 w;
            w.x = pk_bf16(o0[4 * gq] * inv * bflo(gg.x), o0[4 * gq + 1] * inv * bfhi(gg.x));
            w.y = pk_bf16(o0[4 * gq + 2] * inv * bflo(gg.y), o0[4 * gq + 3] * inv * bfhi(gg.y));
            *(u32x2*)(op + 8 * gq) = w;
        }
        {
            const u32x2 gg = ggb[gq];
            u32x2 w;
            w.x = pk_bf16(o1[4 * gq] * inv * bflo(gg.x), o1[4 * gq + 1] * inv * bfhi(gg.x));
            w.y = pk_bf16(o1[4 * gq + 2] * inv * bflo(gg.y), o1[4 * gq + 3] * inv * bfhi(gg.y));
            *(u32x2*)(op + 32 + 8 * gq) = w;
        }
    }
}

DI void pool_item(const bf16_t* __restrict__ Z, const bf16_t* __restrict__ PWT, const float* __restrict__ pscale, bf16_t* __restrict__ MIX,
                  int tokg0, unsigned char* smem) {
    const int tid = opaque_tid(), lane = tid & 63, wave = tid >> 6;
    const int T = (tokg0 < NPROMPT) ? 2048 : 4096;
    const int t0 = tokg0 & (T - 1);
    constexpr int RS = 528;
    const int g = wave & 3, half = 1 << g;
    const int r16 = lane & 15, q4 = lane >> 4;
    const bf16_t* pw = PWT + (size_t)g * 4096 + r16 * 64 + q4 * 8;
    bf16x8 wfr[4][2]; f32x4 psr[4]; u32x2 ggr[2][4];
#pragma unroll
    for (int fi = 0; fi < 4; ++fi) {
        psr[fi] = *(const f32x4*)(pscale + g * 64 + fi * 16 + 4 * q4);
#pragma unroll
        for (int ks = 0; ks < 2; ++ks) wfr[fi][ks] = *(const bf16x8*)(pw + fi * 16 * 64 + ks * 32);
#pragma unroll
        for (int t2 = 0; t2 < 2; ++t2) ggr[t2][fi] = *(const u32x2*)(Z + ((size_t)tokg0 + ((wave >> 2) * 2 + t2) * 16 + r16) * INW + 256 + g * 64 + fi * 16 + 4 * q4);
    }
    __syncthreads();
    for (int id = tid; id < 80 * 32; id += 512) {
        const int rr = id >> 5, c = id & 31;
        const int t = t0 - 8 + rr;
        u32x4 v = (u32x4){0u, 0u, 0u, 0u};
        if (t >= 0 && t < T) v = *(const u32x4*)(Z + (size_t)(tokg0 - 8 + rr) * INW + c * 8);
        *(u32x4*)(smem + rr * RS + c * 16) = v;
    }
    __syncthreads();
    {
        const int th = wave >> 2;
        bf16x8 df[2][2];
#pragma unroll
        for (int t2 = 0; t2 < 2; ++t2)
#pragma unroll
            for (int ks = 0; ks < 2; ++ks) {
                const int tl = (th * 2 + t2) * 16 + r16, t = t0 + tl;
                const int lo = max(t - half, 0), hi = min(t + half, T);
                const float icnt = 1.0f / (float)(hi - lo);
                float s[8];
#pragma unroll
                for (int j = 0; j < 8; ++j) s[j] = 0.f;
                const unsigned char* bp = smem + (tl + 8 - half) * RS + (g * 64 + ks * 32 + q4 * 8) * 2;
                for (int j = 0; j < 2 * half; ++j) {
                    const u32x4 v = *(const u32x4*)(bp + j * RS);
                    s[0] += bflo(v.x); s[1] += bfhi(v.x); s[2] += bflo(v.y); s[3] += bfhi(v.y);
                    s[4] += bflo(v.z); s[5] += bfhi(v.z); s[6] += bflo(v.w); s[7] += bfhi(v.w);
                }
                const u32x4 c = *(const u32x4*)(bp + half * RS);
                u32x4 o;
                o.x = pk_bf16(s[0] * icnt - bflo(c.x), s[1] * icnt - bfhi(c.x));
                o.y = pk_bf16(s[2] * icnt - bflo(c.y), s[3] * icnt - bfhi(c.y));
                o.z = pk_bf16(s[4] * icnt - bflo(c.z), s[5] * icnt - bfhi(c.z));
                o.w = pk_bf16(s[6] * icnt - bflo(c.w), s[7] * icnt - bfhi(c.w));
                df[t2][ks] = __builtin_bit_cast(bf16x8, o);
            }
        f32x4 acc[4][2];
#pragma unroll
        for (int i = 0; i < 4; ++i)
#pragma unroll
            for (int j = 0; j < 2; ++j) acc[i][j] = (f32x4){0.f, 0.f, 0.f, 0.f};
#pragma unroll
        for (int fi = 0; fi < 4; ++fi)
#pragma unroll
            for (int ks = 0; ks < 2; ++ks) {
                const bf16x8 wf = wfr[fi][ks];
#pragma unroll
                for (int t2 = 0; t2 < 2; ++t2) acc[fi][t2] = mfma16(wf, df[t2][ks], acc[fi][t2]);
            }
#pragma unroll
        for (int t2 = 0; t2 < 2; ++t2) {
            const size_t tok = (size_t)tokg0 + (th * 2 + t2) * 16 + r16;
#pragma unroll
            for (int fi = 0; fi < 4; ++fi) {
                const int n = g * 64 + fi * 16 + 4 * q4;
                const f32x4 ps = psr[fi];
                const u32x2 gg = ggr[t2][fi];
                u32x2 w;
                w.x = pk_bf16(acc[fi][t2][0] * ps[0] * bflo(gg.x), acc[fi][t2][1] * ps[1] * bfhi(gg.x));
                w.y = pk_bf16(acc[fi][t2][2] * ps[2] * bflo(gg.y), acc[fi][t2][3] * ps[3] * bfhi(gg.y));
                *(u32x2*)(MIX + tok * 1024 + n) = w;
            }
        }
    }
}

struct PostIn { u32x4 yv[2]; f32x4 xv[4]; };
DI PostIn post_row_load(const float* __restrict__ xsrc, const bf16_t* __restrict__ yh, int lane) {
    PostIn r;
#pragma unroll
    for (int j = 0; j < 2; ++j) r.yv[j] = *(const u32x4*)(yh + j * 512 + lane * 8);
#pragma unroll
    for (int j = 0; j < 2; ++j) { r.xv[2 * j] = *(const f32x4*)(xsrc + j * 512 + lane * 8); r.xv[2 * j + 1] = *(const f32x4*)(xsrc + j * 512 + lane * 8 + 4); }
    return r;
}
DI void post_row_finish(const PostIn& in, bf16_t* __restrict__ yh, const float* __restrict__ gpost, const float* __restrict__ gpre_next,
                        float* __restrict__ xdst, bool last, int lane) {
    u32x4 yv[2]; f32x4 xv[4];
#pragma unroll
    for (int j = 0; j < 2; ++j) yv[j] = in.yv[j];
#pragma unroll
    for (int j = 0; j < 4; ++j) xv[j] = in.xv[j];
    float y[16];
#pragma unroll
    for (int j = 0; j < 2; ++j) {
        y[8 * j + 0] = bflo(yv[j].x); y[8 * j + 1] = bfhi(yv[j].x); y[8 * j + 2] = bflo(yv[j].y); y[8 * j + 3] = bfhi(yv[j].y);
        y[8 * j + 4] = bflo(yv[j].z); y[8 * j + 5] = bfhi(yv[j].z); y[8 * j + 6] = bflo(yv[j].w); y[8 * j + 7] = bfhi(yv[j].w);
    }
    float ss = 0.f;
#pragma unroll
    for (int i = 0; i < 16; ++i) ss += y[i] * y[i];
    ss = wave_sum(ss);
    const float r = rsqrtf(ss * (1.0f / 1024.0f) + EPS);
    float xn[16]; float ss2 = 0.f;
#pragma unroll
    for (int j = 0; j < 2; ++j) {
        const f32x4 g0 = *(const f32x4*)(gpost + j * 512 + lane * 8), g1 = *(const f32x4*)(gpost + j * 512 + lane * 8 + 4);
#pragma unroll
        for (int i = 0; i < 4; ++i) {
            xn[8 * j + i] = xv[2 * j][i] + y[8 * j + i] * r * g0[i];
            xn[8 * j + 4 + i] = xv[2 * j + 1][i] + y[8 * j + 4 + i] * r * g1[i];
        }
    }
#pragma unroll
    for (int i = 0; i < 16; ++i) ss2 += xn[i] * xn[i];
#pragma unroll
    for (int j = 0; j < 2; ++j) {
        *(f32x4*)(xdst + j * 512 + lane * 8) = (f32x4){xn[8 * j], xn[8 * j + 1], xn[8 * j + 2], xn[8 * j + 3]};
        *(f32x4*)(xdst + j * 512 + lane * 8 + 4) = (f32x4){xn[8 * j + 4], xn[8 * j + 5], xn[8 * j + 6], xn[8 * j + 7]};
    }
    if (!last) {
        ss2 = wave_sum(ss2);
        const float r2 = rsqrtf(ss2 * (1.0f / 1024.0f) + EPS);
#pragma unroll
        for (int j = 0; j < 2; ++j) {
            const f32x4 g0 = *(const f32x4*)(gpre_next + j * 512 + lane * 8), g1 = *(const f32x4*)(gpre_next + j * 512 + lane * 8 + 4);
            u32x4 o;
            o.x = pk_bf16(xn[8 * j] * r2 * g0[0], xn[8 * j + 1] * r2 * g0[1]);
            o.y = pk_bf16(xn[8 * j + 2] * r2 * g0[2], xn[8 * j + 3] * r2 * g0[3]);
            o.z = pk_bf16(xn[8 * j + 4] * r2 * g1[0], xn[8 * j + 5] * r2 * g1[1]);
            o.w = pk_bf16(xn[8 * j + 6] * r2 * g1[2], xn[8 * j + 7] * r2 * g1[3]);
            *(u32x4*)(yh + j * 512 + lane * 8) = o;
        }
    }
}

#define XB_TMO      128
#define XB_XCNT(j)  (256  + 64 * (j))
#define XB_XSUB(j)  (1280 + 64 * (j))
#define XB_XGEN(j)  (2304 + 64 * (j))
#define XB_TOP      3328
#define XB_TOPGEN   3392
#define XCD_BAR_WORDS 3456
#define XB_SPIN_CAP (1u << 18)
#define LAS __attribute__((address_space(3)))
DI unsigned xb_ld(unsigned* p)              { return __hip_atomic_load(p, __ATOMIC_RELAXED, __HIP_MEMORY_SCOPE_AGENT); }
DI unsigned xb_add(unsigned* p, unsigned v) { return __hip_atomic_fetch_add(p, v, __ATOMIC_RELAXED, __HIP_MEMORY_SCOPE_AGENT); }
DI unsigned xb_xcc_id() { return (unsigned)__builtin_amdgcn_s_getreg((3 << 11) | 20) & 0xFu; }
#define XB_SPIN(cond, bar) do { unsigned _sp = 0; while (cond) { __builtin_amdgcn_s_sleep(1); \
    if ((++_sp & 255u) == 0u) { if (xb_ld(&(bar)[XB_TMO])) break; if (_sp > XB_SPIN_CAP) { atomicAdd(&(bar)[XB_TMO], 1u); break; } } } } while (0)
struct XcdBarrier { unsigned* bar; unsigned x; volatile LAS unsigned* st; };
DI XcdBarrier xcd_barrier_post(unsigned* bar, volatile LAS unsigned* st) {
    XcdBarrier b; b.bar = bar; b.x = xb_xcc_id(); b.st = st;
    if (threadIdx.x == 0) (void)xb_add(&bar[XB_XCNT(b.x)], 1u);
    return b;
}
DI void xcd_barrier_complete(unsigned* bar, unsigned x, unsigned& nloc, unsigned& nx) {
    const unsigned G = gridDim.x * gridDim.y * gridDim.z;
    unsigned sum, cnt, mine, sp = 0u;
    for (;;) {
        sum = 0u; cnt = 0u; mine = 0u;
#pragma unroll
        for (unsigned j = 0; j < 16; ++j) { const unsigned c = xb_ld(&bar[XB_XCNT(j)]); sum += c; cnt += (c > 0u) ? 1u : 0u; mine = (j == x) ? c : mine; }
        if (sum == G) break;
        __builtin_amdgcn_s_sleep(1);
        if ((++sp & 255u) == 0u) { if (xb_ld(&bar[XB_TMO])) break; if (sp > XB_SPIN_CAP) { atomicAdd(&bar[XB_TMO], 1u); break; } }
    }
    nloc = mine > 0u ? mine : 1u; nx = cnt > 0u ? cnt : 1u;
}
DI void xcd_barrier(const XcdBarrier& b) {
    asm volatile("s_waitcnt vmcnt(0)" ::: "memory");
    __syncthreads();
    if (threadIdx.x == 0) {
        unsigned* bar = b.bar;
        __builtin_amdgcn_s_waitcnt(0);
        unsigned nloc = b.st[0], nx = b.st[1];
        if (nloc == 0u) { xcd_barrier_complete(bar, b.x, nloc, nx); b.st[0] = nloc; b.st[1] = nx; }
        const unsigned old = xb_add(&bar[XB_XSUB(b.x)], 1u);
        const unsigned gen = old / nloc;
        if (old + 1u == (gen + 1u) * nloc) {
            __builtin_amdgcn_fence(__ATOMIC_RELEASE, "agent");
            asm volatile("s_waitcnt vmcnt(0)" ::: "memory");
            const unsigned og = xb_add(&bar[XB_TOP], 1u);
            const unsigned tg = og / nx;
            if (og + 1u == (tg + 1u) * nx) xb_add(&bar[XB_TOPGEN], 1u);
            else XB_SPIN(xb_ld(&bar[XB_TOPGEN]) == tg, bar);
            __builtin_amdgcn_fence(__ATOMIC_ACQUIRE, "agent");
            xb_add(&bar[XB_XGEN(b.x)], 1u);
            asm volatile("s_waitcnt vmcnt(0)" ::: "memory");
        } else {
            XB_SPIN(xb_ld(&bar[XB_XGEN(b.x)]) == gen, bar);
            __builtin_amdgcn_fence(__ATOMIC_ACQUIRE, "agent");
            asm volatile("s_waitcnt vmcnt(0)" ::: "memory");
        }
    }
    __syncthreads();
}

__global__ void __launch_bounds__(512, 2) fwd_megakernel(Params p) {
    __shared__ __attribute__((aligned(16))) unsigned char smem[131072];
    __shared__ uint4 xb_words;
    cg::grid_group grid = cg::this_grid();
    const int nb = gridDim.x, bid = blockIdx.x;
    if (threadIdx.x == 0) xb_words = make_uint4(0u, 0u, 0u, 0u);
    __syncthreads();
    XcdBarrier xb = xcd_barrier_post((unsigned*)(p.ws + OFF_BAR), (volatile LAS unsigned*)&xb_words);
    if (p.phase_end > 1000) grid.sync();
    for (int ph = p.phase_begin; ph < p.phase_end; ++ph) {
        unsigned char* ws = p.ws;
        bf16_t* H = (bf16_t*)(ws + OFF_H);
        bf16_t* Z = (bf16_t*)(ws + OFF_Z);
        bf16_t* VT = (bf16_t*)(ws + OFF_VT);
        bf16_t* MIX = (bf16_t*)(ws + OFF_MIX);
        bf16_t* WIN = (bf16_t*)(ws + OFF_WIN);
        bf16_t* WOUT = (bf16_t*)(ws + OFF_WOUT);
        bf16_t* WMEM = (bf16_t*)(ws + OFF_WMEM);
        bf16_t* PW = (bf16_t*)(ws + OFF_PW);
        bf16_t* MH = (bf16_t*)(ws + OFF_MH);
        bf16_t* KM = (bf16_t*)(ws + OFF_KM);
        bf16_t* VMT = (bf16_t*)(ws + OFF_VMT);
        float* ROPE = (float*)(ws + OFF_ROPE);
        if (ph == 0) {
            for (int i = bid; i < 1928; i += nb) {
                if (i < 1152) { const int l = i / 576, j = i % 576, kt = j / 36, ntile = j % 36;
                    transpose_tile(p.w_in + (size_t)l * DM * INW, INW, WIN + (size_t)l * INW * DM, DM, kt * 64, ntile * 64, smem);
                } else if (i < 1664) { const int ii = i - 1152, l = ii / 256, j = ii % 256, kt = j / 16, ntile = j % 16;
                    transpose_tile(p.w_out + (size_t)l * DM * DM, DM, WOUT + (size_t)l * DM * DM, DM, kt * 64, ntile * 64, smem);
                } else if (i < 1920) { const int ii = i - 1664, l = ii / 128, j = ii % 128, kt = j / 8, ntile = j % 8;
                    transpose_tile(p.w_mem_kv + (size_t)l * DM * 512, 512, WMEM + (size_t)l * 512 * DM, DM, kt * 64, ntile * 64, smem);
                } else { const int ii = i - 1920;
                    transpose_tile(p.pool_w + (size_t)ii * 4096, 64, PW + (size_t)ii * 4096, 64, 0, 0, smem);
                }
            }
            {
                const int tid = opaque_tid(), lane = tid & 63, wave = tid >> 6;
                constexpr int NR = NTOK + 2 * NMEMTOK;
                auto desc = [&](int i, const float*& src, const float*& g, bf16_t*& dst) {
                    if (i < NTOK) { src = (i < NPROMPT) ? p.x_prompt + (size_t)i * DM : p.x_sample + (size_t)(i - NPROMPT) * DM; g = p.norm_pre; dst = H + (size_t)i * DM; }
                    else { const int ii = i - NTOK, l = ii / NMEMTOK, mt = ii % NMEMTOK;
                           src = (mt < 4096) ? p.mem_prompt + (size_t)mt * DM : p.mem_sample + (size_t)(mt - 4096) * DM; g = p.mem_norm + l * DM; dst = MH + ((size_t)l * NMEMTOK + mt) * DM; }
                };
                int i = bid * 8 + wave;
                if (i < NR) {
                    const float *s, *g; bf16_t* d; desc(i, s, g, d);
                    RowIn cur = rms_row_load(s, lane);
                    for (; i < NR; i += nb * 8) {
                        const int in = (i + nb * 8 < NR) ? i + nb * 8 : NR - 1;
                        const float *s2, *g2; bf16_t* d2; desc(in, s2, g2, d2);
                        const RowIn nxt = rms_row_load(s2, lane);
                        rms_row_finish(cur, g, d, lane);
                        cur = nxt; g = g2; d = d2;
                    }
                }
            }
            { const int tid = opaque_tid(); for (int i = bid * 512 + tid; i < 1024; i += nb * 512) rope_entry(i, ROPE); }
        } else {
            const int l = (ph - 1) >> 2, sub = (ph - 1) & 3;
            if (sub == 0) {
                EpiArgs e; e.C = Z; e.VT = VT; e.qn = p.q_norm + l * 64; e.kn = p.k_norm + l * 64; e.rope = ROPE;
                const bf16_t* Wl = WIN + (size_t)l * INW * DM;
                EpiArgs e2; e2.C = KM + (size_t)l * NMEMTOK * 256; e2.VT = VMT + (size_t)l * NMEMTOK * 256; e2.qn = nullptr; e2.kn = nullptr; e2.rope = nullptr;
                const bf16_t* Wm = WMEM + (size_t)l * 512 * DM;
                const bf16_t* Am = MH + (size_t)l * NMEMTOK * DM;
                for (int i = bid; i < 1728 + 40; i += nb) {
                    if (i < 1728) {
                        const int j = i >> 3, mg = j / 72, rem = j % 72;
                        const int mt = (i & 7) * 24 + mg * 8 + (rem & 7), ntile = rem >> 3;
                        gemm_tile<0>(H, Wl, mt * 256, ntile * 256, e, smem);
                    } else {
                        const int j = i - 1728;
                        gemm_tile<2>(Am, Wm, (j >> 1) * 256, (j & 1) * 256, e2, smem);
                    }
                }
            } else if (sub == 1) {
                const int lane = opaque_tid() & 63;
                float gq = fabsf(p.q_norm[l * 64 + lane]), gk = fabsf(p.k_norm[l * 64 + lane]);
                gq = wave_max(gq); gk = wave_max(gk);
                const float mfix = 8.0f * gq * gk * 1.02f * L2E;
                const bool fixm = mfix < 28.0f;
                for (int i = bid; i < 3072; i += nb) {
                    if (i < 1536) {
                        int b, kvh, j, T; size_t tok0, vtb;
                        if (i < 512) { const int R = i >> 8, ip = i & 255, grp = ip & 7; j = R * 32 + (ip >> 3); b = grp >> 1; kvh = grp & 1; T = 4096;
                            tok0 = (size_t)NPROMPT + (size_t)b * 4096; vtb = (size_t)NPROMPT * 128 + ((size_t)(b * 2 + kvh) * 64) * 4096; }
                        else { const int ii = i - 512, R = ii >> 8, ip = ii & 255, grp = R * 8 + (ip & 7); j = ip >> 3; b = grp >> 1; kvh = grp & 1; T = 2048;
                            tok0 = (size_t)b * 2048; vtb = ((size_t)(b * 2 + kvh) * 64) * 2048; }
                        const int qblk = j >> 2, head = kvh * 4 + (j & 3);
                        const size_t q0 = tok0 + (size_t)qblk * 256;
                        if (fixm) attn_item<true>(Z + q0 * INW + 512 + head * 64, INW, Z + tok0 * INW + 1024 + kvh * 64, INW, VT + vtb, T, T,
                                  MIX + q0 * 1024 + 256 + head * 64, Z + q0 * INW + 1280 + head * 64, smem, mfix);
                        else attn_item<false>(Z + q0 * INW + 512 + head * 64, INW, Z + tok0 * INW + 1024 + kvh * 64, INW, VT + vtb, T, T,
                                  MIX + q0 * 1024 + 256 + head * 64, Z + q0 * INW + 1280 + head * 64, smem, 0.f);
                    } else if (i < 2304) {
                        const int ii = i - 1536, qb = ii >> 2, hx = ii & 3;
                        const size_t q0 = (size_t)qb * 256;
                        const int b = (q0 < NPROMPT) ? (int)(q0 >> 11) : 16 + (int)((q0 - NPROMPT) >> 12);
cross_item(Z + q0 * INW + 1792 + hx * 64, KM + ((size_t)l * NMEMTOK + (size_t)b * 256) * 256 + hx * 64,
                                   VMT + (size_t)l * NMEMTOK * 256 + ((size_t)(b * 4 + hx) * 64) * 256,
                                   MIX + q0 * 1024 + 768 + hx * 64, Z + q0 * INW + 2048 + hx * 64, smem);
                    } else {
                        pool_item(Z, PW + (size_t)l * 4 * 4096, p.pool_scale + l * 256, MIX, (i - 2304) * 64, smem);
                    }
                }
            } else if (sub == 2) {
                EpiArgs e; e.C = H; e.VT = nullptr; e.qn = nullptr; e.kn = nullptr; e.rope = nullptr;
                const bf16_t* Wl = WOUT + (size_t)l * DM * DM;
                for (int i = bid; i < 768; i += nb) {
                    const int j = i >> 3, mg = j >> 5, rem = j & 31;
                    const int mt = (i & 7) * 24 + mg * 8 + (rem & 7), ntile = rem >> 3;
                    gemm_tile<1>(MIX, Wl, mt * 256, ntile * 256, e, smem);
                }
            } else {
                const bool last = (l == DEPTH - 1);
                auto xsrc = [&](int i) -> const float* {
                    return (l == 0) ? ((i < NPROMPT) ? p.x_prompt + (size_t)i * DM : p.x_sample + (size_t)(i - NPROMPT) * DM) : p.out + (size_t)i * DM; };
                const int tid = opaque_tid(), lane = tid & 63, wave = tid >> 6;
                int i = bid * 8 + wave;
                if (i < NTOK) {
                    PostIn cur = post_row_load(xsrc(i), H + (size_t)i * DM, lane);
                    for (; i < NTOK; i += nb * 8) {
                        const int in = (i + nb * 8 < NTOK) ? i + nb * 8 : i;
                        const PostIn nxt = post_row_load(xsrc(in), H + (size_t)in * DM, lane);
                        post_row_finish(cur, H + (size_t)i * DM, p.norm_post + l * DM, p.norm_pre + (last ? l : l + 1) * DM, p.out + (size_t)i * DM, last, lane);
                        cur = nxt;
                    }
                }
            }
        }
        if (ph + 1 < p.phase_end) xcd_barrier(xb);
    }
}

extern "C" void kernel_launch(void* const* d_in, const int* in_sizes, int n_in, void* d_out, int out_size, void* d_ws, size_t ws_size,
                              hipStream_t stream) {
    static int grid_blocks = 0;
    if (!grid_blocks) {
        int dev = 0, cus = 0, per_cu = 0;
        hipGetDevice(&dev);
        hipDeviceGetAttribute(&cus, hipDeviceAttributeMultiprocessorCount, dev);
        hipOccupancyMaxActiveBlocksPerMultiprocessor(&per_cu, fwd_megakernel, 512, 0);
        if (per_cu > 1) per_cu = 1;
        if (per_cu < 1) per_cu = 1;
        grid_blocks = cus * per_cu;
    }
    Params p{};
    p.x_prompt = (const float*)d_in[0]; p.x_sample = (const float*)d_in[1]; p.mem_prompt = (const float*)d_in[2]; p.mem_sample = (const float*)d_in[3];
    p.norm_pre = (const float*)d_in[4]; p.norm_post = (const float*)d_in[5]; p.w_in = (const float*)d_in[6]; p.pool_w = (const float*)d_in[7];
    p.pool_scale = (const float*)d_in[8]; p.q_norm = (const float*)d_in[9]; p.k_norm = (const float*)d_in[10]; p.mem_norm = (const float*)d_in[11];
    p.w_mem_kv = (const float*)d_in[12]; p.w_out = (const float*)d_in[13];
    p.out = (float*)d_out; p.ws = (unsigned char*)d_ws;
    p.phase_begin = 0; p.phase_end = 1 + 4 * DEPTH;
    if (ws_size < WS_TOTAL) { fprintf(stderr, "workspace too small: %zu < %zu\n", ws_size, (size_t)WS_TOTAL); return; }
    hipMemsetAsync((unsigned char*)d_ws + OFF_BAR, 0, BAR_BYTES, stream);
    void* args[] = {&p};
    hipError_t e = hipLaunchCooperativeKernel((void*)fwd_megakernel, dim3(grid_blocks), dim3(512), args, 0, stream);
    if (e != hipSuccess) fprintf(stderr, "cooperative launch failed: %s (grid %d)\n", hipGetErrorString(e), grid_blocks);
}
```

```cpp
#include <hip/hip_runtime.h>
#include <hip/hip_cooperative_groups.h>
#include <stdint.h>
#include <cstdio>
namespace cg = cooperative_groups;

typedef unsigned short bf16_t;
typedef short bf16x8 __attribute__((ext_vector_type(8)));
typedef float f32x4 __attribute__((ext_vector_type(4)));
typedef float f32x16 __attribute__((ext_vector_type(16)));
typedef unsigned u32x4 __attribute__((ext_vector_type(4)));
typedef unsigned u32x2 __attribute__((ext_vector_type(2)));
typedef __bf16 bf16x2_t __attribute__((ext_vector_type(2)));
typedef float f32x2_t __attribute__((ext_vector_type(2)));
#define DI __device__ __forceinline__

constexpr int NTOK = 49152;
constexpr int NPROMPT = 32768;
constexpr int DM = 1024;
constexpr int INW = 2304;
constexpr int NMEMTOK = 5120;
constexpr int DEPTH = 2;
constexpr float EPS = 1e-6f;
constexpr float L2E = 1.4426950408889634f;

constexpr size_t OFF_H    = 0;
constexpr size_t OFF_Z    = OFF_H + (size_t)NTOK * DM * 2;
constexpr size_t OFF_VT   = OFF_Z + (size_t)NTOK * INW * 2;
constexpr size_t OFF_MIX  = OFF_VT + (size_t)NTOK * 128 * 2;
constexpr size_t OFF_WIN  = OFF_MIX + (size_t)NTOK * DM * 2;
constexpr size_t OFF_WOUT = OFF_WIN + (size_t)DEPTH * INW * DM * 2;
constexpr size_t OFF_WMEM = OFF_WOUT + (size_t)DEPTH * DM * DM * 2;
constexpr size_t OFF_PW   = OFF_WMEM + (size_t)DEPTH * 512 * DM * 2;
constexpr size_t OFF_MH   = OFF_PW + (size_t)DEPTH * 4 * 64 * 64 * 2;
constexpr size_t OFF_KM   = OFF_MH + (size_t)DEPTH * NMEMTOK * DM * 2;
constexpr size_t OFF_VMT  = OFF_KM + (size_t)DEPTH * NMEMTOK * 256 * 2;
constexpr size_t OFF_ROPE = OFF_VMT + (size_t)DEPTH * NMEMTOK * 256 * 2;
constexpr size_t OFF_BAR  = OFF_ROPE + 64 * 16 * 2 * 4;
constexpr size_t BAR_BYTES = 3456 * 4;
constexpr size_t WS_TOTAL = OFF_BAR + BAR_BYTES;

struct Params {
    const float* x_prompt; const float* x_sample; const float* mem_prompt; const float* mem_sample;
    const float* norm_pre; const float* norm_post; const float* w_in; const float* pool_w; const float* pool_scale;
    const float* q_norm; const float* k_norm; const float* mem_norm; const float* w_mem_kv; const float* w_out;
    float* out; unsigned char* ws;
    int phase_begin; int phase_end;
};

DI unsigned pk_bf16(float a, float b) {
    f32x2_t v = {a, b};
    bf16x2_t r = __builtin_convertvector(v, bf16x2_t);
    return __builtin_bit_cast(unsigned, r);
}
DI int opaque_tid() { int t = threadIdx.x; asm volatile("" : "+v"(t)); return t; }
DI void lds_barrier() { asm volatile("s_waitcnt lgkmcnt(0)\n\ts_barrier" ::: "memory"); }
DI float bflo(unsigned u) { return __uint_as_float(u << 16); }
DI float bfhi(unsigned u) { return __uint_as_float(u & 0xffff0000u); }
template <int CTRL> DI float dppf(float v) { return __uint_as_float(__builtin_amdgcn_update_dpp(0u, __float_as_uint(v), CTRL, 0xf, 0xf, true)); }
DI float x16_add(float v) { auto r = __builtin_amdgcn_permlane16_swap(__float_as_uint(v), __float_as_uint(v), false, false); return __uint_as_float(r[0]) + __uint_as_float(r[1]); }
DI float x32_add(float v) { auto r = __builtin_amdgcn_permlane32_swap(__float_as_uint(v), __float_as_uint(v), false, false); return __uint_as_float(r[0]) + __uint_as_float(r[1]); }
DI float x16_max(float v) { auto r = __builtin_amdgcn_permlane16_swap(__float_as_uint(v), __float_as_uint(v), false, false); return fmaxf(__uint_as_float(r[0]), __uint_as_float(r[1])); }
DI float x32_max(float v) { auto r = __builtin_amdgcn_permlane32_swap(__float_as_uint(v), __float_as_uint(v), false, false); return fmaxf(__uint_as_float(r[0]), __uint_as_float(r[1])); }
DI float wave_sum(float v) {
    v += dppf<0xB1>(v); v += dppf<0x4E>(v); v += dppf<0x141>(v); v += dppf<0x140>(v);
    v = x16_add(v); v = x32_add(v);
    return v;
}
DI float wave_max(float v) {
    v = fmaxf(v, dppf<0xB1>(v)); v = fmaxf(v, dppf<0x4E>(v)); v = fmaxf(v, dppf<0x141>(v)); v = fmaxf(v, dppf<0x140>(v));
    v = x16_max(v); v = x32_max(v);
    return v;
}
DI float xhalf_max(float v) {
    auto r = __builtin_amdgcn_permlane32_swap(__float_as_uint(v), __float_as_uint(v), false, false);
    return fmaxf(__uint_as_float(r[0]), __uint_as_float(r[1]));
}
DI float silu_f(float x) { return x * __builtin_amdgcn_rcpf(1.0f + __builtin_amdgcn_exp2f(-x * L2E)); }
DI f32x4 mfma16(bf16x8 a, bf16x8 b, f32x4 c) { return __builtin_amdgcn_mfma_f32_16x16x32_bf16(a, b, c, 0, 0, 0); }
DI f32x16 mfma32(bf16x8 a, bf16x8 b, f32x16 c) { return __builtin_amdgcn_mfma_f32_32x32x16_bf16(a, b, c, 0, 0, 0); }

DI void transpose_tile(const float* __restrict__ src, int ldn, bf16_t* __restrict__ dst, int ldk, int k0, int n0, unsigned char* smem) {
    float* tile = (float*)smem;
    const int tid = opaque_tid();
    __syncthreads();
#pragma unroll
    for (int i = 0; i < 2; ++i) {
        const int id = tid + 512 * i, r = id >> 4, c4 = id & 15;
        const f32x4 v = *(const f32x4*)(src + (size_t)(k0 + r) * ldn + n0 + c4 * 4);
        tile[r * 65 + c4 * 4 + 0] = v[0]; tile[r * 65 + c4 * 4 + 1] = v[1]; tile[r * 65 + c4 * 4 + 2] = v[2]; tile[r * 65 + c4 * 4 + 3] = v[3];
    }
    __syncthreads();
    {
        const int n = tid >> 3, kc = tid & 7;
        float v[8];
#pragma unroll
        for (int j = 0; j < 8; ++j) v[j] = tile[(kc * 8 + j) * 65 + n];
        u32x4 o; o.x = pk_bf16(v[0], v[1]); o.y = pk_bf16(v[2], v[3]); o.z = pk_bf16(v[4], v[5]); o.w = pk_bf16(v[6], v[7]);
        *(u32x4*)(dst + (size_t)(n0 + n) * ldk + k0 + kc * 8) = o;
    }
}

struct RowIn { f32x4 v[4]; };
DI RowIn rms_row_load(const float* __restrict__ src, int lane) {
    RowIn r;
#pragma unroll
    for (int j = 0; j < 4; ++j) r.v[j] = *(const f32x4*)(src + j * 256 + lane * 4);
    return r;
}
DI void rms_row_finish(const RowIn& in, const float* __restrict__ g, bf16_t* __restrict__ dst, int lane) {
    f32x4 v[4]; float ss = 0.f;
#pragma unroll
    for (int j = 0; j < 4; ++j) { v[j] = in.v[j]; ss += v[j][0] * v[j][0] + v[j][1] * v[j][1] + v[j][2] * v[j][2] + v[j][3] * v[j][3]; }
    ss = wave_sum(ss);
    const float r = rsqrtf(ss * (1.0f / 1024.0f) + EPS);
#pragma unroll
    for (int j = 0; j < 4; ++j) {
        const f32x4 gg = *(const f32x4*)(g + j * 256 + lane * 4);
        u32x2 o; o.x = pk_bf16(v[j][0] * r * gg[0], v[j][1] * r * gg[1]); o.y = pk_bf16(v[j][2] * r * gg[2], v[j][3] * r * gg[3]);
        *(u32x2*)(dst + j * 256 + lane * 4) = o;
    }
}

DI void rope_entry(int idx, float* table) {
    const int n = idx >> 4, pp = idx & 15;
    double fd = 1.0;
    for (int i = 0; i < pp; ++i) fd *= 0.5623413251903491;
    const float f = (float)fd;
    const float a = (float)n * f;
    double r = (double)a;
    const double k = rint(r * 0.15915494309189535);
    r -= k * 6.283185307179586;
    const double r2 = r * r;
    double sn = r, cs = 1.0, ts = r, tc = 1.0;
    for (int i = 1; i <= 16; ++i) {
        tc = -tc * r2 / (double)((2 * i - 1) * (2 * i));
        ts = -ts * r2 / (double)((2 * i) * (2 * i + 1));
        cs += tc; sn += ts;
    }
    table[idx * 2] = (float)cs; table[idx * 2 + 1] = (float)sn;
}

struct EpiArgs {
    bf16_t* C;
    bf16_t* VT;
    const float* qn; const float* kn; const float* rope;
};

DI int g8_lds_byte(int r, int c) { const int st = (r >> 4) * 2 + (c >> 5), rr = r & 15, cc = c & 31, ob = rr * 64 + cc * 2; return st * 1024 + (ob ^ (((ob >> 9) & 1) << 5)); }
DI void g8_stage_rc(int b, int& R, int& C) { const int st = b >> 10, sb = b & 1023, swz = sb ^ (((sb >> 9) & 1) << 5); R = (st >> 1) * 16 + (swz >> 6); C = (st & 1) * 32 + ((swz & 63) >> 1); }

DI const unsigned char* uniform_ptr(const void* p) {
    const unsigned long long v = (unsigned long long)p;
    const unsigned lo = __builtin_amdgcn_readfirstlane((unsigned)v), hi = __builtin_amdgcn_readfirstlane((unsigned)(v >> 32));
    return (const unsigned char*)(((unsigned long long)hi << 32) | lo);
}

template <int MODE>
DI void gemm_tile(const bf16_t* __restrict__ A, const bf16_t* __restrict__ Bt, int m0, int n0, const EpiArgs& e, unsigned char* smem,
                  bool prefetched, const bf16_t* __restrict__ nA, const bf16_t* __restrict__ nB, int nm0, int nn0) {
    constexpr int K = 1024, BK = 64, HALF = 128, HTB = 16384, nt = K / BK;
    const int tid = opaque_tid(), lane = tid & 63, wave = __builtin_amdgcn_readfirstlane(tid >> 6);
    const int wr = wave >> 2, wc = wave & 3, fr = lane & 15, fq = lane >> 4;
    int sR0, sC0, sR1, sC1;
    g8_stage_rc(tid * 16, sR0, sC0); g8_stage_rc(tid * 16 + 8192, sR1, sC1);
    const unsigned so0b = (unsigned)(sR0 * K + sC0) * 2u, so1b = (unsigned)(sR1 * K + sC1) * 2u;
    __attribute__((address_space(3))) unsigned char* lds = (__attribute__((address_space(3))) unsigned char*)smem;
#define G8_SA(b, h) (((b) * 2 + (h)) * HTB)
#define G8_SB(b, h) ((4 + (b) * 2 + (h)) * HTB)
#define G8_STAGE(POFF, BASE, br, kt) { const unsigned char* g_ = uniform_ptr((BASE) + (size_t)(br) * K + (kt) * BK); \
        __builtin_amdgcn_global_load_lds((const __attribute__((address_space(1))) unsigned*)(g_ + so0b), (__attribute__((address_space(3))) unsigned*)(lds + (POFF) + tid * 16), 16, 0, 0); \
        __builtin_amdgcn_global_load_lds((const __attribute__((address_space(1))) unsigned*)(g_ + so1b), (__attribute__((address_space(3))) unsigned*)(lds + (POFF) + tid * 16 + 8192), 16, 0, 0); }
    const int lane_off = (fr * 64 + fq * 16) ^ ((fr >> 3) << 5);
    const unsigned ldsA = (unsigned)(size_t)lds + (unsigned)(lane_off + wr * 8192);
    const unsigned ldsB = (unsigned)(size_t)lds + (unsigned)(lane_off + wc * 4096);
#define G8_DSR(dst, addr, OFF) asm volatile("ds_read_b128 %0, %1 offset:" #OFF : "=v"(dst) : "v"(addr))
#define G8_LDA(dst, b, h) { const unsigned a_ = ldsA + G8_SA(b, h); \
        G8_DSR(dst[0][0], a_, 0); G8_DSR(dst[0][1], a_, 1024); G8_DSR(dst[1][0], a_, 2048); G8_DSR(dst[1][1], a_, 3072); \
        G8_DSR(dst[2][0], a_, 4096); G8_DSR(dst[2][1], a_, 5120); G8_DSR(dst[3][0], a_, 6144); G8_DSR(dst[3][1], a_, 7168); }
#define G8_LDB(dst, b, h) { const unsigned a_ = ldsB + G8_SB(b, h); \
        G8_DSR(dst[0][0], a_, 0); G8_DSR(dst[0][1], a_, 1024); G8_DSR(dst[1][0], a_, 2048); G8_DSR(dst[1][1], a_, 3072); }
#define G8_TIE_A(AT) asm volatile("s_waitcnt lgkmcnt(0)" : "+v"(AT[0][0]), "+v"(AT[0][1]), "+v"(AT[1][0]), "+v"(AT[1][1]), "+v"(AT[2][0]), "+v"(AT[2][1]), "+v"(AT[3][0]), "+v"(AT[3][1]) :: "memory")
#define G8_TIE_B(BX) asm volatile("s_waitcnt lgkmcnt(0)" : "+v"(BX[0][0]), "+v"(BX[0][1]), "+v"(BX[1][0]), "+v"(BX[1][1]) :: "memory")
#define G8_MMA(ai, bj, AT, BX) { __builtin_amdgcn_s_setprio(1); \
        _Pragma("unroll") for (int m = 0; m < 4; ++m) _Pragma("unroll") for (int n = 0; n < 2; ++n) _Pragma("unroll") for (int k = 0; k < 2; ++k) \
            acc[ai][bj][m][n] = mfma16(BX[n][k], AT[m][k], acc[ai][bj][m][n]); \
        __builtin_amdgcn_s_setprio(0); }
#define G8_WV(n) asm volatile("s_waitcnt vmcnt(" #n ")" ::: "memory")
#define G8_WL(n) asm volatile("s_waitcnt lgkmcnt(" #n ")" ::: "memory")
#define G8_BAR __builtin_amdgcn_s_barrier()
#define G8_SCHED __builtin_amdgcn_sched_barrier(0)
    f32x4 acc[2][2][4][2];
#pragma unroll
    for (int a = 0; a < 2; ++a)
#pragma unroll
        for (int b = 0; b < 2; ++b)
#pragma unroll
            for (int m = 0; m < 4; ++m)
#pragma unroll
                for (int n = 0; n < 2; ++n) acc[a][b][m][n] = (f32x4){0.f, 0.f, 0.f, 0.f};
    bf16x8 At[4][2], B0[2][2], B1[2][2];
    if (!prefetched) {
        __syncthreads();
        G8_STAGE(G8_SB(0, 0), Bt, n0, 0); G8_STAGE(G8_SA(0, 0), A, m0, 0);
        G8_STAGE(G8_SB(0, 1), Bt, n0 + HALF, 0); G8_STAGE(G8_SA(0, 1), A, m0 + HALF, 0);
        if (wr == 1) G8_BAR;
        G8_WV(4); G8_BAR;
        G8_STAGE(G8_SB(1, 0), Bt, n0, 1); G8_STAGE(G8_SA(1, 0), A, m0, 1); G8_STAGE(G8_SB(1, 1), Bt, n0 + HALF, 1);
        G8_WV(6); G8_BAR;
    } else {
        G8_WV(0);
        if (wr == 1) G8_BAR;
        G8_BAR;
        G8_BAR;
    }
    for (int t = 0; t < nt - 2; t += 2) {
        G8_LDB(B0, 0, 0); G8_SCHED; G8_LDA(At, 0, 0); G8_STAGE(G8_SA(1, 1), A, m0 + HALF, t + 1);
        G8_WL(8); G8_BAR; G8_TIE_B(B0); G8_TIE_A(At); G8_MMA(0, 0, At, B0); G8_BAR; G8_SCHED;
        G8_LDB(B1, 0, 1); G8_STAGE(G8_SB(0, 0), Bt, n0, t + 2);
        G8_BAR; G8_TIE_B(B1); G8_MMA(0, 1, At, B1); G8_BAR;
        G8_LDA(At, 0, 1); G8_STAGE(G8_SA(0, 0), A, m0, t + 2);
        G8_BAR; G8_TIE_A(At); G8_MMA(1, 0, At, B0); G8_BAR; G8_SCHED;
        G8_STAGE(G8_SB(0, 1), Bt, n0 + HALF, t + 2);
        G8_WV(6); G8_BAR; G8_MMA(1, 1, At, B1); G8_BAR;
        G8_LDB(B0, 1, 0); G8_SCHED; G8_LDA(At, 1, 0); G8_STAGE(G8_SA(0, 1), A, m0 + HALF, t + 2);
        G8_WL(8); G8_BAR; G8_TIE_B(B0); G8_TIE_A(At); G8_MMA(0, 0, At, B0); G8_BAR; G8_SCHED;
        G8_LDB(B1, 1, 1); G8_STAGE(G8_SB(1, 0), Bt, n0, t + 3);
        G8_BAR; G8_TIE_B(B1); G8_MMA(0, 1, At, B1); G8_BAR;
        G8_LDA(At, 1, 1); G8_STAGE(G8_SA(1, 0), A, m0, t + 3);
        G8_BAR; G8_TIE_A(At); G8_MMA(1, 0, At, B0); G8_BAR; G8_SCHED;
        G8_STAGE(G8_SB(1, 1), Bt, n0 + HALF, t + 3);
        G8_WV(6); G8_BAR; G8_MMA(1, 1, At, B1); G8_BAR;
    }
    {
        G8_LDB(B0, 0, 0); G8_LDA(At, 0, 0); G8_STAGE(G8_SA(1, 1), A, m0 + HALF, nt - 1);
        G8_BAR; G8_TIE_B(B0); G8_TIE_A(At); G8_MMA(0, 0, At, B0); G8_BAR;
        G8_LDB(B1, 0, 1); G8_BAR; G8_TIE_B(B1); G8_MMA(0, 1, At, B1); G8_BAR;
        G8_LDA(At, 0, 1); G8_WV(4); G8_BAR; G8_TIE_A(At); G8_MMA(1, 0, At, B0); G8_MMA(1, 1, At, B1); G8_BAR;
    }
    {
        G8_LDB(B0, 1, 0); G8_LDA(At, 1, 0); G8_WV(2); G8_BAR; G8_TIE_B(B0); G8_TIE_A(At); G8_MMA(0, 0, At, B0); G8_BAR;
        G8_LDB(B1, 1, 1); G8_WV(0); G8_BAR; G8_TIE_B(B1); G8_MMA(0, 1, At, B1); G8_BAR;
        G8_LDA(At, 1, 1); G8_BAR; G8_TIE_A(At); G8_MMA(1, 0, At, B0); G8_MMA(1, 1, At, B1); G8_BAR;
    }
    if (wr == 0) G8_BAR;
    if (nA != nullptr) {
        G8_STAGE(G8_SB(0, 0), nB, nn0, 0); G8_STAGE(G8_SA(0, 0), nA, nm0, 0);
        G8_STAGE(G8_SB(0, 1), nB, nn0 + HALF, 0); G8_STAGE(G8_SA(0, 1), nA, nm0 + HALF, 0);
        G8_STAGE(G8_SB(1, 0), nB, nn0, 1); G8_STAGE(G8_SA(1, 0), nA, nm0, 1); G8_STAGE(G8_SB(1, 1), nB, nn0 + HALF, 1);
    }
    __builtin_amdgcn_sched_barrier(0);
#undef G8_SA
#undef G8_SB
#undef G8_STAGE
#undef G8_LDA
#undef G8_LDB
#undef G8_DSR
#undef G8_TIE_A
#undef G8_TIE_B
#undef G8_MMA
#undef G8_WV
#undef G8_WL
#undef G8_BAR
#undef G8_SCHED

    const int tid_e = opaque_tid(), wave_e = __builtin_amdgcn_readfirstlane(tid_e >> 6);
    const int wr_e = wave_e >> 2, wc_e = wave_e & 3, fr_e = tid_e & 15, fq_e = (tid_e >> 4) & 3;
    const int tok_w = m0 + wr_e * 64 + fr_e;
    const int col_w = n0 + wc_e * 32 + 4 * fq_e;
    if (MODE == 1) {
#pragma unroll
        for (int ai = 0; ai < 2; ++ai)
#pragma unroll
            for (int m = 0; m < 4; ++m) {
                bf16_t* rowp = e.C + (size_t)(tok_w + ai * 128 + m * 16) * 1024 + col_w;
#pragma unroll
                for (int bj = 0; bj < 2; ++bj)
#pragma unroll
                    for (int n = 0; n < 2; ++n) {
                        const f32x4 v = acc[ai][bj][m][n];
                        u32x2 o; o.x = pk_bf16(v[0], v[1]); o.y = pk_bf16(v[2], v[3]);
                        *(u32x2*)(rowp + bj * 128 + n * 16) = o;
                    }
            }
    } else if (MODE == 2) {
        if (n0 == 0) {
#pragma unroll
            for (int ai = 0; ai < 2; ++ai)
#pragma unroll
                for (int m = 0; m < 4; ++m) {
                    bf16_t* rowp = e.C + (size_t)(tok_w + ai * 128 + m * 16) * 256 + col_w;
#pragma unroll
                    for (int bj = 0; bj < 2; ++bj)
#pragma unroll
                        for (int n = 0; n < 2; ++n) {
                            const f32x4 v = acc[ai][bj][m][n];
                            u32x2 o; o.x = pk_bf16(v[0], v[1]); o.y = pk_bf16(v[2], v[3]);
                            *(u32x2*)(rowp + bj * 128 + n * 16) = o;
                        }
                }
        } else {
#pragma unroll
            for (int ai = 0; ai < 2; ++ai)
#pragma unroll
                for (int m = 0; m < 4; ++m) {
                    const int mt = tok_w + ai * 128 + m * 16, b = mt >> 8, mm = mt & 255;
#pragma unroll
                    for (int bj = 0; bj < 2; ++bj)
#pragma unroll
                        for (int n = 0; n < 2; ++n) {
                            const int f = (col_w - 256) + bj * 128 + n * 16, hx = f >> 6, d = f & 63;
                            bf16_t* bp = e.VT + ((size_t)(b * 4 + hx) * 64 + d) * 256 + mm;
#pragma unroll
                            for (int j = 0; j < 4; ++j) bp[(size_t)j * 256] = (bf16_t)(pk_bf16(acc[ai][bj][m][n][j], 0.f) & 0xffffu);
                        }
                }
        }
    } else {
        const bool has_qk = (n0 >= 512 && n0 < 1152);
        float* ssx = (float*)(smem + 3 * 16384);
        if (has_qk) {
#pragma unroll
            for (int ai = 0; ai < 2; ++ai)
#pragma unroll
                for (int bj = 0; bj < 2; ++bj)
#pragma unroll
                    for (int m = 0; m < 4; ++m) {
                        float ss = 0.f;
#pragma unroll
                        for (int n = 0; n < 2; ++n)
#pragma unroll
                            for (int j = 0; j < 4; ++j) ss += acc[ai][bj][m][n][j] * acc[ai][bj][m][n][j];
                        ss = x16_add(ss); ss = x32_add(ss);
                        if (fq_e == 0) ssx[((wave_e * 2 + ai) * 2 + bj) * 64 + m * 16 + fr_e] = ss;
                    }
            __syncthreads();
        }
#pragma unroll
        for (int bj = 0; bj < 2; ++bj) {
            const int cb = n0 + bj * 128 + wc_e * 32;
            const int c64 = cb & ~63;
            if (c64 >= 512 && c64 < 1152) {
                const bool isq = c64 < 1024;
                const float* gn = (isq ? e.qn : e.kn) + (wc_e & 1) * 32 + 4 * fq_e;
                const float osc = isq ? 0.125f * L2E : 1.0f;
                const f32x4 g0 = *(const f32x4*)(gn), g1 = *(const f32x4*)(gn + 16);
#pragma unroll
                for (int ai = 0; ai < 2; ++ai)
#pragma unroll
                    for (int m = 0; m < 4; ++m) {
                        const int tok = tok_w + ai * 128 + m * 16;
                        const float ss = ssx[((wave_e * 2 + ai) * 2 + bj) * 64 + m * 16 + fr_e] + ssx[(((wave_e ^ 1) * 2 + ai) * 2 + bj) * 64 + m * 16 + fr_e];
                        const float rinv = rsqrtf(ss * (1.0f / 64.0f) + EPS);
                        const int t = (tok < NPROMPT) ? (tok & 2047) : (tok & 4095);
                        const int ridx = (wc_e & 1) ? (t & 63) : (t >> 6);
                        const f32x4* rt = (const f32x4*)(e.rope + (ridx * 16 + 4 * fq_e) * 2);
                        const f32x4 r01 = rt[0], r23 = rt[1];
                        const float rc[4] = {r01[0], r01[2], r23[0], r23[2]}, rs[4] = {r01[1], r01[3], r23[1], r23[3]};
                        float oa[4], ob[4];
#pragma unroll
                        for (int j = 0; j < 4; ++j) {
                            const float a = acc[ai][bj][m][0][j] * rinv * g0[j], b = acc[ai][bj][m][1][j] * rinv * g1[j];
                            oa[j] = (a * rc[j] - b * rs[j]) * osc; ob[j] = (b * rc[j] + a * rs[j]) * osc;
                        }
                        bf16_t* rowp = e.C + (size_t)tok * INW + cb + 4 * fq_e;
                        u32x2 w0, w1; w0.x = pk_bf16(oa[0], oa[1]); w0.y = pk_bf16(oa[2], oa[3]); w1.x = pk_bf16(ob[0], ob[1]); w1.y = pk_bf16(ob[2], ob[3]);
                        *(u32x2*)(rowp) = w0; *(u32x2*)(rowp + 16) = w1;
                    }
            } else if (c64 >= 1152 && c64 < 1280) {
#pragma unroll
                for (int ai = 0; ai < 2; ++ai)
#pragma unroll
                    for (int m = 0; m < 4; ++m) {
                        const int tok = tok_w + ai * 128 + m * 16;
#pragma unroll
                        for (int n = 0; n < 2; ++n) {
                            const int f = cb + n * 16 + 4 * fq_e - 1152, kvh = f >> 6, d = f & 63;
                            bf16_t* bp; size_t T;
                            if (tok < NPROMPT) { const int b = tok >> 11, t = tok & 2047; T = 2048; bp = e.VT + ((size_t)(b * 2 + kvh) * 64 + d) * 2048 + t; }
                            else { const int b = (tok - NPROMPT) >> 12, t = tok & 4095; T = 4096; bp = e.VT + (size_t)NPROMPT * 128 + ((size_t)(b * 2 + kvh) * 64 + d) * 4096 + t; }
#pragma unroll
                            for (int j = 0; j < 4; ++j) bp[(size_t)j * T] = (bf16_t)(pk_bf16(acc[ai][bj][m][n][j], 0.f) & 0xffffu);
                        }
                    }
            } else {
                const int kind = (c64 < 256) ? 0 : ((c64 >= 1792 && c64 < 2048) ? 2 : 1);
#pragma unroll
                for (int ai = 0; ai < 2; ++ai)
#pragma unroll
                    for (int m = 0; m < 4; ++m) {
                        bf16_t* rowp = e.C + (size_t)(tok_w + ai * 128 + m * 16) * INW + cb + 4 * fq_e;
#pragma unroll
                        for (int n = 0; n < 2; ++n) {
                            float v[4];
#pragma unroll
                            for (int j = 0; j < 4; ++j) { const float x = acc[ai][bj][m][n][j]; v[j] = (kind == 0) ? x : ((kind == 2) ? x * (0.125f * L2E) : silu_f(x)); }
                            u32x2 o; o.x = pk_bf16(v[0], v[1]); o.y = pk_bf16(v[2], v[3]);
                            *(u32x2*)(rowp + n * 16) = o;
                        }
                    }
            }
        }
    }
}

#define SB_() __builtin_amdgcn_sched_barrier(0)
#define KFRAG(KS, KB) (*(const bf16x8*)(kp + (KB) * 4096 + k_off + ((((KS) * 2 + h) ^ kswz) << 4)))
#define VFRAG(KK, DB) (*(const bf16x8*)(vp + (DB) * 4096 + v_off + ((((KK) * 2 + h) ^ vswz) << 4)))
#define EXP4(S, I0) { _Pragma("unroll") for (int i_ = (I0); i_ < (I0) + 4; ++i_) { S[i_] = __builtin_amdgcn_exp2f(S[i_] - mb); rs += S[i_]; } }
#define EXP4F(S, I0) { f32x2_t a_ = {S[(I0)], S[(I0) + 1]}, b_ = {S[(I0) + 2], S[(I0) + 3]}; \
        a_ = a_ - (f32x2_t){mb, mb}; b_ = b_ - (f32x2_t){mb, mb}; \
        S[(I0)] = __builtin_amdgcn_exp2f(a_.x); S[(I0) + 1] = __builtin_amdgcn_exp2f(a_.y); S[(I0) + 2] = __builtin_amdgcn_exp2f(b_.x); S[(I0) + 3] = __builtin_amdgcn_exp2f(b_.y); \
        rs2 += (f32x2_t){S[(I0)], S[(I0) + 1]} + (f32x2_t){S[(I0) + 2], S[(I0) + 3]}; }
#define EXPQ(S, I0) { if (FIXM) EXP4F(S, I0) else EXP4(S, I0) }
#define PACK8(S, I0) ({ u32x4 t_; t_.x = pk_bf16(S[(I0)], S[(I0) + 1]); t_.y = pk_bf16(S[(I0) + 2], S[(I0) + 3]); t_.z = pk_bf16(S[(I0) + 4], S[(I0) + 5]); t_.w = pk_bf16(S[(I0) + 6], S[(I0) + 7]); __builtin_bit_cast(bf16x8, t_); })
DI float max8(const f32x16& s, int i0, float mx) {
    mx = fmaxf(fmaxf(mx, s[i0]), s[i0 + 1]); mx = fmaxf(fmaxf(mx, s[i0 + 2]), s[i0 + 3]);
    mx = fmaxf(fmaxf(mx, s[i0 + 4]), s[i0 + 5]); mx = fmaxf(fmaxf(mx, s[i0 + 6]), s[i0 + 7]);
    return mx;
}
#define EXP2F(S, I0) { S[(I0)] = __builtin_amdgcn_exp2f(S[(I0)]); S[(I0) + 1] = __builtin_amdgcn_exp2f(S[(I0) + 1]); rs += S[(I0)] + S[(I0) + 1]; \
        asm volatile("" : "+v"(S[(I0)]), "+v"(S[(I0) + 1]), "+v"(rs)); }
#define PIN1(X) asm volatile("" : "+v"(X))
template <bool DO_PV, bool DO_QK>
DI void attn_step_fix(f32x16& s0, f32x16& s1, f32x16& n0, f32x16& n1, const bf16x8 (&pp)[4], bf16x8 (&pc)[4],
                      f32x16& o0, f32x16& o1, const float m, float& lsum, const bf16x8 (&qf)[4],
                      const unsigned char* kp, const unsigned char* vp, int k_off, int kswz, int v_off, int vswz, int h) {
    bf16x8 va0, vb0, va1, vb1, va2, vb2, va3, vb3, ka0, kb0, ka1, kb1, ka2, kb2, ka3, kb3;
    float rs = 0.f;
    if (DO_PV) { va0 = VFRAG(0, 0); vb0 = VFRAG(0, 1); va1 = VFRAG(1, 0); vb1 = VFRAG(1, 1); }
    EXP2F(s0, 0);  if (DO_PV) { o0 = mfma32(va0, pp[0], o0); va2 = VFRAG(2, 0); vb2 = VFRAG(2, 1); } SB_();
    EXP2F(s0, 2);  if (DO_PV) { o1 = mfma32(vb0, pp[0], o1); va3 = VFRAG(3, 0); vb3 = VFRAG(3, 1); } SB_();
    EXP2F(s0, 4);  if (DO_PV) { o0 = mfma32(va1, pp[1], o0); } if (DO_QK) { ka0 = KFRAG(0, 0); kb0 = KFRAG(0, 1); } SB_();
    EXP2F(s0, 6);  if (DO_PV) { o1 = mfma32(vb1, pp[1], o1); } if (DO_QK) { ka1 = KFRAG(1, 0); kb1 = KFRAG(1, 1); } SB_();
    EXP2F(s0, 8);  if (DO_PV) { o0 = mfma32(va2, pp[2], o0); } SB_();
    EXP2F(s0, 10); if (DO_PV) { o1 = mfma32(vb2, pp[2], o1); } pc[0] = PACK8(s0, 0); PIN1(pc[0]); SB_();
    EXP2F(s0, 12); if (DO_PV) { o0 = mfma32(va3, pp[3], o0); } SB_();
    EXP2F(s0, 14); if (DO_PV) { o1 = mfma32(vb3, pp[3], o1); } SB_();
    EXP2F(s1, 0);  if (DO_QK) { n0 = mfma32(ka0, qf[0], (f32x16){0.f, 0.f, 0.f, 0.f, 0.f, 0.f, 0.f, 0.f, 0.f, 0.f, 0.f, 0.f, 0.f, 0.f, 0.f, 0.f}); ka2 = KFRAG(2, 0); kb2 = KFRAG(2, 1); } pc[1] = PACK8(s0, 8); PIN1(pc[1]); SB_();
    EXP2F(s1, 2);  if (DO_QK) { n1 = mfma32(kb0, qf[0], (f32x16){0.f, 0.f, 0.f, 0.f, 0.f, 0.f, 0.f, 0.f, 0.f, 0.f, 0.f, 0.f, 0.f, 0.f, 0.f, 0.f}); ka3 = KFRAG(3, 0); kb3 = KFRAG(3, 1); } SB_();
    EXP2F(s1, 4);  if (DO_QK) { n0 = mfma32(ka1, qf[1], n0); } SB_();
    EXP2F(s1, 6);  if (DO_QK) { n1 = mfma32(kb1, qf[1], n1); } SB_();
    EXP2F(s1, 8);  if (DO_QK) { n0 = mfma32(ka2, qf[2], n0); } pc[2] = PACK8(s1, 0); PIN1(pc[2]); SB_();
    EXP2F(s1, 10); if (DO_QK) { n1 = mfma32(kb2, qf[2], n1); } SB_();
    EXP2F(s1, 12); if (DO_QK) { n0 = mfma32(ka3, qf[3], n0); } SB_();
    EXP2F(s1, 14); if (DO_QK) { n1 = mfma32(kb3, qf[3], n1); } pc[3] = PACK8(s1, 8); PIN1(pc[3]);
    lsum += rs;
    SB_();
}
template <bool DO_PV, bool DO_QK, bool FIXM>
DI void attn_step(f32x16& s0, f32x16& s1, f32x16& n0, f32x16& n1, const bf16x8 (&pp)[4], bf16x8 (&pc)[4],
                  f32x16& o0, f32x16& o1, float& m, float& lsum, const bf16x8 (&qf)[4],
                  const unsigned char* kp, const unsigned char* vp, int k_off, int kswz, int v_off, int vswz, int h) {
    if (FIXM) { attn_step_fix<DO_PV, DO_QK>(s0, s1, n0, n1, pp, pc, o0, o1, m, lsum, qf, kp, vp, k_off, kswz, v_off, vswz, h); return; }
    bf16x8 va0, vb0, va1, vb1, va2, vb2, va3, vb3, ka0, kb0, ka1, kb1, ka2, kb2, ka3, kb3;
    if (DO_PV) { va0 = VFRAG(0, 0); vb0 = VFRAG(0, 1); va1 = VFRAG(1, 0); vb1 = VFRAG(1, 1); }
    float mx = s0[0];
    if (DO_PV) o0 = mfma32(va0, pp[0], o0);
    if (!FIXM) mx = max8(s0, 0, mx);
    SB_();
    if (DO_PV) { o1 = mfma32(vb0, pp[0], o1); va2 = VFRAG(2, 0); vb2 = VFRAG(2, 1); }
    if (!FIXM) mx = max8(s0, 8, mx);
    SB_();
    if (DO_PV) { o0 = mfma32(va1, pp[1], o0); va3 = VFRAG(3, 0); vb3 = VFRAG(3, 1); }
    if (!FIXM) mx = max8(s1, 0, mx);
    SB_();
    if (DO_PV) o1 = mfma32(vb1, pp[1], o1);
    bool need = false; float alpha = 1.0f;
    if (!FIXM) {
        mx = max8(s1, 8, mx);
        mx = xhalf_max(mx);
        need = mx > m + 8.0f;
        const float mnew = need ? mx : m;
        alpha = __builtin_amdgcn_exp2f(m - mnew);
        m = mnew;
    }
    const float mb = m;
    float rs = 0.f; f32x2_t rs2 = {0.f, 0.f};
    SB_();
    if (DO_PV) o0 = mfma32(va2, pp[2], o0);
    if (DO_QK) { ka0 = KFRAG(0, 0); kb0 = KFRAG(0, 1); }
    EXPQ(s0, 0);
    SB_();
    if (DO_PV) o1 = mfma32(vb2, pp[2], o1);
    if (DO_QK) { ka1 = KFRAG(1, 0); kb1 = KFRAG(1, 1); }
    EXPQ(s0, 4);
    SB_();
    if (DO_PV) o0 = mfma32(va3, pp[3], o0);
    EXPQ(s0, 8);
    SB_();
    if (DO_PV) o1 = mfma32(vb3, pp[3], o1);
    EXPQ(s0, 12);
    SB_();
    if (DO_QK) { n0 = mfma32(ka0, qf[0], (f32x16){0.f, 0.f, 0.f, 0.f, 0.f, 0.f, 0.f, 0.f, 0.f, 0.f, 0.f, 0.f, 0.f, 0.f, 0.f, 0.f}); ka2 = KFRAG(2, 0); kb2 = KFRAG(2, 1); }
    EXPQ(s1, 0);
    SB_();
    if (DO_QK) { n1 = mfma32(kb0, qf[0], (f32x16){0.f, 0.f, 0.f, 0.f, 0.f, 0.f, 0.f, 0.f, 0.f, 0.f, 0.f, 0.f, 0.f, 0.f, 0.f, 0.f}); ka3 = KFRAG(3, 0); kb3 = KFRAG(3, 1); }
    EXPQ(s1, 4);
    SB_();
    if (DO_QK) n0 = mfma32(ka1, qf[1], n0);
    EXPQ(s1, 8);
    SB_();
    if (DO_QK) n1 = mfma32(kb1, qf[1], n1);
    EXPQ(s1, 12);
    SB_();
    if (DO_QK) n0 = mfma32(ka2, qf[2], n0);
    pc[0] = PACK8(s0, 0);
    SB_();
    if (DO_QK) n1 = mfma32(kb2, qf[2], n1);
    pc[1] = PACK8(s0, 8);
    SB_();
    if (DO_QK) n0 = mfma32(ka3, qf[3], n0);
    pc[2] = PACK8(s1, 0);
    SB_();
    if (DO_QK) n1 = mfma32(kb3, qf[3], n1);
    pc[3] = PACK8(s1, 8);
    if (FIXM) lsum += rs2.x + rs2.y; else lsum = lsum * alpha + rs;
    SB_();
    if (!FIXM) {
        if (__builtin_amdgcn_ballot_w64(need)) {
#pragma unroll
            for (int i = 0; i < 16; ++i) { o0[i] *= alpha; o1[i] *= alpha; }
        }
    }
}

template <bool FIXM>
DI void attn_item(const bf16_t* __restrict__ Q, int ldq, const bf16_t* __restrict__ K, int ldk, const bf16_t* __restrict__ VT, int ldv,
                  int nkeys, bf16_t* __restrict__ O, const bf16_t* __restrict__ G, unsigned char* smem, float mfix) {
    const int tid = opaque_tid(), lane = tid & 63, wave = tid >> 6;
    const int r = lane & 31, h = lane >> 5;
    bf16x8 qf[4];
    {
        const bf16_t* qp = Q + (size_t)(wave * 32 + r) * ldq + h * 8;
#pragma unroll
        for (int ks = 0; ks < 4; ++ks) qf[ks] = *(const bf16x8*)(qp + ks * 16);
    }
    const int lrow = tid >> 3, lc = tid & 7;
    const bf16_t* Kg = K + (size_t)lrow * ldk + lc * 8;
    const bf16_t* Vg = VT + (size_t)lrow * ldv + lc * 8;
    const int st_off = lrow * 128 + ((lc ^ ((lrow >> 1) & 7)) << 4);
    const int pr = (r & ~12) | ((r & 4) << 1) | ((r & 8) >> 1);
    const int kswz = (pr >> 1) & 7, vswz = (r >> 1) & 7;
    const int k_off = pr * 128, v_off = r * 128;
    const int nt = nkeys >> 6;

    f32x16 o0, o1, sa0, sa1, sb0, sb1;
#pragma unroll
    for (int i = 0; i < 16; ++i) { o0[i] = 0.f; o1[i] = 0.f; }
    float m = FIXM ? mfix : -1e30f, lsum = 0.f;
    bf16x8 pa[4], pb[4];

    u32x4 rk, rv;
#define A_LOAD(U) { const int kt_ = ((U) + 2 < nt) ? (U) + 2 : nt - 1; rk = *(const u32x4*)(Kg + (size_t)(kt_ * 64) * ldk); rv = *(const u32x4*)(Vg + (U) * 64); }
#define A_STORE(OFF) { *(u32x4*)(smem + (OFF) + st_off) = rk; *(u32x4*)(smem + (OFF) + 8192 + st_off) = rv; }
    rk = *(const u32x4*)(Kg); rv = *(const u32x4*)(Kg + (size_t)64 * ldk);
    __syncthreads();
    A_STORE(16384);
    A_LOAD(0);
    A_STORE(0);
    A_LOAD(1);
    lds_barrier();
    {
        const unsigned char* kp = smem + 16384;
        sa0 = mfma32(KFRAG(0, 0), qf[0], (f32x16){0.f, 0.f, 0.f, 0.f, 0.f, 0.f, 0.f, 0.f, 0.f, 0.f, 0.f, 0.f, 0.f, 0.f, 0.f, 0.f});
        sa1 = mfma32(KFRAG(0, 1), qf[0], (f32x16){0.f, 0.f, 0.f, 0.f, 0.f, 0.f, 0.f, 0.f, 0.f, 0.f, 0.f, 0.f, 0.f, 0.f, 0.f, 0.f});
#pragma unroll
        for (int ks = 1; ks < 4; ++ks) { sa0 = mfma32(KFRAG(ks, 0), qf[ks], sa0); sa1 = mfma32(KFRAG(ks, 1), qf[ks], sa1); }
    }
    attn_step<false, true, FIXM>(sa0, sa1, sb0, sb1, pb, pa, o0, o1, m, lsum, qf, smem + 16384 + 8192, smem, k_off, kswz, v_off, vswz, h);
    lds_barrier();
    for (int t = 1; t < nt - 1; t += 2) {
        A_STORE(16384);
        A_LOAD(t + 1);
        SB_();
        attn_step<true, true, FIXM>(sb0, sb1, sa0, sa1, pa, pb, o0, o1, m, lsum, qf, smem, smem + 8192, k_off, kswz, v_off, vswz, h);
        lds_barrier();
        A_STORE(0);
        A_LOAD(t + 2);
        SB_();
        attn_step<true, true, FIXM>(sa0, sa1, sb0, sb1, pb, pa, o0, o1, m, lsum, qf, smem + 16384, smem + 16384 + 8192, k_off, kswz, v_off, vswz, h);
        lds_barrier();
    }
    A_STORE(16384);
    const bf16_t* gp = G + (size_t)(wave * 32 + r) * INW + 4 * h;
    u32x2 gga[4], ggb[4];
#pragma unroll
    for (int gq = 0; gq < 4; ++gq) { gga[gq] = *(const u32x2*)(gp + 8 * gq); ggb[gq] = *(const u32x2*)(gp + 32 + 8 * gq); }
    SB_();
    attn_step<true, false, FIXM>(sb0, sb1, sa0, sa1, pa, pb, o0, o1, m, lsum, qf, smem, smem + 8192, k_off, kswz, v_off, vswz, h);
    lds_barrier();
    {
        const unsigned char* vp = smem + 16384 + 8192;
#pragma unroll
        for (int kk = 0; kk < 4; ++kk) { o0 = mfma32(VFRAG(kk, 0), pb[kk], o0); o1 = mfma32(VFRAG(kk, 1), pb[kk], o1); }
    }
#undef A_LOAD
#undef A_STORE
    const float lt = x32_add(lsum);
    const float inv = 1.0f / lt;
    bf16_t* op = O + (size_t)(wave * 32 + r) * 1024 + 4 * h;
#pragma unroll
    for (int gq = 0; gq < 4; ++gq) {
        {
            const u32x2 gg = gga[gq];
            u32x2 w;
            w.x = pk_bf16(o0[4 * gq] * inv * bflo(gg.x), o0[4 * gq + 1] * inv * bfhi(gg.x));
            w.y = pk_bf16(o0[4 * gq + 2] * inv * bflo(gg.y), o0[4 * gq + 3] * inv * bfhi(gg.y));
            *(u32x2*)(op + 8 * gq) = w;
        }
        {
            const u32x2 gg = ggb[gq];
            u32x2 w;
            w.x = pk_bf16(o1[4 * gq] * inv * bflo(gg.x), o1[4 * gq + 1] * inv * bfhi(gg.x));
            w.y = pk_bf16(o1[4 * gq + 2] * inv * bflo(gg.y), o1[4 * gq + 3] * inv * bfhi(gg.y));
            *(u32x2*)(op + 32 + 8 * gq) = w;
        }
    }
}

DI void cross_item(const bf16_t* __restrict__ Q, const bf16_t* __restrict__ K, const bf16_t* __restrict__ VT,
                   bf16_t* __restrict__ O, const bf16_t* __restrict__ G, unsigned char* smem) {
    const int tid = opaque_tid(), lane = tid & 63, wave = tid >> 6;
    const int r = lane & 31, h = lane >> 5;
    bf16x8 qf[4];
    {
        const bf16_t* qp = Q + (size_t)(wave * 32 + r) * INW + h * 8;
#pragma unroll
        for (int ks = 0; ks < 4; ++ks) qf[ks] = *(const bf16x8*)(qp + ks * 16);
    }
    const int lrow = tid >> 3, lc = tid & 7;
    const int st_off = lrow * 128 + ((lc ^ ((lrow >> 1) & 7)) << 4);
    {
        u32x4 kk[4], vv[4];
#pragma unroll
        for (int i = 0; i < 4; ++i) { kk[i] = *(const u32x4*)(K + (size_t)(lrow + 64 * i) * 256 + lc * 8); vv[i] = *(const u32x4*)(VT + (size_t)lrow * 256 + (i * 8 + lc) * 8); }
        __syncthreads();
#pragma unroll
        for (int i = 0; i < 4; ++i) { *(u32x4*)(smem + i * 16384 + st_off) = kk[i]; *(u32x4*)(smem + i * 16384 + 8192 + st_off) = vv[i]; }
    }
    const bf16_t* gp = G + (size_t)(wave * 32 + r) * INW + 4 * h;
    u32x2 gga[4], ggb[4];
#pragma unroll
    for (int gq = 0; gq < 4; ++gq) { gga[gq] = *(const u32x2*)(gp + 8 * gq); ggb[gq] = *(const u32x2*)(gp + 32 + 8 * gq); }
    __syncthreads();
    const int pr = (r & ~12) | ((r & 4) << 1) | ((r & 8) >> 1);
    const int kswz = (pr >> 1) & 7, vswz = (r >> 1) & 7;
    const int k_off = pr * 128, v_off = r * 128;
    f32x16 o0, o1;
#pragma unroll
    for (int i = 0; i < 16; ++i) { o0[i] = 0.f; o1[i] = 0.f; }
    float m = -1e30f, lsum = 0.f;
#pragma unroll 1
    for (int kt = 0; kt < 4; ++kt) {
        const unsigned char* kp = smem + kt * 16384;
        const unsigned char* vp = kp + 8192;
        f32x16 s0, s1;
        s0 = mfma32(KFRAG(0, 0), qf[0], (f32x16){0.f, 0.f, 0.f, 0.f, 0.f, 0.f, 0.f, 0.f, 0.f, 0.f, 0.f, 0.f, 0.f, 0.f, 0.f, 0.f});
        s1 = mfma32(KFRAG(0, 1), qf[0], (f32x16){0.f, 0.f, 0.f, 0.f, 0.f, 0.f, 0.f, 0.f, 0.f, 0.f, 0.f, 0.f, 0.f, 0.f, 0.f, 0.f});
#pragma unroll
        for (int ks = 1; ks < 4; ++ks) { s0 = mfma32(KFRAG(ks, 0), qf[ks], s0); s1 = mfma32(KFRAG(ks, 1), qf[ks], s1); }
        float mx = s0[0];
        mx = max8(s0, 0, mx); mx = max8(s0, 8, mx); mx = max8(s1, 0, mx); mx = max8(s1, 8, mx);
        mx = xhalf_max(mx);
        const float mnew = fmaxf(m, mx);
        const float alpha = __builtin_amdgcn_exp2f(m - mnew);
        m = mnew;
        const float mb = mnew;
        float rs = 0.f;
#pragma unroll
        for (int i = 0; i < 16; ++i) { s0[i] = __builtin_amdgcn_exp2f(s0[i] - mb); s1[i] = __builtin_amdgcn_exp2f(s1[i] - mb); rs += s0[i] + s1[i]; }
        lsum = lsum * alpha + rs;
#pragma unroll
        for (int i = 0; i < 16; ++i) { o0[i] *= alpha; o1[i] *= alpha; }
        bf16x8 pf[4];
        pf[0] = PACK8(s0, 0); pf[1] = PACK8(s0, 8); pf[2] = PACK8(s1, 0); pf[3] = PACK8(s1, 8);
#pragma unroll
        for (int kk2 = 0; kk2 < 4; ++kk2) { o0 = mfma32(VFRAG(kk2, 0), pf[kk2], o0); o1 = mfma32(VFRAG(kk2, 1), pf[kk2], o1); }
    }
    const float lt = x32_add(lsum);
    const float inv = 1.0f / lt;
    bf16_t* op = O + (size_t)(wave * 32 + r) * 1024 + 4 * h;
#pragma unroll
    for (int gq = 0; gq < 4; ++gq) {
        {
            const u32x2 gg = gga[gq];
            u32x2 w;
            w.x = pk_bf16(o0[4 * gq] * inv * bflo(gg.x), o0[4 * gq + 1] * inv * bfhi(gg.x));
            w.y = pk_bf16(o0[4 * gq + 2] * inv * bflo(gg.y), o0[4 * gq + 3] * inv * bfhi(gg.y));
            *(u32x2*)(op + 8 * gq) = w;
        }
        {
            const u32x2 gg = ggb[gq];
            u32x2 w;
            w.x = pk_bf16(o1[4 * gq] * inv * bflo(gg.x), o1[4 * gq + 1] * inv * bfhi(gg.x));
            w.y = pk_bf16(o1[4 * gq + 2] * inv * bflo(gg.y), o1[4 * gq + 3] * inv * bfhi(gg.y));
            *(u32x2*)(op + 32 + 8 * gq) = w;
        }
    }
}

DI void pool_item(const bf16_t* __restrict__ Z, const bf16_t* __restrict__ PWT, const float* __restrict__ pscale, bf16_t* __restrict__ MIX,
                  int tokg0, unsigned char* smem) {
    const int tid = opaque_tid(), lane = tid & 63, wave = tid >> 6;
    const int T = (tokg0 < NPROMPT) ? 2048 : 4096;
    const int t0 = tokg0 & (T - 1);
    constexpr int RS = 528;
    const int g = wave & 3, half = 1 << g;
    const int r16 = lane & 15, q4 = lane >> 4;
    const bf16_t* pw = PWT + (size_t)g * 4096 + r16 * 64 + q4 * 8;
    bf16x8 wfr[4][2]; f32x4 psr[4]; u32x2 ggr[2][4];
#pragma unroll
    for (int fi = 0; fi < 4; ++fi) {
        psr[fi] = *(const f32x4*)(pscale + g * 64 + fi * 16 + 4 * q4);
#pragma unroll
        for (int ks = 0; ks < 2; ++ks) wfr[fi][ks] = *(const bf16x8*)(pw + fi * 16 * 64 + ks * 32);
#pragma unroll
        for (int t2 = 0; t2 < 2; ++t2) ggr[t2][fi] = *(const u32x2*)(Z + ((size_t)tokg0 + ((wave >> 2) * 2 + t2) * 16 + r16) * INW + 256 + g * 64 + fi * 16 + 4 * q4);
    }
    __syncthreads();
    for (int id = tid; id < 80 * 32; id += 512) {
        const int rr = id >> 5, c = id & 31;
        const int t = t0 - 8 + rr;
        u32x4 v = (u32x4){0u, 0u, 0u, 0u};
        if (t >= 0 && t < T) v = *(const u32x4*)(Z + (size_t)(tokg0 - 8 + rr) * INW + c * 8);
        *(u32x4*)(smem + rr * RS + c * 16) = v;
    }
    __syncthreads();
    {
        const int th = wave >> 2;
        bf16x8 df[2][2];
#pragma unroll
        for (int t2 = 0; t2 < 2; ++t2)
#pragma unroll
            for (int ks = 0; ks < 2; ++ks) {
                const int tl = (th * 2 + t2) * 16 + r16, t = t0 + tl;
                const int lo = max(t - half, 0), hi = min(t + half, T);
                const float icnt = 1.0f / (float)(hi - lo);
                float s[8];
#pragma unroll
                for (int j = 0; j < 8; ++j) s[j] = 0.f;
                const unsigned char* bp = smem + (tl + 8 - half) * RS + (g * 64 + ks * 32 + q4 * 8) * 2;
                for (int j = 0; j < 2 * half; ++j) {
                    const u32x4 v = *(const u32x4*)(bp + j * RS);
                    s[0] += bflo(v.x); s[1] += bfhi(v.x); s[2] += bflo(v.y); s[3] += bfhi(v.y);
                    s[4] += bflo(v.z); s[5] += bfhi(v.z); s[6] += bflo(v.w); s[7] += bfhi(v.w);
                }
                const u32x4 c = *(const u32x4*)(bp + half * RS);
                u32x4 o;
                o.x = pk_bf16(s[0] * icnt - bflo(c.x), s[1] * icnt - bfhi(c.x));
                o.y = pk_bf16(s[2] * icnt - bflo(c.y), s[3] * icnt - bfhi(c.y));
                o.z = pk_bf16(s[4] * icnt - bflo(c.z), s[5] * icnt - bfhi(c.z));
                o.w = pk_bf16(s[6] * icnt - bflo(c.w), s[7] * icnt - bfhi(c.w));
                df[t2][ks] = __builtin_bit_cast(bf16x8, o);
            }
        f32x4 acc[4][2];
#pragma unroll
        for (int i = 0; i < 4; ++i)
#pragma unroll
            for (int j = 0; j < 2; ++j) acc[i][j] = (f32x4){0.f, 0.f, 0.f, 0.f};
#pragma unroll
        for (int fi = 0; fi < 4; ++fi)
#pragma unroll
            for (int ks = 0; ks < 2; ++ks) {
                const bf16x8 wf = wfr[fi][ks];
#pragma unroll
                for (int t2 = 0; t2 < 2; ++t2) acc[fi][t2] = mfma16(wf, df[t2][ks], acc[fi][t2]);
            }
#pragma unroll
        for (int t2 = 0; t2 < 2; ++t2) {
            const size_t tok = (size_t)tokg0 + (th * 2 + t2) * 16 + r16;
#pragma unroll
            for (int fi = 0; fi < 4; ++fi) {
                const int n = g * 64 + fi * 16 + 4 * q4;
                const f32x4 ps = psr[fi];
                const u32x2 gg = ggr[t2][fi];
                u32x2 w;
                w.x = pk_bf16(acc[fi][t2][0] * ps[0] * bflo(gg.x), acc[fi][t2][1] * ps[1] * bfhi(gg.x));
                w.y = pk_bf16(acc[fi][t2][2] * ps[2] * bflo(gg.y), acc[fi][t2][3] * ps[3] * bfhi(gg.y));
                *(u32x2*)(MIX + tok * 1024 + n) = w;
            }
        }
    }
}

struct PostIn { u32x4 yv[2]; f32x4 xv[4]; };
DI PostIn post_row_load(const float* __restrict__ xsrc, const bf16_t* __restrict__ yh, int lane) {
    PostIn r;
#pragma unroll
    for (int j = 0; j < 2; ++j) r.yv[j] = *(const u32x4*)(yh + j * 512 + lane * 8);
#pragma unroll
    for (int j = 0; j < 2; ++j) { r.xv[2 * j] = *(const f32x4*)(xsrc + j * 512 + lane * 8); r.xv[2 * j + 1] = *(const f32x4*)(xsrc + j * 512 + lane * 8 + 4); }
    return r;
}
DI void post_row_finish(const PostIn& in, bf16_t* __restrict__ yh, const float* __restrict__ gpost, const float* __restrict__ gpre_next,
                        float* __restrict__ xdst, bool last, int lane) {
    u32x4 yv[2]; f32x4 xv[4];
#pragma unroll
    for (int j = 0; j < 2; ++j) yv[j] = in.yv[j];
#pragma unroll
    for (int j = 0; j < 4; ++j) xv[j] = in.xv[j];
    float y[16];
#pragma unroll
    for (int j = 0; j < 2; ++j) {
        y[8 * j + 0] = bflo(yv[j].x); y[8 * j + 1] = bfhi(yv[j].x); y[8 * j + 2] = bflo(yv[j].y); y[8 * j + 3] = bfhi(yv[j].y);
        y[8 * j + 4] = bflo(yv[j].z); y[8 * j + 5] = bfhi(yv[j].z); y[8 * j + 6] = bflo(yv[j].w); y[8 * j + 7] = bfhi(yv[j].w);
    }
    float ss = 0.f;
#pragma unroll
    for (int i = 0; i < 16; ++i) ss += y[i] * y[i];
    ss = wave_sum(ss);
    const float r = rsqrtf(ss * (1.0f / 1024.0f) + EPS);
    float xn[16]; float ss2 = 0.f;
#pragma unroll
    for (int j = 0; j < 2; ++j) {
        const f32x4 g0 = *(const f32x4*)(gpost + j * 512 + lane * 8), g1 = *(const f32x4*)(gpost + j * 512 + lane * 8 + 4);
#pragma unroll
        for (int i = 0; i < 4; ++i) {
            xn[8 * j + i] = xv[2 * j][i] + y[8 * j + i] * r * g0[i];
            xn[8 * j + 4 + i] = xv[2 * j + 1][i] + y[8 * j + 4 + i] * r * g1[i];
        }
    }
#pragma unroll
    for (int i = 0; i < 16; ++i) ss2 += xn[i] * xn[i];
#pragma unroll
    for (int j = 0; j < 2; ++j) {
        *(f32x4*)(xdst + j * 512 + lane * 8) = (f32x4){xn[8 * j], xn[8 * j + 1], xn[8 * j + 2], xn[8 * j + 3]};
        *(f32x4*)(xdst + j * 512 + lane * 8 + 4) = (f32x4){xn[8 * j + 4], xn[8 * j + 5], xn[8 * j + 6], xn[8 * j + 7]};
    }
    if (!last) {
        ss2 = wave_sum(ss2);
        const float r2 = rsqrtf(ss2 * (1.0f / 1024.0f) + EPS);
#pragma unroll
        for (int j = 0; j < 2; ++j) {
            const f32x4 g0 = *(const f32x4*)(gpre_next + j * 512 + lane * 8), g1 = *(const f32x4*)(gpre_next + j * 512 + lane * 8 + 4);
            u32x4 o;
            o.x = pk_bf16(xn[8 * j] * r2 * g0[0], xn[8 * j + 1] * r2 * g0[1]);
            o.y = pk_bf16(xn[8 * j + 2] * r2 * g0[2], xn[8 * j + 3] * r2 * g0[3]);
            o.z = pk_bf16(xn[8 * j + 4] * r2 * g1[0], xn[8 * j + 5] * r2 * g1[1]);
            o.w = pk_bf16(xn[8 * j + 6] * r2 * g1[2], xn[8 * j + 7] * r2 * g1[3]);
            *(u32x4*)(yh + j * 512 + lane * 8) = o;
        }
    }
}

#define XB_TMO      128
#define XB_XCNT(j)  (256  + 64 * (j))
#define XB_XSUB(j)  (1280 + 64 * (j))
#define XB_XGEN(j)  (2304 + 64 * (j))
#define XB_TOP      3328
#define XB_TOPGEN   3392
#define XCD_BAR_WORDS 3456
#define XB_SPIN_CAP (1u << 18)
#define LAS __attribute__((address_space(3)))
DI unsigned xb_ld(unsigned* p)              { return __hip_atomic_load(p, __ATOMIC_RELAXED, __HIP_MEMORY_SCOPE_AGENT); }
DI unsigned xb_add(unsigned* p, unsigned v) { return __hip_atomic_fetch_add(p, v, __ATOMIC_RELAXED, __HIP_MEMORY_SCOPE_AGENT); }
DI unsigned xb_xcc_id() { return (unsigned)__builtin_amdgcn_s_getreg((3 << 11) | 20) & 0xFu; }
#define XB_SPIN(cond, bar) do { unsigned _sp = 0; while (cond) { __builtin_amdgcn_s_sleep(1); \
    if ((++_sp & 255u) == 0u) { if (xb_ld(&(bar)[XB_TMO])) break; if (_sp > XB_SPIN_CAP) { atomicAdd(&(bar)[XB_TMO], 1u); break; } } } } while (0)
struct XcdBarrier { unsigned* bar; unsigned x; volatile LAS unsigned* st; };
DI XcdBarrier xcd_barrier_post(unsigned* bar, volatile LAS unsigned* st) {
    XcdBarrier b; b.bar = bar; b.x = xb_xcc_id(); b.st = st;
    if (threadIdx.x == 0) (void)xb_add(&bar[XB_XCNT(b.x)], 1u);
    return b;
}
DI void xcd_barrier_complete(unsigned* bar, unsigned x, unsigned& nloc, unsigned& nx) {
    const unsigned G = gridDim.x * gridDim.y * gridDim.z;
    unsigned sum, cnt, mine, sp = 0u;
    for (;;) {
        sum = 0u; cnt = 0u; mine = 0u;
#pragma unroll
        for (unsigned j = 0; j < 16; ++j) { const unsigned c = xb_ld(&bar[XB_XCNT(j)]); sum += c; cnt += (c > 0u) ? 1u : 0u; mine = (j == x) ? c : mine; }
        if (sum == G) break;
        __builtin_amdgcn_s_sleep(1);
        if ((++sp & 255u) == 0u) { if (xb_ld(&bar[XB_TMO])) break; if (sp > XB_SPIN_CAP) { atomicAdd(&bar[XB_TMO], 1u); break; } }
    }
    nloc = mine > 0u ? mine : 1u; nx = cnt > 0u ? cnt : 1u;
}
DI void xcd_barrier(const XcdBarrier& b) {
    asm volatile("s_waitcnt vmcnt(0)" ::: "memory");
    __syncthreads();
    if (threadIdx.x == 0) {
        unsigned* bar = b.bar;
        __builtin_amdgcn_s_waitcnt(0);
        unsigned nloc = b.st[0], nx = b.st[1];
        if (nloc == 0u) { xcd_barrier_complete(bar, b.x, nloc, nx); b.st[0] = nloc; b.st[1] = nx; }
        const unsigned old = xb_add(&bar[XB_XSUB(b.x)], 1u);
        const unsigned gen = old / nloc;
        if (old + 1u == (gen + 1u) * nloc) {
            __builtin_amdgcn_fence(__ATOMIC_RELEASE, "agent");
            asm volatile("s_waitcnt vmcnt(0)" ::: "memory");
            const unsigned og = xb_add(&bar[XB_TOP], 1u);
            const unsigned tg = og / nx;
            if (og + 1u == (tg + 1u) * nx) xb_add(&bar[XB_TOPGEN], 1u);
            else XB_SPIN(xb_ld(&bar[XB_TOPGEN]) == tg, bar);
            __builtin_amdgcn_fence(__ATOMIC_ACQUIRE, "agent");
            xb_add(&bar[XB_XGEN(b.x)], 1u);
            asm volatile("s_waitcnt vmcnt(0)" ::: "memory");
        } else {
            XB_SPIN(xb_ld(&bar[XB_XGEN(b.x)]) == gen, bar);
            __builtin_amdgcn_fence(__ATOMIC_ACQUIRE, "agent");
            asm volatile("s_waitcnt vmcnt(0)" ::: "memory");
        }
    }
    __syncthreads();
}

__global__ void __launch_bounds__(512, 2) fwd_megakernel(Params p) {
    __shared__ __attribute__((aligned(16))) unsigned char smem[131072];
    __shared__ uint4 xb_words;
    cg::grid_group grid = cg::this_grid();
    const int nb = gridDim.x, bid = blockIdx.x;
    if (threadIdx.x == 0) xb_words = make_uint4(0u, 0u, 0u, 0u);
    __syncthreads();
    XcdBarrier xb = xcd_barrier_post((unsigned*)(p.ws + OFF_BAR), (volatile LAS unsigned*)&xb_words);
    if (p.phase_end > 1000) grid.sync();
    for (int ph = p.phase_begin; ph < p.phase_end; ++ph) {
        unsigned char* ws = p.ws;
        bf16_t* H = (bf16_t*)(ws + OFF_H);
        bf16_t* Z = (bf16_t*)(ws + OFF_Z);
        bf16_t* VT = (bf16_t*)(ws + OFF_VT);
        bf16_t* MIX = (bf16_t*)(ws + OFF_MIX);
        bf16_t* WIN = (bf16_t*)(ws + OFF_WIN);
        bf16_t* WOUT = (bf16_t*)(ws + OFF_WOUT);
        bf16_t* WMEM = (bf16_t*)(ws + OFF_WMEM);
        bf16_t* PW = (bf16_t*)(ws + OFF_PW);
        bf16_t* MH = (bf16_t*)(ws + OFF_MH);
        bf16_t* KM = (bf16_t*)(ws + OFF_KM);
        bf16_t* VMT = (bf16_t*)(ws + OFF_VMT);
        float* ROPE = (float*)(ws + OFF_ROPE);
        if (ph == 0) {
            for (int i = bid; i < 1928; i += nb) {
                if (i < 1152) { const int l = i / 576, j = i % 576, kt = j / 36, ntile = j % 36;
                    transpose_tile(p.w_in + (size_t)l * DM * INW, INW, WIN + (size_t)l * INW * DM, DM, kt * 64, ntile * 64, smem);
                } else if (i < 1664) { const int ii = i - 1152, l = ii / 256, j = ii % 256, kt = j / 16, ntile = j % 16;
                    transpose_tile(p.w_out + (size_t)l * DM * DM, DM, WOUT + (size_t)l * DM * DM, DM, kt * 64, ntile * 64, smem);
                } else if (i < 1920) { const int ii = i - 1664, l = ii / 128, j = ii % 128, kt = j / 8, ntile = j % 8;
                    transpose_tile(p.w_mem_kv + (size_t)l * DM * 512, 512, WMEM + (size_t)l * 512 * DM, DM, kt * 64, ntile * 64, smem);
                } else { const int ii = i - 1920;
                    transpose_tile(p.pool_w + (size_t)ii * 4096, 64, PW + (size_t)ii * 4096, 64, 0, 0, smem);
                }
            }
            {
                const int tid = opaque_tid(), lane = tid & 63, wave = tid >> 6;
                constexpr int NR = NTOK + 2 * NMEMTOK;
                auto desc = [&](int i, const float*& src, const float*& g, bf16_t*& dst) {
                    if (i < NTOK) { src = (i < NPROMPT) ? p.x_prompt + (size_t)i * DM : p.x_sample + (size_t)(i - NPROMPT) * DM; g = p.norm_pre; dst = H + (size_t)i * DM; }
                    else { const int ii = i - NTOK, l = ii / NMEMTOK, mt = ii % NMEMTOK;
                           src = (mt < 4096) ? p.mem_prompt + (size_t)mt * DM : p.mem_sample + (size_t)(mt - 4096) * DM; g = p.mem_norm + l * DM; dst = MH + ((size_t)l * NMEMTOK + mt) * DM; }
                };
                int i = bid * 8 + wave;
                if (i < NR) {
                    const float *s, *g; bf16_t* d; desc(i, s, g, d);
                    RowIn cur = rms_row_load(s, lane);
                    for (; i < NR; i += nb * 8) {
                        const int in = (i + nb * 8 < NR) ? i + nb * 8 : NR - 1;
                        const float *s2, *g2; bf16_t* d2; desc(in, s2, g2, d2);
                        const RowIn nxt = rms_row_load(s2, lane);
                        rms_row_finish(cur, g, d, lane);
                        cur = nxt; g = g2; d = d2;
                    }
                }
            }
            { const int tid = opaque_tid(); for (int i = bid * 512 + tid; i < 1024; i += nb * 512) rope_entry(i, ROPE); }
        } else {
            const int l = (ph - 1) >> 2, sub = (ph - 1) & 3;
            if (sub == 0) {
                EpiArgs e; e.C = Z; e.VT = VT; e.qn = p.q_norm + l * 64; e.kn = p.k_norm + l * 64; e.rope = ROPE;
                const bf16_t* Wl = WIN + (size_t)l * INW * DM;
                EpiArgs e2; e2.C = KM + (size_t)l * NMEMTOK * 256; e2.VT = VMT + (size_t)l * NMEMTOK * 256; e2.qn = nullptr; e2.kn = nullptr; e2.rope = nullptr;
                const bf16_t* Wm = WMEM + (size_t)l * 512 * DM;
                const bf16_t* Am = MH + (size_t)l * NMEMTOK * DM;
                auto tile1 = [&](int i, const bf16_t*& ta, const bf16_t*& tb, int& tm0, int& tn0) {
                    if (i < 1728) {
                        const int j = i >> 3, mg = j / 72, rem = j % 72;
                        tm0 = ((i & 7) * 24 + mg * 8 + (rem & 7)) * 256; tn0 = (rem >> 3) * 256; ta = H; tb = Wl;
                    } else { const int j = i - 1728; tm0 = (j >> 1) * 256; tn0 = (j & 1) * 256; ta = Am; tb = Wm; }
                };
                bool pre = false;
                for (int i = bid; i < 1728 + 40; i += nb) {
                    const bf16_t *ta, *tb, *na = nullptr, *nbp = nullptr; int tm0, tn0, xm = 0, xn = 0;
                    tile1(i, ta, tb, tm0, tn0);
                    if (i + nb < 1728 + 40) tile1(i + nb, na, nbp, xm, xn);
                    if (i < 1728) gemm_tile<0>(ta, tb, tm0, tn0, e, smem, pre, na, nbp, xm, xn);
                    else gemm_tile<2>(ta, tb, tm0, tn0, e2, smem, pre, na, nbp, xm, xn);
                    pre = (na != nullptr);
                }
            } else if (sub == 1) {
                const int lane = opaque_tid() & 63;
                float gq = fabsf(p.q_norm[l * 64 + lane]), gk = fabsf(p.k_norm[l * 64 + lane]);
                gq = wave_max(gq); gk = wave_max(gk);
                const float mfix = 8.0f * gq * gk * 1.02f * L2E;
                const bool fixm = mfix < 28.0f;
                for (int i = bid; i < 3072; i += nb) {
                    if (i < 1536) {
                        int b, kvh, j, T; size_t tok0, vtb;
                        if (i < 512) { const int R = i >> 8, ip = i & 255, grp = ip & 7; j = R * 32 + (ip >> 3); b = grp >> 1; kvh = grp & 1; T = 4096;
                            tok0 = (size_t)NPROMPT + (size_t)b * 4096; vtb = (size_t)NPROMPT * 128 + ((size_t)(b * 2 + kvh) * 64) * 4096; }
                        else { const int ii = i - 512, R = ii >> 8, ip = ii & 255, grp = R * 8 + (ip & 7); j = ip >> 3; b = grp >> 1; kvh = grp & 1; T = 2048;
                            tok0 = (size_t)b * 2048; vtb = ((size_t)(b * 2 + kvh) * 64) * 2048; }
                        const int qblk = j >> 2, head = kvh * 4 + (j & 3);
                        const size_t q0 = tok0 + (size_t)qblk * 256;
                        if (fixm) attn_item<true>(Z + q0 * INW + 512 + head * 64, INW, Z + tok0 * INW + 1024 + kvh * 64, INW, VT + vtb, T, T,
                                  MIX + q0 * 1024 + 256 + head * 64, Z + q0 * INW + 1280 + head * 64, smem, mfix);
                        else attn_item<false>(Z + q0 * INW + 512 + head * 64, INW, Z + tok0 * INW + 1024 + kvh * 64, INW, VT + vtb, T, T,
                                  MIX + q0 * 1024 + 256 + head * 64, Z + q0 * INW + 1280 + head * 64, smem, 0.f);
                    } else if (i < 2304) {
                        const int ii = i - 1536, qb = ii >> 2, hx = ii & 3;
                        const size_t q0 = (size_t)qb * 256;
                        const int b = (q0 < NPROMPT) ? (int)(q0 >> 11) : 16 + (int)((q0 - NPROMPT) >> 12);
cross_item(Z + q0 * INW + 1792 + hx * 64, KM + ((size_t)l * NMEMTOK + (size_t)b * 256) * 256 + hx * 64,
                                   VMT + (size_t)l * NMEMTOK * 256 + ((size_t)(b * 4 + hx) * 64) * 256,
                                   MIX + q0 * 1024 + 768 + hx * 64, Z + q0 * INW + 2048 + hx * 64, smem);
                    } else {
                        pool_item(Z, PW + (size_t)l * 4 * 4096, p.pool_scale + l * 256, MIX, (i - 2304) * 64, smem);
                    }
                }
            } else if (sub == 2) {
                EpiArgs e; e.C = H; e.VT = nullptr; e.qn = nullptr; e.kn = nullptr; e.rope = nullptr;
                const bf16_t* Wl = WOUT + (size_t)l * DM * DM;
                auto tile2 = [&](int i, int& tm0, int& tn0) {
                    const int j = i >> 3, mg = j >> 5, rem = j & 31;
                    tm0 = ((i & 7) * 24 + mg * 8 + (rem & 7)) * 256; tn0 = (rem >> 3) * 256;
                };
                bool pre = false;
                for (int i = bid; i < 768; i += nb) {
                    int tm0, tn0, xm = 0, xn = 0; tile2(i, tm0, tn0);
                    const bool more = (i + nb < 768);
                    if (more) tile2(i + nb, xm, xn);
                    gemm_tile<1>(MIX, Wl, tm0, tn0, e, smem, pre, more ? MIX : nullptr, Wl, xm, xn);
                    pre = more;
                }
            } else {
                const bool last = (l == DEPTH - 1);
                auto xsrc = [&](int i) -> const float* {
                    return (l == 0) ? ((i < NPROMPT) ? p.x_prompt + (size_t)i * DM : p.x_sample + (size_t)(i - NPROMPT) * DM) : p.out + (size_t)i * DM; };
                const int tid = opaque_tid(), lane = tid & 63, wave = tid >> 6;
                int i = bid * 8 + wave;
                if (i < NTOK) {
                    PostIn cur = post_row_load(xsrc(i), H + (size_t)i * DM, lane);
                    for (; i < NTOK; i += nb * 8) {
                        const int in = (i + nb * 8 < NTOK) ? i + nb * 8 : i;
                        const PostIn nxt = post_row_load(xsrc(in), H + (size_t)in * DM, lane);
                        post_row_finish(cur, H + (size_t)i * DM, p.norm_post + l * DM, p.norm_pre + (last ? l : l + 1) * DM, p.out + (size_t)i * DM, last, lane);
                        cur = nxt;
                    }
                }
            }
        }
        if (ph + 1 < p.phase_end) xcd_barrier(xb);
    }
}

extern "C" void kernel_launch(void* const* d_in, const int* in_sizes, int n_in, void* d_out, int out_size, void* d_ws, size_t ws_size,
                              hipStream_t stream) {
    static int grid_blocks = 0;
    if (!grid_blocks) {
        int dev = 0, cus = 0, per_cu = 0;
        hipGetDevice(&dev);
        hipDeviceGetAttribute(&cus, hipDeviceAttributeMultiprocessorCount, dev);
        hipOccupancyMaxActiveBlocksPerMultiprocessor(&per_cu, fwd_megakernel, 512, 0);
        if (per_cu > 1) per_cu = 1;
        if (per_cu < 1) per_cu = 1;
        grid_blocks = cus * per_cu;
    }
    Params p{};
    p.x_prompt = (const float*)d_in[0]; p.x_sample = (const float*)d_in[1]; p.mem_prompt = (const float*)d_in[2]; p.mem_sample = (const float*)d_in[3];
    p.norm_pre = (const float*)d_in[4]; p.norm_post = (const float*)d_in[5]; p.w_in = (const float*)d_in[6]; p.pool_w = (const float*)d_in[7];
    p.pool_scale = (const float*)d_in[8]; p.q_norm = (const float*)d_in[9]; p.k_norm = (const float*)d_in[10]; p.mem_norm = (const float*)d_in[11];
    p.w_mem_kv = (const float*)d_in[12]; p.w_out = (const float*)d_in[13];
    p.out = (float*)d_out; p.ws = (unsigned char*)d_ws;
    p.phase_begin = 0; p.phase_end = 1 + 4 * DEPTH;
    if (ws_size < WS_TOTAL) { fprintf(stderr, "workspace too small: %zu < %zu\n", ws_size, (size_t)WS_TOTAL); return; }
    hipMemsetAsync((unsigned char*)d_ws + OFF_BAR, 0, BAR_BYTES, stream);
    void* args[] = {&p};
    hipError_t e = hipLaunchCooperativeKernel((void*)fwd_megakernel, dim3(grid_blocks), dim3(512), args, 0, stream);
    if (e != hipSuccess) fprintf(stderr, "cooperative launch failed: %s (grid %d)\n", hipGetErrorString(e), grid_blocks);
}
```

```cpp
#include <hip/hip_runtime.h>
#include <hip/hip_cooperative_groups.h>
#include <stdint.h>
#include <cstdio>
namespace cg = cooperative_groups;

typedef unsigned short bf16_t;
typedef short bf16x8 __attribute__((ext_vector_type(8)));
typedef float f32x4 __attribute__((ext_vector_type(4)));
typedef float f32x16 __attribute__((ext_vector_type(16)));
typedef unsigned u32x4 __attribute__((ext_vector_type(4)));
typedef unsigned u32x2 __attribute__((ext_vector_type(2)));
typedef __bf16 bf16x2_t __attribute__((ext_vector_type(2)));
typedef float f32x2_t __attribute__((ext_vector_type(2)));
#define DI __device__ __forceinline__

constexpr int NTOK = 49152;
constexpr int NPROMPT = 32768;
constexpr int DM = 1024;
constexpr int INW = 2304;
constexpr int NMEMTOK = 5120;
constexpr int DEPTH = 2;
constexpr float EPS = 1e-6f;
constexpr float L2E = 1.4426950408889634f;

constexpr size_t OFF_H    = 0;
constexpr size_t OFF_Z    = OFF_H + (size_t)NTOK * DM * 2;
constexpr size_t OFF_VT   = OFF_Z + (size_t)NTOK * INW * 2;
constexpr size_t OFF_MIX  = OFF_VT + (size_t)NTOK * 128 * 2;
constexpr size_t OFF_WIN  = OFF_MIX + (size_t)NTOK * DM * 2;
constexpr size_t OFF_WOUT = OFF_WIN + (size_t)DEPTH * INW * DM * 2;
constexpr size_t OFF_WMEM = OFF_WOUT + (size_t)DEPTH * DM * DM * 2;
constexpr size_t OFF_PW   = OFF_WMEM + (size_t)DEPTH * 512 * DM * 2;
constexpr size_t OFF_MH   = OFF_PW + (size_t)DEPTH * 4 * 64 * 64 * 2;
constexpr size_t OFF_KM   = OFF_MH + (size_t)DEPTH * NMEMTOK * DM * 2;
constexpr size_t OFF_VMT  = OFF_KM + (size_t)DEPTH * NMEMTOK * 256 * 2;
constexpr size_t OFF_ROPE = OFF_VMT + (size_t)DEPTH * NMEMTOK * 256 * 2;
constexpr size_t OFF_BAR  = OFF_ROPE + 64 * 16 * 2 * 4;
constexpr size_t BAR_BYTES = 3456 * 4;
constexpr size_t WS_TOTAL = OFF_BAR + BAR_BYTES;

struct Params {
    const float* x_prompt; const float* x_sample; const float* mem_prompt; const float* mem_sample;
    const float* norm_pre; const float* norm_post; const float* w_in; const float* pool_w; const float* pool_scale;
    const float* q_norm; const float* k_norm; const float* mem_norm; const float* w_mem_kv; const float* w_out;
    float* out; unsigned char* ws;
    int phase_begin; int phase_end;
};

DI unsigned pk_bf16(float a, float b) {
    f32x2_t v = {a, b};
    bf16x2_t r = __builtin_convertvector(v, bf16x2_t);
    return __builtin_bit_cast(unsigned, r);
}
DI int opaque_tid() { int t = threadIdx.x; asm volatile("" : "+v"(t)); return t; }
DI void lds_barrier() { asm volatile("s_waitcnt lgkmcnt(0)\n\ts_barrier" ::: "memory"); }
DI float bflo(unsigned u) { return __uint_as_float(u << 16); }
DI float bfhi(unsigned u) { return __uint_as_float(u & 0xffff0000u); }
template <int CTRL> DI float dppf(float v) { return __uint_as_float(__builtin_amdgcn_update_dpp(0u, __float_as_uint(v), CTRL, 0xf, 0xf, true)); }
DI float x16_add(float v) { auto r = __builtin_amdgcn_permlane16_swap(__float_as_uint(v), __float_as_uint(v), false, false); return __uint_as_float(r[0]) + __uint_as_float(r[1]); }
DI float x32_add(float v) { auto r = __builtin_amdgcn_permlane32_swap(__float_as_uint(v), __float_as_uint(v), false, false); return __uint_as_float(r[0]) + __uint_as_float(r[1]); }
DI float x16_max(float v) { auto r = __builtin_amdgcn_permlane16_swap(__float_as_uint(v), __float_as_uint(v), false, false); return fmaxf(__uint_as_float(r[0]), __uint_as_float(r[1])); }
DI float x32_max(float v) { auto r = __builtin_amdgcn_permlane32_swap(__float_as_uint(v), __float_as_uint(v), false, false); return fmaxf(__uint_as_float(r[0]), __uint_as_float(r[1])); }
DI float wave_sum(float v) {
    v += dppf<0xB1>(v); v += dppf<0x4E>(v); v += dppf<0x141>(v); v += dppf<0x140>(v);
    v = x16_add(v); v = x32_add(v);
    return v;
}
DI float wave_max(float v) {
    v = fmaxf(v, dppf<0xB1>(v)); v = fmaxf(v, dppf<0x4E>(v)); v = fmaxf(v, dppf<0x141>(v)); v = fmaxf(v, dppf<0x140>(v));
    v = x16_max(v); v = x32_max(v);
    return v;
}
DI float xhalf_max(float v) {
    auto r = __builtin_amdgcn_permlane32_swap(__float_as_uint(v), __float_as_uint(v), false, false);
    return fmaxf(__uint_as_float(r[0]), __uint_as_float(r[1]));
}
DI float silu_f(float x) { return x * __builtin_amdgcn_rcpf(1.0f + __builtin_amdgcn_exp2f(-x * L2E)); }
DI f32x4 mfma16(bf16x8 a, bf16x8 b, f32x4 c) { return __builtin_amdgcn_mfma_f32_16x16x32_bf16(a, b, c, 0, 0, 0); }
DI f32x16 mfma32(bf16x8 a, bf16x8 b, f32x16 c) { return __builtin_amdgcn_mfma_f32_32x32x16_bf16(a, b, c, 0, 0, 0); }

DI void transpose_tile(const float* __restrict__ src, int ldn, bf16_t* __restrict__ dst, int ldk, int k0, int n0, unsigned char* smem) {
    float* tile = (float*)smem;
    const int tid = opaque_tid();
    __syncthreads();
#pragma unroll
    for (int i = 0; i < 2; ++i) {
        const int id = tid + 512 * i, r = id >> 4, c4 = id & 15;
        const f32x4 v = *(const f32x4*)(src + (size_t)(k0 + r) * ldn + n0 + c4 * 4);
        tile[r * 65 + c4 * 4 + 0] = v[0]; tile[r * 65 + c4 * 4 + 1] = v[1]; tile[r * 65 + c4 * 4 + 2] = v[2]; tile[r * 65 + c4 * 4 + 3] = v[3];
    }
    __syncthreads();
    {
        const int n = tid >> 3, kc = tid & 7;
        float v[8];
#pragma unroll
        for (int j = 0; j < 8; ++j) v[j] = tile[(kc * 8 + j) * 65 + n];
        u32x4 o; o.x = pk_bf16(v[0], v[1]); o.y = pk_bf16(v[2], v[3]); o.z = pk_bf16(v[4], v[5]); o.w = pk_bf16(v[6], v[7]);
        *(u32x4*)(dst + (size_t)(n0 + n) * ldk + k0 + kc * 8) = o;
    }
}

struct RowIn { f32x4 v[4]; };
DI RowIn rms_row_load(const float* __restrict__ src, int lane) {
    RowIn r;
#pragma unroll
    for (int j = 0; j < 2; ++j) { r.v[2 * j] = *(const f32x4*)(src + j * 512 + lane * 8); r.v[2 * j + 1] = *(const f32x4*)(src + j * 512 + lane * 8 + 4); }
    return r;
}
DI void rms_row_finish(const RowIn& in, const float* __restrict__ g, bf16_t* __restrict__ dst, int lane) {
    f32x4 v[4]; float ss = 0.f;
#pragma unroll
    for (int j = 0; j < 4; ++j) { v[j] = in.v[j]; ss += v[j][0] * v[j][0] + v[j][1] * v[j][1] + v[j][2] * v[j][2] + v[j][3] * v[j][3]; }
    ss = wave_sum(ss);
    const float r = rsqrtf(ss * (1.0f / 1024.0f) + EPS);
#pragma unroll
    for (int j = 0; j < 2; ++j) {
        const f32x4 g0 = *(const f32x4*)(g + j * 512 + lane * 8), g1 = *(const f32x4*)(g + j * 512 + lane * 8 + 4);
        const f32x4 a = v[2 * j], b = v[2 * j + 1];
        u32x4 o;
        o.x = pk_bf16(a[0] * r * g0[0], a[1] * r * g0[1]); o.y = pk_bf16(a[2] * r * g0[2], a[3] * r * g0[3]);
        o.z = pk_bf16(b[0] * r * g1[0], b[1] * r * g1[1]); o.w = pk_bf16(b[2] * r * g1[2], b[3] * r * g1[3]);
        *(u32x4*)(dst + j * 512 + lane * 8) = o;
    }
}

DI void rope_entry(int idx, float* table) {
    const int n = idx >> 4, pp = idx & 15;
    double fd = 1.0;
    for (int i = 0; i < pp; ++i) fd *= 0.5623413251903491;
    const float f = (float)fd;
    const float a = (float)n * f;
    double r = (double)a;
    const double k = rint(r * 0.15915494309189535);
    r -= k * 6.283185307179586;
    const double r2 = r * r;
    double sn = r, cs = 1.0, ts = r, tc = 1.0;
    for (int i = 1; i <= 16; ++i) {
        tc = -tc * r2 / (double)((2 * i - 1) * (2 * i));
        ts = -ts * r2 / (double)((2 * i) * (2 * i + 1));
        cs += tc; sn += ts;
    }
    table[idx * 2] = (float)cs; table[idx * 2 + 1] = (float)sn;
}

struct EpiArgs {
    bf16_t* C;
    bf16_t* VT;
    const float* qn; const float* kn; const float* rope;
};

DI int g8_lds_byte(int r, int c) { const int st = (r >> 4) * 2 + (c >> 5), rr = r & 15, cc = c & 31, ob = rr * 64 + cc * 2; return st * 1024 + (ob ^ (((ob >> 9) & 1) << 5)); }
DI void g8_stage_rc(int b, int& R, int& C) { const int st = b >> 10, sb = b & 1023, swz = sb ^ (((sb >> 9) & 1) << 5); R = (st >> 1) * 16 + (swz >> 6); C = (st & 1) * 32 + ((swz & 63) >> 1); }

DI const unsigned char* uniform_ptr(const void* p) {
    const unsigned long long v = (unsigned long long)p;
    const unsigned lo = __builtin_amdgcn_readfirstlane((unsigned)v), hi = __builtin_amdgcn_readfirstlane((unsigned)(v >> 32));
    return (const unsigned char*)(((unsigned long long)hi << 32) | lo);
}

template <int MODE>
DI void gemm_tile(const bf16_t* __restrict__ A, const bf16_t* __restrict__ Bt, int m0, int n0, const EpiArgs& e, unsigned char* smem,
                  bool prefetched, const bf16_t* __restrict__ nA, const bf16_t* __restrict__ nB, int nm0, int nn0, bool nperm) {
    constexpr int K = 1024, BK = 64, HALF = 128, HTB = 16384, nt = K / BK;
    const int tid = opaque_tid(), lane = tid & 63, wave = __builtin_amdgcn_readfirstlane(tid >> 6);
    const int wr = wave >> 2, wc = wave & 3, fr = lane & 15, fq = lane >> 4;
    int sR0, sC0, sR1, sC1;
    g8_stage_rc(tid * 16, sR0, sC0); g8_stage_rc(tid * 16 + 8192, sR1, sC1);
    const unsigned so0b = (unsigned)(sR0 * K + sC0) * 2u, so1b = (unsigned)(sR1 * K + sC1) * 2u;
    const bool perm = (MODE == 1) ? true : ((MODE == 2) ? (n0 == 0) : !(n0 >= 512 && n0 < 1152));
    __attribute__((address_space(3))) unsigned char* lds = (__attribute__((address_space(3))) unsigned char*)smem;
#define G8_SA(b, h) (((b) * 2 + (h)) * HTB)
#define G8_SB(b, h) ((4 + (b) * 2 + (h)) * HTB)
#define G8_PERMOFF(SO) ({ const unsigned R_ = (SO) >> 11, rho_ = R_ & 31u, i_ = rho_ & 15u; const unsigned p_ = 8u * (i_ >> 2) + 4u * (rho_ >> 4) + (i_ & 3u); (SO) + (p_ - rho_) * 2048u; })
#define G8_STAGE_B(POFF, BASE, br, kt, PERM) { const unsigned char* g_ = uniform_ptr((BASE) + (size_t)(br) * K + (kt) * BK); \
        const unsigned b0_ = (PERM) ? G8_PERMOFF(so0b) : so0b, b1_ = (PERM) ? G8_PERMOFF(so1b) : so1b; \
        __builtin_amdgcn_global_load_lds((const __attribute__((address_space(1))) unsigned*)(g_ + b0_), (__attribute__((address_space(3))) unsigned*)(lds + (POFF) + tid * 16), 16, 0, 0); \
        __builtin_amdgcn_global_load_lds((const __attribute__((address_space(1))) unsigned*)(g_ + b1_), (__attribute__((address_space(3))) unsigned*)(lds + (POFF) + tid * 16 + 8192), 16, 0, 0); }
#define G8_STAGE(POFF, BASE, br, kt) { const unsigned char* g_ = uniform_ptr((BASE) + (size_t)(br) * K + (kt) * BK); \
        __builtin_amdgcn_global_load_lds((const __attribute__((address_space(1))) unsigned*)(g_ + so0b), (__attribute__((address_space(3))) unsigned*)(lds + (POFF) + tid * 16), 16, 0, 0); \
        __builtin_amdgcn_global_load_lds((const __attribute__((address_space(1))) unsigned*)(g_ + so1b), (__attribute__((address_space(3))) unsigned*)(lds + (POFF) + tid * 16 + 8192), 16, 0, 0); }
    const int lane_off = (fr * 64 + fq * 16) ^ ((fr >> 3) << 5);
    const unsigned ldsA = (unsigned)(size_t)lds + (unsigned)(lane_off + wr * 8192);
    const unsigned ldsB = (unsigned)(size_t)lds + (unsigned)(lane_off + wc * 4096);
#define G8_DSR(dst, addr, OFF) asm volatile("ds_read_b128 %0, %1 offset:" #OFF : "=v"(dst) : "v"(addr))
#define G8_LDA(dst, b, h) { const unsigned a_ = ldsA + G8_SA(b, h); \
        G8_DSR(dst[0][0], a_, 0); G8_DSR(dst[0][1], a_, 1024); G8_DSR(dst[1][0], a_, 2048); G8_DSR(dst[1][1], a_, 3072); \
        G8_DSR(dst[2][0], a_, 4096); G8_DSR(dst[2][1], a_, 5120); G8_DSR(dst[3][0], a_, 6144); G8_DSR(dst[3][1], a_, 7168); }
#define G8_LDB(dst, b, h) { const unsigned a_ = ldsB + G8_SB(b, h); \
        G8_DSR(dst[0][0], a_, 0); G8_DSR(dst[0][1], a_, 1024); G8_DSR(dst[1][0], a_, 2048); G8_DSR(dst[1][1], a_, 3072); }
#define G8_TIE_A(AT) asm volatile("s_waitcnt lgkmcnt(0)" : "+v"(AT[0][0]), "+v"(AT[0][1]), "+v"(AT[1][0]), "+v"(AT[1][1]), "+v"(AT[2][0]), "+v"(AT[2][1]), "+v"(AT[3][0]), "+v"(AT[3][1]) :: "memory")
#define G8_TIE_B(BX) asm volatile("s_waitcnt lgkmcnt(0)" : "+v"(BX[0][0]), "+v"(BX[0][1]), "+v"(BX[1][0]), "+v"(BX[1][1]) :: "memory")
#define G8_MMA(ai, bj, AT, BX) { __builtin_amdgcn_s_setprio(1); \
        _Pragma("unroll") for (int m = 0; m < 4; ++m) _Pragma("unroll") for (int n = 0; n < 2; ++n) _Pragma("unroll") for (int k = 0; k < 2; ++k) \
            acc[ai][bj][m][n] = mfma16(BX[n][k], AT[m][k], acc[ai][bj][m][n]); \
        __builtin_amdgcn_s_setprio(0); }
#define G8_WV(n) asm volatile("s_waitcnt vmcnt(" #n ")" ::: "memory")
#define G8_WL(n) asm volatile("s_waitcnt lgkmcnt(" #n ")" ::: "memory")
#define G8_BAR __builtin_amdgcn_s_barrier()
#define G8_SCHED __builtin_amdgcn_sched_barrier(0)
    f32x4 acc[2][2][4][2];
#pragma unroll
    for (int a = 0; a < 2; ++a)
#pragma unroll
        for (int b = 0; b < 2; ++b)
#pragma unroll
            for (int m = 0; m < 4; ++m)
#pragma unroll
                for (int n = 0; n < 2; ++n) acc[a][b][m][n] = (f32x4){0.f, 0.f, 0.f, 0.f};
    bf16x8 At[4][2], B0[2][2], B1[2][2];
    if (!prefetched) {
        __syncthreads();
        G8_STAGE_B(G8_SB(0, 0), Bt, n0, 0, perm); G8_STAGE(G8_SA(0, 0), A, m0, 0);
        G8_STAGE_B(G8_SB(0, 1), Bt, n0 + HALF, 0, perm); G8_STAGE(G8_SA(0, 1), A, m0 + HALF, 0);
        if (wr == 1) G8_BAR;
        G8_WV(4); G8_BAR;
        G8_STAGE_B(G8_SB(1, 0), Bt, n0, 1, perm); G8_STAGE(G8_SA(1, 0), A, m0, 1); G8_STAGE_B(G8_SB(1, 1), Bt, n0 + HALF, 1, perm);
        G8_WV(6); G8_BAR;
    } else {
        G8_WV(0);
        if (wr == 1) G8_BAR;
        G8_BAR;
        G8_BAR;
    }
    for (int t = 0; t < nt - 2; t += 2) {
        G8_LDB(B0, 0, 0); G8_SCHED; G8_LDA(At, 0, 0); G8_STAGE(G8_SA(1, 1), A, m0 + HALF, t + 1);
        G8_WL(8); G8_BAR; G8_TIE_B(B0); G8_TIE_A(At); G8_MMA(0, 0, At, B0); G8_BAR; G8_SCHED;
        G8_LDB(B1, 0, 1); G8_STAGE_B(G8_SB(0, 0), Bt, n0, t + 2, perm);
        G8_BAR; G8_TIE_B(B1); G8_MMA(0, 1, At, B1); G8_BAR;
        G8_LDA(At, 0, 1); G8_STAGE(G8_SA(0, 0), A, m0, t + 2);
        G8_BAR; G8_TIE_A(At); G8_MMA(1, 0, At, B0); G8_BAR; G8_SCHED;
        G8_STAGE_B(G8_SB(0, 1), Bt, n0 + HALF, t + 2, perm);
        G8_WV(6); G8_BAR; G8_MMA(1, 1, At, B1); G8_BAR;
        G8_LDB(B0, 1, 0); G8_SCHED; G8_LDA(At, 1, 0); G8_STAGE(G8_SA(0, 1), A, m0 + HALF, t + 2);
        G8_WL(8); G8_BAR; G8_TIE_B(B0); G8_TIE_A(At); G8_MMA(0, 0, At, B0); G8_BAR; G8_SCHED;
        G8_LDB(B1, 1, 1); G8_STAGE_B(G8_SB(1, 0), Bt, n0, t + 3, perm);
        G8_BAR; G8_TIE_B(B1); G8_MMA(0, 1, At, B1); G8_BAR;
        G8_LDA(At, 1, 1); G8_STAGE(G8_SA(1, 0), A, m0, t + 3);
        G8_BAR; G8_TIE_A(At); G8_MMA(1, 0, At, B0); G8_BAR; G8_SCHED;
        G8_STAGE_B(G8_SB(1, 1), Bt, n0 + HALF, t + 3, perm);
        G8_WV(6); G8_BAR; G8_MMA(1, 1, At, B1); G8_BAR;
    }
    {
        G8_LDB(B0, 0, 0); G8_LDA(At, 0, 0); G8_STAGE(G8_SA(1, 1), A, m0 + HALF, nt - 1);
        G8_BAR; G8_TIE_B(B0); G8_TIE_A(At); G8_MMA(0, 0, At, B0); G8_BAR;
        G8_LDB(B1, 0, 1); G8_BAR; G8_TIE_B(B1); G8_MMA(0, 1, At, B1); G8_BAR;
        G8_LDA(At, 0, 1); G8_WV(4); G8_BAR; G8_TIE_A(At); G8_MMA(1, 0, At, B0); G8_MMA(1, 1, At, B1); G8_BAR;
    }
    {
        G8_LDB(B0, 1, 0); G8_LDA(At, 1, 0); G8_WV(2); G8_BAR; G8_TIE_B(B0); G8_TIE_A(At); G8_MMA(0, 0, At, B0); G8_BAR;
        G8_LDB(B1, 1, 1); G8_WV(0); G8_BAR; G8_TIE_B(B1); G8_MMA(0, 1, At, B1); G8_BAR;
        G8_LDA(At, 1, 1); G8_BAR; G8_TIE_A(At); G8_MMA(1, 0, At, B0); G8_MMA(1, 1, At, B1); G8_BAR;
    }
    if (wr == 0) G8_BAR;
    if (nA != nullptr) {
        G8_STAGE_B(G8_SB(0, 0), nB, nn0, 0, nperm); G8_STAGE(G8_SA(0, 0), nA, nm0, 0);
        G8_STAGE_B(G8_SB(0, 1), nB, nn0 + HALF, 0, nperm); G8_STAGE(G8_SA(0, 1), nA, nm0 + HALF, 0);
        G8_STAGE_B(G8_SB(1, 0), nB, nn0, 1, nperm); G8_STAGE(G8_SA(1, 0), nA, nm0, 1); G8_STAGE_B(G8_SB(1, 1), nB, nn0 + HALF, 1, nperm);
    }
    __builtin_amdgcn_sched_barrier(0);
#undef G8_SA
#undef G8_SB
#undef G8_STAGE
#undef G8_STAGE_B
#undef G8_PERMOFF
#undef G8_LDA
#undef G8_LDB
#undef G8_DSR
#undef G8_TIE_A
#undef G8_TIE_B
#undef G8_MMA
#undef G8_WV
#undef G8_WL
#undef G8_BAR
#undef G8_SCHED

    const int tid_e = opaque_tid(), wave_e = __builtin_amdgcn_readfirstlane(tid_e >> 6);
    const int wr_e = wave_e >> 2, wc_e = wave_e & 3, fr_e = tid_e & 15, fq_e = (tid_e >> 4) & 3;
    const int tok_w = m0 + wr_e * 64 + fr_e;
    const int col_w = n0 + wc_e * 32 + 4 * fq_e;
    const int col_p = n0 + wc_e * 32 + 8 * fq_e;
    if (MODE == 1) {
#pragma unroll
        for (int ai = 0; ai < 2; ++ai)
#pragma unroll
            for (int m = 0; m < 4; ++m) {
                bf16_t* rowp = e.C + (size_t)(tok_w + ai * 128 + m * 16) * 1024 + col_p;
#pragma unroll
                for (int bj = 0; bj < 2; ++bj) {
                    const f32x4 v0 = acc[ai][bj][m][0], v1 = acc[ai][bj][m][1];
                    u32x4 o; o.x = pk_bf16(v0[0], v0[1]); o.y = pk_bf16(v0[2], v0[3]); o.z = pk_bf16(v1[0], v1[1]); o.w = pk_bf16(v1[2], v1[3]);
                    *(u32x4*)(rowp + bj * 128) = o;
                }
            }
    } else if (MODE == 2) {
        if (n0 == 0) {
#pragma unroll
            for (int ai = 0; ai < 2; ++ai)
#pragma unroll
                for (int m = 0; m < 4; ++m) {
                    bf16_t* rowp = e.C + (size_t)(tok_w + ai * 128 + m * 16) * 256 + col_p;
#pragma unroll
                    for (int bj = 0; bj < 2; ++bj) {
                        const f32x4 v0 = acc[ai][bj][m][0], v1 = acc[ai][bj][m][1];
                        u32x4 o; o.x = pk_bf16(v0[0], v0[1]); o.y = pk_bf16(v0[2], v0[3]); o.z = pk_bf16(v1[0], v1[1]); o.w = pk_bf16(v1[2], v1[3]);
                        *(u32x4*)(rowp + bj * 128) = o;
                    }
                }
        } else {
#pragma unroll
            for (int ai = 0; ai < 2; ++ai)
#pragma unroll
                for (int m = 0; m < 4; ++m) {
                    const int mt = tok_w + ai * 128 + m * 16, b = mt >> 8, mm = mt & 255;
#pragma unroll
                    for (int bj = 0; bj < 2; ++bj)
#pragma unroll
                        for (int n = 0; n < 2; ++n) {
                            const int f = (col_w - 256) + bj * 128 + n * 16, hx = f >> 6, d = f & 63;
                            bf16_t* bp = e.VT + ((size_t)(b * 4 + hx) * 64 + d) * 256 + mm;
#pragma unroll
                            for (int j = 0; j < 4; ++j) bp[(size_t)j * 256] = (bf16_t)(pk_bf16(acc[ai][bj][m][n][j], 0.f) & 0xffffu);
                        }
                }
        }
    } else {
        const bool has_qk = (n0 >= 512 && n0 < 1152);
        float* ssx = (float*)(smem + 3 * 16384);
        if (has_qk) {
#pragma unroll
            for (int ai = 0; ai < 2; ++ai)
#pragma unroll
                for (int bj = 0; bj < 2; ++bj)
#pragma unroll
                    for (int m = 0; m < 4; ++m) {
                        float ss = 0.f;
#pragma unroll
                        for (int n = 0; n < 2; ++n)
#pragma unroll
                            for (int j = 0; j < 4; ++j) ss += acc[ai][bj][m][n][j] * acc[ai][bj][m][n][j];
                        ss = x16_add(ss); ss = x32_add(ss);
                        if (fq_e == 0) ssx[((wave_e * 2 + ai) * 2 + bj) * 64 + m * 16 + fr_e] = ss;
                    }
            __syncthreads();
        }
#pragma unroll
        for (int bj = 0; bj < 2; ++bj) {
            const int cb = n0 + bj * 128 + wc_e * 32;
            const int c64 = cb & ~63;
            if (c64 >= 512 && c64 < 1152) {
                const bool isq = c64 < 1024;
                const float* gn = (isq ? e.qn : e.kn) + (wc_e & 1) * 32 + 4 * fq_e;
                const float osc = isq ? 0.125f * L2E : 1.0f;
                const f32x4 g0 = *(const f32x4*)(gn), g1 = *(const f32x4*)(gn + 16);
#pragma unroll
                for (int ai = 0; ai < 2; ++ai)
#pragma unroll
                    for (int m = 0; m < 4; ++m) {
                        const int tok = tok_w + ai * 128 + m * 16;
                        const float ss = ssx[((wave_e * 2 + ai) * 2 + bj) * 64 + m * 16 + fr_e] + ssx[(((wave_e ^ 1) * 2 + ai) * 2 + bj) * 64 + m * 16 + fr_e];
                        const float rinv = rsqrtf(ss * (1.0f / 64.0f) + EPS);
                        const int t = (tok < NPROMPT) ? (tok & 2047) : (tok & 4095);
                        const int ridx = (wc_e & 1) ? (t & 63) : (t >> 6);
                        const f32x4* rt = (const f32x4*)(e.rope + (ridx * 16 + 4 * fq_e) * 2);
                        const f32x4 r01 = rt[0], r23 = rt[1];
                        const float rc[4] = {r01[0], r01[2], r23[0], r23[2]}, rs[4] = {r01[1], r01[3], r23[1], r23[3]};
                        float oa[4], ob[4];
#pragma unroll
                        for (int j = 0; j < 4; ++j) {
                            const float a = acc[ai][bj][m][0][j] * rinv * g0[j], b = acc[ai][bj][m][1][j] * rinv * g1[j];
                            oa[j] = (a * rc[j] - b * rs[j]) * osc; ob[j] = (b * rc[j] + a * rs[j]) * osc;
                        }
                        bf16_t* rowp = e.C + (size_t)tok * INW + cb + 4 * fq_e;
                        u32x2 w0, w1; w0.x = pk_bf16(oa[0], oa[1]); w0.y = pk_bf16(oa[2], oa[3]); w1.x = pk_bf16(ob[0], ob[1]); w1.y = pk_bf16(ob[2], ob[3]);
                        *(u32x2*)(rowp) = w0; *(u32x2*)(rowp + 16) = w1;
                    }
            } else if (c64 >= 1152 && c64 < 1280) {
#pragma unroll
                for (int ai = 0; ai < 2; ++ai)
#pragma unroll
                    for (int m = 0; m < 4; ++m) {
                        const int tok = tok_w + ai * 128 + m * 16;
#pragma unroll
                        for (int n = 0; n < 2; ++n) {
                            const int f = cb + n * 16 + 4 * fq_e - 1152, kvh = f >> 6, d = f & 63;
                            bf16_t* bp; size_t T;
                            if (tok < NPROMPT) { const int b = tok >> 11, t = tok & 2047; T = 2048; bp = e.VT + ((size_t)(b * 2 + kvh) * 64 + d) * 2048 + t; }
                            else { const int b = (tok - NPROMPT) >> 12, t = tok & 4095; T = 4096; bp = e.VT + (size_t)NPROMPT * 128 + ((size_t)(b * 2 + kvh) * 64 + d) * 4096 + t; }
#pragma unroll
                            for (int j = 0; j < 4; ++j) bp[(size_t)j * T] = (bf16_t)(pk_bf16(acc[ai][bj][m][n][j], 0.f) & 0xffffu);
                        }
                    }
            } else {
                const int kind = (c64 < 256) ? 0 : ((c64 >= 1792 && c64 < 2048) ? 2 : 1);
#pragma unroll
                for (int ai = 0; ai < 2; ++ai)
#pragma unroll
                    for (int m = 0; m < 4; ++m) {
                        bf16_t* rowp = e.C + (size_t)(tok_w + ai * 128 + m * 16) * INW + cb + 8 * fq_e;
                        float v[8];
#pragma unroll
                        for (int n = 0; n < 2; ++n)
#pragma unroll
                            for (int j = 0; j < 4; ++j) { const float x = acc[ai][bj][m][n][j]; v[4 * n + j] = (kind == 0) ? x : ((kind == 2) ? x * (0.125f * L2E) : silu_f(x)); }
                        u32x4 o; o.x = pk_bf16(v[0], v[1]); o.y = pk_bf16(v[2], v[3]); o.z = pk_bf16(v[4], v[5]); o.w = pk_bf16(v[6], v[7]);
                        *(u32x4*)(rowp) = o;
                    }
            }
        }
    }
}

#define SB_() __builtin_amdgcn_sched_barrier(0)
#define KFRAG(KS, KB) (*(const bf16x8*)(kp + (KB) * 4096 + k_off + ((((KS) * 2 + h) ^ kswz) << 4)))
#define VFRAG(KK, DB) (*(const bf16x8*)(vp + (DB) * 4096 + v_off + ((((KK) * 2 + h) ^ vswz) << 4)))
#define EXP4(S, I0) { _Pragma("unroll") for (int i_ = (I0); i_ < (I0) + 4; ++i_) { S[i_] = __builtin_amdgcn_exp2f(S[i_] - mb); rs += S[i_]; } }
#define EXP4F(S, I0) { f32x2_t a_ = {S[(I0)], S[(I0) + 1]}, b_ = {S[(I0) + 2], S[(I0) + 3]}; \
        a_ = a_ - (f32x2_t){mb, mb}; b_ = b_ - (f32x2_t){mb, mb}; \
        S[(I0)] = __builtin_amdgcn_exp2f(a_.x); S[(I0) + 1] = __builtin_amdgcn_exp2f(a_.y); S[(I0) + 2] = __builtin_amdgcn_exp2f(b_.x); S[(I0) + 3] = __builtin_amdgcn_exp2f(b_.y); \
        rs2 += (f32x2_t){S[(I0)], S[(I0) + 1]} + (f32x2_t){S[(I0) + 2], S[(I0) + 3]}; }
#define EXPQ(S, I0) { if (FIXM) EXP4F(S, I0) else EXP4(S, I0) }
#define PACK8(S, I0) ({ u32x4 t_; t_.x = pk_bf16(S[(I0)], S[(I0) + 1]); t_.y = pk_bf16(S[(I0) + 2], S[(I0) + 3]); t_.z = pk_bf16(S[(I0) + 4], S[(I0) + 5]); t_.w = pk_bf16(S[(I0) + 6], S[(I0) + 7]); __builtin_bit_cast(bf16x8, t_); })
DI float max8(const f32x16& s, int i0, float mx) {
    mx = fmaxf(fmaxf(mx, s[i0]), s[i0 + 1]); mx = fmaxf(fmaxf(mx, s[i0 + 2]), s[i0 + 3]);
    mx = fmaxf(fmaxf(mx, s[i0 + 4]), s[i0 + 5]); mx = fmaxf(fmaxf(mx, s[i0 + 6]), s[i0 + 7]);
    return mx;
}
#define EXP2F(S, I0) { S[(I0)] = __builtin_amdgcn_exp2f(S[(I0)]); S[(I0) + 1] = __builtin_amdgcn_exp2f(S[(I0) + 1]); rs += S[(I0)] + S[(I0) + 1]; \
        asm volatile("" : "+v"(S[(I0)]), "+v"(S[(I0) + 1]), "+v"(rs)); }
#define PIN1(X) asm volatile("" : "+v"(X))
template <bool DO_PV, bool DO_QK>
DI void attn_step_fix(f32x16& s0, f32x16& s1, f32x16& n0, f32x16& n1, const bf16x8 (&pp)[4], bf16x8 (&pc)[4],
                      f32x16& o0, f32x16& o1, const float m, float& lsum, const bf16x8 (&qf)[4],
                      const unsigned char* kp, const unsigned char* vp, int k_off, int kswz, int v_off, int vswz, int h) {
    bf16x8 va0, vb0, va1, vb1, va2, vb2, va3, vb3, ka0, kb0, ka1, kb1, ka2, kb2, ka3, kb3;
    float rs = 0.f;
    if (DO_PV) { va0 = VFRAG(0, 0); vb0 = VFRAG(0, 1); va1 = VFRAG(1, 0); vb1 = VFRAG(1, 1); }
    EXP2F(s0, 0);  if (DO_PV) { o0 = mfma32(va0, pp[0], o0); va2 = VFRAG(2, 0); vb2 = VFRAG(2, 1); } SB_();
    EXP2F(s0, 2);  if (DO_PV) { o1 = mfma32(vb0, pp[0], o1); va3 = VFRAG(3, 0); vb3 = VFRAG(3, 1); } SB_();
    EXP2F(s0, 4);  if (DO_PV) { o0 = mfma32(va1, pp[1], o0); } if (DO_QK) { ka0 = KFRAG(0, 0); kb0 = KFRAG(0, 1); } SB_();
    EXP2F(s0, 6);  if (DO_PV) { o1 = mfma32(vb1, pp[1], o1); } if (DO_QK) { ka1 = KFRAG(1, 0); kb1 = KFRAG(1, 1); } SB_();
    EXP2F(s0, 8);  if (DO_PV) { o0 = mfma32(va2, pp[2], o0); } SB_();
    EXP2F(s0, 10); if (DO_PV) { o1 = mfma32(vb2, pp[2], o1); } pc[0] = PACK8(s0, 0); PIN1(pc[0]); SB_();
    EXP2F(s0, 12); if (DO_PV) { o0 = mfma32(va3, pp[3], o0); } SB_();
    EXP2F(s0, 14); if (DO_PV) { o1 = mfma32(vb3, pp[3], o1); } SB_();
    EXP2F(s1, 0);  if (DO_QK) { n0 = mfma32(ka0, qf[0], (f32x16){0.f, 0.f, 0.f, 0.f, 0.f, 0.f, 0.f, 0.f, 0.f, 0.f, 0.f, 0.f, 0.f, 0.f, 0.f, 0.f}); ka2 = KFRAG(2, 0); kb2 = KFRAG(2, 1); } pc[1] = PACK8(s0, 8); PIN1(pc[1]); SB_();
    EXP2F(s1, 2);  if (DO_QK) { n1 = mfma32(kb0, qf[0], (f32x16){0.f, 0.f, 0.f, 0.f, 0.f, 0.f, 0.f, 0.f, 0.f, 0.f, 0.f, 0.f, 0.f, 0.f, 0.f, 0.f}); ka3 = KFRAG(3, 0); kb3 = KFRAG(3, 1); } SB_();
    EXP2F(s1, 4);  if (DO_QK) { n0 = mfma32(ka1, qf[1], n0); } SB_();
    EXP2F(s1, 6);  if (DO_QK) { n1 = mfma32(kb1, qf[1], n1); } SB_();
    EXP2F(s1, 8);  if (DO_QK) { n0 = mfma32(ka2, qf[2], n0); } pc[2] = PACK8(s1, 0); PIN1(pc[2]); SB_();
    EXP2F(s1, 10); if (DO_QK) { n1 = mfma32(kb2, qf[2], n1); } SB_();
    EXP2F(s1, 12); if (DO_QK) { n0 = mfma32(ka3, qf[3], n0); } SB_();
    EXP2F(s1, 14); if (DO_QK) { n1 = mfma32(kb3, qf[3], n1); } pc[3] = PACK8(s1, 8); PIN1(pc[3]);
    lsum += rs;
    SB_();
}
template <bool DO_PV, bool DO_QK, bool FIXM>
DI void attn_step(f32x16& s0, f32x16& s1, f32x16& n0, f32x16& n1, const bf16x8 (&pp)[4], bf16x8 (&pc)[4],
                  f32x16& o0, f32x16& o1, float& m, float& lsum, const bf16x8 (&qf)[4],
                  const unsigned char* kp, const unsigned char* vp, int k_off, int kswz, int v_off, int vswz, int h) {
    if (FIXM) { attn_step_fix<DO_PV, DO_QK>(s0, s1, n0, n1, pp, pc, o0, o1, m, lsum, qf, kp, vp, k_off, kswz, v_off, vswz, h); return; }
    bf16x8 va0, vb0, va1, vb1, va2, vb2, va3, vb3, ka0, kb0, ka1, kb1, ka2, kb2, ka3, kb3;
    if (DO_PV) { va0 = VFRAG(0, 0); vb0 = VFRAG(0, 1); va1 = VFRAG(1, 0); vb1 = VFRAG(1, 1); }
    float mx = s0[0];
    if (DO_PV) o0 = mfma32(va0, pp[0], o0);
    if (!FIXM) mx = max8(s0, 0, mx);
    SB_();
    if (DO_PV) { o1 = mfma32(vb0, pp[0], o1); va2 = VFRAG(2, 0); vb2 = VFRAG(2, 1); }
    if (!FIXM) mx = max8(s0, 8, mx);
    SB_();
    if (DO_PV) { o0 = mfma32(va1, pp[1], o0); va3 = VFRAG(3, 0); vb3 = VFRAG(3, 1); }
    if (!FIXM) mx = max8(s1, 0, mx);
    SB_();
    if (DO_PV) o1 = mfma32(vb1, pp[1], o1);
    bool need = false; float alpha = 1.0f;
    if (!FIXM) {
        mx = max8(s1, 8, mx);
        mx = xhalf_max(mx);
        need = mx > m + 8.0f;
        const float mnew = need ? mx : m;
        alpha = __builtin_amdgcn_exp2f(m - mnew);
        m = mnew;
    }
    const float mb = m;
    float rs = 0.f; f32x2_t rs2 = {0.f, 0.f};
    SB_();
    if (DO_PV) o0 = mfma32(va2, pp[2], o0);
    if (DO_QK) { ka0 = KFRAG(0, 0); kb0 = KFRAG(0, 1); }
    EXPQ(s0, 0);
    SB_();
    if (DO_PV) o1 = mfma32(vb2, pp[2], o1);
    if (DO_QK) { ka1 = KFRAG(1, 0); kb1 = KFRAG(1, 1); }
    EXPQ(s0, 4);
    SB_();
    if (DO_PV) o0 = mfma32(va3, pp[3], o0);
    EXPQ(s0, 8);
    SB_();
    if (DO_PV) o1 = mfma32(vb3, pp[3], o1);
    EXPQ(s0, 12);
    SB_();
    if (DO_QK) { n0 = mfma32(ka0, qf[0], (f32x16){0.f, 0.f, 0.f, 0.f, 0.f, 0.f, 0.f, 0.f, 0.f, 0.f, 0.f, 0.f, 0.f, 0.f, 0.f, 0.f}); ka2 = KFRAG(2, 0); kb2 = KFRAG(2, 1); }
    EXPQ(s1, 0);
    SB_();
    if (DO_QK) { n1 = mfma32(kb0, qf[0], (f32x16){0.f, 0.f, 0.f, 0.f, 0.f, 0.f, 0.f, 0.f, 0.f, 0.f, 0.f, 0.f, 0.f, 0.f, 0.f, 0.f}); ka3 = KFRAG(3, 0); kb3 = KFRAG(3, 1); }
    EXPQ(s1, 4);
    SB_();
    if (DO_QK) n0 = mfma32(ka1, qf[1], n0);
    EXPQ(s1, 8);
    SB_();
    if (DO_QK) n1 = mfma32(kb1, qf[1], n1);
    EXPQ(s1, 12);
    SB_();
    if (DO_QK) n0 = mfma32(ka2, qf[2], n0);
    pc[0] = PACK8(s0, 0);
    SB_();
    if (DO_QK) n1 = mfma32(kb2, qf[2], n1);
    pc[1] = PACK8(s0, 8);
    SB_();
    if (DO_QK) n0 = mfma32(ka3, qf[3], n0);
    pc[2] = PACK8(s1, 0);
    SB_();
    if (DO_QK) n1 = mfma32(kb3, qf[3], n1);
    pc[3] = PACK8(s1, 8);
    if (FIXM) lsum += rs2.x + rs2.y; else lsum = lsum * alpha + rs;
    SB_();
    if (!FIXM) {
        if (__builtin_amdgcn_ballot_w64(need)) {
#pragma unroll
            for (int i = 0; i < 16; ++i) { o0[i] *= alpha; o1[i] *= alpha; }
        }
    }
}

template <bool FIXM>
DI void attn_item(const bf16_t* __restrict__ Q, int ldq, const bf16_t* __restrict__ K, int ldk, const bf16_t* __restrict__ VT, int ldv,
                  int nkeys, bf16_t* __restrict__ O, const bf16_t* __restrict__ G, unsigned char* smem, float mfix) {
    const int tid = opaque_tid(), lane = tid & 63, wave = tid >> 6;
    const int r = lane & 31, h = lane >> 5;
    bf16x8 qf[4];
    {
        const bf16_t* qp = Q + (size_t)(wave * 32 + r) * ldq + h * 8;
#pragma unroll
        for (int ks = 0; ks < 4; ++ks) qf[ks] = *(const bf16x8*)(qp + ks * 16);
    }
    const int lrow = tid >> 3, lc = tid & 7;
    const bf16_t* Kg = K + (size_t)lrow * ldk + lc * 8;
    const bf16_t* Vg = VT + (size_t)lrow * ldv + lc * 8;
    const int st_off = lrow * 128 + ((lc ^ ((lrow >> 1) & 7)) << 4);
    const int pr = (r & ~12) | ((r & 4) << 1) | ((r & 8) >> 1);
    const int kswz = (pr >> 1) & 7, vswz = (r >> 1) & 7;
    const int k_off = pr * 128, v_off = r * 128;
    const int nt = nkeys >> 6;

    f32x16 o0, o1, sa0, sa1, sb0, sb1;
#pragma unroll
    for (int i = 0; i < 16; ++i) { o0[i] = 0.f; o1[i] = 0.f; }
    float m = FIXM ? mfix : -1e30f, lsum = 0.f;
    bf16x8 pa[4], pb[4];

    u32x4 rk, rv;
#define A_LOAD(U) { const int kt_ = ((U) + 2 < nt) ? (U) + 2 : nt - 1; rk = *(const u32x4*)(Kg + (size_t)(kt_ * 64) * ldk); rv = *(const u32x4*)(Vg + (U) * 64); }
#define A_STORE(OFF) { *(u32x4*)(smem + (OFF) + st_off) = rk; *(u32x4*)(smem + (OFF) + 8192 + st_off) = rv; }
    rk = *(const u32x4*)(Kg); rv = *(const u32x4*)(Kg + (size_t)64 * ldk);
    __syncthreads();
    A_STORE(16384);
    A_LOAD(0);
    A_STORE(0);
    A_LOAD(1);
    lds_barrier();
    {
        const unsigned char* kp = smem + 16384;
        sa0 = mfma32(KFRAG(0, 0), qf[0], (f32x16){0.f, 0.f, 0.f, 0.f, 0.f, 0.f, 0.f, 0.f, 0.f, 0.f, 0.f, 0.f, 0.f, 0.f, 0.f, 0.f});
        sa1 = mfma32(KFRAG(0, 1), qf[0], (f32x16){0.f, 0.f, 0.f, 0.f, 0.f, 0.f, 0.f, 0.f, 0.f, 0.f, 0.f, 0.f, 0.f, 0.f, 0.f, 0.f});
#pragma unroll
        for (int ks = 1; ks < 4; ++ks) { sa0 = mfma32(KFRAG(ks, 0), qf[ks], sa0); sa1 = mfma32(KFRAG(ks, 1), qf[ks], sa1); }
    }
    attn_step<false, true, FIXM>(sa0, sa1, sb0, sb1, pb, pa, o0, o1, m, lsum, qf, smem + 16384 + 8192, smem, k_off, kswz, v_off, vswz, h);
    lds_barrier();
    for (int t = 1; t < nt - 1; t += 2) {
        A_STORE(16384);
        A_LOAD(t + 1);
        SB_();
        attn_step<true, true, FIXM>(sb0, sb1, sa0, sa1, pa, pb, o0, o1, m, lsum, qf, smem, smem + 8192, k_off, kswz, v_off, vswz, h);
        lds_barrier();
        A_STORE(0);
        A_LOAD(t + 2);
        SB_();
        attn_step<true, true, FIXM>(sa0, sa1, sb0, sb1, pb, pa, o0, o1, m, lsum, qf, smem + 16384, smem + 16384 + 8192, k_off, kswz, v_off, vswz, h);
        lds_barrier();
    }
    A_STORE(16384);
    const bf16_t* gp = G + (size_t)(wave * 32 + r) * INW + 4 * h;
    u32x2 gga[4], ggb[4];
#pragma unroll
    for (int gq = 0; gq < 4; ++gq) { gga[gq] = *(const u32x2*)(gp + 8 * gq); ggb[gq] = *(const u32x2*)(gp + 32 + 8 * gq); }
    SB_();
    attn_step<true, false, FIXM>(sb0, sb1, sa0, sa1, pa, pb, o0, o1, m, lsum, qf, smem, smem + 8192, k_off, kswz, v_off, vswz, h);
    lds_barrier();
    {
        const unsigned char* vp = smem + 16384 + 8192;
#pragma unroll
        for (int kk = 0; kk < 4; ++kk) { o0 = mfma32(VFRAG(kk, 0), pb[kk], o0); o1 = mfma32(VFRAG(kk, 1), pb[kk], o1); }
    }
#undef A_LOAD
#undef A_STORE
    const float lt = x32_add(lsum);
    const float inv = 1.0f / lt;
    bf16_t* op = O + (size_t)(wave * 32 + r) * 1024 + 4 * h;
#pragma unroll
    for (int gq = 0; gq < 4; ++gq) {
        {
            const u32x2 gg = gga[gq];
            u32x2 w;
            w.x = pk_bf16(o0[4 * gq] * inv * bflo(gg.x), o0[4 * gq + 1] * inv * bfhi(gg.x));
            w.y = pk_bf16(o0[4 * gq + 2] * inv * bflo(gg.y), o0[4 * gq + 3] * inv * bfhi(gg.y));
            *(u32x2*)(op + 8 * gq) = w;
        }
        {
            const u32x2 gg = ggb[gq];
            u32x2 w;
            w.x = pk_bf16(o1[4 * gq] * inv * bflo(gg.x), o1[4 * gq + 1] * inv * bfhi(gg.x));
            w.y = pk_bf16(o1[4 * gq + 2] * inv * bflo(gg.y), o1[4 * gq + 3] * inv * bfhi(gg.y));
            *(u32x2*)(op + 32 + 8 * gq) = w;
        }
    }
}

DI void cross_item(const bf16_t* __restrict__ Q, const bf16_t* __restrict__ K, const bf16_t* __restrict__ VT,
                   bf16_t* __restrict__ O, const bf16_t* __restrict__ G, unsigned char* smem) {
    const int tid = opaque_tid(), lane = tid & 63, wave = tid >> 6;
    const int r = lane & 31, h = lane >> 5;
    bf16x8 qf[4];
    {
        const bf16_t* qp = Q + (size_t)(wave * 32 + r) * INW + h * 8;
#pragma unroll
        for (int ks = 0; ks < 4; ++ks) qf[ks] = *(const bf16x8*)(qp + ks * 16);
    }
    const int lrow = tid >> 3, lc = tid & 7;
    const int st_off = lrow * 128 + ((lc ^ ((lrow >> 1) & 7)) << 4);
    {
        u32x4 kk[4], vv[4];
#pragma unroll
        for (int i = 0; i < 4; ++i) { kk[i] = *(const u32x4*)(K + (size_t)(lrow + 64 * i) * 256 + lc * 8); vv[i] = *(const u32x4*)(VT + (size_t)lrow * 256 + (i * 8 + lc) * 8); }
        __syncthreads();
#pragma unroll
        for (int i = 0; i < 4; ++i) { *(u32x4*)(smem + i * 16384 + st_off) = kk[i]; *(u32x4*)(smem + i * 16384 + 8192 + st_off) = vv[i]; }
    }
    const bf16_t* gp = G + (size_t)(wave * 32 + r) * INW + 4 * h;
    u32x2 gga[4], ggb[4];
#pragma unroll
    for (int gq = 0; gq < 4; ++gq) { gga[gq] = *(const u32x2*)(gp + 8 * gq); ggb[gq] = *(const u32x2*)(gp + 32 + 8 * gq); }
    __syncthreads();
    const int pr = (r & ~12) | ((r & 4) << 1) | ((r & 8) >> 1);
    const int kswz = (pr >> 1) & 7, vswz = (r >> 1) & 7;
    const int k_off = pr * 128, v_off = r * 128;
    f32x16 o0, o1;
#pragma unroll
    for (int i = 0; i < 16; ++i) { o0[i] = 0.f; o1[i] = 0.f; }
    float m = -1e30f, lsum = 0.f;
#pragma unroll 1
    for (int kt = 0; kt < 4; ++kt) {
        const unsigned char* kp = smem + kt * 16384;
        const unsigned char* vp = kp + 8192;
        f32x16 s0, s1;
        s0 = mfma32(KFRAG(0, 0), qf[0], (f32x16){0.f, 0.f, 0.f, 0.f, 0.f, 0.f, 0.f, 0.f, 0.f, 0.f, 0.f, 0.f, 0.f, 0.f, 0.f, 0.f});
        s1 = mfma32(KFRAG(0, 1), qf[0], (f32x16){0.f, 0.f, 0.f, 0.f, 0.f, 0.f, 0.f, 0.f, 0.f, 0.f, 0.f, 0.f, 0.f, 0.f, 0.f, 0.f});
#pragma unroll
        for (int ks = 1; ks < 4; ++ks) { s0 = mfma32(KFRAG(ks, 0), qf[ks], s0); s1 = mfma32(KFRAG(ks, 1), qf[ks], s1); }
        float mx = s0[0];
        mx = max8(s0, 0, mx); mx = max8(s0, 8, mx); mx = max8(s1, 0, mx); mx = max8(s1, 8, mx);
        mx = xhalf_max(mx);
        const float mnew = fmaxf(m, mx);
        const float alpha = __builtin_amdgcn_exp2f(m - mnew);
        m = mnew;
        const float mb = mnew;
        float rs = 0.f;
#pragma unroll
        for (int i = 0; i < 16; ++i) { s0[i] = __builtin_amdgcn_exp2f(s0[i] - mb); s1[i] = __builtin_amdgcn_exp2f(s1[i] - mb); rs += s0[i] + s1[i]; }
        lsum = lsum * alpha + rs;
#pragma unroll
        for (int i = 0; i < 16; ++i) { o0[i] *= alpha; o1[i] *= alpha; }
        bf16x8 pf[4];
        pf[0] = PACK8(s0, 0); pf[1] = PACK8(s0, 8); pf[2] = PACK8(s1, 0); pf[3] = PACK8(s1, 8);
#pragma unroll
        for (int kk2 = 0; kk2 < 4; ++kk2) { o0 = mfma32(VFRAG(kk2, 0), pf[kk2], o0); o1 = mfma32(VFRAG(kk2, 1), pf[kk2], o1); }
    }
    const float lt = x32_add(lsum);
    const float inv = 1.0f / lt;
    bf16_t* op = O + (size_t)(wave * 32 + r) * 1024 + 4 * h;
#pragma unroll
    for (int gq = 0; gq < 4; ++gq) {
        {
            const u32x2 gg = gga[gq];
            u32x2 w;
            w.x = pk_bf16(o0[4 * gq] * inv * bflo(gg.x), o0[4 * gq + 1] * inv * bfhi(gg.x));
            w.y = pk_bf16(o0[4 * gq + 2] * inv * bflo(gg.y), o0[4 * gq + 3] * inv * bfhi(gg.y));
            *(u32x2*)(op + 8 * gq) = w;
        }
        {
            const u32x2 gg = ggb[gq];
            u32x2 w;
            w.x = pk_bf16(o1[4 * gq] * inv * bflo(gg.x), o1[4 * gq + 1] * inv * bfhi(gg.x));
            w.y = pk_bf16(o1[4 * gq + 2] * inv * bflo(gg.y), o1[4 * gq + 3] * inv * bfhi(gg.y));
            *(u32x2*)(op + 32 + 8 * gq) = w;
        }
    }
}

DI void pool_item(const bf16_t* __restrict__ Z, const bf16_t* __restrict__ PWT, const float* __restrict__ pscale, bf16_t* __restrict__ MIX,
                  int tokg0, unsigned char* smem) {
    const int tid = opaque_tid(), lane = tid & 63, wave = tid >> 6;
    const int T = (tokg0 < NPROMPT) ? 2048 : 4096;
    const int t0 = tokg0 & (T - 1);
    constexpr int RS = 528;
    const int g = wave & 3, half = 1 << g;
    const int r16 = lane & 15, q4 = lane >> 4;
    const bf16_t* pw = PWT + (size_t)g * 4096 + r16 * 64 + q4 * 8;
    bf16x8 wfr[4][2]; f32x4 psr[4]; u32x2 ggr[2][4];
#pragma unroll
    for (int fi = 0; fi < 4; ++fi) {
        psr[fi] = *(const f32x4*)(pscale + g * 64 + fi * 16 + 4 * q4);
#pragma unroll
        for (int ks = 0; ks < 2; ++ks) wfr[fi][ks] = *(const bf16x8*)(pw + fi * 16 * 64 + ks * 32);
#pragma unroll
        for (int t2 = 0; t2 < 2; ++t2) ggr[t2][fi] = *(const u32x2*)(Z + ((size_t)tokg0 + ((wave >> 2) * 2 + t2) * 16 + r16) * INW + 256 + g * 64 + fi * 16 + 4 * q4);
    }
    __syncthreads();
    for (int id = tid; id < 80 * 32; id += 512) {
        const int rr = id >> 5, c = id & 31;
        const int t = t0 - 8 + rr;
        u32x4 v = (u32x4){0u, 0u, 0u, 0u};
        if (t >= 0 && t < T) v = *(const u32x4*)(Z + (size_t)(tokg0 - 8 + rr) * INW + c * 8);
        *(u32x4*)(smem + rr * RS + c * 16) = v;
    }
    __syncthreads();
    {
        const int th = wave >> 2;
        bf16x8 df[2][2];
#pragma unroll
        for (int t2 = 0; t2 < 2; ++t2)
#pragma unroll
            for (int ks = 0; ks < 2; ++ks) {
                const int tl = (th * 2 + t2) * 16 + r16, t = t0 + tl;
                const int lo = max(t - half, 0), hi = min(t + half, T);
                const float icnt = 1.0f / (float)(hi - lo);
                float s[8];
#pragma unroll
                for (int j = 0; j < 8; ++j) s[j] = 0.f;
                const unsigned char* bp = smem + (tl + 8 - half) * RS + (g * 64 + ks * 32 + q4 * 8) * 2;
                for (int j = 0; j < 2 * half; ++j) {
                    const u32x4 v = *(const u32x4*)(bp + j * RS);
                    s[0] += bflo(v.x); s[1] += bfhi(v.x); s[2] += bflo(v.y); s[3] += bfhi(v.y);
                    s[4] += bflo(v.z); s[5] += bfhi(v.z); s[6] += bflo(v.w); s[7] += bfhi(v.w);
                }
                const u32x4 c = *(const u32x4*)(bp + half * RS);
                u32x4 o;
                o.x = pk_bf16(s[0] * icnt - bflo(c.x), s[1] * icnt - bfhi(c.x));
                o.y = pk_bf16(s[2] * icnt - bflo(c.y), s[3] * icnt - bfhi(c.y));
                o.z = pk_bf16(s[4] * icnt - bflo(c.z), s[5] * icnt - bfhi(c.z));
                o.w = pk_bf16(s[6] * icnt - bflo(c.w), s[7] * icnt - bfhi(c.w));
                df[t2][ks] = __builtin_bit_cast(bf16x8, o);
            }
        f32x4 acc[4][2];
#pragma unroll
        for (int i = 0; i < 4; ++i)
#pragma unroll
            for (int j = 0; j < 2; ++j) acc[i][j] = (f32x4){0.f, 0.f, 0.f, 0.f};
#pragma unroll
        for (int fi = 0; fi < 4; ++fi)
#pragma unroll
            for (int ks = 0; ks < 2; ++ks) {
                const bf16x8 wf = wfr[fi][ks];
#pragma unroll
                for (int t2 = 0; t2 < 2; ++t2) acc[fi][t2] = mfma16(wf, df[t2][ks], acc[fi][t2]);
            }
#pragma unroll
        for (int t2 = 0; t2 < 2; ++t2) {
            const size_t tok = (size_t)tokg0 + (th * 2 + t2) * 16 + r16;
#pragma unroll
            for (int fi = 0; fi < 4; ++fi) {
                const int n = g * 64 + fi * 16 + 4 * q4;
                const f32x4 ps = psr[fi];
                const u32x2 gg = ggr[t2][fi];
                u32x2 w;
                w.x = pk_bf16(acc[fi][t2][0] * ps[0] * bflo(gg.x), acc[fi][t2][1] * ps[1] * bfhi(gg.x));
                w.y = pk_bf16(acc[fi][t2][2] * ps[2] * bflo(gg.y), acc[fi][t2][3] * ps[3] * bfhi(gg.y));
                *(u32x2*)(MIX + tok * 1024 + n) = w;
            }
        }
    }
}

struct PostIn { u32x4 yv[2]; f32x4 xv[4]; };
DI PostIn post_row_load(const float* __restrict__ xsrc, const bf16_t* __restrict__ yh, int lane) {
    PostIn r;
#pragma unroll
    for (int j = 0; j < 2; ++j) r.yv[j] = *(const u32x4*)(yh + j * 512 + lane * 8);
#pragma unroll
    for (int j = 0; j < 2; ++j) { r.xv[2 * j] = *(const f32x4*)(xsrc + j * 512 + lane * 8); r.xv[2 * j + 1] = *(const f32x4*)(xsrc + j * 512 + lane * 8 + 4); }
    return r;
}
DI void post_row_finish(const PostIn& in, bf16_t* __restrict__ yh, const float* __restrict__ gpost, const float* __restrict__ gpre_next,
                        float* __restrict__ xdst, bool last, int lane) {
    u32x4 yv[2]; f32x4 xv[4];
#pragma unroll
    for (int j = 0; j < 2; ++j) yv[j] = in.yv[j];
#pragma unroll
    for (int j = 0; j < 4; ++j) xv[j] = in.xv[j];
    float y[16];
#pragma unroll
    for (int j = 0; j < 2; ++j) {
        y[8 * j + 0] = bflo(yv[j].x); y[8 * j + 1] = bfhi(yv[j].x); y[8 * j + 2] = bflo(yv[j].y); y[8 * j + 3] = bfhi(yv[j].y);
        y[8 * j + 4] = bflo(yv[j].z); y[8 * j + 5] = bfhi(yv[j].z); y[8 * j + 6] = bflo(yv[j].w); y[8 * j + 7] = bfhi(yv[j].w);
    }
    float ss = 0.f;
#pragma unroll
    for (int i = 0; i < 16; ++i) ss += y[i] * y[i];
    ss = wave_sum(ss);
    const float r = rsqrtf(ss * (1.0f / 1024.0f) + EPS);
    float xn[16]; float ss2 = 0.f;
#pragma unroll
    for (int j = 0; j < 2; ++j) {
        const f32x4 g0 = *(const f32x4*)(gpost + j * 512 + lane * 8), g1 = *(const f32x4*)(gpost + j * 512 + lane * 8 + 4);
#pragma unroll
        for (int i = 0; i < 4; ++i) {
            xn[8 * j + i] = xv[2 * j][i] + y[8 * j + i] * r * g0[i];
            xn[8 * j + 4 + i] = xv[2 * j + 1][i] + y[8 * j + 4 + i] * r * g1[i];
        }
    }
#pragma unroll
    for (int i = 0; i < 16; ++i) ss2 += xn[i] * xn[i];
#pragma unroll
    for (int j = 0; j < 2; ++j) {
        *(f32x4*)(xdst + j * 512 + lane * 8) = (f32x4){xn[8 * j], xn[8 * j + 1], xn[8 * j + 2], xn[8 * j + 3]};
        *(f32x4*)(xdst + j * 512 + lane * 8 + 4) = (f32x4){xn[8 * j + 4], xn[8 * j + 5], xn[8 * j + 6], xn[8 * j + 7]};
    }
    if (!last) {
        ss2 = wave_sum(ss2);
        const float r2 = rsqrtf(ss2 * (1.0f / 1024.0f) + EPS);
#pragma unroll
        for (int j = 0; j < 2; ++j) {
            const f32x4 g0 = *(const f32x4*)(gpre_next + j * 512 + lane * 8), g1 = *(const f32x4*)(gpre_next + j * 512 + lane * 8 + 4);
            u32x4 o;
            o.x = pk_bf16(xn[8 * j] * r2 * g0[0], xn[8 * j + 1] * r2 * g0[1]);
            o.y = pk_bf16(xn[8 * j + 2] * r2 * g0[2], xn[8 * j + 3] * r2 * g0[3]);
            o.z = pk_bf16(xn[8 * j + 4] * r2 * g1[0], xn[8 * j + 5] * r2 * g1[1]);
            o.w = pk_bf16(xn[8 * j + 6] * r2 * g1[2], xn[8 * j + 7] * r2 * g1[3]);
            *(u32x4*)(yh + j * 512 + lane * 8) = o;
        }
    }
}

#define XB_TMO      128
#define XB_XCNT(j)  (256  + 64 * (j))
#define XB_XSUB(j)  (1280 + 64 * (j))
#define XB_XGEN(j)  (2304 + 64 * (j))
#define XB_TOP      3328
#define XB_TOPGEN   3392
#define XCD_BAR_WORDS 3456
#define XB_SPIN_CAP (1u << 18)
#define LAS __attribute__((address_space(3)))
DI unsigned xb_ld(unsigned* p)              { return __hip_atomic_load(p, __ATOMIC_RELAXED, __HIP_MEMORY_SCOPE_AGENT); }
DI unsigned xb_add(unsigned* p, unsigned v) { return __hip_atomic_fetch_add(p, v, __ATOMIC_RELAXED, __HIP_MEMORY_SCOPE_AGENT); }
DI unsigned xb_xcc_id() { return (unsigned)__builtin_amdgcn_s_getreg((3 << 11) | 20) & 0xFu; }
#define XB_SPIN(cond, bar) do { unsigned _sp = 0; while (cond) { __builtin_amdgcn_s_sleep(1); \
    if ((++_sp & 255u) == 0u) { if (xb_ld(&(bar)[XB_TMO])) break; if (_sp > XB_SPIN_CAP) { atomicAdd(&(bar)[XB_TMO], 1u); break; } } } } while (0)
struct XcdBarrier { unsigned* bar; unsigned x; volatile LAS unsigned* st; };
DI XcdBarrier xcd_barrier_post(unsigned* bar, volatile LAS unsigned* st) {
    XcdBarrier b; b.bar = bar; b.x = xb_xcc_id(); b.st = st;
    if (threadIdx.x == 0) (void)xb_add(&bar[XB_XCNT(b.x)], 1u);
    return b;
}
DI void xcd_barrier_complete(unsigned* bar, unsigned x, unsigned& nloc, unsigned& nx) {
    const unsigned G = gridDim.x * gridDim.y * gridDim.z;
    unsigned sum, cnt, mine, sp = 0u;
    for (;;) {
        sum = 0u; cnt = 0u; mine = 0u;
#pragma unroll
        for (unsigned j = 0; j < 16; ++j) { const unsigned c = xb_ld(&bar[XB_XCNT(j)]); sum += c; cnt += (c > 0u) ? 1u : 0u; mine = (j == x) ? c : mine; }
        if (sum == G) break;
        __builtin_amdgcn_s_sleep(1);
        if ((++sp & 255u) == 0u) { if (xb_ld(&bar[XB_TMO])) break; if (sp > XB_SPIN_CAP) { atomicAdd(&bar[XB_TMO], 1u); break; } }
    }
    nloc = mine > 0u ? mine : 1u; nx = cnt > 0u ? cnt : 1u;
}
DI void xcd_barrier(const XcdBarrier& b) {
    asm volatile("s_waitcnt vmcnt(0)" ::: "memory");
    __syncthreads();
    if (threadIdx.x == 0) {
        unsigned* bar = b.bar;
        __builtin_amdgcn_s_waitcnt(0);
        unsigned nloc = b.st[0], nx = b.st[1];
        if (nloc == 0u) { xcd_barrier_complete(bar, b.x, nloc, nx); b.st[0] = nloc; b.st[1] = nx; }
        const unsigned old = xb_add(&bar[XB_XSUB(b.x)], 1u);
        const unsigned gen = old / nloc;
        if (old + 1u == (gen + 1u) * nloc) {
            __builtin_amdgcn_fence(__ATOMIC_RELEASE, "agent");
            asm volatile("s_waitcnt vmcnt(0)" ::: "memory");
            const unsigned og = xb_add(&bar[XB_TOP], 1u);
            const unsigned tg = og / nx;
            if (og + 1u == (tg + 1u) * nx) xb_add(&bar[XB_TOPGEN], 1u);
            else XB_SPIN(xb_ld(&bar[XB_TOPGEN]) == tg, bar);
            __builtin_amdgcn_fence(__ATOMIC_ACQUIRE, "agent");
            xb_add(&bar[XB_XGEN(b.x)], 1u);
            asm volatile("s_waitcnt vmcnt(0)" ::: "memory");
        } else {
            XB_SPIN(xb_ld(&bar[XB_XGEN(b.x)]) == gen, bar);
            __builtin_amdgcn_fence(__ATOMIC_ACQUIRE, "agent");
            asm volatile("s_waitcnt vmcnt(0)" ::: "memory");
        }
    }
    __syncthreads();
}

__global__ void __launch_bounds__(512, 2) fwd_megakernel(Params p) {
    __shared__ __attribute__((aligned(16))) unsigned char smem[131072];
    __shared__ uint4 xb_words;
    cg::grid_group grid = cg::this_grid();
    const int nb = gridDim.x, bid = blockIdx.x;
    if (threadIdx.x == 0) xb_words = make_uint4(0u, 0u, 0u, 0u);
    __syncthreads();
    XcdBarrier xb = xcd_barrier_post((unsigned*)(p.ws + OFF_BAR), (volatile LAS unsigned*)&xb_words);
    if (p.phase_end > 1000) grid.sync();
    for (int ph = p.phase_begin; ph < p.phase_end; ++ph) {
        unsigned char* ws = p.ws;
        bf16_t* H = (bf16_t*)(ws + OFF_H);
        bf16_t* Z = (bf16_t*)(ws + OFF_Z);
        bf16_t* VT = (bf16_t*)(ws + OFF_VT);
        bf16_t* MIX = (bf16_t*)(ws + OFF_MIX);
        bf16_t* WIN = (bf16_t*)(ws + OFF_WIN);
        bf16_t* WOUT = (bf16_t*)(ws + OFF_WOUT);
        bf16_t* WMEM = (bf16_t*)(ws + OFF_WMEM);
        bf16_t* PW = (bf16_t*)(ws + OFF_PW);
        bf16_t* MH = (bf16_t*)(ws + OFF_MH);
        bf16_t* KM = (bf16_t*)(ws + OFF_KM);
        bf16_t* VMT = (bf16_t*)(ws + OFF_VMT);
        float* ROPE = (float*)(ws + OFF_ROPE);
        if (ph == 0) {
            for (int i = bid; i < 1928; i += nb) {
                if (i < 1152) { const int l = i / 576, j = i % 576, kt = j / 36, ntile = j % 36;
                    transpose_tile(p.w_in + (size_t)l * DM * INW, INW, WIN + (size_t)l * INW * DM, DM, kt * 64, ntile * 64, smem);
                } else if (i < 1664) { const int ii = i - 1152, l = ii / 256, j = ii % 256, kt = j / 16, ntile = j % 16;
                    transpose_tile(p.w_out + (size_t)l * DM * DM, DM, WOUT + (size_t)l * DM * DM, DM, kt * 64, ntile * 64, smem);
                } else if (i < 1920) { const int ii = i - 1664, l = ii / 128, j = ii % 128, kt = j / 8, ntile = j % 8;
                    transpose_tile(p.w_mem_kv + (size_t)l * DM * 512, 512, WMEM + (size_t)l * 512 * DM, DM, kt * 64, ntile * 64, smem);
                } else { const int ii = i - 1920;
                    transpose_tile(p.pool_w + (size_t)ii * 4096, 64, PW + (size_t)ii * 4096, 64, 0, 0, smem);
                }
            }
            {
                const int tid = opaque_tid(), lane = tid & 63, wave = tid >> 6;
                constexpr int NR = NTOK + 2 * NMEMTOK;
                auto desc = [&](int i, const float*& src, const float*& g, bf16_t*& dst) {
                    if (i < NTOK) { src = (i < NPROMPT) ? p.x_prompt + (size_t)i * DM : p.x_sample + (size_t)(i - NPROMPT) * DM; g = p.norm_pre; dst = H + (size_t)i * DM; }
                    else { const int ii = i - NTOK, l = ii / NMEMTOK, mt = ii % NMEMTOK;
                           src = (mt < 4096) ? p.mem_prompt + (size_t)mt * DM : p.mem_sample + (size_t)(mt - 4096) * DM; g = p.mem_norm + l * DM; dst = MH + ((size_t)l * NMEMTOK + mt) * DM; }
                };
                int i = bid * 8 + wave;
                if (i < NR) {
                    const float *s, *g; bf16_t* d; desc(i, s, g, d);
                    RowIn cur = rms_row_load(s, lane);
                    for (; i < NR; i += nb * 8) {
                        const int in = (i + nb * 8 < NR) ? i + nb * 8 : NR - 1;
                        const float *s2, *g2; bf16_t* d2; desc(in, s2, g2, d2);
                        const RowIn nxt = rms_row_load(s2, lane);
                        rms_row_finish(cur, g, d, lane);
                        cur = nxt; g = g2; d = d2;
                    }
                }
            }
            { const int tid = opaque_tid(); for (int i = bid * 512 + tid; i < 1024; i += nb * 512) rope_entry(i, ROPE); }
        } else {
            const int l = (ph - 1) >> 2, sub = (ph - 1) & 3;
            if (sub == 0) {
                EpiArgs e; e.C = Z; e.VT = VT; e.qn = p.q_norm + l * 64; e.kn = p.k_norm + l * 64; e.rope = ROPE;
                const bf16_t* Wl = WIN + (size_t)l * INW * DM;
                EpiArgs e2; e2.C = KM + (size_t)l * NMEMTOK * 256; e2.VT = VMT + (size_t)l * NMEMTOK * 256; e2.qn = nullptr; e2.kn = nullptr; e2.rope = nullptr;
                const bf16_t* Wm = WMEM + (size_t)l * 512 * DM;
                const bf16_t* Am = MH + (size_t)l * NMEMTOK * DM;
                auto tile1 = [&](int i, const bf16_t*& ta, const bf16_t*& tb, int& tm0, int& tn0) {
                    if (i < 1728) {
                        const int j = i >> 3, mg = j / 72, rem = j % 72;
                        tm0 = ((i & 7) * 24 + mg * 8 + (rem & 7)) * 256; tn0 = (rem >> 3) * 256; ta = H; tb = Wl;
                    } else { const int j = i - 1728; tm0 = (j >> 1) * 256; tn0 = (j & 1) * 256; ta = Am; tb = Wm; }
                };
                bool pre = false;
                for (int i = bid; i < 1728 + 40; i += nb) {
                    const bf16_t *ta, *tb, *na = nullptr, *nbp = nullptr; int tm0, tn0, xm = 0, xn = 0;
                    tile1(i, ta, tb, tm0, tn0);
                    if (i + nb < 1728 + 40) tile1(i + nb, na, nbp, xm, xn);
                    const bool nperm = (i + nb < 1728) ? !(xn >= 512 && xn < 1152) : (xn == 0);
                    if (i < 1728) gemm_tile<0>(ta, tb, tm0, tn0, e, smem, pre, na, nbp, xm, xn, nperm);
                    else gemm_tile<2>(ta, tb, tm0, tn0, e2, smem, pre, na, nbp, xm, xn, nperm);
                    pre = (na != nullptr);
                }
            } else if (sub == 1) {
                const int lane = opaque_tid() & 63;
                float gq = fabsf(p.q_norm[l * 64 + lane]), gk = fabsf(p.k_norm[l * 64 + lane]);
                gq = wave_max(gq); gk = wave_max(gk);
                const float mfix = 8.0f * gq * gk * 1.02f * L2E;
                const bool fixm = mfix < 28.0f;
                for (int i = bid; i < 3072; i += nb) {
                    if (i < 1536) {
                        int b, kvh, j, T; size_t tok0, vtb;
                        if (i < 512) { const int R = i >> 8, ip = i & 255, grp = ip & 7; j = R * 32 + (ip >> 3); b = grp >> 1; kvh = grp & 1; T = 4096;
                            tok0 = (size_t)NPROMPT + (size_t)b * 4096; vtb = (size_t)NPROMPT * 128 + ((size_t)(b * 2 + kvh) * 64) * 4096; }
                        else { const int ii = i - 512, R = ii >> 8, ip = ii & 255, grp = R * 8 + (ip & 7); j = ip >> 3; b = grp >> 1; kvh = grp & 1; T = 2048;
                            tok0 = (size_t)b * 2048; vtb = ((size_t)(b * 2 + kvh) * 64) * 2048; }
                        const int qblk = j >> 2, head = kvh * 4 + (j & 3);
                        const size_t q0 = tok0 + (size_t)qblk * 256;
                        if (fixm) attn_item<true>(Z + q0 * INW + 512 + head * 64, INW, Z + tok0 * INW + 1024 + kvh * 64, INW, VT + vtb, T, T,
                                  MIX + q0 * 1024 + 256 + head * 64, Z + q0 * INW + 1280 + head * 64, smem, mfix);
                        else attn_item<false>(Z + q0 * INW + 512 + head * 64, INW, Z + tok0 * INW + 1024 + kvh * 64, INW, VT + vtb, T, T,
                                  MIX + q0 * 1024 + 256 + head * 64, Z + q0 * INW + 1280 + head * 64, smem, 0.f);
                    } else if (i < 2304) {
                        const int ii = i - 1536, qb = ii >> 2, hx = ii & 3;
                        const size_t q0 = (size_t)qb * 256;
                        const int b = (q0 < NPROMPT) ? (int)(q0 >> 11) : 16 + (int)((q0 - NPROMPT) >> 12);
cross_item(Z + q0 * INW + 1792 + hx * 64, KM + ((size_t)l * NMEMTOK + (size_t)b * 256) * 256 + hx * 64,
                                   VMT + (size_t)l * NMEMTOK * 256 + ((size_t)(b * 4 + hx) * 64) * 256,
                                   MIX + q0 * 1024 + 768 + hx * 64, Z + q0 * INW + 2048 + hx * 64, smem);
                    } else {
                        pool_item(Z, PW + (size_t)l * 4 * 4096, p.pool_scale + l * 256, MIX, (i - 2304) * 64, smem);
                    }
                }
            } else if (sub == 2) {
                EpiArgs e; e.C = H; e.VT = nullptr; e.qn = nullptr; e.kn = nullptr; e.rope = nullptr;
                const bf16_t* Wl = WOUT + (size_t)l * DM * DM;
                auto tile2 = [&](int i, int& tm0, int& tn0) {
                    const int j = i >> 3, mg = j >> 5, rem = j & 31;
                    tm0 = ((i & 7) * 24 + mg * 8 + (rem & 7)) * 256; tn0 = (rem >> 3) * 256;
                };
                bool pre = false;
                for (int i = bid; i < 768; i += nb) {
                    int tm0, tn0, xm = 0, xn = 0; tile2(i, tm0, tn0);
                    const bool more = (i + nb < 768);
                    if (more) tile2(i + nb, xm, xn);
                    gemm_tile<1>(MIX, Wl, tm0, tn0, e, smem, pre, more ? MIX : nullptr, Wl, xm, xn, true);
                    pre = more;
                }
            } else {
                const bool last = (l == DEPTH - 1);
                auto xsrc = [&](int i) -> const float* {
                    return (l == 0) ? ((i < NPROMPT) ? p.x_prompt + (size_t)i * DM : p.x_sample + (size_t)(i - NPROMPT) * DM) : p.out + (size_t)i * DM; };
                const int tid = opaque_tid(), lane = tid & 63, wave = tid >> 6;
                int i = bid * 8 + wave;
                if (i < NTOK) {
                    PostIn cur = post_row_load(xsrc(i), H + (size_t)i * DM, lane);
                    for (; i < NTOK; i += nb * 8) {
                        const int in = (i + nb * 8 < NTOK) ? i + nb * 8 : i;
                        const PostIn nxt = post_row_load(xsrc(in), H + (size_t)in * DM, lane);
                        post_row_finish(cur, H + (size_t)i * DM, p.norm_post + l * DM, p.norm_pre + (last ? l : l + 1) * DM, p.out + (size_t)i * DM, last, lane);
                        cur = nxt;
                    }
                }
            }
        }
        if (ph + 1 < p.phase_end) xcd_barrier(xb);
    }
}

extern "C" void kernel_launch(void* const* d_in, const int* in_sizes, int n_in, void* d_out, int out_size, void* d_ws, size_t ws_size,
                              hipStream_t stream) {
    static int grid_blocks = 0;
    if (!grid_blocks) {
        int dev = 0, cus = 0, per_cu = 0;
        hipGetDevice(&dev);
        hipDeviceGetAttribute(&cus, hipDeviceAttributeMultiprocessorCount, dev);
        hipOccupancyMaxActiveBlocksPerMultiprocessor(&per_cu, fwd_megakernel, 512, 0);
        if (per_cu > 1) per_cu = 1;
        if (per_cu < 1) per_cu = 1;
        grid_blocks = cus * per_cu;
    }
    Params p{};
    p.x_prompt = (const float*)d_in[0]; p.x_sample = (const float*)d_in[1]; p.mem_prompt = (const float*)d_in[2]; p.mem_sample = (const float*)d_in[3];
    p.norm_pre = (const float*)d_in[4]; p.norm_post = (const float*)d_in[5]; p.w_in = (const float*)d_in[6]; p.pool_w = (const float*)d_in[7];
    p.pool_scale = (const float*)d_in[8]; p.q_norm = (const float*)d_in[9]; p.k_norm = (const float*)d_in[10]; p.mem_norm = (const float*)d_in[11];
    p.w_mem_kv = (const float*)d_in[12]; p.w_out = (const float*)d_in[13];
    p.out = (float*)d_out; p.ws = (unsigned char*)d_ws;
    p.phase_begin = 0; p.phase_end = 1 + 4 * DEPTH;
    if (ws_size < WS_TOTAL) { fprintf(stderr, "workspace too small: %zu < %zu\n", ws_size, (size_t)WS_TOTAL); return; }
    hipMemsetAsync((unsigned char*)d_ws + OFF_BAR, 0, BAR_BYTES, stream);
    void* args[] = {&p};
    hipError_t e = hipLaunchCooperativeKernel((void*)fwd_megakernel, dim3(grid_blocks), dim3(512), args, 0, stream);
    if (e != hipSuccess) fprintf(stderr, "cooperative launch failed: %s (grid %d)\n", hipGetErrorString(e), grid_blocks);
}
```

```cpp
#include <hip/hip_runtime.h>
#include <hip/hip_cooperative_groups.h>
#include <stdint.h>
#include <cstdio>
namespace cg = cooperative_groups;

typedef unsigned short bf16_t;
typedef short bf16x8 __attribute__((ext_vector_type(8)));
typedef float f32x4 __attribute__((ext_vector_type(4)));
typedef float f32x16 __attribute__((ext_vector_type(16)));
typedef unsigned u32x4 __attribute__((ext_vector_type(4)));
typedef unsigned u32x2 __attribute__((ext_vector_type(2)));
typedef __bf16 bf16x2_t __attribute__((ext_vector_type(2)));
typedef float f32x2_t __attribute__((ext_vector_type(2)));
#define DI __device__ __forceinline__

constexpr int NTOK = 49152;
constexpr int NPROMPT = 32768;
constexpr int DM = 1024;
constexpr int INW = 2304;
constexpr int NMEMTOK = 5120;
constexpr int DEPTH = 2;
constexpr float EPS = 1e-6f;
constexpr float L2E = 1.4426950408889634f;

constexpr size_t OFF_H    = 0;
constexpr size_t OFF_Z    = OFF_H + (size_t)NTOK * DM * 2;
constexpr size_t OFF_VT   = OFF_Z + (size_t)NTOK * INW * 2;
constexpr size_t OFF_MIX  = OFF_VT + (size_t)NTOK * 128 * 2;
constexpr size_t OFF_WIN  = OFF_MIX + (size_t)NTOK * DM * 2;
constexpr size_t OFF_WOUT = OFF_WIN + (size_t)DEPTH * INW * DM * 2;
constexpr size_t OFF_WMEM = OFF_WOUT + (size_t)DEPTH * DM * DM * 2;
constexpr size_t OFF_PW   = OFF_WMEM + (size_t)DEPTH * 512 * DM * 2;
constexpr size_t OFF_MH   = OFF_PW + (size_t)DEPTH * 4 * 64 * 64 * 2;
constexpr size_t OFF_KM   = OFF_MH + (size_t)DEPTH * NMEMTOK * DM * 2;
constexpr size_t OFF_VMT  = OFF_KM + (size_t)DEPTH * NMEMTOK * 256 * 2;
constexpr size_t OFF_ROPE = OFF_VMT + (size_t)DEPTH * NMEMTOK * 256 * 2;
constexpr size_t OFF_BAR  = OFF_ROPE + 64 * 16 * 2 * 4;
constexpr size_t BAR_BYTES = 3456 * 4;
constexpr size_t WS_TOTAL = OFF_BAR + BAR_BYTES;

struct Params {
    const float* x_prompt; const float* x_sample; const float* mem_prompt; const float* mem_sample;
    const float* norm_pre; const float* norm_post; const float* w_in; const float* pool_w; const float* pool_scale;
    const float* q_norm; const float* k_norm; const float* mem_norm; const float* w_mem_kv; const float* w_out;
    float* out; unsigned char* ws;
    int phase_begin; int phase_end;
};

DI unsigned pk_bf16(float a, float b) {
    f32x2_t v = {a, b};
    bf16x2_t r = __builtin_convertvector(v, bf16x2_t);
    return __builtin_bit_cast(unsigned, r);
}
DI int opaque_tid() { int t = threadIdx.x; asm volatile("" : "+v"(t)); return t; }
DI void lds_barrier() { asm volatile("s_waitcnt lgkmcnt(0)\n\ts_barrier" ::: "memory"); }
DI float bflo(unsigned u) { return __uint_as_float(u << 16); }
DI float bfhi(unsigned u) { return __uint_as_float(u & 0xffff0000u); }
template <int CTRL> DI float dppf(float v) { return __uint_as_float(__builtin_amdgcn_update_dpp(0u, __float_as_uint(v), CTRL, 0xf, 0xf, true)); }
DI float x16_add(float v) { auto r = __builtin_amdgcn_permlane16_swap(__float_as_uint(v), __float_as_uint(v), false, false); return __uint_as_float(r[0]) + __uint_as_float(r[1]); }
DI float x32_add(float v) { auto r = __builtin_amdgcn_permlane32_swap(__float_as_uint(v), __float_as_uint(v), false, false); return __uint_as_float(r[0]) + __uint_as_float(r[1]); }
DI float x16_max(float v) { auto r = __builtin_amdgcn_permlane16_swap(__float_as_uint(v), __float_as_uint(v), false, false); return fmaxf(__uint_as_float(r[0]), __uint_as_float(r[1])); }
DI float x32_max(float v) { auto r = __builtin_amdgcn_permlane32_swap(__float_as_uint(v), __float_as_uint(v), false, false); return fmaxf(__uint_as_float(r[0]), __uint_as_float(r[1])); }
DI float wave_sum(float v) {
    v += dppf<0xB1>(v); v += dppf<0x4E>(v); v += dppf<0x141>(v); v += dppf<0x140>(v);
    v = x16_add(v); v = x32_add(v);
    return v;
}
DI float wave_max(float v) {
    v = fmaxf(v, dppf<0xB1>(v)); v = fmaxf(v, dppf<0x4E>(v)); v = fmaxf(v, dppf<0x141>(v)); v = fmaxf(v, dppf<0x140>(v));
    v = x16_max(v); v = x32_max(v);
    return v;
}
DI float xhalf_max(float v) {
    auto r = __builtin_amdgcn_permlane32_swap(__float_as_uint(v), __float_as_uint(v), false, false);
    return fmaxf(__uint_as_float(r[0]), __uint_as_float(r[1]));
}
DI float silu_f(float x) { return x * __builtin_amdgcn_rcpf(1.0f + __builtin_amdgcn_exp2f(-x * L2E)); }
DI f32x4 mfma16(bf16x8 a, bf16x8 b, f32x4 c) { return __builtin_amdgcn_mfma_f32_16x16x32_bf16(a, b, c, 0, 0, 0); }
DI f32x16 mfma32(bf16x8 a, bf16x8 b, f32x16 c) { return __builtin_amdgcn_mfma_f32_32x32x16_bf16(a, b, c, 0, 0, 0); }

DI void transpose_tile(const float* __restrict__ src, int ldn, bf16_t* __restrict__ dst, int ldk, int k0, int n0, unsigned char* smem) {
    float* tile = (float*)smem;
    const int tid = opaque_tid();
    __syncthreads();
#pragma unroll
    for (int i = 0; i < 2; ++i) {
        const int id = tid + 512 * i, r = id >> 4, c4 = id & 15;
        const f32x4 v = *(const f32x4*)(src + (size_t)(k0 + r) * ldn + n0 + c4 * 4);
        tile[r * 65 + c4 * 4 + 0] = v[0]; tile[r * 65 + c4 * 4 + 1] = v[1]; tile[r * 65 + c4 * 4 + 2] = v[2]; tile[r * 65 + c4 * 4 + 3] = v[3];
    }
    __syncthreads();
    {
        const int n = tid >> 3, kc = tid & 7;
        float v[8];
#pragma unroll
        for (int j = 0; j < 8; ++j) v[j] = tile[(kc * 8 + j) * 65 + n];
        u32x4 o; o.x = pk_bf16(v[0], v[1]); o.y = pk_bf16(v[2], v[3]); o.z = pk_bf16(v[4], v[5]); o.w = pk_bf16(v[6], v[7]);
        *(u32x4*)(dst + (size_t)(n0 + n) * ldk + k0 + kc * 8) = o;
    }
}

struct RowIn { f32x4 v[4]; };
DI RowIn rms_row_load(const float* __restrict__ src, int lane) {
    RowIn r;
#pragma unroll
    for (int j = 0; j < 2; ++j) { r.v[2 * j] = *(const f32x4*)(src + j * 512 + lane * 8); r.v[2 * j + 1] = *(const f32x4*)(src + j * 512 + lane * 8 + 4); }
    return r;
}
DI void rms_row_finish(const RowIn& in, const float* __restrict__ g, bf16_t* __restrict__ dst, int lane) {
    f32x4 v[4]; float ss = 0.f;
#pragma unroll
    for (int j = 0; j < 4; ++j) { v[j] = in.v[j]; ss += v[j][0] * v[j][0] + v[j][1] * v[j][1] + v[j][2] * v[j][2] + v[j][3] * v[j][3]; }
    ss = wave_sum(ss);
    const float r = rsqrtf(ss * (1.0f / 1024.0f) + EPS);
#pragma unroll
    for (int j = 0; j < 2; ++j) {
        const f32x4 g0 = *(const f32x4*)(g + j * 512 + lane * 8), g1 = *(const f32x4*)(g + j * 512 + lane * 8 + 4);
        const f32x4 a = v[2 * j], b = v[2 * j + 1];
        u32x4 o;
        o.x = pk_bf16(a[0] * r * g0[0], a[1] * r * g0[1]); o.y = pk_bf16(a[2] * r * g0[2], a[3] * r * g0[3]);
        o.z = pk_bf16(b[0] * r * g1[0], b[1] * r * g1[1]); o.w = pk_bf16(b[2] * r * g1[2], b[3] * r * g1[3]);
        *(u32x4*)(dst + j * 512 + lane * 8) = o;
    }
}

DI void rope_entry(int idx, float* table) {
    const int n = idx >> 4, pp = idx & 15;
    double fd = 1.0;
    for (int i = 0; i < pp; ++i) fd *= 0.5623413251903491;
    const float f = (float)fd;
    const float a = (float)n * f;
    double r = (double)a;
    const double k = rint(r * 0.15915494309189535);
    r -= k * 6.283185307179586;
    const double r2 = r * r;
    double sn = r, cs = 1.0, ts = r, tc = 1.0;
    for (int i = 1; i <= 16; ++i) {
        tc = -tc * r2 / (double)((2 * i - 1) * (2 * i));
        ts = -ts * r2 / (double)((2 * i) * (2 * i + 1));
        cs += tc; sn += ts;
    }
    table[idx * 2] = (float)cs; table[idx * 2 + 1] = (float)sn;
}

struct EpiArgs {
    bf16_t* C;
    bf16_t* VT;
    const float* qn; const float* kn; const float* rope;
};

DI int g8_lds_byte(int r, int c) { const int st = (r >> 4) * 2 + (c >> 5), rr = r & 15, cc = c & 31, ob = rr * 64 + cc * 2; return st * 1024 + (ob ^ (((ob >> 9) & 1) << 5)); }
DI void g8_stage_rc(int b, int& R, int& C) { const int st = b >> 10, sb = b & 1023, swz = sb ^ (((sb >> 9) & 1) << 5); R = (st >> 1) * 16 + (swz >> 6); C = (st & 1) * 32 + ((swz & 63) >> 1); }

DI const unsigned char* uniform_ptr(const void* p) {
    const unsigned long long v = (unsigned long long)p;
    const unsigned lo = __builtin_amdgcn_readfirstlane((unsigned)v), hi = __builtin_amdgcn_readfirstlane((unsigned)(v >> 32));
    return (const unsigned char*)(((unsigned long long)hi << 32) | lo);
}

template <int MODE>
DI void gemm_tile(const bf16_t* __restrict__ A, const bf16_t* __restrict__ Bt, int m0, int n0, const EpiArgs& e, unsigned char* smem,
                  bool prefetched, const bf16_t* __restrict__ nA, const bf16_t* __restrict__ nB, int nm0, int nn0, bool nperm) {
    constexpr int K = 1024, BK = 64, HALF = 128, HTB = 16384, nt = K / BK;
    const int tid = opaque_tid(), lane = tid & 63, wave = __builtin_amdgcn_readfirstlane(tid >> 6);
    const int wr = wave >> 2, wc = wave & 3, fr = lane & 15, fq = lane >> 4;
    int sR0, sC0, sR1, sC1;
    g8_stage_rc(tid * 16, sR0, sC0); g8_stage_rc(tid * 16 + 8192, sR1, sC1);
    const unsigned so0b = (unsigned)(sR0 * K + sC0) * 2u, so1b = (unsigned)(sR1 * K + sC1) * 2u;
    const bool perm = (MODE == 1) ? true : ((MODE == 2) ? (n0 == 0) : !(n0 >= 512 && n0 < 1152));
    __attribute__((address_space(3))) unsigned char* lds = (__attribute__((address_space(3))) unsigned char*)smem;
#define G8_SA(b, h) (((b) * 2 + (h)) * HTB)
#define G8_SB(b, h) ((4 + (b) * 2 + (h)) * HTB)
#define G8_PERMOFF(SO) ({ const unsigned R_ = (SO) >> 11, rho_ = R_ & 31u, i_ = rho_ & 15u; const unsigned p_ = 8u * (i_ >> 2) + 4u * (rho_ >> 4) + (i_ & 3u); (SO) + (p_ - rho_) * 2048u; })
#define G8_STAGE_B(POFF, BASE, br, kt, PERM) { const unsigned char* g_ = uniform_ptr((BASE) + (size_t)(br) * K + (kt) * BK); \
        const unsigned b0_ = (PERM) ? G8_PERMOFF(so0b) : so0b, b1_ = (PERM) ? G8_PERMOFF(so1b) : so1b; \
        __builtin_amdgcn_global_load_lds((const __attribute__((address_space(1))) unsigned*)(g_ + b0_), (__attribute__((address_space(3))) unsigned*)(lds + (POFF) + tid * 16), 16, 0, 0); \
        __builtin_amdgcn_global_load_lds((const __attribute__((address_space(1))) unsigned*)(g_ + b1_), (__attribute__((address_space(3))) unsigned*)(lds + (POFF) + tid * 16 + 8192), 16, 0, 0); }
#define G8_STAGE(POFF, BASE, br, kt) { const unsigned char* g_ = uniform_ptr((BASE) + (size_t)(br) * K + (kt) * BK); \
        __builtin_amdgcn_global_load_lds((const __attribute__((address_space(1))) unsigned*)(g_ + so0b), (__attribute__((address_space(3))) unsigned*)(lds + (POFF) + tid * 16), 16, 0, 0); \
        __builtin_amdgcn_global_load_lds((const __attribute__((address_space(1))) unsigned*)(g_ + so1b), (__attribute__((address_space(3))) unsigned*)(lds + (POFF) + tid * 16 + 8192), 16, 0, 0); }
    const int lane_off = (fr * 64 + fq * 16) ^ ((fr >> 3) << 5);
    const unsigned ldsA = (unsigned)(size_t)lds + (unsigned)(lane_off + wr * 8192);
    const unsigned ldsB = (unsigned)(size_t)lds + (unsigned)(lane_off + wc * 4096);
#define G8_DSR(dst, addr, OFF) asm volatile("ds_read_b128 %0, %1 offset:" #OFF : "=v"(dst) : "v"(addr))
#define G8_LDA(dst, b, h) { const unsigned a_ = ldsA + G8_SA(b, h); \
        G8_DSR(dst[0][0], a_, 0); G8_DSR(dst[0][1], a_, 1024); G8_DSR(dst[1][0], a_, 2048); G8_DSR(dst[1][1], a_, 3072); \
        G8_DSR(dst[2][0], a_, 4096); G8_DSR(dst[2][1], a_, 5120); G8_DSR(dst[3][0], a_, 6144); G8_DSR(dst[3][1], a_, 7168); }
#define G8_LDB(dst, b, h) { const unsigned a_ = ldsB + G8_SB(b, h); \
        G8_DSR(dst[0][0], a_, 0); G8_DSR(dst[0][1], a_, 1024); G8_DSR(dst[1][0], a_, 2048); G8_DSR(dst[1][1], a_, 3072); }
#define G8_TIE_A(AT) asm volatile("s_waitcnt lgkmcnt(0)" : "+v"(AT[0][0]), "+v"(AT[0][1]), "+v"(AT[1][0]), "+v"(AT[1][1]), "+v"(AT[2][0]), "+v"(AT[2][1]), "+v"(AT[3][0]), "+v"(AT[3][1]) :: "memory")
#define G8_TIE_B(BX) asm volatile("s_waitcnt lgkmcnt(0)" : "+v"(BX[0][0]), "+v"(BX[0][1]), "+v"(BX[1][0]), "+v"(BX[1][1]) :: "memory")
#define G8_MMA(ai, bj, AT, BX) { __builtin_amdgcn_s_setprio(1); \
        _Pragma("unroll") for (int m = 0; m < 4; ++m) _Pragma("unroll") for (int n = 0; n < 2; ++n) _Pragma("unroll") for (int k = 0; k < 2; ++k) \
            acc[ai][bj][m][n] = mfma16(BX[n][k], AT[m][k], acc[ai][bj][m][n]); \
        __builtin_amdgcn_s_setprio(0); }
#define G8_WV(n) asm volatile("s_waitcnt vmcnt(" #n ")" ::: "memory")
#define G8_WL(n) asm volatile("s_waitcnt lgkmcnt(" #n ")" ::: "memory")
#define G8_BAR __builtin_amdgcn_s_barrier()
#define G8_SCHED __builtin_amdgcn_sched_barrier(0)
    f32x4 acc[2][2][4][2];
#pragma unroll
    for (int a = 0; a < 2; ++a)
#pragma unroll
        for (int b = 0; b < 2; ++b)
#pragma unroll
            for (int m = 0; m < 4; ++m)
#pragma unroll
                for (int n = 0; n < 2; ++n) acc[a][b][m][n] = (f32x4){0.f, 0.f, 0.f, 0.f};
    bf16x8 At[4][2], B0[2][2], B1[2][2];
    if (!prefetched) {
        __syncthreads();
        G8_STAGE_B(G8_SB(0, 0), Bt, n0, 0, perm); G8_STAGE(G8_SA(0, 0), A, m0, 0);
        G8_STAGE_B(G8_SB(0, 1), Bt, n0 + HALF, 0, perm); G8_STAGE(G8_SA(0, 1), A, m0 + HALF, 0);
        if (wr == 1) G8_BAR;
        G8_WV(4); G8_BAR;
        G8_STAGE_B(G8_SB(1, 0), Bt, n0, 1, perm); G8_STAGE(G8_SA(1, 0), A, m0, 1); G8_STAGE_B(G8_SB(1, 1), Bt, n0 + HALF, 1, perm);
        G8_WV(6); G8_BAR;
    } else {
        G8_WV(0);
        if (wr == 1) G8_BAR;
        G8_BAR;
        G8_BAR;
    }
    for (int t = 0; t < nt - 2; t += 2) {
        G8_LDB(B0, 0, 0); G8_SCHED; G8_LDA(At, 0, 0); G8_STAGE(G8_SA(1, 1), A, m0 + HALF, t + 1);
        G8_WL(8); G8_BAR; G8_TIE_B(B0); G8_TIE_A(At); G8_MMA(0, 0, At, B0); G8_BAR; G8_SCHED;
        G8_LDB(B1, 0, 1); G8_STAGE_B(G8_SB(0, 0), Bt, n0, t + 2, perm);
        G8_BAR; G8_TIE_B(B1); G8_MMA(0, 1, At, B1); G8_BAR;
        G8_LDA(At, 0, 1); G8_STAGE(G8_SA(0, 0), A, m0, t + 2);
        G8_BAR; G8_TIE_A(At); G8_MMA(1, 0, At, B0); G8_BAR; G8_SCHED;
        G8_STAGE_B(G8_SB(0, 1), Bt, n0 + HALF, t + 2, perm);
        G8_WV(6); G8_BAR; G8_MMA(1, 1, At, B1); G8_BAR;
        G8_LDB(B0, 1, 0); G8_SCHED; G8_LDA(At, 1, 0); G8_STAGE(G8_SA(0, 1), A, m0 + HALF, t + 2);
        G8_WL(8); G8_BAR; G8_TIE_B(B0); G8_TIE_A(At); G8_MMA(0, 0, At, B0); G8_BAR; G8_SCHED;
        G8_LDB(B1, 1, 1); G8_STAGE_B(G8_SB(1, 0), Bt, n0, t + 3, perm);
        G8_BAR; G8_TIE_B(B1); G8_MMA(0, 1, At, B1); G8_BAR;
        G8_LDA(At, 1, 1); G8_STAGE(G8_SA(1, 0), A, m0, t + 3);
        G8_BAR; G8_TIE_A(At); G8_MMA(1, 0, At, B0); G8_BAR; G8_SCHED;
        G8_STAGE_B(G8_SB(1, 1), Bt, n0 + HALF, t + 3, perm);
        G8_WV(6); G8_BAR; G8_MMA(1, 1, At, B1); G8_BAR;
    }
    {
        G8_LDB(B0, 0, 0); G8_LDA(At, 0, 0); G8_STAGE(G8_SA(1, 1), A, m0 + HALF, nt - 1);
        G8_BAR; G8_TIE_B(B0); G8_TIE_A(At); G8_MMA(0, 0, At, B0); G8_BAR;
        G8_LDB(B1, 0, 1); G8_BAR; G8_TIE_B(B1); G8_MMA(0, 1, At, B1); G8_BAR;
        G8_LDA(At, 0, 1); G8_WV(4); G8_BAR; G8_TIE_A(At); G8_MMA(1, 0, At, B0); G8_MMA(1, 1, At, B1); G8_BAR;
    }
    {
        G8_LDB(B0, 1, 0); G8_LDA(At, 1, 0); G8_WV(2); G8_BAR; G8_TIE_B(B0); G8_TIE_A(At); G8_MMA(0, 0, At, B0); G8_BAR;
        G8_LDB(B1, 1, 1); G8_WV(0); G8_BAR; G8_TIE_B(B1); G8_MMA(0, 1, At, B1); G8_BAR;
        G8_LDA(At, 1, 1); G8_BAR; G8_TIE_A(At); G8_MMA(1, 0, At, B0); G8_MMA(1, 1, At, B1); G8_BAR;
    }
    if (wr == 0) G8_BAR;
    if (nA != nullptr) {
        G8_STAGE_B(G8_SB(0, 0), nB, nn0, 0, nperm); G8_STAGE(G8_SA(0, 0), nA, nm0, 0);
        G8_STAGE_B(G8_SB(0, 1), nB, nn0 + HALF, 0, nperm); G8_STAGE(G8_SA(0, 1), nA, nm0 + HALF, 0);
        G8_STAGE_B(G8_SB(1, 0), nB, nn0, 1, nperm); G8_STAGE(G8_SA(1, 0), nA, nm0, 1); G8_STAGE_B(G8_SB(1, 1), nB, nn0 + HALF, 1, nperm);
    }
    __builtin_amdgcn_sched_barrier(0);
#undef G8_SA
#undef G8_SB
#undef G8_STAGE
#undef G8_STAGE_B
#undef G8_PERMOFF
#undef G8_LDA
#undef G8_LDB
#undef G8_DSR
#undef G8_TIE_A
#undef G8_TIE_B
#undef G8_MMA
#undef G8_WV
#undef G8_WL
#undef G8_BAR
#undef G8_SCHED

    const int tid_e = opaque_tid(), wave_e = __builtin_amdgcn_readfirstlane(tid_e >> 6);
    const int wr_e = wave_e >> 2, wc_e = wave_e & 3, fr_e = tid_e & 15, fq_e = (tid_e >> 4) & 3;
    const int tok_w = m0 + wr_e * 64 + fr_e;
    const int col_w = n0 + wc_e * 32 + 4 * fq_e;
    const int col_p = n0 + wc_e * 32 + 8 * fq_e;
    if (MODE == 1) {
#pragma unroll
        for (int ai = 0; ai < 2; ++ai)
#pragma unroll
            for (int m = 0; m < 4; ++m) {
                bf16_t* rowp = e.C + (size_t)(tok_w + ai * 128 + m * 16) * 1024 + col_p;
#pragma unroll
                for (int bj = 0; bj < 2; ++bj) {
                    const f32x4 v0 = acc[ai][bj][m][0], v1 = acc[ai][bj][m][1];
                    u32x4 o; o.x = pk_bf16(v0[0], v0[1]); o.y = pk_bf16(v0[2], v0[3]); o.z = pk_bf16(v1[0], v1[1]); o.w = pk_bf16(v1[2], v1[3]);
                    *(u32x4*)(rowp + bj * 128) = o;
                }
            }
    } else if (MODE == 2) {
        if (n0 == 0) {
#pragma unroll
            for (int ai = 0; ai < 2; ++ai)
#pragma unroll
                for (int m = 0; m < 4; ++m) {
                    bf16_t* rowp = e.C + (size_t)(tok_w + ai * 128 + m * 16) * 256 + col_p;
#pragma unroll
                    for (int bj = 0; bj < 2; ++bj) {
                        const f32x4 v0 = acc[ai][bj][m][0], v1 = acc[ai][bj][m][1];
                        u32x4 o; o.x = pk_bf16(v0[0], v0[1]); o.y = pk_bf16(v0[2], v0[3]); o.z = pk_bf16(v1[0], v1[1]); o.w = pk_bf16(v1[2], v1[3]);
                        *(u32x4*)(rowp + bj * 128) = o;
                    }
                }
        } else {
#pragma unroll
            for (int ai = 0; ai < 2; ++ai)
#pragma unroll
                for (int m = 0; m < 4; ++m) {
                    const int mt = tok_w + ai * 128 + m * 16, b = mt >> 8, mm = mt & 255;
#pragma unroll
                    for (int bj = 0; bj < 2; ++bj)
#pragma unroll
                        for (int n = 0; n < 2; ++n) {
                            const int f = (col_w - 256) + bj * 128 + n * 16, hx = f >> 6, d = f & 63;
                            bf16_t* bp = e.VT + ((size_t)(b * 4 + hx) * 64 + d) * 256 + mm;
#pragma unroll
                            for (int j = 0; j < 4; ++j) bp[(size_t)j * 256] = (bf16_t)(pk_bf16(acc[ai][bj][m][n][j], 0.f) & 0xffffu);
                        }
                }
        }
    } else {
        const bool has_qk = (n0 >= 512 && n0 < 1152);
        float* ssx = (float*)(smem + 3 * 16384);
        if (has_qk) {
#pragma unroll
            for (int ai = 0; ai < 2; ++ai)
#pragma unroll
                for (int bj = 0; bj < 2; ++bj)
#pragma unroll
                    for (int m = 0; m < 4; ++m) {
                        float ss = 0.f;
#pragma unroll
                        for (int n = 0; n < 2; ++n)
#pragma unroll
                            for (int j = 0; j < 4; ++j) ss += acc[ai][bj][m][n][j] * acc[ai][bj][m][n][j];
                        ss = x16_add(ss); ss = x32_add(ss);
                        if (fq_e == 0) ssx[((wave_e * 2 + ai) * 2 + bj) * 64 + m * 16 + fr_e] = ss;
                    }
            __syncthreads();
        }
#pragma unroll
        for (int bj = 0; bj < 2; ++bj) {
            const int cb = n0 + bj * 128 + wc_e * 32;
            const int c64 = cb & ~63;
            if (c64 >= 512 && c64 < 1152) {
                const bool isq = c64 < 1024;
                const float* gn = (isq ? e.qn : e.kn) + (wc_e & 1) * 32 + 4 * fq_e;
                const float osc = isq ? 0.125f * L2E : 1.0f;
                const f32x4 g0 = *(const f32x4*)(gn), g1 = *(const f32x4*)(gn + 16);
#pragma unroll
                for (int ai = 0; ai < 2; ++ai)
#pragma unroll
                    for (int m = 0; m < 4; ++m) {
                        const int tok = tok_w + ai * 128 + m * 16;
                        const float ss = ssx[((wave_e * 2 + ai) * 2 + bj) * 64 + m * 16 + fr_e] + ssx[(((wave_e ^ 1) * 2 + ai) * 2 + bj) * 64 + m * 16 + fr_e];
                        const float rinv = rsqrtf(ss * (1.0f / 64.0f) + EPS);
                        const int t = (tok < NPROMPT) ? (tok & 2047) : (tok & 4095);
                        const int ridx = (wc_e & 1) ? (t & 63) : (t >> 6);
                        const f32x4* rt = (const f32x4*)(e.rope + (ridx * 16 + 4 * fq_e) * 2);
                        const f32x4 r01 = rt[0], r23 = rt[1];
                        const float rc[4] = {r01[0], r01[2], r23[0], r23[2]}, rs[4] = {r01[1], r01[3], r23[1], r23[3]};
                        float oa[4], ob[4];
#pragma unroll
                        for (int j = 0; j < 4; ++j) {
                            const float a = acc[ai][bj][m][0][j] * rinv * g0[j], b = acc[ai][bj][m][1][j] * rinv * g1[j];
                            oa[j] = (a * rc[j] - b * rs[j]) * osc; ob[j] = (b * rc[j] + a * rs[j]) * osc;
                        }
                        bf16_t* rowp = e.C + (size_t)tok * INW + cb + 4 * fq_e;
                        u32x2 w0, w1; w0.x = pk_bf16(oa[0], oa[1]); w0.y = pk_bf16(oa[2], oa[3]); w1.x = pk_bf16(ob[0], ob[1]); w1.y = pk_bf16(ob[2], ob[3]);
                        *(u32x2*)(rowp) = w0; *(u32x2*)(rowp + 16) = w1;
                    }
            } else if (c64 >= 1152 && c64 < 1280) {
#pragma unroll
                for (int ai = 0; ai < 2; ++ai)
#pragma unroll
                    for (int m = 0; m < 4; ++m) {
                        const int tok = tok_w + ai * 128 + m * 16;
#pragma unroll
                        for (int n = 0; n < 2; ++n) {
                            const int f = cb + n * 16 + 4 * fq_e - 1152, kvh = f >> 6, d = f & 63;
                            bf16_t* bp; size_t T;
                            if (tok < NPROMPT) { const int b = tok >> 11, t = tok & 2047; T = 2048; bp = e.VT + ((size_t)(b * 2 + kvh) * 64 + d) * 2048 + t; }
                            else { const int b = (tok - NPROMPT) >> 12, t = tok & 4095; T = 4096; bp = e.VT + (size_t)NPROMPT * 128 + ((size_t)(b * 2 + kvh) * 64 + d) * 4096 + t; }
#pragma unroll
                            for (int j = 0; j < 4; ++j) bp[(size_t)j * T] = (bf16_t)(pk_bf16(acc[ai][bj][m][n][j], 0.f) & 0xffffu);
                        }
                    }
            } else {
                const int kind = (c64 < 256) ? 0 : ((c64 >= 1792 && c64 < 2048) ? 2 : 1);
#pragma unroll
                for (int ai = 0; ai < 2; ++ai)
#pragma unroll
                    for (int m = 0; m < 4; ++m) {
                        bf16_t* rowp = e.C + (size_t)(tok_w + ai * 128 + m * 16) * INW + cb + 8 * fq_e;
                        float v[8];
#pragma unroll
                        for (int n = 0; n < 2; ++n)
#pragma unroll
                            for (int j = 0; j < 4; ++j) { const float x = acc[ai][bj][m][n][j]; v[4 * n + j] = (kind == 0) ? x : ((kind == 2) ? x * (0.125f * L2E) : silu_f(x)); }
                        u32x4 o; o.x = pk_bf16(v[0], v[1]); o.y = pk_bf16(v[2], v[3]); o.z = pk_bf16(v[4], v[5]); o.w = pk_bf16(v[6], v[7]);
                        *(u32x4*)(rowp) = o;
                    }
            }
        }
    }
}

#define SB_() __builtin_amdgcn_sched_barrier(0)
#define KFRAG(KS, KB) (*(const bf16x8*)(kp + (KB) * 4096 + k_off + ((((KS) * 2 + h) ^ kswz) << 4)))
#define VFRAG(KK, DB) (*(const bf16x8*)(vp + (DB) * 4096 + v_off + ((((KK) * 2 + h) ^ vswz) << 4)))
#define EXP4(S, I0) { _Pragma("unroll") for (int i_ = (I0); i_ < (I0) + 4; ++i_) { S[i_] = __builtin_amdgcn_exp2f(S[i_] - mb); rs += S[i_]; } }
#define EXP4F(S, I0) { f32x2_t a_ = {S[(I0)], S[(I0) + 1]}, b_ = {S[(I0) + 2], S[(I0) + 3]}; \
        a_ = a_ - (f32x2_t){mb, mb}; b_ = b_ - (f32x2_t){mb, mb}; \
        S[(I0)] = __builtin_amdgcn_exp2f(a_.x); S[(I0) + 1] = __builtin_amdgcn_exp2f(a_.y); S[(I0) + 2] = __builtin_amdgcn_exp2f(b_.x); S[(I0) + 3] = __builtin_amdgcn_exp2f(b_.y); \
        rs2 += (f32x2_t){S[(I0)], S[(I0) + 1]} + (f32x2_t){S[(I0) + 2], S[(I0) + 3]}; }
#define EXPQ(S, I0) { if (FIXM) EXP4F(S, I0) else EXP4(S, I0) }
#define PACK8(S, I0) ({ u32x4 t_; t_.x = pk_bf16(S[(I0)], S[(I0) + 1]); t_.y = pk_bf16(S[(I0) + 2], S[(I0) + 3]); t_.z = pk_bf16(S[(I0) + 4], S[(I0) + 5]); t_.w = pk_bf16(S[(I0) + 6], S[(I0) + 7]); __builtin_bit_cast(bf16x8, t_); })
DI float max8(const f32x16& s, int i0, float mx) {
    mx = fmaxf(fmaxf(mx, s[i0]), s[i0 + 1]); mx = fmaxf(fmaxf(mx, s[i0 + 2]), s[i0 + 3]);
    mx = fmaxf(fmaxf(mx, s[i0 + 4]), s[i0 + 5]); mx = fmaxf(fmaxf(mx, s[i0 + 6]), s[i0 + 7]);
    return mx;
}
#define EXP2F(S, I0) { S[(I0)] = __builtin_amdgcn_exp2f(S[(I0)]); S[(I0) + 1] = __builtin_amdgcn_exp2f(S[(I0) + 1]); rs += S[(I0)] + S[(I0) + 1]; \
        asm volatile("" : "+v"(S[(I0)]), "+v"(S[(I0) + 1]), "+v"(rs)); }
#define PIN1(X) asm volatile("" : "+v"(X))
template <bool DO_PV, bool DO_QK>
DI void attn_step_fix(f32x16& s0, f32x16& s1, f32x16& n0, f32x16& n1, const bf16x8 (&pp)[4], bf16x8 (&pc)[4],
                      f32x16& o0, f32x16& o1, const float m, float& lsum, const bf16x8 (&qf)[4],
                      const unsigned char* kp, const unsigned char* vp, int k_off, int kswz, int v_off, int vswz, int h) {
    bf16x8 va0, vb0, va1, vb1, va2, vb2, va3, vb3, ka0, kb0, ka1, kb1, ka2, kb2, ka3, kb3;
    float rs = 0.f;
    if (DO_PV) { va0 = VFRAG(0, 0); vb0 = VFRAG(0, 1); va1 = VFRAG(1, 0); vb1 = VFRAG(1, 1); }
    EXP2F(s0, 0);  if (DO_PV) { o0 = mfma32(va0, pp[0], o0); va2 = VFRAG(2, 0); vb2 = VFRAG(2, 1); }
    EXP2F(s0, 2);  if (DO_PV) { o1 = mfma32(vb0, pp[0], o1); va3 = VFRAG(3, 0); vb3 = VFRAG(3, 1); }
    EXP2F(s0, 4);  if (DO_PV) { o0 = mfma32(va1, pp[1], o0); } if (DO_QK) { ka0 = KFRAG(0, 0); kb0 = KFRAG(0, 1); }
    EXP2F(s0, 6);  if (DO_PV) { o1 = mfma32(vb1, pp[1], o1); } if (DO_QK) { ka1 = KFRAG(1, 0); kb1 = KFRAG(1, 1); }
    EXP2F(s0, 8);  if (DO_PV) { o0 = mfma32(va2, pp[2], o0); }
    EXP2F(s0, 10); if (DO_PV) { o1 = mfma32(vb2, pp[2], o1); } pc[0] = PACK8(s0, 0); PIN1(pc[0]);
    EXP2F(s0, 12); if (DO_PV) { o0 = mfma32(va3, pp[3], o0); }
    EXP2F(s0, 14); if (DO_PV) { o1 = mfma32(vb3, pp[3], o1); }
    EXP2F(s1, 0);  if (DO_QK) { n0 = mfma32(ka0, qf[0], (f32x16){0.f, 0.f, 0.f, 0.f, 0.f, 0.f, 0.f, 0.f, 0.f, 0.f, 0.f, 0.f, 0.f, 0.f, 0.f, 0.f}); ka2 = KFRAG(2, 0); kb2 = KFRAG(2, 1); } pc[1] = PACK8(s0, 8); PIN1(pc[1]);
    EXP2F(s1, 2);  if (DO_QK) { n1 = mfma32(kb0, qf[0], (f32x16){0.f, 0.f, 0.f, 0.f, 0.f, 0.f, 0.f, 0.f, 0.f, 0.f, 0.f, 0.f, 0.f, 0.f, 0.f, 0.f}); ka3 = KFRAG(3, 0); kb3 = KFRAG(3, 1); }
    EXP2F(s1, 4);  if (DO_QK) { n0 = mfma32(ka1, qf[1], n0); }
    EXP2F(s1, 6);  if (DO_QK) { n1 = mfma32(kb1, qf[1], n1); }
    EXP2F(s1, 8);  if (DO_QK) { n0 = mfma32(ka2, qf[2], n0); } pc[2] = PACK8(s1, 0); PIN1(pc[2]);
    EXP2F(s1, 10); if (DO_QK) { n1 = mfma32(kb2, qf[2], n1); }
    EXP2F(s1, 12); if (DO_QK) { n0 = mfma32(ka3, qf[3], n0); }
    EXP2F(s1, 14); if (DO_QK) { n1 = mfma32(kb3, qf[3], n1); } pc[3] = PACK8(s1, 8); PIN1(pc[3]);
    lsum += rs;

}
template <bool DO_PV, bool DO_QK, bool FIXM>
DI void attn_step(f32x16& s0, f32x16& s1, f32x16& n0, f32x16& n1, const bf16x8 (&pp)[4], bf16x8 (&pc)[4],
                  f32x16& o0, f32x16& o1, float& m, float& lsum, const bf16x8 (&qf)[4],
                  const unsigned char* kp, const unsigned char* vp, int k_off, int kswz, int v_off, int vswz, int h) {
    if (FIXM) { attn_step_fix<DO_PV, DO_QK>(s0, s1, n0, n1, pp, pc, o0, o1, m, lsum, qf, kp, vp, k_off, kswz, v_off, vswz, h); return; }
    bf16x8 va0, vb0, va1, vb1, va2, vb2, va3, vb3, ka0, kb0, ka1, kb1, ka2, kb2, ka3, kb3;
    if (DO_PV) { va0 = VFRAG(0, 0); vb0 = VFRAG(0, 1); va1 = VFRAG(1, 0); vb1 = VFRAG(1, 1); }
    float mx = s0[0];
    if (DO_PV) o0 = mfma32(va0, pp[0], o0);
    if (!FIXM) mx = max8(s0, 0, mx);
    SB_();
    if (DO_PV) { o1 = mfma32(vb0, pp[0], o1); va2 = VFRAG(2, 0); vb2 = VFRAG(2, 1); }
    if (!FIXM) mx = max8(s0, 8, mx);
    SB_();
    if (DO_PV) { o0 = mfma32(va1, pp[1], o0); va3 = VFRAG(3, 0); vb3 = VFRAG(3, 1); }
    if (!FIXM) mx = max8(s1, 0, mx);
    SB_();
    if (DO_PV) o1 = mfma32(vb1, pp[1], o1);
    bool need = false; float alpha = 1.0f;
    if (!FIXM) {
        mx = max8(s1, 8, mx);
        mx = xhalf_max(mx);
        need = mx > m + 8.0f;
        const float mnew = need ? mx : m;
        alpha = __builtin_amdgcn_exp2f(m - mnew);
        m = mnew;
    }
    const float mb = m;
    float rs = 0.f; f32x2_t rs2 = {0.f, 0.f};
    SB_();
    if (DO_PV) o0 = mfma32(va2, pp[2], o0);
    if (DO_QK) { ka0 = KFRAG(0, 0); kb0 = KFRAG(0, 1); }
    EXPQ(s0, 0);
    SB_();
    if (DO_PV) o1 = mfma32(vb2, pp[2], o1);
    if (DO_QK) { ka1 = KFRAG(1, 0); kb1 = KFRAG(1, 1); }
    EXPQ(s0, 4);
    SB_();
    if (DO_PV) o0 = mfma32(va3, pp[3], o0);
    EXPQ(s0, 8);
    SB_();
    if (DO_PV) o1 = mfma32(vb3, pp[3], o1);
    EXPQ(s0, 12);
    SB_();
    if (DO_QK) { n0 = mfma32(ka0, qf[0], (f32x16){0.f, 0.f, 0.f, 0.f, 0.f, 0.f, 0.f, 0.f, 0.f, 0.f, 0.f, 0.f, 0.f, 0.f, 0.f, 0.f}); ka2 = KFRAG(2, 0); kb2 = KFRAG(2, 1); }
    EXPQ(s1, 0);
    SB_();
    if (DO_QK) { n1 = mfma32(kb0, qf[0], (f32x16){0.f, 0.f, 0.f, 0.f, 0.f, 0.f, 0.f, 0.f, 0.f, 0.f, 0.f, 0.f, 0.f, 0.f, 0.f, 0.f}); ka3 = KFRAG(3, 0); kb3 = KFRAG(3, 1); }
    EXPQ(s1, 4);
    SB_();
    if (DO_QK) n0 = mfma32(ka1, qf[1], n0);
    EXPQ(s1, 8);
    SB_();
    if (DO_QK) n1 = mfma32(kb1, qf[1], n1);
    EXPQ(s1, 12);
    SB_();
    if (DO_QK) n0 = mfma32(ka2, qf[2], n0);
    pc[0] = PACK8(s0, 0);
    SB_();
    if (DO_QK) n1 = mfma32(kb2, qf[2], n1);
    pc[1] = PACK8(s0, 8);
    SB_();
    if (DO_QK) n0 = mfma32(ka3, qf[3], n0);
    pc[2] = PACK8(s1, 0);
    SB_();
    if (DO_QK) n1 = mfma32(kb3, qf[3], n1);
    pc[3] = PACK8(s1, 8);
    if (FIXM) lsum += rs2.x + rs2.y; else lsum = lsum * alpha + rs;
    SB_();
    if (!FIXM) {
        if (__builtin_amdgcn_ballot_w64(need)) {
#pragma unroll
            for (int i = 0; i < 16; ++i) { o0[i] *= alpha; o1[i] *= alpha; }
        }
    }
}

template <bool FIXM>
DI void attn_item(const bf16_t* __restrict__ Q, int ldq, const bf16_t* __restrict__ K, int ldk, const bf16_t* __restrict__ VT, int ldv,
                  int nkeys, bf16_t* __restrict__ O, const bf16_t* __restrict__ G, unsigned char* smem, float mfix) {
    const int tid = opaque_tid(), lane = tid & 63, wave = tid >> 6;
    const int r = lane & 31, h = lane >> 5;
    bf16x8 qf[4];
    {
        const bf16_t* qp = Q + (size_t)(wave * 32 + r) * ldq + h * 8;
#pragma unroll
        for (int ks = 0; ks < 4; ++ks) qf[ks] = *(const bf16x8*)(qp + ks * 16);
    }
    const int lrow = tid >> 3, lc = tid & 7;
    const bf16_t* Kg = K + (size_t)lrow * ldk + lc * 8;
    const bf16_t* Vg = VT + (size_t)lrow * ldv + lc * 8;
    const int st_off = lrow * 128 + ((lc ^ ((lrow >> 1) & 7)) << 4);
    const int pr = (r & ~12) | ((r & 4) << 1) | ((r & 8) >> 1);
    const int kswz = (pr >> 1) & 7, vswz = (r >> 1) & 7;
    const int k_off = pr * 128, v_off = r * 128;
    const int nt = nkeys >> 6;

    f32x16 o0, o1, sa0, sa1, sb0, sb1;
#pragma unroll
    for (int i = 0; i < 16; ++i) { o0[i] = 0.f; o1[i] = 0.f; }
    float m = FIXM ? mfix : -1e30f, lsum = 0.f;
    bf16x8 pa[4], pb[4];

    u32x4 rk, rv;
#define A_LOAD(U) { const int kt_ = ((U) + 2 < nt) ? (U) + 2 : nt - 1; rk = *(const u32x4*)(Kg + (size_t)(kt_ * 64) * ldk); rv = *(const u32x4*)(Vg + (U) * 64); }
#define A_STORE(OFF) { *(u32x4*)(smem + (OFF) + st_off) = rk; *(u32x4*)(smem + (OFF) + 8192 + st_off) = rv; }
    rk = *(const u32x4*)(Kg); rv = *(const u32x4*)(Kg + (size_t)64 * ldk);
    __syncthreads();
    A_STORE(16384);
    A_LOAD(0);
    A_STORE(0);
    A_LOAD(1);
    lds_barrier();
    {
        const unsigned char* kp = smem + 16384;
        sa0 = mfma32(KFRAG(0, 0), qf[0], (f32x16){0.f, 0.f, 0.f, 0.f, 0.f, 0.f, 0.f, 0.f, 0.f, 0.f, 0.f, 0.f, 0.f, 0.f, 0.f, 0.f});
        sa1 = mfma32(KFRAG(0, 1), qf[0], (f32x16){0.f, 0.f, 0.f, 0.f, 0.f, 0.f, 0.f, 0.f, 0.f, 0.f, 0.f, 0.f, 0.f, 0.f, 0.f, 0.f});
#pragma unroll
        for (int ks = 1; ks < 4; ++ks) { sa0 = mfma32(KFRAG(ks, 0), qf[ks], sa0); sa1 = mfma32(KFRAG(ks, 1), qf[ks], sa1); }
    }
    attn_step<false, true, FIXM>(sa0, sa1, sb0, sb1, pb, pa, o0, o1, m, lsum, qf, smem + 16384 + 8192, smem, k_off, kswz, v_off, vswz, h);
    lds_barrier();
    for (int t = 1; t < nt - 1; t += 2) {
        A_STORE(16384);
        A_LOAD(t + 1);
        SB_();
        attn_step<true, true, FIXM>(sb0, sb1, sa0, sa1, pa, pb, o0, o1, m, lsum, qf, smem, smem + 8192, k_off, kswz, v_off, vswz, h);
        lds_barrier();
        A_STORE(0);
        A_LOAD(t + 2);
        SB_();
        attn_step<true, true, FIXM>(sa0, sa1, sb0, sb1, pb, pa, o0, o1, m, lsum, qf, smem + 16384, smem + 16384 + 8192, k_off, kswz, v_off, vswz, h);
        lds_barrier();
    }
    A_STORE(16384);
    const bf16_t* gp = G + (size_t)(wave * 32 + r) * INW + 4 * h;
    u32x2 gga[4], ggb[4];
#pragma unroll
    for (int gq = 0; gq < 4; ++gq) { gga[gq] = *(const u32x2*)(gp + 8 * gq); ggb[gq] = *(const u32x2*)(gp + 32 + 8 * gq); }
    SB_();
    attn_step<true, false, FIXM>(sb0, sb1, sa0, sa1, pa, pb, o0, o1, m, lsum, qf, smem, smem + 8192, k_off, kswz, v_off, vswz, h);
    lds_barrier();
    {
        const unsigned char* vp = smem + 16384 + 8192;
#pragma unroll
        for (int kk = 0; kk < 4; ++kk) { o0 = mfma32(VFRAG(kk, 0), pb[kk], o0); o1 = mfma32(VFRAG(kk, 1), pb[kk], o1); }
    }
#undef A_LOAD
#undef A_STORE
    const float lt = x32_add(lsum);
    const float inv = 1.0f / lt;
    bf16_t* op = O + (size_t)(wave * 32 + r) * 1024 + 4 * h;
#pragma unroll
    for (int gq = 0; gq < 4; ++gq) {
        {
            const u32x2 gg = gga[gq];
            u32x2 w;
            w.x = pk_bf16(o0[4 * gq] * inv * bflo(gg.x), o0[4 * gq + 1] * inv * bfhi(gg.x));
            w.y = pk_bf16(o0[4 * gq + 2] * inv * bflo(gg.y), o0[4 * gq + 3] * inv * bfhi(gg.y));
            *(u32x2*)(op + 8 * gq) = w;
        }
        {
            const u32x2 gg = ggb[gq];
            u32x2 w;
            w.x = pk_bf16(o1[4 * gq] * inv * bflo(gg.x), o1[4 * gq + 1] * inv * bfhi(gg.x));
            w.y = pk_bf16(o1[4 * gq + 2] * inv * bflo(gg.y), o1[4 * gq + 3] * inv * bfhi(gg.y));
            *(u32x2*)(op + 32 + 8 * gq) = w;
        }
    }
}

DI void cross_item(const bf16_t* __restrict__ Q, const bf16_t* __restrict__ K, const bf16_t* __restrict__ VT,
                   bf16_t* __restrict__ O, const bf16_t* __restrict__ G, unsigned char* smem) {
    const int tid = opaque_tid(), lane = tid & 63, wave = tid >> 6;
    const int r = lane & 31, h = lane >> 5;
    bf16x8 qf[4];
    {
        const bf16_t* qp = Q + (size_t)(wave * 32 + r) * INW + h * 8;
#pragma unroll
        for (int ks = 0; ks < 4; ++ks) qf[ks] = *(const bf16x8*)(qp + ks * 16);
    }
    const int lrow = tid >> 3, lc = tid & 7;
    const int st_off = lrow * 128 + ((lc ^ ((lrow >> 1) & 7)) << 4);
    {
        u32x4 kk[4], vv[4];
#pragma unroll
        for (int i = 0; i < 4; ++i) { kk[i] = *(const u32x4*)(K + (size_t)(lrow + 64 * i) * 256 + lc * 8); vv[i] = *(const u32x4*)(VT + (size_t)lrow * 256 + (i * 8 + lc) * 8); }
        __syncthreads();
#pragma unroll
        for (int i = 0; i < 4; ++i) { *(u32x4*)(smem + i * 16384 + st_off) = kk[i]; *(u32x4*)(smem + i * 16384 + 8192 + st_off) = vv[i]; }
    }
    const bf16_t* gp = G + (size_t)(wave * 32 + r) * INW + 4 * h;
    u32x2 gga[4], ggb[4];
#pragma unroll
    for (int gq = 0; gq < 4; ++gq) { gga[gq] = *(const u32x2*)(gp + 8 * gq); ggb[gq] = *(const u32x2*)(gp + 32 + 8 * gq); }
    __syncthreads();
    const int pr = (r & ~12) | ((r & 4) << 1) | ((r & 8) >> 1);
    const int kswz = (pr >> 1) & 7, vswz = (r >> 1) & 7;
    const int k_off = pr * 128, v_off = r * 128;
    f32x16 o0, o1;
#pragma unroll
    for (int i = 0; i < 16; ++i) { o0[i] = 0.f; o1[i] = 0.f; }
    float m = -1e30f, lsum = 0.f;
#pragma unroll 1
    for (int kt = 0; kt < 4; ++kt) {
        const unsigned char* kp = smem + kt * 16384;
        const unsigned char* vp = kp + 8192;
        f32x16 s0, s1;
        s0 = mfma32(KFRAG(0, 0), qf[0], (f32x16){0.f, 0.f, 0.f, 0.f, 0.f, 0.f, 0.f, 0.f, 0.f, 0.f, 0.f, 0.f, 0.f, 0.f, 0.f, 0.f});
        s1 = mfma32(KFRAG(0, 1), qf[0], (f32x16){0.f, 0.f, 0.f, 0.f, 0.f, 0.f, 0.f, 0.f, 0.f, 0.f, 0.f, 0.f, 0.f, 0.f, 0.f, 0.f});
#pragma unroll
        for (int ks = 1; ks < 4; ++ks) { s0 = mfma32(KFRAG(ks, 0), qf[ks], s0); s1 = mfma32(KFRAG(ks, 1), qf[ks], s1); }
        float mx = s0[0];
        mx = max8(s0, 0, mx); mx = max8(s0, 8, mx); mx = max8(s1, 0, mx); mx = max8(s1, 8, mx);
        mx = xhalf_max(mx);
        const float mnew = fmaxf(m, mx);
        const float alpha = __builtin_amdgcn_exp2f(m - mnew);
        m = mnew;
        const float mb = mnew;
        float rs = 0.f;
#pragma unroll
        for (int i = 0; i < 16; ++i) { s0[i] = __builtin_amdgcn_exp2f(s0[i] - mb); s1[i] = __builtin_amdgcn_exp2f(s1[i] - mb); rs += s0[i] + s1[i]; }
        lsum = lsum * alpha + rs;
#pragma unroll
        for (int i = 0; i < 16; ++i) { o0[i] *= alpha; o1[i] *= alpha; }
        bf16x8 pf[4];
        pf[0] = PACK8(s0, 0); pf[1] = PACK8(s0, 8); pf[2] = PACK8(s1, 0); pf[3] = PACK8(s1, 8);
#pragma unroll
        for (int kk2 = 0; kk2 < 4; ++kk2) { o0 = mfma32(VFRAG(kk2, 0), pf[kk2], o0); o1 = mfma32(VFRAG(kk2, 1), pf[kk2], o1); }
    }
    const float lt = x32_add(lsum);
    const float inv = 1.0f / lt;
    bf16_t* op = O + (size_t)(wave * 32 + r) * 1024 + 4 * h;
#pragma unroll
    for (int gq = 0; gq < 4; ++gq) {
        {
            const u32x2 gg = gga[gq];
            u32x2 w;
            w.x = pk_bf16(o0[4 * gq] * inv * bflo(gg.x), o0[4 * gq + 1] * inv * bfhi(gg.x));
            w.y = pk_bf16(o0[4 * gq + 2] * inv * bflo(gg.y), o0[4 * gq + 3] * inv * bfhi(gg.y));
            *(u32x2*)(op + 8 * gq) = w;
        }
        {
            const u32x2 gg = ggb[gq];
            u32x2 w;
            w.x = pk_bf16(o1[4 * gq] * inv * bflo(gg.x), o1[4 * gq + 1] * inv * bfhi(gg.x));
            w.y = pk_bf16(o1[4 * gq + 2] * inv * bflo(gg.y), o1[4 * gq + 3] * inv * bfhi(gg.y));
            *(u32x2*)(op + 32 + 8 * gq) = w;
        }
    }
}

DI void pool_item(const bf16_t* __restrict__ Z, const bf16_t* __restrict__ PWT, const float* __restrict__ pscale, bf16_t* __restrict__ MIX,
                  int tokg0, unsigned char* smem) {
    const int tid = opaque_tid(), lane = tid & 63, wave = tid >> 6;
    const int T = (tokg0 < NPROMPT) ? 2048 : 4096;
    const int t0 = tokg0 & (T - 1);
    constexpr int RS = 528;
    const int g = wave & 3, half = 1 << g;
    const int r16 = lane & 15, q4 = lane >> 4;
    const bf16_t* pw = PWT + (size_t)g * 4096 + r16 * 64 + q4 * 8;
    bf16x8 wfr[4][2]; f32x4 psr[4]; u32x2 ggr[2][4];
#pragma unroll
    for (int fi = 0; fi < 4; ++fi) {
        psr[fi] = *(const f32x4*)(pscale + g * 64 + fi * 16 + 4 * q4);
#pragma unroll
        for (int ks = 0; ks < 2; ++ks) wfr[fi][ks] = *(const bf16x8*)(pw + fi * 16 * 64 + ks * 32);
#pragma unroll
        for (int t2 = 0; t2 < 2; ++t2) ggr[t2][fi] = *(const u32x2*)(Z + ((size_t)tokg0 + ((wave >> 2) * 2 + t2) * 16 + r16) * INW + 256 + g * 64 + fi * 16 + 4 * q4);
    }
    __syncthreads();
    for (int id = tid; id < 80 * 32; id += 512) {
        const int rr = id >> 5, c = id & 31;
        const int t = t0 - 8 + rr;
        u32x4 v = (u32x4){0u, 0u, 0u, 0u};
        if (t >= 0 && t < T) v = *(const u32x4*)(Z + (size_t)(tokg0 - 8 + rr) * INW + c * 8);
        *(u32x4*)(smem + rr * RS + c * 16) = v;
    }
    __syncthreads();
    {
        const int th = wave >> 2;
        bf16x8 df[2][2];
#pragma unroll
        for (int t2 = 0; t2 < 2; ++t2)
#pragma unroll
            for (int ks = 0; ks < 2; ++ks) {
                const int tl = (th * 2 + t2) * 16 + r16, t = t0 + tl;
                const int lo = max(t - half, 0), hi = min(t + half, T);
                const float icnt = 1.0f / (float)(hi - lo);
                float s[8];
#pragma unroll
                for (int j = 0; j < 8; ++j) s[j] = 0.f;
                const unsigned char* bp = smem + (tl + 8 - half) * RS + (g * 64 + ks * 32 + q4 * 8) * 2;
                for (int j = 0; j < 2 * half; ++j) {
                    const u32x4 v = *(const u32x4*)(bp + j * RS);
                    s[0] += bflo(v.x); s[1] += bfhi(v.x); s[2] += bflo(v.y); s[3] += bfhi(v.y);
                    s[4] += bflo(v.z); s[5] += bfhi(v.z); s[6] += bflo(v.w); s[7] += bfhi(v.w);
                }
                const u32x4 c = *(const u32x4*)(bp + half * RS);
                u32x4 o;
                o.x = pk_bf16(s[0] * icnt - bflo(c.x), s[1] * icnt - bfhi(c.x));
                o.y = pk_bf16(s[2] * icnt - bflo(c.y), s[3] * icnt - bfhi(c.y));
                o.z = pk_bf16(s[4] * icnt - bflo(c.z), s[5] * icnt - bfhi(c.z));
                o.w = pk_bf16(s[6] * icnt - bflo(c.w), s[7] * icnt - bfhi(c.w));
                df[t2][ks] = __builtin_bit_cast(bf16x8, o);
            }
        f32x4 acc[4][2];
#pragma unroll
        for (int i = 0; i < 4; ++i)
#pragma unroll
            for (int j = 0; j < 2; ++j) acc[i][j] = (f32x4){0.f, 0.f, 0.f, 0.f};
#pragma unroll
        for (int fi = 0; fi < 4; ++fi)
#pragma unroll
            for (int ks = 0; ks < 2; ++ks) {
                const bf16x8 wf = wfr[fi][ks];
#pragma unroll
                for (int t2 = 0; t2 < 2; ++t2) acc[fi][t2] = mfma16(wf, df[t2][ks], acc[fi][t2]);
            }
#pragma unroll
        for (int t2 = 0; t2 < 2; ++t2) {
            const size_t tok = (size_t)tokg0 + (th * 2 + t2) * 16 + r16;
#pragma unroll
            for (int fi = 0; fi < 4; ++fi) {
                const int n = g * 64 + fi * 16 + 4 * q4;
                const f32x4 ps = psr[fi];
                const u32x2 gg = ggr[t2][fi];
                u32x2 w;
                w.x = pk_bf16(acc[fi][t2][0] * ps[0] * bflo(gg.x), acc[fi][t2][1] * ps[1] * bfhi(gg.x));
                w.y = pk_bf16(acc[fi][t2][2] * ps[2] * bflo(gg.y), acc[fi][t2][3] * ps[3] * bfhi(gg.y));
                *(u32x2*)(MIX + tok * 1024 + n) = w;
            }
        }
    }
}

struct PostIn { u32x4 yv[2]; f32x4 xv[4]; };
DI PostIn post_row_load(const float* __restrict__ xsrc, const bf16_t* __restrict__ yh, int lane) {
    PostIn r;
#pragma unroll
    for (int j = 0; j < 2; ++j) r.yv[j] = *(const u32x4*)(yh + j * 512 + lane * 8);
#pragma unroll
    for (int j = 0; j < 2; ++j) { r.xv[2 * j] = *(const f32x4*)(xsrc + j * 512 + lane * 8); r.xv[2 * j + 1] = *(const f32x4*)(xsrc + j * 512 + lane * 8 + 4); }
    return r;
}
DI void post_row_finish(const PostIn& in, bf16_t* __restrict__ yh, const float* __restrict__ gpost, const float* __restrict__ gpre_next,
                        float* __restrict__ xdst, bool last, int lane) {
    u32x4 yv[2]; f32x4 xv[4];
#pragma unroll
    for (int j = 0; j < 2; ++j) yv[j] = in.yv[j];
#pragma unroll
    for (int j = 0; j < 4; ++j) xv[j] = in.xv[j];
    float y[16];
#pragma unroll
    for (int j = 0; j < 2; ++j) {
        y[8 * j + 0] = bflo(yv[j].x); y[8 * j + 1] = bfhi(yv[j].x); y[8 * j + 2] = bflo(yv[j].y); y[8 * j + 3] = bfhi(yv[j].y);
        y[8 * j + 4] = bflo(yv[j].z); y[8 * j + 5] = bfhi(yv[j].z); y[8 * j + 6] = bflo(yv[j].w); y[8 * j + 7] = bfhi(yv[j].w);
    }
    float ss = 0.f;
#pragma unroll
    for (int i = 0; i < 16; ++i) ss += y[i] * y[i];
    ss = wave_sum(ss);
    const float r = rsqrtf(ss * (1.0f / 1024.0f) + EPS);
    float xn[16]; float ss2 = 0.f;
#pragma unroll
    for (int j = 0; j < 2; ++j) {
        const f32x4 g0 = *(const f32x4*)(gpost + j * 512 + lane * 8), g1 = *(const f32x4*)(gpost + j * 512 + lane * 8 + 4);
#pragma unroll
        for (int i = 0; i < 4; ++i) {
            xn[8 * j + i] = xv[2 * j][i] + y[8 * j + i] * r * g0[i];
            xn[8 * j + 4 + i] = xv[2 * j + 1][i] + y[8 * j + 4 + i] * r * g1[i];
        }
    }
#pragma unroll
    for (int i = 0; i < 16; ++i) ss2 += xn[i] * xn[i];
#pragma unroll
    for (int j = 0; j < 2; ++j) {
        *(f32x4*)(xdst + j * 512 + lane * 8) = (f32x4){xn[8 * j], xn[8 * j + 1], xn[8 * j + 2], xn[8 * j + 3]};
        *(f32x4*)(xdst + j * 512 + lane * 8 + 4) = (f32x4){xn[8 * j + 4], xn[8 * j + 5], xn[8 * j + 6], xn[8 * j + 7]};
    }
    if (!last) {
        ss2 = wave_sum(ss2);
        const float r2 = rsqrtf(ss2 * (1.0f / 1024.0f) + EPS);
#pragma unroll
        for (int j = 0; j < 2; ++j) {
            const f32x4 g0 = *(const f32x4*)(gpre_next + j * 512 + lane * 8), g1 = *(const f32x4*)(gpre_next + j * 512 + lane * 8 + 4);
            u32x4 o;
            o.x = pk_bf16(xn[8 * j] * r2 * g0[0], xn[8 * j + 1] * r2 * g0[1]);
            o.y = pk_bf16(xn[8 * j + 2] * r2 * g0[2], xn[8 * j + 3] * r2 * g0[3]);
            o.z = pk_bf16(xn[8 * j + 4] * r2 * g1[0], xn[8 * j + 5] * r2 * g1[1]);
            o.w = pk_bf16(xn[8 * j + 6] * r2 * g1[2], xn[8 * j + 7] * r2 * g1[3]);
            *(u32x4*)(yh + j * 512 + lane * 8) = o;
        }
    }
}

#define XB_TMO      128
#define XB_XCNT(j)  (256  + 64 * (j))
#define XB_XSUB(j)  (1280 + 64 * (j))
#define XB_XGEN(j)  (2304 + 64 * (j))
#define XB_TOP      3328
#define XB_TOPGEN   3392
#define XCD_BAR_WORDS 3456
#define XB_SPIN_CAP (1u << 18)
#define LAS __attribute__((address_space(3)))
DI unsigned xb_ld(unsigned* p)              { return __hip_atomic_load(p, __ATOMIC_RELAXED, __HIP_MEMORY_SCOPE_AGENT); }
DI unsigned xb_add(unsigned* p, unsigned v) { return __hip_atomic_fetch_add(p, v, __ATOMIC_RELAXED, __HIP_MEMORY_SCOPE_AGENT); }
DI unsigned xb_xcc_id() { return (unsigned)__builtin_amdgcn_s_getreg((3 << 11) | 20) & 0xFu; }
#define XB_SPIN(cond, bar) do { unsigned _sp = 0; while (cond) { __builtin_amdgcn_s_sleep(1); \
    if ((++_sp & 255u) == 0u) { if (xb_ld(&(bar)[XB_TMO])) break; if (_sp > XB_SPIN_CAP) { atomicAdd(&(bar)[XB_TMO], 1u); break; } } } } while (0)
struct XcdBarrier { unsigned* bar; unsigned x; volatile LAS unsigned* st; };
DI XcdBarrier xcd_barrier_post(unsigned* bar, volatile LAS unsigned* st) {
    XcdBarrier b; b.bar = bar; b.x = xb_xcc_id(); b.st = st;
    if (threadIdx.x == 0) (void)xb_add(&bar[XB_XCNT(b.x)], 1u);
    return b;
}
DI void xcd_barrier_complete(unsigned* bar, unsigned x, unsigned& nloc, unsigned& nx) {
    const unsigned G = gridDim.x * gridDim.y * gridDim.z;
    unsigned sum, cnt, mine, sp = 0u;
    for (;;) {
        sum = 0u; cnt = 0u; mine = 0u;
#pragma unroll
        for (unsigned j = 0; j < 16; ++j) { const unsigned c = xb_ld(&bar[XB_XCNT(j)]); sum += c; cnt += (c > 0u) ? 1u : 0u; mine = (j == x) ? c : mine; }
        if (sum == G) break;
        __builtin_amdgcn_s_sleep(1);
        if ((++sp & 255u) == 0u) { if (xb_ld(&bar[XB_TMO])) break; if (sp > XB_SPIN_CAP) { atomicAdd(&bar[XB_TMO], 1u); break; } }
    }
    nloc = mine > 0u ? mine : 1u; nx = cnt > 0u ? cnt : 1u;
}
DI void xcd_barrier(const XcdBarrier& b) {
    asm volatile("s_waitcnt vmcnt(0)" ::: "memory");
    __syncthreads();
    if (threadIdx.x == 0) {
        unsigned* bar = b.bar;
        __builtin_amdgcn_s_waitcnt(0);
        unsigned nloc = b.st[0], nx = b.st[1];
        if (nloc == 0u) { xcd_barrier_complete(bar, b.x, nloc, nx); b.st[0] = nloc; b.st[1] = nx; }
        const unsigned old = xb_add(&bar[XB_XSUB(b.x)], 1u);
        const unsigned gen = old / nloc;
        if (old + 1u == (gen + 1u) * nloc) {
            __builtin_amdgcn_fence(__ATOMIC_RELEASE, "agent");
            asm volatile("s_waitcnt vmcnt(0)" ::: "memory");
            const unsigned og = xb_add(&bar[XB_TOP], 1u);
            const unsigned tg = og / nx;
            if (og + 1u == (tg + 1u) * nx) xb_add(&bar[XB_TOPGEN], 1u);
            else XB_SPIN(xb_ld(&bar[XB_TOPGEN]) == tg, bar);
            __builtin_amdgcn_fence(__ATOMIC_ACQUIRE, "agent");
            xb_add(&bar[XB_XGEN(b.x)], 1u);
            asm volatile("s_waitcnt vmcnt(0)" ::: "memory");
        } else {
            XB_SPIN(xb_ld(&bar[XB_XGEN(b.x)]) == gen, bar);
            __builtin_amdgcn_fence(__ATOMIC_ACQUIRE, "agent");
            asm volatile("s_waitcnt vmcnt(0)" ::: "memory");
        }
    }
    __syncthreads();
}

__global__ void __launch_bounds__(512, 2) fwd_megakernel(Params p) {
    __shared__ __attribute__((aligned(16))) unsigned char smem[131072];
    __shared__ uint4 xb_words;
    cg::grid_group grid = cg::this_grid();
    const int nb = gridDim.x, bid = blockIdx.x;
    if (threadIdx.x == 0) xb_words = make_uint4(0u, 0u, 0u, 0u);
    __syncthreads();
    XcdBarrier xb = xcd_barrier_post((unsigned*)(p.ws + OFF_BAR), (volatile LAS unsigned*)&xb_words);
    if (p.phase_end > 1000) grid.sync();
    for (int ph = p.phase_begin; ph < p.phase_end; ++ph) {
        unsigned char* ws = p.ws;
        bf16_t* H = (bf16_t*)(ws + OFF_H);
        bf16_t* Z = (bf16_t*)(ws + OFF_Z);
        bf16_t* VT = (bf16_t*)(ws + OFF_VT);
        bf16_t* MIX = (bf16_t*)(ws + OFF_MIX);
        bf16_t* WIN = (bf16_t*)(ws + OFF_WIN);
        bf16_t* WOUT = (bf16_t*)(ws + OFF_WOUT);
        bf16_t* WMEM = (bf16_t*)(ws + OFF_WMEM);
        bf16_t* PW = (bf16_t*)(ws + OFF_PW);
        bf16_t* MH = (bf16_t*)(ws + OFF_MH);
        bf16_t* KM = (bf16_t*)(ws + OFF_KM);
        bf16_t* VMT = (bf16_t*)(ws + OFF_VMT);
        float* ROPE = (float*)(ws + OFF_ROPE);
        if (ph == 0) {
            for (int i = bid; i < 1928; i += nb) {
                if (i < 1152) { const int l = i / 576, j = i % 576, kt = j / 36, ntile = j % 36;
                    transpose_tile(p.w_in + (size_t)l * DM * INW, INW, WIN + (size_t)l * INW * DM, DM, kt * 64, ntile * 64, smem);
                } else if (i < 1664) { const int ii = i - 1152, l = ii / 256, j = ii % 256, kt = j / 16, ntile = j % 16;
                    transpose_tile(p.w_out + (size_t)l * DM * DM, DM, WOUT + (size_t)l * DM * DM, DM, kt * 64, ntile * 64, smem);
                } else if (i < 1920) { const int ii = i - 1664, l = ii / 128, j = ii % 128, kt = j / 8, ntile = j % 8;
                    transpose_tile(p.w_mem_kv + (size_t)l * DM * 512, 512, WMEM + (size_t)l * 512 * DM, DM, kt * 64, ntile * 64, smem);
                } else { const int ii = i - 1920;
                    transpose_tile(p.pool_w + (size_t)ii * 4096, 64, PW + (size_t)ii * 4096, 64, 0, 0, smem);
                }
            }
            {
                const int tid = opaque_tid(), lane = tid & 63, wave = tid >> 6;
                constexpr int NR = NTOK + 2 * NMEMTOK;
                auto desc = [&](int i, const float*& src, const float*& g, bf16_t*& dst) {
                    if (i < NTOK) { src = (i < NPROMPT) ? p.x_prompt + (size_t)i * DM : p.x_sample + (size_t)(i - NPROMPT) * DM; g = p.norm_pre; dst = H + (size_t)i * DM; }
                    else { const int ii = i - NTOK, l = ii / NMEMTOK, mt = ii % NMEMTOK;
                           src = (mt < 4096) ? p.mem_prompt + (size_t)mt * DM : p.mem_sample + (size_t)(mt - 4096) * DM; g = p.mem_norm + l * DM; dst = MH + ((size_t)l * NMEMTOK + mt) * DM; }
                };
                int i = bid * 8 + wave;
                if (i < NR) {
                    const float *s, *g; bf16_t* d; desc(i, s, g, d);
                    RowIn cur = rms_row_load(s, lane);
                    for (; i < NR; i += nb * 8) {
                        const int in = (i + nb * 8 < NR) ? i + nb * 8 : NR - 1;
                        const float *s2, *g2; bf16_t* d2; desc(in, s2, g2, d2);
                        const RowIn nxt = rms_row_load(s2, lane);
                        rms_row_finish(cur, g, d, lane);
                        cur = nxt; g = g2; d = d2;
                    }
                }
            }
            { const int tid = opaque_tid(); for (int i = bid * 512 + tid; i < 1024; i += nb * 512) rope_entry(i, ROPE); }
        } else {
            const int l = (ph - 1) >> 2, sub = (ph - 1) & 3;
            if (sub == 0) {
                EpiArgs e; e.C = Z; e.VT = VT; e.qn = p.q_norm + l * 64; e.kn = p.k_norm + l * 64; e.rope = ROPE;
                const bf16_t* Wl = WIN + (size_t)l * INW * DM;
                EpiArgs e2; e2.C = KM + (size_t)l * NMEMTOK * 256; e2.VT = VMT + (size_t)l * NMEMTOK * 256; e2.qn = nullptr; e2.kn = nullptr; e2.rope = nullptr;
                const bf16_t* Wm = WMEM + (size_t)l * 512 * DM;
                const bf16_t* Am = MH + (size_t)l * NMEMTOK * DM;
                auto tile1 = [&](int i, const bf16_t*& ta, const bf16_t*& tb, int& tm0, int& tn0) {
                    if (i < 1728) {
                        const int j = i >> 3, mg = j / 72, rem = j % 72;
                        tm0 = ((i & 7) * 24 + mg * 8 + (rem & 7)) * 256; tn0 = (rem >> 3) * 256; ta = H; tb = Wl;
                    } else { const int j = i - 1728; tm0 = (j >> 1) * 256; tn0 = (j & 1) * 256; ta = Am; tb = Wm; }
                };
                bool pre = false;
                for (int i = bid; i < 1728 + 40; i += nb) {
                    const bf16_t *ta, *tb, *na = nullptr, *nbp = nullptr; int tm0, tn0, xm = 0, xn = 0;
                    tile1(i, ta, tb, tm0, tn0);
                    if (i + nb < 1728 + 40) tile1(i + nb, na, nbp, xm, xn);
                    const bool nperm = (i + nb < 1728) ? !(xn >= 512 && xn < 1152) : (xn == 0);
                    if (i < 1728) gemm_tile<0>(ta, tb, tm0, tn0, e, smem, pre, na, nbp, xm, xn, nperm);
                    else gemm_tile<2>(ta, tb, tm0, tn0, e2, smem, pre, na, nbp, xm, xn, nperm);
                    pre = (na != nullptr);
                }
            } else if (sub == 1) {
                const int lane = opaque_tid() & 63;
                float gq = fabsf(p.q_norm[l * 64 + lane]), gk = fabsf(p.k_norm[l * 64 + lane]);
                gq = wave_max(gq); gk = wave_max(gk);
                const float mfix = 8.0f * gq * gk * 1.02f * L2E;
                const bool fixm = mfix < 28.0f;
                for (int i = bid; i < 3072; i += nb) {
                    if (i < 1536) {
                        int b, kvh, j, T; size_t tok0, vtb;
                        if (i < 512) { const int R = i >> 8, ip = i & 255, grp = ip & 7; j = R * 32 + (ip >> 3); b = grp >> 1; kvh = grp & 1; T = 4096;
                            tok0 = (size_t)NPROMPT + (size_t)b * 4096; vtb = (size_t)NPROMPT * 128 + ((size_t)(b * 2 + kvh) * 64) * 4096; }
                        else { const int ii = i - 512, R = ii >> 8, ip = ii & 255, grp = R * 8 + (ip & 7); j = ip >> 3; b = grp >> 1; kvh = grp & 1; T = 2048;
                            tok0 = (size_t)b * 2048; vtb = ((size_t)(b * 2 + kvh) * 64) * 2048; }
                        const int qblk = j >> 2, head = kvh * 4 + (j & 3);
                        const size_t q0 = tok0 + (size_t)qblk * 256;
                        if (fixm) attn_item<true>(Z + q0 * INW + 512 + head * 64, INW, Z + tok0 * INW + 1024 + kvh * 64, INW, VT + vtb, T, T,
                                  MIX + q0 * 1024 + 256 + head * 64, Z + q0 * INW + 1280 + head * 64, smem, mfix);
                        else attn_item<false>(Z + q0 * INW + 512 + head * 64, INW, Z + tok0 * INW + 1024 + kvh * 64, INW, VT + vtb, T, T,
                                  MIX + q0 * 1024 + 256 + head * 64, Z + q0 * INW + 1280 + head * 64, smem, 0.f);
                    } else if (i < 2304) {
                        const int ii = i - 1536, qb = ii >> 2, hx = ii & 3;
                        const size_t q0 = (size_t)qb * 256;
                        const int b = (q0 < NPROMPT) ? (int)(q0 >> 11) : 16 + (int)((q0 - NPROMPT) >> 12);
cross_item(Z + q0 * INW + 1792 + hx * 64, KM + ((size_t)l * NMEMTOK + (size_t)b * 256) * 256 + hx * 64,
                                   VMT + (size_t)l * NMEMTOK * 256 + ((size_t)(b * 4 + hx) * 64) * 256,
                                   MIX + q0 * 1024 + 768 + hx * 64, Z + q0 * INW + 2048 + hx * 64, smem);
                    } else {
                        pool_item(Z, PW + (size_t)l * 4 * 4096, p.pool_scale + l * 256, MIX, (i - 2304) * 64, smem);
                    }
                }
            } else if (sub == 2) {
                EpiArgs e; e.C = H; e.VT = nullptr; e.qn = nullptr; e.kn = nullptr; e.rope = nullptr;
                const bf16_t* Wl = WOUT + (size_t)l * DM * DM;
                auto tile2 = [&](int i, int& tm0, int& tn0) {
                    const int j = i >> 3, mg = j >> 5, rem = j & 31;
                    tm0 = ((i & 7) * 24 + mg * 8 + (rem & 7)) * 256; tn0 = (rem >> 3) * 256;
                };
                bool pre = false;
                for (int i = bid; i < 768; i += nb) {
                    int tm0, tn0, xm = 0, xn = 0; tile2(i, tm0, tn0);
                    const bool more = (i + nb < 768);
                    if (more) tile2(i + nb, xm, xn);
                    gemm_tile<1>(MIX, Wl, tm0, tn0, e, smem, pre, more ? MIX : nullptr, Wl, xm, xn, true);
                    pre = more;
                }
            } else {
                const bool last = (l == DEPTH - 1);
                auto xsrc = [&](int i) -> const float* {
                    return (l == 0) ? ((i < NPROMPT) ? p.x_prompt + (size_t)i * DM : p.x_sample + (size_t)(i - NPROMPT) * DM) : p.out + (size_t)i * DM; };
                const int tid = opaque_tid(), lane = tid & 63, wave = tid >> 6;
                int i = bid * 8 + wave;
                if (i < NTOK) {
                    PostIn cur = post_row_load(xsrc(i), H + (size_t)i * DM, lane);
                    for (; i < NTOK; i += nb * 8) {
                        const int in = (i + nb * 8 < NTOK) ? i + nb * 8 : i;
                        const PostIn nxt = post_row_load(xsrc(in), H + (size_t)in * DM, lane);
                        post_row_finish(cur, H + (size_t)i * DM, p.norm_post + l * DM, p.norm_pre + (last ? l : l + 1) * DM, p.out + (size_t)i * DM, last, lane);
                        cur = nxt;
                    }
                }
            }
        }
        if (ph + 1 < p.phase_end) xcd_barrier(xb);
    }
}

extern "C" void kernel_launch(void* const* d_in, const int* in_sizes, int n_in, void* d_out, int out_size, void* d_ws, size_t ws_size,
                              hipStream_t stream) {
    static int grid_blocks = 0;
    if (!grid_blocks) {
        int dev = 0, cus = 0, per_cu = 0;
        hipGetDevice(&dev);
        hipDeviceGetAttribute(&cus, hipDeviceAttributeMultiprocessorCount, dev);
        hipOccupancyMaxActiveBlocksPerMultiprocessor(&per_cu, fwd_megakernel, 512, 0);
        if (per_cu > 1) per_cu = 1;
        if (per_cu < 1) per_cu = 1;
        grid_blocks = cus * per_cu;
    }
    Params p{};
    p.x_prompt = (const float*)d_in[0]; p.x_sample = (const float*)d_in[1]; p.mem_prompt = (const float*)d_in[2]; p.mem_sample = (const float*)d_in[3];
    p.norm_pre = (const float*)d_in[4]; p.norm_post = (const float*)d_in[5]; p.w_in = (const float*)d_in[6]; p.pool_w = (const float*)d_in[7];
    p.pool_scale = (const float*)d_in[8]; p.q_norm = (const float*)d_in[9]; p.k_norm = (const float*)d_in[10]; p.mem_norm = (const float*)d_in[11];
    p.w_mem_kv = (const float*)d_in[12]; p.w_out = (const float*)d_in[13];
    p.out = (float*)d_out; p.ws = (unsigned char*)d_ws;
    p.phase_begin = 0; p.phase_end = 1 + 4 * DEPTH;
    if (ws_size < WS_TOTAL) { fprintf(stderr, "workspace too small: %zu < %zu\n", ws_size, (size_t)WS_TOTAL); return; }
    hipMemsetAsync((unsigned char*)d_ws + OFF_BAR, 0, BAR_BYTES, stream);
    void* args[] = {&p};
    hipError_t e = hipLaunchCooperativeKernel((void*)fwd_megakernel, dim3(grid_blocks), dim3(512), args, 0, stream);
    if (e != hipSuccess) fprintf(stderr, "cooperative launch failed: %s (grid %d)\n", hipGetErrorString(e), grid_blocks);
}
```

```cpp
#include <hip/hip_runtime.h>
#include <hip/hip_cooperative_groups.h>
#include <stdint.h>
#include <cstdio>
namespace cg = cooperative_groups;

typedef unsigned short bf16_t;
typedef short bf16x8 __attribute__((ext_vector_type(8)));
typedef float f32x4 __attribute__((ext_vector_type(4)));
typedef float f32x16 __attribute__((ext_vector_type(16)));
typedef unsigned u32x4 __attribute__((ext_vector_type(4)));
typedef unsigned u32x2 __attribute__((ext_vector_type(2)));
typedef __bf16 bf16x2_t __attribute__((ext_vector_type(2)));
typedef float f32x2_t __attribute__((ext_vector_type(2)));
#define DI __device__ __forceinline__

constexpr int NTOK = 49152;
constexpr int NPROMPT = 32768;
constexpr int DM = 1024;
constexpr int INW = 2304;
constexpr int NMEMTOK = 5120;
constexpr int DEPTH = 2;
constexpr float EPS = 1e-6f;
constexpr float L2E = 1.4426950408889634f;

constexpr size_t OFF_H    = 0;
constexpr size_t OFF_Z    = OFF_H + (size_t)NTOK * DM * 2;
constexpr size_t OFF_VT   = OFF_Z + (size_t)NTOK * INW * 2;
constexpr size_t OFF_MIX  = OFF_VT + (size_t)NTOK * 128 * 2;
constexpr size_t OFF_WIN  = OFF_MIX + (size_t)NTOK * DM * 2;
constexpr size_t OFF_WOUT = OFF_WIN + (size_t)DEPTH * INW * DM * 2;
constexpr size_t OFF_WMEM = OFF_WOUT + (size_t)DEPTH * DM * DM * 2;
constexpr size_t OFF_PW   = OFF_WMEM + (size_t)DEPTH * 512 * DM * 2;
constexpr size_t OFF_MH   = OFF_PW + (size_t)DEPTH * 4 * 64 * 64 * 2;
constexpr size_t OFF_KM   = OFF_MH + (size_t)DEPTH * NMEMTOK * DM * 2;
constexpr size_t OFF_VMT  = OFF_KM + (size_t)DEPTH * NMEMTOK * 256 * 2;
constexpr size_t OFF_ROPE = OFF_VMT + (size_t)DEPTH * NMEMTOK * 256 * 2;
constexpr size_t OFF_BAR  = OFF_ROPE + 64 * 16 * 2 * 4;
constexpr size_t BAR_BYTES = 3456 * 4;
constexpr size_t WS_TOTAL = OFF_BAR + BAR_BYTES;

struct Params {
    const float* x_prompt; const float* x_sample; const float* mem_prompt; const float* mem_sample;
    const float* norm_pre; const float* norm_post; const float* w_in; const float* pool_w; const float* pool_scale;
    const float* q_norm; const float* k_norm; const float* mem_norm; const float* w_mem_kv; const float* w_out;
    float* out; unsigned char* ws;
    int phase_begin; int phase_end;
};

DI unsigned pk_bf16(float a, float b) {
    f32x2_t v = {a, b};
    bf16x2_t r = __builtin_convertvector(v, bf16x2_t);
    return __builtin_bit_cast(unsigned, r);
}
DI int opaque_tid() { int t = threadIdx.x; asm volatile("" : "+v"(t)); return t; }
DI void lds_barrier() { asm volatile("s_waitcnt lgkmcnt(0)\n\ts_barrier" ::: "memory"); }
DI float bflo(unsigned u) { return __uint_as_float(u << 16); }
DI float bfhi(unsigned u) { return __uint_as_float(u & 0xffff0000u); }
template <int CTRL> DI float dppf(float v) { return __uint_as_float(__builtin_amdgcn_update_dpp(0u, __float_as_uint(v), CTRL, 0xf, 0xf, true)); }
DI float x16_add(float v) { auto r = __builtin_amdgcn_permlane16_swap(__float_as_uint(v), __float_as_uint(v), false, false); return __uint_as_float(r[0]) + __uint_as_float(r[1]); }
DI float x32_add(float v) { auto r = __builtin_amdgcn_permlane32_swap(__float_as_uint(v), __float_as_uint(v), false, false); return __uint_as_float(r[0]) + __uint_as_float(r[1]); }
DI float x16_max(float v) { auto r = __builtin_amdgcn_permlane16_swap(__float_as_uint(v), __float_as_uint(v), false, false); return fmaxf(__uint_as_float(r[0]), __uint_as_float(r[1])); }
DI float x32_max(float v) { auto r = __builtin_amdgcn_permlane32_swap(__float_as_uint(v), __float_as_uint(v), false, false); return fmaxf(__uint_as_float(r[0]), __uint_as_float(r[1])); }
DI float wave_sum(float v) {
    v += dppf<0xB1>(v); v += dppf<0x4E>(v); v += dppf<0x141>(v); v += dppf<0x140>(v);
    v = x16_add(v); v = x32_add(v);
    return v;
}
DI float wave_max(float v) {
    v = fmaxf(v, dppf<0xB1>(v)); v = fmaxf(v, dppf<0x4E>(v)); v = fmaxf(v, dppf<0x141>(v)); v = fmaxf(v, dppf<0x140>(v));
    v = x16_max(v); v = x32_max(v);
    return v;
}
DI float xhalf_max(float v) {
    auto r = __builtin_amdgcn_permlane32_swap(__float_as_uint(v), __float_as_uint(v), false, false);
    return fmaxf(__uint_as_float(r[0]), __uint_as_float(r[1]));
}
DI void swap32(unsigned& a, unsigned& b) { auto r = __builtin_amdgcn_permlane32_swap(a, b, false, false); a = r[0]; b = r[1]; }
DI u32x4 o_pair_wide(const f32x16& ov, int gqA, float inv, u32x4 gw) {
    unsigned gax = gw.x, gay = gw.y, gbx = gw.z, gby = gw.w;
    swap32(gax, gbx); swap32(gay, gby);
    const int a = 4 * gqA, b = a + 4;
    unsigned ax = pk_bf16(ov[a] * inv * bflo(gax), ov[a + 1] * inv * bfhi(gax)), ay = pk_bf16(ov[a + 2] * inv * bflo(gay), ov[a + 3] * inv * bfhi(gay));
    unsigned bx = pk_bf16(ov[b] * inv * bflo(gbx), ov[b + 1] * inv * bfhi(gbx)), by = pk_bf16(ov[b + 2] * inv * bflo(gby), ov[b + 3] * inv * bfhi(gby));
    swap32(ax, bx); swap32(ay, by);
    return (u32x4){ax, ay, bx, by};
}
DI float silu_f(float x) { return x * __builtin_amdgcn_rcpf(1.0f + __builtin_amdgcn_exp2f(-x * L2E)); }
DI f32x4 mfma16(bf16x8 a, bf16x8 b, f32x4 c) { return __builtin_amdgcn_mfma_f32_16x16x32_bf16(a, b, c, 0, 0, 0); }
DI f32x16 mfma32(bf16x8 a, bf16x8 b, f32x16 c) { return __builtin_amdgcn_mfma_f32_32x32x16_bf16(a, b, c, 0, 0, 0); }

DI void transpose_tile(const float* __restrict__ src, int ldn, bf16_t* __restrict__ dst, int ldk, int k0, int n0, unsigned char* smem) {
    float* tile = (float*)smem;
    const int tid = opaque_tid();
    __syncthreads();
#pragma unroll
    for (int i = 0; i < 2; ++i) {
        const int id = tid + 512 * i, r = id >> 4, c4 = id & 15;
        const f32x4 v = *(const f32x4*)(src + (size_t)(k0 + r) * ldn + n0 + c4 * 4);
        tile[r * 65 + c4 * 4 + 0] = v[0]; tile[r * 65 + c4 * 4 + 1] = v[1]; tile[r * 65 + c4 * 4 + 2] = v[2]; tile[r * 65 + c4 * 4 + 3] = v[3];
    }
    __syncthreads();
    {
        const int n = tid >> 3, kc = tid & 7;
        float v[8];
#pragma unroll
        for (int j = 0; j < 8; ++j) v[j] = tile[(kc * 8 + j) * 65 + n];
        u32x4 o; o.x = pk_bf16(v[0], v[1]); o.y = pk_bf16(v[2], v[3]); o.z = pk_bf16(v[4], v[5]); o.w = pk_bf16(v[6], v[7]);
        *(u32x4*)(dst + (size_t)(n0 + n) * ldk + k0 + kc * 8) = o;
    }
}

struct RowIn { f32x4 v[4]; };
DI RowIn rms_row_load(const float* __restrict__ src, int lane) {
    RowIn r;
#pragma unroll
    for (int j = 0; j < 2; ++j) { r.v[2 * j] = *(const f32x4*)(src + j * 512 + lane * 8); r.v[2 * j + 1] = *(const f32x4*)(src + j * 512 + lane * 8 + 4); }
    return r;
}
DI void rms_row_finish(const RowIn& in, const float* __restrict__ g, bf16_t* __restrict__ dst, int lane) {
    f32x4 v[4]; float ss = 0.f;
#pragma unroll
    for (int j = 0; j < 4; ++j) { v[j] = in.v[j]; ss += v[j][0] * v[j][0] + v[j][1] * v[j][1] + v[j][2] * v[j][2] + v[j][3] * v[j][3]; }
    ss = wave_sum(ss);
    const float r = rsqrtf(ss * (1.0f / 1024.0f) + EPS);
#pragma unroll
    for (int j = 0; j < 2; ++j) {
        const f32x4 g0 = *(const f32x4*)(g + j * 512 + lane * 8), g1 = *(const f32x4*)(g + j * 512 + lane * 8 + 4);
        const f32x4 a = v[2 * j], b = v[2 * j + 1];
        u32x4 o;
        o.x = pk_bf16(a[0] * r * g0[0], a[1] * r * g0[1]); o.y = pk_bf16(a[2] * r * g0[2], a[3] * r * g0[3]);
        o.z = pk_bf16(b[0] * r * g1[0], b[1] * r * g1[1]); o.w = pk_bf16(b[2] * r * g1[2], b[3] * r * g1[3]);
        *(u32x4*)(dst + j * 512 + lane * 8) = o;
    }
}

DI void rope_entry(int idx, float* table) {
    const int n = idx >> 4, pp = idx & 15;
    double fd = 1.0;
    for (int i = 0; i < pp; ++i) fd *= 0.5623413251903491;
    const float f = (float)fd;
    const float a = (float)n * f;
    double r = (double)a;
    const double k = rint(r * 0.15915494309189535);
    r -= k * 6.283185307179586;
    const double r2 = r * r;
    double sn = r, cs = 1.0, ts = r, tc = 1.0;
    for (int i = 1; i <= 16; ++i) {
        tc = -tc * r2 / (double)((2 * i - 1) * (2 * i));
        ts = -ts * r2 / (double)((2 * i) * (2 * i + 1));
        cs += tc; sn += ts;
    }
    table[idx * 2] = (float)cs; table[idx * 2 + 1] = (float)sn;
}

struct EpiArgs {
    bf16_t* C;
    bf16_t* VT;
    const float* qn; const float* kn; const float* rope;
};

DI int g8_lds_byte(int r, int c) { const int st = (r >> 4) * 2 + (c >> 5), rr = r & 15, cc = c & 31, ob = rr * 64 + cc * 2; return st * 1024 + (ob ^ (((ob >> 9) & 1) << 5)); }
DI void g8_stage_rc(int b, int& R, int& C) { const int st = b >> 10, sb = b & 1023, swz = sb ^ (((sb >> 9) & 1) << 5); R = (st >> 1) * 16 + (swz >> 6); C = (st & 1) * 32 + ((swz & 63) >> 1); }

DI const unsigned char* uniform_ptr(const void* p) {
    const unsigned long long v = (unsigned long long)p;
    const unsigned lo = __builtin_amdgcn_readfirstlane((unsigned)v), hi = __builtin_amdgcn_readfirstlane((unsigned)(v >> 32));
    return (const unsigned char*)(((unsigned long long)hi << 32) | lo);
}

template <int MODE>
DI void gemm_tile(const bf16_t* __restrict__ A, const bf16_t* __restrict__ Bt, int m0, int n0, const EpiArgs& e, unsigned char* smem,
                  bool prefetched, const bf16_t* __restrict__ nA, const bf16_t* __restrict__ nB, int nm0, int nn0, bool nperm) {
    constexpr int K = 1024, BK = 64, HALF = 128, HTB = 16384, nt = K / BK;
    const int tid = opaque_tid(), lane = tid & 63, wave = __builtin_amdgcn_readfirstlane(tid >> 6);
    const int wr = wave >> 2, wc = wave & 3, fr = lane & 15, fq = lane >> 4;
    int sR0, sC0, sR1, sC1;
    g8_stage_rc(tid * 16, sR0, sC0); g8_stage_rc(tid * 16 + 8192, sR1, sC1);
    const unsigned so0b = (unsigned)(sR0 * K + sC0) * 2u, so1b = (unsigned)(sR1 * K + sC1) * 2u;
    const bool perm = (MODE == 1) ? true : ((MODE == 2) ? (n0 == 0) : !(n0 >= 512 && n0 < 1152));
    __attribute__((address_space(3))) unsigned char* lds = (__attribute__((address_space(3))) unsigned char*)smem;
#define G8_SA(b, h) (((b) * 2 + (h)) * HTB)
#define G8_SB(b, h) ((4 + (b) * 2 + (h)) * HTB)
#define G8_PERMOFF(SO) ({ const unsigned R_ = (SO) >> 11, rho_ = R_ & 31u, i_ = rho_ & 15u; const unsigned p_ = 8u * (i_ >> 2) + 4u * (rho_ >> 4) + (i_ & 3u); (SO) + (p_ - rho_) * 2048u; })
#define G8_STAGE_B(POFF, BASE, br, kt, PERM) { const unsigned char* g_ = uniform_ptr((BASE) + (size_t)(br) * K + (kt) * BK); \
        const unsigned b0_ = (PERM) ? G8_PERMOFF(so0b) : so0b, b1_ = (PERM) ? G8_PERMOFF(so1b) : so1b; \
        __builtin_amdgcn_global_load_lds((const __attribute__((address_space(1))) unsigned*)(g_ + b0_), (__attribute__((address_space(3))) unsigned*)(lds + (POFF) + tid * 16), 16, 0, 0); \
        __builtin_amdgcn_global_load_lds((const __attribute__((address_space(1))) unsigned*)(g_ + b1_), (__attribute__((address_space(3))) unsigned*)(lds + (POFF) + tid * 16 + 8192), 16, 0, 0); }
#define G8_STAGE(POFF, BASE, br, kt) { const unsigned char* g_ = uniform_ptr((BASE) + (size_t)(br) * K + (kt) * BK); \
        __builtin_amdgcn_global_load_lds((const __attribute__((address_space(1))) unsigned*)(g_ + so0b), (__attribute__((address_space(3))) unsigned*)(lds + (POFF) + tid * 16), 16, 0, 0); \
        __builtin_amdgcn_global_load_lds((const __attribute__((address_space(1))) unsigned*)(g_ + so1b), (__attribute__((address_space(3))) unsigned*)(lds + (POFF) + tid * 16 + 8192), 16, 0, 0); }
    const int lane_off = (fr * 64 + fq * 16) ^ ((fr >> 3) << 5);
    const unsigned ldsA = (unsigned)(size_t)lds + (unsigned)(lane_off + wr * 8192);
    const unsigned ldsB = (unsigned)(size_t)lds + (unsigned)(lane_off + wc * 4096);
#define G8_DSR(dst, addr, OFF) asm volatile("ds_read_b128 %0, %1 offset:" #OFF : "=v"(dst) : "v"(addr))
#define G8_LDA(dst, b, h) { const unsigned a_ = ldsA + G8_SA(b, h); \
        G8_DSR(dst[0][0], a_, 0); G8_DSR(dst[0][1], a_, 1024); G8_DSR(dst[1][0], a_, 2048); G8_DSR(dst[1][1], a_, 3072); \
        G8_DSR(dst[2][0], a_, 4096); G8_DSR(dst[2][1], a_, 5120); G8_DSR(dst[3][0], a_, 6144); G8_DSR(dst[3][1], a_, 7168); }
#define G8_LDB(dst, b, h) { const unsigned a_ = ldsB + G8_SB(b, h); \
        G8_DSR(dst[0][0], a_, 0); G8_DSR(dst[0][1], a_, 1024); G8_DSR(dst[1][0], a_, 2048); G8_DSR(dst[1][1], a_, 3072); }
#define G8_TIE_A(AT) asm volatile("s_waitcnt lgkmcnt(0)" : "+v"(AT[0][0]), "+v"(AT[0][1]), "+v"(AT[1][0]), "+v"(AT[1][1]), "+v"(AT[2][0]), "+v"(AT[2][1]), "+v"(AT[3][0]), "+v"(AT[3][1]) :: "memory")
#define G8_TIE_B(BX) asm volatile("s_waitcnt lgkmcnt(0)" : "+v"(BX[0][0]), "+v"(BX[0][1]), "+v"(BX[1][0]), "+v"(BX[1][1]) :: "memory")
#define G8_MMA(ai, bj, AT, BX) { __builtin_amdgcn_s_setprio(1); \
        _Pragma("unroll") for (int m = 0; m < 4; ++m) _Pragma("unroll") for (int n = 0; n < 2; ++n) _Pragma("unroll") for (int k = 0; k < 2; ++k) \
            acc[ai][bj][m][n] = mfma16(BX[n][k], AT[m][k], acc[ai][bj][m][n]); \
        __builtin_amdgcn_s_setprio(0); }
#define G8_WV(n) asm volatile("s_waitcnt vmcnt(" #n ")" ::: "memory")
#define G8_WL(n) asm volatile("s_waitcnt lgkmcnt(" #n ")" ::: "memory")
#define G8_BAR __builtin_amdgcn_s_barrier()
#define G8_SCHED __builtin_amdgcn_sched_barrier(0)
    f32x4 acc[2][2][4][2];
#pragma unroll
    for (int a = 0; a < 2; ++a)
#pragma unroll
        for (int b = 0; b < 2; ++b)
#pragma unroll
            for (int m = 0; m < 4; ++m)
#pragma unroll
                for (int n = 0; n < 2; ++n) acc[a][b][m][n] = (f32x4){0.f, 0.f, 0.f, 0.f};
    bf16x8 At[4][2], B0[2][2], B1[2][2];
    if (!prefetched) {
        __syncthreads();
        G8_STAGE_B(G8_SB(0, 0), Bt, n0, 0, perm); G8_STAGE(G8_SA(0, 0), A, m0, 0);
        G8_STAGE_B(G8_SB(0, 1), Bt, n0 + HALF, 0, perm); G8_STAGE(G8_SA(0, 1), A, m0 + HALF, 0);
        if (wr == 1) G8_BAR;
        G8_WV(4); G8_BAR;
        G8_STAGE_B(G8_SB(1, 0), Bt, n0, 1, perm); G8_STAGE(G8_SA(1, 0), A, m0, 1); G8_STAGE_B(G8_SB(1, 1), Bt, n0 + HALF, 1, perm);
        G8_WV(6); G8_BAR;
    } else {
        G8_WV(0);
        if (wr == 1) G8_BAR;
        G8_BAR;
        G8_BAR;
    }
    for (int t = 0; t < nt - 2; t += 2) {
        G8_LDB(B0, 0, 0); G8_SCHED; G8_LDA(At, 0, 0); G8_STAGE(G8_SA(1, 1), A, m0 + HALF, t + 1);
        G8_WL(8); G8_BAR; G8_TIE_B(B0); G8_TIE_A(At); G8_MMA(0, 0, At, B0); G8_BAR; G8_SCHED;
        G8_LDB(B1, 0, 1); G8_STAGE_B(G8_SB(0, 0), Bt, n0, t + 2, perm);
        G8_BAR; G8_TIE_B(B1); G8_MMA(0, 1, At, B1); G8_BAR;
        G8_LDA(At, 0, 1); G8_STAGE(G8_SA(0, 0), A, m0, t + 2);
        G8_BAR; G8_TIE_A(At); G8_MMA(1, 0, At, B0); G8_BAR; G8_SCHED;
        G8_STAGE_B(G8_SB(0, 1), Bt, n0 + HALF, t + 2, perm);
        G8_WV(6); G8_BAR; G8_MMA(1, 1, At, B1); G8_BAR;
        G8_LDB(B0, 1, 0); G8_SCHED; G8_LDA(At, 1, 0); G8_STAGE(G8_SA(0, 1), A, m0 + HALF, t + 2);
        G8_WL(8); G8_BAR; G8_TIE_B(B0); G8_TIE_A(At); G8_MMA(0, 0, At, B0); G8_BAR; G8_SCHED;
        G8_LDB(B1, 1, 1); G8_STAGE_B(G8_SB(1, 0), Bt, n0, t + 3, perm);
        G8_BAR; G8_TIE_B(B1); G8_MMA(0, 1, At, B1); G8_BAR;
        G8_LDA(At, 1, 1); G8_STAGE(G8_SA(1, 0), A, m0, t + 3);
        G8_BAR; G8_TIE_A(At); G8_MMA(1, 0, At, B0); G8_BAR; G8_SCHED;
        G8_STAGE_B(G8_SB(1, 1), Bt, n0 + HALF, t + 3, perm);
        G8_WV(6); G8_BAR; G8_MMA(1, 1, At, B1); G8_BAR;
    }
    {
        G8_LDB(B0, 0, 0); G8_LDA(At, 0, 0); G8_STAGE(G8_SA(1, 1), A, m0 + HALF, nt - 1);
        G8_BAR; G8_TIE_B(B0); G8_TIE_A(At); G8_MMA(0, 0, At, B0); G8_BAR;
        G8_LDB(B1, 0, 1); G8_BAR; G8_TIE_B(B1); G8_MMA(0, 1, At, B1); G8_BAR;
        G8_LDA(At, 0, 1); G8_WV(4); G8_BAR; G8_TIE_A(At); G8_MMA(1, 0, At, B0); G8_MMA(1, 1, At, B1); G8_BAR;
    }
    {
        G8_LDB(B0, 1, 0); G8_LDA(At, 1, 0); G8_WV(2); G8_BAR; G8_TIE_B(B0); G8_TIE_A(At); G8_MMA(0, 0, At, B0); G8_BAR;
        G8_LDB(B1, 1, 1); G8_WV(0); G8_BAR; G8_TIE_B(B1); G8_MMA(0, 1, At, B1); G8_BAR;
        G8_LDA(At, 1, 1); G8_BAR; G8_TIE_A(At); G8_MMA(1, 0, At, B0); G8_MMA(1, 1, At, B1); G8_BAR;
    }
    if (wr == 0) G8_BAR;
    if (nA != nullptr) {
        G8_STAGE_B(G8_SB(0, 0), nB, nn0, 0, nperm); G8_STAGE(G8_SA(0, 0), nA, nm0, 0);
        G8_STAGE_B(G8_SB(0, 1), nB, nn0 + HALF, 0, nperm); G8_STAGE(G8_SA(0, 1), nA, nm0 + HALF, 0);
        G8_STAGE_B(G8_SB(1, 0), nB, nn0, 1, nperm); G8_STAGE(G8_SA(1, 0), nA, nm0, 1); G8_STAGE_B(G8_SB(1, 1), nB, nn0 + HALF, 1, nperm);
    }
    __builtin_amdgcn_sched_barrier(0);
#undef G8_SA
#undef G8_SB
#undef G8_STAGE
#undef G8_STAGE_B
#undef G8_PERMOFF
#undef G8_LDA
#undef G8_LDB
#undef G8_DSR
#undef G8_TIE_A
#undef G8_TIE_B
#undef G8_MMA
#undef G8_WV
#undef G8_WL
#undef G8_BAR
#undef G8_SCHED

    const int tid_e = opaque_tid(), wave_e = __builtin_amdgcn_readfirstlane(tid_e >> 6);
    const int wr_e = wave_e >> 2, wc_e = wave_e & 3, fr_e = tid_e & 15, fq_e = (tid_e >> 4) & 3;
    const int tok_w = m0 + wr_e * 64 + fr_e;
    const int col_w = n0 + wc_e * 32 + 4 * fq_e;
    const int col_p = n0 + wc_e * 32 + 8 * fq_e;
    if (MODE == 1) {
#pragma unroll
        for (int ai = 0; ai < 2; ++ai)
#pragma unroll
            for (int m = 0; m < 4; ++m) {
                bf16_t* rowp = e.C + (size_t)(tok_w + ai * 128 + m * 16) * 1024 + col_p;
#pragma unroll
                for (int bj = 0; bj < 2; ++bj) {
                    const f32x4 v0 = acc[ai][bj][m][0], v1 = acc[ai][bj][m][1];
                    u32x4 o; o.x = pk_bf16(v0[0], v0[1]); o.y = pk_bf16(v0[2], v0[3]); o.z = pk_bf16(v1[0], v1[1]); o.w = pk_bf16(v1[2], v1[3]);
                    *(u32x4*)(rowp + bj * 128) = o;
                }
            }
    } else if (MODE == 2) {
        if (n0 == 0) {
#pragma unroll
            for (int ai = 0; ai < 2; ++ai)
#pragma unroll
                for (int m = 0; m < 4; ++m) {
                    bf16_t* rowp = e.C + (size_t)(tok_w + ai * 128 + m * 16) * 256 + col_p;
#pragma unroll
                    for (int bj = 0; bj < 2; ++bj) {
                        const f32x4 v0 = acc[ai][bj][m][0], v1 = acc[ai][bj][m][1];
                        u32x4 o; o.x = pk_bf16(v0[0], v0[1]); o.y = pk_bf16(v0[2], v0[3]); o.z = pk_bf16(v1[0], v1[1]); o.w = pk_bf16(v1[2], v1[3]);
                        *(u32x4*)(rowp + bj * 128) = o;
                    }
                }
        } else {
#pragma unroll
            for (int ai = 0; ai < 2; ++ai)
#pragma unroll
                for (int m = 0; m < 4; ++m) {
                    const int mt = tok_w + ai * 128 + m * 16, b = mt >> 8, mm = mt & 255;
#pragma unroll
                    for (int bj = 0; bj < 2; ++bj)
#pragma unroll
                        for (int n = 0; n < 2; ++n) {
                            const int f = (col_w - 256) + bj * 128 + n * 16, hx = f >> 6, d = f & 63;
                            bf16_t* bp = e.VT + ((size_t)(b * 4 + hx) * 64 + d) * 256 + mm;
#pragma unroll
                            for (int j = 0; j < 4; ++j) bp[(size_t)j * 256] = (bf16_t)(pk_bf16(acc[ai][bj][m][n][j], 0.f) & 0xffffu);
                        }
                }
        }
    } else {
        const bool has_qk = (n0 >= 512 && n0 < 1152);
        float* ssx = (float*)(smem + 3 * 16384);
        if (has_qk) {
#pragma unroll
            for (int ai = 0; ai < 2; ++ai)
#pragma unroll
                for (int bj = 0; bj < 2; ++bj)
#pragma unroll
                    for (int m = 0; m < 4; ++m) {
                        float ss = 0.f;
#pragma unroll
                        for (int n = 0; n < 2; ++n)
#pragma unroll
                            for (int j = 0; j < 4; ++j) ss += acc[ai][bj][m][n][j] * acc[ai][bj][m][n][j];
                        ss = x16_add(ss); ss = x32_add(ss);
                        if (fq_e == 0) ssx[((wave_e * 2 + ai) * 2 + bj) * 64 + m * 16 + fr_e] = ss;
                    }
            __syncthreads();
        }
#pragma unroll
        for (int bj = 0; bj < 2; ++bj) {
            const int cb = n0 + bj * 128 + wc_e * 32;
            const int c64 = cb & ~63;
            if (c64 >= 512 && c64 < 1152) {
                const bool isq = c64 < 1024;
                const float* gn = (isq ? e.qn : e.kn) + (wc_e & 1) * 32 + 4 * fq_e;
                const float osc = isq ? 0.125f * L2E : 1.0f;
                const f32x4 g0 = *(const f32x4*)(gn), g1 = *(const f32x4*)(gn + 16);
#pragma unroll
                for (int ai = 0; ai < 2; ++ai)
#pragma unroll
                    for (int m = 0; m < 4; ++m) {
                        const int tok = tok_w + ai * 128 + m * 16;
                        const float ss = ssx[((wave_e * 2 + ai) * 2 + bj) * 64 + m * 16 + fr_e] + ssx[(((wave_e ^ 1) * 2 + ai) * 2 + bj) * 64 + m * 16 + fr_e];
                        const float rinv = rsqrtf(ss * (1.0f / 64.0f) + EPS);
                        const int t = (tok < NPROMPT) ? (tok & 2047) : (tok & 4095);
                        const int ridx = (wc_e & 1) ? (t & 63) : (t >> 6);
                        const f32x4* rt = (const f32x4*)(e.rope + (ridx * 16 + 4 * fq_e) * 2);
                        const f32x4 r01 = rt[0], r23 = rt[1];
                        const float rc[4] = {r01[0], r01[2], r23[0], r23[2]}, rs[4] = {r01[1], r01[3], r23[1], r23[3]};
                        float oa[4], ob[4];
#pragma unroll
                        for (int j = 0; j < 4; ++j) {
                            const float a = acc[ai][bj][m][0][j] * rinv * g0[j], b = acc[ai][bj][m][1][j] * rinv * g1[j];
                            oa[j] = (a * rc[j] - b * rs[j]) * osc; ob[j] = (b * rc[j] + a * rs[j]) * osc;
                        }
                        bf16_t* rowp = e.C + (size_t)tok * INW + cb + 4 * fq_e;
                        u32x2 w0, w1; w0.x = pk_bf16(oa[0], oa[1]); w0.y = pk_bf16(oa[2], oa[3]); w1.x = pk_bf16(ob[0], ob[1]); w1.y = pk_bf16(ob[2], ob[3]);
                        *(u32x2*)(rowp) = w0; *(u32x2*)(rowp + 16) = w1;
                    }
            } else if (c64 >= 1152 && c64 < 1280) {
#pragma unroll
                for (int ai = 0; ai < 2; ++ai)
#pragma unroll
                    for (int m = 0; m < 4; ++m) {
                        const int tok = tok_w + ai * 128 + m * 16;
#pragma unroll
                        for (int n = 0; n < 2; ++n) {
                            const int f = cb + n * 16 + 4 * fq_e - 1152, kvh = f >> 6, d = f & 63;
                            bf16_t* bp; size_t T;
                            if (tok < NPROMPT) { const int b = tok >> 11, t = tok & 2047; T = 2048; bp = e.VT + ((size_t)(b * 2 + kvh) * 64 + d) * 2048 + t; }
                            else { const int b = (tok - NPROMPT) >> 12, t = tok & 4095; T = 4096; bp = e.VT + (size_t)NPROMPT * 128 + ((size_t)(b * 2 + kvh) * 64 + d) * 4096 + t; }
#pragma unroll
                            for (int j = 0; j < 4; ++j) bp[(size_t)j * T] = (bf16_t)(pk_bf16(acc[ai][bj][m][n][j], 0.f) & 0xffffu);
                        }
                    }
            } else {
                const int kind = (c64 < 256) ? 0 : ((c64 >= 1792 && c64 < 2048) ? 2 : 1);
#pragma unroll
                for (int ai = 0; ai < 2; ++ai)
#pragma unroll
                    for (int m = 0; m < 4; ++m) {
                        bf16_t* rowp = e.C + (size_t)(tok_w + ai * 128 + m * 16) * INW + cb + 8 * fq_e;
                        float v[8];
#pragma unroll
                        for (int n = 0; n < 2; ++n)
#pragma unroll
                            for (int j = 0; j < 4; ++j) { const float x = acc[ai][bj][m][n][j]; v[4 * n + j] = (kind == 0) ? x : ((kind == 2) ? x * (0.125f * L2E) : silu_f(x)); }
                        u32x4 o; o.x = pk_bf16(v[0], v[1]); o.y = pk_bf16(v[2], v[3]); o.z = pk_bf16(v[4], v[5]); o.w = pk_bf16(v[6], v[7]);
                        *(u32x4*)(rowp) = o;
                    }
            }
        }
    }
}

#define SB_() __builtin_amdgcn_sched_barrier(0)
#define KFRAG(KS, KB) (*(const bf16x8*)(kp + (KB) * 4096 + k_off + ((((KS) * 2 + h) ^ kswz) << 4)))
#define VFRAG(KK, DB) (*(const bf16x8*)(vp + (DB) * 4096 + v_off + ((((KK) * 2 + h) ^ vswz) << 4)))
#define EXP4(S, I0) { _Pragma("unroll") for (int i_ = (I0); i_ < (I0) + 4; ++i_) { S[i_] = __builtin_amdgcn_exp2f(S[i_] - mb); rs += S[i_]; } }
#define EXP4F(S, I0) { f32x2_t a_ = {S[(I0)], S[(I0) + 1]}, b_ = {S[(I0) + 2], S[(I0) + 3]}; \
        a_ = a_ - (f32x2_t){mb, mb}; b_ = b_ - (f32x2_t){mb, mb}; \
        S[(I0)] = __builtin_amdgcn_exp2f(a_.x); S[(I0) + 1] = __builtin_amdgcn_exp2f(a_.y); S[(I0) + 2] = __builtin_amdgcn_exp2f(b_.x); S[(I0) + 3] = __builtin_amdgcn_exp2f(b_.y); \
        rs2 += (f32x2_t){S[(I0)], S[(I0) + 1]} + (f32x2_t){S[(I0) + 2], S[(I0) + 3]}; }
#define EXPQ(S, I0) { if (FIXM) EXP4F(S, I0) else EXP4(S, I0) }
#define PACK8(S, I0) ({ u32x4 t_; t_.x = pk_bf16(S[(I0)], S[(I0) + 1]); t_.y = pk_bf16(S[(I0) + 2], S[(I0) + 3]); t_.z = pk_bf16(S[(I0) + 4], S[(I0) + 5]); t_.w = pk_bf16(S[(I0) + 6], S[(I0) + 7]); __builtin_bit_cast(bf16x8, t_); })
DI float max8(const f32x16& s, int i0, float mx) {
    mx = fmaxf(fmaxf(mx, s[i0]), s[i0 + 1]); mx = fmaxf(fmaxf(mx, s[i0 + 2]), s[i0 + 3]);
    mx = fmaxf(fmaxf(mx, s[i0 + 4]), s[i0 + 5]); mx = fmaxf(fmaxf(mx, s[i0 + 6]), s[i0 + 7]);
    return mx;
}
#define EXP2F(S, I0) { S[(I0)] = __builtin_amdgcn_exp2f(S[(I0)]); S[(I0) + 1] = __builtin_amdgcn_exp2f(S[(I0) + 1]); rs += S[(I0)] + S[(I0) + 1]; \
        asm volatile("" : "+v"(S[(I0)]), "+v"(S[(I0) + 1]), "+v"(rs)); }
#define PIN1(X) asm volatile("" : "+v"(X))
template <bool DO_PV, bool DO_QK>
DI void attn_step_fix(f32x16& s0, f32x16& s1, f32x16& n0, f32x16& n1, const bf16x8 (&pp)[4], bf16x8 (&pc)[4],
                      f32x16& o0, f32x16& o1, const float m, float& lsum, const bf16x8 (&qf)[4],
                      const unsigned char* kp, const unsigned char* vp, int k_off, int kswz, int v_off, int vswz, int h) {
    bf16x8 va0, vb0, va1, vb1, va2, vb2, va3, vb3, ka0, kb0, ka1, kb1, ka2, kb2, ka3, kb3;
    float rs = 0.f;
    if (DO_PV) { va0 = VFRAG(0, 0); vb0 = VFRAG(0, 1); va1 = VFRAG(1, 0); vb1 = VFRAG(1, 1); }
    EXP2F(s0, 0);  if (DO_PV) { o0 = mfma32(va0, pp[0], o0); va2 = VFRAG(2, 0); vb2 = VFRAG(2, 1); }
    EXP2F(s0, 2);  if (DO_PV) { o1 = mfma32(vb0, pp[0], o1); va3 = VFRAG(3, 0); vb3 = VFRAG(3, 1); }
    EXP2F(s0, 4);  if (DO_PV) { o0 = mfma32(va1, pp[1], o0); } if (DO_QK) { ka0 = KFRAG(0, 0); kb0 = KFRAG(0, 1); }
    EXP2F(s0, 6);  if (DO_PV) { o1 = mfma32(vb1, pp[1], o1); } if (DO_QK) { ka1 = KFRAG(1, 0); kb1 = KFRAG(1, 1); }
    EXP2F(s0, 8);  if (DO_PV) { o0 = mfma32(va2, pp[2], o0); }
    EXP2F(s0, 10); if (DO_PV) { o1 = mfma32(vb2, pp[2], o1); } pc[0] = PACK8(s0, 0); PIN1(pc[0]);
    EXP2F(s0, 12); if (DO_PV) { o0 = mfma32(va3, pp[3], o0); }
    EXP2F(s0, 14); if (DO_PV) { o1 = mfma32(vb3, pp[3], o1); }
    EXP2F(s1, 0);  if (DO_QK) { n0 = mfma32(ka0, qf[0], (f32x16){0.f, 0.f, 0.f, 0.f, 0.f, 0.f, 0.f, 0.f, 0.f, 0.f, 0.f, 0.f, 0.f, 0.f, 0.f, 0.f}); ka2 = KFRAG(2, 0); kb2 = KFRAG(2, 1); } pc[1] = PACK8(s0, 8); PIN1(pc[1]);
    EXP2F(s1, 2);  if (DO_QK) { n1 = mfma32(kb0, qf[0], (f32x16){0.f, 0.f, 0.f, 0.f, 0.f, 0.f, 0.f, 0.f, 0.f, 0.f, 0.f, 0.f, 0.f, 0.f, 0.f, 0.f}); ka3 = KFRAG(3, 0); kb3 = KFRAG(3, 1); }
    EXP2F(s1, 4);  if (DO_QK) { n0 = mfma32(ka1, qf[1], n0); }
    EXP2F(s1, 6);  if (DO_QK) { n1 = mfma32(kb1, qf[1], n1); }
    EXP2F(s1, 8);  if (DO_QK) { n0 = mfma32(ka2, qf[2], n0); } pc[2] = PACK8(s1, 0); PIN1(pc[2]);
    EXP2F(s1, 10); if (DO_QK) { n1 = mfma32(kb2, qf[2], n1); }
    EXP2F(s1, 12); if (DO_QK) { n0 = mfma32(ka3, qf[3], n0); }
    EXP2F(s1, 14); if (DO_QK) { n1 = mfma32(kb3, qf[3], n1); } pc[3] = PACK8(s1, 8); PIN1(pc[3]);
    lsum += rs;

}
template <bool DO_PV, bool DO_QK, bool FIXM>
DI void attn_step(f32x16& s0, f32x16& s1, f32x16& n0, f32x16& n1, const bf16x8 (&pp)[4], bf16x8 (&pc)[4],
                  f32x16& o0, f32x16& o1, float& m, float& lsum, const bf16x8 (&qf)[4],
                  const unsigned char* kp, const unsigned char* vp, int k_off, int kswz, int v_off, int vswz, int h) {
    if (FIXM) { attn_step_fix<DO_PV, DO_QK>(s0, s1, n0, n1, pp, pc, o0, o1, m, lsum, qf, kp, vp, k_off, kswz, v_off, vswz, h); return; }
    bf16x8 va0, vb0, va1, vb1, va2, vb2, va3, vb3, ka0, kb0, ka1, kb1, ka2, kb2, ka3, kb3;
    if (DO_PV) { va0 = VFRAG(0, 0); vb0 = VFRAG(0, 1); va1 = VFRAG(1, 0); vb1 = VFRAG(1, 1); }
    float mx = s0[0];
    if (DO_PV) o0 = mfma32(va0, pp[0], o0);
    if (!FIXM) mx = max8(s0, 0, mx);
    SB_();
    if (DO_PV) { o1 = mfma32(vb0, pp[0], o1); va2 = VFRAG(2, 0); vb2 = VFRAG(2, 1); }
    if (!FIXM) mx = max8(s0, 8, mx);
    SB_();
    if (DO_PV) { o0 = mfma32(va1, pp[1], o0); va3 = VFRAG(3, 0); vb3 = VFRAG(3, 1); }
    if (!FIXM) mx = max8(s1, 0, mx);
    SB_();
    if (DO_PV) o1 = mfma32(vb1, pp[1], o1);
    bool need = false; float alpha = 1.0f;
    if (!FIXM) {
        mx = max8(s1, 8, mx);
        mx = xhalf_max(mx);
        need = mx > m + 8.0f;
        const float mnew = need ? mx : m;
        alpha = __builtin_amdgcn_exp2f(m - mnew);
        m = mnew;
    }
    const float mb = m;
    float rs = 0.f; f32x2_t rs2 = {0.f, 0.f};
    SB_();
    if (DO_PV) o0 = mfma32(va2, pp[2], o0);
    if (DO_QK) { ka0 = KFRAG(0, 0); kb0 = KFRAG(0, 1); }
    EXPQ(s0, 0);
    SB_();
    if (DO_PV) o1 = mfma32(vb2, pp[2], o1);
    if (DO_QK) { ka1 = KFRAG(1, 0); kb1 = KFRAG(1, 1); }
    EXPQ(s0, 4);
    SB_();
    if (DO_PV) o0 = mfma32(va3, pp[3], o0);
    EXPQ(s0, 8);
    SB_();
    if (DO_PV) o1 = mfma32(vb3, pp[3], o1);
    EXPQ(s0, 12);
    SB_();
    if (DO_QK) { n0 = mfma32(ka0, qf[0], (f32x16){0.f, 0.f, 0.f, 0.f, 0.f, 0.f, 0.f, 0.f, 0.f, 0.f, 0.f, 0.f, 0.f, 0.f, 0.f, 0.f}); ka2 = KFRAG(2, 0); kb2 = KFRAG(2, 1); }
    EXPQ(s1, 0);
    SB_();
    if (DO_QK) { n1 = mfma32(kb0, qf[0], (f32x16){0.f, 0.f, 0.f, 0.f, 0.f, 0.f, 0.f, 0.f, 0.f, 0.f, 0.f, 0.f, 0.f, 0.f, 0.f, 0.f}); ka3 = KFRAG(3, 0); kb3 = KFRAG(3, 1); }
    EXPQ(s1, 4);
    SB_();
    if (DO_QK) n0 = mfma32(ka1, qf[1], n0);
    EXPQ(s1, 8);
    SB_();
    if (DO_QK) n1 = mfma32(kb1, qf[1], n1);
    EXPQ(s1, 12);
    SB_();
    if (DO_QK) n0 = mfma32(ka2, qf[2], n0);
    pc[0] = PACK8(s0, 0);
    SB_();
    if (DO_QK) n1 = mfma32(kb2, qf[2], n1);
    pc[1] = PACK8(s0, 8);
    SB_();
    if (DO_QK) n0 = mfma32(ka3, qf[3], n0);
    pc[2] = PACK8(s1, 0);
    SB_();
    if (DO_QK) n1 = mfma32(kb3, qf[3], n1);
    pc[3] = PACK8(s1, 8);
    if (FIXM) lsum += rs2.x + rs2.y; else lsum = lsum * alpha + rs;
    SB_();
    if (!FIXM) {
        if (__builtin_amdgcn_ballot_w64(need)) {
#pragma unroll
            for (int i = 0; i < 16; ++i) { o0[i] *= alpha; o1[i] *= alpha; }
        }
    }
}

struct AttnPre { bf16x8 q[4]; u32x4 k0, k1, s0k, s0v; };
DI void attn_prefetch(AttnPre& pre, const bf16_t* __restrict__ Q, const bf16_t* __restrict__ K, const bf16_t* __restrict__ VT, int ldv, int tid) {
    const int lane = tid & 63, wave = tid >> 6, r = lane & 31, h = lane >> 5, lrow = tid >> 3, lc = tid & 7;
    const bf16_t* qp = Q + (size_t)(wave * 32 + r) * INW + h * 8;
#pragma unroll
    for (int ks = 0; ks < 4; ++ks) pre.q[ks] = *(const bf16x8*)(qp + ks * 16);
    const bf16_t* Kg = K + (size_t)lrow * INW + lc * 8;
    pre.k0 = *(const u32x4*)(Kg); pre.k1 = *(const u32x4*)(Kg + (size_t)64 * INW); pre.s0k = *(const u32x4*)(Kg + (size_t)128 * INW);
    pre.s0v = *(const u32x4*)(VT + (size_t)lrow * ldv + lc * 8);
}

template <bool FIXM>
DI void attn_item(const bf16_t* __restrict__ Q, int ldq, const bf16_t* __restrict__ K, int ldk, const bf16_t* __restrict__ VT, int ldv,
                  int nkeys, bf16_t* __restrict__ O, const bf16_t* __restrict__ G, unsigned char* smem, float mfix,
                  AttnPre& pre, const bf16_t* __restrict__ nQ, const bf16_t* __restrict__ nK, const bf16_t* __restrict__ nVT, int nldv) {
    const int tid = opaque_tid(), lane = tid & 63, wave = tid >> 6;
    const int r = lane & 31, h = lane >> 5;
    bf16x8 qf[4];
#pragma unroll
    for (int ks = 0; ks < 4; ++ks) qf[ks] = pre.q[ks];
    const int lrow = tid >> 3, lc = tid & 7;
    const bf16_t* Kg = K + (size_t)lrow * ldk + lc * 8;
    const bf16_t* Vg = VT + (size_t)lrow * ldv + lc * 8;
    const int st_off = lrow * 128 + ((lc ^ ((lrow >> 1) & 7)) << 4);
    const int pr = (r & ~12) | ((r & 4) << 1) | ((r & 8) >> 1);
    const int kswz = (pr >> 1) & 7, vswz = (r >> 1) & 7;
    const int k_off = pr * 128, v_off = r * 128;
    const int nt = nkeys >> 6;

    f32x16 o0, o1, sa0, sa1, sb0, sb1;
#pragma unroll
    for (int i = 0; i < 16; ++i) { o0[i] = 0.f; o1[i] = 0.f; }
    float m = FIXM ? mfix : -1e30f, lsum = 0.f;
    bf16x8 pa[4], pb[4];

    u32x4 rk, rv;
#define A_LOAD(U) { const int kt_ = ((U) + 2 < nt) ? (U) + 2 : nt - 1; rk = *(const u32x4*)(Kg + (size_t)(kt_ * 64) * ldk); rv = *(const u32x4*)(Vg + (U) * 64); }
#define A_STORE(OFF) { *(u32x4*)(smem + (OFF) + st_off) = rk; *(u32x4*)(smem + (OFF) + 8192 + st_off) = rv; }
    lds_barrier();
    *(u32x4*)(smem + 16384 + st_off) = pre.k0; *(u32x4*)(smem + 16384 + 8192 + st_off) = pre.k1;
    *(u32x4*)(smem + st_off) = pre.s0k; *(u32x4*)(smem + 8192 + st_off) = pre.s0v;
    A_LOAD(1);
    lds_barrier();
    {
        const unsigned char* kp = smem + 16384;
        sa0 = mfma32(KFRAG(0, 0), qf[0], (f32x16){0.f, 0.f, 0.f, 0.f, 0.f, 0.f, 0.f, 0.f, 0.f, 0.f, 0.f, 0.f, 0.f, 0.f, 0.f, 0.f});
        sa1 = mfma32(KFRAG(0, 1), qf[0], (f32x16){0.f, 0.f, 0.f, 0.f, 0.f, 0.f, 0.f, 0.f, 0.f, 0.f, 0.f, 0.f, 0.f, 0.f, 0.f, 0.f});
#pragma unroll
        for (int ks = 1; ks < 4; ++ks) { sa0 = mfma32(KFRAG(ks, 0), qf[ks], sa0); sa1 = mfma32(KFRAG(ks, 1), qf[ks], sa1); }
    }
    attn_step<false, true, FIXM>(sa0, sa1, sb0, sb1, pb, pa, o0, o1, m, lsum, qf, smem + 16384 + 8192, smem, k_off, kswz, v_off, vswz, h);
    lds_barrier();
    for (int t = 1; t < nt - 1; t += 2) {
        A_STORE(16384);
        A_LOAD(t + 1);
        SB_();
        attn_step<true, true, FIXM>(sb0, sb1, sa0, sa1, pa, pb, o0, o1, m, lsum, qf, smem, smem + 8192, k_off, kswz, v_off, vswz, h);
        lds_barrier();
        A_STORE(0);
        A_LOAD(t + 2);
        SB_();
        attn_step<true, true, FIXM>(sa0, sa1, sb0, sb1, pb, pa, o0, o1, m, lsum, qf, smem + 16384, smem + 16384 + 8192, k_off, kswz, v_off, vswz, h);
        lds_barrier();
    }
    A_STORE(16384);
    const bf16_t* gp = G + (size_t)(wave * 32 + r) * INW + 8 * h;
    u32x4 gw[4];
#pragma unroll
    for (int pp = 0; pp < 4; ++pp) gw[pp] = *(const u32x4*)(gp + 16 * pp);
    attn_prefetch(pre, nQ, nK, nVT, nldv, tid);
    SB_();
    attn_step<true, false, FIXM>(sb0, sb1, sa0, sa1, pa, pb, o0, o1, m, lsum, qf, smem, smem + 8192, k_off, kswz, v_off, vswz, h);
    lds_barrier();
    {
        const unsigned char* vp = smem + 16384 + 8192;
#pragma unroll
        for (int kk = 0; kk < 4; ++kk) { o0 = mfma32(VFRAG(kk, 0), pb[kk], o0); o1 = mfma32(VFRAG(kk, 1), pb[kk], o1); }
    }
#undef A_LOAD
#undef A_STORE
    const float lt = x32_add(lsum);
    const float inv = 1.0f / lt;
    bf16_t* op = O + (size_t)(wave * 32 + r) * 1024 + 8 * h;
    *(u32x4*)(op) = o_pair_wide(o0, 0, inv, gw[0]);
    *(u32x4*)(op + 16) = o_pair_wide(o0, 2, inv, gw[1]);
    *(u32x4*)(op + 32) = o_pair_wide(o1, 0, inv, gw[2]);
    *(u32x4*)(op + 48) = o_pair_wide(o1, 2, inv, gw[3]);
}

DI void cross_item(const bf16_t* __restrict__ Q, const bf16_t* __restrict__ K, const bf16_t* __restrict__ VT,
                   bf16_t* __restrict__ O, const bf16_t* __restrict__ G, unsigned char* smem) {
    const int tid = opaque_tid(), lane = tid & 63, wave = tid >> 6;
    const int r = lane & 31, h = lane >> 5;
    bf16x8 qf[4];
    {
        const bf16_t* qp = Q + (size_t)(wave * 32 + r) * INW + h * 8;
#pragma unroll
        for (int ks = 0; ks < 4; ++ks) qf[ks] = *(const bf16x8*)(qp + ks * 16);
    }
    const int lrow = tid >> 3, lc = tid & 7;
    const int st_off = lrow * 128 + ((lc ^ ((lrow >> 1) & 7)) << 4);
    {
        u32x4 kk[4], vv[4];
#pragma unroll
        for (int i = 0; i < 4; ++i) { kk[i] = *(const u32x4*)(K + (size_t)(lrow + 64 * i) * 256 + lc * 8); vv[i] = *(const u32x4*)(VT + (size_t)lrow * 256 + (i * 8 + lc) * 8); }
        __syncthreads();
#pragma unroll
        for (int i = 0; i < 4; ++i) { *(u32x4*)(smem + i * 16384 + st_off) = kk[i]; *(u32x4*)(smem + i * 16384 + 8192 + st_off) = vv[i]; }
    }
    const bf16_t* gp = G + (size_t)(wave * 32 + r) * INW + 8 * h;
    u32x4 gw[4];
#pragma unroll
    for (int pp = 0; pp < 4; ++pp) gw[pp] = *(const u32x4*)(gp + 16 * pp);
    __syncthreads();
    const int pr = (r & ~12) | ((r & 4) << 1) | ((r & 8) >> 1);
    const int kswz = (pr >> 1) & 7, vswz = (r >> 1) & 7;
    const int k_off = pr * 128, v_off = r * 128;
    f32x16 o0, o1;
#pragma unroll
    for (int i = 0; i < 16; ++i) { o0[i] = 0.f; o1[i] = 0.f; }
    float m = -1e30f, lsum = 0.f;
#pragma unroll 1
    for (int kt = 0; kt < 4; ++kt) {
        const unsigned char* kp = smem + kt * 16384;
        const unsigned char* vp = kp + 8192;
        f32x16 s0, s1;
        s0 = mfma32(KFRAG(0, 0), qf[0], (f32x16){0.f, 0.f, 0.f, 0.f, 0.f, 0.f, 0.f, 0.f, 0.f, 0.f, 0.f, 0.f, 0.f, 0.f, 0.f, 0.f});
        s1 = mfma32(KFRAG(0, 1), qf[0], (f32x16){0.f, 0.f, 0.f, 0.f, 0.f, 0.f, 0.f, 0.f, 0.f, 0.f, 0.f, 0.f, 0.f, 0.f, 0.f, 0.f});
#pragma unroll
        for (int ks = 1; ks < 4; ++ks) { s0 = mfma32(KFRAG(ks, 0), qf[ks], s0); s1 = mfma32(KFRAG(ks, 1), qf[ks], s1); }
        float mx = s0[0];
        mx = max8(s0, 0, mx); mx = max8(s0, 8, mx); mx = max8(s1, 0, mx); mx = max8(s1, 8, mx);
        mx = xhalf_max(mx);
        const float mnew = fmaxf(m, mx);
        const float alpha = __builtin_amdgcn_exp2f(m - mnew);
        m = mnew;
        const float mb = mnew;
        float rs = 0.f;
#pragma unroll
        for (int i = 0; i < 16; ++i) { s0[i] = __builtin_amdgcn_exp2f(s0[i] - mb); s1[i] = __builtin_amdgcn_exp2f(s1[i] - mb); rs += s0[i] + s1[i]; }
        lsum = lsum * alpha + rs;
#pragma unroll
        for (int i = 0; i < 16; ++i) { o0[i] *= alpha; o1[i] *= alpha; }
        bf16x8 pf[4];
        pf[0] = PACK8(s0, 0); pf[1] = PACK8(s0, 8); pf[2] = PACK8(s1, 0); pf[3] = PACK8(s1, 8);
#pragma unroll
        for (int kk2 = 0; kk2 < 4; ++kk2) { o0 = mfma32(VFRAG(kk2, 0), pf[kk2], o0); o1 = mfma32(VFRAG(kk2, 1), pf[kk2], o1); }
    }
    const float lt = x32_add(lsum);
    const float inv = 1.0f / lt;
    bf16_t* op = O + (size_t)(wave * 32 + r) * 1024 + 8 * h;
    *(u32x4*)(op) = o_pair_wide(o0, 0, inv, gw[0]);
    *(u32x4*)(op + 16) = o_pair_wide(o0, 2, inv, gw[1]);
    *(u32x4*)(op + 32) = o_pair_wide(o1, 0, inv, gw[2]);
    *(u32x4*)(op + 48) = o_pair_wide(o1, 2, inv, gw[3]);
}

DI void pool_item(const bf16_t* __restrict__ Z, const bf16_t* __restrict__ PWT, const float* __restrict__ pscale, bf16_t* __restrict__ MIX,
                  int tokg0, unsigned char* smem) {
    const int tid = opaque_tid(), lane = tid & 63, wave = tid >> 6;
    const int T = (tokg0 < NPROMPT) ? 2048 : 4096;
    const int t0 = tokg0 & (T - 1);
    constexpr int RS = 528;
    const int g = wave & 3, half = 1 << g;
    const int r16 = lane & 15, q4 = lane >> 4;
    const bf16_t* pw = PWT + (size_t)g * 4096 + r16 * 64 + q4 * 8;
    bf16x8 wfr[4][2]; f32x4 psr[4]; u32x2 ggr[2][4];
#pragma unroll
    for (int fi = 0; fi < 4; ++fi) {
        psr[fi] = *(const f32x4*)(pscale + g * 64 + fi * 16 + 4 * q4);
#pragma unroll
        for (int ks = 0; ks < 2; ++ks) wfr[fi][ks] = *(const bf16x8*)(pw + fi * 16 * 64 + ks * 32);
#pragma unroll
        for (int t2 = 0; t2 < 2; ++t2) ggr[t2][fi] = *(const u32x2*)(Z + ((size_t)tokg0 + ((wave >> 2) * 2 + t2) * 16 + r16) * INW + 256 + g * 64 + fi * 16 + 4 * q4);
    }
    __syncthreads();
    for (int id = tid; id < 80 * 32; id += 512) {
        const int rr = id >> 5, c = id & 31;
        const int t = t0 - 8 + rr;
        u32x4 v = (u32x4){0u, 0u, 0u, 0u};
        if (t >= 0 && t < T) v = *(const u32x4*)(Z + (size_t)(tokg0 - 8 + rr) * INW + c * 8);
        *(u32x4*)(smem + rr * RS + c * 16) = v;
    }
    __syncthreads();
    {
        const int th = wave >> 2;
        bf16x8 df[2][2];
#pragma unroll
        for (int t2 = 0; t2 < 2; ++t2)
#pragma unroll
            for (int ks = 0; ks < 2; ++ks) {
                const int tl = (th * 2 + t2) * 16 + r16, t = t0 + tl;
                const int lo = max(t - half, 0), hi = min(t + half, T);
                const float icnt = 1.0f / (float)(hi - lo);
                float s[8];
#pragma unroll
                for (int j = 0; j < 8; ++j) s[j] = 0.f;
                const unsigned char* bp = smem + (tl + 8 - half) * RS + (g * 64 + ks * 32 + q4 * 8) * 2;
                for (int j = 0; j < 2 * half; ++j) {
                    const u32x4 v = *(const u32x4*)(bp + j * RS);
                    s[0] += bflo(v.x); s[1] += bfhi(v.x); s[2] += bflo(v.y); s[3] += bfhi(v.y);
                    s[4] += bflo(v.z); s[5] += bfhi(v.z); s[6] += bflo(v.w); s[7] += bfhi(v.w);
                }
                const u32x4 c = *(const u32x4*)(bp + half * RS);
                u32x4 o;
                o.x = pk_bf16(s[0] * icnt - bflo(c.x), s[1] * icnt - bfhi(c.x));
                o.y = pk_bf16(s[2] * icnt - bflo(c.y), s[3] * icnt - bfhi(c.y));
                o.z = pk_bf16(s[4] * icnt - bflo(c.z), s[5] * icnt - bfhi(c.z));
                o.w = pk_bf16(s[6] * icnt - bflo(c.w), s[7] * icnt - bfhi(c.w));
                df[t2][ks] = __builtin_bit_cast(bf16x8, o);
            }
        f32x4 acc[4][2];
#pragma unroll
        for (int i = 0; i < 4; ++i)
#pragma unroll
            for (int j = 0; j < 2; ++j) acc[i][j] = (f32x4){0.f, 0.f, 0.f, 0.f};
#pragma unroll
        for (int fi = 0; fi < 4; ++fi)
#pragma unroll
            for (int ks = 0; ks < 2; ++ks) {
                const bf16x8 wf = wfr[fi][ks];
#pragma unroll
                for (int t2 = 0; t2 < 2; ++t2) acc[fi][t2] = mfma16(wf, df[t2][ks], acc[fi][t2]);
            }
#pragma unroll
        for (int t2 = 0; t2 < 2; ++t2) {
            const size_t tok = (size_t)tokg0 + (th * 2 + t2) * 16 + r16;
#pragma unroll
            for (int fi = 0; fi < 4; ++fi) {
                const int n = g * 64 + fi * 16 + 4 * q4;
                const f32x4 ps = psr[fi];
                const u32x2 gg = ggr[t2][fi];
                u32x2 w;
                w.x = pk_bf16(acc[fi][t2][0] * ps[0] * bflo(gg.x), acc[fi][t2][1] * ps[1] * bfhi(gg.x));
                w.y = pk_bf16(acc[fi][t2][2] * ps[2] * bflo(gg.y), acc[fi][t2][3] * ps[3] * bfhi(gg.y));
                *(u32x2*)(MIX + tok * 1024 + n) = w;
            }
        }
    }
}

struct PostIn { u32x4 yv[2]; f32x4 xv[4]; };
DI PostIn post_row_load(const float* __restrict__ xsrc, const bf16_t* __restrict__ yh, int lane) {
    PostIn r;
#pragma unroll
    for (int j = 0; j < 2; ++j) r.yv[j] = *(const u32x4*)(yh + j * 512 + lane * 8);
#pragma unroll
    for (int j = 0; j < 2; ++j) { r.xv[2 * j] = *(const f32x4*)(xsrc + j * 512 + lane * 8); r.xv[2 * j + 1] = *(const f32x4*)(xsrc + j * 512 + lane * 8 + 4); }
    return r;
}
DI void post_row_finish(const PostIn& in, bf16_t* __restrict__ yh, const float* __restrict__ gpost, const float* __restrict__ gpre_next,
                        float* __restrict__ xdst, bool last, int lane) {
    u32x4 yv[2]; f32x4 xv[4];
#pragma unroll
    for (int j = 0; j < 2; ++j) yv[j] = in.yv[j];
#pragma unroll
    for (int j = 0; j < 4; ++j) xv[j] = in.xv[j];
    float y[16];
#pragma unroll
    for (int j = 0; j < 2; ++j) {
        y[8 * j + 0] = bflo(yv[j].x); y[8 * j + 1] = bfhi(yv[j].x); y[8 * j + 2] = bflo(yv[j].y); y[8 * j + 3] = bfhi(yv[j].y);
        y[8 * j + 4] = bflo(yv[j].z); y[8 * j + 5] = bfhi(yv[j].z); y[8 * j + 6] = bflo(yv[j].w); y[8 * j + 7] = bfhi(yv[j].w);
    }
    float ss = 0.f;
#pragma unroll
    for (int i = 0; i < 16; ++i) ss += y[i] * y[i];
    ss = wave_sum(ss);
    const float r = rsqrtf(ss * (1.0f / 1024.0f) + EPS);
    float xn[16]; float ss2 = 0.f;
#pragma unroll
    for (int j = 0; j < 2; ++j) {
        const f32x4 g0 = *(const f32x4*)(gpost + j * 512 + lane * 8), g1 = *(const f32x4*)(gpost + j * 512 + lane * 8 + 4);
#pragma unroll
        for (int i = 0; i < 4; ++i) {
            xn[8 * j + i] = xv[2 * j][i] + y[8 * j + i] * r * g0[i];
            xn[8 * j + 4 + i] = xv[2 * j + 1][i] + y[8 * j + 4 + i] * r * g1[i];
        }
    }
#pragma unroll
    for (int i = 0; i < 16; ++i) ss2 += xn[i] * xn[i];
#pragma unroll
    for (int j = 0; j < 2; ++j) {
        *(f32x4*)(xdst + j * 512 + lane * 8) = (f32x4){xn[8 * j], xn[8 * j + 1], xn[8 * j + 2], xn[8 * j + 3]};
        *(f32x4*)(xdst + j * 512 + lane * 8 + 4) = (f32x4){xn[8 * j + 4], xn[8 * j + 5], xn[8 * j + 6], xn[8 * j + 7]};
    }
    if (!last) {
        ss2 = wave_sum(ss2);
        const float r2 = rsqrtf(ss2 * (1.0f / 1024.0f) + EPS);
#pragma unroll
        for (int j = 0; j < 2; ++j) {
            const f32x4 g0 = *(const f32x4*)(gpre_next + j * 512 + lane * 8), g1 = *(const f32x4*)(gpre_next + j * 512 + lane * 8 + 4);
            u32x4 o;
            o.x = pk_bf16(xn[8 * j] * r2 * g0[0], xn[8 * j + 1] * r2 * g0[1]);
            o.y = pk_bf16(xn[8 * j + 2] * r2 * g0[2], xn[8 * j + 3] * r2 * g0[3]);
            o.z = pk_bf16(xn[8 * j + 4] * r2 * g1[0], xn[8 * j + 5] * r2 * g1[1]);
            o.w = pk_bf16(xn[8 * j + 6] * r2 * g1[2], xn[8 * j + 7] * r2 * g1[3]);
            *(u32x4*)(yh + j * 512 + lane * 8) = o;
        }
    }
}

#define XB_TMO      128
#define XB_XCNT(j)  (256  + 64 * (j))
#define XB_XSUB(j)  (1280 + 64 * (j))
#define XB_XGEN(j)  (2304 + 64 * (j))
#define XB_TOP      3328
#define XB_TOPGEN   3392
#define XCD_BAR_WORDS 3456
#define XB_SPIN_CAP (1u << 18)
#define LAS __attribute__((address_space(3)))
DI unsigned xb_ld(unsigned* p)              { return __hip_atomic_load(p, __ATOMIC_RELAXED, __HIP_MEMORY_SCOPE_AGENT); }
DI unsigned xb_add(unsigned* p, unsigned v) { return __hip_atomic_fetch_add(p, v, __ATOMIC_RELAXED, __HIP_MEMORY_SCOPE_AGENT); }
DI unsigned xb_xcc_id() { return (unsigned)__builtin_amdgcn_s_getreg((3 << 11) | 20) & 0xFu; }
#define XB_SPIN(cond, bar) do { unsigned _sp = 0; while (cond) { __builtin_amdgcn_s_sleep(1); \
    if ((++_sp & 255u) == 0u) { if (xb_ld(&(bar)[XB_TMO])) break; if (_sp > XB_SPIN_CAP) { atomicAdd(&(bar)[XB_TMO], 1u); break; } } } } while (0)
struct XcdBarrier { unsigned* bar; unsigned x; volatile LAS unsigned* st; };
DI XcdBarrier xcd_barrier_post(unsigned* bar, volatile LAS unsigned* st) {
    XcdBarrier b; b.bar = bar; b.x = xb_xcc_id(); b.st = st;
    if (threadIdx.x == 0) (void)xb_add(&bar[XB_XCNT(b.x)], 1u);
    return b;
}
DI void xcd_barrier_complete(unsigned* bar, unsigned x, unsigned& nloc, unsigned& nx) {
    const unsigned G = gridDim.x * gridDim.y * gridDim.z;
    unsigned sum, cnt, mine, sp = 0u;
    for (;;) {
        sum = 0u; cnt = 0u; mine = 0u;
#pragma unroll
        for (unsigned j = 0; j < 16; ++j) { const unsigned c = xb_ld(&bar[XB_XCNT(j)]); sum += c; cnt += (c > 0u) ? 1u : 0u; mine = (j == x) ? c : mine; }
        if (sum == G) break;
        __builtin_amdgcn_s_sleep(1);
        if ((++sp & 255u) == 0u) { if (xb_ld(&bar[XB_TMO])) break; if (sp > XB_SPIN_CAP) { atomicAdd(&bar[XB_TMO], 1u); break; } }
    }
    nloc = mine > 0u ? mine : 1u; nx = cnt > 0u ? cnt : 1u;
}
DI void xcd_barrier(const XcdBarrier& b) {
    asm volatile("s_waitcnt vmcnt(0)" ::: "memory");
    __syncthreads();
    if (threadIdx.x == 0) {
        unsigned* bar = b.bar;
        __builtin_amdgcn_s_waitcnt(0);
        unsigned nloc = b.st[0], nx = b.st[1];
        if (nloc == 0u) { xcd_barrier_complete(bar, b.x, nloc, nx); b.st[0] = nloc; b.st[1] = nx; }
        const unsigned old = xb_add(&bar[XB_XSUB(b.x)], 1u);
        const unsigned gen = old / nloc;
        if (old + 1u == (gen + 1u) * nloc) {
            __builtin_amdgcn_fence(__ATOMIC_RELEASE, "agent");
            asm volatile("s_waitcnt vmcnt(0)" ::: "memory");
            const unsigned og = xb_add(&bar[XB_TOP], 1u);
            const unsigned tg = og / nx;
            if (og + 1u == (tg + 1u) * nx) xb_add(&bar[XB_TOPGEN], 1u);
            else XB_SPIN(xb_ld(&bar[XB_TOPGEN]) == tg, bar);
            __builtin_amdgcn_fence(__ATOMIC_ACQUIRE, "agent");
            xb_add(&bar[XB_XGEN(b.x)], 1u);
            asm volatile("s_waitcnt vmcnt(0)" ::: "memory");
        } else {
            XB_SPIN(xb_ld(&bar[XB_XGEN(b.x)]) == gen, bar);
            __builtin_amdgcn_fence(__ATOMIC_ACQUIRE, "agent");
            asm volatile("s_waitcnt vmcnt(0)" ::: "memory");
        }
    }
    __syncthreads();
}

__global__ void __launch_bounds__(512, 2) fwd_megakernel(Params p) {
    __shared__ __attribute__((aligned(16))) unsigned char smem[131072];
    __shared__ uint4 xb_words;
    cg::grid_group grid = cg::this_grid();
    const int nb = gridDim.x, bid = blockIdx.x;
    if (threadIdx.x == 0) xb_words = make_uint4(0u, 0u, 0u, 0u);
    __syncthreads();
    XcdBarrier xb = xcd_barrier_post((unsigned*)(p.ws + OFF_BAR), (volatile LAS unsigned*)&xb_words);
    if (p.phase_end > 1000) grid.sync();
    for (int ph = p.phase_begin; ph < p.phase_end; ++ph) {
        unsigned char* ws = p.ws;
        bf16_t* H = (bf16_t*)(ws + OFF_H);
        bf16_t* Z = (bf16_t*)(ws + OFF_Z);
        bf16_t* VT = (bf16_t*)(ws + OFF_VT);
        bf16_t* MIX = (bf16_t*)(ws + OFF_MIX);
        bf16_t* WIN = (bf16_t*)(ws + OFF_WIN);
        bf16_t* WOUT = (bf16_t*)(ws + OFF_WOUT);
        bf16_t* WMEM = (bf16_t*)(ws + OFF_WMEM);
        bf16_t* PW = (bf16_t*)(ws + OFF_PW);
        bf16_t* MH = (bf16_t*)(ws + OFF_MH);
        bf16_t* KM = (bf16_t*)(ws + OFF_KM);
        bf16_t* VMT = (bf16_t*)(ws + OFF_VMT);
        float* ROPE = (float*)(ws + OFF_ROPE);
        if (ph == 0) {
            for (int i = bid; i < 1928; i += nb) {
                if (i < 1152) { const int l = i / 576, j = i % 576, kt = j / 36, ntile = j % 36;
                    transpose_tile(p.w_in + (size_t)l * DM * INW, INW, WIN + (size_t)l * INW * DM, DM, kt * 64, ntile * 64, smem);
                } else if (i < 1664) { const int ii = i - 1152, l = ii / 256, j = ii % 256, kt = j / 16, ntile = j % 16;
                    transpose_tile(p.w_out + (size_t)l * DM * DM, DM, WOUT + (size_t)l * DM * DM, DM, kt * 64, ntile * 64, smem);
                } else if (i < 1920) { const int ii = i - 1664, l = ii / 128, j = ii % 128, kt = j / 8, ntile = j % 8;
                    transpose_tile(p.w_mem_kv + (size_t)l * DM * 512, 512, WMEM + (size_t)l * 512 * DM, DM, kt * 64, ntile * 64, smem);
                } else { const int ii = i - 1920;
                    transpose_tile(p.pool_w + (size_t)ii * 4096, 64, PW + (size_t)ii * 4096, 64, 0, 0, smem);
                }
            }
            {
                const int tid = opaque_tid(), lane = tid & 63, wave = tid >> 6;
                constexpr int NR = NTOK + 2 * NMEMTOK;
                auto desc = [&](int i, const float*& src, const float*& g, bf16_t*& dst) {
                    if (i < NTOK) { src = (i < NPROMPT) ? p.x_prompt + (size_t)i * DM : p.x_sample + (size_t)(i - NPROMPT) * DM; g = p.norm_pre; dst = H + (size_t)i * DM; }
                    else { const int ii = i - NTOK, l = ii / NMEMTOK, mt = ii % NMEMTOK;
                           src = (mt < 4096) ? p.mem_prompt + (size_t)mt * DM : p.mem_sample + (size_t)(mt - 4096) * DM; g = p.mem_norm + l * DM; dst = MH + ((size_t)l * NMEMTOK + mt) * DM; }
                };
                int i = bid * 8 + wave;
                if (i < NR) {
                    const float *s, *g; bf16_t* d; desc(i, s, g, d);
                    RowIn cur = rms_row_load(s, lane);
                    for (; i < NR; i += nb * 8) {
                        const int in = (i + nb * 8 < NR) ? i + nb * 8 : NR - 1;
                        const float *s2, *g2; bf16_t* d2; desc(in, s2, g2, d2);
                        const RowIn nxt = rms_row_load(s2, lane);
                        rms_row_finish(cur, g, d, lane);
                        cur = nxt; g = g2; d = d2;
                    }
                }
            }
            { const int tid = opaque_tid(); for (int i = bid * 512 + tid; i < 1024; i += nb * 512) rope_entry(i, ROPE); }
        } else {
            const int l = (ph - 1) >> 2, sub = (ph - 1) & 3;
            if (sub == 0) {
                EpiArgs e; e.C = Z; e.VT = VT; e.qn = p.q_norm + l * 64; e.kn = p.k_norm + l * 64; e.rope = ROPE;
                const bf16_t* Wl = WIN + (size_t)l * INW * DM;
                EpiArgs e2; e2.C = KM + (size_t)l * NMEMTOK * 256; e2.VT = VMT + (size_t)l * NMEMTOK * 256; e2.qn = nullptr; e2.kn = nullptr; e2.rope = nullptr;
                const bf16_t* Wm = WMEM + (size_t)l * 512 * DM;
                const bf16_t* Am = MH + (size_t)l * NMEMTOK * DM;
                auto tile1 = [&](int i, const bf16_t*& ta, const bf16_t*& tb, int& tm0, int& tn0) {
                    if (i < 1728) {
                        const int j = i >> 3, mg = j / 72, rem = j % 72;
                        tm0 = ((i & 7) * 24 + mg * 8 + (rem & 7)) * 256; tn0 = (rem >> 3) * 256; ta = H; tb = Wl;
                    } else { const int j = i - 1728; tm0 = (j >> 1) * 256; tn0 = (j & 1) * 256; ta = Am; tb = Wm; }
                };
                bool pre = false;
                for (int i = bid; i < 1728 + 40; i += nb) {
                    const bf16_t *ta, *tb, *na = nullptr, *nbp = nullptr; int tm0, tn0, xm = 0, xn = 0;
                    tile1(i, ta, tb, tm0, tn0);
                    if (i + nb < 1728 + 40) tile1(i + nb, na, nbp, xm, xn);
                    const bool nperm = (i + nb < 1728) ? !(xn >= 512 && xn < 1152) : (xn == 0);
                    if (i < 1728) gemm_tile<0>(ta, tb, tm0, tn0, e, smem, pre, na, nbp, xm, xn, nperm);
                    else gemm_tile<2>(ta, tb, tm0, tn0, e2, smem, pre, na, nbp, xm, xn, nperm);
                    pre = (na != nullptr);
                }
            } else if (sub == 1) {
                const int lane = opaque_tid() & 63;
                float gq = fabsf(p.q_norm[l * 64 + lane]), gk = fabsf(p.k_norm[l * 64 + lane]);
                gq = wave_max(gq); gk = wave_max(gk);
                const float mfix = 8.0f * gq * gk * 1.02f * L2E;
                const bool fixm = mfix < 28.0f;
                {
                    auto sdec = [&](int i, const bf16_t*& q, const bf16_t*& k, const bf16_t*& vt, int& T, bf16_t*& o, const bf16_t*& g) {
                        int b, kvh, j; size_t tok0, vtb;
                        if (i < 512) { const int R = i >> 8, ip = i & 255, grp = ip & 7; j = R * 32 + (ip >> 3); b = grp >> 1; kvh = grp & 1; T = 4096;
                            tok0 = (size_t)NPROMPT + (size_t)b * 4096; vtb = (size_t)NPROMPT * 128 + ((size_t)(b * 2 + kvh) * 64) * 4096; }
                        else { const int ii = i - 512, R = ii >> 8, ip = ii & 255, grp = R * 8 + (ip & 7); j = ip >> 3; b = grp >> 1; kvh = grp & 1; T = 2048;
                            tok0 = (size_t)b * 2048; vtb = ((size_t)(b * 2 + kvh) * 64) * 2048; }
                        const int qblk = j >> 2, head = kvh * 4 + (j & 3);
                        const size_t q0 = tok0 + (size_t)qblk * 256;
                        q = Z + q0 * INW + 512 + head * 64; k = Z + tok0 * INW + 1024 + kvh * 64; vt = VT + vtb;
                        o = MIX + q0 * 1024 + 256 + head * 64; g = Z + q0 * INW + 1280 + head * 64;
                    };
                    if (bid < 1536) {
                        AttnPre pre;
                        { const bf16_t *q, *k, *vt, *g; bf16_t* o; int T; sdec(bid, q, k, vt, T, o, g); attn_prefetch(pre, q, k, vt, T, opaque_tid()); }
                        __builtin_amdgcn_s_waitcnt(0x0F70);
                        for (int i = bid; i < 1536; i += nb) {
                            const bf16_t *q, *k, *vt, *g, *nq, *nk, *nvt, *ng; bf16_t *o, *no; int T, nT;
                            sdec(i, q, k, vt, T, o, g);
                            sdec((i + nb < 1536) ? i + nb : i, nq, nk, nvt, nT, no, ng);
                            if (fixm) attn_item<true>(q, INW, k, INW, vt, T, T, o, g, smem, mfix, pre, nq, nk, nvt, nT);
                            else attn_item<false>(q, INW, k, INW, vt, T, T, o, g, smem, 0.f, pre, nq, nk, nvt, nT);
                        }
                    }
                }
                for (int i = bid; i < 768; i += nb) {
                    const int qb = i >> 2, hx = i & 3;
                    const size_t q0 = (size_t)qb * 256;
                    const int b = (q0 < NPROMPT) ? (int)(q0 >> 11) : 16 + (int)((q0 - NPROMPT) >> 12);
                    cross_item(Z + q0 * INW + 1792 + hx * 64, KM + ((size_t)l * NMEMTOK + (size_t)b * 256) * 256 + hx * 64,
                               VMT + (size_t)l * NMEMTOK * 256 + ((size_t)(b * 4 + hx) * 64) * 256,
                               MIX + q0 * 1024 + 768 + hx * 64, Z + q0 * INW + 2048 + hx * 64, smem);
                }
                for (int i = bid; i < 768; i += nb) pool_item(Z, PW + (size_t)l * 4 * 4096, p.pool_scale + l * 256, MIX, i * 64, smem);
            } else if (sub == 2) {
                EpiArgs e; e.C = H; e.VT = nullptr; e.qn = nullptr; e.kn = nullptr; e.rope = nullptr;
                const bf16_t* Wl = WOUT + (size_t)l * DM * DM;
                auto tile2 = [&](int i, int& tm0, int& tn0) {
                    const int j = i >> 3, mg = j >> 5, rem = j & 31;
                    tm0 = ((i & 7) * 24 + mg * 8 + (rem & 7)) * 256; tn0 = (rem >> 3) * 256;
                };
                bool pre = false;
                for (int i = bid; i < 768; i += nb) {
                    int tm0, tn0, xm = 0, xn = 0; tile2(i, tm0, tn0);
                    const bool more = (i + nb < 768);
                    if (more) tile2(i + nb, xm, xn);
                    gemm_tile<1>(MIX, Wl, tm0, tn0, e, smem, pre, more ? MIX : nullptr, Wl, xm, xn, true);
                    pre = more;
                }
            } else {
                const bool last = (l == DEPTH - 1);
                auto xsrc = [&](int i) -> const float* {
                    return (l == 0) ? ((i < NPROMPT) ? p.x_prompt + (size_t)i * DM : p.x_sample + (size_t)(i - NPROMPT) * DM) : p.out + (size_t)i * DM; };
                const int tid = opaque_tid(), lane = tid & 63, wave = tid >> 6;
                int i = bid * 8 + wave;
                if (i < NTOK) {
                    PostIn cur = post_row_load(xsrc(i), H + (size_t)i * DM, lane);
                    for (; i < NTOK; i += nb * 8) {
                        const int in = (i + nb * 8 < NTOK) ? i + nb * 8 : i;
                        const PostIn nxt = post_row_load(xsrc(in), H + (size_t)in * DM, lane);
                        post_row_finish(cur, H + (size_t)i * DM, p.norm_post + l * DM, p.norm_pre + (last ? l : l + 1) * DM, p.out + (size_t)i * DM, last, lane);
                        cur = nxt;
                    }
                }
            }
        }
        if (ph + 1 < p.phase_end) xcd_barrier(xb);
    }
}

extern "C" void kernel_launch(void* const* d_in, const int* in_sizes, int n_in, void* d_out, int out_size, void* d_ws, size_t ws_size,
                              hipStream_t stream) {
    static int grid_blocks = 0;
    if (!grid_blocks) {
        int dev = 0, cus = 0, per_cu = 0;
        hipGetDevice(&dev);
        hipDeviceGetAttribute(&cus, hipDeviceAttributeMultiprocessorCount, dev);
        hipOccupancyMaxActiveBlocksPerMultiprocessor(&per_cu, fwd_megakernel, 512, 0);
        if (per_cu > 1) per_cu = 1;
        if (per_cu < 1) per_cu = 1;
        grid_blocks = cus * per_cu;
    }
    Params p{};
    p.x_prompt = (const float*)d_in[0]; p.x_sample = (const float*)d_in[1]; p.mem_prompt = (const float*)d_in[2]; p.mem_sample = (const float*)d_in[3];
    p.norm_pre = (const float*)d_in[4]; p.norm_post = (const float*)d_in[5]; p.w_in = (const float*)d_in[6]; p.pool_w = (const float*)d_in[7];
    p.pool_scale = (const float*)d_in[8]; p.q_norm = (const float*)d_in[9]; p.k_norm = (const float*)d_in[10]; p.mem_norm = (const float*)d_in[11];
    p.w_mem_kv = (const float*)d_in[12]; p.w_out = (const float*)d_in[13];
    p.out = (float*)d_out; p.ws = (unsigned char*)d_ws;
    p.phase_begin = 0; p.phase_end = 1 + 4 * DEPTH;
    if (ws_size < WS_TOTAL) { fprintf(stderr, "workspace too small: %zu < %zu\n", ws_size, (size_t)WS_TOTAL); return; }
    hipMemsetAsync((unsigned char*)d_ws + OFF_BAR, 0, BAR_BYTES, stream);
    void* args[] = {&p};
    hipError_t e = hipLaunchCooperativeKernel((void*)fwd_megakernel, dim3(grid_blocks), dim3(512), args, 0, stream);
    if (e != hipSuccess) fprintf(stderr, "cooperative launch failed: %s (grid %d)\n", hipGetErrorString(e), grid_blocks);
}
```

```cpp
#include <hip/hip_runtime.h>
#include <hip/hip_cooperative_groups.h>
#include <stdint.h>
#include <cstdio>
namespace cg = cooperative_groups;

typedef unsigned short bf16_t;
typedef short bf16x8 __attribute__((ext_vector_type(8)));
typedef float f32x4 __attribute__((ext_vector_type(4)));
typedef float f32x16 __attribute__((ext_vector_type(16)));
typedef unsigned u32x4 __attribute__((ext_vector_type(4)));
typedef unsigned u32x2 __attribute__((ext_vector_type(2)));
typedef __bf16 bf16x2_t __attribute__((ext_vector_type(2)));
typedef float f32x2_t __attribute__((ext_vector_type(2)));
#define DI __device__ __forceinline__

constexpr int NTOK = 49152;
constexpr int NPROMPT = 32768;
constexpr int DM = 1024;
constexpr int INW = 2304;
constexpr int NMEMTOK = 5120;
constexpr int DEPTH = 2;
constexpr float EPS = 1e-6f;
constexpr float L2E = 1.4426950408889634f;

constexpr size_t OFF_H    = 0;
constexpr size_t OFF_Z    = OFF_H + (size_t)NTOK * DM * 2;
constexpr size_t OFF_VT   = OFF_Z + (size_t)NTOK * INW * 2;
constexpr size_t OFF_MIX  = OFF_VT + (size_t)NTOK * 128 * 2;
constexpr size_t OFF_WIN  = OFF_MIX + (size_t)NTOK * DM * 2;
constexpr size_t OFF_WOUT = OFF_WIN + (size_t)DEPTH * INW * DM * 2;
constexpr size_t OFF_WMEM = OFF_WOUT + (size_t)DEPTH * DM * DM * 2;
constexpr size_t OFF_PW   = OFF_WMEM + (size_t)DEPTH * 512 * DM * 2;
constexpr size_t OFF_MH   = OFF_PW + (size_t)DEPTH * 4 * 64 * 64 * 2;
constexpr size_t OFF_KM   = OFF_MH + (size_t)DEPTH * NMEMTOK * DM * 2;
constexpr size_t OFF_VMT  = OFF_KM + (size_t)DEPTH * NMEMTOK * 256 * 2;
constexpr size_t OFF_ROPE = OFF_VMT + (size_t)DEPTH * NMEMTOK * 256 * 2;
constexpr size_t OFF_BAR  = OFF_ROPE + 64 * 16 * 2 * 4;
constexpr size_t BAR_BYTES = 3456 * 4;
constexpr size_t WS_TOTAL = OFF_BAR + BAR_BYTES;

struct Params {
    const float* x_prompt; const float* x_sample; const float* mem_prompt; const float* mem_sample;
    const float* norm_pre; const float* norm_post; const float* w_in; const float* pool_w; const float* pool_scale;
    const float* q_norm; const float* k_norm; const float* mem_norm; const float* w_mem_kv; const float* w_out;
    float* out; unsigned char* ws;
    int phase_begin; int phase_end;
};

DI unsigned pk_bf16(float a, float b) {
    f32x2_t v = {a, b};
    bf16x2_t r = __builtin_convertvector(v, bf16x2_t);
    return __builtin_bit_cast(unsigned, r);
}
DI int opaque_tid() { int t = threadIdx.x; asm volatile("" : "+v"(t)); return t; }
DI void lds_barrier() { asm volatile("s_waitcnt lgkmcnt(0)\n\ts_barrier" ::: "memory"); }
DI float bflo(unsigned u) { return __uint_as_float(u << 16); }
DI float bfhi(unsigned u) { return __uint_as_float(u & 0xffff0000u); }
template <int CTRL> DI float dppf(float v) { return __uint_as_float(__builtin_amdgcn_update_dpp(0u, __float_as_uint(v), CTRL, 0xf, 0xf, true)); }
DI float x16_add(float v) { auto r = __builtin_amdgcn_permlane16_swap(__float_as_uint(v), __float_as_uint(v), false, false); return __uint_as_float(r[0]) + __uint_as_float(r[1]); }
DI float x32_add(float v) { auto r = __builtin_amdgcn_permlane32_swap(__float_as_uint(v), __float_as_uint(v), false, false); return __uint_as_float(r[0]) + __uint_as_float(r[1]); }
DI float x16_max(float v) { auto r = __builtin_amdgcn_permlane16_swap(__float_as_uint(v), __float_as_uint(v), false, false); return fmaxf(__uint_as_float(r[0]), __uint_as_float(r[1])); }
DI float x32_max(float v) { auto r = __builtin_amdgcn_permlane32_swap(__float_as_uint(v), __float_as_uint(v), false, false); return fmaxf(__uint_as_float(r[0]), __uint_as_float(r[1])); }
DI float wave_sum(float v) {
    v += dppf<0xB1>(v); v += dppf<0x4E>(v); v += dppf<0x141>(v); v += dppf<0x140>(v);
    v = x16_add(v); v = x32_add(v);
    return v;
}
DI float wave_max(float v) {
    v = fmaxf(v, dppf<0xB1>(v)); v = fmaxf(v, dppf<0x4E>(v)); v = fmaxf(v, dppf<0x141>(v)); v = fmaxf(v, dppf<0x140>(v));
    v = x16_max(v); v = x32_max(v);
    return v;
}
DI float xhalf_max(float v) {
    auto r = __builtin_amdgcn_permlane32_swap(__float_as_uint(v), __float_as_uint(v), false, false);
    return fmaxf(__uint_as_float(r[0]), __uint_as_float(r[1]));
}
DI void swap32(unsigned& a, unsigned& b) { auto r = __builtin_amdgcn_permlane32_swap(a, b, false, false); a = r[0]; b = r[1]; }
DI u32x4 o_pair_wide(const f32x16& ov, int gqA, float inv, u32x4 gw) {
    unsigned gax = gw.x, gay = gw.y, gbx = gw.z, gby = gw.w;
    swap32(gax, gbx); swap32(gay, gby);
    const int a = 4 * gqA, b = a + 4;
    unsigned ax = pk_bf16(ov[a] * inv * bflo(gax), ov[a + 1] * inv * bfhi(gax)), ay = pk_bf16(ov[a + 2] * inv * bflo(gay), ov[a + 3] * inv * bfhi(gay));
    unsigned bx = pk_bf16(ov[b] * inv * bflo(gbx), ov[b + 1] * inv * bfhi(gbx)), by = pk_bf16(ov[b + 2] * inv * bflo(gby), ov[b + 3] * inv * bfhi(gby));
    swap32(ax, bx); swap32(ay, by);
    return (u32x4){ax, ay, bx, by};
}
DI float silu_f(float x) { return x * __builtin_amdgcn_rcpf(1.0f + __builtin_amdgcn_exp2f(-x * L2E)); }
DI f32x4 mfma16(bf16x8 a, bf16x8 b, f32x4 c) { return __builtin_amdgcn_mfma_f32_16x16x32_bf16(a, b, c, 0, 0, 0); }
DI f32x16 mfma32(bf16x8 a, bf16x8 b, f32x16 c) { return __builtin_amdgcn_mfma_f32_32x32x16_bf16(a, b, c, 0, 0, 0); }

DI void transpose_tile(const float* __restrict__ src, int ldn, bf16_t* __restrict__ dst, int ldk, int k0, int n0, unsigned char* smem) {
    float* tile = (float*)smem;
    const int tid = opaque_tid();
    __syncthreads();
#pragma unroll
    for (int i = 0; i < 2; ++i) {
        const int id = tid + 512 * i, r = id >> 4, c4 = id & 15;
        const f32x4 v = *(const f32x4*)(src + (size_t)(k0 + r) * ldn + n0 + c4 * 4);
        tile[r * 65 + c4 * 4 + 0] = v[0]; tile[r * 65 + c4 * 4 + 1] = v[1]; tile[r * 65 + c4 * 4 + 2] = v[2]; tile[r * 65 + c4 * 4 + 3] = v[3];
    }
    __syncthreads();
    {
        const int n = tid >> 3, kc = tid & 7;
        float v[8];
#pragma unroll
        for (int j = 0; j < 8; ++j) v[j] = tile[(kc * 8 + j) * 65 + n];
        u32x4 o; o.x = pk_bf16(v[0], v[1]); o.y = pk_bf16(v[2], v[3]); o.z = pk_bf16(v[4], v[5]); o.w = pk_bf16(v[6], v[7]);
        *(u32x4*)(dst + (size_t)(n0 + n) * ldk + k0 + kc * 8) = o;
    }
}

struct RowIn { f32x4 v[4]; };
DI RowIn rms_row_load(const float* __restrict__ src, int lane) {
    RowIn r;
#pragma unroll
    for (int j = 0; j < 2; ++j) { r.v[2 * j] = *(const f32x4*)(src + j * 512 + lane * 8); r.v[2 * j + 1] = *(const f32x4*)(src + j * 512 + lane * 8 + 4); }
    return r;
}
DI void rms_row_finish(const RowIn& in, const float* __restrict__ g, bf16_t* __restrict__ dst, int lane) {
    f32x4 v[4]; float ss = 0.f;
#pragma unroll
    for (int j = 0; j < 4; ++j) { v[j] = in.v[j]; ss += v[j][0] * v[j][0] + v[j][1] * v[j][1] + v[j][2] * v[j][2] + v[j][3] * v[j][3]; }
    ss = wave_sum(ss);
    const float r = rsqrtf(ss * (1.0f / 1024.0f) + EPS);
#pragma unroll
    for (int j = 0; j < 2; ++j) {
        const f32x4 g0 = *(const f32x4*)(g + j * 512 + lane * 8), g1 = *(const f32x4*)(g + j * 512 + lane * 8 + 4);
        const f32x4 a = v[2 * j], b = v[2 * j + 1];
        u32x4 o;
        o.x = pk_bf16(a[0] * r * g0[0], a[1] * r * g0[1]); o.y = pk_bf16(a[2] * r * g0[2], a[3] * r * g0[3]);
        o.z = pk_bf16(b[0] * r * g1[0], b[1] * r * g1[1]); o.w = pk_bf16(b[2] * r * g1[2], b[3] * r * g1[3]);
        *(u32x4*)(dst + j * 512 + lane * 8) = o;
    }
}

DI void rope_entry(int idx, float* table) {
    const int n = idx >> 4, pp = idx & 15;
    double fd = 1.0;
    for (int i = 0; i < pp; ++i) fd *= 0.5623413251903491;
    const float f = (float)fd;
    const float a = (float)n * f;
    double r = (double)a;
    const double k = rint(r * 0.15915494309189535);
    r -= k * 6.283185307179586;
    const double r2 = r * r;
    double sn = r, cs = 1.0, ts = r, tc = 1.0;
    for (int i = 1; i <= 16; ++i) {
        tc = -tc * r2 / (double)((2 * i - 1) * (2 * i));
        ts = -ts * r2 / (double)((2 * i) * (2 * i + 1));
        cs += tc; sn += ts;
    }
    table[idx * 2] = (float)cs; table[idx * 2 + 1] = (float)sn;
}

struct EpiArgs {
    bf16_t* C;
    bf16_t* VT;
    const float* qn; const float* kn; const float* rope;
};

DI int g8_lds_byte(int r, int c) { const int st = (r >> 4) * 2 + (c >> 5), rr = r & 15, cc = c & 31, ob = rr * 64 + cc * 2; return st * 1024 + (ob ^ (((ob >> 9) & 1) << 5)); }
DI void g8_stage_rc(int b, int& R, int& C) { const int st = b >> 10, sb = b & 1023, swz = sb ^ (((sb >> 9) & 1) << 5); R = (st >> 1) * 16 + (swz >> 6); C = (st & 1) * 32 + ((swz & 63) >> 1); }

DI void store_T16x32(const f32x4& v0, const f32x4& v1, unsigned char* wl, bf16_t* __restrict__ dst, size_t ld, int fr, int fq, int lane) {
#pragma unroll
    for (int j = 0; j < 4; ++j) {
        *(bf16_t*)(wl + ((4 * fq + j) * 16 + fr) * 2) = (bf16_t)(pk_bf16(v0[j], 0.f) & 0xffffu);
        *(bf16_t*)(wl + ((16 + 4 * fq + j) * 16 + fr) * 2) = (bf16_t)(pk_bf16(v1[j], 0.f) & 0xffffu);
    }
    __builtin_amdgcn_fence(__ATOMIC_RELEASE, "wavefront"); __builtin_amdgcn_wave_barrier(); __builtin_amdgcn_fence(__ATOMIC_ACQUIRE, "wavefront");
    const int d = lane >> 1, hf = lane & 1;
    const u32x4 val = *(const u32x4*)(wl + d * 32 + hf * 16);
    *(u32x4*)(dst + (size_t)d * ld + hf * 8) = val;
    __builtin_amdgcn_fence(__ATOMIC_RELEASE, "wavefront"); __builtin_amdgcn_wave_barrier(); __builtin_amdgcn_fence(__ATOMIC_ACQUIRE, "wavefront");
}

DI const unsigned char* uniform_ptr(const void* p) {
    const unsigned long long v = (unsigned long long)p;
    const unsigned lo = __builtin_amdgcn_readfirstlane((unsigned)v), hi = __builtin_amdgcn_readfirstlane((unsigned)(v >> 32));
    return (const unsigned char*)(((unsigned long long)hi << 32) | lo);
}

template <int MODE>
DI void gemm_tile(const bf16_t* __restrict__ A, const bf16_t* __restrict__ Bt, int m0, int n0, const EpiArgs& e, unsigned char* smem,
                  bool prefetched, const bf16_t* __restrict__ nA, const bf16_t* __restrict__ nB, int nm0, int nn0, bool nperm) {
    constexpr int K = 1024, BK = 64, HALF = 128, HTB = 16384, nt = K / BK;
    const int tid = opaque_tid(), lane = tid & 63, wave = __builtin_amdgcn_readfirstlane(tid >> 6);
    const int wr = wave >> 2, wc = wave & 3, fr = lane & 15, fq = lane >> 4;
    int sR0, sC0, sR1, sC1;
    g8_stage_rc(tid * 16, sR0, sC0); g8_stage_rc(tid * 16 + 8192, sR1, sC1);
    const unsigned so0b = (unsigned)(sR0 * K + sC0) * 2u, so1b = (unsigned)(sR1 * K + sC1) * 2u;
    const bool perm = (MODE == 1) ? true : ((MODE == 2) ? (n0 == 0) : !(n0 >= 512 && n0 < 1152));
    __attribute__((address_space(3))) unsigned char* lds = (__attribute__((address_space(3))) unsigned char*)smem;
#define G8_SA(b, h) (((b) * 2 + (h)) * HTB)
#define G8_SB(b, h) ((4 + (b) * 2 + (h)) * HTB)
#define G8_PERMOFF(SO) ({ const unsigned R_ = (SO) >> 11, rho_ = R_ & 31u, i_ = rho_ & 15u; const unsigned p_ = 8u * (i_ >> 2) + 4u * (rho_ >> 4) + (i_ & 3u); (SO) + (p_ - rho_) * 2048u; })
#define G8_STAGE_B(POFF, BASE, br, kt, PERM) { const unsigned char* g_ = uniform_ptr((BASE) + (size_t)(br) * K + (kt) * BK); \
        const unsigned b0_ = (PERM) ? G8_PERMOFF(so0b) : so0b, b1_ = (PERM) ? G8_PERMOFF(so1b) : so1b; \
        __builtin_amdgcn_global_load_lds((const __attribute__((address_space(1))) unsigned*)(g_ + b0_), (__attribute__((address_space(3))) unsigned*)(lds + (POFF) + tid * 16), 16, 0, 0); \
        __builtin_amdgcn_global_load_lds((const __attribute__((address_space(1))) unsigned*)(g_ + b1_), (__attribute__((address_space(3))) unsigned*)(lds + (POFF) + tid * 16 + 8192), 16, 0, 0); }
#define G8_STAGE(POFF, BASE, br, kt) { const unsigned char* g_ = uniform_ptr((BASE) + (size_t)(br) * K + (kt) * BK); \
        __builtin_amdgcn_global_load_lds((const __attribute__((address_space(1))) unsigned*)(g_ + so0b), (__attribute__((address_space(3))) unsigned*)(lds + (POFF) + tid * 16), 16, 0, 0); \
        __builtin_amdgcn_global_load_lds((const __attribute__((address_space(1))) unsigned*)(g_ + so1b), (__attribute__((address_space(3))) unsigned*)(lds + (POFF) + tid * 16 + 8192), 16, 0, 0); }
    const int lane_off = (fr * 64 + fq * 16) ^ ((fr >> 3) << 5);
    const unsigned ldsA = (unsigned)(size_t)lds + (unsigned)(lane_off + wr * 8192);
    const unsigned ldsB = (unsigned)(size_t)lds + (unsigned)(lane_off + wc * 4096);
#define G8_DSR(dst, addr, OFF) asm volatile("ds_read_b128 %0, %1 offset:" #OFF : "=v"(dst) : "v"(addr))
#define G8_LDA(dst, b, h) { const unsigned a_ = ldsA + G8_SA(b, h); \
        G8_DSR(dst[0][0], a_, 0); G8_DSR(dst[0][1], a_, 1024); G8_DSR(dst[1][0], a_, 2048); G8_DSR(dst[1][1], a_, 3072); \
        G8_DSR(dst[2][0], a_, 4096); G8_DSR(dst[2][1], a_, 5120); G8_DSR(dst[3][0], a_, 6144); G8_DSR(dst[3][1], a_, 7168); }
#define G8_LDB(dst, b, h) { const unsigned a_ = ldsB + G8_SB(b, h); \
        G8_DSR(dst[0][0], a_, 0); G8_DSR(dst[0][1], a_, 1024); G8_DSR(dst[1][0], a_, 2048); G8_DSR(dst[1][1], a_, 3072); }
#define G8_TIE_A(AT) asm volatile("s_waitcnt lgkmcnt(0)" : "+v"(AT[0][0]), "+v"(AT[0][1]), "+v"(AT[1][0]), "+v"(AT[1][1]), "+v"(AT[2][0]), "+v"(AT[2][1]), "+v"(AT[3][0]), "+v"(AT[3][1]) :: "memory")
#define G8_TIE_B(BX) asm volatile("s_waitcnt lgkmcnt(0)" : "+v"(BX[0][0]), "+v"(BX[0][1]), "+v"(BX[1][0]), "+v"(BX[1][1]) :: "memory")
#define G8_MMA(ai, bj, AT, BX) { __builtin_amdgcn_s_setprio(1); \
        _Pragma("unroll") for (int m = 0; m < 4; ++m) _Pragma("unroll") for (int n = 0; n < 2; ++n) _Pragma("unroll") for (int k = 0; k < 2; ++k) \
            acc[ai][bj][m][n] = mfma16(BX[n][k], AT[m][k], acc[ai][bj][m][n]); \
        __builtin_amdgcn_s_setprio(0); }
#define G8_WV(n) asm volatile("s_waitcnt vmcnt(" #n ")" ::: "memory")
#define G8_WL(n) asm volatile("s_waitcnt lgkmcnt(" #n ")" ::: "memory")
#define G8_BAR __builtin_amdgcn_s_barrier()
#define G8_SCHED __builtin_amdgcn_sched_barrier(0)
    f32x4 acc[2][2][4][2];
#pragma unroll
    for (int a = 0; a < 2; ++a)
#pragma unroll
        for (int b = 0; b < 2; ++b)
#pragma unroll
            for (int m = 0; m < 4; ++m)
#pragma unroll
                for (int n = 0; n < 2; ++n) acc[a][b][m][n] = (f32x4){0.f, 0.f, 0.f, 0.f};
    bf16x8 At[4][2], B0[2][2], B1[2][2];
    if (!prefetched) {
        __syncthreads();
        G8_STAGE_B(G8_SB(0, 0), Bt, n0, 0, perm); G8_STAGE(G8_SA(0, 0), A, m0, 0);
        G8_STAGE_B(G8_SB(0, 1), Bt, n0 + HALF, 0, perm); G8_STAGE(G8_SA(0, 1), A, m0 + HALF, 0);
        if (wr == 1) G8_BAR;
        G8_WV(4); G8_BAR;
        G8_STAGE_B(G8_SB(1, 0), Bt, n0, 1, perm); G8_STAGE(G8_SA(1, 0), A, m0, 1); G8_STAGE_B(G8_SB(1, 1), Bt, n0 + HALF, 1, perm);
        G8_WV(6); G8_BAR;
    } else {
        G8_WV(16);
        if (wr == 1) G8_BAR;
        G8_BAR;
        G8_BAR;
    }
    for (int t = 0; t < nt - 2; t += 2) {
        G8_LDB(B0, 0, 0); G8_SCHED; G8_LDA(At, 0, 0); G8_STAGE(G8_SA(1, 1), A, m0 + HALF, t + 1);
        G8_WL(8); G8_BAR; G8_TIE_B(B0); G8_TIE_A(At); G8_MMA(0, 0, At, B0); G8_BAR; G8_SCHED;
        G8_LDB(B1, 0, 1); G8_STAGE_B(G8_SB(0, 0), Bt, n0, t + 2, perm);
        G8_BAR; G8_TIE_B(B1); G8_MMA(0, 1, At, B1); G8_BAR;
        G8_LDA(At, 0, 1); G8_STAGE(G8_SA(0, 0), A, m0, t + 2);
        G8_BAR; G8_TIE_A(At); G8_MMA(1, 0, At, B0); G8_BAR; G8_SCHED;
        G8_STAGE_B(G8_SB(0, 1), Bt, n0 + HALF, t + 2, perm);
        G8_WV(6); G8_BAR; G8_MMA(1, 1, At, B1); G8_BAR;
        G8_LDB(B0, 1, 0); G8_SCHED; G8_LDA(At, 1, 0); G8_STAGE(G8_SA(0, 1), A, m0 + HALF, t + 2);
        G8_WL(8); G8_BAR; G8_TIE_B(B0); G8_TIE_A(At); G8_MMA(0, 0, At, B0); G8_BAR; G8_SCHED;
        G8_LDB(B1, 1, 1); G8_STAGE_B(G8_SB(1, 0), Bt, n0, t + 3, perm);
        G8_BAR; G8_TIE_B(B1); G8_MMA(0, 1, At, B1); G8_BAR;
        G8_LDA(At, 1, 1); G8_STAGE(G8_SA(1, 0), A, m0, t + 3);
        G8_BAR; G8_TIE_A(At); G8_MMA(1, 0, At, B0); G8_BAR; G8_SCHED;
        G8_STAGE_B(G8_SB(1, 1), Bt, n0 + HALF, t + 3, perm);
        G8_WV(6); G8_BAR; G8_MMA(1, 1, At, B1); G8_BAR;
    }
    {
        G8_LDB(B0, 0, 0); G8_LDA(At, 0, 0); G8_STAGE(G8_SA(1, 1), A, m0 + HALF, nt - 1);
        G8_BAR; G8_TIE_B(B0); G8_TIE_A(At); G8_MMA(0, 0, At, B0); G8_BAR;
        G8_LDB(B1, 0, 1); G8_BAR; G8_TIE_B(B1); G8_MMA(0, 1, At, B1); G8_BAR;
        G8_LDA(At, 0, 1); G8_WV(4); G8_BAR; G8_TIE_A(At); G8_MMA(1, 0, At, B0); G8_MMA(1, 1, At, B1); G8_BAR;
    }
    {
        G8_LDB(B0, 1, 0); G8_LDA(At, 1, 0); G8_WV(2); G8_BAR; G8_TIE_B(B0); G8_TIE_A(At); G8_MMA(0, 0, At, B0); G8_BAR;
        G8_LDB(B1, 1, 1); G8_WV(0); G8_BAR; G8_TIE_B(B1); G8_MMA(0, 1, At, B1); G8_BAR;
        G8_LDA(At, 1, 1); G8_BAR; G8_TIE_A(At); G8_MMA(1, 0, At, B0); G8_MMA(1, 1, At, B1); G8_BAR;
    }
    if (wr == 0) G8_BAR;
    if (nA != nullptr) {
        G8_STAGE_B(G8_SB(0, 0), nB, nn0, 0, nperm); G8_STAGE(G8_SA(0, 0), nA, nm0, 0);
        G8_STAGE_B(G8_SB(0, 1), nB, nn0 + HALF, 0, nperm); G8_STAGE(G8_SA(0, 1), nA, nm0 + HALF, 0);
        G8_STAGE_B(G8_SB(1, 0), nB, nn0, 1, nperm); G8_STAGE(G8_SA(1, 0), nA, nm0, 1); G8_STAGE_B(G8_SB(1, 1), nB, nn0 + HALF, 1, nperm);
    }
    __builtin_amdgcn_sched_barrier(0);
#undef G8_SA
#undef G8_SB
#undef G8_STAGE
#undef G8_STAGE_B
#undef G8_PERMOFF
#undef G8_LDA
#undef G8_LDB
#undef G8_DSR
#undef G8_TIE_A
#undef G8_TIE_B
#undef G8_MMA
#undef G8_WV
#undef G8_WL
#undef G8_BAR
#undef G8_SCHED

    const int tid_e = opaque_tid(), wave_e = __builtin_amdgcn_readfirstlane(tid_e >> 6);
    const int wr_e = wave_e >> 2, wc_e = wave_e & 3, fr_e = tid_e & 15, fq_e = (tid_e >> 4) & 3;
    const int tok_w = m0 + wr_e * 64 + fr_e;
    const int col_w = n0 + wc_e * 32 + 4 * fq_e;
    const int col_p = n0 + wc_e * 32 + 8 * fq_e;
    if (MODE == 1) {
#pragma unroll
        for (int ai = 0; ai < 2; ++ai)
#pragma unroll
            for (int m = 0; m < 4; ++m) {
                bf16_t* rowp = e.C + (size_t)(tok_w + ai * 128 + m * 16) * 1024 + col_p;
#pragma unroll
                for (int bj = 0; bj < 2; ++bj) {
                    const f32x4 v0 = acc[ai][bj][m][0], v1 = acc[ai][bj][m][1];
                    u32x4 o; o.x = pk_bf16(v0[0], v0[1]); o.y = pk_bf16(v0[2], v0[3]); o.z = pk_bf16(v1[0], v1[1]); o.w = pk_bf16(v1[2], v1[3]);
                    *(u32x4*)(rowp + bj * 128) = o;
                }
            }
    } else if (MODE == 2) {
        if (n0 == 0) {
#pragma unroll
            for (int ai = 0; ai < 2; ++ai)
#pragma unroll
                for (int m = 0; m < 4; ++m) {
                    bf16_t* rowp = e.C + (size_t)(tok_w + ai * 128 + m * 16) * 256 + col_p;
#pragma unroll
                    for (int bj = 0; bj < 2; ++bj) {
                        const f32x4 v0 = acc[ai][bj][m][0], v1 = acc[ai][bj][m][1];
                        u32x4 o; o.x = pk_bf16(v0[0], v0[1]); o.y = pk_bf16(v0[2], v0[3]); o.z = pk_bf16(v1[0], v1[1]); o.w = pk_bf16(v1[2], v1[3]);
                        *(u32x4*)(rowp + bj * 128) = o;
                    }
                }
        } else {
#pragma unroll
            for (int ai = 0; ai < 2; ++ai)
#pragma unroll
                for (int m = 0; m < 4; ++m) {
                    const int mt0 = m0 + wr_e * 64 + ai * 128 + m * 16, b = mt0 >> 8, mm0 = mt0 & 255;
#pragma unroll
                    for (int bj = 0; bj < 2; ++bj) {
                        const int f0 = bj * 128 + wc_e * 32, hx = f0 >> 6, d0 = f0 & 63;
                        store_T16x32(acc[ai][bj][m][0], acc[ai][bj][m][1], smem + 3 * 16384 + 8192 + wave_e * 1024,
                                     e.VT + ((size_t)(b * 4 + hx) * 64 + d0) * 256 + mm0, 256, fr_e, fq_e, tid_e & 63);
                    }
                }
        }
    } else {
        const bool has_qk = (n0 >= 512 && n0 < 1152);
        float* ssx = (float*)(smem + 3 * 16384);
        if (has_qk) {
#pragma unroll
            for (int ai = 0; ai < 2; ++ai)
#pragma unroll
                for (int bj = 0; bj < 2; ++bj)
#pragma unroll
                    for (int m = 0; m < 4; ++m) {
                        float ss = 0.f;
#pragma unroll
                        for (int n = 0; n < 2; ++n)
#pragma unroll
                            for (int j = 0; j < 4; ++j) ss += acc[ai][bj][m][n][j] * acc[ai][bj][m][n][j];
                        ss = x16_add(ss); ss = x32_add(ss);
                        if (fq_e == 0) ssx[((wave_e * 2 + ai) * 2 + bj) * 64 + m * 16 + fr_e] = ss;
                    }
            __syncthreads();
        }
#pragma unroll
        for (int bj = 0; bj < 2; ++bj) {
            const int cb = n0 + bj * 128 + wc_e * 32;
            const int c64 = cb & ~63;
            if (c64 >= 512 && c64 < 1152) {
                const bool isq = c64 < 1024;
                const float* gn = (isq ? e.qn : e.kn) + (wc_e & 1) * 32 + 4 * fq_e;
                const float osc = isq ? 0.125f * L2E : 1.0f;
                const f32x4 g0 = *(const f32x4*)(gn), g1 = *(const f32x4*)(gn + 16);
#pragma unroll
                for (int ai = 0; ai < 2; ++ai)
#pragma unroll
                    for (int m = 0; m < 4; ++m) {
                        const int tok = tok_w + ai * 128 + m * 16;
                        const float ss = ssx[((wave_e * 2 + ai) * 2 + bj) * 64 + m * 16 + fr_e] + ssx[(((wave_e ^ 1) * 2 + ai) * 2 + bj) * 64 + m * 16 + fr_e];
                        const float rinv = rsqrtf(ss * (1.0f / 64.0f) + EPS);
                        const int t = (tok < NPROMPT) ? (tok & 2047) : (tok & 4095);
                        const int ridx = (wc_e & 1) ? (t & 63) : (t >> 6);
                        const f32x4* rt = (const f32x4*)(e.rope + (ridx * 16 + 4 * fq_e) * 2);
                        const f32x4 r01 = rt[0], r23 = rt[1];
                        const float rc[4] = {r01[0], r01[2], r23[0], r23[2]}, rs[4] = {r01[1], r01[3], r23[1], r23[3]};
                        float oa[4], ob[4];
#pragma unroll
                        for (int j = 0; j < 4; ++j) {
                            const float a = acc[ai][bj][m][0][j] * rinv * g0[j], b = acc[ai][bj][m][1][j] * rinv * g1[j];
                            oa[j] = (a * rc[j] - b * rs[j]) * osc; ob[j] = (b * rc[j] + a * rs[j]) * osc;
                        }
                        bf16_t* rowp = e.C + (size_t)tok * INW + cb + 4 * fq_e;
                        u32x2 w0, w1; w0.x = pk_bf16(oa[0], oa[1]); w0.y = pk_bf16(oa[2], oa[3]); w1.x = pk_bf16(ob[0], ob[1]); w1.y = pk_bf16(ob[2], ob[3]);
                        *(u32x2*)(rowp) = w0; *(u32x2*)(rowp + 16) = w1;
                    }
            } else if (c64 >= 1152 && c64 < 1280) {
#pragma unroll
                for (int ai = 0; ai < 2; ++ai)
#pragma unroll
                    for (int m = 0; m < 4; ++m) {
                        const int tok0 = m0 + wr_e * 64 + ai * 128 + m * 16;
                        const int f0 = cb - 1152, kvh = f0 >> 6, d0 = f0 & 63;
                        bf16_t* bp; size_t T;
                        if (tok0 < NPROMPT) { const int b = tok0 >> 11, t = tok0 & 2047; T = 2048; bp = e.VT + ((size_t)(b * 2 + kvh) * 64 + d0) * 2048 + t; }
                        else { const int b = (tok0 - NPROMPT) >> 12, t = tok0 & 4095; T = 4096; bp = e.VT + (size_t)NPROMPT * 128 + ((size_t)(b * 2 + kvh) * 64 + d0) * 4096 + t; }
                        store_T16x32(acc[ai][bj][m][0], acc[ai][bj][m][1], smem + 3 * 16384 + 8192 + wave_e * 1024, bp, T, fr_e, fq_e, tid_e & 63);
                    }
            } else {
                const int kind = (c64 < 256) ? 0 : ((c64 >= 1792 && c64 < 2048) ? 2 : 1);
#pragma unroll
                for (int ai = 0; ai < 2; ++ai)
#pragma unroll
                    for (int m = 0; m < 4; ++m) {
                        bf16_t* rowp = e.C + (size_t)(tok_w + ai * 128 + m * 16) * INW + cb + 8 * fq_e;
                        float v[8];
#pragma unroll
                        for (int n = 0; n < 2; ++n)
#pragma unroll
                            for (int j = 0; j < 4; ++j) { const float x = acc[ai][bj][m][n][j]; v[4 * n + j] = (kind == 0) ? x : ((kind == 2) ? x * (0.125f * L2E) : silu_f(x)); }
                        u32x4 o; o.x = pk_bf16(v[0], v[1]); o.y = pk_bf16(v[2], v[3]); o.z = pk_bf16(v[4], v[5]); o.w = pk_bf16(v[6], v[7]);
                        *(u32x4*)(rowp) = o;
                    }
            }
        }
    }
}

#define SB_() __builtin_amdgcn_sched_barrier(0)
#define KFRAG(KS, KB) (*(const bf16x8*)(kp + (KB) * 4096 + k_off + ((((KS) * 2 + h) ^ kswz) << 4)))
#define VFRAG(KK, DB) (*(const bf16x8*)(vp + (DB) * 4096 + v_off + ((((KK) * 2 + h) ^ vswz) << 4)))
#define EXP4(S, I0) { _Pragma("unroll") for (int i_ = (I0); i_ < (I0) + 4; ++i_) { S[i_] = __builtin_amdgcn_exp2f(S[i_] - mb); rs += S[i_]; } }
#define EXP4F(S, I0) { f32x2_t a_ = {S[(I0)], S[(I0) + 1]}, b_ = {S[(I0) + 2], S[(I0) + 3]}; \
        a_ = a_ - (f32x2_t){mb, mb}; b_ = b_ - (f32x2_t){mb, mb}; \
        S[(I0)] = __builtin_amdgcn_exp2f(a_.x); S[(I0) + 1] = __builtin_amdgcn_exp2f(a_.y); S[(I0) + 2] = __builtin_amdgcn_exp2f(b_.x); S[(I0) + 3] = __builtin_amdgcn_exp2f(b_.y); \
        rs2 += (f32x2_t){S[(I0)], S[(I0) + 1]} + (f32x2_t){S[(I0) + 2], S[(I0) + 3]}; }
#define EXPQ(S, I0) { if (FIXM) EXP4F(S, I0) else EXP4(S, I0) }
#define PACK8(S, I0) ({ u32x4 t_; t_.x = pk_bf16(S[(I0)], S[(I0) + 1]); t_.y = pk_bf16(S[(I0) + 2], S[(I0) + 3]); t_.z = pk_bf16(S[(I0) + 4], S[(I0) + 5]); t_.w = pk_bf16(S[(I0) + 6], S[(I0) + 7]); __builtin_bit_cast(bf16x8, t_); })
DI float max8(const f32x16& s, int i0, float mx) {
    mx = fmaxf(fmaxf(mx, s[i0]), s[i0 + 1]); mx = fmaxf(fmaxf(mx, s[i0 + 2]), s[i0 + 3]);
    mx = fmaxf(fmaxf(mx, s[i0 + 4]), s[i0 + 5]); mx = fmaxf(fmaxf(mx, s[i0 + 6]), s[i0 + 7]);
    return mx;
}
#define EXP2F(S, I0) { S[(I0)] = __builtin_amdgcn_exp2f(S[(I0)]); S[(I0) + 1] = __builtin_amdgcn_exp2f(S[(I0) + 1]); rs += S[(I0)] + S[(I0) + 1]; \
        asm volatile("" : "+v"(S[(I0)]), "+v"(S[(I0) + 1]), "+v"(rs)); }
#define PIN1(X) asm volatile("" : "+v"(X))
template <bool DO_PV, bool DO_QK>
DI void attn_step_fix(f32x16& s0, f32x16& s1, f32x16& n0, f32x16& n1, const bf16x8 (&pp)[4], bf16x8 (&pc)[4],
                      f32x16& o0, f32x16& o1, const float m, float& lsum, const bf16x8 (&qf)[4],
                      const unsigned char* kp, const unsigned char* vp, int k_off, int kswz, int v_off, int vswz, int h) {
    bf16x8 va0, vb0, va1, vb1, va2, vb2, va3, vb3, ka0, kb0, ka1, kb1, ka2, kb2, ka3, kb3;
    float rs = 0.f;
    if (DO_PV) { va0 = VFRAG(0, 0); vb0 = VFRAG(0, 1); va1 = VFRAG(1, 0); vb1 = VFRAG(1, 1); }
    EXP2F(s0, 0);  if (DO_PV) { o0 = mfma32(va0, pp[0], o0); va2 = VFRAG(2, 0); vb2 = VFRAG(2, 1); }
    EXP2F(s0, 2);  if (DO_PV) { o1 = mfma32(vb0, pp[0], o1); va3 = VFRAG(3, 0); vb3 = VFRAG(3, 1); }
    EXP2F(s0, 4);  if (DO_PV) { o0 = mfma32(va1, pp[1], o0); } if (DO_QK) { ka0 = KFRAG(0, 0); kb0 = KFRAG(0, 1); }
    EXP2F(s0, 6);  if (DO_PV) { o1 = mfma32(vb1, pp[1], o1); } if (DO_QK) { ka1 = KFRAG(1, 0); kb1 = KFRAG(1, 1); }
    EXP2F(s0, 8);  if (DO_PV) { o0 = mfma32(va2, pp[2], o0); }
    EXP2F(s0, 10); if (DO_PV) { o1 = mfma32(vb2, pp[2], o1); } pc[0] = PACK8(s0, 0); PIN1(pc[0]);
    EXP2F(s0, 12); if (DO_PV) { o0 = mfma32(va3, pp[3], o0); }
    EXP2F(s0, 14); if (DO_PV) { o1 = mfma32(vb3, pp[3], o1); }
    EXP2F(s1, 0);  if (DO_QK) { n0 = mfma32(ka0, qf[0], (f32x16){0.f, 0.f, 0.f, 0.f, 0.f, 0.f, 0.f, 0.f, 0.f, 0.f, 0.f, 0.f, 0.f, 0.f, 0.f, 0.f}); ka2 = KFRAG(2, 0); kb2 = KFRAG(2, 1); } pc[1] = PACK8(s0, 8); PIN1(pc[1]);
    EXP2F(s1, 2);  if (DO_QK) { n1 = mfma32(kb0, qf[0], (f32x16){0.f, 0.f, 0.f, 0.f, 0.f, 0.f, 0.f, 0.f, 0.f, 0.f, 0.f, 0.f, 0.f, 0.f, 0.f, 0.f}); ka3 = KFRAG(3, 0); kb3 = KFRAG(3, 1); }
    EXP2F(s1, 4);  if (DO_QK) { n0 = mfma32(ka1, qf[1], n0); }
    EXP2F(s1, 6);  if (DO_QK) { n1 = mfma32(kb1, qf[1], n1); }
    EXP2F(s1, 8);  if (DO_QK) { n0 = mfma32(ka2, qf[2], n0); } pc[2] = PACK8(s1, 0); PIN1(pc[2]);
    EXP2F(s1, 10); if (DO_QK) { n1 = mfma32(kb2, qf[2], n1); }
    EXP2F(s1, 12); if (DO_QK) { n0 = mfma32(ka3, qf[3], n0); }
    EXP2F(s1, 14); if (DO_QK) { n1 = mfma32(kb3, qf[3], n1); } pc[3] = PACK8(s1, 8); PIN1(pc[3]);
    lsum += rs;

}
template <bool DO_PV, bool DO_QK, bool FIXM>
DI void attn_step(f32x16& s0, f32x16& s1, f32x16& n0, f32x16& n1, const bf16x8 (&pp)[4], bf16x8 (&pc)[4],
                  f32x16& o0, f32x16& o1, float& m, float& lsum, const bf16x8 (&qf)[4],
                  const unsigned char* kp, const unsigned char* vp, int k_off, int kswz, int v_off, int vswz, int h) {
    if (FIXM) { attn_step_fix<DO_PV, DO_QK>(s0, s1, n0, n1, pp, pc, o0, o1, m, lsum, qf, kp, vp, k_off, kswz, v_off, vswz, h); return; }
    bf16x8 va0, vb0, va1, vb1, va2, vb2, va3, vb3, ka0, kb0, ka1, kb1, ka2, kb2, ka3, kb3;
    if (DO_PV) { va0 = VFRAG(0, 0); vb0 = VFRAG(0, 1); va1 = VFRAG(1, 0); vb1 = VFRAG(1, 1); }
    float mx = s0[0];
    if (DO_PV) o0 = mfma32(va0, pp[0], o0);
    if (!FIXM) mx = max8(s0, 0, mx);
    SB_();
    if (DO_PV) { o1 = mfma32(vb0, pp[0], o1); va2 = VFRAG(2, 0); vb2 = VFRAG(2, 1); }
    if (!FIXM) mx = max8(s0, 8, mx);
    SB_();
    if (DO_PV) { o0 = mfma32(va1, pp[1], o0); va3 = VFRAG(3, 0); vb3 = VFRAG(3, 1); }
    if (!FIXM) mx = max8(s1, 0, mx);
    SB_();
    if (DO_PV) o1 = mfma32(vb1, pp[1], o1);
    bool need = false; float alpha = 1.0f;
    if (!FIXM) {
        mx = max8(s1, 8, mx);
        mx = xhalf_max(mx);
        need = mx > m + 8.0f;
        const float mnew = need ? mx : m;
        alpha = __builtin_amdgcn_exp2f(m - mnew);
        m = mnew;
    }
    const float mb = m;
    float rs = 0.f; f32x2_t rs2 = {0.f, 0.f};
    SB_();
    if (DO_PV) o0 = mfma32(va2, pp[2], o0);
    if (DO_QK) { ka0 = KFRAG(0, 0); kb0 = KFRAG(0, 1); }
    EXPQ(s0, 0);
    SB_();
    if (DO_PV) o1 = mfma32(vb2, pp[2], o1);
    if (DO_QK) { ka1 = KFRAG(1, 0); kb1 = KFRAG(1, 1); }
    EXPQ(s0, 4);
    SB_();
    if (DO_PV) o0 = mfma32(va3, pp[3], o0);
    EXPQ(s0, 8);
    SB_();
    if (DO_PV) o1 = mfma32(vb3, pp[3], o1);
    EXPQ(s0, 12);
    SB_();
    if (DO_QK) { n0 = mfma32(ka0, qf[0], (f32x16){0.f, 0.f, 0.f, 0.f, 0.f, 0.f, 0.f, 0.f, 0.f, 0.f, 0.f, 0.f, 0.f, 0.f, 0.f, 0.f}); ka2 = KFRAG(2, 0); kb2 = KFRAG(2, 1); }
    EXPQ(s1, 0);
    SB_();
    if (DO_QK) { n1 = mfma32(kb0, qf[0], (f32x16){0.f, 0.f, 0.f, 0.f, 0.f, 0.f, 0.f, 0.f, 0.f, 0.f, 0.f, 0.f, 0.f, 0.f, 0.f, 0.f}); ka3 = KFRAG(3, 0); kb3 = KFRAG(3, 1); }
    EXPQ(s1, 4);
    SB_();
    if (DO_QK) n0 = mfma32(ka1, qf[1], n0);
    EXPQ(s1, 8);
    SB_();
    if (DO_QK) n1 = mfma32(kb1, qf[1], n1);
    EXPQ(s1, 12);
    SB_();
    if (DO_QK) n0 = mfma32(ka2, qf[2], n0);
    pc[0] = PACK8(s0, 0);
    SB_();
    if (DO_QK) n1 = mfma32(kb2, qf[2], n1);
    pc[1] = PACK8(s0, 8);
    SB_();
    if (DO_QK) n0 = mfma32(ka3, qf[3], n0);
    pc[2] = PACK8(s1, 0);
    SB_();
    if (DO_QK) n1 = mfma32(kb3, qf[3], n1);
    pc[3] = PACK8(s1, 8);
    if (FIXM) lsum += rs2.x + rs2.y; else lsum = lsum * alpha + rs;
    SB_();
    if (!FIXM) {
        if (__builtin_amdgcn_ballot_w64(need)) {
#pragma unroll
            for (int i = 0; i < 16; ++i) { o0[i] *= alpha; o1[i] *= alpha; }
        }
    }
}

struct AttnPre { bf16x8 q[4]; u32x4 k0, k1, s0k, s0v; };
DI void attn_prefetch(AttnPre& pre, const bf16_t* __restrict__ Q, const bf16_t* __restrict__ K, const bf16_t* __restrict__ VT, int ldv, int tid) {
    const int lane = tid & 63, wave = tid >> 6, r = lane & 31, h = lane >> 5, lrow = tid >> 3, lc = tid & 7;
    const bf16_t* qp = Q + (size_t)(wave * 32 + r) * INW + h * 8;
#pragma unroll
    for (int ks = 0; ks < 4; ++ks) pre.q[ks] = *(const bf16x8*)(qp + ks * 16);
    const bf16_t* Kg = K + (size_t)lrow * INW + lc * 8;
    pre.k0 = *(const u32x4*)(Kg); pre.k1 = *(const u32x4*)(Kg + (size_t)64 * INW); pre.s0k = *(const u32x4*)(Kg + (size_t)128 * INW);
    pre.s0v = *(const u32x4*)(VT + (size_t)lrow * ldv + lc * 8);
}

template <bool FIXM>
DI void attn_item(const bf16_t* __restrict__ Q, int ldq, const bf16_t* __restrict__ K, int ldk, const bf16_t* __restrict__ VT, int ldv,
                  int nkeys, bf16_t* __restrict__ O, const bf16_t* __restrict__ G, unsigned char* smem, float mfix,
                  AttnPre& pre, const bf16_t* __restrict__ nQ, const bf16_t* __restrict__ nK, const bf16_t* __restrict__ nVT, int nldv) {
    const int tid = opaque_tid(), lane = tid & 63, wave = tid >> 6;
    const int r = lane & 31, h = lane >> 5;
    bf16x8 qf[4];
#pragma unroll
    for (int ks = 0; ks < 4; ++ks) qf[ks] = pre.q[ks];
    const int lrow = tid >> 3, lc = tid & 7;
    const bf16_t* Kg = K + (size_t)lrow * ldk + lc * 8;
    const bf16_t* Vg = VT + (size_t)lrow * ldv + lc * 8;
    const int st_off = lrow * 128 + ((lc ^ ((lrow >> 1) & 7)) << 4);
    const int pr = (r & ~12) | ((r & 4) << 1) | ((r & 8) >> 1);
    const int kswz = (pr >> 1) & 7, vswz = (r >> 1) & 7;
    const int k_off = pr * 128, v_off = r * 128;
    const int nt = nkeys >> 6;

    f32x16 o0, o1, sa0, sa1, sb0, sb1;
#pragma unroll
    for (int i = 0; i < 16; ++i) { o0[i] = 0.f; o1[i] = 0.f; }
    float m = FIXM ? mfix : -1e30f, lsum = 0.f;
    bf16x8 pa[4], pb[4];

    u32x4 rk, rv;
#define A_LOAD(U) { const int kt_ = ((U) + 2 < nt) ? (U) + 2 : nt - 1; rk = *(const u32x4*)(Kg + (size_t)(kt_ * 64) * ldk); rv = *(const u32x4*)(Vg + (U) * 64); }
#define A_STORE(OFF) { *(u32x4*)(smem + (OFF) + st_off) = rk; *(u32x4*)(smem + (OFF) + 8192 + st_off) = rv; }
    lds_barrier();
    *(u32x4*)(smem + 16384 + st_off) = pre.k0; *(u32x4*)(smem + 16384 + 8192 + st_off) = pre.k1;
    *(u32x4*)(smem + st_off) = pre.s0k; *(u32x4*)(smem + 8192 + st_off) = pre.s0v;
    A_LOAD(1);
    lds_barrier();
    {
        const unsigned char* kp = smem + 16384;
        sa0 = mfma32(KFRAG(0, 0), qf[0], (f32x16){0.f, 0.f, 0.f, 0.f, 0.f, 0.f, 0.f, 0.f, 0.f, 0.f, 0.f, 0.f, 0.f, 0.f, 0.f, 0.f});
        sa1 = mfma32(KFRAG(0, 1), qf[0], (f32x16){0.f, 0.f, 0.f, 0.f, 0.f, 0.f, 0.f, 0.f, 0.f, 0.f, 0.f, 0.f, 0.f, 0.f, 0.f, 0.f});
#pragma unroll
        for (int ks = 1; ks < 4; ++ks) { sa0 = mfma32(KFRAG(ks, 0), qf[ks], sa0); sa1 = mfma32(KFRAG(ks, 1), qf[ks], sa1); }
    }
    attn_step<false, true, FIXM>(sa0, sa1, sb0, sb1, pb, pa, o0, o1, m, lsum, qf, smem + 16384 + 8192, smem, k_off, kswz, v_off, vswz, h);
    lds_barrier();
    for (int t = 1; t < nt - 1; t += 2) {
        A_STORE(16384);
        A_LOAD(t + 1);
        SB_();
        attn_step<true, true, FIXM>(sb0, sb1, sa0, sa1, pa, pb, o0, o1, m, lsum, qf, smem, smem + 8192, k_off, kswz, v_off, vswz, h);
        lds_barrier();
        A_STORE(0);
        A_LOAD(t + 2);
        SB_();
        attn_step<true, true, FIXM>(sa0, sa1, sb0, sb1, pb, pa, o0, o1, m, lsum, qf, smem + 16384, smem + 16384 + 8192, k_off, kswz, v_off, vswz, h);
        lds_barrier();
    }
    A_STORE(16384);
    const bf16_t* gp = G + (size_t)(wave * 32 + r) * INW + 8 * h;
    u32x4 gw[4];
#pragma unroll
    for (int pp = 0; pp < 4; ++pp) gw[pp] = *(const u32x4*)(gp + 16 * pp);
    attn_prefetch(pre, nQ, nK, nVT, nldv, tid);
    SB_();
    attn_step<true, false, FIXM>(sb0, sb1, sa0, sa1, pa, pb, o0, o1, m, lsum, qf, smem, smem + 8192, k_off, kswz, v_off, vswz, h);
    lds_barrier();
    {
        const unsigned char* vp = smem + 16384 + 8192;
#pragma unroll
        for (int kk = 0; kk < 4; ++kk) { o0 = mfma32(VFRAG(kk, 0), pb[kk], o0); o1 = mfma32(VFRAG(kk, 1), pb[kk], o1); }
    }
#undef A_LOAD
#undef A_STORE
    const float lt = x32_add(lsum);
    const float inv = 1.0f / lt;
    bf16_t* op = O + (size_t)(wave * 32 + r) * 1024 + 8 * h;
    *(u32x4*)(op) = o_pair_wide(o0, 0, inv, gw[0]);
    *(u32x4*)(op + 16) = o_pair_wide(o0, 2, inv, gw[1]);
    *(u32x4*)(op + 32) = o_pair_wide(o1, 0, inv, gw[2]);
    *(u32x4*)(op + 48) = o_pair_wide(o1, 2, inv, gw[3]);
}

DI void cross_item(const bf16_t* __restrict__ Q, const bf16_t* __restrict__ K, const bf16_t* __restrict__ VT,
                   bf16_t* __restrict__ O, const bf16_t* __restrict__ G, unsigned char* smem) {
    const int tid = opaque_tid(), lane = tid & 63, wave = tid >> 6;
    const int r = lane & 31, h = lane >> 5;
    bf16x8 qf[4];
    {
        const bf16_t* qp = Q + (size_t)(wave * 32 + r) * INW + h * 8;
#pragma unroll
        for (int ks = 0; ks < 4; ++ks) qf[ks] = *(const bf16x8*)(qp + ks * 16);
    }
    const int lrow = tid >> 3, lc = tid & 7;
    const int st_off = lrow * 128 + ((lc ^ ((lrow >> 1) & 7)) << 4);
    {
        u32x4 kk[4], vv[4];
#pragma unroll
        for (int i = 0; i < 4; ++i) { kk[i] = *(const u32x4*)(K + (size_t)(lrow + 64 * i) * 256 + lc * 8); vv[i] = *(const u32x4*)(VT + (size_t)lrow * 256 + (i * 8 + lc) * 8); }
        __syncthreads();
#pragma unroll
        for (int i = 0; i < 4; ++i) { *(u32x4*)(smem + i * 16384 + st_off) = kk[i]; *(u32x4*)(smem + i * 16384 + 8192 + st_off) = vv[i]; }
    }
    const bf16_t* gp = G + (size_t)(wave * 32 + r) * INW + 8 * h;
    u32x4 gw[4];
#pragma unroll
    for (int pp = 0; pp < 4; ++pp) gw[pp] = *(const u32x4*)(gp + 16 * pp);
    __syncthreads();
    const int pr = (r & ~12) | ((r & 4) << 1) | ((r & 8) >> 1);
    const int kswz = (pr >> 1) & 7, vswz = (r >> 1) & 7;
    const int k_off = pr * 128, v_off = r * 128;
    f32x16 o0, o1;
#pragma unroll
    for (int i = 0; i < 16; ++i) { o0[i] = 0.f; o1[i] = 0.f; }
    float m = -1e30f, lsum = 0.f;
#pragma unroll 1
    for (int kt = 0; kt < 4; ++kt) {
        const unsigned char* kp = smem + kt * 16384;
        const unsigned char* vp = kp + 8192;
        f32x16 s0, s1;
        s0 = mfma32(KFRAG(0, 0), qf[0], (f32x16){0.f, 0.f, 0.f, 0.f, 0.f, 0.f, 0.f, 0.f, 0.f, 0.f, 0.f, 0.f, 0.f, 0.f, 0.f, 0.f});
        s1 = mfma32(KFRAG(0, 1), qf[0], (f32x16){0.f, 0.f, 0.f, 0.f, 0.f, 0.f, 0.f, 0.f, 0.f, 0.f, 0.f, 0.f, 0.f, 0.f, 0.f, 0.f});
#pragma unroll
        for (int ks = 1; ks < 4; ++ks) { s0 = mfma32(KFRAG(ks, 0), qf[ks], s0); s1 = mfma32(KFRAG(ks, 1), qf[ks], s1); }
        float mx = s0[0];
        mx = max8(s0, 0, mx); mx = max8(s0, 8, mx); mx = max8(s1, 0, mx); mx = max8(s1, 8, mx);
        mx = xhalf_max(mx);
        const float mnew = fmaxf(m, mx);
        const float alpha = __builtin_amdgcn_exp2f(m - mnew);
        m = mnew;
        const float mb = mnew;
        float rs = 0.f;
#pragma unroll
        for (int i = 0; i < 16; ++i) { s0[i] = __builtin_amdgcn_exp2f(s0[i] - mb); s1[i] = __builtin_amdgcn_exp2f(s1[i] - mb); rs += s0[i] + s1[i]; }
        lsum = lsum * alpha + rs;
#pragma unroll
        for (int i = 0; i < 16; ++i) { o0[i] *= alpha; o1[i] *= alpha; }
        bf16x8 pf[4];
        pf[0] = PACK8(s0, 0); pf[1] = PACK8(s0, 8); pf[2] = PACK8(s1, 0); pf[3] = PACK8(s1, 8);
#pragma unroll
        for (int kk2 = 0; kk2 < 4; ++kk2) { o0 = mfma32(VFRAG(kk2, 0), pf[kk2], o0); o1 = mfma32(VFRAG(kk2, 1), pf[kk2], o1); }
    }
    const float lt = x32_add(lsum);
    const float inv = 1.0f / lt;
    bf16_t* op = O + (size_t)(wave * 32 + r) * 1024 + 8 * h;
    *(u32x4*)(op) = o_pair_wide(o0, 0, inv, gw[0]);
    *(u32x4*)(op + 16) = o_pair_wide(o0, 2, inv, gw[1]);
    *(u32x4*)(op + 32) = o_pair_wide(o1, 0, inv, gw[2]);
    *(u32x4*)(op + 48) = o_pair_wide(o1, 2, inv, gw[3]);
}

DI void pool_item(const bf16_t* __restrict__ Z, const bf16_t* __restrict__ PWT, const float* __restrict__ pscale, bf16_t* __restrict__ MIX,
                  int tokg0, unsigned char* smem) {
    const int tid = opaque_tid(), lane = tid & 63, wave = tid >> 6;
    const int T = (tokg0 < NPROMPT) ? 2048 : 4096;
    const int t0 = tokg0 & (T - 1);
    constexpr int RS = 528;
    const int g = wave & 3, half = 1 << g;
    const int r16 = lane & 15, q4 = lane >> 4;
    const bf16_t* pw = PWT + (size_t)g * 4096 + r16 * 64 + q4 * 8;
    bf16x8 wfr[4][2]; f32x4 psr[4]; u32x2 ggr[2][4];
#pragma unroll
    for (int fi = 0; fi < 4; ++fi) {
        psr[fi] = *(const f32x4*)(pscale + g * 64 + fi * 16 + 4 * q4);
#pragma unroll
        for (int ks = 0; ks < 2; ++ks) wfr[fi][ks] = *(const bf16x8*)(pw + fi * 16 * 64 + ks * 32);
#pragma unroll
        for (int t2 = 0; t2 < 2; ++t2) ggr[t2][fi] = *(const u32x2*)(Z + ((size_t)tokg0 + ((wave >> 2) * 2 + t2) * 16 + r16) * INW + 256 + g * 64 + fi * 16 + 4 * q4);
    }
    __syncthreads();
    for (int id = tid; id < 80 * 32; id += 512) {
        const int rr = id >> 5, c = id & 31;
        const int t = t0 - 8 + rr;
        u32x4 v = (u32x4){0u, 0u, 0u, 0u};
        if (t >= 0 && t < T) v = *(const u32x4*)(Z + (size_t)(tokg0 - 8 + rr) * INW + c * 8);
        *(u32x4*)(smem + rr * RS + c * 16) = v;
    }
    __syncthreads();
    {
        const int th = wave >> 2;
        bf16x8 df[2][2];
#pragma unroll
        for (int t2 = 0; t2 < 2; ++t2)
#pragma unroll
            for (int ks = 0; ks < 2; ++ks) {
                const int tl = (th * 2 + t2) * 16 + r16, t = t0 + tl;
                const int lo = max(t - half, 0), hi = min(t + half, T);
                const float icnt = 1.0f / (float)(hi - lo);
                float s[8];
#pragma unroll
                for (int j = 0; j < 8; ++j) s[j] = 0.f;
                const unsigned char* bp = smem + (tl + 8 - half) * RS + (g * 64 + ks * 32 + q4 * 8) * 2;
                for (int j = 0; j < 2 * half; ++j) {
                    const u32x4 v = *(const u32x4*)(bp + j * RS);
                    s[0] += bflo(v.x); s[1] += bfhi(v.x); s[2] += bflo(v.y); s[3] += bfhi(v.y);
                    s[4] += bflo(v.z); s[5] += bfhi(v.z); s[6] += bflo(v.w); s[7] += bfhi(v.w);
                }
                const u32x4 c = *(const u32x4*)(bp + half * RS);
                u32x4 o;
                o.x = pk_bf16(s[0] * icnt - bflo(c.x), s[1] * icnt - bfhi(c.x));
                o.y = pk_bf16(s[2] * icnt - bflo(c.y), s[3] * icnt - bfhi(c.y));
                o.z = pk_bf16(s[4] * icnt - bflo(c.z), s[5] * icnt - bfhi(c.z));
                o.w = pk_bf16(s[6] * icnt - bflo(c.w), s[7] * icnt - bfhi(c.w));
                df[t2][ks] = __builtin_bit_cast(bf16x8, o);
            }
        f32x4 acc[4][2];
#pragma unroll
        for (int i = 0; i < 4; ++i)
#pragma unroll
            for (int j = 0; j < 2; ++j) acc[i][j] = (f32x4){0.f, 0.f, 0.f, 0.f};
#pragma unroll
        for (int fi = 0; fi < 4; ++fi)
#pragma unroll
            for (int ks = 0; ks < 2; ++ks) {
                const bf16x8 wf = wfr[fi][ks];
#pragma unroll
                for (int t2 = 0; t2 < 2; ++t2) acc[fi][t2] = mfma16(wf, df[t2][ks], acc[fi][t2]);
            }
#pragma unroll
        for (int t2 = 0; t2 < 2; ++t2) {
            const size_t tok = (size_t)tokg0 + (th * 2 + t2) * 16 + r16;
#pragma unroll
            for (int fi = 0; fi < 4; ++fi) {
                const int n = g * 64 + fi * 16 + 4 * q4;
                const f32x4 ps = psr[fi];
                const u32x2 gg = ggr[t2][fi];
                u32x2 w;
                w.x = pk_bf16(acc[fi][t2][0] * ps[0] * bflo(gg.x), acc[fi][t2][1] * ps[1] * bfhi(gg.x));
                w.y = pk_bf16(acc[fi][t2][2] * ps[2] * bflo(gg.y), acc[fi][t2][3] * ps[3] * bfhi(gg.y));
                *(u32x2*)(MIX + tok * 1024 + n) = w;
            }
        }
    }
}

struct PostIn { u32x4 yv[2]; f32x4 xv[4]; };
DI PostIn post_row_load(const float* __restrict__ xsrc, const bf16_t* __restrict__ yh, int lane) {
    PostIn r;
#pragma unroll
    for (int j = 0; j < 2; ++j) r.yv[j] = *(const u32x4*)(yh + j * 512 + lane * 8);
#pragma unroll
    for (int j = 0; j < 2; ++j) { r.xv[2 * j] = *(const f32x4*)(xsrc + j * 512 + lane * 8); r.xv[2 * j + 1] = *(const f32x4*)(xsrc + j * 512 + lane * 8 + 4); }
    return r;
}
DI void post_row_finish(const PostIn& in, bf16_t* __restrict__ yh, const float* __restrict__ gpost, const float* __restrict__ gpre_next,
                        float* __restrict__ xdst, bool last, int lane) {
    u32x4 yv[2]; f32x4 xv[4];
#pragma unroll
    for (int j = 0; j < 2; ++j) yv[j] = in.yv[j];
#pragma unroll
    for (int j = 0; j < 4; ++j) xv[j] = in.xv[j];
    float y[16];
#pragma unroll
    for (int j = 0; j < 2; ++j) {
        y[8 * j + 0] = bflo(yv[j].x); y[8 * j + 1] = bfhi(yv[j].x); y[8 * j + 2] = bflo(yv[j].y); y[8 * j + 3] = bfhi(yv[j].y);
        y[8 * j + 4] = bflo(yv[j].z); y[8 * j + 5] = bfhi(yv[j].z); y[8 * j + 6] = bflo(yv[j].w); y[8 * j + 7] = bfhi(yv[j].w);
    }
    float ss = 0.f;
#pragma unroll
    for (int i = 0; i < 16; ++i) ss += y[i] * y[i];
    ss = wave_sum(ss);
    const float r = rsqrtf(ss * (1.0f / 1024.0f) + EPS);
    float xn[16]; float ss2 = 0.f;
#pragma unroll
    for (int j = 0; j < 2; ++j) {
        const f32x4 g0 = *(const f32x4*)(gpost + j * 512 + lane * 8), g1 = *(const f32x4*)(gpost + j * 512 + lane * 8 + 4);
#pragma unroll
        for (int i = 0; i < 4; ++i) {
            xn[8 * j + i] = xv[2 * j][i] + y[8 * j + i] * r * g0[i];
            xn[8 * j + 4 + i] = xv[2 * j + 1][i] + y[8 * j + 4 + i] * r * g1[i];
        }
    }
#pragma unroll
    for (int i = 0; i < 16; ++i) ss2 += xn[i] * xn[i];
#pragma unroll
    for (int j = 0; j < 2; ++j) {
        *(f32x4*)(xdst + j * 512 + lane * 8) = (f32x4){xn[8 * j], xn[8 * j + 1], xn[8 * j + 2], xn[8 * j + 3]};
        *(f32x4*)(xdst + j * 512 + lane * 8 + 4) = (f32x4){xn[8 * j + 4], xn[8 * j + 5], xn[8 * j + 6], xn[8 * j + 7]};
    }
    if (!last) {
        ss2 = wave_sum(ss2);
        const float r2 = rsqrtf(ss2 * (1.0f / 1024.0f) + EPS);
#pragma unroll
        for (int j = 0; j < 2; ++j) {
            const f32x4 g0 = *(const f32x4*)(gpre_next + j * 512 + lane * 8), g1 = *(const f32x4*)(gpre_next + j * 512 + lane * 8 + 4);
            u32x4 o;
            o.x = pk_bf16(xn[8 * j] * r2 * g0[0], xn[8 * j + 1] * r2 * g0[1]);
            o.y = pk_bf16(xn[8 * j + 2] * r2 * g0[2], xn[8 * j + 3] * r2 * g0[3]);
            o.z = pk_bf16(xn[8 * j + 4] * r2 * g1[0], xn[8 * j + 5] * r2 * g1[1]);
            o.w = pk_bf16(xn[8 * j + 6] * r2 * g1[2], xn[8 * j + 7] * r2 * g1[3]);
            *(u32x4*)(yh + j * 512 + lane * 8) = o;
        }
    }
}

#define XB_TMO      128
#define XB_XCNT(j)  (256  + 64 * (j))
#define XB_XSUB(j)  (1280 + 64 * (j))
#define XB_XGEN(j)  (2304 + 64 * (j))
#define XB_TOP      3328
#define XB_TOPGEN   3392
#define XCD_BAR_WORDS 3456
#define XB_SPIN_CAP (1u << 18)
#define LAS __attribute__((address_space(3)))
DI unsigned xb_ld(unsigned* p)              { return __hip_atomic_load(p, __ATOMIC_RELAXED, __HIP_MEMORY_SCOPE_AGENT); }
DI unsigned xb_add(unsigned* p, unsigned v) { return __hip_atomic_fetch_add(p, v, __ATOMIC_RELAXED, __HIP_MEMORY_SCOPE_AGENT); }
DI unsigned xb_xcc_id() { return (unsigned)__builtin_amdgcn_s_getreg((3 << 11) | 20) & 0xFu; }
#define XB_SPIN(cond, bar) do { unsigned _sp = 0; while (cond) { __builtin_amdgcn_s_sleep(1); \
    if ((++_sp & 255u) == 0u) { if (xb_ld(&(bar)[XB_TMO])) break; if (_sp > XB_SPIN_CAP) { atomicAdd(&(bar)[XB_TMO], 1u); break; } } } } while (0)
struct XcdBarrier { unsigned* bar; unsigned x; volatile LAS unsigned* st; };
DI XcdBarrier xcd_barrier_post(unsigned* bar, volatile LAS unsigned* st) {
    XcdBarrier b; b.bar = bar; b.x = xb_xcc_id(); b.st = st;
    if (threadIdx.x == 0) (void)xb_add(&bar[XB_XCNT(b.x)], 1u);
    return b;
}
DI void xcd_barrier_complete(unsigned* bar, unsigned x, unsigned& nloc, unsigned& nx) {
    const unsigned G = gridDim.x * gridDim.y * gridDim.z;
    unsigned sum, cnt, mine, sp = 0u;
    for (;;) {
        sum = 0u; cnt = 0u; mine = 0u;
#pragma unroll
        for (unsigned j = 0; j < 16; ++j) { const unsigned c = xb_ld(&bar[XB_XCNT(j)]); sum += c; cnt += (c > 0u) ? 1u : 0u; mine = (j == x) ? c : mine; }
        if (sum == G) break;
        __builtin_amdgcn_s_sleep(1);
        if ((++sp & 255u) == 0u) { if (xb_ld(&bar[XB_TMO])) break; if (sp > XB_SPIN_CAP) { atomicAdd(&bar[XB_TMO], 1u); break; } }
    }
    nloc = mine > 0u ? mine : 1u; nx = cnt > 0u ? cnt : 1u;
}
DI void xcd_barrier(const XcdBarrier& b) {
    asm volatile("s_waitcnt vmcnt(0)" ::: "memory");
    __syncthreads();
    if (threadIdx.x == 0) {
        unsigned* bar = b.bar;
        __builtin_amdgcn_s_waitcnt(0);
        unsigned nloc = b.st[0], nx = b.st[1];
        if (nloc == 0u) { xcd_barrier_complete(bar, b.x, nloc, nx); b.st[0] = nloc; b.st[1] = nx; }
        const unsigned old = xb_add(&bar[XB_XSUB(b.x)], 1u);
        const unsigned gen = old / nloc;
        if (old + 1u == (gen + 1u) * nloc) {
            __builtin_amdgcn_fence(__ATOMIC_RELEASE, "agent");
            asm volatile("s_waitcnt vmcnt(0)" ::: "memory");
            const unsigned og = xb_add(&bar[XB_TOP], 1u);
            const unsigned tg = og / nx;
            if (og + 1u == (tg + 1u) * nx) xb_add(&bar[XB_TOPGEN], 1u);
            else XB_SPIN(xb_ld(&bar[XB_TOPGEN]) == tg, bar);
            __builtin_amdgcn_fence(__ATOMIC_ACQUIRE, "agent");
            xb_add(&bar[XB_XGEN(b.x)], 1u);
            asm volatile("s_waitcnt vmcnt(0)" ::: "memory");
        } else {
            XB_SPIN(xb_ld(&bar[XB_XGEN(b.x)]) == gen, bar);
            __builtin_amdgcn_fence(__ATOMIC_ACQUIRE, "agent");
            asm volatile("s_waitcnt vmcnt(0)" ::: "memory");
        }
    }
    __syncthreads();
}

__global__ void __launch_bounds__(512, 2) fwd_megakernel(Params p) {
    __shared__ __attribute__((aligned(16))) unsigned char smem[131072];
    __shared__ uint4 xb_words;
    cg::grid_group grid = cg::this_grid();
    const int nb = gridDim.x, bid = blockIdx.x;
    if (threadIdx.x == 0) xb_words = make_uint4(0u, 0u, 0u, 0u);
    __syncthreads();
    XcdBarrier xb = xcd_barrier_post((unsigned*)(p.ws + OFF_BAR), (volatile LAS unsigned*)&xb_words);
    if (p.phase_end > 1000) grid.sync();
    for (int ph = p.phase_begin; ph < p.phase_end; ++ph) {
        unsigned char* ws = p.ws;
        bf16_t* H = (bf16_t*)(ws + OFF_H);
        bf16_t* Z = (bf16_t*)(ws + OFF_Z);
        bf16_t* VT = (bf16_t*)(ws + OFF_VT);
        bf16_t* MIX = (bf16_t*)(ws + OFF_MIX);
        bf16_t* WIN = (bf16_t*)(ws + OFF_WIN);
        bf16_t* WOUT = (bf16_t*)(ws + OFF_WOUT);
        bf16_t* WMEM = (bf16_t*)(ws + OFF_WMEM);
        bf16_t* PW = (bf16_t*)(ws + OFF_PW);
        bf16_t* MH = (bf16_t*)(ws + OFF_MH);
        bf16_t* KM = (bf16_t*)(ws + OFF_KM);
        bf16_t* VMT = (bf16_t*)(ws + OFF_VMT);
        float* ROPE = (float*)(ws + OFF_ROPE);
        if (ph == 0) {
            for (int i = bid; i < 1928; i += nb) {
                if (i < 1152) { const int l = i / 576, j = i % 576, kt = j / 36, ntile = j % 36;
                    transpose_tile(p.w_in + (size_t)l * DM * INW, INW, WIN + (size_t)l * INW * DM, DM, kt * 64, ntile * 64, smem);
                } else if (i < 1664) { const int ii = i - 1152, l = ii / 256, j = ii % 256, kt = j / 16, ntile = j % 16;
                    transpose_tile(p.w_out + (size_t)l * DM * DM, DM, WOUT + (size_t)l * DM * DM, DM, kt * 64, ntile * 64, smem);
                } else if (i < 1920) { const int ii = i - 1664, l = ii / 128, j = ii % 128, kt = j / 8, ntile = j % 8;
                    transpose_tile(p.w_mem_kv + (size_t)l * DM * 512, 512, WMEM + (size_t)l * 512 * DM, DM, kt * 64, ntile * 64, smem);
                } else { const int ii = i - 1920;
                    transpose_tile(p.pool_w + (size_t)ii * 4096, 64, PW + (size_t)ii * 4096, 64, 0, 0, smem);
                }
            }
            {
                const int tid = opaque_tid(), lane = tid & 63, wave = tid >> 6;
                constexpr int NR = NTOK + 2 * NMEMTOK;
                auto desc = [&](int i, const float*& src, const float*& g, bf16_t*& dst) {
                    if (i < NTOK) { src = (i < NPROMPT) ? p.x_prompt + (size_t)i * DM : p.x_sample + (size_t)(i - NPROMPT) * DM; g = p.norm_pre; dst = H + (size_t)i * DM; }
                    else { const int ii = i - NTOK, l = ii / NMEMTOK, mt = ii % NMEMTOK;
                           src = (mt < 4096) ? p.mem_prompt + (size_t)mt * DM : p.mem_sample + (size_t)(mt - 4096) * DM; g = p.mem_norm + l * DM; dst = MH + ((size_t)l * NMEMTOK + mt) * DM; }
                };
                int i = bid * 8 + wave;
                if (i < NR) {
                    const float *s, *g; bf16_t* d; desc(i, s, g, d);
                    RowIn cur = rms_row_load(s, lane);
                    for (; i < NR; i += nb * 8) {
                        const int in = (i + nb * 8 < NR) ? i + nb * 8 : NR - 1;
                        const float *s2, *g2; bf16_t* d2; desc(in, s2, g2, d2);
                        const RowIn nxt = rms_row_load(s2, lane);
                        rms_row_finish(cur, g, d, lane);
                        cur = nxt; g = g2; d = d2;
                    }
                }
            }
            { const int tid = opaque_tid(); for (int i = bid * 512 + tid; i < 1024; i += nb * 512) rope_entry(i, ROPE); }
        } else {
            const int l = (ph - 1) >> 2, sub = (ph - 1) & 3;
            if (sub == 0) {
                EpiArgs e; e.C = Z; e.VT = VT; e.qn = p.q_norm + l * 64; e.kn = p.k_norm + l * 64; e.rope = ROPE;
                const bf16_t* Wl = WIN + (size_t)l * INW * DM;
                EpiArgs e2; e2.C = KM + (size_t)l * NMEMTOK * 256; e2.VT = VMT + (size_t)l * NMEMTOK * 256; e2.qn = nullptr; e2.kn = nullptr; e2.rope = nullptr;
                const bf16_t* Wm = WMEM + (size_t)l * 512 * DM;
                const bf16_t* Am = MH + (size_t)l * NMEMTOK * DM;
                auto tile1 = [&](int i, const bf16_t*& ta, const bf16_t*& tb, int& tm0, int& tn0) {
                    if (i < 1728) {
                        const int j = i >> 3, mg = j / 72, rem = j % 72;
                        tm0 = ((i & 7) * 24 + mg * 8 + (rem & 7)) * 256; tn0 = (rem >> 3) * 256; ta = H; tb = Wl;
                    } else { const int j = i - 1728; tm0 = (j >> 1) * 256; tn0 = (j & 1) * 256; ta = Am; tb = Wm; }
                };
                bool pre = false;
                for (int i = bid; i < 1728 + 40; i += nb) {
                    const bf16_t *ta, *tb, *na = nullptr, *nbp = nullptr; int tm0, tn0, xm = 0, xn = 0;
                    tile1(i, ta, tb, tm0, tn0);
                    if (i + nb < 1728 + 40) tile1(i + nb, na, nbp, xm, xn);
                    const bool nperm = (i + nb < 1728) ? !(xn >= 512 && xn < 1152) : (xn == 0);
                    if (i < 1728) gemm_tile<0>(ta, tb, tm0, tn0, e, smem, pre, na, nbp, xm, xn, nperm);
                    else gemm_tile<2>(ta, tb, tm0, tn0, e2, smem, pre, na, nbp, xm, xn, nperm);
                    pre = (na != nullptr);
                }
            } else if (sub == 1) {
                const int lane = opaque_tid() & 63;
                float gq = fabsf(p.q_norm[l * 64 + lane]), gk = fabsf(p.k_norm[l * 64 + lane]);
                gq = wave_max(gq); gk = wave_max(gk);
                const float mfix = 8.0f * gq * gk * 1.02f * L2E;
                const bool fixm = mfix < 28.0f;
                {
                    auto sdec = [&](int i, const bf16_t*& q, const bf16_t*& k, const bf16_t*& vt, int& T, bf16_t*& o, const bf16_t*& g) {
                        int b, kvh, j; size_t tok0, vtb;
                        if (i < 512) { const int R = i >> 8, ip = i & 255, grp = ip & 7; j = R * 32 + (ip >> 3); b = grp >> 1; kvh = grp & 1; T = 4096;
                            tok0 = (size_t)NPROMPT + (size_t)b * 4096; vtb = (size_t)NPROMPT * 128 + ((size_t)(b * 2 + kvh) * 64) * 4096; }
                        else { const int ii = i - 512, R = ii >> 8, ip = ii & 255, grp = R * 8 + (ip & 7); j = ip >> 3; b = grp >> 1; kvh = grp & 1; T = 2048;
                            tok0 = (size_t)b * 2048; vtb = ((size_t)(b * 2 + kvh) * 64) * 2048; }
                        const int qblk = j >> 2, head = kvh * 4 + (j & 3);
                        const size_t q0 = tok0 + (size_t)qblk * 256;
                        q = Z + q0 * INW + 512 + head * 64; k = Z + tok0 * INW + 1024 + kvh * 64; vt = VT + vtb;
                        o = MIX + q0 * 1024 + 256 + head * 64; g = Z + q0 * INW + 1280 + head * 64;
                    };
                    if (bid < 1536) {
                        AttnPre pre;
                        { const bf16_t *q, *k, *vt, *g; bf16_t* o; int T; sdec(bid, q, k, vt, T, o, g); attn_prefetch(pre, q, k, vt, T, opaque_tid()); }
                        __builtin_amdgcn_s_waitcnt(0x0F70);
                        for (int i = bid; i < 1536; i += nb) {
                            const bf16_t *q, *k, *vt, *g, *nq, *nk, *nvt, *ng; bf16_t *o, *no; int T, nT;
                            sdec(i, q, k, vt, T, o, g);
                            sdec((i + nb < 1536) ? i + nb : i, nq, nk, nvt, nT, no, ng);
                            if (fixm) attn_item<true>(q, INW, k, INW, vt, T, T, o, g, smem, mfix, pre, nq, nk, nvt, nT);
                            else attn_item<false>(q, INW, k, INW, vt, T, T, o, g, smem, 0.f, pre, nq, nk, nvt, nT);
                        }
                    }
                }
                for (int i = bid; i < 768; i += nb) {
                    const int qb = i >> 2, hx = i & 3;
                    const size_t q0 = (size_t)qb * 256;
                    const int b = (q0 < NPROMPT) ? (int)(q0 >> 11) : 16 + (int)((q0 - NPROMPT) >> 12);
                    cross_item(Z + q0 * INW + 1792 + hx * 64, KM + ((size_t)l * NMEMTOK + (size_t)b * 256) * 256 + hx * 64,
                               VMT + (size_t)l * NMEMTOK * 256 + ((size_t)(b * 4 + hx) * 64) * 256,
                               MIX + q0 * 1024 + 768 + hx * 64, Z + q0 * INW + 2048 + hx * 64, smem);
                }
                for (int i = bid; i < 768; i += nb) pool_item(Z, PW + (size_t)l * 4 * 4096, p.pool_scale + l * 256, MIX, i * 64, smem);
            } else if (sub == 2) {
                EpiArgs e; e.C = H; e.VT = nullptr; e.qn = nullptr; e.kn = nullptr; e.rope = nullptr;
                const bf16_t* Wl = WOUT + (size_t)l * DM * DM;
                auto tile2 = [&](int i, int& tm0, int& tn0) {
                    const int j = i >> 3, mg = j >> 5, rem = j & 31;
                    tm0 = ((i & 7) * 24 + mg * 8 + (rem & 7)) * 256; tn0 = (rem >> 3) * 256;
                };
                bool pre = false;
                for (int i = bid; i < 768; i += nb) {
                    int tm0, tn0, xm = 0, xn = 0; tile2(i, tm0, tn0);
                    const bool more = (i + nb < 768);
                    if (more) tile2(i + nb, xm, xn);
                    gemm_tile<1>(MIX, Wl, tm0, tn0, e, smem, pre, more ? MIX : nullptr, Wl, xm, xn, true);
                    pre = more;
                }
            } else {
                const bool last = (l == DEPTH - 1);
                auto xsrc = [&](int i) -> const float* {
                    return (l == 0) ? ((i < NPROMPT) ? p.x_prompt + (size_t)i * DM : p.x_sample + (size_t)(i - NPROMPT) * DM) : p.out + (size_t)i * DM; };
                const int tid = opaque_tid(), lane = tid & 63, wave = tid >> 6;
                int i = bid * 8 + wave;
                if (i < NTOK) {
                    PostIn cur = post_row_load(xsrc(i), H + (size_t)i * DM, lane);
                    for (; i < NTOK; i += nb * 8) {
                        const int in = (i + nb * 8 < NTOK) ? i + nb * 8 : i;
                        const PostIn nxt = post_row_load(xsrc(in), H + (size_t)in * DM, lane);
                        post_row_finish(cur, H + (size_t)i * DM, p.norm_post + l * DM, p.norm_pre + (last ? l : l + 1) * DM, p.out + (size_t)i * DM, last, lane);
                        cur = nxt;
                    }
                }
            }
        }
        if (ph + 1 < p.phase_end) xcd_barrier(xb);
    }
}

extern "C" void kernel_launch(void* const* d_in, const int* in_sizes, int n_in, void* d_out, int out_size, void* d_ws, size_t ws_size,
                              hipStream_t stream) {
    static int grid_blocks = 0;
    if (!grid_blocks) {
        int dev = 0, cus = 0, per_cu = 0;
        hipGetDevice(&dev);
        hipDeviceGetAttribute(&cus, hipDeviceAttributeMultiprocessorCount, dev);
        hipOccupancyMaxActiveBlocksPerMultiprocessor(&per_cu, fwd_megakernel, 512, 0);
        if (per_cu > 1) per_cu = 1;
        if (per_cu < 1) per_cu = 1;
        grid_blocks = cus * per_cu;
    }
    Params p{};
    p.x_prompt = (const float*)d_in[0]; p.x_sample = (const float*)d_in[1]; p.mem_prompt = (const float*)d_in[2]; p.mem_sample = (const float*)d_in[3];
    p.norm_pre = (const float*)d_in[4]; p.norm_post = (const float*)d_in[5]; p.w_in = (const float*)d_in[6]; p.pool_w = (const float*)d_in[7];
    p.pool_scale = (const float*)d_in[8]; p.q_norm = (const float*)d_in[9]; p.k_norm = (const float*)d_in[10]; p.mem_norm = (const float*)d_in[11];
    p.w_mem_kv = (const float*)d_in[12]; p.w_out = (const float*)d_in[13];
    p.out = (float*)d_out; p.ws = (unsigned char*)d_ws;
    p.phase_begin = 0; p.phase_end = 1 + 4 * DEPTH;
    if (ws_size < WS_TOTAL) { fprintf(stderr, "workspace too small: %zu < %zu\n", ws_size, (size_t)WS_TOTAL); return; }
    hipMemsetAsync((unsigned char*)d_ws + OFF_BAR, 0, BAR_BYTES, stream);
    void* args[] = {&p};
    hipError_t e = hipLaunchCooperativeKernel((void*)fwd_megakernel, dim3(grid_blocks), dim3(512), args, 0, stream);
    if (e != hipSuccess) fprintf(stderr, "cooperative launch failed: %s (grid %d)\n", hipGetErrorString(e), grid_blocks);
}
```

```cpp
#include <hip/hip_runtime.h>
#include <hip/hip_cooperative_groups.h>
#include <stdint.h>
#include <cstdio>
namespace cg = cooperative_groups;

typedef unsigned short bf16_t;
typedef short bf16x8 __attribute__((ext_vector_type(8)));
typedef float f32x4 __attribute__((ext_vector_type(4)));
typedef float f32x16 __attribute__((ext_vector_type(16)));
typedef unsigned u32x4 __attribute__((ext_vector_type(4)));
typedef unsigned u32x2 __attribute__((ext_vector_type(2)));
typedef __bf16 bf16x2_t __attribute__((ext_vector_type(2)));
typedef float f32x2_t __attribute__((ext_vector_type(2)));
#define DI __device__ __forceinline__

constexpr int NTOK = 49152;
constexpr int NPROMPT = 32768;
constexpr int DM = 1024;
constexpr int INW = 2304;
constexpr int NMEMTOK = 5120;
constexpr int DEPTH = 2;
constexpr float EPS = 1e-6f;
constexpr float L2E = 1.4426950408889634f;

constexpr size_t OFF_H    = 0;
constexpr size_t OFF_Z    = OFF_H + (size_t)NTOK * DM * 2;
constexpr size_t OFF_VT   = OFF_Z + (size_t)NTOK * INW * 2;
constexpr size_t OFF_MIX  = OFF_VT + (size_t)NTOK * 128 * 2;
constexpr size_t OFF_WIN  = OFF_MIX + (size_t)NTOK * DM * 2;
constexpr size_t OFF_WOUT = OFF_WIN + (size_t)DEPTH * INW * DM * 2;
constexpr size_t OFF_WMEM = OFF_WOUT + (size_t)DEPTH * DM * DM * 2;
constexpr size_t OFF_PW   = OFF_WMEM + (size_t)DEPTH * 512 * DM * 2;
constexpr size_t OFF_MH   = OFF_PW + (size_t)DEPTH * 4 * 64 * 64 * 2;
constexpr size_t OFF_KM   = OFF_MH + (size_t)DEPTH * NMEMTOK * DM * 2;
constexpr size_t OFF_VMT  = OFF_KM + (size_t)DEPTH * NMEMTOK * 256 * 2;
constexpr size_t OFF_ROPE = OFF_VMT + (size_t)DEPTH * NMEMTOK * 256 * 2;
constexpr size_t OFF_BAR  = OFF_ROPE + 64 * 16 * 2 * 4;
constexpr size_t BAR_BYTES = 3456 * 4;
constexpr size_t WS_TOTAL = OFF_BAR + BAR_BYTES;

struct Params {
    const float* x_prompt; const float* x_sample; const float* mem_prompt; const float* mem_sample;
    const float* norm_pre; const float* norm_post; const float* w_in; const float* pool_w; const float* pool_scale;
    const float* q_norm; const float* k_norm; const float* mem_norm; const float* w_mem_kv; const float* w_out;
    float* out; unsigned char* ws;
    int phase_begin; int phase_end;
};

DI unsigned pk_bf16(float a, float b) {
    f32x2_t v = {a, b};
    bf16x2_t r = __builtin_convertvector(v, bf16x2_t);
    return __builtin_bit_cast(unsigned, r);
}
DI int opaque_tid() { int t = threadIdx.x; asm volatile("" : "+v"(t)); return t; }
DI void lds_barrier() { asm volatile("s_waitcnt lgkmcnt(0)\n\ts_barrier" ::: "memory"); }
DI float bflo(unsigned u) { return __uint_as_float(u << 16); }
DI float bfhi(unsigned u) { return __uint_as_float(u & 0xffff0000u); }
template <int CTRL> DI float dppf(float v) { return __uint_as_float(__builtin_amdgcn_update_dpp(0u, __float_as_uint(v), CTRL, 0xf, 0xf, true)); }
DI float x16_add(float v) { auto r = __builtin_amdgcn_permlane16_swap(__float_as_uint(v), __float_as_uint(v), false, false); return __uint_as_float(r[0]) + __uint_as_float(r[1]); }
DI float x32_add(float v) { auto r = __builtin_amdgcn_permlane32_swap(__float_as_uint(v), __float_as_uint(v), false, false); return __uint_as_float(r[0]) + __uint_as_float(r[1]); }
DI float x16_max(float v) { auto r = __builtin_amdgcn_permlane16_swap(__float_as_uint(v), __float_as_uint(v), false, false); return fmaxf(__uint_as_float(r[0]), __uint_as_float(r[1])); }
DI float x32_max(float v) { auto r = __builtin_amdgcn_permlane32_swap(__float_as_uint(v), __float_as_uint(v), false, false); return fmaxf(__uint_as_float(r[0]), __uint_as_float(r[1])); }
DI float wave_sum(float v) {
    v += dppf<0xB1>(v); v += dppf<0x4E>(v); v += dppf<0x141>(v); v += dppf<0x140>(v);
    v = x16_add(v); v = x32_add(v);
    return v;
}
DI float wave_max(float v) {
    v = fmaxf(v, dppf<0xB1>(v)); v = fmaxf(v, dppf<0x4E>(v)); v = fmaxf(v, dppf<0x141>(v)); v = fmaxf(v, dppf<0x140>(v));
    v = x16_max(v); v = x32_max(v);
    return v;
}
DI float xhalf_max(float v) {
    auto r = __builtin_amdgcn_permlane32_swap(__float_as_uint(v), __float_as_uint(v), false, false);
    return fmaxf(__uint_as_float(r[0]), __uint_as_float(r[1]));
}
DI void swap32(unsigned& a, unsigned& b) { auto r = __builtin_amdgcn_permlane32_swap(a, b, false, false); a = r[0]; b = r[1]; }
DI u32x4 o_pair_wide(const f32x16& ov, int gqA, float inv, u32x4 gw) {
    unsigned gax = gw.x, gay = gw.y, gbx = gw.z, gby = gw.w;
    swap32(gax, gbx); swap32(gay, gby);
    const int a = 4 * gqA, b = a + 4;
    unsigned ax = pk_bf16(ov[a] * inv * bflo(gax), ov[a + 1] * inv * bfhi(gax)), ay = pk_bf16(ov[a + 2] * inv * bflo(gay), ov[a + 3] * inv * bfhi(gay));
    unsigned bx = pk_bf16(ov[b] * inv * bflo(gbx), ov[b + 1] * inv * bfhi(gbx)), by = pk_bf16(ov[b + 2] * inv * bflo(gby), ov[b + 3] * inv * bfhi(gby));
    swap32(ax, bx); swap32(ay, by);
    return (u32x4){ax, ay, bx, by};
}
DI float silu_f(float x) { return x * __builtin_amdgcn_rcpf(1.0f + __builtin_amdgcn_exp2f(-x * L2E)); }
DI f32x4 mfma16(bf16x8 a, bf16x8 b, f32x4 c) { return __builtin_amdgcn_mfma_f32_16x16x32_bf16(a, b, c, 0, 0, 0); }
DI f32x16 mfma32(bf16x8 a, bf16x8 b, f32x16 c) { return __builtin_amdgcn_mfma_f32_32x32x16_bf16(a, b, c, 0, 0, 0); }

DI void transpose_tile(const float* __restrict__ src, int ldn, bf16_t* __restrict__ dst, int ldk, int k0, int n0, unsigned char* smem) {
    float* tile = (float*)smem;
    const int tid = opaque_tid();
    __syncthreads();
#pragma unroll
    for (int i = 0; i < 2; ++i) {
        const int id = tid + 512 * i, r = id >> 4, c4 = id & 15;
        const f32x4 v = *(const f32x4*)(src + (size_t)(k0 + r) * ldn + n0 + c4 * 4);
        tile[r * 65 + c4 * 4 + 0] = v[0]; tile[r * 65 + c4 * 4 + 1] = v[1]; tile[r * 65 + c4 * 4 + 2] = v[2]; tile[r * 65 + c4 * 4 + 3] = v[3];
    }
    __syncthreads();
    {
        const int n = tid >> 3, kc = tid & 7;
        float v[8];
#pragma unroll
        for (int j = 0; j < 8; ++j) v[j] = tile[(kc * 8 + j) * 65 + n];
        u32x4 o; o.x = pk_bf16(v[0], v[1]); o.y = pk_bf16(v[2], v[3]); o.z = pk_bf16(v[4], v[5]); o.w = pk_bf16(v[6], v[7]);
        *(u32x4*)(dst + (size_t)(n0 + n) * ldk + k0 + kc * 8) = o;
    }
}

struct RowIn { f32x4 v[4]; };
DI RowIn rms_row_load(const float* __restrict__ src, int lane) {
    RowIn r;
#pragma unroll
    for (int j = 0; j < 2; ++j) { r.v[2 * j] = *(const f32x4*)(src + j * 512 + lane * 8); r.v[2 * j + 1] = *(const f32x4*)(src + j * 512 + lane * 8 + 4); }
    return r;
}
DI void rms_row_finish(const RowIn& in, const float* __restrict__ g, bf16_t* __restrict__ dst, int lane) {
    f32x4 v[4]; float ss = 0.f;
#pragma unroll
    for (int j = 0; j < 4; ++j) { v[j] = in.v[j]; ss += v[j][0] * v[j][0] + v[j][1] * v[j][1] + v[j][2] * v[j][2] + v[j][3] * v[j][3]; }
    ss = wave_sum(ss);
    const float r = rsqrtf(ss * (1.0f / 1024.0f) + EPS);
#pragma unroll
    for (int j = 0; j < 2; ++j) {
        const f32x4 g0 = *(const f32x4*)(g + j * 512 + lane * 8), g1 = *(const f32x4*)(g + j * 512 + lane * 8 + 4);
        const f32x4 a = v[2 * j], b = v[2 * j + 1];
        u32x4 o;
        o.x = pk_bf16(a[0] * r * g0[0], a[1] * r * g0[1]); o.y = pk_bf16(a[2] * r * g0[2], a[3] * r * g0[3]);
        o.z = pk_bf16(b[0] * r * g1[0], b[1] * r * g1[1]); o.w = pk_bf16(b[2] * r * g1[2], b[3] * r * g1[3]);
        *(u32x4*)(dst + j * 512 + lane * 8) = o;
    }
}

DI void rope_entry(int idx, float* table) {
    const int n = idx >> 4, pp = idx & 15;
    double fd = 1.0;
    for (int i = 0; i < pp; ++i) fd *= 0.5623413251903491;
    const float f = (float)fd;
    const float a = (float)n * f;
    double r = (double)a;
    const double k = rint(r * 0.15915494309189535);
    r -= k * 6.283185307179586;
    const double r2 = r * r;
    double sn = r, cs = 1.0, ts = r, tc = 1.0;
    for (int i = 1; i <= 16; ++i) {
        tc = -tc * r2 / (double)((2 * i - 1) * (2 * i));
        ts = -ts * r2 / (double)((2 * i) * (2 * i + 1));
        cs += tc; sn += ts;
    }
    table[idx * 2] = (float)cs; table[idx * 2 + 1] = (float)sn;
}

struct EpiArgs {
    bf16_t* C;
    bf16_t* VT;
    const float* qn; const float* kn; const float* rope;
};

DI int g8_lds_byte(int r, int c) { const int st = (r >> 4) * 2 + (c >> 5), rr = r & 15, cc = c & 31, ob = rr * 64 + cc * 2; return st * 1024 + (ob ^ (((ob >> 9) & 1) << 5)); }
DI void g8_stage_rc(int b, int& R, int& C) { const int st = b >> 10, sb = b & 1023, swz = sb ^ (((sb >> 9) & 1) << 5); R = (st >> 1) * 16 + (swz >> 6); C = (st & 1) * 32 + ((swz & 63) >> 1); }

DI void store_T16x32(const f32x4& v0, const f32x4& v1, unsigned char* wl, bf16_t* __restrict__ dst, size_t ld, int fr, int fq, int lane) {
#pragma unroll
    for (int j = 0; j < 4; ++j) {
        *(bf16_t*)(wl + ((4 * fq + j) * 16 + fr) * 2) = (bf16_t)(pk_bf16(v0[j], 0.f) & 0xffffu);
        *(bf16_t*)(wl + ((16 + 4 * fq + j) * 16 + fr) * 2) = (bf16_t)(pk_bf16(v1[j], 0.f) & 0xffffu);
    }
    __builtin_amdgcn_fence(__ATOMIC_RELEASE, "wavefront"); __builtin_amdgcn_wave_barrier(); __builtin_amdgcn_fence(__ATOMIC_ACQUIRE, "wavefront");
    const int d = lane >> 1, hf = lane & 1;
    const u32x4 val = *(const u32x4*)(wl + d * 32 + hf * 16);
    *(u32x4*)(dst + (size_t)d * ld + hf * 8) = val;
    __builtin_amdgcn_fence(__ATOMIC_RELEASE, "wavefront"); __builtin_amdgcn_wave_barrier(); __builtin_amdgcn_fence(__ATOMIC_ACQUIRE, "wavefront");
}

DI const unsigned char* uniform_ptr(const void* p) {
    const unsigned long long v = (unsigned long long)p;
    const unsigned lo = __builtin_amdgcn_readfirstlane((unsigned)v), hi = __builtin_amdgcn_readfirstlane((unsigned)(v >> 32));
    return (const unsigned char*)(((unsigned long long)hi << 32) | lo);
}

template <int MODE>
DI void gemm_tile(const bf16_t* __restrict__ A, const bf16_t* __restrict__ Bt, int m0, int n0, const EpiArgs& e, unsigned char* smem,
                  bool prefetched, const bf16_t* __restrict__ nA, const bf16_t* __restrict__ nB, int nm0, int nn0, bool nperm) {
    constexpr int K = 1024, BK = 64, HALF = 128, HTB = 16384, nt = K / BK;
    const int tid = opaque_tid(), lane = tid & 63, wave = __builtin_amdgcn_readfirstlane(tid >> 6);
    const int wr = wave >> 2, wc = wave & 3, fr = lane & 15, fq = lane >> 4;
    int sR0, sC0, sR1, sC1;
    g8_stage_rc(tid * 16, sR0, sC0); g8_stage_rc(tid * 16 + 8192, sR1, sC1);
    const unsigned so0b = (unsigned)(sR0 * K + sC0) * 2u, so1b = (unsigned)(sR1 * K + sC1) * 2u;
    const bool perm = (MODE == 1) ? true : ((MODE == 2) ? (n0 == 0) : !(n0 >= 512 && n0 < 1152));
    __attribute__((address_space(3))) unsigned char* lds = (__attribute__((address_space(3))) unsigned char*)smem;
#define G8_SA(b, h) (((b) * 2 + (h)) * HTB)
#define G8_SB(b, h) ((4 + (b) * 2 + (h)) * HTB)
#define G8_PERMOFF(SO) ({ const unsigned R_ = (SO) >> 11, rho_ = R_ & 31u, i_ = rho_ & 15u; const unsigned p_ = 8u * (i_ >> 2) + 4u * (rho_ >> 4) + (i_ & 3u); (SO) + (p_ - rho_) * 2048u; })
#define G8_STAGE_B(POFF, BASE, br, kt, PERM) { const unsigned char* g_ = uniform_ptr((BASE) + (size_t)(br) * K + (kt) * BK); \
        const unsigned b0_ = (PERM) ? G8_PERMOFF(so0b) : so0b, b1_ = (PERM) ? G8_PERMOFF(so1b) : so1b; \
        __builtin_amdgcn_global_load_lds((const __attribute__((address_space(1))) unsigned*)(g_ + b0_), (__attribute__((address_space(3))) unsigned*)(lds + (POFF) + tid * 16), 16, 0, 0); \
        __builtin_amdgcn_global_load_lds((const __attribute__((address_space(1))) unsigned*)(g_ + b1_), (__attribute__((address_space(3))) unsigned*)(lds + (POFF) + tid * 16 + 8192), 16, 0, 0); }
#define G8_STAGE(POFF, BASE, br, kt) { const unsigned char* g_ = uniform_ptr((BASE) + (size_t)(br) * K + (kt) * BK); \
        __builtin_amdgcn_global_load_lds((const __attribute__((address_space(1))) unsigned*)(g_ + so0b), (__attribute__((address_space(3))) unsigned*)(lds + (POFF) + tid * 16), 16, 0, 0); \
        __builtin_amdgcn_global_load_lds((const __attribute__((address_space(1))) unsigned*)(g_ + so1b), (__attribute__((address_space(3))) unsigned*)(lds + (POFF) + tid * 16 + 8192), 16, 0, 0); }
    const int lane_off = (fr * 64 + fq * 16) ^ ((fr >> 3) << 5);
    const unsigned ldsA = (unsigned)(size_t)lds + (unsigned)(lane_off + wr * 8192);
    const unsigned ldsB = (unsigned)(size_t)lds + (unsigned)(lane_off + wc * 4096);
#define G8_DSR(dst, addr, OFF) asm volatile("ds_read_b128 %0, %1 offset:" #OFF : "=v"(dst) : "v"(addr))
#define G8_LDA(dst, b, h) { const unsigned a_ = ldsA + G8_SA(b, h); \
        G8_DSR(dst[0][0], a_, 0); G8_DSR(dst[0][1], a_, 1024); G8_DSR(dst[1][0], a_, 2048); G8_DSR(dst[1][1], a_, 3072); \
        G8_DSR(dst[2][0], a_, 4096); G8_DSR(dst[2][1], a_, 5120); G8_DSR(dst[3][0], a_, 6144); G8_DSR(dst[3][1], a_, 7168); }
#define G8_LDB(dst, b, h) { const unsigned a_ = ldsB + G8_SB(b, h); \
        G8_DSR(dst[0][0], a_, 0); G8_DSR(dst[0][1], a_, 1024); G8_DSR(dst[1][0], a_, 2048); G8_DSR(dst[1][1], a_, 3072); }
#define G8_TIE_A(AT) asm volatile("s_waitcnt lgkmcnt(0)" : "+v"(AT[0][0]), "+v"(AT[0][1]), "+v"(AT[1][0]), "+v"(AT[1][1]), "+v"(AT[2][0]), "+v"(AT[2][1]), "+v"(AT[3][0]), "+v"(AT[3][1]) :: "memory")
#define G8_TIE_B(BX) asm volatile("s_waitcnt lgkmcnt(0)" : "+v"(BX[0][0]), "+v"(BX[0][1]), "+v"(BX[1][0]), "+v"(BX[1][1]) :: "memory")
#define G8_MMA(ai, bj, AT, BX) { __builtin_amdgcn_s_setprio(1); \
        _Pragma("unroll") for (int m = 0; m < 4; ++m) _Pragma("unroll") for (int n = 0; n < 2; ++n) _Pragma("unroll") for (int k = 0; k < 2; ++k) \
            acc[ai][bj][m][n] = mfma16(BX[n][k], AT[m][k], acc[ai][bj][m][n]); \
        __builtin_amdgcn_s_setprio(0); }
#define G8_WV(n) asm volatile("s_waitcnt vmcnt(" #n ")" ::: "memory")
#define G8_WL(n) asm volatile("s_waitcnt lgkmcnt(" #n ")" ::: "memory")
#define G8_BAR __builtin_amdgcn_s_barrier()
#define G8_SCHED __builtin_amdgcn_sched_barrier(0)
    f32x4 acc[2][2][4][2];
#pragma unroll
    for (int a = 0; a < 2; ++a)
#pragma unroll
        for (int b = 0; b < 2; ++b)
#pragma unroll
            for (int m = 0; m < 4; ++m)
#pragma unroll
                for (int n = 0; n < 2; ++n) acc[a][b][m][n] = (f32x4){0.f, 0.f, 0.f, 0.f};
    bf16x8 At[4][2], B0[2][2], B1[2][2];
    if (!prefetched) {
        __syncthreads();
        G8_STAGE_B(G8_SB(0, 0), Bt, n0, 0, perm); G8_STAGE(G8_SA(0, 0), A, m0, 0);
        G8_STAGE_B(G8_SB(0, 1), Bt, n0 + HALF, 0, perm); G8_STAGE(G8_SA(0, 1), A, m0 + HALF, 0);
        if (wr == 1) G8_BAR;
        G8_WV(4); G8_BAR;
        G8_STAGE_B(G8_SB(1, 0), Bt, n0, 1, perm); G8_STAGE(G8_SA(1, 0), A, m0, 1); G8_STAGE_B(G8_SB(1, 1), Bt, n0 + HALF, 1, perm);
        G8_WV(6); G8_BAR;
    } else {
        G8_WV(16);
        if (wr == 1) G8_BAR;
        G8_BAR;
        G8_BAR;
    }
    for (int t = 0; t < nt - 2; t += 2) {
        G8_LDB(B0, 0, 0); G8_SCHED; G8_LDA(At, 0, 0); G8_STAGE(G8_SA(1, 1), A, m0 + HALF, t + 1);
        G8_WL(8); G8_BAR; G8_TIE_B(B0); G8_TIE_A(At); G8_MMA(0, 0, At, B0); G8_BAR; G8_SCHED;
        G8_LDB(B1, 0, 1); G8_STAGE_B(G8_SB(0, 0), Bt, n0, t + 2, perm);
        G8_BAR; G8_TIE_B(B1); G8_MMA(0, 1, At, B1); G8_BAR;
        G8_LDA(At, 0, 1); G8_STAGE(G8_SA(0, 0), A, m0, t + 2);
        G8_BAR; G8_TIE_A(At); G8_MMA(1, 0, At, B0); G8_BAR; G8_SCHED;
        G8_STAGE_B(G8_SB(0, 1), Bt, n0 + HALF, t + 2, perm);
        G8_WV(6); G8_BAR; G8_MMA(1, 1, At, B1); G8_BAR;
        G8_LDB(B0, 1, 0); G8_SCHED; G8_LDA(At, 1, 0); G8_STAGE(G8_SA(0, 1), A, m0 + HALF, t + 2);
        G8_WL(8); G8_BAR; G8_TIE_B(B0); G8_TIE_A(At); G8_MMA(0, 0, At, B0); G8_BAR; G8_SCHED;
        G8_LDB(B1, 1, 1); G8_STAGE_B(G8_SB(1, 0), Bt, n0, t + 3, perm);
        G8_BAR; G8_TIE_B(B1); G8_MMA(0, 1, At, B1); G8_BAR;
        G8_LDA(At, 1, 1); G8_STAGE(G8_SA(1, 0), A, m0, t + 3);
        G8_BAR; G8_TIE_A(At); G8_MMA(1, 0, At, B0); G8_BAR; G8_SCHED;
        G8_STAGE_B(G8_SB(1, 1), Bt, n0 + HALF, t + 3, perm);
        G8_WV(6); G8_BAR; G8_MMA(1, 1, At, B1); G8_BAR;
    }
    {
        G8_LDB(B0, 0, 0); G8_LDA(At, 0, 0); G8_STAGE(G8_SA(1, 1), A, m0 + HALF, nt - 1);
        G8_BAR; G8_TIE_B(B0); G8_TIE_A(At); G8_MMA(0, 0, At, B0); G8_BAR;
        G8_LDB(B1, 0, 1); G8_BAR; G8_TIE_B(B1); G8_MMA(0, 1, At, B1); G8_BAR;
        G8_LDA(At, 0, 1); G8_WV(4); G8_BAR; G8_TIE_A(At); G8_MMA(1, 0, At, B0); G8_MMA(1, 1, At, B1); G8_BAR;
    }
    {
        G8_LDB(B0, 1, 0); G8_LDA(At, 1, 0); G8_WV(2); G8_BAR; G8_TIE_B(B0); G8_TIE_A(At); G8_MMA(0, 0, At, B0); G8_BAR;
        G8_LDB(B1, 1, 1); G8_WV(0); G8_BAR; G8_TIE_B(B1); G8_MMA(0, 1, At, B1); G8_BAR;
        G8_LDA(At, 1, 1); G8_BAR; G8_TIE_A(At); G8_MMA(1, 0, At, B0); G8_MMA(1, 1, At, B1); G8_BAR;
    }
    if (wr == 0) G8_BAR;
    if (nA != nullptr) {
        G8_STAGE_B(G8_SB(0, 0), nB, nn0, 0, nperm); G8_STAGE(G8_SA(0, 0), nA, nm0, 0);
        G8_STAGE_B(G8_SB(0, 1), nB, nn0 + HALF, 0, nperm); G8_STAGE(G8_SA(0, 1), nA, nm0 + HALF, 0);
        G8_STAGE_B(G8_SB(1, 0), nB, nn0, 1, nperm); G8_STAGE(G8_SA(1, 0), nA, nm0, 1); G8_STAGE_B(G8_SB(1, 1), nB, nn0 + HALF, 1, nperm);
    }
    __builtin_amdgcn_sched_barrier(0);
#undef G8_SA
#undef G8_SB
#undef G8_STAGE
#undef G8_STAGE_B
#undef G8_PERMOFF
#undef G8_LDA
#undef G8_LDB
#undef G8_DSR
#undef G8_TIE_A
#undef G8_TIE_B
#undef G8_MMA
#undef G8_WV
#undef G8_WL
#undef G8_BAR
#undef G8_SCHED

    const int tid_e = opaque_tid(), wave_e = __builtin_amdgcn_readfirstlane(tid_e >> 6);
    const int wr_e = wave_e >> 2, wc_e = wave_e & 3, fr_e = tid_e & 15, fq_e = (tid_e >> 4) & 3;
    const int tok_w = m0 + wr_e * 64 + fr_e;
    const int col_w = n0 + wc_e * 32 + 4 * fq_e;
    const int col_p = n0 + wc_e * 32 + 8 * fq_e;
    if (MODE == 1) {
#pragma unroll
        for (int ai = 0; ai < 2; ++ai)
#pragma unroll
            for (int m = 0; m < 4; ++m) {
                bf16_t* rowp = e.C + (size_t)(tok_w + ai * 128 + m * 16) * 1024 + col_p;
#pragma unroll
                for (int bj = 0; bj < 2; ++bj) {
                    const f32x4 v0 = acc[ai][bj][m][0], v1 = acc[ai][bj][m][1];
                    u32x4 o; o.x = pk_bf16(v0[0], v0[1]); o.y = pk_bf16(v0[2], v0[3]); o.z = pk_bf16(v1[0], v1[1]); o.w = pk_bf16(v1[2], v1[3]);
                    *(u32x4*)(rowp + bj * 128) = o;
                }
            }
    } else if (MODE == 2) {
        if (n0 == 0) {
#pragma unroll
            for (int ai = 0; ai < 2; ++ai)
#pragma unroll
                for (int m = 0; m < 4; ++m) {
                    bf16_t* rowp = e.C + (size_t)(tok_w + ai * 128 + m * 16) * 256 + col_p;
#pragma unroll
                    for (int bj = 0; bj < 2; ++bj) {
                        const f32x4 v0 = acc[ai][bj][m][0], v1 = acc[ai][bj][m][1];
                        u32x4 o; o.x = pk_bf16(v0[0], v0[1]); o.y = pk_bf16(v0[2], v0[3]); o.z = pk_bf16(v1[0], v1[1]); o.w = pk_bf16(v1[2], v1[3]);
                        *(u32x4*)(rowp + bj * 128) = o;
                    }
                }
        } else {
#pragma unroll
            for (int ai = 0; ai < 2; ++ai)
#pragma unroll
                for (int m = 0; m < 4; ++m) {
                    const int mt0 = m0 + wr_e * 64 + ai * 128 + m * 16, b = mt0 >> 8, mm0 = mt0 & 255;
#pragma unroll
                    for (int bj = 0; bj < 2; ++bj) {
                        const int f0 = bj * 128 + wc_e * 32, hx = f0 >> 6, d0 = f0 & 63;
                        store_T16x32(acc[ai][bj][m][0], acc[ai][bj][m][1], smem + 3 * 16384 + 8192 + wave_e * 1024,
                                     e.VT + ((size_t)(b * 4 + hx) * 64 + d0) * 256 + mm0, 256, fr_e, fq_e, tid_e & 63);
                    }
                }
        }
    } else {
        const bool has_qk = (n0 >= 512 && n0 < 1152);
        float* ssx = (float*)(smem + 3 * 16384);
        if (has_qk) {
#pragma unroll
            for (int ai = 0; ai < 2; ++ai)
#pragma unroll
                for (int bj = 0; bj < 2; ++bj)
#pragma unroll
                    for (int m = 0; m < 4; ++m) {
                        float ss = 0.f;
#pragma unroll
                        for (int n = 0; n < 2; ++n)
#pragma unroll
                            for (int j = 0; j < 4; ++j) ss += acc[ai][bj][m][n][j] * acc[ai][bj][m][n][j];
                        ss = x16_add(ss); ss = x32_add(ss);
                        if (fq_e == 0) ssx[((wave_e * 2 + ai) * 2 + bj) * 64 + m * 16 + fr_e] = ss;
                    }
            __syncthreads();
        }
#pragma unroll
        for (int bj = 0; bj < 2; ++bj) {
            const int cb = n0 + bj * 128 + wc_e * 32;
            const int c64 = cb & ~63;
            if (c64 >= 512 && c64 < 1152) {
                const bool isq = c64 < 1024;
                const float* gn = (isq ? e.qn : e.kn) + (wc_e & 1) * 32 + 4 * fq_e;
                const float osc = isq ? 0.125f * L2E : 1.0f;
                const f32x4 g0 = *(const f32x4*)(gn), g1 = *(const f32x4*)(gn + 16);
#pragma unroll
                for (int ai = 0; ai < 2; ++ai)
#pragma unroll
                    for (int m = 0; m < 4; ++m) {
                        const int tok = tok_w + ai * 128 + m * 16;
                        const float ss = ssx[((wave_e * 2 + ai) * 2 + bj) * 64 + m * 16 + fr_e] + ssx[(((wave_e ^ 1) * 2 + ai) * 2 + bj) * 64 + m * 16 + fr_e];
                        const float rinv = rsqrtf(ss * (1.0f / 64.0f) + EPS);
                        const int t = (tok < NPROMPT) ? (tok & 2047) : (tok & 4095);
                        const int ridx = (wc_e & 1) ? (t & 63) : (t >> 6);
                        const f32x4* rt = (const f32x4*)(e.rope + (ridx * 16 + 4 * fq_e) * 2);
                        const f32x4 r01 = rt[0], r23 = rt[1];
                        const float rc[4] = {r01[0], r01[2], r23[0], r23[2]}, rs[4] = {r01[1], r01[3], r23[1], r23[3]};
                        float oa[4], ob[4];
#pragma unroll
                        for (int j = 0; j < 4; ++j) {
                            const float a = acc[ai][bj][m][0][j] * rinv * g0[j], b = acc[ai][bj][m][1][j] * rinv * g1[j];
                            oa[j] = (a * rc[j] - b * rs[j]) * osc; ob[j] = (b * rc[j] + a * rs[j]) * osc;
                        }
                        unsigned ax = pk_bf16(oa[0], oa[1]), ay = pk_bf16(oa[2], oa[3]), bx = pk_bf16(ob[0], ob[1]), by = pk_bf16(ob[2], ob[3]);
                        { auto r_ = __builtin_amdgcn_permlane16_swap(ax, bx, false, false); ax = r_[0]; bx = r_[1]; }
                        { auto r_ = __builtin_amdgcn_permlane16_swap(ay, by, false, false); ay = r_[0]; by = r_[1]; }
                        bf16_t* rowp = e.C + (size_t)tok * INW + cb + 4 * fq_e + ((fq_e & 1) ? 12 : 0);
                        *(u32x4*)(rowp) = (u32x4){ax, ay, bx, by};
                    }
            } else if (c64 >= 1152 && c64 < 1280) {
#pragma unroll
                for (int ai = 0; ai < 2; ++ai)
#pragma unroll
                    for (int m = 0; m < 4; ++m) {
                        const int tok0 = m0 + wr_e * 64 + ai * 128 + m * 16;
                        const int f0 = cb - 1152, kvh = f0 >> 6, d0 = f0 & 63;
                        bf16_t* bp; size_t T;
                        if (tok0 < NPROMPT) { const int b = tok0 >> 11, t = tok0 & 2047; T = 2048; bp = e.VT + ((size_t)(b * 2 + kvh) * 64 + d0) * 2048 + t; }
                        else { const int b = (tok0 - NPROMPT) >> 12, t = tok0 & 4095; T = 4096; bp = e.VT + (size_t)NPROMPT * 128 + ((size_t)(b * 2 + kvh) * 64 + d0) * 4096 + t; }
                        store_T16x32(acc[ai][bj][m][0], acc[ai][bj][m][1], smem + 3 * 16384 + 8192 + wave_e * 1024, bp, T, fr_e, fq_e, tid_e & 63);
                    }
            } else {
                const int kind = (c64 < 256) ? 0 : ((c64 >= 1792 && c64 < 2048) ? 2 : 1);
#pragma unroll
                for (int ai = 0; ai < 2; ++ai)
#pragma unroll
                    for (int m = 0; m < 4; ++m) {
                        bf16_t* rowp = e.C + (size_t)(tok_w + ai * 128 + m * 16) * INW + cb + 8 * fq_e;
                        float v[8];
#pragma unroll
                        for (int n = 0; n < 2; ++n)
#pragma unroll
                            for (int j = 0; j < 4; ++j) { const float x = acc[ai][bj][m][n][j]; v[4 * n + j] = (kind == 0) ? x : ((kind == 2) ? x * (0.125f * L2E) : silu_f(x)); }
                        u32x4 o; o.x = pk_bf16(v[0], v[1]); o.y = pk_bf16(v[2], v[3]); o.z = pk_bf16(v[4], v[5]); o.w = pk_bf16(v[6], v[7]);
                        *(u32x4*)(rowp) = o;
                    }
            }
        }
    }
}

#define SB_() __builtin_amdgcn_sched_barrier(0)
#define KFRAG(KS, KB) (*(const bf16x8*)(kp + (KB) * 4096 + k_off + ((((KS) * 2 + h) ^ kswz) << 4)))
#define VFRAG(KK, DB) (*(const bf16x8*)(vp + (DB) * 4096 + v_off + ((((KK) * 2 + h) ^ vswz) << 4)))
#define EXP4(S, I0) { _Pragma("unroll") for (int i_ = (I0); i_ < (I0) + 4; ++i_) { S[i_] = __builtin_amdgcn_exp2f(S[i_] - mb); rs += S[i_]; } }
#define EXP4F(S, I0) { f32x2_t a_ = {S[(I0)], S[(I0) + 1]}, b_ = {S[(I0) + 2], S[(I0) + 3]}; \
        a_ = a_ - (f32x2_t){mb, mb}; b_ = b_ - (f32x2_t){mb, mb}; \
        S[(I0)] = __builtin_amdgcn_exp2f(a_.x); S[(I0) + 1] = __builtin_amdgcn_exp2f(a_.y); S[(I0) + 2] = __builtin_amdgcn_exp2f(b_.x); S[(I0) + 3] = __builtin_amdgcn_exp2f(b_.y); \
        rs2 += (f32x2_t){S[(I0)], S[(I0) + 1]} + (f32x2_t){S[(I0) + 2], S[(I0) + 3]}; }
#define EXPQ(S, I0) { if (FIXM) EXP4F(S, I0) else EXP4(S, I0) }
#define PACK8(S, I0) ({ u32x4 t_; t_.x = pk_bf16(S[(I0)], S[(I0) + 1]); t_.y = pk_bf16(S[(I0) + 2], S[(I0) + 3]); t_.z = pk_bf16(S[(I0) + 4], S[(I0) + 5]); t_.w = pk_bf16(S[(I0) + 6], S[(I0) + 7]); __builtin_bit_cast(bf16x8, t_); })
DI float max8(const f32x16& s, int i0, float mx) {
    mx = fmaxf(fmaxf(mx, s[i0]), s[i0 + 1]); mx = fmaxf(fmaxf(mx, s[i0 + 2]), s[i0 + 3]);
    mx = fmaxf(fmaxf(mx, s[i0 + 4]), s[i0 + 5]); mx = fmaxf(fmaxf(mx, s[i0 + 6]), s[i0 + 7]);
    return mx;
}
#define EXP2F(S, I0) { S[(I0)] = __builtin_amdgcn_exp2f(S[(I0)]); S[(I0) + 1] = __builtin_amdgcn_exp2f(S[(I0) + 1]); rs += S[(I0)] + S[(I0) + 1]; \
        asm volatile("" : "+v"(S[(I0)]), "+v"(S[(I0) + 1]), "+v"(rs)); }
#define PIN1(X) asm volatile("" : "+v"(X))
template <bool DO_PV, bool DO_QK>
DI void attn_step_fix(f32x16& s0, f32x16& s1, f32x16& n0, f32x16& n1, const bf16x8 (&pp)[4], bf16x8 (&pc)[4],
                      f32x16& o0, f32x16& o1, const float m, float& lsum, const bf16x8 (&qf)[4],
                      const unsigned char* kp, const unsigned char* vp, int k_off, int kswz, int v_off, int vswz, int h) {
    bf16x8 va0, vb0, va1, vb1, va2, vb2, va3, vb3, ka0, kb0, ka1, kb1, ka2, kb2, ka3, kb3;
    float rs = 0.f;
    if (DO_PV) { va0 = VFRAG(0, 0); vb0 = VFRAG(0, 1); va1 = VFRAG(1, 0); vb1 = VFRAG(1, 1); }
    EXP2F(s0, 0);  if (DO_PV) { o0 = mfma32(va0, pp[0], o0); va2 = VFRAG(2, 0); vb2 = VFRAG(2, 1); }
    EXP2F(s0, 2);  if (DO_PV) { o1 = mfma32(vb0, pp[0], o1); va3 = VFRAG(3, 0); vb3 = VFRAG(3, 1); }
    EXP2F(s0, 4);  if (DO_PV) { o0 = mfma32(va1, pp[1], o0); } if (DO_QK) { ka0 = KFRAG(0, 0); kb0 = KFRAG(0, 1); }
    EXP2F(s0, 6);  if (DO_PV) { o1 = mfma32(vb1, pp[1], o1); } if (DO_QK) { ka1 = KFRAG(1, 0); kb1 = KFRAG(1, 1); }
    EXP2F(s0, 8);  if (DO_PV) { o0 = mfma32(va2, pp[2], o0); }
    EXP2F(s0, 10); if (DO_PV) { o1 = mfma32(vb2, pp[2], o1); } pc[0] = PACK8(s0, 0); PIN1(pc[0]);
    EXP2F(s0, 12); if (DO_PV) { o0 = mfma32(va3, pp[3], o0); }
    EXP2F(s0, 14); if (DO_PV) { o1 = mfma32(vb3, pp[3], o1); }
    EXP2F(s1, 0);  if (DO_QK) { n0 = mfma32(ka0, qf[0], (f32x16){0.f, 0.f, 0.f, 0.f, 0.f, 0.f, 0.f, 0.f, 0.f, 0.f, 0.f, 0.f, 0.f, 0.f, 0.f, 0.f}); ka2 = KFRAG(2, 0); kb2 = KFRAG(2, 1); } pc[1] = PACK8(s0, 8); PIN1(pc[1]);
    EXP2F(s1, 2);  if (DO_QK) { n1 = mfma32(kb0, qf[0], (f32x16){0.f, 0.f, 0.f, 0.f, 0.f, 0.f, 0.f, 0.f, 0.f, 0.f, 0.f, 0.f, 0.f, 0.f, 0.f, 0.f}); ka3 = KFRAG(3, 0); kb3 = KFRAG(3, 1); }
    EXP2F(s1, 4);  if (DO_QK) { n0 = mfma32(ka1, qf[1], n0); }
    EXP2F(s1, 6);  if (DO_QK) { n1 = mfma32(kb1, qf[1], n1); }
    EXP2F(s1, 8);  if (DO_QK) { n0 = mfma32(ka2, qf[2], n0); } pc[2] = PACK8(s1, 0); PIN1(pc[2]);
    EXP2F(s1, 10); if (DO_QK) { n1 = mfma32(kb2, qf[2], n1); }
    EXP2F(s1, 12); if (DO_QK) { n0 = mfma32(ka3, qf[3], n0); }
    EXP2F(s1, 14); if (DO_QK) { n1 = mfma32(kb3, qf[3], n1); } pc[3] = PACK8(s1, 8); PIN1(pc[3]);
    lsum += rs;

}
template <bool DO_PV, bool DO_QK, bool FIXM>
DI void attn_step(f32x16& s0, f32x16& s1, f32x16& n0, f32x16& n1, const bf16x8 (&pp)[4], bf16x8 (&pc)[4],
                  f32x16& o0, f32x16& o1, float& m, float& lsum, const bf16x8 (&qf)[4],
                  const unsigned char* kp, const unsigned char* vp, int k_off, int kswz, int v_off, int vswz, int h) {
    if (FIXM) { attn_step_fix<DO_PV, DO_QK>(s0, s1, n0, n1, pp, pc, o0, o1, m, lsum, qf, kp, vp, k_off, kswz, v_off, vswz, h); return; }
    bf16x8 va0, vb0, va1, vb1, va2, vb2, va3, vb3, ka0, kb0, ka1, kb1, ka2, kb2, ka3, kb3;
    if (DO_PV) { va0 = VFRAG(0, 0); vb0 = VFRAG(0, 1); va1 = VFRAG(1, 0); vb1 = VFRAG(1, 1); }
    float mx = s0[0];
    if (DO_PV) o0 = mfma32(va0, pp[0], o0);
    if (!FIXM) mx = max8(s0, 0, mx);
    SB_();
    if (DO_PV) { o1 = mfma32(vb0, pp[0], o1); va2 = VFRAG(2, 0); vb2 = VFRAG(2, 1); }
    if (!FIXM) mx = max8(s0, 8, mx);
    SB_();
    if (DO_PV) { o0 = mfma32(va1, pp[1], o0); va3 = VFRAG(3, 0); vb3 = VFRAG(3, 1); }
    if (!FIXM) mx = max8(s1, 0, mx);
    SB_();
    if (DO_PV) o1 = mfma32(vb1, pp[1], o1);
    bool need = false; float alpha = 1.0f;
    if (!FIXM) {
        mx = max8(s1, 8, mx);
        mx = xhalf_max(mx);
        need = mx > m + 8.0f;
        const float mnew = need ? mx : m;
        alpha = __builtin_amdgcn_exp2f(m - mnew);
        m = mnew;
    }
    const float mb = m;
    float rs = 0.f; f32x2_t rs2 = {0.f, 0.f};
    SB_();
    if (DO_PV) o0 = mfma32(va2, pp[2], o0);
    if (DO_QK) { ka0 = KFRAG(0, 0); kb0 = KFRAG(0, 1); }
    EXPQ(s0, 0);
    SB_();
    if (DO_PV) o1 = mfma32(vb2, pp[2], o1);
    if (DO_QK) { ka1 = KFRAG(1, 0); kb1 = KFRAG(1, 1); }
    EXPQ(s0, 4);
    SB_();
    if (DO_PV) o0 = mfma32(va3, pp[3], o0);
    EXPQ(s0, 8);
    SB_();
    if (DO_PV) o1 = mfma32(vb3, pp[3], o1);
    EXPQ(s0, 12);
    SB_();
    if (DO_QK) { n0 = mfma32(ka0, qf[0], (f32x16){0.f, 0.f, 0.f, 0.f, 0.f, 0.f, 0.f, 0.f, 0.f, 0.f, 0.f, 0.f, 0.f, 0.f, 0.f, 0.f}); ka2 = KFRAG(2, 0); kb2 = KFRAG(2, 1); }
    EXPQ(s1, 0);
    SB_();
    if (DO_QK) { n1 = mfma32(kb0, qf[0], (f32x16){0.f, 0.f, 0.f, 0.f, 0.f, 0.f, 0.f, 0.f, 0.f, 0.f, 0.f, 0.f, 0.f, 0.f, 0.f, 0.f}); ka3 = KFRAG(3, 0); kb3 = KFRAG(3, 1); }
    EXPQ(s1, 4);
    SB_();
    if (DO_QK) n0 = mfma32(ka1, qf[1], n0);
    EXPQ(s1, 8);
    SB_();
    if (DO_QK) n1 = mfma32(kb1, qf[1], n1);
    EXPQ(s1, 12);
    SB_();
    if (DO_QK) n0 = mfma32(ka2, qf[2], n0);
    pc[0] = PACK8(s0, 0);
    SB_();
    if (DO_QK) n1 = mfma32(kb2, qf[2], n1);
    pc[1] = PACK8(s0, 8);
    SB_();
    if (DO_QK) n0 = mfma32(ka3, qf[3], n0);
    pc[2] = PACK8(s1, 0);
    SB_();
    if (DO_QK) n1 = mfma32(kb3, qf[3], n1);
    pc[3] = PACK8(s1, 8);
    if (FIXM) lsum += rs2.x + rs2.y; else lsum = lsum * alpha + rs;
    SB_();
    if (!FIXM) {
        if (__builtin_amdgcn_ballot_w64(need)) {
#pragma unroll
            for (int i = 0; i < 16; ++i) { o0[i] *= alpha; o1[i] *= alpha; }
        }
    }
}

struct AttnPre { bf16x8 q[4]; u32x4 k0, k1, s0k, s0v; };
DI void attn_prefetch(AttnPre& pre, const bf16_t* __restrict__ Q, const bf16_t* __restrict__ K, const bf16_t* __restrict__ VT, int ldv, int tid) {
    const int lane = tid & 63, wave = tid >> 6, r = lane & 31, h = lane >> 5, lrow = tid >> 3, lc = tid & 7;
    const bf16_t* qp = Q + (size_t)(wave * 32 + r) * INW + h * 8;
#pragma unroll
    for (int ks = 0; ks < 4; ++ks) pre.q[ks] = *(const bf16x8*)(qp + ks * 16);
    const bf16_t* Kg = K + (size_t)lrow * INW + lc * 8;
    pre.k0 = *(const u32x4*)(Kg); pre.k1 = *(const u32x4*)(Kg + (size_t)64 * INW); pre.s0k = *(const u32x4*)(Kg + (size_t)128 * INW);
    pre.s0v = *(const u32x4*)(VT + (size_t)lrow * ldv + lc * 8);
}

template <bool FIXM>
DI void attn_item(const bf16_t* __restrict__ Q, int ldq, const bf16_t* __restrict__ K, int ldk, const bf16_t* __restrict__ VT, int ldv,
                  int nkeys, bf16_t* __restrict__ O, const bf16_t* __restrict__ G, unsigned char* smem, float mfix,
                  AttnPre& pre, const bf16_t* __restrict__ nQ, const bf16_t* __restrict__ nK, const bf16_t* __restrict__ nVT, int nldv) {
    const int tid = opaque_tid(), lane = tid & 63, wave = tid >> 6;
    const int r = lane & 31, h = lane >> 5;
    bf16x8 qf[4];
#pragma unroll
    for (int ks = 0; ks < 4; ++ks) qf[ks] = pre.q[ks];
    const int lrow = tid >> 3, lc = tid & 7;
    const bf16_t* Kg = K + (size_t)lrow * ldk + lc * 8;
    const bf16_t* Vg = VT + (size_t)lrow * ldv + lc * 8;
    const int st_off = lrow * 128 + ((lc ^ ((lrow >> 1) & 7)) << 4);
    const int pr = (r & ~12) | ((r & 4) << 1) | ((r & 8) >> 1);
    const int kswz = (pr >> 1) & 7, vswz = (r >> 1) & 7;
    const int k_off = pr * 128, v_off = r * 128;
    const int nt = nkeys >> 6;

    f32x16 o0, o1, sa0, sa1, sb0, sb1;
#pragma unroll
    for (int i = 0; i < 16; ++i) { o0[i] = 0.f; o1[i] = 0.f; }
    float m = FIXM ? mfix : -1e30f, lsum = 0.f;
    bf16x8 pa[4], pb[4];

    u32x4 rk, rv;
#define A_LOAD(U) { const int kt_ = ((U) + 2 < nt) ? (U) + 2 : nt - 1; rk = *(const u32x4*)(Kg + (size_t)(kt_ * 64) * ldk); rv = *(const u32x4*)(Vg + (U) * 64); }
#define A_STORE(OFF) { *(u32x4*)(smem + (OFF) + st_off) = rk; *(u32x4*)(smem + (OFF) + 8192 + st_off) = rv; }
    lds_barrier();
    *(u32x4*)(smem + 16384 + st_off) = pre.k0; *(u32x4*)(smem + 16384 + 8192 + st_off) = pre.k1;
    *(u32x4*)(smem + st_off) = pre.s0k; *(u32x4*)(smem + 8192 + st_off) = pre.s0v;
    A_LOAD(1);
    lds_barrier();
    {
        const unsigned char* kp = smem + 16384;
        sa0 = mfma32(KFRAG(0, 0), qf[0], (f32x16){0.f, 0.f, 0.f, 0.f, 0.f, 0.f, 0.f, 0.f, 0.f, 0.f, 0.f, 0.f, 0.f, 0.f, 0.f, 0.f});
        sa1 = mfma32(KFRAG(0, 1), qf[0], (f32x16){0.f, 0.f, 0.f, 0.f, 0.f, 0.f, 0.f, 0.f, 0.f, 0.f, 0.f, 0.f, 0.f, 0.f, 0.f, 0.f});
#pragma unroll
        for (int ks = 1; ks < 4; ++ks) { sa0 = mfma32(KFRAG(ks, 0), qf[ks], sa0); sa1 = mfma32(KFRAG(ks, 1), qf[ks], sa1); }
    }
    attn_step<false, true, FIXM>(sa0, sa1, sb0, sb1, pb, pa, o0, o1, m, lsum, qf, smem + 16384 + 8192, smem, k_off, kswz, v_off, vswz, h);
    lds_barrier();
    for (int t = 1; t < nt - 1; t += 2) {
        A_STORE(16384);
        A_LOAD(t + 1);
        SB_();
        attn_step<true, true, FIXM>(sb0, sb1, sa0, sa1, pa, pb, o0, o1, m, lsum, qf, smem, smem + 8192, k_off, kswz, v_off, vswz, h);
        lds_barrier();
        A_STORE(0);
        A_LOAD(t + 2);
        SB_();
        attn_step<true, true, FIXM>(sa0, sa1, sb0, sb1, pb, pa, o0, o1, m, lsum, qf, smem + 16384, smem + 16384 + 8192, k_off, kswz, v_off, vswz, h);
        lds_barrier();
    }
    A_STORE(16384);
    const bf16_t* gp = G + (size_t)(wave * 32 + r) * INW + 8 * h;
    u32x4 gw[4];
#pragma unroll
    for (int pp = 0; pp < 4; ++pp) gw[pp] = *(const u32x4*)(gp + 16 * pp);
    attn_prefetch(pre, nQ, nK, nVT, nldv, tid);
    SB_();
    attn_step<true, false, FIXM>(sb0, sb1, sa0, sa1, pa, pb, o0, o1, m, lsum, qf, smem, smem + 8192, k_off, kswz, v_off, vswz, h);
    lds_barrier();
    {
        const unsigned char* vp = smem + 16384 + 8192;
#pragma unroll
        for (int kk = 0; kk < 4; ++kk) { o0 = mfma32(VFRAG(kk, 0), pb[kk], o0); o1 = mfma32(VFRAG(kk, 1), pb[kk], o1); }
    }
#undef A_LOAD
#undef A_STORE
    const float lt = x32_add(lsum);
    const float inv = 1.0f / lt;
    bf16_t* op = O + (size_t)(wave * 32 + r) * 1024 + 8 * h;
    *(u32x4*)(op) = o_pair_wide(o0, 0, inv, gw[0]);
    *(u32x4*)(op + 16) = o_pair_wide(o0, 2, inv, gw[1]);
    *(u32x4*)(op + 32) = o_pair_wide(o1, 0, inv, gw[2]);
    *(u32x4*)(op + 48) = o_pair_wide(o1, 2, inv, gw[3]);
}

DI void cross_item(const bf16_t* __restrict__ Q, const bf16_t* __restrict__ K, const bf16_t* __restrict__ VT,
                   bf16_t* __restrict__ O, const bf16_t* __restrict__ G, unsigned char* smem) {
    const int tid = opaque_tid(), lane = tid & 63, wave = tid >> 6;
    const int r = lane & 31, h = lane >> 5;
    bf16x8 qf[4];
    {
        const bf16_t* qp = Q + (size_t)(wave * 32 + r) * INW + h * 8;
#pragma unroll
        for (int ks = 0; ks < 4; ++ks) qf[ks] = *(const bf16x8*)(qp + ks * 16);
    }
    const int lrow = tid >> 3, lc = tid & 7;
    const int st_off = lrow * 128 + ((lc ^ ((lrow >> 1) & 7)) << 4);
    {
        u32x4 kk[4], vv[4];
#pragma unroll
        for (int i = 0; i < 4; ++i) { kk[i] = *(const u32x4*)(K + (size_t)(lrow + 64 * i) * 256 + lc * 8); vv[i] = *(const u32x4*)(VT + (size_t)lrow * 256 + (i * 8 + lc) * 8); }
        __syncthreads();
#pragma unroll
        for (int i = 0; i < 4; ++i) { *(u32x4*)(smem + i * 16384 + st_off) = kk[i]; *(u32x4*)(smem + i * 16384 + 8192 + st_off) = vv[i]; }
    }
    const bf16_t* gp = G + (size_t)(wave * 32 + r) * INW + 8 * h;
    u32x4 gw[4];
#pragma unroll
    for (int pp = 0; pp < 4; ++pp) gw[pp] = *(const u32x4*)(gp + 16 * pp);
    __syncthreads();
    const int pr = (r & ~12) | ((r & 4) << 1) | ((r & 8) >> 1);
    const int kswz = (pr >> 1) & 7, vswz = (r >> 1) & 7;
    const int k_off = pr * 128, v_off = r * 128;
    f32x16 o0, o1;
#pragma unroll
    for (int i = 0; i < 16; ++i) { o0[i] = 0.f; o1[i] = 0.f; }
    float m = -1e30f, lsum = 0.f;
#pragma unroll
    for (int kt = 0; kt < 4; ++kt) {
        const unsigned char* kp = smem + kt * 16384;
        const unsigned char* vp = kp + 8192;
        f32x16 s0, s1;
        s0 = mfma32(KFRAG(0, 0), qf[0], (f32x16){0.f, 0.f, 0.f, 0.f, 0.f, 0.f, 0.f, 0.f, 0.f, 0.f, 0.f, 0.f, 0.f, 0.f, 0.f, 0.f});
        s1 = mfma32(KFRAG(0, 1), qf[0], (f32x16){0.f, 0.f, 0.f, 0.f, 0.f, 0.f, 0.f, 0.f, 0.f, 0.f, 0.f, 0.f, 0.f, 0.f, 0.f, 0.f});
#pragma unroll
        for (int ks = 1; ks < 4; ++ks) { s0 = mfma32(KFRAG(ks, 0), qf[ks], s0); s1 = mfma32(KFRAG(ks, 1), qf[ks], s1); }
        float mx = s0[0];
        mx = max8(s0, 0, mx); mx = max8(s0, 8, mx); mx = max8(s1, 0, mx); mx = max8(s1, 8, mx);
        mx = xhalf_max(mx);
        const float mnew = fmaxf(m, mx);
        const float alpha = __builtin_amdgcn_exp2f(m - mnew);
        m = mnew;
        const float mb = mnew;
        float rs = 0.f;
#pragma unroll
        for (int i = 0; i < 16; ++i) { s0[i] = __builtin_amdgcn_exp2f(s0[i] - mb); s1[i] = __builtin_amdgcn_exp2f(s1[i] - mb); rs += s0[i] + s1[i]; }
        lsum = lsum * alpha + rs;
#pragma unroll
        for (int i = 0; i < 16; ++i) { o0[i] *= alpha; o1[i] *= alpha; }
        bf16x8 pf[4];
        pf[0] = PACK8(s0, 0); pf[1] = PACK8(s0, 8); pf[2] = PACK8(s1, 0); pf[3] = PACK8(s1, 8);
#pragma unroll
        for (int kk2 = 0; kk2 < 4; ++kk2) { o0 = mfma32(VFRAG(kk2, 0), pf[kk2], o0); o1 = mfma32(VFRAG(kk2, 1), pf[kk2], o1); }
    }
    const float lt = x32_add(lsum);
    const float inv = 1.0f / lt;
    bf16_t* op = O + (size_t)(wave * 32 + r) * 1024 + 8 * h;
    *(u32x4*)(op) = o_pair_wide(o0, 0, inv, gw[0]);
    *(u32x4*)(op + 16) = o_pair_wide(o0, 2, inv, gw[1]);
    *(u32x4*)(op + 32) = o_pair_wide(o1, 0, inv, gw[2]);
    *(u32x4*)(op + 48) = o_pair_wide(o1, 2, inv, gw[3]);
}

template <int HALF>
DI void pool_window(bf16x8 (&df)[2][2], const unsigned char* smem, int th, int r16, int q4, int g, int t0, int T) {
    constexpr int RS = 528;
#pragma unroll
    for (int t2 = 0; t2 < 2; ++t2)
#pragma unroll
        for (int ks = 0; ks < 2; ++ks) {
            const int tl = (th * 2 + t2) * 16 + r16, t = t0 + tl;
            const int lo = max(t - HALF, 0), hi = min(t + HALF, T);
            const float icnt = 1.0f / (float)(hi - lo);
            float s[8];
#pragma unroll
            for (int j = 0; j < 8; ++j) s[j] = 0.f;
            const unsigned char* bp = smem + (tl + 8 - HALF) * RS + (g * 64 + ks * 32 + q4 * 8) * 2;
#pragma unroll
            for (int j = 0; j < 2 * HALF; ++j) {
                const u32x4 v = *(const u32x4*)(bp + j * RS);
                s[0] += bflo(v.x); s[1] += bfhi(v.x); s[2] += bflo(v.y); s[3] += bfhi(v.y);
                s[4] += bflo(v.z); s[5] += bfhi(v.z); s[6] += bflo(v.w); s[7] += bfhi(v.w);
            }
            const u32x4 c = *(const u32x4*)(bp + HALF * RS);
            u32x4 o;
            o.x = pk_bf16(s[0] * icnt - bflo(c.x), s[1] * icnt - bfhi(c.x));
            o.y = pk_bf16(s[2] * icnt - bflo(c.y), s[3] * icnt - bfhi(c.y));
            o.z = pk_bf16(s[4] * icnt - bflo(c.z), s[5] * icnt - bfhi(c.z));
            o.w = pk_bf16(s[6] * icnt - bflo(c.w), s[7] * icnt - bfhi(c.w));
            df[t2][ks] = __builtin_bit_cast(bf16x8, o);
        }
}

struct PoolPre { u32x4 u[5]; u32x4 gg[2][2]; };
DI void pool_prefetch(PoolPre& pp, const bf16_t* __restrict__ Z, int tokg0, int tid) {
    const int lane = tid & 63, wave = tid >> 6, g = wave & 3, th = wave >> 2, r16 = lane & 15, q4 = lane >> 4;
    const int T = (tokg0 < NPROMPT) ? 2048 : 4096, t0 = tokg0 & (T - 1);
#pragma unroll
    for (int k = 0; k < 5; ++k) {
        const int id = tid + 512 * k, rr = id >> 5, c = id & 31, t = t0 - 8 + rr;
        u32x4 v = (u32x4){0u, 0u, 0u, 0u};
        if (t >= 0 && t < T) v = *(const u32x4*)(Z + (size_t)(tokg0 - 8 + rr) * INW + c * 8);
        pp.u[k] = v;
    }
#pragma unroll
    for (int t2 = 0; t2 < 2; ++t2)
#pragma unroll
        for (int pr = 0; pr < 2; ++pr)
            pp.gg[t2][pr] = *(const u32x4*)(Z + ((size_t)tokg0 + (th * 2 + t2) * 16 + r16) * INW + 256 + g * 64 + pr * 32 + 8 * q4);
}
DI void pool_phase(const bf16_t* __restrict__ Z, const bf16_t* __restrict__ PWT, const float* __restrict__ pscale, bf16_t* __restrict__ MIX,
                   int bid, int nb, unsigned char* smem) {
    if (bid >= 768) return;
    const int tid = opaque_tid(), lane = tid & 63, wave = tid >> 6;
    constexpr int RS = 528;
    const int g = wave & 3, th = wave >> 2, r16 = lane & 15, q4 = lane >> 4;
    bf16x8 wfr[4][2]; f32x4 psr[4];
#pragma unroll
    for (int fi = 0; fi < 4; ++fi) {
        const int nrow = 32 * (fi >> 1) + 8 * (r16 >> 2) + 4 * (fi & 1) + (r16 & 3);
#pragma unroll
        for (int ks = 0; ks < 2; ++ks) wfr[fi][ks] = *(const bf16x8*)(PWT + (size_t)g * 4096 + nrow * 64 + ks * 32 + q4 * 8);
        psr[fi] = *(const f32x4*)(pscale + g * 64 + 32 * (fi >> 1) + 8 * q4 + 4 * (fi & 1));
    }
    PoolPre pp;
    pool_prefetch(pp, Z, bid * 64, tid);
    for (int i = bid; i < 768; i += nb) {
        const int tokg0 = i * 64;
        const int T = (tokg0 < NPROMPT) ? 2048 : 4096, t0 = tokg0 & (T - 1);
        lds_barrier();
#pragma unroll
        for (int k = 0; k < 5; ++k) { const int id = tid + 512 * k, rr = id >> 5, c = id & 31; *(u32x4*)(smem + rr * RS + c * 16) = pp.u[k]; }
        u32x4 gcur[2][2];
#pragma unroll
        for (int t2 = 0; t2 < 2; ++t2) { gcur[t2][0] = pp.gg[t2][0]; gcur[t2][1] = pp.gg[t2][1]; }
        pool_prefetch(pp, Z, ((i + nb < 768) ? i + nb : i) * 64, tid);
        lds_barrier();
        bf16x8 df[2][2];
        switch (g) {
            case 0: pool_window<1>(df, smem, th, r16, q4, g, t0, T); break;
            case 1: pool_window<2>(df, smem, th, r16, q4, g, t0, T); break;
            case 2: pool_window<4>(df, smem, th, r16, q4, g, t0, T); break;
            default: pool_window<8>(df, smem, th, r16, q4, g, t0, T); break;
        }
        f32x4 acc[4][2];
#pragma unroll
        for (int a = 0; a < 4; ++a)
#pragma unroll
            for (int j = 0; j < 2; ++j) acc[a][j] = (f32x4){0.f, 0.f, 0.f, 0.f};
#pragma unroll
        for (int fi = 0; fi < 4; ++fi)
#pragma unroll
            for (int ks = 0; ks < 2; ++ks)
#pragma unroll
                for (int t2 = 0; t2 < 2; ++t2) acc[fi][t2] = mfma16(wfr[fi][ks], df[t2][ks], acc[fi][t2]);
#pragma unroll
        for (int t2 = 0; t2 < 2; ++t2) {
            const size_t tok = (size_t)tokg0 + (th * 2 + t2) * 16 + r16;
#pragma unroll
            for (int pr = 0; pr < 2; ++pr) {
                const u32x4 gg = gcur[t2][pr];
                const f32x4 a = acc[2 * pr][t2], b = acc[2 * pr + 1][t2], pa = psr[2 * pr], pb = psr[2 * pr + 1];
                u32x4 w;
                w.x = pk_bf16(a[0] * pa[0] * bflo(gg.x), a[1] * pa[1] * bfhi(gg.x)); w.y = pk_bf16(a[2] * pa[2] * bflo(gg.y), a[3] * pa[3] * bfhi(gg.y));
                w.z = pk_bf16(b[0] * pb[0] * bflo(gg.z), b[1] * pb[1] * bfhi(gg.z)); w.w = pk_bf16(b[2] * pb[2] * bflo(gg.w), b[3] * pb[3] * bfhi(gg.w));
                *(u32x4*)(MIX + tok * 1024 + g * 64 + pr * 32 + 8 * q4) = w;
            }
        }
    }
}

struct PostIn { u32x4 yv[2]; f32x4 xv[4]; };
DI PostIn post_row_load(const float* __restrict__ xsrc, const bf16_t* __restrict__ yh, int lane) {
    PostIn r;
#pragma unroll
    for (int j = 0; j < 2; ++j) r.yv[j] = *(const u32x4*)(yh + j * 512 + lane * 8);
#pragma unroll
    for (int j = 0; j < 2; ++j) { r.xv[2 * j] = *(const f32x4*)(xsrc + j * 512 + lane * 8); r.xv[2 * j + 1] = *(const f32x4*)(xsrc + j * 512 + lane * 8 + 4); }
    return r;
}
DI void post_row_finish(const PostIn& in, bf16_t* __restrict__ yh, const float* __restrict__ gpost, const float* __restrict__ gpre_next,
                        float* __restrict__ xdst, bool last, int lane) {
    u32x4 yv[2]; f32x4 xv[4];
#pragma unroll
    for (int j = 0; j < 2; ++j) yv[j] = in.yv[j];
#pragma unroll
    for (int j = 0; j < 4; ++j) xv[j] = in.xv[j];
    float y[16];
#pragma unroll
    for (int j = 0; j < 2; ++j) {
        y[8 * j + 0] = bflo(yv[j].x); y[8 * j + 1] = bfhi(yv[j].x); y[8 * j + 2] = bflo(yv[j].y); y[8 * j + 3] = bfhi(yv[j].y);
        y[8 * j + 4] = bflo(yv[j].z); y[8 * j + 5] = bfhi(yv[j].z); y[8 * j + 6] = bflo(yv[j].w); y[8 * j + 7] = bfhi(yv[j].w);
    }
    float ss = 0.f;
#pragma unroll
    for (int i = 0; i < 16; ++i) ss += y[i] * y[i];
    ss = wave_sum(ss);
    const float r = rsqrtf(ss * (1.0f / 1024.0f) + EPS);
    float xn[16]; float ss2 = 0.f;
#pragma unroll
    for (int j = 0; j < 2; ++j) {
        const f32x4 g0 = *(const f32x4*)(gpost + j * 512 + lane * 8), g1 = *(const f32x4*)(gpost + j * 512 + lane * 8 + 4);
#pragma unroll
        for (int i = 0; i < 4; ++i) {
            xn[8 * j + i] = xv[2 * j][i] + y[8 * j + i] * r * g0[i];
            xn[8 * j + 4 + i] = xv[2 * j + 1][i] + y[8 * j + 4 + i] * r * g1[i];
        }
    }
#pragma unroll
    for (int i = 0; i < 16; ++i) ss2 += xn[i] * xn[i];
#pragma unroll
    for (int j = 0; j < 2; ++j) {
        *(f32x4*)(xdst + j * 512 + lane * 8) = (f32x4){xn[8 * j], xn[8 * j + 1], xn[8 * j + 2], xn[8 * j + 3]};
        *(f32x4*)(xdst + j * 512 + lane * 8 + 4) = (f32x4){xn[8 * j + 4], xn[8 * j + 5], xn[8 * j + 6], xn[8 * j + 7]};
    }
    if (!last) {
        ss2 = wave_sum(ss2);
        const float r2 = rsqrtf(ss2 * (1.0f / 1024.0f) + EPS);
#pragma unroll
        for (int j = 0; j < 2; ++j) {
            const f32x4 g0 = *(const f32x4*)(gpre_next + j * 512 + lane * 8), g1 = *(const f32x4*)(gpre_next + j * 512 + lane * 8 + 4);
            u32x4 o;
            o.x = pk_bf16(xn[8 * j] * r2 * g0[0], xn[8 * j + 1] * r2 * g0[1]);
            o.y = pk_bf16(xn[8 * j + 2] * r2 * g0[2], xn[8 * j + 3] * r2 * g0[3]);
            o.z = pk_bf16(xn[8 * j + 4] * r2 * g1[0], xn[8 * j + 5] * r2 * g1[1]);
            o.w = pk_bf16(xn[8 * j + 6] * r2 * g1[2], xn[8 * j + 7] * r2 * g1[3]);
            *(u32x4*)(yh + j * 512 + lane * 8) = o;
        }
    }
}

#define XB_TMO      128
#define XB_XCNT(j)  (256  + 64 * (j))
#define XB_XSUB(j)  (1280 + 64 * (j))
#define XB_XGEN(j)  (2304 + 64 * (j))
#define XB_TOP      3328
#define XB_TOPGEN   3392
#define XCD_BAR_WORDS 3456
#define XB_SPIN_CAP (1u << 18)
#define LAS __attribute__((address_space(3)))
DI unsigned xb_ld(unsigned* p)              { return __hip_atomic_load(p, __ATOMIC_RELAXED, __HIP_MEMORY_SCOPE_AGENT); }
DI unsigned xb_add(unsigned* p, unsigned v) { return __hip_atomic_fetch_add(p, v, __ATOMIC_RELAXED, __HIP_MEMORY_SCOPE_AGENT); }
DI unsigned xb_xcc_id() { return (unsigned)__builtin_amdgcn_s_getreg((3 << 11) | 20) & 0xFu; }
#define XB_SPIN(cond, bar) do { unsigned _sp = 0; while (cond) { __builtin_amdgcn_s_sleep(1); \
    if ((++_sp & 255u) == 0u) { if (xb_ld(&(bar)[XB_TMO])) break; if (_sp > XB_SPIN_CAP) { atomicAdd(&(bar)[XB_TMO], 1u); break; } } } } while (0)
struct XcdBarrier { unsigned* bar; unsigned x; volatile LAS unsigned* st; };
DI XcdBarrier xcd_barrier_post(unsigned* bar, volatile LAS unsigned* st) {
    XcdBarrier b; b.bar = bar; b.x = xb_xcc_id(); b.st = st;
    if (threadIdx.x == 0) (void)xb_add(&bar[XB_XCNT(b.x)], 1u);
    return b;
}
DI void xcd_barrier_complete(unsigned* bar, unsigned x, unsigned& nloc, unsigned& nx) {
    const unsigned G = gridDim.x * gridDim.y * gridDim.z;
    unsigned sum, cnt, mine, sp = 0u;
    for (;;) {
        sum = 0u; cnt = 0u; mine = 0u;
#pragma unroll
        for (unsigned j = 0; j < 16; ++j) { const unsigned c = xb_ld(&bar[XB_XCNT(j)]); sum += c; cnt += (c > 0u) ? 1u : 0u; mine = (j == x) ? c : mine; }
        if (sum == G) break;
        __builtin_amdgcn_s_sleep(1);
        if ((++sp & 255u) == 0u) { if (xb_ld(&bar[XB_TMO])) break; if (sp > XB_SPIN_CAP) { atomicAdd(&bar[XB_TMO], 1u); break; } }
    }
    nloc = mine > 0u ? mine : 1u; nx = cnt > 0u ? cnt : 1u;
}
DI void xcd_barrier(const XcdBarrier& b) {
    asm volatile("s_waitcnt vmcnt(0)" ::: "memory");
    __syncthreads();
    if (threadIdx.x == 0) {
        unsigned* bar = b.bar;
        __builtin_amdgcn_s_waitcnt(0);
        unsigned nloc = b.st[0], nx = b.st[1];
        if (nloc == 0u) { xcd_barrier_complete(bar, b.x, nloc, nx); b.st[0] = nloc; b.st[1] = nx; }
        const unsigned old = xb_add(&bar[XB_XSUB(b.x)], 1u);
        const unsigned gen = old / nloc;
        if (old + 1u == (gen + 1u) * nloc) {
            __builtin_amdgcn_fence(__ATOMIC_RELEASE, "agent");
            asm volatile("s_waitcnt vmcnt(0)" ::: "memory");
            const unsigned og = xb_add(&bar[XB_TOP], 1u);
            const unsigned tg = og / nx;
            if (og + 1u == (tg + 1u) * nx) xb_add(&bar[XB_TOPGEN], 1u);
            else XB_SPIN(xb_ld(&bar[XB_TOPGEN]) == tg, bar);
            __builtin_amdgcn_fence(__ATOMIC_ACQUIRE, "agent");
            xb_add(&bar[XB_XGEN(b.x)], 1u);
            asm volatile("s_waitcnt vmcnt(0)" ::: "memory");
        } else {
            XB_SPIN(xb_ld(&bar[XB_XGEN(b.x)]) == gen, bar);
            __builtin_amdgcn_fence(__ATOMIC_ACQUIRE, "agent");
            asm volatile("s_waitcnt vmcnt(0)" ::: "memory");
        }
    }
    __syncthreads();
}

__global__ void __launch_bounds__(512, 2) fwd_megakernel(Params p) {
    __shared__ __attribute__((aligned(16))) unsigned char smem[131072];
    __shared__ uint4 xb_words;
    cg::grid_group grid = cg::this_grid();
    const int nb = gridDim.x, bid = blockIdx.x;
    if (threadIdx.x == 0) xb_words = make_uint4(0u, 0u, 0u, 0u);
    __syncthreads();
    XcdBarrier xb = xcd_barrier_post((unsigned*)(p.ws + OFF_BAR), (volatile LAS unsigned*)&xb_words);
    if (p.phase_end > 1000) grid.sync();
    for (int ph = p.phase_begin; ph < p.phase_end; ++ph) {
        unsigned char* ws = p.ws;
        bf16_t* H = (bf16_t*)(ws + OFF_H);
        bf16_t* Z = (bf16_t*)(ws + OFF_Z);
        bf16_t* VT = (bf16_t*)(ws + OFF_VT);
        bf16_t* MIX = (bf16_t*)(ws + OFF_MIX);
        bf16_t* WIN = (bf16_t*)(ws + OFF_WIN);
        bf16_t* WOUT = (bf16_t*)(ws + OFF_WOUT);
        bf16_t* WMEM = (bf16_t*)(ws + OFF_WMEM);
        bf16_t* PW = (bf16_t*)(ws + OFF_PW);
        bf16_t* MH = (bf16_t*)(ws + OFF_MH);
        bf16_t* KM = (bf16_t*)(ws + OFF_KM);
        bf16_t* VMT = (bf16_t*)(ws + OFF_VMT);
        float* ROPE = (float*)(ws + OFF_ROPE);
        if (ph == 0) {
            for (int i = bid; i < 1928; i += nb) {
                if (i < 1152) { const int l = i / 576, j = i % 576, kt = j / 36, ntile = j % 36;
                    transpose_tile(p.w_in + (size_t)l * DM * INW, INW, WIN + (size_t)l * INW * DM, DM, kt * 64, ntile * 64, smem);
                } else if (i < 1664) { const int ii = i - 1152, l = ii / 256, j = ii % 256, kt = j / 16, ntile = j % 16;
                    transpose_tile(p.w_out + (size_t)l * DM * DM, DM, WOUT + (size_t)l * DM * DM, DM, kt * 64, ntile * 64, smem);
                } else if (i < 1920) { const int ii = i - 1664, l = ii / 128, j = ii % 128, kt = j / 8, ntile = j % 8;
                    transpose_tile(p.w_mem_kv + (size_t)l * DM * 512, 512, WMEM + (size_t)l * 512 * DM, DM, kt * 64, ntile * 64, smem);
                } else { const int ii = i - 1920;
                    transpose_tile(p.pool_w + (size_t)ii * 4096, 64, PW + (size_t)ii * 4096, 64, 0, 0, smem);
                }
            }
            {
                const int tid = opaque_tid(), lane = tid & 63, wave = tid >> 6;
                constexpr int NR = NTOK + 2 * NMEMTOK;
                auto desc = [&](int i, const float*& src, const float*& g, bf16_t*& dst) {
                    if (i < NTOK) { src = (i < NPROMPT) ? p.x_prompt + (size_t)i * DM : p.x_sample + (size_t)(i - NPROMPT) * DM; g = p.norm_pre; dst = H + (size_t)i * DM; }
                    else { const int ii = i - NTOK, l = ii / NMEMTOK, mt = ii % NMEMTOK;
                           src = (mt < 4096) ? p.mem_prompt + (size_t)mt * DM : p.mem_sample + (size_t)(mt - 4096) * DM; g = p.mem_norm + l * DM; dst = MH + ((size_t)l * NMEMTOK + mt) * DM; }
                };
                int i = bid * 8 + wave;
                if (i < NR) {
                    const float *s, *g; bf16_t* d; desc(i, s, g, d);
                    RowIn cur = rms_row_load(s, lane);
                    for (; i < NR; i += nb * 8) {
                        const int in = (i + nb * 8 < NR) ? i + nb * 8 : NR - 1;
                        const float *s2, *g2; bf16_t* d2; desc(in, s2, g2, d2);
                        const RowIn nxt = rms_row_load(s2, lane);
                        rms_row_finish(cur, g, d, lane);
                        cur = nxt; g = g2; d = d2;
                    }
                }
            }
            { const int tid = opaque_tid(); for (int i = bid * 512 + tid; i < 1024; i += nb * 512) rope_entry(i, ROPE); }
        } else {
            const int l = (ph - 1) >> 2, sub = (ph - 1) & 3;
            if (sub == 0) {
                EpiArgs e; e.C = Z; e.VT = VT; e.qn = p.q_norm + l * 64; e.kn = p.k_norm + l * 64; e.rope = ROPE;
                const bf16_t* Wl = WIN + (size_t)l * INW * DM;
                EpiArgs e2; e2.C = KM + (size_t)l * NMEMTOK * 256; e2.VT = VMT + (size_t)l * NMEMTOK * 256; e2.qn = nullptr; e2.kn = nullptr; e2.rope = nullptr;
                const bf16_t* Wm = WMEM + (size_t)l * 512 * DM;
                const bf16_t* Am = MH + (size_t)l * NMEMTOK * DM;
                auto tile1 = [&](int i, const bf16_t*& ta, const bf16_t*& tb, int& tm0, int& tn0) {
                    if (i < 1728) {
                        const int j = i >> 3, mg = j / 72, rem = j % 72;
                        tm0 = ((i & 7) * 24 + mg * 8 + (rem & 7)) * 256; tn0 = (rem >> 3) * 256; ta = H; tb = Wl;
                    } else { const int j = i - 1728; tm0 = (j >> 1) * 256; tn0 = (j & 1) * 256; ta = Am; tb = Wm; }
                };
                bool pre = false;
                for (int i = bid; i < 1728 + 40; i += nb) {
                    const bf16_t *ta, *tb, *na = nullptr, *nbp = nullptr; int tm0, tn0, xm = 0, xn = 0;
                    tile1(i, ta, tb, tm0, tn0);
                    if (i + nb < 1728 + 40) tile1(i + nb, na, nbp, xm, xn);
                    const bool nperm = (i + nb < 1728) ? !(xn >= 512 && xn < 1152) : (xn == 0);
                    if (i < 1728) gemm_tile<0>(ta, tb, tm0, tn0, e, smem, pre, na, nbp, xm, xn, nperm);
                    else gemm_tile<2>(ta, tb, tm0, tn0, e2, smem, pre, na, nbp, xm, xn, nperm);
                    pre = (na != nullptr);
                }
            } else if (sub == 1) {
                const int lane = opaque_tid() & 63;
                float gq = fabsf(p.q_norm[l * 64 + lane]), gk = fabsf(p.k_norm[l * 64 + lane]);
                gq = wave_max(gq); gk = wave_max(gk);
                const float mfix = 8.0f * gq * gk * 1.02f * L2E;
                const bool fixm = mfix < 28.0f;
                {
                    auto sdec = [&](int i, const bf16_t*& q, const bf16_t*& k, const bf16_t*& vt, int& T, bf16_t*& o, const bf16_t*& g) {
                        int b, kvh, j; size_t tok0, vtb;
                        if (i < 512) { const int R = i >> 8, ip = i & 255, grp = ip & 7; j = R * 32 + (ip >> 3); b = grp >> 1; kvh = grp & 1; T = 4096;
                            tok0 = (size_t)NPROMPT + (size_t)b * 4096; vtb = (size_t)NPROMPT * 128 + ((size_t)(b * 2 + kvh) * 64) * 4096; }
                        else { const int ii = i - 512, R = ii >> 8, ip = ii & 255, grp = R * 8 + (ip & 7); j = ip >> 3; b = grp >> 1; kvh = grp & 1; T = 2048;
                            tok0 = (size_t)b * 2048; vtb = ((size_t)(b * 2 + kvh) * 64) * 2048; }
                        const int qblk = j >> 2, head = kvh * 4 + (j & 3);
                        const size_t q0 = tok0 + (size_t)qblk * 256;
                        q = Z + q0 * INW + 512 + head * 64; k = Z + tok0 * INW + 1024 + kvh * 64; vt = VT + vtb;
                        o = MIX + q0 * 1024 + 256 + head * 64; g = Z + q0 * INW + 1280 + head * 64;
                    };
                    if (bid < 1536) {
                        AttnPre pre;
                        { const bf16_t *q, *k, *vt, *g; bf16_t* o; int T; sdec(bid, q, k, vt, T, o, g); attn_prefetch(pre, q, k, vt, T, opaque_tid()); }
                        __builtin_amdgcn_s_waitcnt(0x0F70);
                        for (int i = bid; i < 1536; i += nb) {
                            const bf16_t *q, *k, *vt, *g, *nq, *nk, *nvt, *ng; bf16_t *o, *no; int T, nT;
                            sdec(i, q, k, vt, T, o, g);
                            sdec((i + nb < 1536) ? i + nb : i, nq, nk, nvt, nT, no, ng);
                            if (fixm) attn_item<true>(q, INW, k, INW, vt, T, T, o, g, smem, mfix, pre, nq, nk, nvt, nT);
                            else attn_item<false>(q, INW, k, INW, vt, T, T, o, g, smem, 0.f, pre, nq, nk, nvt, nT);
                        }
                    }
                }
                for (int i = bid; i < 768; i += nb) {
                    const int qb = i >> 2, hx = i & 3;
                    const size_t q0 = (size_t)qb * 256;
                    const int b = (q0 < NPROMPT) ? (int)(q0 >> 11) : 16 + (int)((q0 - NPROMPT) >> 12);
                    cross_item(Z + q0 * INW + 1792 + hx * 64, KM + ((size_t)l * NMEMTOK + (size_t)b * 256) * 256 + hx * 64,
                               VMT + (size_t)l * NMEMTOK * 256 + ((size_t)(b * 4 + hx) * 64) * 256,
                               MIX + q0 * 1024 + 768 + hx * 64, Z + q0 * INW + 2048 + hx * 64, smem);
                }
                pool_phase(Z, PW + (size_t)l * 4 * 4096, p.pool_scale + l * 256, MIX, bid, nb, smem);
            } else if (sub == 2) {
                EpiArgs e; e.C = H; e.VT = nullptr; e.qn = nullptr; e.kn = nullptr; e.rope = nullptr;
                const bf16_t* Wl = WOUT + (size_t)l * DM * DM;
                auto tile2 = [&](int i, int& tm0, int& tn0) {
                    const int j = i >> 3, mg = j >> 5, rem = j & 31;
                    tm0 = ((i & 7) * 24 + mg * 8 + (rem & 7)) * 256; tn0 = (rem >> 3) * 256;
                };
                bool pre = false;
                for (int i = bid; i < 768; i += nb) {
                    int tm0, tn0, xm = 0, xn = 0; tile2(i, tm0, tn0);
                    const bool more = (i + nb < 768);
                    if (more) tile2(i + nb, xm, xn);
                    gemm_tile<1>(MIX, Wl, tm0, tn0, e, smem, pre, more ? MIX : nullptr, Wl, xm, xn, true);
                    pre = more;
                }
            } else {
                const bool last = (l == DEPTH - 1);
                auto xsrc = [&](int i) -> const float* {
                    return (l == 0) ? ((i < NPROMPT) ? p.x_prompt + (size_t)i * DM : p.x_sample + (size_t)(i - NPROMPT) * DM) : p.out + (size_t)i * DM; };
                const int tid = opaque_tid(), lane = tid & 63, wave = tid >> 6;
                int i = bid * 8 + wave;
                if (i < NTOK) {
                    PostIn cur = post_row_load(xsrc(i), H + (size_t)i * DM, lane);
                    for (; i < NTOK; i += nb * 8) {
                        const int in = (i + nb * 8 < NTOK) ? i + nb * 8 : i;
                        const PostIn nxt = post_row_load(xsrc(in), H + (size_t)in * DM, lane);
                        post_row_finish(cur, H + (size_t)i * DM, p.norm_post + l * DM, p.norm_pre + (last ? l : l + 1) * DM, p.out + (size_t)i * DM, last, lane);
                        cur = nxt;
                    }
                }
            }
        }
        if (ph + 1 < p.phase_end) xcd_barrier(xb);
    }
}

extern "C" void kernel_launch(void* const* d_in, const int* in_sizes, int n_in, void* d_out, int out_size, void* d_ws, size_t ws_size,
                              hipStream_t stream) {
    static int grid_blocks = 0;
    if (!grid_blocks) {
        int dev = 0, cus = 0, per_cu = 0;
        hipGetDevice(&dev);
        hipDeviceGetAttribute(&cus, hipDeviceAttributeMultiprocessorCount, dev);
        hipOccupancyMaxActiveBlocksPerMultiprocessor(&per_cu, fwd_megakernel, 512, 0);
        if (per_cu > 1) per_cu = 1;
        if (per_cu < 1) per_cu = 1;
        grid_blocks = cus * per_cu;
    }
    Params p{};
    p.x_prompt = (const float*)d_in[0]; p.x_sample = (const float*)d_in[1]; p.mem_prompt = (const float*)d_in[2]; p.mem_sample = (const float*)d_in[3];
    p.norm_pre = (const float*)d_in[4]; p.norm_post = (const float*)d_in[5]; p.w_in = (const float*)d_in[6]; p.pool_w = (const float*)d_in[7];
    p.pool_scale = (const float*)d_in[8]; p.q_norm = (const float*)d_in[9]; p.k_norm = (const float*)d_in[10]; p.mem_norm = (const float*)d_in[11];
    p.w_mem_kv = (const float*)d_in[12]; p.w_out = (const float*)d_in[13];
    p.out = (float*)d_out; p.ws = (unsigned char*)d_ws;
    p.phase_begin = 0; p.phase_end = 1 + 4 * DEPTH;
    if (ws_size < WS_TOTAL) { fprintf(stderr, "workspace too small: %zu < %zu\n", ws_size, (size_t)WS_TOTAL); return; }
    hipMemsetAsync((unsigned char*)d_ws + OFF_BAR, 0, BAR_BYTES, stream);
    void* args[] = {&p};
    hipError_t e = hipLaunchCooperativeKernel((void*)fwd_megakernel, dim3(grid_blocks), dim3(512), args, 0, stream);
    if (e != hipSuccess) fprintf(stderr, "cooperative launch failed: %s (grid %d)\n", hipGetErrorString(e), grid_blocks);
}
```

```cpp
#include <hip/hip_runtime.h>
#include <hip/hip_cooperative_groups.h>
#include <stdint.h>
#include <cstdio>
namespace cg = cooperative_groups;

typedef unsigned short bf16_t;
typedef short bf16x8 __attribute__((ext_vector_type(8)));
typedef float f32x4 __attribute__((ext_vector_type(4)));
typedef float f32x16 __attribute__((ext_vector_type(16)));
typedef unsigned u32x4 __attribute__((ext_vector_type(4)));
typedef unsigned u32x2 __attribute__((ext_vector_type(2)));
typedef __bf16 bf16x2_t __attribute__((ext_vector_type(2)));
typedef float f32x2_t __attribute__((ext_vector_type(2)));
#define DI __device__ __forceinline__

constexpr int NTOK = 49152;
constexpr int NPROMPT = 32768;
constexpr int DM = 1024;
constexpr int INW = 2304;
constexpr int NMEMTOK = 5120;
constexpr int DEPTH = 2;
constexpr float EPS = 1e-6f;
constexpr float L2E = 1.4426950408889634f;

constexpr size_t OFF_H    = 0;
constexpr size_t OFF_Z    = OFF_H + (size_t)NTOK * DM * 2;
constexpr size_t OFF_VT   = OFF_Z + (size_t)NTOK * INW * 2;
constexpr size_t OFF_MIX  = OFF_VT + (size_t)NTOK * 128 * 2;
constexpr size_t OFF_WIN  = OFF_MIX + (size_t)NTOK * DM * 2;
constexpr size_t OFF_WOUT = OFF_WIN + (size_t)DEPTH * INW * DM * 2;
constexpr size_t OFF_WMEM = OFF_WOUT + (size_t)DEPTH * DM * DM * 2;
constexpr size_t OFF_PW   = OFF_WMEM + (size_t)DEPTH * 512 * DM * 2;
constexpr size_t OFF_MH   = OFF_PW + (size_t)DEPTH * 4 * 64 * 64 * 2;
constexpr size_t OFF_KM   = OFF_MH + (size_t)DEPTH * NMEMTOK * DM * 2;
constexpr size_t OFF_VMT  = OFF_KM + (size_t)DEPTH * NMEMTOK * 256 * 2;
constexpr size_t OFF_ROPE = OFF_VMT + (size_t)DEPTH * NMEMTOK * 256 * 2;
constexpr size_t OFF_BAR  = OFF_ROPE + 64 * 16 * 2 * 4;
constexpr size_t BAR_BYTES = 3456 * 4;
constexpr size_t WS_TOTAL = OFF_BAR + BAR_BYTES;

struct Params {
    const float* x_prompt; const float* x_sample; const float* mem_prompt; const float* mem_sample;
    const float* norm_pre; const float* norm_post; const float* w_in; const float* pool_w; const float* pool_scale;
    const float* q_norm; const float* k_norm; const float* mem_norm; const float* w_mem_kv; const float* w_out;
    float* out; unsigned char* ws;
    int phase_begin; int phase_end;
};

DI unsigned pk_bf16(float a, float b) {
    f32x2_t v = {a, b};
    bf16x2_t r = __builtin_convertvector(v, bf16x2_t);
    return __builtin_bit_cast(unsigned, r);
}
DI int opaque_tid() { int t = threadIdx.x; asm volatile("" : "+v"(t)); return t; }
DI void lds_barrier() { asm volatile("s_waitcnt lgkmcnt(0)\n\ts_barrier" ::: "memory"); }
DI float bflo(unsigned u) { return __uint_as_float(u << 16); }
DI float bfhi(unsigned u) { return __uint_as_float(u & 0xffff0000u); }
template <int CTRL> DI float dppf(float v) { return __uint_as_float(__builtin_amdgcn_update_dpp(0u, __float_as_uint(v), CTRL, 0xf, 0xf, true)); }
DI float x16_add(float v) { auto r = __builtin_amdgcn_permlane16_swap(__float_as_uint(v), __float_as_uint(v), false, false); return __uint_as_float(r[0]) + __uint_as_float(r[1]); }
DI float x32_add(float v) { auto r = __builtin_amdgcn_permlane32_swap(__float_as_uint(v), __float_as_uint(v), false, false); return __uint_as_float(r[0]) + __uint_as_float(r[1]); }
DI float x16_max(float v) { auto r = __builtin_amdgcn_permlane16_swap(__float_as_uint(v), __float_as_uint(v), false, false); return fmaxf(__uint_as_float(r[0]), __uint_as_float(r[1])); }
DI float x32_max(float v) { auto r = __builtin_amdgcn_permlane32_swap(__float_as_uint(v), __float_as_uint(v), false, false); return fmaxf(__uint_as_float(r[0]), __uint_as_float(r[1])); }
DI float wave_sum(float v) {
    v += dppf<0xB1>(v); v += dppf<0x4E>(v); v += dppf<0x141>(v); v += dppf<0x140>(v);
    v = x16_add(v); v = x32_add(v);
    return v;
}
DI float wave_max(float v) {
    v = fmaxf(v, dppf<0xB1>(v)); v = fmaxf(v, dppf<0x4E>(v)); v = fmaxf(v, dppf<0x141>(v)); v = fmaxf(v, dppf<0x140>(v));
    v = x16_max(v); v = x32_max(v);
    return v;
}
DI float xhalf_max(float v) {
    auto r = __builtin_amdgcn_permlane32_swap(__float_as_uint(v), __float_as_uint(v), false, false);
    return fmaxf(__uint_as_float(r[0]), __uint_as_float(r[1]));
}
DI void swap32(unsigned& a, unsigned& b) { auto r = __builtin_amdgcn_permlane32_swap(a, b, false, false); a = r[0]; b = r[1]; }
DI u32x4 o_pair_wide(const f32x16& ov, int gqA, float inv, u32x4 gw) {
    unsigned gax = gw.x, gay = gw.y, gbx = gw.z, gby = gw.w;
    swap32(gax, gbx); swap32(gay, gby);
    const int a = 4 * gqA, b = a + 4;
    unsigned ax = pk_bf16(ov[a] * inv * bflo(gax), ov[a + 1] * inv * bfhi(gax)), ay = pk_bf16(ov[a + 2] * inv * bflo(gay), ov[a + 3] * inv * bfhi(gay));
    unsigned bx = pk_bf16(ov[b] * inv * bflo(gbx), ov[b + 1] * inv * bfhi(gbx)), by = pk_bf16(ov[b + 2] * inv * bflo(gby), ov[b + 3] * inv * bfhi(gby));
    swap32(ax, bx); swap32(ay, by);
    return (u32x4){ax, ay, bx, by};
}
DI float silu_f(float x) { return x * __builtin_amdgcn_rcpf(1.0f + __builtin_amdgcn_exp2f(-x * L2E)); }
DI f32x4 mfma16(bf16x8 a, bf16x8 b, f32x4 c) { return __builtin_amdgcn_mfma_f32_16x16x32_bf16(a, b, c, 0, 0, 0); }
DI f32x16 mfma32(bf16x8 a, bf16x8 b, f32x16 c) { return __builtin_amdgcn_mfma_f32_32x32x16_bf16(a, b, c, 0, 0, 0); }

DI void transpose_tile(const float* __restrict__ src, int ldn, bf16_t* __restrict__ dst, int ldk, int k0, int n0, unsigned char* smem) {
    float* tile = (float*)smem;
    const int tid = opaque_tid();
    __syncthreads();
#pragma unroll
    for (int i = 0; i < 2; ++i) {
        const int id = tid + 512 * i, r = id >> 4, c4 = id & 15;
        const f32x4 v = *(const f32x4*)(src + (size_t)(k0 + r) * ldn + n0 + c4 * 4);
        tile[r * 65 + c4 * 4 + 0] = v[0]; tile[r * 65 + c4 * 4 + 1] = v[1]; tile[r * 65 + c4 * 4 + 2] = v[2]; tile[r * 65 + c4 * 4 + 3] = v[3];
    }
    __syncthreads();
    {
        const int n = tid >> 3, kc = tid & 7;
        float v[8];
#pragma unroll
        for (int j = 0; j < 8; ++j) v[j] = tile[(kc * 8 + j) * 65 + n];
        u32x4 o; o.x = pk_bf16(v[0], v[1]); o.y = pk_bf16(v[2], v[3]); o.z = pk_bf16(v[4], v[5]); o.w = pk_bf16(v[6], v[7]);
        *(u32x4*)(dst + (size_t)(n0 + n) * ldk + k0 + kc * 8) = o;
    }
}

struct RowIn { f32x4 v[4]; };
DI RowIn rms_row_load(const float* __restrict__ src, int lane) {
    RowIn r;
#pragma unroll
    for (int j = 0; j < 2; ++j) { r.v[2 * j] = *(const f32x4*)(src + j * 512 + lane * 8); r.v[2 * j + 1] = *(const f32x4*)(src + j * 512 + lane * 8 + 4); }
    return r;
}
DI void rms_row_finish(const RowIn& in, const float* __restrict__ g, bf16_t* __restrict__ dst, int lane,
                       const float* __restrict__ g2 = nullptr, bf16_t* __restrict__ dst2 = nullptr) {
    f32x4 v[4]; float ss = 0.f;
#pragma unroll
    for (int j = 0; j < 4; ++j) { v[j] = in.v[j]; ss += v[j][0] * v[j][0] + v[j][1] * v[j][1] + v[j][2] * v[j][2] + v[j][3] * v[j][3]; }
    ss = wave_sum(ss);
    const float r = rsqrtf(ss * (1.0f / 1024.0f) + EPS);
#pragma unroll
    for (int j = 0; j < 2; ++j) {
        const f32x4 g0 = *(const f32x4*)(g + j * 512 + lane * 8), g1 = *(const f32x4*)(g + j * 512 + lane * 8 + 4);
        const f32x4 a = v[2 * j], b = v[2 * j + 1];
        u32x4 o;
        o.x = pk_bf16(a[0] * r * g0[0], a[1] * r * g0[1]); o.y = pk_bf16(a[2] * r * g0[2], a[3] * r * g0[3]);
        o.z = pk_bf16(b[0] * r * g1[0], b[1] * r * g1[1]); o.w = pk_bf16(b[2] * r * g1[2], b[3] * r * g1[3]);
        *(u32x4*)(dst + j * 512 + lane * 8) = o;
    }
    if (g2 != nullptr) {
#pragma unroll
        for (int j = 0; j < 2; ++j) {
            const f32x4 g0 = *(const f32x4*)(g2 + j * 512 + lane * 8), g1 = *(const f32x4*)(g2 + j * 512 + lane * 8 + 4);
            const f32x4 a = v[2 * j], b = v[2 * j + 1];
            u32x4 o;
            o.x = pk_bf16(a[0] * r * g0[0], a[1] * r * g0[1]); o.y = pk_bf16(a[2] * r * g0[2], a[3] * r * g0[3]);
            o.z = pk_bf16(b[0] * r * g1[0], b[1] * r * g1[1]); o.w = pk_bf16(b[2] * r * g1[2], b[3] * r * g1[3]);
            *(u32x4*)(dst2 + j * 512 + lane * 8) = o;
        }
    }
}

DI void rope_entry(int idx, float* table) {
    const int n = idx >> 4, pp = idx & 15;
    double fd = 1.0;
    for (int i = 0; i < pp; ++i) fd *= 0.5623413251903491;
    const float f = (float)fd;
    const float a = (float)n * f;
    double r = (double)a;
    const double k = rint(r * 0.15915494309189535);
    r -= k * 6.283185307179586;
    const double r2 = r * r;
    double sn = r, cs = 1.0, ts = r, tc = 1.0;
    for (int i = 1; i <= 16; ++i) {
        tc = -tc * r2 / (double)((2 * i - 1) * (2 * i));
        ts = -ts * r2 / (double)((2 * i) * (2 * i + 1));
        cs += tc; sn += ts;
    }
    table[idx * 2] = (float)cs; table[idx * 2 + 1] = (float)sn;
}

struct EpiArgs {
    bf16_t* C;
    bf16_t* VT;
    const float* qn; const float* kn; const float* rope;
};

DI int g8_lds_byte(int r, int c) { const int st = (r >> 4) * 2 + (c >> 5), rr = r & 15, cc = c & 31, ob = rr * 64 + cc * 2; return st * 1024 + (ob ^ (((ob >> 9) & 1) << 5)); }
DI void g8_stage_rc(int b, int& R, int& C) { const int st = b >> 10, sb = b & 1023, swz = sb ^ (((sb >> 9) & 1) << 5); R = (st >> 1) * 16 + (swz >> 6); C = (st & 1) * 32 + ((swz & 63) >> 1); }

DI void store_T16x32(const f32x4& v0, const f32x4& v1, unsigned char* wl, bf16_t* __restrict__ dst, size_t ld, int fr, int fq, int lane) {
#pragma unroll
    for (int j = 0; j < 4; ++j) {
        *(bf16_t*)(wl + ((4 * fq + j) * 16 + fr) * 2) = (bf16_t)(pk_bf16(v0[j], 0.f) & 0xffffu);
        *(bf16_t*)(wl + ((16 + 4 * fq + j) * 16 + fr) * 2) = (bf16_t)(pk_bf16(v1[j], 0.f) & 0xffffu);
    }
    __builtin_amdgcn_fence(__ATOMIC_RELEASE, "wavefront"); __builtin_amdgcn_wave_barrier(); __builtin_amdgcn_fence(__ATOMIC_ACQUIRE, "wavefront");
    const int d = lane >> 1, hf = lane & 1;
    const u32x4 val = *(const u32x4*)(wl + d * 32 + hf * 16);
    *(u32x4*)(dst + (size_t)d * ld + hf * 8) = val;
    __builtin_amdgcn_fence(__ATOMIC_RELEASE, "wavefront"); __builtin_amdgcn_wave_barrier(); __builtin_amdgcn_fence(__ATOMIC_ACQUIRE, "wavefront");
}

DI const unsigned char* uniform_ptr(const void* p) {
    const unsigned long long v = (unsigned long long)p;
    const unsigned lo = __builtin_amdgcn_readfirstlane((unsigned)v), hi = __builtin_amdgcn_readfirstlane((unsigned)(v >> 32));
    return (const unsigned char*)(((unsigned long long)hi << 32) | lo);
}

template <int MODE>
DI void gemm_tile(const bf16_t* __restrict__ A, const bf16_t* __restrict__ Bt, int m0, int n0, const EpiArgs& e, unsigned char* smem,
                  bool prefetched, const bf16_t* __restrict__ nA, const bf16_t* __restrict__ nB, int nm0, int nn0, bool nperm) {
    constexpr int K = 1024, BK = 64, HALF = 128, HTB = 16384, nt = K / BK;
    const int tid = opaque_tid(), lane = tid & 63, wave = __builtin_amdgcn_readfirstlane(tid >> 6);
    const int wr = wave >> 2, wc = wave & 3, fr = lane & 15, fq = lane >> 4;
    int sR0, sC0, sR1, sC1;
    g8_stage_rc(tid * 16, sR0, sC0); g8_stage_rc(tid * 16 + 8192, sR1, sC1);
    const unsigned so0b = (unsigned)(sR0 * K + sC0) * 2u, so1b = (unsigned)(sR1 * K + sC1) * 2u;
    const bool perm = (MODE == 1) ? true : ((MODE == 2) ? (n0 == 0) : !(n0 >= 512 && n0 < 1152));
    __attribute__((address_space(3))) unsigned char* lds = (__attribute__((address_space(3))) unsigned char*)smem;
#define G8_SA(b, h) (((b) * 2 + (h)) * HTB)
#define G8_SB(b, h) ((4 + (b) * 2 + (h)) * HTB)
#define G8_PERMOFF(SO) ({ const unsigned R_ = (SO) >> 11, rho_ = R_ & 31u, i_ = rho_ & 15u; const unsigned p_ = 8u * (i_ >> 2) + 4u * (rho_ >> 4) + (i_ & 3u); (SO) + (p_ - rho_) * 2048u; })
#define G8_STAGE_B(POFF, BASE, br, kt, PERM) { const unsigned char* g_ = uniform_ptr((BASE) + (size_t)(br) * K + (kt) * BK); \
        const unsigned b0_ = (PERM) ? G8_PERMOFF(so0b) : so0b, b1_ = (PERM) ? G8_PERMOFF(so1b) : so1b; \
        __builtin_amdgcn_global_load_lds((const __attribute__((address_space(1))) unsigned*)(g_ + b0_), (__attribute__((address_space(3))) unsigned*)(lds + (POFF) + tid * 16), 16, 0, 0); \
        __builtin_amdgcn_global_load_lds((const __attribute__((address_space(1))) unsigned*)(g_ + b1_), (__attribute__((address_space(3))) unsigned*)(lds + (POFF) + tid * 16 + 8192), 16, 0, 0); }
#define G8_STAGE(POFF, BASE, br, kt) { const unsigned char* g_ = uniform_ptr((BASE) + (size_t)(br) * K + (kt) * BK); \
        __builtin_amdgcn_global_load_lds((const __attribute__((address_space(1))) unsigned*)(g_ + so0b), (__attribute__((address_space(3))) unsigned*)(lds + (POFF) + tid * 16), 16, 0, 0); \
        __builtin_amdgcn_global_load_lds((const __attribute__((address_space(1))) unsigned*)(g_ + so1b), (__attribute__((address_space(3))) unsigned*)(lds + (POFF) + tid * 16 + 8192), 16, 0, 0); }
    const int lane_off = (fr * 64 + fq * 16) ^ ((fr >> 3) << 5);
    const unsigned ldsA = (unsigned)(size_t)lds + (unsigned)(lane_off + wr * 8192);
    const unsigned ldsB = (unsigned)(size_t)lds + (unsigned)(lane_off + wc * 4096);
#define G8_DSR(dst, addr, OFF) asm volatile("ds_read_b128 %0, %1 offset:" #OFF : "=v"(dst) : "v"(addr))
#define G8_LDA(dst, b, h) { const unsigned a_ = ldsA + G8_SA(b, h); \
        G8_DSR(dst[0][0], a_, 0); G8_DSR(dst[0][1], a_, 1024); G8_DSR(dst[1][0], a_, 2048); G8_DSR(dst[1][1], a_, 3072); \
        G8_DSR(dst[2][0], a_, 4096); G8_DSR(dst[2][1], a_, 5120); G8_DSR(dst[3][0], a_, 6144); G8_DSR(dst[3][1], a_, 7168); }
#define G8_LDB(dst, b, h) { const unsigned a_ = ldsB + G8_SB(b, h); \
        G8_DSR(dst[0][0], a_, 0); G8_DSR(dst[0][1], a_, 1024); G8_DSR(dst[1][0], a_, 2048); G8_DSR(dst[1][1], a_, 3072); }
#define G8_TIE_A(AT) asm volatile("s_waitcnt lgkmcnt(0)" : "+v"(AT[0][0]), "+v"(AT[0][1]), "+v"(AT[1][0]), "+v"(AT[1][1]), "+v"(AT[2][0]), "+v"(AT[2][1]), "+v"(AT[3][0]), "+v"(AT[3][1]) :: "memory")
#define G8_TIE_B(BX) asm volatile("s_waitcnt lgkmcnt(0)" : "+v"(BX[0][0]), "+v"(BX[0][1]), "+v"(BX[1][0]), "+v"(BX[1][1]) :: "memory")
#define G8_MMA(ai, bj, AT, BX) { __builtin_amdgcn_s_setprio(1); \
        _Pragma("unroll") for (int m = 0; m < 4; ++m) _Pragma("unroll") for (int n = 0; n < 2; ++n) _Pragma("unroll") for (int k = 0; k < 2; ++k) \
            acc[ai][bj][m][n] = mfma16(BX[n][k], AT[m][k], acc[ai][bj][m][n]); \
        __builtin_amdgcn_s_setprio(0); }
#define G8_WV(n) asm volatile("s_waitcnt vmcnt(" #n ")" ::: "memory")
#define G8_WL(n) asm volatile("s_waitcnt lgkmcnt(" #n ")" ::: "memory")
#define G8_BAR __builtin_amdgcn_s_barrier()
#define G8_SCHED __builtin_amdgcn_sched_barrier(0)
    f32x4 acc[2][2][4][2];
#pragma unroll
    for (int a = 0; a < 2; ++a)
#pragma unroll
        for (int b = 0; b < 2; ++b)
#pragma unroll
            for (int m = 0; m < 4; ++m)
#pragma unroll
                for (int n = 0; n < 2; ++n) acc[a][b][m][n] = (f32x4){0.f, 0.f, 0.f, 0.f};
    bf16x8 At[4][2], B0[2][2], B1[2][2];
    if (!prefetched) {
        __syncthreads();
        G8_STAGE_B(G8_SB(0, 0), Bt, n0, 0, perm); G8_STAGE(G8_SA(0, 0), A, m0, 0);
        G8_STAGE_B(G8_SB(0, 1), Bt, n0 + HALF, 0, perm); G8_STAGE(G8_SA(0, 1), A, m0 + HALF, 0);
        if (wr == 1) G8_BAR;
        G8_WV(4); G8_BAR;
        G8_STAGE_B(G8_SB(1, 0), Bt, n0, 1, perm); G8_STAGE(G8_SA(1, 0), A, m0, 1); G8_STAGE_B(G8_SB(1, 1), Bt, n0 + HALF, 1, perm);
        G8_WV(6); G8_BAR;
    } else {
        G8_WV(16);
        if (wr == 1) G8_BAR;
        G8_BAR;
        G8_BAR;
    }
    for (int t = 0; t < nt - 2; t += 2) {
        G8_LDB(B0, 0, 0); G8_SCHED; G8_LDA(At, 0, 0); G8_STAGE(G8_SA(1, 1), A, m0 + HALF, t + 1);
        G8_WL(8); G8_BAR; G8_TIE_B(B0); G8_TIE_A(At); G8_MMA(0, 0, At, B0); G8_BAR; G8_SCHED;
        G8_LDB(B1, 0, 1); G8_STAGE_B(G8_SB(0, 0), Bt, n0, t + 2, perm);
        G8_BAR; G8_TIE_B(B1); G8_MMA(0, 1, At, B1); G8_BAR;
        G8_LDA(At, 0, 1); G8_STAGE(G8_SA(0, 0), A, m0, t + 2);
        G8_BAR; G8_TIE_A(At); G8_MMA(1, 0, At, B0); G8_BAR; G8_SCHED;
        G8_STAGE_B(G8_SB(0, 1), Bt, n0 + HALF, t + 2, perm);
        G8_WV(6); G8_BAR; G8_MMA(1, 1, At, B1); G8_BAR;
        G8_LDB(B0, 1, 0); G8_SCHED; G8_LDA(At, 1, 0); G8_STAGE(G8_SA(0, 1), A, m0 + HALF, t + 2);
        G8_WL(8); G8_BAR; G8_TIE_B(B0); G8_TIE_A(At); G8_MMA(0, 0, At, B0); G8_BAR; G8_SCHED;
        G8_LDB(B1, 1, 1); G8_STAGE_B(G8_SB(1, 0), Bt, n0, t + 3, perm);
        G8_BAR; G8_TIE_B(B1); G8_MMA(0, 1, At, B1); G8_BAR;
        G8_LDA(At, 1, 1); G8_STAGE(G8_SA(1, 0), A, m0, t + 3);
        G8_BAR; G8_TIE_A(At); G8_MMA(1, 0, At, B0); G8_BAR; G8_SCHED;
        G8_STAGE_B(G8_SB(1, 1), Bt, n0 + HALF, t + 3, perm);
        G8_WV(6); G8_BAR; G8_MMA(1, 1, At, B1); G8_BAR;
    }
    {
        G8_LDB(B0, 0, 0); G8_LDA(At, 0, 0); G8_STAGE(G8_SA(1, 1), A, m0 + HALF, nt - 1);
        G8_BAR; G8_TIE_B(B0); G8_TIE_A(At); G8_MMA(0, 0, At, B0); G8_BAR;
        G8_LDB(B1, 0, 1); G8_BAR; G8_TIE_B(B1); G8_MMA(0, 1, At, B1); G8_BAR;
        G8_LDA(At, 0, 1); G8_WV(4); G8_BAR; G8_TIE_A(At); G8_MMA(1, 0, At, B0); G8_MMA(1, 1, At, B1); G8_BAR;
    }
    {
        G8_LDB(B0, 1, 0); G8_LDA(At, 1, 0); G8_WV(2); G8_BAR; G8_TIE_B(B0); G8_TIE_A(At); G8_MMA(0, 0, At, B0); G8_BAR;
        G8_LDB(B1, 1, 1); G8_WV(0); G8_BAR; G8_TIE_B(B1); G8_MMA(0, 1, At, B1); G8_BAR;
        G8_LDA(At, 1, 1); G8_BAR; G8_TIE_A(At); G8_MMA(1, 0, At, B0); G8_MMA(1, 1, At, B1); G8_BAR;
    }
    if (wr == 0) G8_BAR;
    if (nA != nullptr) {
        G8_STAGE_B(G8_SB(0, 0), nB, nn0, 0, nperm); G8_STAGE(G8_SA(0, 0), nA, nm0, 0);
        G8_STAGE_B(G8_SB(0, 1), nB, nn0 + HALF, 0, nperm); G8_STAGE(G8_SA(0, 1), nA, nm0 + HALF, 0);
        G8_STAGE_B(G8_SB(1, 0), nB, nn0, 1, nperm); G8_STAGE(G8_SA(1, 0), nA, nm0, 1); G8_STAGE_B(G8_SB(1, 1), nB, nn0 + HALF, 1, nperm);
    }
    __builtin_amdgcn_sched_barrier(0);
#undef G8_SA
#undef G8_SB
#undef G8_STAGE
#undef G8_STAGE_B
#undef G8_PERMOFF
#undef G8_LDA
#undef G8_LDB
#undef G8_DSR
#undef G8_TIE_A
#undef G8_TIE_B
#undef G8_MMA
#undef G8_WV
#undef G8_WL
#undef G8_BAR
#undef G8_SCHED

    const int tid_e = opaque_tid(), wave_e = __builtin_amdgcn_readfirstlane(tid_e >> 6);
    const int wr_e = wave_e >> 2, wc_e = wave_e & 3, fr_e = tid_e & 15, fq_e = (tid_e >> 4) & 3;
    const int tok_w = m0 + wr_e * 64 + fr_e;
    const int col_w = n0 + wc_e * 32 + 4 * fq_e;
    const int col_p = n0 + wc_e * 32 + 8 * fq_e;
    if (MODE == 1) {
#pragma unroll
        for (int ai = 0; ai < 2; ++ai)
#pragma unroll
            for (int m = 0; m < 4; ++m) {
                bf16_t* rowp = e.C + (size_t)(tok_w + ai * 128 + m * 16) * 1024 + col_p;
#pragma unroll
                for (int bj = 0; bj < 2; ++bj) {
                    const f32x4 v0 = acc[ai][bj][m][0], v1 = acc[ai][bj][m][1];
                    u32x4 o; o.x = pk_bf16(v0[0], v0[1]); o.y = pk_bf16(v0[2], v0[3]); o.z = pk_bf16(v1[0], v1[1]); o.w = pk_bf16(v1[2], v1[3]);
                    *(u32x4*)(rowp + bj * 128) = o;
                }
            }
    } else if (MODE == 2) {
        if (n0 == 0) {
#pragma unroll
            for (int ai = 0; ai < 2; ++ai)
#pragma unroll
                for (int m = 0; m < 4; ++m) {
                    bf16_t* rowp = e.C + (size_t)(tok_w + ai * 128 + m * 16) * 256 + col_p;
#pragma unroll
                    for (int bj = 0; bj < 2; ++bj) {
                        const f32x4 v0 = acc[ai][bj][m][0], v1 = acc[ai][bj][m][1];
                        u32x4 o; o.x = pk_bf16(v0[0], v0[1]); o.y = pk_bf16(v0[2], v0[3]); o.z = pk_bf16(v1[0], v1[1]); o.w = pk_bf16(v1[2], v1[3]);
                        *(u32x4*)(rowp + bj * 128) = o;
                    }
                }
        } else {
#pragma unroll
            for (int ai = 0; ai < 2; ++ai)
#pragma unroll
                for (int m = 0; m < 4; ++m) {
                    const int mt0 = m0 + wr_e * 64 + ai * 128 + m * 16, b = mt0 >> 8, mm0 = mt0 & 255;
#pragma unroll
                    for (int bj = 0; bj < 2; ++bj) {
                        const int f0 = bj * 128 + wc_e * 32, hx = f0 >> 6, d0 = f0 & 63;
                        store_T16x32(acc[ai][bj][m][0], acc[ai][bj][m][1], smem + 3 * 16384 + 8192 + wave_e * 1024,
                                     e.VT + ((size_t)(b * 4 + hx) * 64 + d0) * 256 + mm0, 256, fr_e, fq_e, tid_e & 63);
                    }
                }
        }
    } else {
        const bool has_qk = (n0 >= 512 && n0 < 1152);
        float* ssx = (float*)(smem + 3 * 16384);
        if (has_qk) {
#pragma unroll
            for (int ai = 0; ai < 2; ++ai)
#pragma unroll
                for (int bj = 0; bj < 2; ++bj)
#pragma unroll
                    for (int m = 0; m < 4; ++m) {
                        float ss = 0.f;
#pragma unroll
                        for (int n = 0; n < 2; ++n)
#pragma unroll
                            for (int j = 0; j < 4; ++j) ss += acc[ai][bj][m][n][j] * acc[ai][bj][m][n][j];
                        ss = x16_add(ss); ss = x32_add(ss);
                        if (fq_e == 0) ssx[((wave_e * 2 + ai) * 2 + bj) * 64 + m * 16 + fr_e] = ss;
                    }
            __syncthreads();
        }
#pragma unroll
        for (int bj = 0; bj < 2; ++bj) {
            const int cb = n0 + bj * 128 + wc_e * 32;
            const int c64 = cb & ~63;
            if (c64 >= 512 && c64 < 1152) {
                const bool isq = c64 < 1024;
                const float* gn = (isq ? e.qn : e.kn) + (wc_e & 1) * 32 + 4 * fq_e;
                const float osc = isq ? 0.125f * L2E : 1.0f;
                const f32x4 g0 = *(const f32x4*)(gn), g1 = *(const f32x4*)(gn + 16);
#pragma unroll
                for (int ai = 0; ai < 2; ++ai)
#pragma unroll
                    for (int m = 0; m < 4; ++m) {
                        const int tok = tok_w + ai * 128 + m * 16;
                        const float ss = ssx[((wave_e * 2 + ai) * 2 + bj) * 64 + m * 16 + fr_e] + ssx[(((wave_e ^ 1) * 2 + ai) * 2 + bj) * 64 + m * 16 + fr_e];
                        const float rinv = rsqrtf(ss * (1.0f / 64.0f) + EPS);
                        const int t = (tok < NPROMPT) ? (tok & 2047) : (tok & 4095);
                        const int ridx = (wc_e & 1) ? (t & 63) : (t >> 6);
                        const f32x4* rt = (const f32x4*)(e.rope + (ridx * 16 + 4 * fq_e) * 2);
                        const f32x4 r01 = rt[0], r23 = rt[1];
                        const float rc[4] = {r01[0], r01[2], r23[0], r23[2]}, rs[4] = {r01[1], r01[3], r23[1], r23[3]};
                        float oa[4], ob[4];
#pragma unroll
                        for (int j = 0; j < 4; ++j) {
                            const float a = acc[ai][bj][m][0][j] * rinv * g0[j], b = acc[ai][bj][m][1][j] * rinv * g1[j];
                            oa[j] = (a * rc[j] - b * rs[j]) * osc; ob[j] = (b * rc[j] + a * rs[j]) * osc;
                        }
                        unsigned ax = pk_bf16(oa[0], oa[1]), ay = pk_bf16(oa[2], oa[3]), bx = pk_bf16(ob[0], ob[1]), by = pk_bf16(ob[2], ob[3]);
                        { auto r_ = __builtin_amdgcn_permlane16_swap(ax, bx, false, false); ax = r_[0]; bx = r_[1]; }
                        { auto r_ = __builtin_amdgcn_permlane16_swap(ay, by, false, false); ay = r_[0]; by = r_[1]; }
                        bf16_t* rowp = e.C + (size_t)tok * INW + cb + 4 * fq_e + ((fq_e & 1) ? 12 : 0);
                        *(u32x4*)(rowp) = (u32x4){ax, ay, bx, by};
                    }
            } else if (c64 >= 1152 && c64 < 1280) {
#pragma unroll
                for (int ai = 0; ai < 2; ++ai)
#pragma unroll
                    for (int m = 0; m < 4; ++m) {
                        const int tok0 = m0 + wr_e * 64 + ai * 128 + m * 16;
                        const int f0 = cb - 1152, kvh = f0 >> 6, d0 = f0 & 63;
                        bf16_t* bp; size_t T;
                        if (tok0 < NPROMPT) { const int b = tok0 >> 11, t = tok0 & 2047; T = 2048; bp = e.VT + ((size_t)(b * 2 + kvh) * 64 + d0) * 2048 + t; }
                        else { const int b = (tok0 - NPROMPT) >> 12, t = tok0 & 4095; T = 4096; bp = e.VT + (size_t)NPROMPT * 128 + ((size_t)(b * 2 + kvh) * 64 + d0) * 4096 + t; }
                        store_T16x32(acc[ai][bj][m][0], acc[ai][bj][m][1], smem + 3 * 16384 + 8192 + wave_e * 1024, bp, T, fr_e, fq_e, tid_e & 63);
                    }
            } else {
                const int kind = (c64 < 256) ? 0 : ((c64 >= 1792 && c64 < 2048) ? 2 : 1);
#pragma unroll
                for (int ai = 0; ai < 2; ++ai)
#pragma unroll
                    for (int m = 0; m < 4; ++m) {
                        bf16_t* rowp = e.C + (size_t)(tok_w + ai * 128 + m * 16) * INW + cb + 8 * fq_e;
                        float v[8];
#pragma unroll
                        for (int n = 0; n < 2; ++n)
#pragma unroll
                            for (int j = 0; j < 4; ++j) { const float x = acc[ai][bj][m][n][j]; v[4 * n + j] = (kind == 0) ? x : ((kind == 2) ? x * (0.125f * L2E) : silu_f(x)); }
                        u32x4 o; o.x = pk_bf16(v[0], v[1]); o.y = pk_bf16(v[2], v[3]); o.z = pk_bf16(v[4], v[5]); o.w = pk_bf16(v[6], v[7]);
                        *(u32x4*)(rowp) = o;
                    }
            }
        }
    }
}

#define SB_() __builtin_amdgcn_sched_barrier(0)
#define KFRAG(KS, KB) (*(const bf16x8*)(kp + (KB) * 4096 + k_off + ((((KS) * 2 + h) ^ kswz) << 4)))
#define VFRAG(KK, DB) (*(const bf16x8*)(vp + (DB) * 4096 + v_off + ((((KK) * 2 + h) ^ vswz) << 4)))
#define EXP4(S, I0) { _Pragma("unroll") for (int i_ = (I0); i_ < (I0) + 4; ++i_) { S[i_] = __builtin_amdgcn_exp2f(S[i_] - mb); rs += S[i_]; } }
#define EXP4F(S, I0) { f32x2_t a_ = {S[(I0)], S[(I0) + 1]}, b_ = {S[(I0) + 2], S[(I0) + 3]}; \
        a_ = a_ - (f32x2_t){mb, mb}; b_ = b_ - (f32x2_t){mb, mb}; \
        S[(I0)] = __builtin_amdgcn_exp2f(a_.x); S[(I0) + 1] = __builtin_amdgcn_exp2f(a_.y); S[(I0) + 2] = __builtin_amdgcn_exp2f(b_.x); S[(I0) + 3] = __builtin_amdgcn_exp2f(b_.y); \
        rs2 += (f32x2_t){S[(I0)], S[(I0) + 1]} + (f32x2_t){S[(I0) + 2], S[(I0) + 3]}; }
#define EXPQ(S, I0) { if (FIXM) EXP4F(S, I0) else EXP4(S, I0) }
#define PACK8(S, I0) ({ u32x4 t_; t_.x = pk_bf16(S[(I0)], S[(I0) + 1]); t_.y = pk_bf16(S[(I0) + 2], S[(I0) + 3]); t_.z = pk_bf16(S[(I0) + 4], S[(I0) + 5]); t_.w = pk_bf16(S[(I0) + 6], S[(I0) + 7]); __builtin_bit_cast(bf16x8, t_); })
DI float max8(const f32x16& s, int i0, float mx) {
    mx = fmaxf(fmaxf(mx, s[i0]), s[i0 + 1]); mx = fmaxf(fmaxf(mx, s[i0 + 2]), s[i0 + 3]);
    mx = fmaxf(fmaxf(mx, s[i0 + 4]), s[i0 + 5]); mx = fmaxf(fmaxf(mx, s[i0 + 6]), s[i0 + 7]);
    return mx;
}
#define EXP2F(S, I0) { S[(I0)] = __builtin_amdgcn_exp2f(S[(I0)]); S[(I0) + 1] = __builtin_amdgcn_exp2f(S[(I0) + 1]); rs += S[(I0)] + S[(I0) + 1]; \
        asm volatile("" : "+v"(S[(I0)]), "+v"(S[(I0) + 1]), "+v"(rs)); }
#define PIN1(X) asm volatile("" : "+v"(X))
template <bool DO_PV, bool DO_QK>
DI void attn_step_fix(f32x16& s0, f32x16& s1, f32x16& n0, f32x16& n1, const bf16x8 (&pp)[4], bf16x8 (&pc)[4],
                      f32x16& o0, f32x16& o1, const float m, float& lsum, const bf16x8 (&qf)[4],
                      const unsigned char* kp, const unsigned char* vp, int k_off, int kswz, int v_off, int vswz, int h) {
    bf16x8 va0, vb0, va1, vb1, va2, vb2, va3, vb3, ka0, kb0, ka1, kb1, ka2, kb2, ka3, kb3;
    float rs = 0.f;
    if (DO_PV) { va0 = VFRAG(0, 0); vb0 = VFRAG(0, 1); va1 = VFRAG(1, 0); vb1 = VFRAG(1, 1); }
    EXP2F(s0, 0);  if (DO_PV) { o0 = mfma32(va0, pp[0], o0); va2 = VFRAG(2, 0); vb2 = VFRAG(2, 1); }
    EXP2F(s0, 2);  if (DO_PV) { o1 = mfma32(vb0, pp[0], o1); va3 = VFRAG(3, 0); vb3 = VFRAG(3, 1); }
    EXP2F(s0, 4);  if (DO_PV) { o0 = mfma32(va1, pp[1], o0); } if (DO_QK) { ka0 = KFRAG(0, 0); kb0 = KFRAG(0, 1); }
    EXP2F(s0, 6);  if (DO_PV) { o1 = mfma32(vb1, pp[1], o1); } if (DO_QK) { ka1 = KFRAG(1, 0); kb1 = KFRAG(1, 1); }
    EXP2F(s0, 8);  if (DO_PV) { o0 = mfma32(va2, pp[2], o0); }
    EXP2F(s0, 10); if (DO_PV) { o1 = mfma32(vb2, pp[2], o1); } pc[0] = PACK8(s0, 0); PIN1(pc[0]);
    EXP2F(s0, 12); if (DO_PV) { o0 = mfma32(va3, pp[3], o0); }
    EXP2F(s0, 14); if (DO_PV) { o1 = mfma32(vb3, pp[3], o1); }
    EXP2F(s1, 0);  if (DO_QK) { n0 = mfma32(ka0, qf[0], (f32x16){0.f, 0.f, 0.f, 0.f, 0.f, 0.f, 0.f, 0.f, 0.f, 0.f, 0.f, 0.f, 0.f, 0.f, 0.f, 0.f}); ka2 = KFRAG(2, 0); kb2 = KFRAG(2, 1); } pc[1] = PACK8(s0, 8); PIN1(pc[1]);
    EXP2F(s1, 2);  if (DO_QK) { n1 = mfma32(kb0, qf[0], (f32x16){0.f, 0.f, 0.f, 0.f, 0.f, 0.f, 0.f, 0.f, 0.f, 0.f, 0.f, 0.f, 0.f, 0.f, 0.f, 0.f}); ka3 = KFRAG(3, 0); kb3 = KFRAG(3, 1); }
    EXP2F(s1, 4);  if (DO_QK) { n0 = mfma32(ka1, qf[1], n0); }
    EXP2F(s1, 6);  if (DO_QK) { n1 = mfma32(kb1, qf[1], n1); }
    EXP2F(s1, 8);  if (DO_QK) { n0 = mfma32(ka2, qf[2], n0); } pc[2] = PACK8(s1, 0); PIN1(pc[2]);
    EXP2F(s1, 10); if (DO_QK) { n1 = mfma32(kb2, qf[2], n1); }
    EXP2F(s1, 12); if (DO_QK) { n0 = mfma32(ka3, qf[3], n0); }
    EXP2F(s1, 14); if (DO_QK) { n1 = mfma32(kb3, qf[3], n1); } pc[3] = PACK8(s1, 8); PIN1(pc[3]);
    lsum += rs;

}
template <bool DO_PV, bool DO_QK, bool FIXM>
DI void attn_step(f32x16& s0, f32x16& s1, f32x16& n0, f32x16& n1, const bf16x8 (&pp)[4], bf16x8 (&pc)[4],
                  f32x16& o0, f32x16& o1, float& m, float& lsum, const bf16x8 (&qf)[4],
                  const unsigned char* kp, const unsigned char* vp, int k_off, int kswz, int v_off, int vswz, int h) {
    if (FIXM) { attn_step_fix<DO_PV, DO_QK>(s0, s1, n0, n1, pp, pc, o0, o1, m, lsum, qf, kp, vp, k_off, kswz, v_off, vswz, h); return; }
    bf16x8 va0, vb0, va1, vb1, va2, vb2, va3, vb3, ka0, kb0, ka1, kb1, ka2, kb2, ka3, kb3;
    if (DO_PV) { va0 = VFRAG(0, 0); vb0 = VFRAG(0, 1); va1 = VFRAG(1, 0); vb1 = VFRAG(1, 1); }
    float mx = s0[0];
    if (DO_PV) o0 = mfma32(va0, pp[0], o0);
    if (!FIXM) mx = max8(s0, 0, mx);
    SB_();
    if (DO_PV) { o1 = mfma32(vb0, pp[0], o1); va2 = VFRAG(2, 0); vb2 = VFRAG(2, 1); }
    if (!FIXM) mx = max8(s0, 8, mx);
    SB_();
    if (DO_PV) { o0 = mfma32(va1, pp[1], o0); va3 = VFRAG(3, 0); vb3 = VFRAG(3, 1); }
    if (!FIXM) mx = max8(s1, 0, mx);
    SB_();
    if (DO_PV) o1 = mfma32(vb1, pp[1], o1);
    bool need = false; float alpha = 1.0f;
    if (!FIXM) {
        mx = max8(s1, 8, mx);
        mx = xhalf_max(mx);
        need = mx > m + 8.0f;
        const float mnew = need ? mx : m;
        alpha = __builtin_amdgcn_exp2f(m - mnew);
        m = mnew;
    }
    const float mb = m;
    float rs = 0.f; f32x2_t rs2 = {0.f, 0.f};
    SB_();
    if (DO_PV) o0 = mfma32(va2, pp[2], o0);
    if (DO_QK) { ka0 = KFRAG(0, 0); kb0 = KFRAG(0, 1); }
    EXPQ(s0, 0);
    SB_();
    if (DO_PV) o1 = mfma32(vb2, pp[2], o1);
    if (DO_QK) { ka1 = KFRAG(1, 0); kb1 = KFRAG(1, 1); }
    EXPQ(s0, 4);
    SB_();
    if (DO_PV) o0 = mfma32(va3, pp[3], o0);
    EXPQ(s0, 8);
    SB_();
    if (DO_PV) o1 = mfma32(vb3, pp[3], o1);
    EXPQ(s0, 12);
    SB_();
    if (DO_QK) { n0 = mfma32(ka0, qf[0], (f32x16){0.f, 0.f, 0.f, 0.f, 0.f, 0.f, 0.f, 0.f, 0.f, 0.f, 0.f, 0.f, 0.f, 0.f, 0.f, 0.f}); ka2 = KFRAG(2, 0); kb2 = KFRAG(2, 1); }
    EXPQ(s1, 0);
    SB_();
    if (DO_QK) { n1 = mfma32(kb0, qf[0], (f32x16){0.f, 0.f, 0.f, 0.f, 0.f, 0.f, 0.f, 0.f, 0.f, 0.f, 0.f, 0.f, 0.f, 0.f, 0.f, 0.f}); ka3 = KFRAG(3, 0); kb3 = KFRAG(3, 1); }
    EXPQ(s1, 4);
    SB_();
    if (DO_QK) n0 = mfma32(ka1, qf[1], n0);
    EXPQ(s1, 8);
    SB_();
    if (DO_QK) n1 = mfma32(kb1, qf[1], n1);
    EXPQ(s1, 12);
    SB_();
    if (DO_QK) n0 = mfma32(ka2, qf[2], n0);
    pc[0] = PACK8(s0, 0);
    SB_();
    if (DO_QK) n1 = mfma32(kb2, qf[2], n1);
    pc[1] = PACK8(s0, 8);
    SB_();
    if (DO_QK) n0 = mfma32(ka3, qf[3], n0);
    pc[2] = PACK8(s1, 0);
    SB_();
    if (DO_QK) n1 = mfma32(kb3, qf[3], n1);
    pc[3] = PACK8(s1, 8);
    if (FIXM) lsum += rs2.x + rs2.y; else lsum = lsum * alpha + rs;
    SB_();
    if (!FIXM) {
        if (__builtin_amdgcn_ballot_w64(need)) {
#pragma unroll
            for (int i = 0; i < 16; ++i) { o0[i] *= alpha; o1[i] *= alpha; }
        }
    }
}

struct AttnPre { bf16x8 q[4]; u32x4 k0, k1, s0k, s0v; };
DI void attn_prefetch(AttnPre& pre, const bf16_t* __restrict__ Q, const bf16_t* __restrict__ K, const bf16_t* __restrict__ VT, int ldv, int tid) {
    const int lane = tid & 63, wave = tid >> 6, r = lane & 31, h = lane >> 5, lrow = tid >> 3, lc = tid & 7;
    const bf16_t* qp = Q + (size_t)(wave * 32 + r) * INW + h * 8;
#pragma unroll
    for (int ks = 0; ks < 4; ++ks) pre.q[ks] = *(const bf16x8*)(qp + ks * 16);
    const bf16_t* Kg = K + (size_t)lrow * INW + lc * 8;
    pre.k0 = *(const u32x4*)(Kg); pre.k1 = *(const u32x4*)(Kg + (size_t)64 * INW); pre.s0k = *(const u32x4*)(Kg + (size_t)128 * INW);
    pre.s0v = *(const u32x4*)(VT + (size_t)lrow * ldv + lc * 8);
}

template <bool FIXM>
DI void attn_item(const bf16_t* __restrict__ Q, int ldq, const bf16_t* __restrict__ K, int ldk, const bf16_t* __restrict__ VT, int ldv,
                  int nkeys, bf16_t* __restrict__ O, const bf16_t* __restrict__ G, unsigned char* smem, float mfix,
                  AttnPre& pre, const bf16_t* __restrict__ nQ, const bf16_t* __restrict__ nK, const bf16_t* __restrict__ nVT, int nldv) {
    const int tid = opaque_tid(), lane = tid & 63, wave = tid >> 6;
    const int r = lane & 31, h = lane >> 5;
    bf16x8 qf[4];
#pragma unroll
    for (int ks = 0; ks < 4; ++ks) qf[ks] = pre.q[ks];
    const int lrow = tid >> 3, lc = tid & 7;
    const bf16_t* Kg = K + (size_t)lrow * ldk + lc * 8;
    const bf16_t* Vg = VT + (size_t)lrow * ldv + lc * 8;
    const int st_off = lrow * 128 + ((lc ^ ((lrow >> 1) & 7)) << 4);
    const int pr = (r & ~12) | ((r & 4) << 1) | ((r & 8) >> 1);
    const int kswz = (pr >> 1) & 7, vswz = (r >> 1) & 7;
    const int k_off = pr * 128, v_off = r * 128;
    const int nt = nkeys >> 6;

    f32x16 o0, o1, sa0, sa1, sb0, sb1;
#pragma unroll
    for (int i = 0; i < 16; ++i) { o0[i] = 0.f; o1[i] = 0.f; }
    float m = FIXM ? mfix : -1e30f, lsum = 0.f;
    bf16x8 pa[4], pb[4];

    u32x4 rk, rv;
#define A_LOAD(U) { const int kt_ = ((U) + 2 < nt) ? (U) + 2 : nt - 1; rk = *(const u32x4*)(Kg + (size_t)(kt_ * 64) * ldk); rv = *(const u32x4*)(Vg + (U) * 64); }
#define A_STORE(OFF) { *(u32x4*)(smem + (OFF) + st_off) = rk; *(u32x4*)(smem + (OFF) + 8192 + st_off) = rv; }
    lds_barrier();
    *(u32x4*)(smem + 16384 + st_off) = pre.k0; *(u32x4*)(smem + 16384 + 8192 + st_off) = pre.k1;
    *(u32x4*)(smem + st_off) = pre.s0k; *(u32x4*)(smem + 8192 + st_off) = pre.s0v;
    A_LOAD(1);
    lds_barrier();
    {
        const unsigned char* kp = smem + 16384;
        sa0 = mfma32(KFRAG(0, 0), qf[0], (f32x16){0.f, 0.f, 0.f, 0.f, 0.f, 0.f, 0.f, 0.f, 0.f, 0.f, 0.f, 0.f, 0.f, 0.f, 0.f, 0.f});
        sa1 = mfma32(KFRAG(0, 1), qf[0], (f32x16){0.f, 0.f, 0.f, 0.f, 0.f, 0.f, 0.f, 0.f, 0.f, 0.f, 0.f, 0.f, 0.f, 0.f, 0.f, 0.f});
#pragma unroll
        for (int ks = 1; ks < 4; ++ks) { sa0 = mfma32(KFRAG(ks, 0), qf[ks], sa0); sa1 = mfma32(KFRAG(ks, 1), qf[ks], sa1); }
    }
    attn_step<false, true, FIXM>(sa0, sa1, sb0, sb1, pb, pa, o0, o1, m, lsum, qf, smem + 16384 + 8192, smem, k_off, kswz, v_off, vswz, h);
    lds_barrier();
    for (int t = 1; t < nt - 1; t += 2) {
        A_STORE(16384);
        A_LOAD(t + 1);
        SB_();
        attn_step<true, true, FIXM>(sb0, sb1, sa0, sa1, pa, pb, o0, o1, m, lsum, qf, smem, smem + 8192, k_off, kswz, v_off, vswz, h);
        lds_barrier();
        A_STORE(0);
        A_LOAD(t + 2);
        SB_();
        attn_step<true, true, FIXM>(sa0, sa1, sb0, sb1, pb, pa, o0, o1, m, lsum, qf, smem + 16384, smem + 16384 + 8192, k_off, kswz, v_off, vswz, h);
        lds_barrier();
    }
    A_STORE(16384);
    const bf16_t* gp = G + (size_t)(wave * 32 + r) * INW + 8 * h;
    u32x4 gw[4];
#pragma unroll
    for (int pp = 0; pp < 4; ++pp) gw[pp] = *(const u32x4*)(gp + 16 * pp);
    attn_prefetch(pre, nQ, nK, nVT, nldv, tid);
    SB_();
    attn_step<true, false, FIXM>(sb0, sb1, sa0, sa1, pa, pb, o0, o1, m, lsum, qf, smem, smem + 8192, k_off, kswz, v_off, vswz, h);
    lds_barrier();
    {
        const unsigned char* vp = smem + 16384 + 8192;
#pragma unroll
        for (int kk = 0; kk < 4; ++kk) { o0 = mfma32(VFRAG(kk, 0), pb[kk], o0); o1 = mfma32(VFRAG(kk, 1), pb[kk], o1); }
    }
#undef A_LOAD
#undef A_STORE
    const float lt = x32_add(lsum);
    const float inv = 1.0f / lt;
    bf16_t* op = O + (size_t)(wave * 32 + r) * 1024 + 8 * h;
    *(u32x4*)(op) = o_pair_wide(o0, 0, inv, gw[0]);
    *(u32x4*)(op + 16) = o_pair_wide(o0, 2, inv, gw[1]);
    *(u32x4*)(op + 32) = o_pair_wide(o1, 0, inv, gw[2]);
    *(u32x4*)(op + 48) = o_pair_wide(o1, 2, inv, gw[3]);
}

DI void cross_item(const bf16_t* __restrict__ Q, const bf16_t* __restrict__ K, const bf16_t* __restrict__ VT,
                   bf16_t* __restrict__ O, const bf16_t* __restrict__ G, unsigned char* smem) {
    const int tid = opaque_tid(), lane = tid & 63, wave = tid >> 6;
    const int r = lane & 31, h = lane >> 5;
    bf16x8 qf[4];
    {
        const bf16_t* qp = Q + (size_t)(wave * 32 + r) * INW + h * 8;
#pragma unroll
        for (int ks = 0; ks < 4; ++ks) qf[ks] = *(const bf16x8*)(qp + ks * 16);
    }
    const int lrow = tid >> 3, lc = tid & 7;
    const int st_off = lrow * 128 + ((lc ^ ((lrow >> 1) & 7)) << 4);
    {
        u32x4 kk[4], vv[4];
#pragma unroll
        for (int i = 0; i < 4; ++i) { kk[i] = *(const u32x4*)(K + (size_t)(lrow + 64 * i) * 256 + lc * 8); vv[i] = *(const u32x4*)(VT + (size_t)lrow * 256 + (i * 8 + lc) * 8); }
        __syncthreads();
#pragma unroll
        for (int i = 0; i < 4; ++i) { *(u32x4*)(smem + i * 16384 + st_off) = kk[i]; *(u32x4*)(smem + i * 16384 + 8192 + st_off) = vv[i]; }
    }
    const bf16_t* gp = G + (size_t)(wave * 32 + r) * INW + 8 * h;
    u32x4 gw[4];
#pragma unroll
    for (int pp = 0; pp < 4; ++pp) gw[pp] = *(const u32x4*)(gp + 16 * pp);
    __syncthreads();
    const int pr = (r & ~12) | ((r & 4) << 1) | ((r & 8) >> 1);
    const int kswz = (pr >> 1) & 7, vswz = (r >> 1) & 7;
    const int k_off = pr * 128, v_off = r * 128;
    f32x16 o0, o1;
#pragma unroll
    for (int i = 0; i < 16; ++i) { o0[i] = 0.f; o1[i] = 0.f; }
    float m = -1e30f, lsum = 0.f;
#pragma unroll
    for (int kt = 0; kt < 4; ++kt) {
        const unsigned char* kp = smem + kt * 16384;
        const unsigned char* vp = kp + 8192;
        f32x16 s0, s1;
        s0 = mfma32(KFRAG(0, 0), qf[0], (f32x16){0.f, 0.f, 0.f, 0.f, 0.f, 0.f, 0.f, 0.f, 0.f, 0.f, 0.f, 0.f, 0.f, 0.f, 0.f, 0.f});
        s1 = mfma32(KFRAG(0, 1), qf[0], (f32x16){0.f, 0.f, 0.f, 0.f, 0.f, 0.f, 0.f, 0.f, 0.f, 0.f, 0.f, 0.f, 0.f, 0.f, 0.f, 0.f});
#pragma unroll
        for (int ks = 1; ks < 4; ++ks) { s0 = mfma32(KFRAG(ks, 0), qf[ks], s0); s1 = mfma32(KFRAG(ks, 1), qf[ks], s1); }
        float mx = s0[0];
        mx = max8(s0, 0, mx); mx = max8(s0, 8, mx); mx = max8(s1, 0, mx); mx = max8(s1, 8, mx);
        mx = xhalf_max(mx);
        const float mnew = fmaxf(m, mx);
        const float alpha = __builtin_amdgcn_exp2f(m - mnew);
        m = mnew;
        const float mb = mnew;
        float rs = 0.f;
#pragma unroll
        for (int i = 0; i < 16; ++i) { s0[i] = __builtin_amdgcn_exp2f(s0[i] - mb); s1[i] = __builtin_amdgcn_exp2f(s1[i] - mb); rs += s0[i] + s1[i]; }
        lsum = lsum * alpha + rs;
#pragma unroll
        for (int i = 0; i < 16; ++i) { o0[i] *= alpha; o1[i] *= alpha; }
        bf16x8 pf[4];
        pf[0] = PACK8(s0, 0); pf[1] = PACK8(s0, 8); pf[2] = PACK8(s1, 0); pf[3] = PACK8(s1, 8);
#pragma unroll
        for (int kk2 = 0; kk2 < 4; ++kk2) { o0 = mfma32(VFRAG(kk2, 0), pf[kk2], o0); o1 = mfma32(VFRAG(kk2, 1), pf[kk2], o1); }
    }
    const float lt = x32_add(lsum);
    const float inv = 1.0f / lt;
    bf16_t* op = O + (size_t)(wave * 32 + r) * 1024 + 8 * h;
    *(u32x4*)(op) = o_pair_wide(o0, 0, inv, gw[0]);
    *(u32x4*)(op + 16) = o_pair_wide(o0, 2, inv, gw[1]);
    *(u32x4*)(op + 32) = o_pair_wide(o1, 0, inv, gw[2]);
    *(u32x4*)(op + 48) = o_pair_wide(o1, 2, inv, gw[3]);
}

template <int HALF>
DI void pool_window(bf16x8 (&df)[2], const unsigned char* smem, int ti, int r16, int q4, int g, int t0, int T) {
    constexpr int RS = 528;
#pragma unroll
    for (int ks = 0; ks < 2; ++ks) {
        const int tl = ti * 16 + r16, t = t0 + tl;
        const int lo = max(t - HALF, 0), hi = min(t + HALF, T);
        const float icnt = 1.0f / (float)(hi - lo);
        float s[8];
#pragma unroll
        for (int j = 0; j < 8; ++j) s[j] = 0.f;
        const unsigned char* bp = smem + (tl + 8 - HALF) * RS + (g * 64 + ks * 32 + q4 * 8) * 2;
#pragma unroll
        for (int j = 0; j < 2 * HALF; ++j) {
            const u32x4 v = *(const u32x4*)(bp + j * RS);
            s[0] += bflo(v.x); s[1] += bfhi(v.x); s[2] += bflo(v.y); s[3] += bfhi(v.y);
            s[4] += bflo(v.z); s[5] += bfhi(v.z); s[6] += bflo(v.w); s[7] += bfhi(v.w);
        }
        const u32x4 c = *(const u32x4*)(bp + HALF * RS);
        u32x4 o;
        o.x = pk_bf16(s[0] * icnt - bflo(c.x), s[1] * icnt - bfhi(c.x));
        o.y = pk_bf16(s[2] * icnt - bflo(c.y), s[3] * icnt - bfhi(c.y));
        o.z = pk_bf16(s[4] * icnt - bflo(c.z), s[5] * icnt - bfhi(c.z));
        o.w = pk_bf16(s[6] * icnt - bflo(c.w), s[7] * icnt - bfhi(c.w));
        df[ks] = __builtin_bit_cast(bf16x8, o);
    }
}

struct PoolPre { u32x4 u[5]; u32x4 gg[2][2]; };
DI void pool_prefetch(PoolPre& pp, const bf16_t* __restrict__ Z, int tokg0, int tid) {
    const int lane = tid & 63, wave = tid >> 6, ti = wave & 3, gp = wave >> 2, r16 = lane & 15, q4 = lane >> 4;
    const int T = (tokg0 < NPROMPT) ? 2048 : 4096, t0 = tokg0 & (T - 1);
#pragma unroll
    for (int k = 0; k < 5; ++k) {
        const int id = tid + 512 * k, rr = id >> 5, c = id & 31, t = t0 - 8 + rr;
        u32x4 v = (u32x4){0u, 0u, 0u, 0u};
        if (t >= 0 && t < T) v = *(const u32x4*)(Z + (size_t)(tokg0 - 8 + rr) * INW + c * 8);
        pp.u[k] = v;
    }
#pragma unroll
    for (int s = 0; s < 2; ++s) {
        const int g = s ? (gp ? 2 : 3) : (gp ? 1 : 0);
#pragma unroll
        for (int pr = 0; pr < 2; ++pr)
            pp.gg[s][pr] = *(const u32x4*)(Z + ((size_t)tokg0 + ti * 16 + r16) * INW + 256 + g * 64 + pr * 32 + 8 * q4);
    }
}
DI void pool_phase(const bf16_t* __restrict__ Z, const bf16_t* __restrict__ PWT, const float* __restrict__ pscale, bf16_t* __restrict__ MIX,
                   int bid, int nb, unsigned char* smem) {
    if (bid >= 768) return;
    const int tid = opaque_tid(), lane = tid & 63, wave = tid >> 6;
    constexpr int RS = 528;
    const int ti = wave & 3, gp = wave >> 2, r16 = lane & 15, q4 = lane >> 4;
    const int g0 = gp ? 1 : 0, g1 = gp ? 2 : 3;
    bf16x8 wfr[2][4][2]; f32x4 psr[2][4];
#pragma unroll
    for (int s = 0; s < 2; ++s) {
        const int g = s ? g1 : g0;
#pragma unroll
        for (int fi = 0; fi < 4; ++fi) {
            const int nrow = 32 * (fi >> 1) + 8 * (r16 >> 2) + 4 * (fi & 1) + (r16 & 3);
#pragma unroll
            for (int ks = 0; ks < 2; ++ks) wfr[s][fi][ks] = *(const bf16x8*)(PWT + (size_t)g * 4096 + nrow * 64 + ks * 32 + q4 * 8);
            psr[s][fi] = *(const f32x4*)(pscale + g * 64 + 32 * (fi >> 1) + 8 * q4 + 4 * (fi & 1));
        }
    }
    PoolPre pp;
    pool_prefetch(pp, Z, bid * 64, tid);
    for (int i = bid; i < 768; i += nb) {
        const int tokg0 = i * 64;
        const int T = (tokg0 < NPROMPT) ? 2048 : 4096, t0 = tokg0 & (T - 1);
        lds_barrier();
#pragma unroll
        for (int k = 0; k < 5; ++k) { const int id = tid + 512 * k, rr = id >> 5, c = id & 31; *(u32x4*)(smem + rr * RS + c * 16) = pp.u[k]; }
        u32x4 gcur[2][2];
#pragma unroll
        for (int s = 0; s < 2; ++s) { gcur[s][0] = pp.gg[s][0]; gcur[s][1] = pp.gg[s][1]; }
        pool_prefetch(pp, Z, ((i + nb < 768) ? i + nb : i) * 64, tid);
        lds_barrier();
        const size_t tok = (size_t)tokg0 + ti * 16 + r16;
#pragma unroll
        for (int s = 0; s < 2; ++s) {
            const int g = s ? g1 : g0;
            bf16x8 df[2];
            if (gp == 0) { if (s == 0) pool_window<1>(df, smem, ti, r16, q4, g, t0, T); else pool_window<8>(df, smem, ti, r16, q4, g, t0, T); }
            else         { if (s == 0) pool_window<2>(df, smem, ti, r16, q4, g, t0, T); else pool_window<4>(df, smem, ti, r16, q4, g, t0, T); }
            f32x4 acc[4];
#pragma unroll
            for (int a = 0; a < 4; ++a) acc[a] = (f32x4){0.f, 0.f, 0.f, 0.f};
#pragma unroll
            for (int fi = 0; fi < 4; ++fi)
#pragma unroll
                for (int ks = 0; ks < 2; ++ks) acc[fi] = mfma16(wfr[s][fi][ks], df[ks], acc[fi]);
#pragma unroll
            for (int pr = 0; pr < 2; ++pr) {
                const u32x4 gg = gcur[s][pr];
                const f32x4 a = acc[2 * pr], b = acc[2 * pr + 1], pa = psr[s][2 * pr], pb = psr[s][2 * pr + 1];
                u32x4 w;
                w.x = pk_bf16(a[0] * pa[0] * bflo(gg.x), a[1] * pa[1] * bfhi(gg.x)); w.y = pk_bf16(a[2] * pa[2] * bflo(gg.y), a[3] * pa[3] * bfhi(gg.y));
                w.z = pk_bf16(b[0] * pb[0] * bflo(gg.z), b[1] * pb[1] * bfhi(gg.z)); w.w = pk_bf16(b[2] * pb[2] * bflo(gg.w), b[3] * pb[3] * bfhi(gg.w));
                *(u32x4*)(MIX + tok * 1024 + g * 64 + pr * 32 + 8 * q4) = w;
            }
        }
    }
}

struct PostIn { u32x4 yv[2]; f32x4 xv[4]; };
DI PostIn post_row_load(const float* __restrict__ xsrc, const bf16_t* __restrict__ yh, int lane) {
    PostIn r;
#pragma unroll
    for (int j = 0; j < 2; ++j) r.yv[j] = *(const u32x4*)(yh + j * 512 + lane * 8);
#pragma unroll
    for (int j = 0; j < 2; ++j) { r.xv[2 * j] = *(const f32x4*)(xsrc + j * 512 + lane * 8); r.xv[2 * j + 1] = *(const f32x4*)(xsrc + j * 512 + lane * 8 + 4); }
    return r;
}
DI void post_row_finish(const PostIn& in, bf16_t* __restrict__ yh, const float* __restrict__ gpost, const float* __restrict__ gpre_next,
                        float* __restrict__ xdst, bool last, int lane) {
    u32x4 yv[2]; f32x4 xv[4];
#pragma unroll
    for (int j = 0; j < 2; ++j) yv[j] = in.yv[j];
#pragma unroll
    for (int j = 0; j < 4; ++j) xv[j] = in.xv[j];
    float y[16];
#pragma unroll
    for (int j = 0; j < 2; ++j) {
        y[8 * j + 0] = bflo(yv[j].x); y[8 * j + 1] = bfhi(yv[j].x); y[8 * j + 2] = bflo(yv[j].y); y[8 * j + 3] = bfhi(yv[j].y);
        y[8 * j + 4] = bflo(yv[j].z); y[8 * j + 5] = bfhi(yv[j].z); y[8 * j + 6] = bflo(yv[j].w); y[8 * j + 7] = bfhi(yv[j].w);
    }
    float ss = 0.f;
#pragma unroll
    for (int i = 0; i < 16; ++i) ss += y[i] * y[i];
    ss = wave_sum(ss);
    const float r = rsqrtf(ss * (1.0f / 1024.0f) + EPS);
    float xn[16]; float ss2 = 0.f;
#pragma unroll
    for (int j = 0; j < 2; ++j) {
        const f32x4 g0 = *(const f32x4*)(gpost + j * 512 + lane * 8), g1 = *(const f32x4*)(gpost + j * 512 + lane * 8 + 4);
#pragma unroll
        for (int i = 0; i < 4; ++i) {
            xn[8 * j + i] = xv[2 * j][i] + y[8 * j + i] * r * g0[i];
            xn[8 * j + 4 + i] = xv[2 * j + 1][i] + y[8 * j + 4 + i] * r * g1[i];
        }
    }
#pragma unroll
    for (int i = 0; i < 16; ++i) ss2 += xn[i] * xn[i];
#pragma unroll
    for (int j = 0; j < 2; ++j) {
        *(f32x4*)(xdst + j * 512 + lane * 8) = (f32x4){xn[8 * j], xn[8 * j + 1], xn[8 * j + 2], xn[8 * j + 3]};
        *(f32x4*)(xdst + j * 512 + lane * 8 + 4) = (f32x4){xn[8 * j + 4], xn[8 * j + 5], xn[8 * j + 6], xn[8 * j + 7]};
    }
    if (!last) {
        ss2 = wave_sum(ss2);
        const float r2 = rsqrtf(ss2 * (1.0f / 1024.0f) + EPS);
#pragma unroll
        for (int j = 0; j < 2; ++j) {
            const f32x4 g0 = *(const f32x4*)(gpre_next + j * 512 + lane * 8), g1 = *(const f32x4*)(gpre_next + j * 512 + lane * 8 + 4);
            u32x4 o;
            o.x = pk_bf16(xn[8 * j] * r2 * g0[0], xn[8 * j + 1] * r2 * g0[1]);
            o.y = pk_bf16(xn[8 * j + 2] * r2 * g0[2], xn[8 * j + 3] * r2 * g0[3]);
            o.z = pk_bf16(xn[8 * j + 4] * r2 * g1[0], xn[8 * j + 5] * r2 * g1[1]);
            o.w = pk_bf16(xn[8 * j + 6] * r2 * g1[2], xn[8 * j + 7] * r2 * g1[3]);
            *(u32x4*)(yh + j * 512 + lane * 8) = o;
        }
    }
}

#define XB_TMO      128
#define XB_XCNT(j)  (256  + 64 * (j))
#define XB_XSUB(j)  (1280 + 64 * (j))
#define XB_XGEN(j)  (2304 + 64 * (j))
#define XB_TOP      3328
#define XB_TOPGEN   3392
#define XCD_BAR_WORDS 3456
#define XB_SPIN_CAP (1u << 18)
#define LAS __attribute__((address_space(3)))
DI unsigned xb_ld(unsigned* p)              { return __hip_atomic_load(p, __ATOMIC_RELAXED, __HIP_MEMORY_SCOPE_AGENT); }
DI unsigned xb_add(unsigned* p, unsigned v) { return __hip_atomic_fetch_add(p, v, __ATOMIC_RELAXED, __HIP_MEMORY_SCOPE_AGENT); }
DI unsigned xb_xcc_id() { return (unsigned)__builtin_amdgcn_s_getreg((3 << 11) | 20) & 0xFu; }
#define XB_SPIN(cond, bar) do { unsigned _sp = 0; while (cond) { __builtin_amdgcn_s_sleep(1); \
    if ((++_sp & 255u) == 0u) { if (xb_ld(&(bar)[XB_TMO])) break; if (_sp > XB_SPIN_CAP) { atomicAdd(&(bar)[XB_TMO], 1u); break; } } } } while (0)
struct XcdBarrier { unsigned* bar; unsigned x; volatile LAS unsigned* st; };
DI XcdBarrier xcd_barrier_post(unsigned* bar, volatile LAS unsigned* st) {
    XcdBarrier b; b.bar = bar; b.x = xb_xcc_id(); b.st = st;
    if (threadIdx.x == 0) (void)xb_add(&bar[XB_XCNT(b.x)], 1u);
    return b;
}
DI void xcd_barrier_complete(unsigned* bar, unsigned x, unsigned& nloc, unsigned& nx) {
    const unsigned G = gridDim.x * gridDim.y * gridDim.z;
    unsigned sum, cnt, mine, sp = 0u;
    for (;;) {
        sum = 0u; cnt = 0u; mine = 0u;
#pragma unroll
        for (unsigned j = 0; j < 16; ++j) { const unsigned c = xb_ld(&bar[XB_XCNT(j)]); sum += c; cnt += (c > 0u) ? 1u : 0u; mine = (j == x) ? c : mine; }
        if (sum == G) break;
        __builtin_amdgcn_s_sleep(1);
        if ((++sp & 255u) == 0u) { if (xb_ld(&bar[XB_TMO])) break; if (sp > XB_SPIN_CAP) { atomicAdd(&bar[XB_TMO], 1u); break; } }
    }
    nloc = mine > 0u ? mine : 1u; nx = cnt > 0u ? cnt : 1u;
}
DI void xcd_barrier(const XcdBarrier& b) {
    asm volatile("s_waitcnt vmcnt(0)" ::: "memory");
    __syncthreads();
    if (threadIdx.x == 0) {
        unsigned* bar = b.bar;
        __builtin_amdgcn_s_waitcnt(0);
        unsigned nloc = b.st[0], nx = b.st[1];
        if (nloc == 0u) { xcd_barrier_complete(bar, b.x, nloc, nx); b.st[0] = nloc; b.st[1] = nx; }
        const unsigned old = xb_add(&bar[XB_XSUB(b.x)], 1u);
        const unsigned gen = old / nloc;
        if (old + 1u == (gen + 1u) * nloc) {
            __builtin_amdgcn_fence(__ATOMIC_RELEASE, "agent");
            asm volatile("s_waitcnt vmcnt(0)" ::: "memory");
            const unsigned og = xb_add(&bar[XB_TOP], 1u);
            const unsigned tg = og / nx;
            if (og + 1u == (tg + 1u) * nx) xb_add(&bar[XB_TOPGEN], 1u);
            else XB_SPIN(xb_ld(&bar[XB_TOPGEN]) == tg, bar);
            __builtin_amdgcn_fence(__ATOMIC_ACQUIRE, "agent");
            xb_add(&bar[XB_XGEN(b.x)], 1u);
            asm volatile("s_waitcnt vmcnt(0)" ::: "memory");
        } else {
            XB_SPIN(xb_ld(&bar[XB_XGEN(b.x)]) == gen, bar);
            __builtin_amdgcn_fence(__ATOMIC_ACQUIRE, "agent");
            asm volatile("s_waitcnt vmcnt(0)" ::: "memory");
        }
    }
    __syncthreads();
}

__global__ void __launch_bounds__(512, 2) fwd_megakernel(Params p) {
    __shared__ __attribute__((aligned(16))) unsigned char smem[131072];
    __shared__ uint4 xb_words;
    cg::grid_group grid = cg::this_grid();
    const int nb = gridDim.x, bid = blockIdx.x;
    if (threadIdx.x == 0) xb_words = make_uint4(0u, 0u, 0u, 0u);
    __syncthreads();
    XcdBarrier xb = xcd_barrier_post((unsigned*)(p.ws + OFF_BAR), (volatile LAS unsigned*)&xb_words);
    if (p.phase_end > 1000) grid.sync();
    for (int ph = p.phase_begin; ph < p.phase_end; ++ph) {
        unsigned char* ws = p.ws;
        bf16_t* H = (bf16_t*)(ws + OFF_H);
        bf16_t* Z = (bf16_t*)(ws + OFF_Z);
        bf16_t* VT = (bf16_t*)(ws + OFF_VT);
        bf16_t* MIX = (bf16_t*)(ws + OFF_MIX);
        bf16_t* WIN = (bf16_t*)(ws + OFF_WIN);
        bf16_t* WOUT = (bf16_t*)(ws + OFF_WOUT);
        bf16_t* WMEM = (bf16_t*)(ws + OFF_WMEM);
        bf16_t* PW = (bf16_t*)(ws + OFF_PW);
        bf16_t* MH = (bf16_t*)(ws + OFF_MH);
        bf16_t* KM = (bf16_t*)(ws + OFF_KM);
        bf16_t* VMT = (bf16_t*)(ws + OFF_VMT);
        float* ROPE = (float*)(ws + OFF_ROPE);
        if (ph == 0) {
            for (int i = bid; i < 1928; i += nb) {
                if (i < 1152) { const int l = i / 576, j = i % 576, kt = j / 36, ntile = j % 36;
                    transpose_tile(p.w_in + (size_t)l * DM * INW, INW, WIN + (size_t)l * INW * DM, DM, kt * 64, ntile * 64, smem);
                } else if (i < 1664) { const int ii = i - 1152, l = ii / 256, j = ii % 256, kt = j / 16, ntile = j % 16;
                    transpose_tile(p.w_out + (size_t)l * DM * DM, DM, WOUT + (size_t)l * DM * DM, DM, kt * 64, ntile * 64, smem);
                } else if (i < 1920) { const int ii = i - 1664, l = ii / 128, j = ii % 128, kt = j / 8, ntile = j % 8;
                    transpose_tile(p.w_mem_kv + (size_t)l * DM * 512, 512, WMEM + (size_t)l * 512 * DM, DM, kt * 64, ntile * 64, smem);
                } else { const int ii = i - 1920;
                    transpose_tile(p.pool_w + (size_t)ii * 4096, 64, PW + (size_t)ii * 4096, 64, 0, 0, smem);
                }
            }
            {
                const int tid = opaque_tid(), lane = tid & 63, wave = tid >> 6;
                constexpr int NR = NTOK + NMEMTOK;
                auto desc = [&](int i, const float*& src, const float*& g, bf16_t*& dst, const float*& gb, bf16_t*& dstb) {
                    if (i < NTOK) { src = (i < NPROMPT) ? p.x_prompt + (size_t)i * DM : p.x_sample + (size_t)(i - NPROMPT) * DM; g = p.norm_pre; dst = H + (size_t)i * DM; gb = nullptr; dstb = nullptr; }
                    else { const int mt = i - NTOK;
                           src = (mt < 4096) ? p.mem_prompt + (size_t)mt * DM : p.mem_sample + (size_t)(mt - 4096) * DM;
                           g = p.mem_norm; dst = MH + (size_t)mt * DM; gb = p.mem_norm + DM; dstb = MH + ((size_t)NMEMTOK + mt) * DM; }
                };
                int i = bid * 8 + wave;
                if (i < NR) {
                    const float *s, *g, *gb; bf16_t *d, *db; desc(i, s, g, d, gb, db);
                    RowIn cur = rms_row_load(s, lane);
                    for (; i < NR; i += nb * 8) {
                        const int in = (i + nb * 8 < NR) ? i + nb * 8 : NR - 1;
                        const float *s2, *g2, *gb2; bf16_t *d2, *db2; desc(in, s2, g2, d2, gb2, db2);
                        const RowIn nxt = rms_row_load(s2, lane);
                        rms_row_finish(cur, g, d, lane, gb, db);
                        cur = nxt; g = g2; d = d2; gb = gb2; db = db2;
                    }
                }
            }
            { const int tid = opaque_tid(); for (int i = bid * 512 + tid; i < 1024; i += nb * 512) rope_entry(i, ROPE); }
        } else {
            const int l = (ph - 1) >> 2, sub = (ph - 1) & 3;
            if (sub == 0) {
                EpiArgs e; e.C = Z; e.VT = VT; e.qn = p.q_norm + l * 64; e.kn = p.k_norm + l * 64; e.rope = ROPE;
                const bf16_t* Wl = WIN + (size_t)l * INW * DM;
                EpiArgs e2; e2.C = KM + (size_t)l * NMEMTOK * 256; e2.VT = VMT + (size_t)l * NMEMTOK * 256; e2.qn = nullptr; e2.kn = nullptr; e2.rope = nullptr;
                const bf16_t* Wm = WMEM + (size_t)l * 512 * DM;
                const bf16_t* Am = MH + (size_t)l * NMEMTOK * DM;
                auto tile1 = [&](int i, const bf16_t*& ta, const bf16_t*& tb, int& tm0, int& tn0) {
                    if (i < 1728) {
                        const int j = i >> 3, mg = j / 72, rem = j % 72;
                        tm0 = ((i & 7) * 24 + mg * 8 + (rem & 7)) * 256; tn0 = (rem >> 3) * 256; ta = H; tb = Wl;
                    } else { const int j = i - 1728; tm0 = (j >> 1) * 256; tn0 = (j & 1) * 256; ta = Am; tb = Wm; }
                };
                bool pre = false;
                for (int i = bid; i < 1728 + 40; i += nb) {
                    const bf16_t *ta, *tb, *na = nullptr, *nbp = nullptr; int tm0, tn0, xm = 0, xn = 0;
                    tile1(i, ta, tb, tm0, tn0);
                    if (i + nb < 1728 + 40) tile1(i + nb, na, nbp, xm, xn);
                    const bool nperm = (i + nb < 1728) ? !(xn >= 512 && xn < 1152) : (xn == 0);
                    if (i < 1728) gemm_tile<0>(ta, tb, tm0, tn0, e, smem, pre, na, nbp, xm, xn, nperm);
                    else gemm_tile<2>(ta, tb, tm0, tn0, e2, smem, pre, na, nbp, xm, xn, nperm);
                    pre = (na != nullptr);
                }
            } else if (sub == 1) {
                const int lane = opaque_tid() & 63;
                float gq = fabsf(p.q_norm[l * 64 + lane]), gk = fabsf(p.k_norm[l * 64 + lane]);
                gq = wave_max(gq); gk = wave_max(gk);
                const float mfix = 8.0f * gq * gk * 1.02f * L2E;
                const bool fixm = mfix < 28.0f;
                {
                    auto sdec = [&](int i, const bf16_t*& q, const bf16_t*& k, const bf16_t*& vt, int& T, bf16_t*& o, const bf16_t*& g) {
                        int b, kvh, j; size_t tok0, vtb;
                        if (i < 512) { const int R = i >> 8, ip = i & 255, grp = ip & 7; j = R * 32 + (ip >> 3); b = grp >> 1; kvh = grp & 1; T = 4096;
                            tok0 = (size_t)NPROMPT + (size_t)b * 4096; vtb = (size_t)NPROMPT * 128 + ((size_t)(b * 2 + kvh) * 64) * 4096; }
                        else { const int ii = i - 512, R = ii >> 8, ip = ii & 255, grp = R * 8 + (ip & 7); j = ip >> 3; b = grp >> 1; kvh = grp & 1; T = 2048;
                            tok0 = (size_t)b * 2048; vtb = ((size_t)(b * 2 + kvh) * 64) * 2048; }
                        const int qblk = j >> 2, head = kvh * 4 + (j & 3);
                        const size_t q0 = tok0 + (size_t)qblk * 256;
                        q = Z + q0 * INW + 512 + head * 64; k = Z + tok0 * INW + 1024 + kvh * 64; vt = VT + vtb;
                        o = MIX + q0 * 1024 + 256 + head * 64; g = Z + q0 * INW + 1280 + head * 64;
                    };
                    if (bid < 1536) {
                        AttnPre pre;
                        { const bf16_t *q, *k, *vt, *g; bf16_t* o; int T; sdec(bid, q, k, vt, T, o, g); attn_prefetch(pre, q, k, vt, T, opaque_tid()); }
                        __builtin_amdgcn_s_waitcnt(0x0F70);
                        for (int i = bid; i < 1536; i += nb) {
                            const bf16_t *q, *k, *vt, *g, *nq, *nk, *nvt, *ng; bf16_t *o, *no; int T, nT;
                            sdec(i, q, k, vt, T, o, g);
                            sdec((i + nb < 1536) ? i + nb : i, nq, nk, nvt, nT, no, ng);
                            if (fixm) attn_item<true>(q, INW, k, INW, vt, T, T, o, g, smem, mfix, pre, nq, nk, nvt, nT);
                            else attn_item<false>(q, INW, k, INW, vt, T, T, o, g, smem, 0.f, pre, nq, nk, nvt, nT);
                        }
                    }
                }
                for (int i = bid; i < 768; i += nb) {
                    const int qb = i >> 2, hx = i & 3;
                    const size_t q0 = (size_t)qb * 256;
                    const int b = (q0 < NPROMPT) ? (int)(q0 >> 11) : 16 + (int)((q0 - NPROMPT) >> 12);
                    cross_item(Z + q0 * INW + 1792 + hx * 64, KM + ((size_t)l * NMEMTOK + (size_t)b * 256) * 256 + hx * 64,
                               VMT + (size_t)l * NMEMTOK * 256 + ((size_t)(b * 4 + hx) * 64) * 256,
                               MIX + q0 * 1024 + 768 + hx * 64, Z + q0 * INW + 2048 + hx * 64, smem);
                }
                pool_phase(Z, PW + (size_t)l * 4 * 4096, p.pool_scale + l * 256, MIX, bid, nb, smem);
            } else if (sub == 2) {
                EpiArgs e; e.C = H; e.VT = nullptr; e.qn = nullptr; e.kn = nullptr; e.rope = nullptr;
                const bf16_t* Wl = WOUT + (size_t)l * DM * DM;
                auto tile2 = [&](int i, int& tm0, int& tn0) {
                    const int j = i >> 3, mg = j >> 5, rem = j & 31;
                    tm0 = ((i & 7) * 24 + mg * 8 + (rem & 7)) * 256; tn0 = (rem >> 3) * 256;
                };
                bool pre = false;
                for (int i = bid; i < 768; i += nb) {
                    int tm0, tn0, xm = 0, xn = 0; tile2(i, tm0, tn0);
                    const bool more = (i + nb < 768);
                    if (more) tile2(i + nb, xm, xn);
                    gemm_tile<1>(MIX, Wl, tm0, tn0, e, smem, pre, more ? MIX : nullptr, Wl, xm, xn, true);
                    pre = more;
                }
            } else {
                const bool last = (l == DEPTH - 1);
                auto xsrc = [&](int i) -> const float* {
                    return (l == 0) ? ((i < NPROMPT) ? p.x_prompt + (size_t)i * DM : p.x_sample + (size_t)(i - NPROMPT) * DM) : p.out + (size_t)i * DM; };
                const int tid = opaque_tid(), lane = tid & 63, wave = tid >> 6;
                int i = bid * 8 + wave;
                if (i < NTOK) {
                    PostIn cur = post_row_load(xsrc(i), H + (size_t)i * DM, lane);
                    for (; i < NTOK; i += nb * 8) {
                        const int in = (i + nb * 8 < NTOK) ? i + nb * 8 : i;
                        const PostIn nxt = post_row_load(xsrc(in), H + (size_t)in * DM, lane);
                        post_row_finish(cur, H + (size_t)i * DM, p.norm_post + l * DM, p.norm_pre + (last ? l : l + 1) * DM, p.out + (size_t)i * DM, last, lane);
                        cur = nxt;
                    }
                }
            }
        }
        if (ph + 1 < p.phase_end) xcd_barrier(xb);
    }
}

extern "C" void kernel_launch(void* const* d_in, const int* in_sizes, int n_in, void* d_out, int out_size, void* d_ws, size_t ws_size,
                              hipStream_t stream) {
    static int grid_blocks = 0;
    if (!grid_blocks) {
        int dev = 0, cus = 0, per_cu = 0;
        hipGetDevice(&dev);
        hipDeviceGetAttribute(&cus, hipDeviceAttributeMultiprocessorCount, dev);
        hipOccupancyMaxActiveBlocksPerMultiprocessor(&per_cu, fwd_megakernel, 512, 0);
        if (per_cu > 1) per_cu = 1;
        if (per_cu < 1) per_cu = 1;
        grid_blocks = cus * per_cu;
    }
    Params p{};
    p.x_prompt = (const float*)d_in[0]; p.x_sample = (const float*)d_in[1]; p.mem_prompt = (const float*)d_in[2]; p.mem_sample = (const float*)d_in[3];
    p.norm_pre = (const float*)d_in[4]; p.norm_post = (const float*)d_in[5]; p.w_in = (const float*)d_in[6]; p.pool_w = (const float*)d_in[7];
    p.pool_scale = (const float*)d_in[8]; p.q_norm = (const float*)d_in[9]; p.k_norm = (const float*)d_in[10]; p.mem_norm = (const float*)d_in[11];
    p.w_mem_kv = (const float*)d_in[12]; p.w_out = (const float*)d_in[13];
    p.out = (float*)d_out; p.ws = (unsigned char*)d_ws;
    p.phase_begin = 0; p.phase_end = 1 + 4 * DEPTH;
    if (ws_size < WS_TOTAL) { fprintf(stderr, "workspace too small: %zu < %zu\n", ws_size, (size_t)WS_TOTAL); return; }
    hipMemsetAsync((unsigned char*)d_ws + OFF_BAR, 0, BAR_BYTES, stream);
    void* args[] = {&p};
    hipError_t e = hipLaunchCooperativeKernel((void*)fwd_megakernel, dim3(grid_blocks), dim3(512), args, 0, stream);
    if (e != hipSuccess) fprintf(stderr, "cooperative launch failed: %s (grid %d)\n", hipGetErrorString(e), grid_blocks);
}
```

```cpp
#include <hip/hip_runtime.h>
#include <hip/hip_cooperative_groups.h>
#include <stdint.h>
#include <cstdio>
namespace cg = cooperative_groups;

typedef unsigned short bf16_t;
typedef short bf16x8 __attribute__((ext_vector_type(8)));
typedef float f32x4 __attribute__((ext_vector_type(4)));
typedef float f32x16 __attribute__((ext_vector_type(16)));
typedef unsigned u32x4 __attribute__((ext_vector_type(4)));
typedef unsigned u32x2 __attribute__((ext_vector_type(2)));
typedef __bf16 bf16x2_t __attribute__((ext_vector_type(2)));
typedef float f32x2_t __attribute__((ext_vector_type(2)));
#define DI __device__ __forceinline__

constexpr int NTOK = 49152;
constexpr int NPROMPT = 32768;
constexpr int DM = 1024;
constexpr int INW = 2304;
constexpr int NMEMTOK = 5120;
constexpr int DEPTH = 2;
constexpr float EPS = 1e-6f;
constexpr float L2E = 1.4426950408889634f;

constexpr size_t OFF_H    = 0;
constexpr size_t OFF_Z    = OFF_H + (size_t)NTOK * DM * 2;
constexpr size_t OFF_VT   = OFF_Z + (size_t)NTOK * INW * 2;
constexpr size_t OFF_MIX  = OFF_VT + (size_t)NTOK * 128 * 2;
constexpr size_t OFF_WIN  = OFF_MIX + (size_t)NTOK * DM * 2;
constexpr size_t OFF_WOUT = OFF_WIN + (size_t)DEPTH * INW * DM * 2;
constexpr size_t OFF_WMEM = OFF_WOUT + (size_t)DEPTH * DM * DM * 2;
constexpr size_t OFF_PW   = OFF_WMEM + (size_t)DEPTH * 512 * DM * 2;
constexpr size_t OFF_MH   = OFF_PW + (size_t)DEPTH * 4 * 64 * 64 * 2;
constexpr size_t OFF_KM   = OFF_MH + (size_t)DEPTH * NMEMTOK * DM * 2;
constexpr size_t OFF_VMT  = OFF_KM + (size_t)DEPTH * NMEMTOK * 256 * 2;
constexpr size_t OFF_ROPE = OFF_VMT + (size_t)DEPTH * NMEMTOK * 256 * 2;
constexpr size_t OFF_BAR  = OFF_ROPE + 64 * 16 * 2 * 4;
constexpr size_t BAR_BYTES = 3456 * 4;
constexpr size_t WS_TOTAL = OFF_BAR + BAR_BYTES;

struct Params {
    const float* x_prompt; const float* x_sample; const float* mem_prompt; const float* mem_sample;
    const float* norm_pre; const float* norm_post; const float* w_in; const float* pool_w; const float* pool_scale;
    const float* q_norm; const float* k_norm; const float* mem_norm; const float* w_mem_kv; const float* w_out;
    float* out; unsigned char* ws;
    int phase_begin; int phase_end;
};

DI unsigned pk_bf16(float a, float b) {
    f32x2_t v = {a, b};
    bf16x2_t r = __builtin_convertvector(v, bf16x2_t);
    return __builtin_bit_cast(unsigned, r);
}
DI int opaque_tid() { int t = threadIdx.x; asm volatile("" : "+v"(t)); return t; }
DI void lds_barrier() { asm volatile("s_waitcnt lgkmcnt(0)\n\ts_barrier" ::: "memory"); }
DI float bflo(unsigned u) { return __uint_as_float(u << 16); }
DI float bfhi(unsigned u) { return __uint_as_float(u & 0xffff0000u); }
template <int CTRL> DI float dppf(float v) { return __uint_as_float(__builtin_amdgcn_update_dpp(0u, __float_as_uint(v), CTRL, 0xf, 0xf, true)); }
DI float x16_add(float v) { auto r = __builtin_amdgcn_permlane16_swap(__float_as_uint(v), __float_as_uint(v), false, false); return __uint_as_float(r[0]) + __uint_as_float(r[1]); }
DI float x32_add(float v) { auto r = __builtin_amdgcn_permlane32_swap(__float_as_uint(v), __float_as_uint(v), false, false); return __uint_as_float(r[0]) + __uint_as_float(r[1]); }
DI float x16_max(float v) { auto r = __builtin_amdgcn_permlane16_swap(__float_as_uint(v), __float_as_uint(v), false, false); return fmaxf(__uint_as_float(r[0]), __uint_as_float(r[1])); }
DI float x32_max(float v) { auto r = __builtin_amdgcn_permlane32_swap(__float_as_uint(v), __float_as_uint(v), false, false); return fmaxf(__uint_as_float(r[0]), __uint_as_float(r[1])); }
DI float wave_sum(float v) {
    v += dppf<0xB1>(v); v += dppf<0x4E>(v); v += dppf<0x141>(v); v += dppf<0x140>(v);
    v = x16_add(v); v = x32_add(v);
    return v;
}
DI float wave_max(float v) {
    v = fmaxf(v, dppf<0xB1>(v)); v = fmaxf(v, dppf<0x4E>(v)); v = fmaxf(v, dppf<0x141>(v)); v = fmaxf(v, dppf<0x140>(v));
    v = x16_max(v); v = x32_max(v);
    return v;
}
DI float xhalf_max(float v) {
    auto r = __builtin_amdgcn_permlane32_swap(__float_as_uint(v), __float_as_uint(v), false, false);
    return fmaxf(__uint_as_float(r[0]), __uint_as_float(r[1]));
}
DI void swap32(unsigned& a, unsigned& b) { auto r = __builtin_amdgcn_permlane32_swap(a, b, false, false); a = r[0]; b = r[1]; }
DI u32x4 o_pair_wide(const f32x16& ov, int gqA, float inv, u32x4 gw) {
    unsigned gax = gw.x, gay = gw.y, gbx = gw.z, gby = gw.w;
    swap32(gax, gbx); swap32(gay, gby);
    const int a = 4 * gqA, b = a + 4;
    unsigned ax = pk_bf16(ov[a] * inv * bflo(gax), ov[a + 1] * inv * bfhi(gax)), ay = pk_bf16(ov[a + 2] * inv * bflo(gay), ov[a + 3] * inv * bfhi(gay));
    unsigned bx = pk_bf16(ov[b] * inv * bflo(gbx), ov[b + 1] * inv * bfhi(gbx)), by = pk_bf16(ov[b + 2] * inv * bflo(gby), ov[b + 3] * inv * bfhi(gby));
    swap32(ax, bx); swap32(ay, by);
    return (u32x4){ax, ay, bx, by};
}
DI float silu_f(float x) { return x * __builtin_amdgcn_rcpf(1.0f + __builtin_amdgcn_exp2f(-x * L2E)); }
DI f32x4 mfma16(bf16x8 a, bf16x8 b, f32x4 c) { return __builtin_amdgcn_mfma_f32_16x16x32_bf16(a, b, c, 0, 0, 0); }
DI f32x16 mfma32(bf16x8 a, bf16x8 b, f32x16 c) { return __builtin_amdgcn_mfma_f32_32x32x16_bf16(a, b, c, 0, 0, 0); }

DI void transpose_tile(const float* __restrict__ src, int ldn, bf16_t* __restrict__ dst, int ldk, int k0, int n0, unsigned char* smem) {
    float* tile = (float*)smem;
    const int tid = opaque_tid();
    __syncthreads();
#pragma unroll
    for (int i = 0; i < 2; ++i) {
        const int id = tid + 512 * i, r = id >> 4, c4 = id & 15;
        const f32x4 v = *(const f32x4*)(src + (size_t)(k0 + r) * ldn + n0 + c4 * 4);
        tile[r * 65 + c4 * 4 + 0] = v[0]; tile[r * 65 + c4 * 4 + 1] = v[1]; tile[r * 65 + c4 * 4 + 2] = v[2]; tile[r * 65 + c4 * 4 + 3] = v[3];
    }
    __syncthreads();
    {
        const int n = tid >> 3, kc = tid & 7;
        float v[8];
#pragma unroll
        for (int j = 0; j < 8; ++j) v[j] = tile[(kc * 8 + j) * 65 + n];
        u32x4 o; o.x = pk_bf16(v[0], v[1]); o.y = pk_bf16(v[2], v[3]); o.z = pk_bf16(v[4], v[5]); o.w = pk_bf16(v[6], v[7]);
        *(u32x4*)(dst + (size_t)(n0 + n) * ldk + k0 + kc * 8) = o;
    }
}

struct RowIn { f32x4 v[4]; };
DI RowIn rms_row_load(const float* __restrict__ src, int lane) {
    RowIn r;
#pragma unroll
    for (int j = 0; j < 2; ++j) { r.v[2 * j] = *(const f32x4*)(src + j * 512 + lane * 8); r.v[2 * j + 1] = *(const f32x4*)(src + j * 512 + lane * 8 + 4); }
    return r;
}
DI void rms_row_finish(const RowIn& in, const float* __restrict__ g, bf16_t* __restrict__ dst, int lane,
                       const float* __restrict__ g2 = nullptr, bf16_t* __restrict__ dst2 = nullptr) {
    f32x4 v[4]; float ss = 0.f;
#pragma unroll
    for (int j = 0; j < 4; ++j) { v[j] = in.v[j]; ss += v[j][0] * v[j][0] + v[j][1] * v[j][1] + v[j][2] * v[j][2] + v[j][3] * v[j][3]; }
    ss = wave_sum(ss);
    const float r = rsqrtf(ss * (1.0f / 1024.0f) + EPS);
#pragma unroll
    for (int j = 0; j < 2; ++j) {
        const f32x4 g0 = *(const f32x4*)(g + j * 512 + lane * 8), g1 = *(const f32x4*)(g + j * 512 + lane * 8 + 4);
        const f32x4 a = v[2 * j], b = v[2 * j + 1];
        u32x4 o;
        o.x = pk_bf16(a[0] * r * g0[0], a[1] * r * g0[1]); o.y = pk_bf16(a[2] * r * g0[2], a[3] * r * g0[3]);
        o.z = pk_bf16(b[0] * r * g1[0], b[1] * r * g1[1]); o.w = pk_bf16(b[2] * r * g1[2], b[3] * r * g1[3]);
        *(u32x4*)(dst + j * 512 + lane * 8) = o;
    }
    if (g2 != nullptr) {
#pragma unroll
        for (int j = 0; j < 2; ++j) {
            const f32x4 g0 = *(const f32x4*)(g2 + j * 512 + lane * 8), g1 = *(const f32x4*)(g2 + j * 512 + lane * 8 + 4);
            const f32x4 a = v[2 * j], b = v[2 * j + 1];
            u32x4 o;
            o.x = pk_bf16(a[0] * r * g0[0], a[1] * r * g0[1]); o.y = pk_bf16(a[2] * r * g0[2], a[3] * r * g0[3]);
            o.z = pk_bf16(b[0] * r * g1[0], b[1] * r * g1[1]); o.w = pk_bf16(b[2] * r * g1[2], b[3] * r * g1[3]);
            *(u32x4*)(dst2 + j * 512 + lane * 8) = o;
        }
    }
}

DI void rope_entry(int idx, float* table) {
    const int n = idx >> 4, pp = idx & 15;
    double fd = 1.0;
    for (int i = 0; i < pp; ++i) fd *= 0.5623413251903491;
    const float f = (float)fd;
    const float a = (float)n * f;
    double r = (double)a;
    const double k = rint(r * 0.15915494309189535);
    r -= k * 6.283185307179586;
    const double r2 = r * r;
    double sn = r, cs = 1.0, ts = r, tc = 1.0;
    for (int i = 1; i <= 16; ++i) {
        tc = -tc * r2 / (double)((2 * i - 1) * (2 * i));
        ts = -ts * r2 / (double)((2 * i) * (2 * i + 1));
        cs += tc; sn += ts;
    }
    table[idx * 2] = (float)cs; table[idx * 2 + 1] = (float)sn;
}

struct EpiArgs {
    bf16_t* C;
    bf16_t* VT;
    const float* qn; const float* kn; const float* rope;
};

DI int g8_lds_byte(int r, int c) { const int st = (r >> 4) * 2 + (c >> 5), rr = r & 15, cc = c & 31, ob = rr * 64 + cc * 2; return st * 1024 + (ob ^ (((ob >> 9) & 1) << 5)); }
DI void g8_stage_rc(int b, int& R, int& C) { const int st = b >> 10, sb = b & 1023, swz = sb ^ (((sb >> 9) & 1) << 5); R = (st >> 1) * 16 + (swz >> 6); C = (st & 1) * 32 + ((swz & 63) >> 1); }

DI void store_T16x32(const f32x4& v0, const f32x4& v1, unsigned char* wl, bf16_t* __restrict__ dst, size_t ld, int fr, int fq, int lane) {
#pragma unroll
    for (int j = 0; j < 4; ++j) {
        *(bf16_t*)(wl + ((4 * fq + j) * 16 + fr) * 2) = (bf16_t)(pk_bf16(v0[j], 0.f) & 0xffffu);
        *(bf16_t*)(wl + ((16 + 4 * fq + j) * 16 + fr) * 2) = (bf16_t)(pk_bf16(v1[j], 0.f) & 0xffffu);
    }
    __builtin_amdgcn_fence(__ATOMIC_RELEASE, "wavefront"); __builtin_amdgcn_wave_barrier(); __builtin_amdgcn_fence(__ATOMIC_ACQUIRE, "wavefront");
    const int d = lane >> 1, hf = lane & 1;
    const u32x4 val = *(const u32x4*)(wl + d * 32 + hf * 16);
    *(u32x4*)(dst + (size_t)d * ld + hf * 8) = val;
    __builtin_amdgcn_fence(__ATOMIC_RELEASE, "wavefront"); __builtin_amdgcn_wave_barrier(); __builtin_amdgcn_fence(__ATOMIC_ACQUIRE, "wavefront");
}

DI const unsigned char* uniform_ptr(const void* p) {
    const unsigned long long v = (unsigned long long)p;
    const unsigned lo = __builtin_amdgcn_readfirstlane((unsigned)v), hi = __builtin_amdgcn_readfirstlane((unsigned)(v >> 32));
    return (const unsigned char*)(((unsigned long long)hi << 32) | lo);
}

template <int MODE>
DI void gemm_tile(const bf16_t* __restrict__ A, const bf16_t* __restrict__ Bt, int m0, int n0, const EpiArgs& e, unsigned char* smem,
                  bool prefetched, const bf16_t* __restrict__ nA, const bf16_t* __restrict__ nB, int nm0, int nn0, bool nperm) {
    constexpr int K = 1024, BK = 64, HALF = 128, HTB = 16384, nt = K / BK;
    const int tid = opaque_tid(), lane = tid & 63, wave = __builtin_amdgcn_readfirstlane(tid >> 6);
    const int wr = wave >> 2, wc = wave & 3, fr = lane & 15, fq = lane >> 4;
    int sR0, sC0, sR1, sC1;
    g8_stage_rc(tid * 16, sR0, sC0); g8_stage_rc(tid * 16 + 8192, sR1, sC1);
    const unsigned so0b = (unsigned)(sR0 * K + sC0) * 2u, so1b = (unsigned)(sR1 * K + sC1) * 2u;
    const bool perm = (MODE == 1) ? true : ((MODE == 2) ? (n0 == 0) : !(n0 >= 512 && n0 < 1152));
    __attribute__((address_space(3))) unsigned char* lds = (__attribute__((address_space(3))) unsigned char*)smem;
#define G8_SA(b, h) (((b) * 2 + (h)) * HTB)
#define G8_SB(b, h) ((4 + (b) * 2 + (h)) * HTB)
#define G8_PERMOFF(SO) ({ const unsigned R_ = (SO) >> 11, rho_ = R_ & 31u, i_ = rho_ & 15u; const unsigned p_ = 8u * (i_ >> 2) + 4u * (rho_ >> 4) + (i_ & 3u); (SO) + (p_ - rho_) * 2048u; })
#define G8_STAGE_B(POFF, BASE, br, kt, PERM) { const unsigned char* g_ = uniform_ptr((BASE) + (size_t)(br) * K + (kt) * BK); \
        const unsigned b0_ = (PERM) ? G8_PERMOFF(so0b) : so0b, b1_ = (PERM) ? G8_PERMOFF(so1b) : so1b; \
        __builtin_amdgcn_global_load_lds((const __attribute__((address_space(1))) unsigned*)(g_ + b0_), (__attribute__((address_space(3))) unsigned*)(lds + (POFF) + tid * 16), 16, 0, 0); \
        __builtin_amdgcn_global_load_lds((const __attribute__((address_space(1))) unsigned*)(g_ + b1_), (__attribute__((address_space(3))) unsigned*)(lds + (POFF) + tid * 16 + 8192), 16, 0, 0); }
#define G8_STAGE(POFF, BASE, br, kt) { const unsigned char* g_ = uniform_ptr((BASE) + (size_t)(br) * K + (kt) * BK); \
        __builtin_amdgcn_global_load_lds((const __attribute__((address_space(1))) unsigned*)(g_ + so0b), (__attribute__((address_space(3))) unsigned*)(lds + (POFF) + tid * 16), 16, 0, 0); \
        __builtin_amdgcn_global_load_lds((const __attribute__((address_space(1))) unsigned*)(g_ + so1b), (__attribute__((address_space(3))) unsigned*)(lds + (POFF) + tid * 16 + 8192), 16, 0, 0); }
    const int lane_off = (fr * 64 + fq * 16) ^ ((fr >> 3) << 5);
    const unsigned ldsA = (unsigned)(size_t)lds + (unsigned)(lane_off + wr * 8192);
    const unsigned ldsB = (unsigned)(size_t)lds + (unsigned)(lane_off + wc * 4096);
#define G8_DSR(dst, addr, OFF) asm volatile("ds_read_b128 %0, %1 offset:" #OFF : "=v"(dst) : "v"(addr))
#define G8_LDA(dst, b, h) { const unsigned a_ = ldsA + G8_SA(b, h); \
        G8_DSR(dst[0][0], a_, 0); G8_DSR(dst[0][1], a_, 1024); G8_DSR(dst[1][0], a_, 2048); G8_DSR(dst[1][1], a_, 3072); \
        G8_DSR(dst[2][0], a_, 4096); G8_DSR(dst[2][1], a_, 5120); G8_DSR(dst[3][0], a_, 6144); G8_DSR(dst[3][1], a_, 7168); }
#define G8_LDB(dst, b, h) { const unsigned a_ = ldsB + G8_SB(b, h); \
        G8_DSR(dst[0][0], a_, 0); G8_DSR(dst[0][1], a_, 1024); G8_DSR(dst[1][0], a_, 2048); G8_DSR(dst[1][1], a_, 3072); }
#define G8_TIE_A(AT) asm volatile("s_waitcnt lgkmcnt(0)" : "+v"(AT[0][0]), "+v"(AT[0][1]), "+v"(AT[1][0]), "+v"(AT[1][1]), "+v"(AT[2][0]), "+v"(AT[2][1]), "+v"(AT[3][0]), "+v"(AT[3][1]) :: "memory")
#define G8_TIE_B(BX) asm volatile("s_waitcnt lgkmcnt(0)" : "+v"(BX[0][0]), "+v"(BX[0][1]), "+v"(BX[1][0]), "+v"(BX[1][1]) :: "memory")
#define G8_MMA(ai, bj, AT, BX) { __builtin_amdgcn_s_setprio(1); \
        _Pragma("unroll") for (int m = 0; m < 4; ++m) _Pragma("unroll") for (int n = 0; n < 2; ++n) _Pragma("unroll") for (int k = 0; k < 2; ++k) \
            acc[ai][bj][m][n] = mfma16(BX[n][k], AT[m][k], acc[ai][bj][m][n]); \
        __builtin_amdgcn_s_setprio(0); }
#define G8_WV(n) asm volatile("s_waitcnt vmcnt(" #n ")" ::: "memory")
#define G8_WL(n) asm volatile("s_waitcnt lgkmcnt(" #n ")" ::: "memory")
#define G8_BAR __builtin_amdgcn_s_barrier()
#define G8_SCHED __builtin_amdgcn_sched_barrier(0)
    f32x4 acc[2][2][4][2];
#pragma unroll
    for (int a = 0; a < 2; ++a)
#pragma unroll
        for (int b = 0; b < 2; ++b)
#pragma unroll
            for (int m = 0; m < 4; ++m)
#pragma unroll
                for (int n = 0; n < 2; ++n) acc[a][b][m][n] = (f32x4){0.f, 0.f, 0.f, 0.f};
    bf16x8 At[4][2], B0[2][2], B1[2][2];
    if (!prefetched) {
        __syncthreads();
        G8_STAGE_B(G8_SB(0, 0), Bt, n0, 0, perm); G8_STAGE(G8_SA(0, 0), A, m0, 0);
        G8_STAGE_B(G8_SB(0, 1), Bt, n0 + HALF, 0, perm); G8_STAGE(G8_SA(0, 1), A, m0 + HALF, 0);
        if (wr == 1) G8_BAR;
        G8_WV(4); G8_BAR;
        G8_STAGE_B(G8_SB(1, 0), Bt, n0, 1, perm); G8_STAGE(G8_SA(1, 0), A, m0, 1); G8_STAGE_B(G8_SB(1, 1), Bt, n0 + HALF, 1, perm);
        G8_WV(6); G8_BAR;
    } else {
        G8_WV(16);
        if (wr == 1) G8_BAR;
        G8_BAR;
        G8_BAR;
    }
    for (int t = 0; t < nt - 2; t += 2) {
        G8_LDB(B0, 0, 0); G8_SCHED; G8_LDA(At, 0, 0); G8_STAGE(G8_SA(1, 1), A, m0 + HALF, t + 1);
        G8_WL(8); G8_BAR; G8_TIE_B(B0); G8_TIE_A(At); G8_MMA(0, 0, At, B0); G8_BAR; G8_SCHED;
        G8_LDB(B1, 0, 1); G8_STAGE_B(G8_SB(0, 0), Bt, n0, t + 2, perm);
        G8_BAR; G8_TIE_B(B1); G8_MMA(0, 1, At, B1); G8_BAR;
        G8_LDA(At, 0, 1); G8_STAGE(G8_SA(0, 0), A, m0, t + 2);
        G8_BAR; G8_TIE_A(At); G8_MMA(1, 0, At, B0); G8_BAR; G8_SCHED;
        G8_STAGE_B(G8_SB(0, 1), Bt, n0 + HALF, t + 2, perm);
        G8_WV(6); G8_BAR; G8_MMA(1, 1, At, B1); G8_BAR;
        G8_LDB(B0, 1, 0); G8_SCHED; G8_LDA(At, 1, 0); G8_STAGE(G8_SA(0, 1), A, m0 + HALF, t + 2);
        G8_WL(8); G8_BAR; G8_TIE_B(B0); G8_TIE_A(At); G8_MMA(0, 0, At, B0); G8_BAR; G8_SCHED;
        G8_LDB(B1, 1, 1); G8_STAGE_B(G8_SB(1, 0), Bt, n0, t + 3, perm);
        G8_BAR; G8_TIE_B(B1); G8_MMA(0, 1, At, B1); G8_BAR;
        G8_LDA(At, 1, 1); G8_STAGE(G8_SA(1, 0), A, m0, t + 3);
        G8_BAR; G8_TIE_A(At); G8_MMA(1, 0, At, B0); G8_BAR; G8_SCHED;
        G8_STAGE_B(G8_SB(1, 1), Bt, n0 + HALF, t + 3, perm);
        G8_WV(6); G8_BAR; G8_MMA(1, 1, At, B1); G8_BAR;
    }
    {
        G8_LDB(B0, 0, 0); G8_LDA(At, 0, 0); G8_STAGE(G8_SA(1, 1), A, m0 + HALF, nt - 1);
        G8_BAR; G8_TIE_B(B0); G8_TIE_A(At); G8_MMA(0, 0, At, B0); G8_BAR;
        G8_LDB(B1, 0, 1); G8_BAR; G8_TIE_B(B1); G8_MMA(0, 1, At, B1); G8_BAR;
        G8_LDA(At, 0, 1); G8_WV(4); G8_BAR; G8_TIE_A(At); G8_MMA(1, 0, At, B0); G8_MMA(1, 1, At, B1); G8_BAR;
    }
    {
        G8_LDB(B0, 1, 0); G8_LDA(At, 1, 0); G8_WV(2); G8_BAR; G8_TIE_B(B0); G8_TIE_A(At); G8_MMA(0, 0, At, B0); G8_BAR;
        G8_LDB(B1, 1, 1); G8_WV(0); G8_BAR; G8_TIE_B(B1); G8_MMA(0, 1, At, B1); G8_BAR;
        G8_LDA(At, 1, 1); G8_BAR; G8_TIE_A(At); G8_MMA(1, 0, At, B0); G8_MMA(1, 1, At, B1); G8_BAR;
    }
    if (wr == 0) G8_BAR;
    if (nA != nullptr) {
        G8_STAGE_B(G8_SB(0, 0), nB, nn0, 0, nperm); G8_STAGE(G8_SA(0, 0), nA, nm0, 0);
        G8_STAGE_B(G8_SB(0, 1), nB, nn0 + HALF, 0, nperm); G8_STAGE(G8_SA(0, 1), nA, nm0 + HALF, 0);
        G8_STAGE_B(G8_SB(1, 0), nB, nn0, 1, nperm); G8_STAGE(G8_SA(1, 0), nA, nm0, 1); G8_STAGE_B(G8_SB(1, 1), nB, nn0 + HALF, 1, nperm);
    }
    __builtin_amdgcn_sched_barrier(0);
#undef G8_SA
#undef G8_SB
#undef G8_STAGE
#undef G8_STAGE_B
#undef G8_PERMOFF
#undef G8_LDA
#undef G8_LDB
#undef G8_DSR
#undef G8_TIE_A
#undef G8_TIE_B
#undef G8_MMA
#undef G8_WV
#undef G8_WL
#undef G8_BAR
#undef G8_SCHED

    const int tid_e = opaque_tid(), wave_e = __builtin_amdgcn_readfirstlane(tid_e >> 6);
    const int wr_e = wave_e >> 2, wc_e = wave_e & 3, fr_e = tid_e & 15, fq_e = (tid_e >> 4) & 3;
    const int tok_w = m0 + wr_e * 64 + fr_e;
    const int col_w = n0 + wc_e * 32 + 4 * fq_e;
    const int col_p = n0 + wc_e * 32 + 8 * fq_e;
    if (MODE == 1) {
#pragma unroll
        for (int ai = 0; ai < 2; ++ai)
#pragma unroll
            for (int m = 0; m < 4; ++m) {
                bf16_t* rowp = e.C + (size_t)(tok_w + ai * 128 + m * 16) * 1024 + col_p;
#pragma unroll
                for (int bj = 0; bj < 2; ++bj) {
                    const f32x4 v0 = acc[ai][bj][m][0], v1 = acc[ai][bj][m][1];
                    u32x4 o; o.x = pk_bf16(v0[0], v0[1]); o.y = pk_bf16(v0[2], v0[3]); o.z = pk_bf16(v1[0], v1[1]); o.w = pk_bf16(v1[2], v1[3]);
                    *(u32x4*)(rowp + bj * 128) = o;
                }
            }
    } else if (MODE == 2) {
        if (n0 == 0) {
#pragma unroll
            for (int ai = 0; ai < 2; ++ai)
#pragma unroll
                for (int m = 0; m < 4; ++m) {
                    bf16_t* rowp = e.C + (size_t)(tok_w + ai * 128 + m * 16) * 256 + col_p;
#pragma unroll
                    for (int bj = 0; bj < 2; ++bj) {
                        const f32x4 v0 = acc[ai][bj][m][0], v1 = acc[ai][bj][m][1];
                        u32x4 o; o.x = pk_bf16(v0[0], v0[1]); o.y = pk_bf16(v0[2], v0[3]); o.z = pk_bf16(v1[0], v1[1]); o.w = pk_bf16(v1[2], v1[3]);
                        *(u32x4*)(rowp + bj * 128) = o;
                    }
                }
        } else {
#pragma unroll
            for (int ai = 0; ai < 2; ++ai)
#pragma unroll
                for (int m = 0; m < 4; ++m) {
                    const int mt0 = m0 + wr_e * 64 + ai * 128 + m * 16, b = mt0 >> 8, mm0 = mt0 & 255;
#pragma unroll
                    for (int bj = 0; bj < 2; ++bj) {
                        const int f0 = bj * 128 + wc_e * 32, hx = f0 >> 6, d0 = f0 & 63;
                        store_T16x32(acc[ai][bj][m][0], acc[ai][bj][m][1], smem + 3 * 16384 + 8192 + wave_e * 1024,
                                     e.VT + ((size_t)(b * 4 + hx) * 64 + d0) * 256 + mm0, 256, fr_e, fq_e, tid_e & 63);
                    }
                }
        }
    } else {
        const bool has_qk = (n0 >= 512 && n0 < 1152);
        float* ssx = (float*)(smem + 3 * 16384);
        if (has_qk) {
#pragma unroll
            for (int ai = 0; ai < 2; ++ai)
#pragma unroll
                for (int bj = 0; bj < 2; ++bj)
#pragma unroll
                    for (int m = 0; m < 4; ++m) {
                        float ss = 0.f;
#pragma unroll
                        for (int n = 0; n < 2; ++n)
#pragma unroll
                            for (int j = 0; j < 4; ++j) ss += acc[ai][bj][m][n][j] * acc[ai][bj][m][n][j];
                        ss = x16_add(ss); ss = x32_add(ss);
                        if (fq_e == 0) ssx[((wave_e * 2 + ai) * 2 + bj) * 64 + m * 16 + fr_e] = ss;
                    }
            __syncthreads();
        }
#pragma unroll
        for (int bj = 0; bj < 2; ++bj) {
            const int cb = n0 + bj * 128 + wc_e * 32;
            const int c64 = cb & ~63;
            if (c64 >= 512 && c64 < 1152) {
                const bool isq = c64 < 1024;
                const float* gn = (isq ? e.qn : e.kn) + (wc_e & 1) * 32 + 4 * fq_e;
                const float osc = isq ? 0.125f * L2E : 1.0f;
                const f32x4 g0 = *(const f32x4*)(gn), g1 = *(const f32x4*)(gn + 16);
#pragma unroll
                for (int ai = 0; ai < 2; ++ai)
#pragma unroll
                    for (int m = 0; m < 4; ++m) {
                        const int tok = tok_w + ai * 128 + m * 16;
                        const float ss = ssx[((wave_e * 2 + ai) * 2 + bj) * 64 + m * 16 + fr_e] + ssx[(((wave_e ^ 1) * 2 + ai) * 2 + bj) * 64 + m * 16 + fr_e];
                        const float rinv = rsqrtf(ss * (1.0f / 64.0f) + EPS);
                        const int t = (tok < NPROMPT) ? (tok & 2047) : (tok & 4095);
                        const int ridx = (wc_e & 1) ? (t & 63) : (t >> 6);
                        const f32x4* rt = (const f32x4*)(e.rope + (ridx * 16 + 4 * fq_e) * 2);
                        const f32x4 r01 = rt[0], r23 = rt[1];
                        const float rc[4] = {r01[0], r01[2], r23[0], r23[2]}, rs[4] = {r01[1], r01[3], r23[1], r23[3]};
                        float oa[4], ob[4];
#pragma unroll
                        for (int j = 0; j < 4; ++j) {
                            const float a = acc[ai][bj][m][0][j] * rinv * g0[j], b = acc[ai][bj][m][1][j] * rinv * g1[j];
                            oa[j] = (a * rc[j] - b * rs[j]) * osc; ob[j] = (b * rc[j] + a * rs[j]) * osc;
                        }
                        unsigned ax = pk_bf16(oa[0], oa[1]), ay = pk_bf16(oa[2], oa[3]), bx = pk_bf16(ob[0], ob[1]), by = pk_bf16(ob[2], ob[3]);
                        { auto r_ = __builtin_amdgcn_permlane16_swap(ax, bx, false, false); ax = r_[0]; bx = r_[1]; }
                        { auto r_ = __builtin_amdgcn_permlane16_swap(ay, by, false, false); ay = r_[0]; by = r_[1]; }
                        bf16_t* rowp = e.C + (size_t)tok * INW + cb + 4 * fq_e + ((fq_e & 1) ? 12 : 0);
                        *(u32x4*)(rowp) = (u32x4){ax, ay, bx, by};
                    }
            } else if (c64 >= 1152 && c64 < 1280) {
#pragma unroll
                for (int ai = 0; ai < 2; ++ai)
#pragma unroll
                    for (int m = 0; m < 4; ++m) {
                        const int tok0 = m0 + wr_e * 64 + ai * 128 + m * 16;
                        const int f0 = cb - 1152, kvh = f0 >> 6, d0 = f0 & 63;
                        bf16_t* bp; size_t T;
                        if (tok0 < NPROMPT) { const int b = tok0 >> 11, t = tok0 & 2047; T = 2048; bp = e.VT + ((size_t)(b * 2 + kvh) * 64 + d0) * 2048 + t; }
                        else { const int b = (tok0 - NPROMPT) >> 12, t = tok0 & 4095; T = 4096; bp = e.VT + (size_t)NPROMPT * 128 + ((size_t)(b * 2 + kvh) * 64 + d0) * 4096 + t; }
                        store_T16x32(acc[ai][bj][m][0], acc[ai][bj][m][1], smem + 3 * 16384 + 8192 + wave_e * 1024, bp, T, fr_e, fq_e, tid_e & 63);
                    }
            } else {
                const int kind = (c64 < 256) ? 0 : ((c64 >= 1792 && c64 < 2048) ? 2 : 1);
#pragma unroll
                for (int ai = 0; ai < 2; ++ai)
#pragma unroll
                    for (int m = 0; m < 4; ++m) {
                        bf16_t* rowp = e.C + (size_t)(tok_w + ai * 128 + m * 16) * INW + cb + 8 * fq_e;
                        float v[8];
#pragma unroll
                        for (int n = 0; n < 2; ++n)
#pragma unroll
                            for (int j = 0; j < 4; ++j) { const float x = acc[ai][bj][m][n][j]; v[4 * n + j] = (kind == 0) ? x : ((kind == 2) ? x * (0.125f * L2E) : silu_f(x)); }
                        u32x4 o; o.x = pk_bf16(v[0], v[1]); o.y = pk_bf16(v[2], v[3]); o.z = pk_bf16(v[4], v[5]); o.w = pk_bf16(v[6], v[7]);
                        *(u32x4*)(rowp) = o;
                    }
            }
        }
    }
}

#define SB_() __builtin_amdgcn_sched_barrier(0)
#define KFRAG(KS, KB) (*(const bf16x8*)(kp + (KB) * 4096 + k_off + ((((KS) * 2 + h) ^ kswz) << 4)))
#define VFRAG(KK, DB) (*(const bf16x8*)(vp + (DB) * 4096 + v_off + ((((KK) * 2 + h) ^ vswz) << 4)))
#define EXP4(S, I0) { _Pragma("unroll") for (int i_ = (I0); i_ < (I0) + 4; ++i_) { S[i_] = __builtin_amdgcn_exp2f(S[i_] - mb); rs += S[i_]; } }
#define EXP4F(S, I0) { f32x2_t a_ = {S[(I0)], S[(I0) + 1]}, b_ = {S[(I0) + 2], S[(I0) + 3]}; \
        a_ = a_ - (f32x2_t){mb, mb}; b_ = b_ - (f32x2_t){mb, mb}; \
        S[(I0)] = __builtin_amdgcn_exp2f(a_.x); S[(I0) + 1] = __builtin_amdgcn_exp2f(a_.y); S[(I0) + 2] = __builtin_amdgcn_exp2f(b_.x); S[(I0) + 3] = __builtin_amdgcn_exp2f(b_.y); \
        rs2 += (f32x2_t){S[(I0)], S[(I0) + 1]} + (f32x2_t){S[(I0) + 2], S[(I0) + 3]}; }
#define EXPQ(S, I0) { if (FIXM) EXP4F(S, I0) else EXP4(S, I0) }
#define PACK8(S, I0) ({ u32x4 t_; t_.x = pk_bf16(S[(I0)], S[(I0) + 1]); t_.y = pk_bf16(S[(I0) + 2], S[(I0) + 3]); t_.z = pk_bf16(S[(I0) + 4], S[(I0) + 5]); t_.w = pk_bf16(S[(I0) + 6], S[(I0) + 7]); __builtin_bit_cast(bf16x8, t_); })
DI float max8(const f32x16& s, int i0, float mx) {
    mx = fmaxf(fmaxf(mx, s[i0]), s[i0 + 1]); mx = fmaxf(fmaxf(mx, s[i0 + 2]), s[i0 + 3]);
    mx = fmaxf(fmaxf(mx, s[i0 + 4]), s[i0 + 5]); mx = fmaxf(fmaxf(mx, s[i0 + 6]), s[i0 + 7]);
    return mx;
}
#define EXP2F(S, I0) { S[(I0)] = __builtin_amdgcn_exp2f(S[(I0)]); S[(I0) + 1] = __builtin_amdgcn_exp2f(S[(I0) + 1]); rs += S[(I0)]; rs1 += S[(I0) + 1]; \
        asm volatile("" : "+v"(S[(I0)]), "+v"(S[(I0) + 1]), "+v"(rs), "+v"(rs1)); }
#define PIN1(X) asm volatile("" : "+v"(X))
template <bool DO_PV, bool DO_QK>
DI void attn_step_fix(f32x16& s0, f32x16& s1, f32x16& n0, f32x16& n1, const bf16x8 (&pp)[4], bf16x8 (&pc)[4],
                      f32x16& o0, f32x16& o1, const float m, float& lsum, const bf16x8 (&qf)[4],
                      const unsigned char* kp, const unsigned char* vp, int k_off, int kswz, int v_off, int vswz, int h) {
    bf16x8 va0, vb0, va1, vb1, va2, vb2, va3, vb3, ka0, kb0, ka1, kb1, ka2, kb2, ka3, kb3;
    float rs = 0.f, rs1 = 0.f;
    if (DO_PV) { va0 = VFRAG(0, 0); vb0 = VFRAG(0, 1); va1 = VFRAG(1, 0); vb1 = VFRAG(1, 1); }
    EXP2F(s0, 0);  if (DO_PV) { o0 = mfma32(va0, pp[0], o0); va2 = VFRAG(2, 0); vb2 = VFRAG(2, 1); }
    EXP2F(s0, 2);  if (DO_PV) { o1 = mfma32(vb0, pp[0], o1); va3 = VFRAG(3, 0); vb3 = VFRAG(3, 1); }
    EXP2F(s0, 4);  if (DO_PV) { o0 = mfma32(va1, pp[1], o0); } if (DO_QK) { ka0 = KFRAG(0, 0); kb0 = KFRAG(0, 1); }
    EXP2F(s0, 6);  if (DO_PV) { o1 = mfma32(vb1, pp[1], o1); } if (DO_QK) { ka1 = KFRAG(1, 0); kb1 = KFRAG(1, 1); }
    EXP2F(s0, 8);  if (DO_PV) { o0 = mfma32(va2, pp[2], o0); }
    EXP2F(s0, 10); if (DO_PV) { o1 = mfma32(vb2, pp[2], o1); } pc[0] = PACK8(s0, 0); PIN1(pc[0]);
    EXP2F(s0, 12); if (DO_PV) { o0 = mfma32(va3, pp[3], o0); }
    EXP2F(s0, 14); if (DO_PV) { o1 = mfma32(vb3, pp[3], o1); }
    EXP2F(s1, 0);  if (DO_QK) { n0 = mfma32(ka0, qf[0], (f32x16){0.f, 0.f, 0.f, 0.f, 0.f, 0.f, 0.f, 0.f, 0.f, 0.f, 0.f, 0.f, 0.f, 0.f, 0.f, 0.f}); ka2 = KFRAG(2, 0); kb2 = KFRAG(2, 1); } pc[1] = PACK8(s0, 8); PIN1(pc[1]);
    EXP2F(s1, 2);  if (DO_QK) { n1 = mfma32(kb0, qf[0], (f32x16){0.f, 0.f, 0.f, 0.f, 0.f, 0.f, 0.f, 0.f, 0.f, 0.f, 0.f, 0.f, 0.f, 0.f, 0.f, 0.f}); ka3 = KFRAG(3, 0); kb3 = KFRAG(3, 1); }
    EXP2F(s1, 4);  if (DO_QK) { n0 = mfma32(ka1, qf[1], n0); }
    EXP2F(s1, 6);  if (DO_QK) { n1 = mfma32(kb1, qf[1], n1); }
    EXP2F(s1, 8);  if (DO_QK) { n0 = mfma32(ka2, qf[2], n0); } pc[2] = PACK8(s1, 0); PIN1(pc[2]);
    EXP2F(s1, 10); if (DO_QK) { n1 = mfma32(kb2, qf[2], n1); }
    EXP2F(s1, 12); if (DO_QK) { n0 = mfma32(ka3, qf[3], n0); }
    EXP2F(s1, 14); if (DO_QK) { n1 = mfma32(kb3, qf[3], n1); } pc[3] = PACK8(s1, 8); PIN1(pc[3]);
    lsum += rs + rs1;

}
template <bool DO_PV, bool DO_QK, bool FIXM>
DI void attn_step(f32x16& s0, f32x16& s1, f32x16& n0, f32x16& n1, const bf16x8 (&pp)[4], bf16x8 (&pc)[4],
                  f32x16& o0, f32x16& o1, float& m, float& lsum, const bf16x8 (&qf)[4],
                  const unsigned char* kp, const unsigned char* vp, int k_off, int kswz, int v_off, int vswz, int h) {
    if (FIXM) { attn_step_fix<DO_PV, DO_QK>(s0, s1, n0, n1, pp, pc, o0, o1, m, lsum, qf, kp, vp, k_off, kswz, v_off, vswz, h); return; }
    bf16x8 va0, vb0, va1, vb1, va2, vb2, va3, vb3, ka0, kb0, ka1, kb1, ka2, kb2, ka3, kb3;
    if (DO_PV) { va0 = VFRAG(0, 0); vb0 = VFRAG(0, 1); va1 = VFRAG(1, 0); vb1 = VFRAG(1, 1); }
    float mx = s0[0];
    if (DO_PV) o0 = mfma32(va0, pp[0], o0);
    if (!FIXM) mx = max8(s0, 0, mx);
    SB_();
    if (DO_PV) { o1 = mfma32(vb0, pp[0], o1); va2 = VFRAG(2, 0); vb2 = VFRAG(2, 1); }
    if (!FIXM) mx = max8(s0, 8, mx);
    SB_();
    if (DO_PV) { o0 = mfma32(va1, pp[1], o0); va3 = VFRAG(3, 0); vb3 = VFRAG(3, 1); }
    if (!FIXM) mx = max8(s1, 0, mx);
    SB_();
    if (DO_PV) o1 = mfma32(vb1, pp[1], o1);
    bool need = false; float alpha = 1.0f;
    if (!FIXM) {
        mx = max8(s1, 8, mx);
        mx = xhalf_max(mx);
        need = mx > m + 8.0f;
        const float mnew = need ? mx : m;
        alpha = __builtin_amdgcn_exp2f(m - mnew);
        m = mnew;
    }
    const float mb = m;
    float rs = 0.f; f32x2_t rs2 = {0.f, 0.f};
    SB_();
    if (DO_PV) o0 = mfma32(va2, pp[2], o0);
    if (DO_QK) { ka0 = KFRAG(0, 0); kb0 = KFRAG(0, 1); }
    EXPQ(s0, 0);
    SB_();
    if (DO_PV) o1 = mfma32(vb2, pp[2], o1);
    if (DO_QK) { ka1 = KFRAG(1, 0); kb1 = KFRAG(1, 1); }
    EXPQ(s0, 4);
    SB_();
    if (DO_PV) o0 = mfma32(va3, pp[3], o0);
    EXPQ(s0, 8);
    SB_();
    if (DO_PV) o1 = mfma32(vb3, pp[3], o1);
    EXPQ(s0, 12);
    SB_();
    if (DO_QK) { n0 = mfma32(ka0, qf[0], (f32x16){0.f, 0.f, 0.f, 0.f, 0.f, 0.f, 0.f, 0.f, 0.f, 0.f, 0.f, 0.f, 0.f, 0.f, 0.f, 0.f}); ka2 = KFRAG(2, 0); kb2 = KFRAG(2, 1); }
    EXPQ(s1, 0);
    SB_();
    if (DO_QK) { n1 = mfma32(kb0, qf[0], (f32x16){0.f, 0.f, 0.f, 0.f, 0.f, 0.f, 0.f, 0.f, 0.f, 0.f, 0.f, 0.f, 0.f, 0.f, 0.f, 0.f}); ka3 = KFRAG(3, 0); kb3 = KFRAG(3, 1); }
    EXPQ(s1, 4);
    SB_();
    if (DO_QK) n0 = mfma32(ka1, qf[1], n0);
    EXPQ(s1, 8);
    SB_();
    if (DO_QK) n1 = mfma32(kb1, qf[1], n1);
    EXPQ(s1, 12);
    SB_();
    if (DO_QK) n0 = mfma32(ka2, qf[2], n0);
    pc[0] = PACK8(s0, 0);
    SB_();
    if (DO_QK) n1 = mfma32(kb2, qf[2], n1);
    pc[1] = PACK8(s0, 8);
    SB_();
    if (DO_QK) n0 = mfma32(ka3, qf[3], n0);
    pc[2] = PACK8(s1, 0);
    SB_();
    if (DO_QK) n1 = mfma32(kb3, qf[3], n1);
    pc[3] = PACK8(s1, 8);
    if (FIXM) lsum += rs2.x + rs2.y; else lsum = lsum * alpha + rs;
    SB_();
    if (!FIXM) {
        if (__builtin_amdgcn_ballot_w64(need)) {
#pragma unroll
            for (int i = 0; i < 16; ++i) { o0[i] *= alpha; o1[i] *= alpha; }
        }
    }
}

struct AttnPre { bf16x8 q[4]; u32x4 k0, k1, s0k, s0v; };
DI void attn_prefetch(AttnPre& pre, const bf16_t* __restrict__ Q, const bf16_t* __restrict__ K, const bf16_t* __restrict__ VT, int ldv, int tid) {
    const int lane = tid & 63, wave = tid >> 6, r = lane & 31, h = lane >> 5, lrow = tid >> 3, lc = tid & 7;
    const bf16_t* qp = Q + (size_t)(wave * 32 + r) * INW + h * 8;
#pragma unroll
    for (int ks = 0; ks < 4; ++ks) pre.q[ks] = *(const bf16x8*)(qp + ks * 16);
    const bf16_t* Kg = K + (size_t)lrow * INW + lc * 8;
    pre.k0 = *(const u32x4*)(Kg); pre.k1 = *(const u32x4*)(Kg + (size_t)64 * INW); pre.s0k = *(const u32x4*)(Kg + (size_t)128 * INW);
    pre.s0v = *(const u32x4*)(VT + (size_t)lrow * ldv + lc * 8);
}

template <bool FIXM>
DI void attn_item(const bf16_t* __restrict__ Q, int ldq, const bf16_t* __restrict__ K, int ldk, const bf16_t* __restrict__ VT, int ldv,
                  int nkeys, bf16_t* __restrict__ O, const bf16_t* __restrict__ G, unsigned char* smem, float mfix,
                  AttnPre& pre, const bf16_t* __restrict__ nQ, const bf16_t* __restrict__ nK, const bf16_t* __restrict__ nVT, int nldv) {
    const int tid = opaque_tid(), lane = tid & 63, wave = tid >> 6;
    const int r = lane & 31, h = lane >> 5;
    bf16x8 qf[4];
#pragma unroll
    for (int ks = 0; ks < 4; ++ks) qf[ks] = pre.q[ks];
    const int lrow = tid >> 3, lc = tid & 7;
    const bf16_t* Kg = K + (size_t)lrow * ldk + lc * 8;
    const bf16_t* Vg = VT + (size_t)lrow * ldv + lc * 8;
    const int st_off = lrow * 128 + ((lc ^ ((lrow >> 1) & 7)) << 4);
    const int pr = (r & ~12) | ((r & 4) << 1) | ((r & 8) >> 1);
    const int kswz = (pr >> 1) & 7, vswz = (r >> 1) & 7;
    const int k_off = pr * 128, v_off = r * 128;
    const int nt = nkeys >> 6;

    f32x16 o0, o1, sa0, sa1, sb0, sb1;
#pragma unroll
    for (int i = 0; i < 16; ++i) { o0[i] = 0.f; o1[i] = 0.f; }
    float m = FIXM ? mfix : -1e30f, lsum = 0.f;
    bf16x8 pa[4], pb[4];

    u32x4 rk, rv;
#define A_LOAD(U) { const int kt_ = ((U) + 2 < nt) ? (U) + 2 : nt - 1; rk = *(const u32x4*)(Kg + (size_t)(kt_ * 64) * ldk); rv = *(const u32x4*)(Vg + (U) * 64); }
#define A_STORE(OFF) { *(u32x4*)(smem + (OFF) + st_off) = rk; *(u32x4*)(smem + (OFF) + 8192 + st_off) = rv; }
    lds_barrier();
    *(u32x4*)(smem + 16384 + st_off) = pre.k0; *(u32x4*)(smem + 16384 + 8192 + st_off) = pre.k1;
    *(u32x4*)(smem + st_off) = pre.s0k; *(u32x4*)(smem + 8192 + st_off) = pre.s0v;
    A_LOAD(1);
    lds_barrier();
    {
        const unsigned char* kp = smem + 16384;
        sa0 = mfma32(KFRAG(0, 0), qf[0], (f32x16){0.f, 0.f, 0.f, 0.f, 0.f, 0.f, 0.f, 0.f, 0.f, 0.f, 0.f, 0.f, 0.f, 0.f, 0.f, 0.f});
        sa1 = mfma32(KFRAG(0, 1), qf[0], (f32x16){0.f, 0.f, 0.f, 0.f, 0.f, 0.f, 0.f, 0.f, 0.f, 0.f, 0.f, 0.f, 0.f, 0.f, 0.f, 0.f});
#pragma unroll
        for (int ks = 1; ks < 4; ++ks) { sa0 = mfma32(KFRAG(ks, 0), qf[ks], sa0); sa1 = mfma32(KFRAG(ks, 1), qf[ks], sa1); }
    }
    attn_step<false, true, FIXM>(sa0, sa1, sb0, sb1, pb, pa, o0, o1, m, lsum, qf, smem + 16384 + 8192, smem, k_off, kswz, v_off, vswz, h);
    lds_barrier();
    for (int t = 1; t < nt - 1; t += 2) {
        A_STORE(16384);
        A_LOAD(t + 1);
        SB_();
        attn_step<true, true, FIXM>(sb0, sb1, sa0, sa1, pa, pb, o0, o1, m, lsum, qf, smem, smem + 8192, k_off, kswz, v_off, vswz, h);
        lds_barrier();
        A_STORE(0);
        A_LOAD(t + 2);
        SB_();
        attn_step<true, true, FIXM>(sa0, sa1, sb0, sb1, pb, pa, o0, o1, m, lsum, qf, smem + 16384, smem + 16384 + 8192, k_off, kswz, v_off, vswz, h);
        lds_barrier();
    }
    A_STORE(16384);
    const bf16_t* gp = G + (size_t)(wave * 32 + r) * INW + 8 * h;
    u32x4 gw[4];
#pragma unroll
    for (int pp = 0; pp < 4; ++pp) gw[pp] = *(const u32x4*)(gp + 16 * pp);
    attn_prefetch(pre, nQ, nK, nVT, nldv, tid);
    SB_();
    attn_step<true, false, FIXM>(sb0, sb1, sa0, sa1, pa, pb, o0, o1, m, lsum, qf, smem, smem + 8192, k_off, kswz, v_off, vswz, h);
    lds_barrier();
    {
        const unsigned char* vp = smem + 16384 + 8192;
#pragma unroll
        for (int kk = 0; kk < 4; ++kk) { o0 = mfma32(VFRAG(kk, 0), pb[kk], o0); o1 = mfma32(VFRAG(kk, 1), pb[kk], o1); }
    }
#undef A_LOAD
#undef A_STORE
    const float lt = x32_add(lsum);
    const float inv = 1.0f / lt;
    bf16_t* op = O + (size_t)(wave * 32 + r) * 1024 + 8 * h;
    *(u32x4*)(op) = o_pair_wide(o0, 0, inv, gw[0]);
    *(u32x4*)(op + 16) = o_pair_wide(o0, 2, inv, gw[1]);
    *(u32x4*)(op + 32) = o_pair_wide(o1, 0, inv, gw[2]);
    *(u32x4*)(op + 48) = o_pair_wide(o1, 2, inv, gw[3]);
}

DI void cross_item(const bf16_t* __restrict__ Q, const bf16_t* __restrict__ K, const bf16_t* __restrict__ VT,
                   bf16_t* __restrict__ O, const bf16_t* __restrict__ G, unsigned char* smem) {
    const int tid = opaque_tid(), lane = tid & 63, wave = tid >> 6;
    const int r = lane & 31, h = lane >> 5;
    bf16x8 qf[4];
    {
        const bf16_t* qp = Q + (size_t)(wave * 32 + r) * INW + h * 8;
#pragma unroll
        for (int ks = 0; ks < 4; ++ks) qf[ks] = *(const bf16x8*)(qp + ks * 16);
    }
    const int lrow = tid >> 3, lc = tid & 7;
    const int st_off = lrow * 128 + ((lc ^ ((lrow >> 1) & 7)) << 4);
    {
        u32x4 kk[4], vv[4];
#pragma unroll
        for (int i = 0; i < 4; ++i) { kk[i] = *(const u32x4*)(K + (size_t)(lrow + 64 * i) * 256 + lc * 8); vv[i] = *(const u32x4*)(VT + (size_t)lrow * 256 + (i * 8 + lc) * 8); }
        __syncthreads();
#pragma unroll
        for (int i = 0; i < 4; ++i) { *(u32x4*)(smem + i * 16384 + st_off) = kk[i]; *(u32x4*)(smem + i * 16384 + 8192 + st_off) = vv[i]; }
    }
    const bf16_t* gp = G + (size_t)(wave * 32 + r) * INW + 8 * h;
    u32x4 gw[4];
#pragma unroll
    for (int pp = 0; pp < 4; ++pp) gw[pp] = *(const u32x4*)(gp + 16 * pp);
    __syncthreads();
    const int pr = (r & ~12) | ((r & 4) << 1) | ((r & 8) >> 1);
    const int kswz = (pr >> 1) & 7, vswz = (r >> 1) & 7;
    const int k_off = pr * 128, v_off = r * 128;
    f32x16 o0, o1;
#pragma unroll
    for (int i = 0; i < 16; ++i) { o0[i] = 0.f; o1[i] = 0.f; }
    float m = -1e30f, lsum = 0.f;
#pragma unroll
    for (int kt = 0; kt < 4; ++kt) {
        const unsigned char* kp = smem + kt * 16384;
        const unsigned char* vp = kp + 8192;
        f32x16 s0, s1;
        s0 = mfma32(KFRAG(0, 0), qf[0], (f32x16){0.f, 0.f, 0.f, 0.f, 0.f, 0.f, 0.f, 0.f, 0.f, 0.f, 0.f, 0.f, 0.f, 0.f, 0.f, 0.f});
        s1 = mfma32(KFRAG(0, 1), qf[0], (f32x16){0.f, 0.f, 0.f, 0.f, 0.f, 0.f, 0.f, 0.f, 0.f, 0.f, 0.f, 0.f, 0.f, 0.f, 0.f, 0.f});
#pragma unroll
        for (int ks = 1; ks < 4; ++ks) { s0 = mfma32(KFRAG(ks, 0), qf[ks], s0); s1 = mfma32(KFRAG(ks, 1), qf[ks], s1); }
        float mx = s0[0];
        mx = max8(s0, 0, mx); mx = max8(s0, 8, mx); mx = max8(s1, 0, mx); mx = max8(s1, 8, mx);
        mx = xhalf_max(mx);
        const float mnew = fmaxf(m, mx);
        const float alpha = __builtin_amdgcn_exp2f(m - mnew);
        m = mnew;
        const float mb = mnew;
        float rs = 0.f;
#pragma unroll
        for (int i = 0; i < 16; ++i) { s0[i] = __builtin_amdgcn_exp2f(s0[i] - mb); s1[i] = __builtin_amdgcn_exp2f(s1[i] - mb); rs += s0[i] + s1[i]; }
        lsum = lsum * alpha + rs;
#pragma unroll
        for (int i = 0; i < 16; ++i) { o0[i] *= alpha; o1[i] *= alpha; }
        bf16x8 pf[4];
        pf[0] = PACK8(s0, 0); pf[1] = PACK8(s0, 8); pf[2] = PACK8(s1, 0); pf[3] = PACK8(s1, 8);
#pragma unroll
        for (int kk2 = 0; kk2 < 4; ++kk2) { o0 = mfma32(VFRAG(kk2, 0), pf[kk2], o0); o1 = mfma32(VFRAG(kk2, 1), pf[kk2], o1); }
    }
    const float lt = x32_add(lsum);
    const float inv = 1.0f / lt;
    bf16_t* op = O + (size_t)(wave * 32 + r) * 1024 + 8 * h;
    *(u32x4*)(op) = o_pair_wide(o0, 0, inv, gw[0]);
    *(u32x4*)(op + 16) = o_pair_wide(o0, 2, inv, gw[1]);
    *(u32x4*)(op + 32) = o_pair_wide(o1, 0, inv, gw[2]);
    *(u32x4*)(op + 48) = o_pair_wide(o1, 2, inv, gw[3]);
}

template <int HALF>
DI void pool_window(bf16x8 (&df)[2], const unsigned char* smem, int ti, int r16, int q4, int g, int t0, int T) {
    constexpr int RS = 528;
#pragma unroll
    for (int ks = 0; ks < 2; ++ks) {
        const int tl = ti * 16 + r16, t = t0 + tl;
        const int lo = max(t - HALF, 0), hi = min(t + HALF, T);
        const float icnt = 1.0f / (float)(hi - lo);
        float s[8];
#pragma unroll
        for (int j = 0; j < 8; ++j) s[j] = 0.f;
        const unsigned char* bp = smem + (tl + 8 - HALF) * RS + (g * 64 + ks * 32 + q4 * 8) * 2;
#pragma unroll
        for (int j = 0; j < 2 * HALF; ++j) {
            const u32x4 v = *(const u32x4*)(bp + j * RS);
            s[0] += bflo(v.x); s[1] += bfhi(v.x); s[2] += bflo(v.y); s[3] += bfhi(v.y);
            s[4] += bflo(v.z); s[5] += bfhi(v.z); s[6] += bflo(v.w); s[7] += bfhi(v.w);
        }
        const u32x4 c = *(const u32x4*)(bp + HALF * RS);
        u32x4 o;
        o.x = pk_bf16(s[0] * icnt - bflo(c.x), s[1] * icnt - bfhi(c.x));
        o.y = pk_bf16(s[2] * icnt - bflo(c.y), s[3] * icnt - bfhi(c.y));
        o.z = pk_bf16(s[4] * icnt - bflo(c.z), s[5] * icnt - bfhi(c.z));
        o.w = pk_bf16(s[6] * icnt - bflo(c.w), s[7] * icnt - bfhi(c.w));
        df[ks] = __builtin_bit_cast(bf16x8, o);
    }
}

struct PoolPre { u32x4 u[5]; u32x4 gg[2][2]; };
DI void pool_prefetch(PoolPre& pp, const bf16_t* __restrict__ Z, int tokg0, int tid) {
    const int lane = tid & 63, wave = tid >> 6, ti = wave & 3, gp = wave >> 2, r16 = lane & 15, q4 = lane >> 4;
    const int T = (tokg0 < NPROMPT) ? 2048 : 4096, t0 = tokg0 & (T - 1);
#pragma unroll
    for (int k = 0; k < 5; ++k) {
        const int id = tid + 512 * k, rr = id >> 5, c = id & 31, t = t0 - 8 + rr;
        u32x4 v = (u32x4){0u, 0u, 0u, 0u};
        if (t >= 0 && t < T) v = *(const u32x4*)(Z + (size_t)(tokg0 - 8 + rr) * INW + c * 8);
        pp.u[k] = v;
    }
#pragma unroll
    for (int s = 0; s < 2; ++s) {
        const int g = s ? (gp ? 2 : 3) : (gp ? 1 : 0);
#pragma unroll
        for (int pr = 0; pr < 2; ++pr)
            pp.gg[s][pr] = *(const u32x4*)(Z + ((size_t)tokg0 + ti * 16 + r16) * INW + 256 + g * 64 + pr * 32 + 8 * q4);
    }
}
DI void pool_phase(const bf16_t* __restrict__ Z, const bf16_t* __restrict__ PWT, const float* __restrict__ pscale, bf16_t* __restrict__ MIX,
                   int bid, int nb, unsigned char* smem) {
    if (bid >= 768) return;
    const int tid = opaque_tid(), lane = tid & 63, wave = tid >> 6;
    constexpr int RS = 528;
    const int ti = wave & 3, gp = wave >> 2, r16 = lane & 15, q4 = lane >> 4;
    const int g0 = gp ? 1 : 0, g1 = gp ? 2 : 3;
    bf16x8 wfr[2][4][2]; f32x4 psr[2][4];
#pragma unroll
    for (int s = 0; s < 2; ++s) {
        const int g = s ? g1 : g0;
#pragma unroll
        for (int fi = 0; fi < 4; ++fi) {
            const int nrow = 32 * (fi >> 1) + 8 * (r16 >> 2) + 4 * (fi & 1) + (r16 & 3);
#pragma unroll
            for (int ks = 0; ks < 2; ++ks) wfr[s][fi][ks] = *(const bf16x8*)(PWT + (size_t)g * 4096 + nrow * 64 + ks * 32 + q4 * 8);
            psr[s][fi] = *(const f32x4*)(pscale + g * 64 + 32 * (fi >> 1) + 8 * q4 + 4 * (fi & 1));
        }
    }
    PoolPre pp;
    pool_prefetch(pp, Z, bid * 64, tid);
    for (int i = bid; i < 768; i += nb) {
        const int tokg0 = i * 64;
        const int T = (tokg0 < NPROMPT) ? 2048 : 4096, t0 = tokg0 & (T - 1);
        lds_barrier();
#pragma unroll
        for (int k = 0; k < 5; ++k) { const int id = tid + 512 * k, rr = id >> 5, c = id & 31; *(u32x4*)(smem + rr * RS + c * 16) = pp.u[k]; }
        u32x4 gcur[2][2];
#pragma unroll
        for (int s = 0; s < 2; ++s) { gcur[s][0] = pp.gg[s][0]; gcur[s][1] = pp.gg[s][1]; }
        pool_prefetch(pp, Z, ((i + nb < 768) ? i + nb : i) * 64, tid);
        lds_barrier();
        const size_t tok = (size_t)tokg0 + ti * 16 + r16;
#pragma unroll
        for (int s = 0; s < 2; ++s) {
            const int g = s ? g1 : g0;
            bf16x8 df[2];
            if (gp == 0) { if (s == 0) pool_window<1>(df, smem, ti, r16, q4, g, t0, T); else pool_window<8>(df, smem, ti, r16, q4, g, t0, T); }
            else         { if (s == 0) pool_window<2>(df, smem, ti, r16, q4, g, t0, T); else pool_window<4>(df, smem, ti, r16, q4, g, t0, T); }
            f32x4 acc[4];
#pragma unroll
            for (int a = 0; a < 4; ++a) acc[a] = (f32x4){0.f, 0.f, 0.f, 0.f};
#pragma unroll
            for (int fi = 0; fi < 4; ++fi)
#pragma unroll
                for (int ks = 0; ks < 2; ++ks) acc[fi] = mfma16(wfr[s][fi][ks], df[ks], acc[fi]);
#pragma unroll
            for (int pr = 0; pr < 2; ++pr) {
                const u32x4 gg = gcur[s][pr];
                const f32x4 a = acc[2 * pr], b = acc[2 * pr + 1], pa = psr[s][2 * pr], pb = psr[s][2 * pr + 1];
                u32x4 w;
                w.x = pk_bf16(a[0] * pa[0] * bflo(gg.x), a[1] * pa[1] * bfhi(gg.x)); w.y = pk_bf16(a[2] * pa[2] * bflo(gg.y), a[3] * pa[3] * bfhi(gg.y));
                w.z = pk_bf16(b[0] * pb[0] * bflo(gg.z), b[1] * pb[1] * bfhi(gg.z)); w.w = pk_bf16(b[2] * pb[2] * bflo(gg.w), b[3] * pb[3] * bfhi(gg.w));
                *(u32x4*)(MIX + tok * 1024 + g * 64 + pr * 32 + 8 * q4) = w;
            }
        }
    }
}

struct PostIn { u32x4 yv[2]; f32x4 xv[4]; };
DI PostIn post_row_load(const float* __restrict__ xsrc, const bf16_t* __restrict__ yh, int lane) {
    PostIn r;
#pragma unroll
    for (int j = 0; j < 2; ++j) r.yv[j] = *(const u32x4*)(yh + j * 512 + lane * 8);
#pragma unroll
    for (int j = 0; j < 2; ++j) { r.xv[2 * j] = *(const f32x4*)(xsrc + j * 512 + lane * 8); r.xv[2 * j + 1] = *(const f32x4*)(xsrc + j * 512 + lane * 8 + 4); }
    return r;
}
DI void post_row_finish(const PostIn& in, bf16_t* __restrict__ yh, const float* __restrict__ gpost, const float* __restrict__ gpre_next,
                        float* __restrict__ xdst, bool last, int lane) {
    u32x4 yv[2]; f32x4 xv[4];
#pragma unroll
    for (int j = 0; j < 2; ++j) yv[j] = in.yv[j];
#pragma unroll
    for (int j = 0; j < 4; ++j) xv[j] = in.xv[j];
    float y[16];
#pragma unroll
    for (int j = 0; j < 2; ++j) {
        y[8 * j + 0] = bflo(yv[j].x); y[8 * j + 1] = bfhi(yv[j].x); y[8 * j + 2] = bflo(yv[j].y); y[8 * j + 3] = bfhi(yv[j].y);
        y[8 * j + 4] = bflo(yv[j].z); y[8 * j + 5] = bfhi(yv[j].z); y[8 * j + 6] = bflo(yv[j].w); y[8 * j + 7] = bfhi(yv[j].w);
    }
    float ss = 0.f;
#pragma unroll
    for (int i = 0; i < 16; ++i) ss += y[i] * y[i];
    ss = wave_sum(ss);
    const float r = rsqrtf(ss * (1.0f / 1024.0f) + EPS);
    float xn[16]; float ss2 = 0.f;
#pragma unroll
    for (int j = 0; j < 2; ++j) {
        const f32x4 g0 = *(const f32x4*)(gpost + j * 512 + lane * 8), g1 = *(const f32x4*)(gpost + j * 512 + lane * 8 + 4);
#pragma unroll
        for (int i = 0; i < 4; ++i) {
            xn[8 * j + i] = xv[2 * j][i] + y[8 * j + i] * r * g0[i];
            xn[8 * j + 4 + i] = xv[2 * j + 1][i] + y[8 * j + 4 + i] * r * g1[i];
        }
    }
#pragma unroll
    for (int i = 0; i < 16; ++i) ss2 += xn[i] * xn[i];
#pragma unroll
    for (int j = 0; j < 2; ++j) {
        *(f32x4*)(xdst + j * 512 + lane * 8) = (f32x4){xn[8 * j], xn[8 * j + 1], xn[8 * j + 2], xn[8 * j + 3]};
        *(f32x4*)(xdst + j * 512 + lane * 8 + 4) = (f32x4){xn[8 * j + 4], xn[8 * j + 5], xn[8 * j + 6], xn[8 * j + 7]};
    }
    if (!last) {
        ss2 = wave_sum(ss2);
        const float r2 = rsqrtf(ss2 * (1.0f / 1024.0f) + EPS);
#pragma unroll
        for (int j = 0; j < 2; ++j) {
            const f32x4 g0 = *(const f32x4*)(gpre_next + j * 512 + lane * 8), g1 = *(const f32x4*)(gpre_next + j * 512 + lane * 8 + 4);
            u32x4 o;
            o.x = pk_bf16(xn[8 * j] * r2 * g0[0], xn[8 * j + 1] * r2 * g0[1]);
            o.y = pk_bf16(xn[8 * j + 2] * r2 * g0[2], xn[8 * j + 3] * r2 * g0[3]);
            o.z = pk_bf16(xn[8 * j + 4] * r2 * g1[0], xn[8 * j + 5] * r2 * g1[1]);
            o.w = pk_bf16(xn[8 * j + 6] * r2 * g1[2], xn[8 * j + 7] * r2 * g1[3]);
            *(u32x4*)(yh + j * 512 + lane * 8) = o;
        }
    }
}

#define XB_TMO      128
#define XB_XCNT(j)  (256  + 64 * (j))
#define XB_XSUB(j)  (1280 + 64 * (j))
#define XB_XGEN(j)  (2304 + 64 * (j))
#define XB_TOP      3328
#define XB_TOPGEN   3392
#define XCD_BAR_WORDS 3456
#define XB_SPIN_CAP (1u << 18)
#define LAS __attribute__((address_space(3)))
DI unsigned xb_ld(unsigned* p)              { return __hip_atomic_load(p, __ATOMIC_RELAXED, __HIP_MEMORY_SCOPE_AGENT); }
DI unsigned xb_add(unsigned* p, unsigned v) { return __hip_atomic_fetch_add(p, v, __ATOMIC_RELAXED, __HIP_MEMORY_SCOPE_AGENT); }
DI unsigned xb_xcc_id() { return (unsigned)__builtin_amdgcn_s_getreg((3 << 11) | 20) & 0xFu; }
#define XB_SPIN(cond, bar) do { unsigned _sp = 0; while (cond) { __builtin_amdgcn_s_sleep(1); \
    if ((++_sp & 255u) == 0u) { if (xb_ld(&(bar)[XB_TMO])) break; if (_sp > XB_SPIN_CAP) { atomicAdd(&(bar)[XB_TMO], 1u); break; } } } } while (0)
struct XcdBarrier { unsigned* bar; unsigned x; volatile LAS unsigned* st; };
DI XcdBarrier xcd_barrier_post(unsigned* bar, volatile LAS unsigned* st) {
    XcdBarrier b; b.bar = bar; b.x = xb_xcc_id(); b.st = st;
    if (threadIdx.x == 0) (void)xb_add(&bar[XB_XCNT(b.x)], 1u);
    return b;
}
DI void xcd_barrier_complete(unsigned* bar, unsigned x, unsigned& nloc, unsigned& nx) {
    const unsigned G = gridDim.x * gridDim.y * gridDim.z;
    unsigned sum, cnt, mine, sp = 0u;
    for (;;) {
        sum = 0u; cnt = 0u; mine = 0u;
#pragma unroll
        for (unsigned j = 0; j < 16; ++j) { const unsigned c = xb_ld(&bar[XB_XCNT(j)]); sum += c; cnt += (c > 0u) ? 1u : 0u; mine = (j == x) ? c : mine; }
        if (sum == G) break;
        __builtin_amdgcn_s_sleep(1);
        if ((++sp & 255u) == 0u) { if (xb_ld(&bar[XB_TMO])) break; if (sp > XB_SPIN_CAP) { atomicAdd(&bar[XB_TMO], 1u); break; } }
    }
    nloc = mine > 0u ? mine : 1u; nx = cnt > 0u ? cnt : 1u;
}
DI void xcd_barrier(const XcdBarrier& b) {
    asm volatile("s_waitcnt vmcnt(0)" ::: "memory");
    __syncthreads();
    if (threadIdx.x == 0) {
        unsigned* bar = b.bar;
        __builtin_amdgcn_s_waitcnt(0);
        unsigned nloc = b.st[0], nx = b.st[1];
        if (nloc == 0u) { xcd_barrier_complete(bar, b.x, nloc, nx); b.st[0] = nloc; b.st[1] = nx; }
        const unsigned old = xb_add(&bar[XB_XSUB(b.x)], 1u);
        const unsigned gen = old / nloc;
        if (old + 1u == (gen + 1u) * nloc) {
            __builtin_amdgcn_fence(__ATOMIC_RELEASE, "agent");
            asm volatile("s_waitcnt vmcnt(0)" ::: "memory");
            const unsigned og = xb_add(&bar[XB_TOP], 1u);
            const unsigned tg = og / nx;
            if (og + 1u == (tg + 1u) * nx) xb_add(&bar[XB_TOPGEN], 1u);
            else XB_SPIN(xb_ld(&bar[XB_TOPGEN]) == tg, bar);
            __builtin_amdgcn_fence(__ATOMIC_ACQUIRE, "agent");
            xb_add(&bar[XB_XGEN(b.x)], 1u);
            asm volatile("s_waitcnt vmcnt(0)" ::: "memory");
        } else {
            XB_SPIN(xb_ld(&bar[XB_XGEN(b.x)]) == gen, bar);
            __builtin_amdgcn_fence(__ATOMIC_ACQUIRE, "agent");
            asm volatile("s_waitcnt vmcnt(0)" ::: "memory");
        }
    }
    __syncthreads();
}

__global__ void __launch_bounds__(512, 2) fwd_megakernel(Params p) {
    __shared__ __attribute__((aligned(16))) unsigned char smem[131072];
    __shared__ uint4 xb_words;
    cg::grid_group grid = cg::this_grid();
    const int nb = gridDim.x, bid = blockIdx.x;
    if (threadIdx.x == 0) xb_words = make_uint4(0u, 0u, 0u, 0u);
    __syncthreads();
    XcdBarrier xb = xcd_barrier_post((unsigned*)(p.ws + OFF_BAR), (volatile LAS unsigned*)&xb_words);
    if (p.phase_end > 1000) grid.sync();
    for (int ph = p.phase_begin; ph < p.phase_end; ++ph) {
        unsigned char* ws = p.ws;
        bf16_t* H = (bf16_t*)(ws + OFF_H);
        bf16_t* Z = (bf16_t*)(ws + OFF_Z);
        bf16_t* VT = (bf16_t*)(ws + OFF_VT);
        bf16_t* MIX = (bf16_t*)(ws + OFF_MIX);
        bf16_t* WIN = (bf16_t*)(ws + OFF_WIN);
        bf16_t* WOUT = (bf16_t*)(ws + OFF_WOUT);
        bf16_t* WMEM = (bf16_t*)(ws + OFF_WMEM);
        bf16_t* PW = (bf16_t*)(ws + OFF_PW);
        bf16_t* MH = (bf16_t*)(ws + OFF_MH);
        bf16_t* KM = (bf16_t*)(ws + OFF_KM);
        bf16_t* VMT = (bf16_t*)(ws + OFF_VMT);
        float* ROPE = (float*)(ws + OFF_ROPE);
        if (ph == 0) {
            for (int i = bid; i < 1928; i += nb) {
                if (i < 1152) { const int l = i / 576, j = i % 576, kt = j / 36, ntile = j % 36;
                    transpose_tile(p.w_in + (size_t)l * DM * INW, INW, WIN + (size_t)l * INW * DM, DM, kt * 64, ntile * 64, smem);
                } else if (i < 1664) { const int ii = i - 1152, l = ii / 256, j = ii % 256, kt = j / 16, ntile = j % 16;
                    transpose_tile(p.w_out + (size_t)l * DM * DM, DM, WOUT + (size_t)l * DM * DM, DM, kt * 64, ntile * 64, smem);
                } else if (i < 1920) { const int ii = i - 1664, l = ii / 128, j = ii % 128, kt = j / 8, ntile = j % 8;
                    transpose_tile(p.w_mem_kv + (size_t)l * DM * 512, 512, WMEM + (size_t)l * 512 * DM, DM, kt * 64, ntile * 64, smem);
                } else { const int ii = i - 1920;
                    transpose_tile(p.pool_w + (size_t)ii * 4096, 64, PW + (size_t)ii * 4096, 64, 0, 0, smem);
                }
            }
            {
                const int tid = opaque_tid(), lane = tid & 63, wave = tid >> 6;
                constexpr int NR = NTOK + NMEMTOK;
                auto desc = [&](int i, const float*& src, const float*& g, bf16_t*& dst, const float*& gb, bf16_t*& dstb) {
                    if (i < NTOK) { src = (i < NPROMPT) ? p.x_prompt + (size_t)i * DM : p.x_sample + (size_t)(i - NPROMPT) * DM; g = p.norm_pre; dst = H + (size_t)i * DM; gb = nullptr; dstb = nullptr; }
                    else { const int mt = i - NTOK;
                           src = (mt < 4096) ? p.mem_prompt + (size_t)mt * DM : p.mem_sample + (size_t)(mt - 4096) * DM;
                           g = p.mem_norm; dst = MH + (size_t)mt * DM; gb = p.mem_norm + DM; dstb = MH + ((size_t)NMEMTOK + mt) * DM; }
                };
                int i = bid * 8 + wave;
                if (i < NR) {
                    const float *s, *g, *gb; bf16_t *d, *db; desc(i, s, g, d, gb, db);
                    RowIn cur = rms_row_load(s, lane);
                    for (; i < NR; i += nb * 8) {
                        const int in = (i + nb * 8 < NR) ? i + nb * 8 : NR - 1;
                        const float *s2, *g2, *gb2; bf16_t *d2, *db2; desc(in, s2, g2, d2, gb2, db2);
                        const RowIn nxt = rms_row_load(s2, lane);
                        rms_row_finish(cur, g, d, lane, gb, db);
                        cur = nxt; g = g2; d = d2; gb = gb2; db = db2;
                    }
                }
            }
            { const int tid = opaque_tid(); for (int i = bid * 512 + tid; i < 1024; i += nb * 512) rope_entry(i, ROPE); }
        } else {
            const int l = (ph - 1) >> 2, sub = (ph - 1) & 3;
            if (sub == 0) {
                EpiArgs e; e.C = Z; e.VT = VT; e.qn = p.q_norm + l * 64; e.kn = p.k_norm + l * 64; e.rope = ROPE;
                const bf16_t* Wl = WIN + (size_t)l * INW * DM;
                EpiArgs e2; e2.C = KM + (size_t)l * NMEMTOK * 256; e2.VT = VMT + (size_t)l * NMEMTOK * 256; e2.qn = nullptr; e2.kn = nullptr; e2.rope = nullptr;
                const bf16_t* Wm = WMEM + (size_t)l * 512 * DM;
                const bf16_t* Am = MH + (size_t)l * NMEMTOK * DM;
                auto tile1 = [&](int i, const bf16_t*& ta, const bf16_t*& tb, int& tm0, int& tn0) {
                    if (i < 1728) {
                        const int j = i >> 3, mg = j / 72, rem = j % 72;
                        tm0 = ((i & 7) * 24 + mg * 8 + (rem & 7)) * 256; tn0 = (rem >> 3) * 256; ta = H; tb = Wl;
                    } else { const int j = i - 1728; tm0 = (j >> 1) * 256; tn0 = (j & 1) * 256; ta = Am; tb = Wm; }
                };
                bool pre = false;
                for (int i = bid; i < 1728 + 40; i += nb) {
                    const bf16_t *ta, *tb, *na = nullptr, *nbp = nullptr; int tm0, tn0, xm = 0, xn = 0;
                    tile1(i, ta, tb, tm0, tn0);
                    if (i + nb < 1728 + 40) tile1(i + nb, na, nbp, xm, xn);
                    const bool nperm = (i + nb < 1728) ? !(xn >= 512 && xn < 1152) : (xn == 0);
                    if (i < 1728) gemm_tile<0>(ta, tb, tm0, tn0, e, smem, pre, na, nbp, xm, xn, nperm);
                    else gemm_tile<2>(ta, tb, tm0, tn0, e2, smem, pre, na, nbp, xm, xn, nperm);
                    pre = (na != nullptr);
                }
            } else if (sub == 1) {
                const int lane = opaque_tid() & 63;
                float gq = fabsf(p.q_norm[l * 64 + lane]), gk = fabsf(p.k_norm[l * 64 + lane]);
                gq = wave_max(gq); gk = wave_max(gk);
                const float mfix = 8.0f * gq * gk * 1.02f * L2E;
                const bool fixm = mfix < 28.0f;
                {
                    auto sdec = [&](int i, const bf16_t*& q, const bf16_t*& k, const bf16_t*& vt, int& T, bf16_t*& o, const bf16_t*& g) {
                        int b, kvh, j; size_t tok0, vtb;
                        if (i < 512) { const int R = i >> 8, ip = i & 255, grp = ip & 7; j = R * 32 + (ip >> 3); b = grp >> 1; kvh = grp & 1; T = 4096;
                            tok0 = (size_t)NPROMPT + (size_t)b * 4096; vtb = (size_t)NPROMPT * 128 + ((size_t)(b * 2 + kvh) * 64) * 4096; }
                        else { const int ii = i - 512, R = ii >> 8, ip = ii & 255, grp = R * 8 + (ip & 7); j = ip >> 3; b = grp >> 1; kvh = grp & 1; T = 2048;
                            tok0 = (size_t)b * 2048; vtb = ((size_t)(b * 2 + kvh) * 64) * 2048; }
                        const int qblk = j >> 2, head = kvh * 4 + (j & 3);
                        const size_t q0 = tok0 + (size_t)qblk * 256;
                        q = Z + q0 * INW + 512 + head * 64; k = Z + tok0 * INW + 1024 + kvh * 64; vt = VT + vtb;
                        o = MIX + q0 * 1024 + 256 + head * 64; g = Z + q0 * INW + 1280 + head * 64;
                    };
                    if (bid < 1536) {
                        AttnPre pre;
                        { const bf16_t *q, *k, *vt, *g; bf16_t* o; int T; sdec(bid, q, k, vt, T, o, g); attn_prefetch(pre, q, k, vt, T, opaque_tid()); }
                        __builtin_amdgcn_s_waitcnt(0x0F70);
                        for (int i = bid; i < 1536; i += nb) {
                            const bf16_t *q, *k, *vt, *g, *nq, *nk, *nvt, *ng; bf16_t *o, *no; int T, nT;
                            sdec(i, q, k, vt, T, o, g);
                            sdec((i + nb < 1536) ? i + nb : i, nq, nk, nvt, nT, no, ng);
                            if (fixm) attn_item<true>(q, INW, k, INW, vt, T, T, o, g, smem, mfix, pre, nq, nk, nvt, nT);
                            else attn_item<false>(q, INW, k, INW, vt, T, T, o, g, smem, 0.f, pre, nq, nk, nvt, nT);
                        }
                    }
                }
                for (int i = bid; i < 768; i += nb) {
                    const int qb = i >> 2, hx = i & 3;
                    const size_t q0 = (size_t)qb * 256;
                    const int b = (q0 < NPROMPT) ? (int)(q0 >> 11) : 16 + (int)((q0 - NPROMPT) >> 12);
                    cross_item(Z + q0 * INW + 1792 + hx * 64, KM + ((size_t)l * NMEMTOK + (size_t)b * 256) * 256 + hx * 64,
                               VMT + (size_t)l * NMEMTOK * 256 + ((size_t)(b * 4 + hx) * 64) * 256,
                               MIX + q0 * 1024 + 768 + hx * 64, Z + q0 * INW + 2048 + hx * 64, smem);
                }
                pool_phase(Z, PW + (size_t)l * 4 * 4096, p.pool_scale + l * 256, MIX, bid, nb, smem);
            } else if (sub == 2) {
                EpiArgs e; e.C = H; e.VT = nullptr; e.qn = nullptr; e.kn = nullptr; e.rope = nullptr;
                const bf16_t* Wl = WOUT + (size_t)l * DM * DM;
                auto tile2 = [&](int i, int& tm0, int& tn0) {
                    const int j = i >> 3, mg = j >> 5, rem = j & 31;
                    tm0 = ((i & 7) * 24 + mg * 8 + (rem & 7)) * 256; tn0 = (rem >> 3) * 256;
                };
                bool pre = false;
                for (int i = bid; i < 768; i += nb) {
                    int tm0, tn0, xm = 0, xn = 0; tile2(i, tm0, tn0);
                    const bool more = (i + nb < 768);
                    if (more) tile2(i + nb, xm, xn);
                    gemm_tile<1>(MIX, Wl, tm0, tn0, e, smem, pre, more ? MIX : nullptr, Wl, xm, xn, true);
                    pre = more;
                }
            } else {
                const bool last = (l == DEPTH - 1);
                auto xsrc = [&](int i) -> const float* {
                    return (l == 0) ? ((i < NPROMPT) ? p.x_prompt + (size_t)i * DM : p.x_sample + (size_t)(i - NPROMPT) * DM) : p.out + (size_t)i * DM; };
                const int tid = opaque_tid(), lane = tid & 63, wave = tid >> 6;
                int i = bid * 8 + wave;
                if (i < NTOK) {
                    PostIn cur = post_row_load(xsrc(i), H + (size_t)i * DM, lane);
                    for (; i < NTOK; i += nb * 8) {
                        const int in = (i + nb * 8 < NTOK) ? i + nb * 8 : i;
                        const PostIn nxt = post_row_load(xsrc(in), H + (size_t)in * DM, lane);
                        post_row_finish(cur, H + (size_t)i * DM, p.norm_post + l * DM, p.norm_pre + (last ? l : l + 1) * DM, p.out + (size_t)i * DM, last, lane);
                        cur = nxt;
                    }
                }
            }
        }
        if (ph + 1 < p.phase_end) xcd_barrier(xb);
    }
}

extern "C" void kernel_launch(void* const* d_in, const int* in_sizes, int n_in, void* d_out, int out_size, void* d_ws, size_t ws_size,
                              hipStream_t stream) {
    static int grid_blocks = 0;
    if (!grid_blocks) {
        int dev = 0, cus = 0, per_cu = 0;
        hipGetDevice(&dev);
        hipDeviceGetAttribute(&cus, hipDeviceAttributeMultiprocessorCount, dev);
        hipOccupancyMaxActiveBlocksPerMultiprocessor(&per_cu, fwd_megakernel, 512, 0);
        if (per_cu > 1) per_cu = 1;
        if (per_cu < 1) per_cu = 1;
        grid_blocks = cus * per_cu;
    }
    Params p{};
    p.x_prompt = (const float*)d_in[0]; p.x_sample = (const float*)d_in[1]; p.mem_prompt = (const float*)d_in[2]; p.mem_sample = (const float*)d_in[3];
    p.norm_pre = (const float*)d_in[4]; p.norm_post = (const float*)d_in[5]; p.w_in = (const float*)d_in[6]; p.pool_w = (const float*)d_in[7];
    p.pool_scale = (const float*)d_in[8]; p.q_norm = (const float*)d_in[9]; p.k_norm = (const float*)d_in[10]; p.mem_norm = (const float*)d_in[11];
    p.w_mem_kv = (const float*)d_in[12]; p.w_out = (const float*)d_in[13];
    p.out = (float*)d_out; p.ws = (unsigned char*)d_ws;
    p.phase_begin = 0; p.phase_end = 1 + 4 * DEPTH;
    if (ws_size < WS_TOTAL) { fprintf(stderr, "workspace too small: %zu < %zu\n", ws_size, (size_t)WS_TOTAL); return; }
    hipMemsetAsync((unsigned char*)d_ws + OFF_BAR, 0, BAR_BYTES, stream);
    void* args[] = {&p};
    hipError_t e = hipLaunchCooperativeKernel((void*)fwd_megakernel, dim3(grid_blocks), dim3(512), args, 0, stream);
    if (e != hipSuccess) fprintf(stderr, "cooperative launch failed: %s (grid %d)\n", hipGetErrorString(e), grid_blocks);
}
```
